# Optimizing an MI355X kernel written in HIP

```python
import math
import jax
import jax.numpy as jnp
from jax import lax
import numpy as np

D_MODEL = 1024
BATCH = 8
SEQ = 8192
DEPTH = 2

GRID_W = 64
CTX_LEN = 256
EPS = 1e-6

HY_WIDTH = 384
HY_ORDER = 2
HY_BANDS = 8
HY_FEAT = 1 + 2 * HY_BANDS
HY_FILTER_HIDDEN = 64
HY_FILTER_OUT = 2 * HY_ORDER * HY_WIDTH
HY_MIN_DECAY = -math.log(1e-2) / 1.5
HY_MAX_DECAY = -math.log(1e-2) / 0.3

S5_WIDTH = 384
S5_GROUP = 16
S5_GROUPS = S5_WIDTH // S5_GROUP
S5_STATE = 64
S5_MIN_STEP = 1e-3
S5_MAX_STEP = 1e-1

MLA_HEADS = 8
MLA_NOPE = 64
MLA_ROPE = 32
MLA_V = 64
MLA_Q_LORA = 512
MLA_KV_LORA = 256
MLA_WIDTH = MLA_HEADS * MLA_V
MLA_SCALE = (MLA_NOPE + MLA_ROPE) ** -0.5
ROPE_THETA = 10000.0
Q_BLOCK = 128

FFN_HIDDEN = 2816

N_BRANCH = 3
COL_S5 = 0
COL_KV = COL_S5 + S5_WIDTH
COL_KR = COL_KV + MLA_KV_LORA
COL_Q = COL_KR + MLA_ROPE
COL_HY = COL_Q + MLA_Q_LORA
COL_GATE = COL_HY + (HY_ORDER + 1) * HY_WIDTH
IN_WIDTH = COL_GATE + N_BRANCH * D_MODEL
CTX_SIDE_COLS = COL_Q

kernel_name = "hybrid_hyena_s5_mla_prefix_dit"


def rmsnorm(x, g):
    xf = x.astype(jnp.float32)
    y = xf * lax.rsqrt(jnp.mean(xf * xf, axis=-1, keepdims=True) + EPS)
    return (y * g.astype(jnp.float32)).astype(x.dtype)


def dwconv3(x, w, b):
    xp = jnp.pad(x, ((0, 0), (1, 1), (0, 0)))
    return xp[:, :-2] * w[0] + xp[:, 1:-1] * w[1] + xp[:, 2:] * w[2] + b


def hyena_filters(L, f_w1, f_b1, f_w2, f_b2, f_w3, f_freq, f_decay):
    t = jnp.arange(L, dtype=jnp.float32)[:, None]
    t_norm = t / L
    bands = jnp.arange(1, HY_BANDS + 1, dtype=jnp.float32)
    ang = (2.0 * math.pi / L) * t * bands
    feats = jnp.concatenate([t_norm, jnp.cos(ang), jnp.sin(ang)], axis=-1)
    freq = f_freq.astype(jnp.float32)
    z = jnp.sin(freq * (feats @ f_w1.astype(jnp.float32) + f_b1.astype(jnp.float32)))
    z = jnp.sin(freq * (z @ f_w2.astype(jnp.float32) + f_b2.astype(jnp.float32)))
    h = (z @ f_w3.astype(jnp.float32)) * jnp.exp(-t_norm * jnp.abs(f_decay.astype(jnp.float32)))
    h = h.reshape(L, 2, HY_ORDER, HY_WIDTH)
    h = h / jnp.sum(jnp.abs(h), axis=(0, 1), keepdims=True)
    return h[:, 0], h[:, 1]


def bidir_long_conv(u, hf, hb, bias):
    L = u.shape[1]
    C = u.shape[2]
    taps = jnp.concatenate([hf, jnp.zeros((1, C), hf.dtype), hb[:0:-1]], axis=0)
    u_f = jnp.fft.rfft(u.astype(jnp.float32), n=2 * L, axis=1)
    t_f = jnp.fft.rfft(taps, n=2 * L, axis=0)
    y = jnp.fft.irfft(u_f * t_f[None], n=2 * L, axis=1)[:, :L]
    return (y + u.astype(jnp.float32) * bias.astype(jnp.float32)).astype(u.dtype)


def hyena(p, conv_w, conv_b, hf, hb, bias):
    z = dwconv3(p, conv_w, conv_b)
    parts = jnp.split(z, HY_ORDER + 1, axis=-1)
    u = parts[0]
    for o in range(HY_ORDER):
        u = parts[o + 1] * bidir_long_conv(u, hf[:, o], hb[:, o], bias[o])
    return u


def s5_discretize(lam_re, lam_im, log_step, b_re, b_im):
    lam = lax.complex(lam_re.astype(jnp.float32), lam_im.astype(jnp.float32))
    step = jnp.exp(log_step.astype(jnp.float32))[:, None]
    a_bar = jnp.exp(lam * step)
    b_bar = ((a_bar - 1.0) / lam)[..., None] * lax.complex(b_re.astype(jnp.float32), b_im.astype(jnp.float32))
    return a_bar, b_bar


def _linear_recurrence_combine(left, right):
    a_l, b_l = left
    a_r, b_r = right
    return a_r * a_l, a_r * b_l + b_r


def s5_states(u, a_bar, b_bar, h0):
    L = u.shape[1]
    bu = jnp.einsum('blgc,gnc->blgn', u.astype(jnp.complex64), b_bar)
    if h0 is not None:
        bu = bu.at[:, 0].add(a_bar * h0)
    a = jnp.broadcast_to(a_bar, (1, L) + a_bar.shape)
    _, h = lax.associative_scan(_linear_recurrence_combine, (a, bu), axis=1)
    return h


def s5_readout(h, c_mat):
    return jnp.real(jnp.einsum('blgn,gcn->blgc', h, c_mat))


def s5_glu(y, w_glu):
    y = jax.nn.gelu(y)
    a, g = jnp.split(y @ w_glu.astype(jnp.float32), 2, axis=-1)
    return a * jax.nn.sigmoid(g)


def _flip(s, flip):
    return s[:, ::-1] if flip else s


def s5_branch(u, uc, lam_re, lam_im, log_step, b_re, b_im, c_re, c_im, d_skip, w_glu, with_ctx_out):
    B, L, _ = u.shape
    Lc = uc.shape[1]
    uf = u.astype(jnp.float32)
    ucf = uc.astype(jnp.float32)
    ug = uf.reshape(B, L, S5_GROUPS, S5_GROUP)
    ucg = ucf.reshape(B, Lc, S5_GROUPS, S5_GROUP)
    d32 = d_skip.astype(jnp.float32)
    y = d32 * uf
    yc = d32 * ucf if with_ctx_out else None
    for d in range(2):
        a_bar, b_bar = s5_discretize(lam_re[d], lam_im[d], log_step[d], b_re[d], b_im[d])
        c_mat = lax.complex(c_re[d].astype(jnp.float32), c_im[d].astype(jnp.float32))
        flip = d == 1
        hc = s5_states(_flip(ucg, flip), a_bar, b_bar, None)
        h = s5_states(_flip(ug, flip), a_bar, b_bar, hc[:, -1])
        y = y + _flip(s5_readout(h, c_mat), flip).reshape(B, L, S5_WIDTH)
        if with_ctx_out:
            yc = yc + _flip(s5_readout(hc, c_mat), flip).reshape(B, Lc, S5_WIDTH)
    out = s5_glu(y, w_glu).astype(u.dtype)
    out_c = s5_glu(yc, w_glu).astype(uc.dtype) if with_ctx_out else None
    return out, out_c


def axial_rope_tables(L):
    rows = L // GRID_W
    row = jnp.repeat(jnp.arange(rows, dtype=jnp.float32), GRID_W)
    col = jnp.tile(jnp.arange(GRID_W, dtype=jnp.float32), rows)
    n_ax = MLA_ROPE // 4
    inv = ROPE_THETA ** (-jnp.arange(n_ax, dtype=jnp.float32) / n_ax)
    ang = jnp.concatenate([row[:, None] * inv, col[:, None] * inv], axis=-1)
    return jnp.cos(ang), jnp.sin(ang)


def apply_rope(x, cos, sin):
    half = x.shape[-1] // 2
    x1 = x[..., :half].astype(jnp.float32)
    x2 = x[..., half:].astype(jnp.float32)
    c = cos[None, :, None, :]
    s = sin[None, :, None, :]
    return jnp.concatenate([x1 * c - x2 * s, x1 * s + x2 * c], axis=-1).astype(x.dtype)


def mla_keys_values(p_kv, p_kr, g_kv, w_ukv, rope):
    B, L, _ = p_kv.shape
    kv = (rmsnorm(p_kv, g_kv) @ w_ukv).reshape(B, L, MLA_HEADS, MLA_NOPE + MLA_V)
    k_nope, v = kv[..., :MLA_NOPE], kv[..., MLA_NOPE:]
    k_rope = p_kr[:, :, None, :]
    if rope is not None:
        k_rope = apply_rope(k_rope, rope[0], rope[1])
    k = jnp.concatenate([k_nope, jnp.broadcast_to(k_rope, (B, L, MLA_HEADS, MLA_ROPE))], axis=-1)
    return k, v


def mla_queries(p_q, g_q, w_uq, rope):
    B, L, _ = p_q.shape
    q = (rmsnorm(p_q, g_q) @ w_uq).reshape(B, L, MLA_HEADS, MLA_NOPE + MLA_ROPE)
    q_nope, q_rope = q[..., :MLA_NOPE], q[..., MLA_NOPE:]
    if rope is not None:
        q_rope = apply_rope(q_rope, rope[0], rope[1])
    return jnp.concatenate([q_nope, q_rope], axis=-1) * MLA_SCALE


def attention(q, k, v):
    s = jnp.einsum('bqhd,bkhd->bhqk', q, k, preferred_element_type=jnp.float32)
    p = jax.nn.softmax(s, axis=-1)
    return jnp.einsum('bhqk,bkhd->bqhd', p.astype(v.dtype), v)


def blocked_attention(q, k, v):
    B, L, H, Dk = q.shape
    nb = L // Q_BLOCK
    qb = q.reshape(B, nb, Q_BLOCK, H, Dk).transpose(1, 0, 2, 3, 4)
    ob = lax.map(lambda q_blk: attention(q_blk, k, v), qb)
    return ob.transpose(1, 0, 2, 3, 4).reshape(B, L, H, ob.shape[-1])


def merge_branches(p_gate, y_hy, y_s5, y_mla, w_br_hy, w_br_s5, w_br_mla, w_o):
    g_hy, g_s5, g_mla = jnp.split(jax.nn.sigmoid(p_gate), N_BRANCH, axis=-1)
    merged = g_hy * (y_hy @ w_br_hy) + g_s5 * (y_s5 @ w_br_s5) + g_mla * (y_mla @ w_br_mla)
    return merged @ w_o


def conv_ffn(h, w_up, conv_w, conv_b, w_down):
    a = dwconv3(h @ w_up, conv_w, conv_b)
    u, g = jnp.split(a, 2, axis=-1)
    return (jax.nn.silu(u) * g) @ w_down


def setup_inputs(seed: int = 0) -> dict:
    key = jax.random.key(seed)
    ks = iter(jax.random.split(key, 64))

    def nrm(shape, scale):
        return jax.random.normal(next(ks), shape, jnp.float32) * scale

    def gain(shape):
        return 1.0 + nrm(shape, 0.01)

    D = D_MODEL
    G, N, CG = S5_GROUPS, S5_STATE, S5_GROUP
    HID = HY_FILTER_HIDDEN
    n_idx = jnp.arange(N, dtype=jnp.float32)
    return {
        "x": nrm((BATCH, SEQ, D), 1.0),
        "c": nrm((BATCH, D), 1.0),
        "ctx": nrm((BATCH, CTX_LEN, D), 1.0),
        "c_ctx": nrm((D,), 1.0),
        "w_mod": nrm((DEPTH, D, 6 * D), 0.5 * D ** -0.5),
        "b_mod": nrm((DEPTH, 6 * D), 0.01),
        "norm1_g": gain((DEPTH, D)),
        "norm2_g": gain((DEPTH, D)),
        "w_in": nrm((DEPTH, D, IN_WIDTH), D ** -0.5),
        "hy_conv_w": nrm((DEPTH, 3, (HY_ORDER + 1) * HY_WIDTH), 3 ** -0.5),
        "hy_conv_b": nrm((DEPTH, (HY_ORDER + 1) * HY_WIDTH), 0.01),
        "hy_f_w1": nrm((DEPTH, HY_FEAT, HID), HY_FEAT ** -0.5),
        "hy_f_b1": nrm((DEPTH, HID), 0.1),
        "hy_f_w2": nrm((DEPTH, HID, HID), HID ** -0.5),
        "hy_f_b2": nrm((DEPTH, HID), 0.1),
        "hy_f_w3": nrm((DEPTH, HID, HY_FILTER_OUT), HID ** -0.5),
        "hy_f_freq": 1.0 + nrm((DEPTH, HID), 0.1),
        "hy_f_decay": jax.random.uniform(next(ks), (DEPTH, HY_FILTER_OUT), jnp.float32, HY_MIN_DECAY, HY_MAX_DECAY),
        "hy_bias": nrm((DEPTH, HY_ORDER, HY_WIDTH), 1.0),
        "s5_lam_re": -0.5 + nrm((DEPTH, 2, G, N), 0.01),
        "s5_lam_im": math.pi * n_idx + nrm((DEPTH, 2, G, N), 0.01),
        "s5_log_step": jax.random.uniform(next(ks), (DEPTH, 2, G), jnp.float32, math.log(S5_MIN_STEP), math.log(S5_MAX_STEP)),
        "s5_b_re": nrm((DEPTH, 2, G, N, CG), (2 * CG) ** -0.5),
        "s5_b_im": nrm((DEPTH, 2, G, N, CG), (2 * CG) ** -0.5),
        "s5_c_re": nrm((DEPTH, 2, G, CG, N), N ** -0.5),
        "s5_c_im": nrm((DEPTH, 2, G, CG, N), N ** -0.5),
        "s5_d": nrm((DEPTH, S5_WIDTH), 1.0),
        "s5_w_glu": nrm((DEPTH, S5_WIDTH, 2 * S5_WIDTH), S5_WIDTH ** -0.5),
        "mla_g_q": gain((DEPTH, MLA_Q_LORA)),
        "mla_w_uq": nrm((DEPTH, MLA_Q_LORA, MLA_HEADS * (MLA_NOPE + MLA_ROPE)), MLA_Q_LORA ** -0.5),
        "mla_g_kv": gain((DEPTH, MLA_KV_LORA)),
        "mla_w_ukv": nrm((DEPTH, MLA_KV_LORA, MLA_HEADS * (MLA_NOPE + MLA_V)), MLA_KV_LORA ** -0.5),
        "w_br_hy": nrm((DEPTH, HY_WIDTH, D), HY_WIDTH ** -0.5),
        "w_br_s5": nrm((DEPTH, S5_WIDTH, D), S5_WIDTH ** -0.5),
        "w_br_mla": nrm((DEPTH, MLA_WIDTH, D), MLA_WIDTH ** -0.5),
        "w_o": nrm((DEPTH, D, D), D ** -0.5),
        "ffn_w_up": nrm((DEPTH, D, 2 * FFN_HIDDEN), D ** -0.5),
        "ffn_conv_w": nrm((DEPTH, 3, 2 * FFN_HIDDEN), 3 ** -0.5),
        "ffn_conv_b": nrm((DEPTH, 2 * FFN_HIDDEN), 0.01),
        "ffn_w_down": nrm((DEPTH, FFN_HIDDEN, D), FFN_HIDDEN ** -0.5),
        "final_g": gain((D,)),
    }


def reference(x, c, ctx, c_ctx, w_mod, b_mod, norm1_g, norm2_g, w_in, hy_conv_w, hy_conv_b,
              hy_f_w1, hy_f_b1, hy_f_w2, hy_f_b2, hy_f_w3, hy_f_freq, hy_f_decay, hy_bias,
              s5_lam_re, s5_lam_im, s5_log_step, s5_b_re, s5_b_im, s5_c_re, s5_c_im, s5_d, s5_w_glu,
              mla_g_q, mla_w_uq, mla_g_kv, mla_w_ukv, w_br_hy, w_br_s5, w_br_mla, w_o,
              ffn_w_up, ffn_conv_w, ffn_conv_b, ffn_w_down, final_g):
    B, L, _ = x.shape
    Lc = ctx.shape[1]
    rope = axial_rope_tables(L)
    xc = ctx
    for i in range(DEPTH):
        ctx_out = i < DEPTH - 1
        mod = (jax.nn.silu(c) @ w_mod[i] + b_mod[i])[:, None, :]
        mod_c = jax.nn.silu(c_ctx) @ w_mod[i] + b_mod[i]
        sh1, sc1, g1, sh2, sc2, g2 = jnp.split(mod, 6, axis=-1)
        sh1c, sc1c, g1c, sh2c, sc2c, g2c = jnp.split(mod_c, 6, axis=-1)

        h = rmsnorm(x, norm1_g[i]) * (1.0 + sc1) + sh1
        hc = rmsnorm(xc, norm1_g[i]) * (1.0 + sc1c) + sh1c
        p = h @ w_in[i]
        pc = hc @ (w_in[i] if ctx_out else w_in[i][:, :CTX_SIDE_COLS])

        y_s5, yc_s5 = s5_branch(p[..., COL_S5:COL_KV], pc[..., COL_S5:COL_KV],
                                s5_lam_re[i], s5_lam_im[i], s5_log_step[i], s5_b_re[i], s5_b_im[i],
                                s5_c_re[i], s5_c_im[i], s5_d[i], s5_w_glu[i], ctx_out)

        k_lat, v_lat = mla_keys_values(p[..., COL_KV:COL_KR], p[..., COL_KR:COL_Q], mla_g_kv[i], mla_w_ukv[i], rope)
        k_ctx, v_ctx = mla_keys_values(pc[..., COL_KV:COL_KR], pc[..., COL_KR:COL_Q], mla_g_kv[i], mla_w_ukv[i], None)
        q_lat = mla_queries(p[..., COL_Q:COL_HY], mla_g_q[i], mla_w_uq[i], rope)
        y_mla = blocked_attention(q_lat, jnp.concatenate([k_lat, k_ctx], axis=1),
                                  jnp.concatenate([v_lat, v_ctx], axis=1)).reshape(B, L, MLA_WIDTH)

        filt = (hy_f_w1[i], hy_f_b1[i], hy_f_w2[i], hy_f_b2[i], hy_f_w3[i], hy_f_freq[i], hy_f_decay[i])
        hf, hb = hyena_filters(L, *filt)
        y_hy = hyena(p[..., COL_HY:COL_GATE], hy_conv_w[i], hy_conv_b[i], hf, hb, hy_bias[i])

        x = x + g1 * merge_branches(p[..., COL_GATE:], y_hy, y_s5, y_mla,
                                    w_br_hy[i], w_br_s5[i], w_br_mla[i], w_o[i])

        if ctx_out:
            hfc, hbc = hyena_filters(Lc, *filt)
            yc_hy = hyena(pc[..., COL_HY:COL_GATE], hy_conv_w[i], hy_conv_b[i], hfc, hbc, hy_bias[i])
            q_ctx = mla_queries(pc[..., COL_Q:COL_HY], mla_g_q[i], mla_w_uq[i], None)
            yc_mla = attention(q_ctx, k_ctx, v_ctx).reshape(B, Lc, MLA_WIDTH)
            xc = xc + g1c * merge_branches(pc[..., COL_GATE:], yc_hy, yc_s5, yc_mla,
                                           w_br_hy[i], w_br_s5[i], w_br_mla[i], w_o[i])

        x = x + g2 * conv_ffn(rmsnorm(x, norm2_g[i]) * (1.0 + sc2) + sh2,
                              ffn_w_up[i], ffn_conv_w[i], ffn_conv_b[i], ffn_w_down[i])
        if ctx_out:
            xc = xc + g2c * conv_ffn(rmsnorm(xc, norm2_g[i]) * (1.0 + sc2c) + sh2c,
                                     ffn_w_up[i], ffn_conv_w[i], ffn_conv_b[i], ffn_w_down[i])
    return rmsnorm(x, final_g)
```

```cpp
#include <hip/hip_runtime.h>
#include <hip/hip_cooperative_groups.h>
#include <cstdio>
namespace cg = cooperative_groups;

typedef _Float16 h16;
typedef _Float16 h16x8 __attribute__((ext_vector_type(8)));
typedef _Float16 h16x4 __attribute__((ext_vector_type(4)));
typedef float f32x4 __attribute__((ext_vector_type(4)));
typedef float f32x16 __attribute__((ext_vector_type(16)));
#define DI __device__ __forceinline__

constexpr int DM = 1024, NBATCH = 8, SEQ = 8192, CTXL = 256, TLAT = 65536, TCTX = 2048, TT = 67584;
constexpr int KEYS = SEQ + CTXL;
constexpr int NTHREADS = 256;
constexpr float EPS = 1e-6f;
constexpr float QSCALE = 0.10206207261596575f * 1.4426950408889634f;

constexpr long WT_WIN = 0, WT_WGATE = WT_WIN + 2432L * 1024, WT_UKV = WT_WGATE + 3072L * 1024, WT_UQ = WT_UKV + 1024L * 256,
               WT_GLU = WT_UQ + 1024L * 512, WT_BRHY = WT_GLU + 768L * 384, WT_BRS5 = WT_BRHY + 1024L * 384,
               WT_BRMLA = WT_BRS5 + 1024L * 384, WT_WO = WT_BRMLA + 1024L * 512, WT_UP = WT_WO + 1024L * 1024,
               WT_DOWN = WT_UP + 5632L * 1024, WT_LAYER = WT_DOWN + 1024L * 2816;
constexpr size_t al256(size_t x) { return (x + 255) / 256 * 256; }
constexpr size_t OFF_WT = 0;
constexpr size_t OFF_H1 = al256(OFF_WT + 2 * WT_LAYER * 2);
constexpr size_t OFF_U = al256(OFF_H1 + (size_t)TT * 1024 * 2);
constexpr size_t OFF_KVLAT = al256(OFF_U + (size_t)TT * 384 * 2);
constexpr size_t OFF_QLAT = al256(OFF_KVLAT + (size_t)TT * 256 * 2);
constexpr size_t OFF_PHY = al256(OFF_QLAT + (size_t)TT * 512 * 2);
constexpr size_t OFF_PHYC = al256(OFF_PHY + (size_t)NBATCH * 1152 * SEQ * 2);
constexpr size_t OFF_Q = al256(OFF_PHYC + (size_t)NBATCH * 1152 * CTXL * 2);
constexpr size_t OFF_K = al256(OFF_Q + (size_t)64 * KEYS * 96 * 2);
constexpr size_t OFF_VT = al256(OFF_K + (size_t)64 * KEYS * 96 * 2);
constexpr size_t OFF_YS5PRE = al256(OFF_VT + (size_t)64 * 64 * KEYS * 2);
constexpr size_t OFF_YHY = al256(OFF_YS5PRE + (size_t)TT * 384 * 2);
constexpr size_t OFF_FILT = al256(OFF_YHY + (size_t)TT * 384 * 2);
constexpr size_t OFF_TAPSC = al256(OFF_FILT + (size_t)768 * 2 * SEQ * 8);
constexpr size_t OFF_E = al256(OFF_TAPSC + (size_t)768 * 2 * CTXL * 4);
constexpr size_t OFF_XC = al256(OFF_E + (size_t)NBATCH * 2 * 24 * 132 * 64 * 8);
constexpr size_t OFF_MOD = al256(OFF_XC + (size_t)TCTX * 1024 * 4);
constexpr size_t OFF_Z2 = al256(OFF_MOD + (size_t)2 * 9 * 6144 * 4);
constexpr size_t OFF_Z2C = al256(OFF_Z2 + (size_t)2 * SEQ * 64 * 4);
constexpr size_t OFF_S5A = al256(OFF_Z2C + (size_t)2 * CTXL * 64 * 4);
constexpr size_t OFF_S5A64 = al256(OFF_S5A + (size_t)2 * 2 * 24 * 64 * 8);
constexpr size_t OFF_S5B = al256(OFF_S5A64 + (size_t)2 * 2 * 24 * 64 * 8);
constexpr size_t OFF_S5C = al256(OFF_S5B + (size_t)2 * 2 * 24 * 64 * 16 * 8);
constexpr size_t OFF_ROPE = al256(OFF_S5C + (size_t)2 * 2 * 24 * 16 * 128 * 2);
constexpr size_t OFF_END = al256(OFF_ROPE + (size_t)SEQ * 16 * 8);
constexpr size_t OFF_YS5 = OFF_U, OFF_YMLA = OFF_QLAT, OFF_MERGED = OFF_Q, OFF_F = OFF_U, OFF_H2 = OFF_H1;
static_assert(OFF_END <= (size_t)1024 * 1024 * 1024, "workspace over 1 GiB");
static_assert(OFF_F + (size_t)TT * 2816 * 2 <= OFF_FILT, "f alias overruns");
static_assert(OFF_MERGED + (size_t)TT * 1024 * 2 <= OFF_VT, "merged alias overruns");

constexpr int SMEM_BYTES = 73728 + 2048;

struct Params {
  const float* in[41];
  float* out;
  char* ws;
  unsigned long long pad_;
};
enum { I_X = 0, I_C, I_CTX, I_CCTX, I_WMOD, I_BMOD, I_N1G, I_N2G, I_WIN, I_HCW, I_HCB, I_FW1, I_FB1, I_FW2, I_FB2, I_FW3, I_FFREQ,
       I_FDECAY, I_HBIAS, I_LAMRE, I_LAMIM, I_LOGSTEP, I_BRE, I_BIM, I_CRE, I_CIM, I_S5D, I_WGLU, I_GQ, I_WUQ, I_GKV, I_WUKV,
       I_WBRHY, I_WBRS5, I_WBRMLA, I_WO, I_WUP, I_FCW, I_FCB, I_WDOWN, I_FINALG };

DI int tidx() { int t = threadIdx.x; asm volatile("" : "+v"(t)); return t; }
DI int opaque_tid() { return tidx(); }
DI float sigmoidf_(float x) { return 1.f / (1.f + __expf(-x)); }
DI float siluf_(float x) { return x / (1.f + __expf(-x)); }
DI float geluf_(float x) { float z = 0.7978845608028654f * (x + 0.044715f * x * x * x); float t = 1.f - 2.f / (1.f + __expf(2.f * z)); return 0.5f * x * (1.f + t); }
DI float wave_sum(float v) { for (int o = 32; o > 0; o >>= 1) v += __shfl_xor(v, o); return v; }
DI float wave_max(float v) { for (int o = 32; o > 0; o >>= 1) v = fmaxf(v, __shfl_xor(v, o)); return v; }
DI void dsincos(double x, double& s, double& c) {
  const double TWO_PI = 6.283185307179586476925287;
  double r = x - TWO_PI * rint(x / TWO_PI);
  double r2 = r * r, ts = r, tc = 1.0; s = r; c = 1.0;
  for (int k = 1; k <= 15; ++k) { tc = -tc * r2 / (double)((2 * k - 1) * (2 * k)); c += tc; ts = -ts * r2 / (double)((2 * k) * (2 * k + 1)); s += ts; }
}
DI float2 twid(float f) { return make_float2(__builtin_amdgcn_cosf(f), __builtin_amdgcn_sinf(f)); }
DI float2 cmul(float2 a, float2 b) { return make_float2(a.x * b.x - a.y * b.y, a.x * b.y + a.y * b.x); }

struct Tok { int b, pos, ctx, mrow; };
DI Tok tokinfo(int t) { Tok k; if (t < TLAT) { k.b = t >> 13; k.pos = t & 8191; k.ctx = 0; k.mrow = k.b; } else { int u = t - TLAT; k.b = u >> 8; k.pos = u & 255; k.ctx = 1; k.mrow = 8; } return k; }

DI void gemm_kloop(f32x4 (&acc)[4][4], const h16* __restrict__ A, long lda, int a_lo, int a_hi,
                   const h16* __restrict__ Bt, long ldb, int K, char* smem, int tid) {
  const int lane = tid & 63, wid = tid >> 6, wr = wid >> 1, wc = wid & 1, fr = lane & 15, fq = lane >> 4;
  uint4 ra[4], rb[4];
  const int srow = tid >> 3, skc = tid & 7;
  auto gload = [&](int k0) {
#pragma unroll
    for (int i = 0; i < 4; ++i) {
      const int row = srow + 32 * i;
      if (row >= a_lo && row < a_hi) ra[i] = *reinterpret_cast<const uint4*>(A + (long)row * lda + k0 + skc * 8);
      else ra[i] = make_uint4(0, 0, 0, 0);
      rb[i] = *reinterpret_cast<const uint4*>(Bt + (long)row * ldb + k0 + skc * 8);
    }
  };
  auto swrite = [&](int buf) {
    char* sa = smem + buf * 36864; char* sb = sa + 18432;
#pragma unroll
    for (int i = 0; i < 4; ++i) {
      const int row = srow + 32 * i;
      *reinterpret_cast<uint4*>(sa + row * 144 + skc * 16) = ra[i];
      *reinterpret_cast<uint4*>(sb + row * 144 + skc * 16) = rb[i];
    }
  };
  gload(0); swrite(0); __syncthreads();
  const int nk = K >> 6;
  for (int kt = 0; kt < nk; ++kt) {
    if (kt + 1 < nk) gload((kt + 1) << 6);
    const char* sa = smem + (kt & 1) * 36864; const char* sb = sa + 18432;
#pragma unroll
    for (int ks = 0; ks < 2; ++ks) {
      h16x8 af[4], bf[4];
#pragma unroll
      for (int m = 0; m < 4; ++m) af[m] = *reinterpret_cast<const h16x8*>(sa + (wr * 64 + m * 16 + fr) * 144 + ks * 64 + fq * 16);
#pragma unroll
      for (int n = 0; n < 4; ++n) bf[n] = *reinterpret_cast<const h16x8*>(sb + (wc * 64 + n * 16 + fr) * 144 + ks * 64 + fq * 16);
#pragma unroll
      for (int m = 0; m < 4; ++m)
#pragma unroll
        for (int n = 0; n < 4; ++n) acc[m][n] = __builtin_amdgcn_mfma_f32_16x16x32_f16(af[m], bf[n], acc[m][n], 0, 0, 0);
    }
    if (kt + 1 < nk) swrite((kt + 1) & 1);
    __syncthreads();
  }
}
DI void acc_zero(f32x4 (&acc)[4][4]) {
#pragma unroll
  for (int m = 0; m < 4; ++m)
#pragma unroll
    for (int n = 0; n < 4; ++n) acc[m][n] = f32x4{0.f, 0.f, 0.f, 0.f};
}
DI void row_rms(const h16* __restrict__ A, long lda, int K, float* rs) {
  const int tid = tidx(), row = tid >> 1, half = tid & 1;
  const h16* p = A + (long)row * lda + half * (K >> 1);
  float ss = 0.f;
  for (int k = 0; k < (K >> 1); k += 8) {
    h16x8 v = *reinterpret_cast<const h16x8*>(p + k);
#pragma unroll
    for (int j = 0; j < 8; ++j) { float f = (float)v[j]; ss += f * f; }
  }
  ss += __shfl_xor(ss, 1);
  if (half == 0) rs[row] = rsqrtf(ss / (float)K + EPS);
}
DI int map_interleave(int n, int half) { int tile = n >> 7, r = n & 127, sub = r >> 4, fr = r & 15; int j = tile * 64 + (sub >> 1) * 16 + fr; return (sub & 1) ? half + j : j; }
DI int map_col(int mat, int n) {
  switch (mat) {
    case 0: if (n < 640) return n; if (n < 2304) return n + 32; if (n < 2336) return n - 2304 + 640; return -1;
    case 1: return 2336 + n;
    case 3: { int h = n >> 7, j = n & 127; return j < 96 ? h * 96 + j : -1; }
    case 4: return map_interleave(n, 384);
    case 9: return map_interleave(n, 2816);
    default: return n;
  }
}
struct MatDesc { const float* src; const float* scale; long dst; int K, Nmy, Nsrc; };
DI MatDesc get_mat(const Params& P, int layer, int mat) {
  MatDesc d; d.scale = nullptr;
  switch (mat) {
    case 0: d.src = P.in[I_WIN] + (long)layer * 1024 * 5408; d.dst = WT_WIN; d.K = 1024; d.Nmy = 2432; d.Nsrc = 5408; break;
    case 1: d.src = P.in[I_WIN] + (long)layer * 1024 * 5408; d.dst = WT_WGATE; d.K = 1024; d.Nmy = 3072; d.Nsrc = 5408; break;
    case 2: d.src = P.in[I_WUKV] + (long)layer * 256 * 1024; d.dst = WT_UKV; d.K = 256; d.Nmy = 1024; d.Nsrc = 1024; d.scale = P.in[I_GKV] + layer * 256; break;
    case 3: d.src = P.in[I_WUQ] + (long)layer * 512 * 768; d.dst = WT_UQ; d.K = 512; d.Nmy = 1024; d.Nsrc = 768; d.scale = P.in[I_GQ] + layer * 512; break;
    case 4: d.src = P.in[I_WGLU] + (long)layer * 384 * 768; d.dst = WT_GLU; d.K = 384; d.Nmy = 768; d.Nsrc = 768; break;
    case 5: d.src = P.in[I_WBRHY] + (long)layer * 384 * 1024; d.dst = WT_BRHY; d.K = 384; d.Nmy = 1024; d.Nsrc = 1024; break;
    case 6: d.src = P.in[I_WBRS5] + (long)layer * 384 * 1024; d.dst = WT_BRS5; d.K = 384; d.Nmy = 1024; d.Nsrc = 1024; break;
    case 7: d.src = P.in[I_WBRMLA] + (long)layer * 512 * 1024; d.dst = WT_BRMLA; d.K = 512; d.Nmy = 1024; d.Nsrc = 1024; break;
    case 8: d.src = P.in[I_WO] + (long)layer * 1024 * 1024; d.dst = WT_WO; d.K = 1024; d.Nmy = 1024; d.Nsrc = 1024; break;
    case 9: d.src = P.in[I_WUP] + (long)layer * 1024 * 5632; d.dst = WT_UP; d.K = 1024; d.Nmy = 5632; d.Nsrc = 5632; break;
    default: d.src = P.in[I_WDOWN] + (long)layer * 2816 * 1024; d.dst = WT_DOWN; d.K = 2816; d.Nmy = 1024; d.Nsrc = 1024; break;
  }
  return d;
}
constexpr int WT_TILES_PER_LAYER = 608 + 768 + 64 + 128 + 72 + 96 + 96 + 128 + 256 + 1408 + 704;
DI void item_wt(const Params& P, int item, char* smem) {
  const int layer = item / WT_TILES_PER_LAYER; int r = item % WT_TILES_PER_LAYER;
  const int cnt[11] = {608, 768, 64, 128, 72, 96, 96, 128, 256, 1408, 704};
  int mat = 0;
#pragma unroll
  for (int i = 0; i < 10; ++i) { if (mat == i && r >= cnt[i]) { r -= cnt[i]; mat = i + 1; } }
  MatDesc d = get_mat(P, layer, mat);
  const int kt = d.K >> 6, n0 = (r / kt) * 64, k0 = (r % kt) * 64;
  float* tile = reinterpret_cast<float*>(smem);
  h16* dst = reinterpret_cast<h16*>(P.ws + OFF_WT) + (long)layer * WT_LAYER + d.dst;
  const int tid = tidx(), lx = tid & 63, ly = tid >> 6;
  const int sc = map_col(mat, n0 + lx);
#pragma unroll 4
  for (int i = 0; i < 16; ++i) { int kk = i * 4 + ly; tile[kk * 65 + lx] = sc >= 0 ? d.src[(long)(k0 + kk) * d.Nsrc + sc] : 0.f; }
  __syncthreads();
  const float s = d.scale ? d.scale[k0 + lx] : 1.f;
#pragma unroll 4
  for (int i = 0; i < 16; ++i) { int nn = i * 4 + ly; dst[(long)(n0 + nn) * d.K + k0 + lx] = (h16)(tile[lx * 65 + nn] * s); }
  __syncthreads();
}
DI void item_mod(const Params& P, int item, char* smem) {
  const int layer = item / 96, n0 = (item % 96) * 64;
  float* s = reinterpret_cast<float*>(smem);
  float* part = s + 9 * 1024;
  const int tid = tidx(), lane = tid & 63, wid = tid >> 6;
  for (int i = tid; i < 9 * 1024; i += NTHREADS) { float v = i < 8192 ? P.in[I_C][i] : P.in[I_CCTX][i - 8192]; s[i] = siluf_(v); }
  __syncthreads();
  const float* w = P.in[I_WMOD] + (long)layer * 1024 * 6144 + n0 + lane;
  float acc[9];
#pragma unroll
  for (int r = 0; r < 9; ++r) acc[r] = 0.f;
  for (int k = wid * 256; k < wid * 256 + 256; ++k) {
    const float wv = w[(long)k * 6144];
#pragma unroll
    for (int r = 0; r < 9; ++r) acc[r] += s[r * 1024 + k] * wv;
  }
#pragma unroll
  for (int r = 0; r < 9; ++r) part[(wid * 9 + r) * 64 + lane] = acc[r];
  __syncthreads();
  float* mod = reinterpret_cast<float*>(P.ws + OFF_MOD) + (long)layer * 9 * 6144;
  for (int i = tid; i < 9 * 64; i += NTHREADS) {
    const int r = i >> 6, c = i & 63;
    mod[r * 6144 + n0 + c] = part[(0 * 9 + r) * 64 + c] + part[(1 * 9 + r) * 64 + c] + part[(2 * 9 + r) * 64 + c] + part[(3 * 9 + r) * 64 + c] + P.in[I_BMOD][layer * 6144 + n0 + c];
  }
  __syncthreads();
}
DI void item_hymlp(const Params& P, int item, char* smem) {
  const int layer = item / 132; int r = item % 132;
  const int isc = r >= 128; const int Lf = isc ? CTXL : SEQ; const int t0 = (isc ? r - 128 : r) * 64;
  float* z1 = reinterpret_cast<float*>(smem);
  const int tid = tidx(), tl = tid >> 2, h0 = (tid & 3) * 16; const int t = t0 + tl;
  const float* w1 = P.in[I_FW1] + layer * 17 * 64; const float* b1 = P.in[I_FB1] + layer * 64;
  const float* w2 = P.in[I_FW2] + layer * 64 * 64; const float* b2 = P.in[I_FB2] + layer * 64; const float* fq = P.in[I_FFREQ] + layer * 64;
  float feat[17]; feat[0] = (float)t / (float)Lf;
#pragma unroll
  for (int k = 1; k <= 8; ++k) { float rev = (float)((t * k) % Lf) / (float)Lf; feat[k] = __builtin_amdgcn_cosf(rev); feat[8 + k] = __builtin_amdgcn_sinf(rev); }
#pragma unroll 4
  for (int j = 0; j < 16; ++j) {
    const int h = h0 + j; float a = b1[h];
#pragma unroll
    for (int f = 0; f < 17; ++f) a += feat[f] * w1[f * 64 + h];
    z1[tl * 65 + h] = __sinf(fq[h] * a);
  }
  __syncthreads();
  float* z2 = isc ? reinterpret_cast<float*>(P.ws + OFF_Z2C) + (long)layer * CTXL * 64 : reinterpret_cast<float*>(P.ws + OFF_Z2) + (long)layer * SEQ * 64;
  float a2[16];
#pragma unroll
  for (int j = 0; j < 16; ++j) a2[j] = b2[h0 + j];
  for (int k = 0; k < 64; ++k) {
    const float zv = z1[tl * 65 + k];
#pragma unroll
    for (int j = 0; j < 16; ++j) a2[j] += zv * w2[k * 64 + h0 + j];
  }
#pragma unroll
  for (int j = 0; j < 16; ++j) z2[(long)t * 64 + h0 + j] = __sinf(fq[h0 + j] * a2[j]);
  __syncthreads();
}
DI void item_s5disc(const Params& P, int item) {
  const int layer = item / 12, dir = (item % 12) / 6, gb = item % 6;
  const int tid = tidx(), g = gb * 4 + (tid >> 6), n = tid & 63;
  const int ld = layer * 2 + dir; const long gi = (long)ld * 24 + g;
  const double lre = P.in[I_LAMRE][gi * 64 + n], lim = P.in[I_LAMIM][gi * 64 + n];
  const double step = exp((double)P.in[I_LOGSTEP][gi]);
  double sn, cs; dsincos(lim * step, sn, cs);
  const double mag = exp(lre * step);
  const double are = mag * cs, aim = mag * sn;
  const double nr = are - 1.0, ni = aim, den = lre * lre + lim * lim;
  const double fre = (nr * lre + ni * lim) / den, fim = (ni * lre - nr * lim) / den;
  float2* A = reinterpret_cast<float2*>(P.ws + OFF_S5A); float2* A64 = reinterpret_cast<float2*>(P.ws + OFF_S5A64);
  A[gi * 64 + n] = make_float2((float)are, (float)aim);
  double pr = are, pi = aim;
  for (int i = 0; i < 6; ++i) { double t = pr * pr - pi * pi; pi = 2.0 * pr * pi; pr = t; }
  A64[gi * 64 + n] = make_float2((float)pr, (float)pi);
  float2* Bb = reinterpret_cast<float2*>(P.ws + OFF_S5B) + (gi * 64 + n) * 16;
  const float* bre = P.in[I_BRE] + (gi * 64 + n) * 16; const float* bim = P.in[I_BIM] + (gi * 64 + n) * 16;
  for (int c = 0; c < 16; ++c) { double br = bre[c], bi = bim[c]; Bb[c] = make_float2((float)(fre * br - fim * bi), (float)(fre * bi + fim * br)); }
  h16* Ct = reinterpret_cast<h16*>(P.ws + OFF_S5C) + gi * 16 * 128;
  const float* cre = P.in[I_CRE] + gi * 16 * 64; const float* cim = P.in[I_CIM] + gi * 16 * 64;
  for (int c = 0; c < 16; ++c) { Ct[c * 128 + n] = (h16)cre[c * 64 + n]; Ct[c * 128 + 64 + n] = (h16)(-cim[c * 64 + n]); }
}
DI void item_rope(const Params& P, int item) {
  const int idx = item * NTHREADS + tidx(); const int pos = idx >> 4, i = idx & 15;
  const double inv[8] = {1.0, 0.31622776601683794, 0.1, 0.031622776601683794, 0.01, 0.0031622776601683794, 0.001, 0.00031622776601683794};
  double iv = 1.0;
#pragma unroll
  for (int k = 0; k < 8; ++k) if ((i & 7) == k) iv = inv[k];
  const double ang = (double)(i < 8 ? (pos >> 6) : (pos & 63)) * iv;
  double s, c; dsincos(ang, s, c);
  reinterpret_cast<float2*>(P.ws + OFF_ROPE)[idx] = make_float2((float)c, (float)s);
}
constexpr int PRO_N_WT = 2 * WT_TILES_PER_LAYER, PRO_N_MOD = 192, PRO_N_HY = 264, PRO_N_S5 = 24, PRO_N_ROPE = 512;
DI void phase_prologue(const Params& P, char* smem) {
  const int total = PRO_N_MOD + PRO_N_HY + PRO_N_S5 + PRO_N_ROPE + PRO_N_WT;
  for (int it = blockIdx.x; it < total; it += gridDim.x) {
    int i = it;
    if (i < PRO_N_MOD) { item_mod(P, i, smem); continue; } i -= PRO_N_MOD;
    if (i < PRO_N_HY) { item_hymlp(P, i, smem); continue; } i -= PRO_N_HY;
    if (i < PRO_N_S5) { item_s5disc(P, i); continue; } i -= PRO_N_S5;
    if (i < PRO_N_ROPE) { item_rope(P, i); continue; } i -= PRO_N_ROPE;
    item_wt(P, i, smem);
  }
}

DI const float* xrow_src(const Params& P, int layer_stage, int t) {
  if (t < TLAT) return (layer_stage == 0 ? P.in[I_X] : P.out) + (long)t * 1024;
  return (layer_stage == 0 ? P.in[I_CTX] : reinterpret_cast<const float*>(P.ws + OFF_XC)) + (long)(t - TLAT) * 1024;
}
DI float* xrow_dst(const Params& P, int t) {
  if (t < TLAT) return P.out + (long)t * 1024;
  return reinterpret_cast<float*>(P.ws + OFF_XC) + (long)(t - TLAT) * 1024;
}
DI void normmod_rows(const Params& P, int layer, int which, int stage, int ntok, int item, int nitems_stride) {
  const int tid = tidx(), lane = tid & 63, wid = tid >> 6;
  const float* g = P.in[which ? I_N2G : I_N1G] + layer * 1024;
  const float* mod = reinterpret_cast<const float*>(P.ws + OFF_MOD) + (long)layer * 9 * 6144;
  h16* H = reinterpret_cast<h16*>(P.ws + OFF_H1);
  for (int rg = item; rg * 4 < ntok; rg += nitems_stride) {
    const int t = rg * 4 + wid;
    const Tok k = tokinfo(t);
    const float* xr = xrow_src(P, stage, t);
    const float* sh = mod + k.mrow * 6144 + (which ? 3 : 0) * 1024; const float* sc = sh + 1024;
    float4 v[4]; float ss = 0.f;
#pragma unroll
    for (int i = 0; i < 4; ++i) { v[i] = *reinterpret_cast<const float4*>(xr + i * 256 + lane * 4); ss += v[i].x * v[i].x + v[i].y * v[i].y + v[i].z * v[i].z + v[i].w * v[i].w; }
    ss = wave_sum(ss);
    const float r = rsqrtf(ss * (1.f / 1024.f) + EPS);
#pragma unroll
    for (int i = 0; i < 4; ++i) {
      const int c = i * 256 + lane * 4;
      const float4 gg = *reinterpret_cast<const float4*>(g + c), s1 = *reinterpret_cast<const float4*>(sc + c), s0 = *reinterpret_cast<const float4*>(sh + c);
      h16x4 o;
      o[0] = (h16)(v[i].x * r * gg.x * (1.f + s1.x) + s0.x); o[1] = (h16)(v[i].y * r * gg.y * (1.f + s1.y) + s0.y);
      o[2] = (h16)(v[i].z * r * gg.z * (1.f + s1.z) + s0.z); o[3] = (h16)(v[i].w * r * gg.w * (1.f + s1.w) + s0.w);
      *reinterpret_cast<h16x4*>(H + (long)t * 1024 + c) = o;
    }
  }
}
DI void phase_final(const Params& P) {
  const int lane = tidx() & 63, wid = tidx() >> 6;
  const float* g = P.in[I_FINALG];
  for (int rg = blockIdx.x; rg * 4 < TLAT; rg += gridDim.x) {
    float* xr = P.out + (long)(rg * 4 + wid) * 1024;
    float4 v[4]; float ss = 0.f;
#pragma unroll
    for (int i = 0; i < 4; ++i) { v[i] = *reinterpret_cast<const float4*>(xr + i * 256 + lane * 4); ss += v[i].x * v[i].x + v[i].y * v[i].y + v[i].z * v[i].z + v[i].w * v[i].w; }
    ss = wave_sum(ss);
    const float r = rsqrtf(ss * (1.f / 1024.f) + EPS);
#pragma unroll
    for (int i = 0; i < 4; ++i) {
      const int c = i * 256 + lane * 4; const float4 gg = *reinterpret_cast<const float4*>(g + c);
      *reinterpret_cast<float4*>(xr + c) = make_float4(v[i].x * r * gg.x, v[i].y * r * gg.y, v[i].z * r * gg.z, v[i].w * r * gg.w);
    }
  }
}
template <int S> DI void fft_dif_pass(float2* X, int h) {
  const int hs = h >> (S - 1);
#pragma unroll 1
  for (int item = tidx(); item < (8192 >> S); item += NTHREADS) {
    const int j = item % hs, blk = item / hs, i0 = blk * 2 * h + j;
    float2 v[1 << S];
#pragma unroll
    for (int k = 0; k < (1 << S); ++k) v[k] = X[i0 + k * hs];
#pragma unroll
    for (int q = 0; q < S; ++q) {
      const int hq = h >> q, dist = 1 << (S - 1 - q);
#pragma unroll
      for (int k = 0; k < (1 << S); ++k) {
        if (k & dist) continue;
        const float2 a = v[k], b = v[k + dist];
        const int e = j + (k & (dist - 1)) * hs;
        v[k] = make_float2(a.x + b.x, a.y + b.y);
        v[k + dist] = cmul(make_float2(a.x - b.x, a.y - b.y), twid(-(float)e / (float)(2 * hq)));
      }
    }
#pragma unroll
    for (int k = 0; k < (1 << S); ++k) X[i0 + k * hs] = v[k];
  }
  __syncthreads();
}
template <int S> DI void fft_dit_pass(float2* X, int hs) {
  const int hmax = hs << (S - 1);
#pragma unroll 1
  for (int item = tidx(); item < (8192 >> S); item += NTHREADS) {
    const int j = item % hs, blk = item / hs, i0 = blk * 2 * hmax + j;
    float2 v[1 << S];
#pragma unroll
    for (int k = 0; k < (1 << S); ++k) v[k] = X[i0 + k * hs];
#pragma unroll
    for (int q = 0; q < S; ++q) {
      const int hq = hs << q, dist = 1 << q;
#pragma unroll
      for (int k = 0; k < (1 << S); ++k) {
        if (k & dist) continue;
        const int e = j + (k & (dist - 1)) * hs;
        const float2 a = v[k], b = cmul(v[k + dist], twid((float)e / (float)(2 * hq)));
        v[k] = make_float2(a.x + b.x, a.y + b.y);
        v[k + dist] = make_float2(a.x - b.x, a.y - b.y);
      }
    }
#pragma unroll
    for (int k = 0; k < (1 << S); ++k) X[i0 + k * hs] = v[k];
  }
  __syncthreads();
}
DI void fft_fwd(float2* X) { fft_dif_pass<3>(X, 4096); fft_dif_pass<3>(X, 512); fft_dif_pass<3>(X, 64); fft_dif_pass<2>(X, 8); fft_dif_pass<2>(X, 2); }
DI void fft_inv(float2* X) { fft_dit_pass<2>(X, 1); fft_dit_pass<2>(X, 4); fft_dit_pass<3>(X, 16); fft_dit_pass<3>(X, 128); fft_dit_pass<3>(X, 1024); }

DI float block_sum(float v, float* red) {
  v = wave_sum(v);
  __syncthreads();
  if ((tidx() & 63) == 0) red[tidx() >> 6] = v;
  __syncthreads();
  const float r = red[0] + red[1] + red[2] + red[3];
  __syncthreads();
  return r;
}
DI void item_filter(const Params& P, int layer, int oc, char* smem) {
  float2* X = reinterpret_cast<float2*>(smem); float* red = reinterpret_cast<float*>(smem + 65536);
  const int tid = tidx();
  const float* z2 = reinterpret_cast<const float*>(P.ws + OFF_Z2) + (long)layer * SEQ * 64;
  const float* w3 = P.in[I_FW3] + (long)layer * 64 * 1536; const float* dec = P.in[I_FDECAY] + layer * 1536;
  const int colf = oc, colb = 768 + oc;
  const float df = fabsf(dec[colf]), db = fabsf(dec[colb]);
  float lsum = 0.f;
  for (int i = 0; i < 32; ++i) {
    const int t = tid + 256 * i; const float* zr = z2 + (long)t * 64;
    float af = 0.f, ab = 0.f;
#pragma unroll 8
    for (int k = 0; k < 64; ++k) { const float z = zr[k]; af += z * w3[k * 1536 + colf]; ab += z * w3[k * 1536 + colb]; }
    const float tn = (float)t * (1.f / 8192.f);
    af *= __expf(-tn * df); ab *= __expf(-tn * db);
    lsum += fabsf(af) + fabsf(ab);
    X[t] = make_float2(af, ab);
  }
  const float nrm = block_sum(lsum, red);
  const float sc = 0.5f / 8192.f / nrm;
  float ev[32];
  float2* F = reinterpret_cast<float2*>(P.ws + OFF_FILT) + (long)oc * 2 * 8192;
#pragma unroll
  for (int i = 0; i < 32; ++i) {
    const int n = tid + 256 * i; const float lo = X[n].x; const float hi = n > 0 ? X[8192 - n].y : 0.f;
    ev[i] = (lo + hi) * sc; F[8192 + n] = make_float2((lo - hi) * sc, 0.f);
  }
  __syncthreads();
#pragma unroll
  for (int i = 0; i < 32; ++i) X[tid + 256 * i] = make_float2(ev[i], 0.f);
  __syncthreads();
  fft_fwd(X);
#pragma unroll 4
  for (int i = 0; i < 32; ++i) F[tid + 256 * i] = X[tid + 256 * i];
  __syncthreads();
#pragma unroll 4
  for (int i = 0; i < 32; ++i) { const int n = tid + 256 * i; const float d = F[8192 + n].x; const float2 w = twid(-(float)n * (1.f / 16384.f)); X[n] = make_float2(d * w.x, d * w.y); }
  __syncthreads();
  fft_fwd(X);
#pragma unroll 4
  for (int i = 0; i < 32; ++i) F[8192 + tid + 256 * i] = X[tid + 256 * i];
  __syncthreads();
}
DI void item_filter_ctx(const Params& P, int layer, int oc, char* smem) {
  float* red = reinterpret_cast<float*>(smem);
  const int t = tidx();
  const float* zr = reinterpret_cast<const float*>(P.ws + OFF_Z2C) + (long)layer * CTXL * 64 + t * 64;
  const float* w3 = P.in[I_FW3] + (long)layer * 64 * 1536; const float* dec = P.in[I_FDECAY] + layer * 1536;
  float af = 0.f, ab = 0.f;
  for (int k = 0; k < 64; ++k) { const float z = zr[k]; af += z * w3[k * 1536 + oc]; ab += z * w3[k * 1536 + 768 + oc]; }
  const float tn = (float)t * (1.f / 256.f);
  af *= __expf(-tn * fabsf(dec[oc])); ab *= __expf(-tn * fabsf(dec[768 + oc]));
  const float nrm = block_sum(fabsf(af) + fabsf(ab), red);
  float* T = reinterpret_cast<float*>(P.ws + OFF_TAPSC) + (long)oc * 512;
  T[t] = af / nrm; T[256 + t] = ab / nrm;
}

DI void phase_norm1(const Params& P, int layer, char* smem) {
  const int nfilt = 768 + (layer == 0 ? 768 : 0);
  for (int it = blockIdx.x; it < nfilt; it += gridDim.x) {
    if (it < 768) item_filter(P, layer, it, smem); else item_filter_ctx(P, layer, it - 768, smem);
  }
  normmod_rows(P, layer, 0, layer, TT, blockIdx.x, gridDim.x);
}

DI void phase_gemm_in(const Params& P, int layer, char* smem) {
  const int tid = tidx(), lane = tid & 63, wid = tid >> 6, wr = wid >> 1, wc = wid & 1, fr = lane & 15, fq = lane >> 4;
  const h16* H = reinterpret_cast<const h16*>(P.ws + OFF_H1);
  const h16* W = reinterpret_cast<const h16*>(P.ws + OFF_WT) + (long)layer * WT_LAYER + WT_WIN;
  h16* U = reinterpret_cast<h16*>(P.ws + OFF_U); h16* KV = reinterpret_cast<h16*>(P.ws + OFF_KVLAT); h16* QL = reinterpret_cast<h16*>(P.ws + OFF_QLAT);
  h16* PHY = reinterpret_cast<h16*>(P.ws + OFF_PHY); h16* PHYC = reinterpret_cast<h16*>(P.ws + OFF_PHYC); h16* Kb = reinterpret_cast<h16*>(P.ws + OFF_K);
  const float2* rope = reinterpret_cast<const float2*>(P.ws + OFF_ROPE);
  constexpr int NT = 19, MT = TT / 128;
  for (int tile = blockIdx.x; tile < MT * NT; tile += gridDim.x) {
    const int mt = tile / NT, nt = tile % NT;
    f32x4 acc[4][4]; acc_zero(acc);
    gemm_kloop(acc, H + (long)mt * 128 * 1024, 1024, 0, 128, W + (long)nt * 128 * 1024, 1024, 1024, smem, opaque_tid());
    const int t0 = mt * 128; const Tok tk = tokinfo(t0);
    if (nt < 9) {
      h16* dst; int ld, cb;
      if (nt < 3) { dst = U; ld = 384; cb = nt * 128; } else if (nt < 5) { dst = KV; ld = 256; cb = (nt - 3) * 128; } else { dst = QL; ld = 512; cb = (nt - 5) * 128; }
#pragma unroll
      for (int m = 0; m < 4; ++m)
#pragma unroll
        for (int n = 0; n < 4; ++n)
#pragma unroll
          for (int j = 0; j < 4; ++j) dst[(long)(t0 + wr * 64 + m * 16 + fq * 4 + j) * ld + cb + wc * 64 + n * 16 + fr] = (h16)acc[m][n][j];
    } else if (nt < 18) {
      h16* base = tk.ctx ? PHYC + (long)tk.b * 1152 * CTXL : PHY + (long)tk.b * 1152 * SEQ; const int lp = tk.ctx ? CTXL : SEQ;
#pragma unroll
      for (int m = 0; m < 4; ++m)
#pragma unroll
        for (int n = 0; n < 4; ++n) {
          const int ch = (nt - 9) * 128 + wc * 64 + n * 16 + fr; const int pos = tk.pos + wr * 64 + m * 16 + fq * 4;
          h16x4 o; o[0] = (h16)acc[m][n][0]; o[1] = (h16)acc[m][n][1]; o[2] = (h16)acc[m][n][2]; o[3] = (h16)acc[m][n][3];
          *reinterpret_cast<h16x4*>(base + (long)ch * lp + pos) = o;
        }
    } else if (wc == 0) {
#pragma unroll
      for (int m = 0; m < 4; ++m)
#pragma unroll
        for (int j = 0; j < 4; ++j) {
          const int pos = tk.pos + wr * 64 + m * 16 + fq * 4 + j; const int key = tk.ctx ? SEQ + pos : pos;
          float x1 = acc[m][0][j], x2 = acc[m][1][j];
          if (!tk.ctx) { const float2 cs = rope[pos * 16 + fr]; const float y1 = x1 * cs.x - x2 * cs.y, y2 = x1 * cs.y + x2 * cs.x; x1 = y1; x2 = y2; }
#pragma unroll
          for (int h = 0; h < 8; ++h) { h16* kr = Kb + ((long)(tk.b * 8 + h) * KEYS + key) * 96 + 64; kr[fr] = (h16)x1; kr[16 + fr] = (h16)x2; }
        }
    }
  }
}
DI void item_kv(const Params& P, int layer, int tile, char* smem) {
  const int tid = tidx(), lane = tid & 63, wid = tid >> 6, wr = wid >> 1, wc = wid & 1, fr = lane & 15, fq = lane >> 4;
  const int mt = tile >> 3, hd = tile & 7; const int t0 = mt * 128; const Tok tk = tokinfo(t0);
  const h16* A = reinterpret_cast<const h16*>(P.ws + OFF_KVLAT) + (long)t0 * 256;
  const h16* W = reinterpret_cast<const h16*>(P.ws + OFF_WT) + (long)layer * WT_LAYER + WT_UKV + (long)hd * 128 * 256;
  float* rs = reinterpret_cast<float*>(smem + 73728);
  row_rms(A, 256, 256, rs);
  f32x4 acc[4][4]; acc_zero(acc);
  gemm_kloop(acc, A, 256, 0, 128, W, 256, 256, smem, opaque_tid());
  h16* Kb = reinterpret_cast<h16*>(P.ws + OFF_K) + (long)(tk.b * 8 + hd) * KEYS * 96;
  h16* Vt = reinterpret_cast<h16*>(P.ws + OFF_VT) + (long)(tk.b * 8 + hd) * 64 * KEYS;
  const int key0 = (tk.ctx ? SEQ : 0) + tk.pos;
#pragma unroll
  for (int m = 0; m < 4; ++m) {
    const int r0 = wr * 64 + m * 16 + fq * 4;
    const float s0 = rs[r0], s1 = rs[r0 + 1], s2 = rs[r0 + 2], s3 = rs[r0 + 3];
#pragma unroll
    for (int n = 0; n < 4; ++n) {
      const int col = n * 16 + fr;
      if (wc == 0) {
        Kb[(long)(key0 + r0 + 0) * 96 + col] = (h16)(acc[m][n][0] * s0); Kb[(long)(key0 + r0 + 1) * 96 + col] = (h16)(acc[m][n][1] * s1);
        Kb[(long)(key0 + r0 + 2) * 96 + col] = (h16)(acc[m][n][2] * s2); Kb[(long)(key0 + r0 + 3) * 96 + col] = (h16)(acc[m][n][3] * s3);
      } else {
        h16x4 o; o[0] = (h16)(acc[m][n][0] * s0); o[1] = (h16)(acc[m][n][1] * s1); o[2] = (h16)(acc[m][n][2] * s2); o[3] = (h16)(acc[m][n][3] * s3);
        *reinterpret_cast<h16x4*>(Vt + (long)col * KEYS + key0 + r0) = o;
      }
    }
  }
  __syncthreads();
}
DI void item_q(const Params& P, int layer, int tile, char* smem) {
  const int tid = tidx(), lane = tid & 63, wid = tid >> 6, wr = wid >> 1, wc = wid & 1, fr = lane & 15, fq = lane >> 4;
  const int mt = tile >> 3, hd = tile & 7; const int t0 = mt * 128; const Tok tk = tokinfo(t0);
  const h16* A = reinterpret_cast<const h16*>(P.ws + OFF_QLAT) + (long)t0 * 512;
  const h16* W = reinterpret_cast<const h16*>(P.ws + OFF_WT) + (long)layer * WT_LAYER + WT_UQ + (long)hd * 128 * 512;
  float* rs = reinterpret_cast<float*>(smem + 73728);
  row_rms(A, 512, 512, rs);
  f32x4 acc[4][4]; acc_zero(acc);
  gemm_kloop(acc, A, 512, 0, 128, W, 512, 512, smem, opaque_tid());
  h16* Qb = reinterpret_cast<h16*>(P.ws + OFF_Q) + (long)(tk.b * 8 + hd) * KEYS * 96;
  const float2* rope = reinterpret_cast<const float2*>(P.ws + OFF_ROPE);
  const int q0 = (tk.ctx ? SEQ : 0) + tk.pos;
#pragma unroll
  for (int m = 0; m < 4; ++m)
#pragma unroll
    for (int j = 0; j < 4; ++j) {
      const int r = wr * 64 + m * 16 + fq * 4 + j; const float s = rs[r] * QSCALE;
      h16* qr = Qb + (long)(q0 + r) * 96;
      if (wc == 0) {
#pragma unroll
        for (int n = 0; n < 4; ++n) qr[n * 16 + fr] = (h16)(acc[m][n][j] * s);
      } else {
        float x1 = acc[m][0][j], x2 = acc[m][1][j];
        if (!tk.ctx) { const float2 cs = rope[(tk.pos + r) * 16 + fr]; const float y1 = x1 * cs.x - x2 * cs.y, y2 = x1 * cs.y + x2 * cs.x; x1 = y1; x2 = y2; }
        qr[64 + fr] = (h16)(x1 * s); qr[80 + fr] = (h16)(x2 * s);
      }
    }
  __syncthreads();
}
DI int s5_chunk_base(int b, int dir, int si) {
  if (si < 4) { const int cc = dir ? 3 - si : si; return TLAT + b * CTXL + cc * 64; }
  const int lc = dir ? 127 - (si - 4) : si - 4; return b * SEQ + lc * 64;
}
DI void s5_stage_u(const h16* __restrict__ U, int tokbase, int g, float* us) {
  const int lane = tidx() & 63;
  const h16* p = U + (long)(tokbase + lane) * 384 + g * 16;
  const h16x8 v0 = *reinterpret_cast<const h16x8*>(p), v1 = *reinterpret_cast<const h16x8*>(p + 8);
#pragma unroll
  for (int j = 0; j < 8; ++j) { us[lane * 16 + j] = (float)v0[j]; us[lane * 16 + 8 + j] = (float)v1[j]; }
}
DI void item_s5_pass1(const Params& P, int layer, int wtask, char* smem) {
  const int lane = tidx() & 63, wid = tidx() >> 6;
  float* us = reinterpret_cast<float*>(smem + wid * 12800);
  const int si = wtask % 132; int r = wtask / 132; const int g = r % 24; r /= 24; const int dir = r & 1, b = r >> 1;
  const long gi = (long)(layer * 2 + dir) * 24 + g;
  const float2 a = reinterpret_cast<const float2*>(P.ws + OFF_S5A)[gi * 64 + lane];
  const float2* Bb = reinterpret_cast<const float2*>(P.ws + OFF_S5B) + (gi * 64 + lane) * 16;
  float bre[16], bim[16];
#pragma unroll
  for (int c = 0; c < 16; ++c) { const float2 v = Bb[c]; bre[c] = v.x; bim[c] = v.y; }
  s5_stage_u(reinterpret_cast<const h16*>(P.ws + OFF_U), s5_chunk_base(b, dir, si), g, us);
  float hr = 0.f, hi = 0.f;
  for (int s = 0; s < 64; ++s) {
    const int tau = dir ? 63 - s : s;
    const float4* up = reinterpret_cast<const float4*>(us + tau * 16);
    float br = 0.f, bi = 0.f;
#pragma unroll
    for (int q = 0; q < 4; ++q) { const float4 u = up[q];
      br += bre[q * 4] * u.x + bre[q * 4 + 1] * u.y + bre[q * 4 + 2] * u.z + bre[q * 4 + 3] * u.w;
      bi += bim[q * 4] * u.x + bim[q * 4 + 1] * u.y + bim[q * 4 + 2] * u.z + bim[q * 4 + 3] * u.w; }
    const float nr = a.x * hr - a.y * hi + br, ni = a.x * hi + a.y * hr + bi; hr = nr; hi = ni;
  }
  reinterpret_cast<float2*>(P.ws + OFF_E)[((long)((b * 2 + dir) * 24 + g) * 132 + si) * 64 + lane] = make_float2(hr, hi);
}

DI float hy_dw(const h16* __restrict__ p, int t, int Ls, float w0, float w1, float w2, float bias) {
  const float xm = t > 0 ? (float)p[t - 1] : 0.f, x0 = (float)p[t], xp = t + 1 < Ls ? (float)p[t + 1] : 0.f;
  return xm * w0 + x0 * w1 + xp * w2 + bias;
}
DI void item_hyena(const Params& P, int layer, int task, char* smem) {
  float2* X = reinterpret_cast<float2*>(smem);
  const int tid = tidx(); const int pair = task / 384, c = task % 384;
  const h16* PH0 = reinterpret_cast<const h16*>(P.ws + OFF_PHY) + (long)(2 * pair) * 1152 * SEQ;
  const h16* PH1 = PH0 + (long)1152 * SEQ;
  const float* cw = P.in[I_HCW] + layer * 3 * 1152; const float* cb = P.in[I_HCB] + layer * 1152;
  const float2* F = reinterpret_cast<const float2*>(P.ws + OFF_FILT);
  float2* SCR = reinterpret_cast<float2*>(P.ws + OFF_YS5PRE) + (long)blockIdx.x * 12288;
  float2* SCR2 = SCR + 8192;
  const float vw0 = cw[c], vw1 = cw[1152 + c], vw2 = cw[2304 + c], vbb = cb[c];
  const h16* pv0 = PH0 + (long)c * SEQ; const h16* pv1 = PH1 + (long)c * SEQ;
  float2 ye[16]; int tq;
#pragma unroll 1
  for (int o = 0; o < 2; ++o) {
    const float2* Te = F + (long)(o * 384 + c) * 2 * 8192; const float2* To = Te + 8192;
    float ts = 1.f / 16384.f; asm volatile("" : "+v"(ts));
{ tq = tid; asm volatile("" : "+v"(tq)); }
#pragma unroll 1
    for (int i = 0; i < 32; ++i) { const int t = tq + 256 * i;
      X[t] = o == 0 ? make_float2(hy_dw(pv0, t, SEQ, vw0, vw1, vw2, vbb), hy_dw(pv1, t, SEQ, vw0, vw1, vw2, vbb)) : SCR[t]; }
    __syncthreads();
    fft_fwd(X);
{ tq = tid; asm volatile("" : "+v"(tq)); }
#pragma unroll 2
    for (int i = 0; i < 32; ++i) { const int n = tq + 256 * i; X[n] = cmul(X[n], Te[n]); }
    __syncthreads();
    fft_inv(X);
{ tq = tid; asm volatile("" : "+v"(tq)); }
#pragma unroll
    for (int i = 0; i < 16; ++i) { ye[i] = X[tq + 256 * i]; SCR2[tq + 256 * i] = X[tq + 4096 + 256 * i]; }
    __syncthreads();
{ tq = tid; asm volatile("" : "+v"(tq)); }
#pragma unroll 1
    for (int i = 0; i < 32; ++i) { const int t = tq + 256 * i;
      const float2 zz = o == 0 ? make_float2(hy_dw(pv0, t, SEQ, vw0, vw1, vw2, vbb), hy_dw(pv1, t, SEQ, vw0, vw1, vw2, vbb)) : SCR[t];
      X[t] = cmul(zz, twid(-(float)t * ts)); }
    __syncthreads();
    fft_fwd(X);
{ tq = tid; asm volatile("" : "+v"(tq)); }
#pragma unroll 2
    for (int i = 0; i < 32; ++i) { const int n = tq + 256 * i; X[n] = cmul(X[n], To[n]); }
    __syncthreads();
    fft_inv(X);
    asm volatile("" : "+v"(ts));
{ tq = tid; asm volatile("" : "+v"(tq)); }
#pragma unroll
    for (int i = 0; i < 16; ++i) { const int t = tq + 256 * i; const float2 yo = cmul(X[t], twid((float)t * ts)); X[t] = make_float2(ye[i].x + yo.x, ye[i].y + yo.y); }
{ tq = tid; asm volatile("" : "+v"(tq)); }
#pragma unroll 2
    for (int i = 0; i < 16; ++i) { const int t = tq + 4096 + 256 * i; const float2 yo = cmul(X[t], twid((float)t * ts)); const float2 y2 = SCR2[tq + 256 * i]; X[t] = make_float2(y2.x + yo.x, y2.y + yo.y); }
    const int gc = (o + 1) * 384 + c;
    const float w0 = cw[gc], w1 = cw[1152 + gc], w2 = cw[2304 + gc], bb = cb[gc];
    const float bias = P.in[I_HBIAS][(layer * 2 + o) * 384 + c];
    const h16* pg0 = PH0 + (long)gc * SEQ; const h16* pg1 = PH1 + (long)gc * SEQ;
    h16* Y = reinterpret_cast<h16*>(P.ws + OFF_YHY);
{ tq = tid; asm volatile("" : "+v"(tq)); }
#pragma unroll 1
    for (int i = 0; i < 32; ++i) {
      const int t = tq + 256 * i;
      const float2 lc = X[t];
      const float2 zz = o == 0 ? make_float2(hy_dw(pv0, t, SEQ, vw0, vw1, vw2, vbb), hy_dw(pv1, t, SEQ, vw0, vw1, vw2, vbb)) : SCR[t];
      const float gx = hy_dw(pg0, t, SEQ, w0, w1, w2, bb), gy = hy_dw(pg1, t, SEQ, w0, w1, w2, bb);
      const float2 res = make_float2(gx * (lc.x + bias * zz.x), gy * (lc.y + bias * zz.y));
      if (o == 0) SCR[t] = res;
      else { Y[((long)(2 * pair) * SEQ + t) * 384 + c] = (h16)res.x; Y[((long)(2 * pair + 1) * SEQ + t) * 384 + c] = (h16)res.y; }
    }
    __syncthreads();
  }
}
DI void item_hyena_ctx(const Params& P, int layer, int task, char* smem) {
  float* su = reinterpret_cast<float*>(smem); float* sf = su + 256; float* sb = sf + 256;
  const int t = tidx(); const int b = task / 384, c = task % 384;
  const h16* PH = reinterpret_cast<const h16*>(P.ws + OFF_PHYC) + (long)b * 1152 * CTXL;
  const float* cw = P.in[I_HCW] + layer * 3 * 1152; const float* cb = P.in[I_HCB] + layer * 1152;
  float u = hy_dw(PH + (long)c * CTXL, t, CTXL, cw[c], cw[1152 + c], cw[2304 + c], cb[c]);
  for (int o = 0; o < 2; ++o) {
    const float* T = reinterpret_cast<const float*>(P.ws + OFF_TAPSC) + (long)(o * 384 + c) * 512;
    __syncthreads();
    su[t] = u; sf[t] = T[t]; sb[t] = T[256 + t];
    __syncthreads();
    float y = 0.f;
    for (int s = 0; s <= t; ++s) y += sf[t - s] * su[s];
    for (int s = t + 1; s < 256; ++s) y += sb[s - t] * su[s];
    const int gc = (o + 1) * 384 + c;
    const float gx = hy_dw(PH + (long)gc * CTXL, t, CTXL, cw[gc], cw[1152 + gc], cw[2304 + gc], cb[gc]);
    u = gx * (y + P.in[I_HBIAS][(layer * 2 + o) * 384 + c] * u);
  }
  reinterpret_cast<h16*>(P.ws + OFF_YHY)[((long)TLAT + b * CTXL + t) * 384 + c] = (h16)u;
  __syncthreads();
}

DI int first_item(int base) { const int g = (int)gridDim.x; return (((int)blockIdx.x - base) % g + g) % g; }
DI void phase_mix1(const Params& P, int layer, char* smem) {
  const int n_hy = 4 * 384, n_hyc = layer == 0 ? 8 * 384 : 0;
  const int n_kv = (TT / 128) * 8, n_q = (layer == 0 ? TT / 128 : TLAT / 128) * 8;
  const int n_s5 = (NBATCH * 2 * 24 * 132) / 4;
  const int g = gridDim.x;
#pragma unroll 1
  for (int i = first_item(0); i < n_hy; i += g) item_hyena(P, layer, i, smem);
  asm volatile("" ::: "memory");
#pragma unroll 1
  for (int i = first_item(n_hy); i < n_kv; i += g) item_kv(P, layer, i, smem);
  asm volatile("" ::: "memory");
#pragma unroll 1
  for (int i = first_item(n_hy + n_kv); i < n_q; i += g) item_q(P, layer, i, smem);
  asm volatile("" ::: "memory");
#pragma unroll 1
  for (int i = first_item(n_hy + n_kv + n_q); i < n_s5; i += g) { item_s5_pass1(P, layer, i * 4 + (tidx() >> 6), smem); __syncthreads(); }
  asm volatile("" ::: "memory");
#pragma unroll 1
  for (int i = first_item(n_hy + n_kv + n_q + n_s5); i < n_hyc; i += g) item_hyena_ctx(P, layer, i, smem);
}
DI int crow32(int r, int hi) { return (r & 3) + 8 * (r >> 2) + 4 * hi; }
DI void item_attn(const Params& P, int bh, int q0, int key_lo, int ntiles, char* smem) {
  const int tid = tidx(), lane = tid & 63, wid = tid >> 6, r32 = lane & 31, hi = lane >> 5;
  const h16* Qb = reinterpret_cast<const h16*>(P.ws + OFF_Q) + (long)bh * KEYS * 96;
  const h16* Kb = reinterpret_cast<const h16*>(P.ws + OFF_K) + (long)bh * KEYS * 96;
  const h16* Vt = reinterpret_cast<const h16*>(P.ws + OFF_VT) + (long)bh * 64 * KEYS;
  h16x8 qf[6];
  { const h16* qrow = Qb + (long)(q0 + wid * 32 + r32) * 96 + hi * 8;
#pragma unroll
    for (int ds = 0; ds < 6; ++ds) qf[ds] = *reinterpret_cast<const h16x8*>(qrow + ds * 16); }
  constexpr int KT_BYTES = 64 * 208, VT_BYTES = 64 * 136, BUF = KT_BYTES + VT_BYTES;
  uint4 kr[3]; uint4 vr[2];
  const int vdv0 = tid >> 3, vpart = tid & 7;
  auto gload = [&](int j) {
    const long key0 = key_lo + j * 64;
#pragma unroll
    for (int i = 0; i < 3; ++i) kr[i] = *reinterpret_cast<const uint4*>(Kb + key0 * 96 + (long)(tid + 256 * i) * 8);
#pragma unroll
    for (int i = 0; i < 2; ++i) vr[i] = *reinterpret_cast<const uint4*>(Vt + (long)(vdv0 + 32 * i) * KEYS + key0 + vpart * 8);
  };
  auto swrite = [&](int buf) {
    char* ks = smem + buf * BUF; char* vs = ks + KT_BYTES;
#pragma unroll
    for (int i = 0; i < 3; ++i) { const int c = tid + 256 * i; *reinterpret_cast<uint4*>(ks + (c / 12) * 208 + (c % 12) * 16) = kr[i]; }
#pragma unroll
    for (int i = 0; i < 2; ++i) { char* d = vs + (vdv0 + 32 * i) * 136 + vpart * 16;
      *reinterpret_cast<uint2*>(d) = make_uint2(vr[i].x, vr[i].y); *reinterpret_cast<uint2*>(d + 8) = make_uint2(vr[i].z, vr[i].w); }
  };
  f32x16 o0, o1;
#pragma unroll
  for (int r = 0; r < 16; ++r) { o0[r] = 0.f; o1[r] = 0.f; }
  float m_run = -1e30f, l_run = 0.f;
  gload(0); swrite(0); __syncthreads();
  for (int j = 0; j < ntiles; ++j) {
    if (j + 1 < ntiles) gload(j + 1);
    const char* ks = smem + (j & 1) * BUF; const char* vs = ks + KT_BYTES;
    f32x16 p0, p1;
#pragma unroll
    for (int r = 0; r < 16; ++r) { p0[r] = 0.f; p1[r] = 0.f; }
#pragma unroll
    for (int ds = 0; ds < 6; ++ds) {
      const h16x8 a0 = *reinterpret_cast<const h16x8*>(ks + r32 * 208 + (ds * 16 + hi * 8) * 2);
      const h16x8 a1 = *reinterpret_cast<const h16x8*>(ks + (32 + r32) * 208 + (ds * 16 + hi * 8) * 2);
      p0 = __builtin_amdgcn_mfma_f32_32x32x16_f16(a0, qf[ds], p0, 0, 0, 0);
      p1 = __builtin_amdgcn_mfma_f32_32x32x16_f16(a1, qf[ds], p1, 0, 0, 0);
    }
    float mx = p0[0];
#pragma unroll
    for (int r = 1; r < 16; ++r) mx = fmaxf(mx, p0[r]);
#pragma unroll
    for (int r = 0; r < 16; ++r) mx = fmaxf(mx, p1[r]);
    mx = fmaxf(mx, __shfl_xor(mx, 32));
    const float mnew = fmaxf(m_run, mx);
    const float alpha = __builtin_amdgcn_exp2f(m_run - mnew);
    m_run = mnew;
    float rsum = 0.f;
#pragma unroll
    for (int r = 0; r < 16; ++r) { p0[r] = __builtin_amdgcn_exp2f(p0[r] - mnew); rsum += p0[r]; }
#pragma unroll
    for (int r = 0; r < 16; ++r) { p1[r] = __builtin_amdgcn_exp2f(p1[r] - mnew); rsum += p1[r]; }
    l_run = l_run * alpha + rsum;
#pragma unroll
    for (int r = 0; r < 16; ++r) { o0[r] *= alpha; o1[r] *= alpha; }
#pragma unroll
    for (int kb = 0; kb < 2; ++kb)
#pragma unroll
      for (int s = 0; s < 2; ++s) {
        h16x8 pf;
#pragma unroll
        for (int e = 0; e < 8; ++e) pf[e] = (h16)(kb ? p1[8 * s + e] : p0[8 * s + e]);
        const int koff = (32 * kb + 16 * s + 4 * hi) * 2;
        {
          const h16x4 lo = *reinterpret_cast<const h16x4*>(vs + r32 * 136 + koff), hh = *reinterpret_cast<const h16x4*>(vs + r32 * 136 + koff + 16);
          const h16x8 af = __builtin_shufflevector(lo, hh, 0, 1, 2, 3, 4, 5, 6, 7);
          o0 = __builtin_amdgcn_mfma_f32_32x32x16_f16(af, pf, o0, 0, 0, 0);
        }
        {
          const h16x4 lo = *reinterpret_cast<const h16x4*>(vs + (32 + r32) * 136 + koff), hh = *reinterpret_cast<const h16x4*>(vs + (32 + r32) * 136 + koff + 16);
          const h16x8 af = __builtin_shufflevector(lo, hh, 0, 1, 2, 3, 4, 5, 6, 7);
          o1 = __builtin_amdgcn_mfma_f32_32x32x16_f16(af, pf, o1, 0, 0, 0);
        }
      }
    if (j + 1 < ntiles) swrite((j + 1) & 1);
    __syncthreads();
  }
  const float lt = l_run + __shfl_xor(l_run, 32);
  const float inv = 1.f / lt;
  const int b = bh >> 3, hd = bh & 7; const int q = q0 + wid * 32 + r32;
  const long tok = q < SEQ ? (long)b * SEQ + q : (long)TLAT + b * CTXL + (q - SEQ);
  h16* yr = reinterpret_cast<h16*>(P.ws + OFF_YMLA) + tok * 512 + hd * 64;
#pragma unroll
  for (int g = 0; g < 4; ++g) {
    h16x4 a, c;
#pragma unroll
    for (int e = 0; e < 4; ++e) { a[e] = (h16)(o0[4 * g + e] * inv); c[e] = (h16)(o1[4 * g + e] * inv); }
    *reinterpret_cast<h16x4*>(yr + 8 * g + 4 * hi) = a;
    *reinterpret_cast<h16x4*>(yr + 32 + 8 * g + 4 * hi) = c;
  }
}
DI void item_s5_pass3(const Params& P, int layer, int b, int g, int ck, char* smem) {
  const int lane = tidx() & 63, wid = tidx() >> 6, fr = lane & 15, fq = lane >> 4;
  float* us = reinterpret_cast<float*>(smem + wid * 12800); char* Hs = smem + wid * 12800 + 4096;
  const int tokbase = ck < 4 ? TLAT + b * CTXL + ck * 64 : b * SEQ + (ck - 4) * 64;
  s5_stage_u(reinterpret_cast<const h16*>(P.ws + OFF_U), tokbase, g, us);
  __syncthreads();
  f32x4 yacc[4];
#pragma unroll
  for (int i = 0; i < 4; ++i) yacc[i] = f32x4{0.f, 0.f, 0.f, 0.f};
#pragma unroll
  for (int dir = 0; dir < 2; ++dir) {
    const long gi = (long)(layer * 2 + dir) * 24 + g;
    const float2 a = reinterpret_cast<const float2*>(P.ws + OFF_S5A)[gi * 64 + lane];
    const float2 a64 = reinterpret_cast<const float2*>(P.ws + OFF_S5A64)[gi * 64 + lane];
    const float2* Bb = reinterpret_cast<const float2*>(P.ws + OFF_S5B) + (gi * 64 + lane) * 16;
    float bre[16], bim[16];
#pragma unroll
    for (int c = 0; c < 16; ++c) { const float2 v = Bb[c]; bre[c] = v.x; bim[c] = v.y; }
    const int si = ck < 4 ? (dir ? 3 - ck : ck) : 4 + (dir ? 127 - (ck - 4) : ck - 4);
    const float2* Ep = reinterpret_cast<const float2*>(P.ws + OFF_E) + ((long)((b * 2 + dir) * 24 + g) * 132) * 64 + lane;
    float hr = 0.f, hi = 0.f;
    for (int i = 0; i < si; ++i) { const float2 e = Ep[(long)i * 64]; const float nr = a64.x * hr - a64.y * hi + e.x, ni = a64.x * hi + a64.y * hr + e.y; hr = nr; hi = ni; }
    const h16* Ct = reinterpret_cast<const h16*>(P.ws + OFF_S5C) + gi * 16 * 128 + fr * 128 + fq * 8;
    h16x8 cf[4];
#pragma unroll
    for (int ks = 0; ks < 4; ++ks) cf[ks] = *reinterpret_cast<const h16x8*>(Ct + ks * 32);
#pragma unroll
    for (int half = 0; half < 2; ++half) {
      for (int s = 0; s < 32; ++s) {
        const int step = half * 32 + s; const int tau = dir ? 63 - step : step;
        const float4* up = reinterpret_cast<const float4*>(us + tau * 16);
        float br = 0.f, bi = 0.f;
#pragma unroll
        for (int q = 0; q < 4; ++q) { const float4 u = up[q];
          br += bre[q * 4] * u.x + bre[q * 4 + 1] * u.y + bre[q * 4 + 2] * u.z + bre[q * 4 + 3] * u.w;
          bi += bim[q * 4] * u.x + bim[q * 4 + 1] * u.y + bim[q * 4 + 2] * u.z + bim[q * 4 + 3] * u.w; }
        const float nr = a.x * hr - a.y * hi + br, ni = a.x * hi + a.y * hr + bi; hr = nr; hi = ni;
        h16* hrow = reinterpret_cast<h16*>(Hs + (tau & 31) * 272);
        hrow[lane] = (h16)hr; hrow[64 + lane] = (h16)hi;
      }
      __syncthreads();
      const int tb = dir ? 1 - half : half;
#pragma unroll
      for (int sb2 = 0; sb2 < 2; ++sb2)
#pragma unroll
        for (int ks = 0; ks < 4; ++ks) {
          const h16x8 bf = *reinterpret_cast<const h16x8*>(Hs + (sb2 * 16 + fr) * 272 + (ks * 32 + fq * 8) * 2);
          yacc[tb * 2 + sb2] = __builtin_amdgcn_mfma_f32_16x16x32_f16(cf[ks], bf, yacc[tb * 2 + sb2], 0, 0, 0);
        }
      __syncthreads();
    }
  }
  const float* dsk = P.in[I_S5D] + layer * 384 + g * 16 + fq * 4;
  h16* Y = reinterpret_cast<h16*>(P.ws + OFF_YS5PRE);
#pragma unroll
  for (int sbi = 0; sbi < 4; ++sbi) {
    const int tl = sbi * 16 + fr; h16x4 o;
#pragma unroll
    for (int j = 0; j < 4; ++j) o[j] = (h16)geluf_(yacc[sbi][j] + dsk[j] * us[tl * 16 + fq * 4 + j]);
    *reinterpret_cast<h16x4*>(Y + (long)(tokbase + tl) * 384 + g * 16 + fq * 4) = o;
  }
  __syncthreads();
}
DI void phase_mix2(const Params& P, int layer, char* smem) {
  if ((gridDim.x & 7) == 0) {
    const int xcd = blockIdx.x & 7, li = blockIdx.x >> 3, nloc = gridDim.x >> 3;
    for (int k = li; k < 512; k += nloc) item_attn(P, xcd + 8 * (k >> 6), (k & 63) * 128, 0, KEYS / 64, smem);
  } else {
    for (int k = blockIdx.x; k < 4096; k += gridDim.x) item_attn(P, k >> 6, (k & 63) * 128, 0, KEYS / 64, smem);
  }
  const int n_actx = layer == 0 ? 128 : 0;
  const int nck = layer == 0 ? 132 : 128;
  const int n_s5 = NBATCH * 24 * nck / 4;
  for (int it = blockIdx.x; it < n_actx + n_s5; it += gridDim.x) {
    if (it < n_actx) { item_attn(P, it >> 1, SEQ + (it & 1) * 128, SEQ, CTXL / 64, smem); continue; }
    const int w = (it - n_actx) * 4 + (tidx() >> 6);
    const int ck = w % nck + (layer == 0 ? 0 : 4); const int r = w / nck;
    item_s5_pass3(P, layer, r / 24, r % 24, ck, smem);
  }
}
DI void phase_glu(const Params& P, int layer, char* smem) {
  const int tid = tidx(), lane = tid & 63, wid = tid >> 6, wr = wid >> 1, wc = wid & 1, fr = lane & 15, fq = lane >> 4;
  const h16* A = reinterpret_cast<const h16*>(P.ws + OFF_YS5PRE);
  const h16* W = reinterpret_cast<const h16*>(P.ws + OFF_WT) + (long)layer * WT_LAYER + WT_GLU;
  h16* Y = reinterpret_cast<h16*>(P.ws + OFF_YS5);
  const int MT = (layer == 0 ? TT : TLAT) / 128;
  for (int tile = blockIdx.x; tile < MT * 6; tile += gridDim.x) {
    const int mt = tile / 6, nt = tile % 6;
    f32x4 acc[4][4]; acc_zero(acc);
    gemm_kloop(acc, A + (long)mt * 128 * 384, 384, 0, 128, W + (long)nt * 128 * 384, 384, 384, smem, opaque_tid());
#pragma unroll
    for (int m = 0; m < 4; ++m)
#pragma unroll
      for (int np = 0; np < 2; ++np)
#pragma unroll
        for (int j = 0; j < 4; ++j) {
          const int row = mt * 128 + wr * 64 + m * 16 + fq * 4 + j, col = nt * 64 + wc * 32 + np * 16 + fr;
          Y[(long)row * 384 + col] = (h16)(acc[m][2 * np][j] * sigmoidf_(acc[m][2 * np + 1][j]));
        }
  }
}
DI void phase_merge(const Params& P, int layer, char* smem) {
  const int tid = tidx(), lane = tid & 63, wid = tid >> 6, wr = wid >> 1, wc = wid & 1, fr = lane & 15, fq = lane >> 4;
  const h16* H = reinterpret_cast<const h16*>(P.ws + OFF_H1);
  const h16* WL = reinterpret_cast<const h16*>(P.ws + OFF_WT) + (long)layer * WT_LAYER;
  h16* Mg = reinterpret_cast<h16*>(P.ws + OFF_MERGED);
  const int MT = (layer == 0 ? TT : TLAT) / 128;
  for (int tile = blockIdx.x; tile < MT * 8; tile += gridDim.x) {
    const int mt = tile >> 3, nt = tile & 7;
#pragma unroll 1
    for (int br = 0; br < 3; ++br) {
      const h16* Ab; const h16* Wb; int Kb;
      if (br == 0) { Ab = reinterpret_cast<const h16*>(P.ws + OFF_YHY) + (long)mt * 128 * 384; Wb = WL + WT_BRHY + (long)nt * 128 * 384; Kb = 384; }
      else if (br == 1) { Ab = reinterpret_cast<const h16*>(P.ws + OFF_YS5) + (long)mt * 128 * 384; Wb = WL + WT_BRS5 + (long)nt * 128 * 384; Kb = 384; }
      else { Ab = reinterpret_cast<const h16*>(P.ws + OFF_YMLA) + (long)mt * 128 * 512; Wb = WL + WT_BRMLA + (long)nt * 128 * 512; Kb = 512; }
      h16x4 sg[4][4];
      {
        f32x4 acc[4][4]; acc_zero(acc);
        gemm_kloop(acc, H + (long)mt * 128 * 1024, 1024, 0, 128, WL + WT_WGATE + (long)(br * 1024 + nt * 128) * 1024, 1024, 1024, smem, opaque_tid());
#pragma unroll
        for (int m = 0; m < 4; ++m)
#pragma unroll
          for (int n = 0; n < 4; ++n)
#pragma unroll
            for (int j = 0; j < 4; ++j) sg[m][n][j] = (h16)sigmoidf_(acc[m][n][j]);
      }
      f32x4 acc[4][4]; acc_zero(acc);
      gemm_kloop(acc, Ab, Kb, 0, 128, Wb, Kb, Kb, smem, opaque_tid());
#pragma unroll
      for (int m = 0; m < 4; ++m)
#pragma unroll
        for (int n = 0; n < 4; ++n)
#pragma unroll
          for (int j = 0; j < 4; ++j) {
            h16* dst = Mg + (long)(mt * 128 + wr * 64 + m * 16 + fq * 4 + j) * 1024 + nt * 128 + wc * 64 + n * 16 + fr;
            const float prev = br == 0 ? 0.f : (float)*dst;
            *dst = (h16)(prev + (float)sg[m][n][j] * acc[m][n][j]);
          }
    }
  }
}
DI void phase_resid(const Params& P, int layer, int stage_src, size_t a_off, int K, long w_off, int gate_idx, char* smem) {
  const int tid = tidx(), lane = tid & 63, wid = tid >> 6, wr = wid >> 1, wc = wid & 1, fr = lane & 15, fq = lane >> 4;
  const h16* A = reinterpret_cast<const h16*>(P.ws + a_off);
  const h16* W = reinterpret_cast<const h16*>(P.ws + OFF_WT) + (long)layer * WT_LAYER + w_off;
  const float* mod = reinterpret_cast<const float*>(P.ws + OFF_MOD) + (long)layer * 9 * 6144 + gate_idx * 1024;
  const int MT = (layer == 0 ? TT : TLAT) / 128;
  for (int tile = blockIdx.x; tile < MT * 8; tile += gridDim.x) {
    const int mt = tile >> 3, nt = tile & 7;
    f32x4 acc[4][4]; acc_zero(acc);
    gemm_kloop(acc, A + (long)mt * 128 * K, K, 0, 128, W + (long)nt * 128 * K, K, K, smem, opaque_tid());
    const Tok tk = tokinfo(mt * 128);
    const float* gp = mod + tk.mrow * 6144 + nt * 128 + wc * 64 + fr;
#pragma unroll
    for (int m = 0; m < 4; ++m)
#pragma unroll
      for (int j = 0; j < 4; ++j) {
        const int t = mt * 128 + wr * 64 + m * 16 + fq * 4 + j;
        const float* xs = xrow_src(P, stage_src, t) + nt * 128 + wc * 64 + fr; float* xd = xrow_dst(P, t) + nt * 128 + wc * 64 + fr;
#pragma unroll
        for (int n = 0; n < 4; ++n) xd[n * 16] = xs[n * 16] + gp[n * 16] * acc[m][n][j];
      }
  }
}
DI void phase_ffn_up(const Params& P, int layer, char* smem) {
  const int tid = tidx(), lane = tid & 63, wid = tid >> 6, wr = wid >> 1, wc = wid & 1, fr = lane & 15, fq = lane >> 4;
  const h16* H = reinterpret_cast<const h16*>(P.ws + OFF_H2);
  const h16* W = reinterpret_cast<const h16*>(P.ws + OFF_WT) + (long)layer * WT_LAYER + WT_UP;
  h16* F = reinterpret_cast<h16*>(P.ws + OFF_F);
  const float* cw = P.in[I_FCW] + (long)layer * 3 * 5632; const float* cb = P.in[I_FCB] + (long)layer * 5632;
  float* Zs = reinterpret_cast<float*>(smem);
  const int n_mt = 8 * 66 + (layer == 0 ? 8 * 3 : 0);
  for (int tile = blockIdx.x; tile < n_mt * 44; tile += gridDim.x) {
    const int mi = tile / 44, nt = tile % 44;
    int seq0, Ls, ti;
    if (mi < 528) { seq0 = (mi / 66) * SEQ; Ls = SEQ; ti = mi % 66; } else { const int u = mi - 528; seq0 = TLAT + (u / 3) * CTXL; Ls = CTXL; ti = u % 3; }
    const int p0 = ti * 126 - 1;
    const int a_lo = ti == 0 ? 1 : 0, a_hi = min(128, Ls - p0);
    const int nout = min(126, Ls - ti * 126);
    f32x4 acc[4][4]; acc_zero(acc);
    gemm_kloop(acc, H + ((long)seq0 + p0) * 1024, 1024, a_lo, a_hi, W + (long)nt * 128 * 1024, 1024, 1024, smem, opaque_tid());
#pragma unroll
    for (int m = 0; m < 4; ++m)
#pragma unroll
      for (int n = 0; n < 4; ++n)
#pragma unroll
        for (int j = 0; j < 4; ++j) Zs[(wr * 64 + m * 16 + fq * 4 + j) * 132 + wc * 64 + n * 16 + fr] = acc[m][n][j];
    __syncthreads();
    {
      const int jc = tid & 63, rg = tid >> 6;
      const int ucol = (jc >> 5) * 64 + ((jc >> 4) & 1) * 32 + (jc & 15), gcol = ucol + 16;
      const int cu = nt * 64 + jc, cg = 2816 + cu;
      const float wu0 = cw[cu], wu1 = cw[5632 + cu], wu2 = cw[2 * 5632 + cu], bu = cb[cu];
      const float wg0 = cw[cg], wg1 = cw[5632 + cg], wg2 = cw[2 * 5632 + cg], bg = cb[cg];
      for (int r = 1 + rg; r <= nout; r += 4) {
        const float au = wu0 * Zs[(r - 1) * 132 + ucol] + wu1 * Zs[r * 132 + ucol] + wu2 * Zs[(r + 1) * 132 + ucol] + bu;
        const float ag = wg0 * Zs[(r - 1) * 132 + gcol] + wg1 * Zs[r * 132 + gcol] + wg2 * Zs[(r + 1) * 132 + gcol] + bg;
        F[((long)seq0 + p0 + r) * 2816 + cu] = (h16)(siluf_(au) * ag);
      }
    }
    __syncthreads();
  }
}
DI void phase_norm2(const Params& P, int layer) { normmod_rows(P, layer, 1, 1, layer == 0 ? TT : TLAT, blockIdx.x, gridDim.x); }

constexpr int N_PHASES = 22;
template <int PH> DI void run_phase_t(const Params& P, char* smem) {
  asm volatile("" ::: "memory");
  if constexpr (PH == 0) phase_prologue(P, smem);
  else if constexpr (PH == 21) phase_final(P);
  else {
    constexpr int layer = (PH - 1) / 10, s = (PH - 1) % 10;
    if constexpr (s == 0) phase_norm1(P, layer, smem);
    else if constexpr (s == 1) phase_gemm_in(P, layer, smem);
    else if constexpr (s == 2) phase_mix1(P, layer, smem);
    else if constexpr (s == 3) phase_mix2(P, layer, smem);
    else if constexpr (s == 4) phase_glu(P, layer, smem);
    else if constexpr (s == 5) phase_merge(P, layer, smem);
    else if constexpr (s == 6) phase_resid(P, layer, layer, OFF_MERGED, 1024, WT_WO, 2, smem);
    else if constexpr (s == 7) phase_norm2(P, layer);
    else if constexpr (s == 8) phase_ffn_up(P, layer, smem);
    else phase_resid(P, layer, 1, OFF_F, 2816, WT_DOWN, 5, smem);
  }
}
DI void run_phase(const Params& P, int ph, char* smem) {
  switch (ph) {
#define RP(i) case i: run_phase_t<i>(P, smem); break;
    RP(0) RP(1) RP(2) RP(3) RP(4) RP(5) RP(6) RP(7) RP(8) RP(9) RP(10) RP(11) RP(12) RP(13) RP(14) RP(15) RP(16) RP(17) RP(18) RP(19) RP(20) RP(21)
#undef RP
    default: break;
  }
}
#ifndef MULTI_LAUNCH
#define MULTI_LAUNCH 0
#endif
__global__ void __launch_bounds__(NTHREADS, 2) fwd_megakernel(Params P) {
  extern __shared__ __attribute__((aligned(16))) char smem[];
  cg::grid_group grid = cg::this_grid();
#define RP(i) run_phase_t<i>(P, smem); grid.sync();
  RP(0) RP(1) RP(2) RP(3) RP(4) RP(5) RP(6) RP(7) RP(8) RP(9) RP(10) RP(11) RP(12) RP(13) RP(14) RP(15) RP(16) RP(17) RP(18) RP(19) RP(20)
#undef RP
  run_phase_t<21>(P, smem);
}
#if MULTI_LAUNCH
__global__ void __launch_bounds__(NTHREADS, 2) fwd_phase_kernel(Params P, int ph) {
  extern __shared__ __attribute__((aligned(16))) char smem[];
  run_phase(P, ph, smem);
}
#endif

extern "C" void kernel_launch(void* const* d_in, const int* in_sizes, int n_in, void* d_out, int out_size, void* d_ws, size_t ws_size,
                              hipStream_t stream) {
  static int grid_blocks = 0;
  if (!grid_blocks) {
    int dev = 0, cus = 0, per_cu = 0;
    (void)hipGetDevice(&dev);
    (void)hipDeviceGetAttribute(&cus, hipDeviceAttributeMultiprocessorCount, dev);
    (void)hipFuncSetAttribute((const void*)fwd_megakernel, hipFuncAttributeMaxDynamicSharedMemorySize, SMEM_BYTES);
#if MULTI_LAUNCH
    (void)hipFuncSetAttribute((const void*)fwd_phase_kernel, hipFuncAttributeMaxDynamicSharedMemorySize, SMEM_BYTES);
#endif
    (void)hipOccupancyMaxActiveBlocksPerMultiprocessor(&per_cu, fwd_megakernel, NTHREADS, SMEM_BYTES);
    if (per_cu > 2) per_cu = 2;
    if (per_cu < 1) per_cu = 1;
    grid_blocks = cus * per_cu;
    if (ws_size < OFF_END) fprintf(stderr, "workspace too small: %zu < %zu\n", ws_size, (size_t)OFF_END);
  }
  Params p{};
  for (int i = 0; i < 41; ++i) p.in[i] = (const float*)d_in[i];
  p.out = (float*)d_out; p.ws = (char*)d_ws; p.pad_ = 0;
#if MULTI_LAUNCH
  for (int ph = 0; ph < N_PHASES; ++ph) hipLaunchKernelGGL(fwd_phase_kernel, dim3(grid_blocks), dim3(NTHREADS), SMEM_BYTES, stream, p, ph);
#else
  void* args[] = {&p};
  hipError_t e = hipLaunchCooperativeKernel((void*)fwd_megakernel, dim3(grid_blocks), dim3(NTHREADS), args, SMEM_BYTES, stream);
  if (e != hipSuccess) fprintf(stderr, "cooperative launch failed: %s (grid %d)\n", hipGetErrorString(e), grid_blocks);
#endif
}
```

```cpp
#include <hip/hip_runtime.h>
#include <hip/hip_cooperative_groups.h>
#include <cstdio>
namespace cg = cooperative_groups;

typedef _Float16 h16;
typedef _Float16 h16x8 __attribute__((ext_vector_type(8)));
typedef _Float16 h16x4 __attribute__((ext_vector_type(4)));
typedef float f32x4 __attribute__((ext_vector_type(4)));
typedef float f32x16 __attribute__((ext_vector_type(16)));
#define DI __device__ __forceinline__

constexpr int DM = 1024, NBATCH = 8, SEQ = 8192, CTXL = 256, TLAT = 65536, TCTX = 2048, TT = 67584;
constexpr int KEYS = SEQ + CTXL;
constexpr int NTHREADS = 256;
constexpr float EPS = 1e-6f;
constexpr float QSCALE = 0.10206207261596575f * 1.4426950408889634f;

constexpr long WT_WIN = 0, WT_WGATE = WT_WIN + 2432L * 1024, WT_UKV = WT_WGATE + 3072L * 1024, WT_UQ = WT_UKV + 1024L * 256,
               WT_GLU = WT_UQ + 1024L * 512, WT_BRHY = WT_GLU + 768L * 384, WT_BRS5 = WT_BRHY + 1024L * 384,
               WT_BRMLA = WT_BRS5 + 1024L * 384, WT_WO = WT_BRMLA + 1024L * 512, WT_UP = WT_WO + 1024L * 1024,
               WT_DOWN = WT_UP + 5632L * 1024, WT_LAYER = WT_DOWN + 1024L * 2816;
constexpr size_t al256(size_t x) { return (x + 255) / 256 * 256; }
constexpr size_t OFF_WT = 0;
constexpr size_t OFF_H1 = al256(OFF_WT + 2 * WT_LAYER * 2);
constexpr size_t OFF_U = al256(OFF_H1 + (size_t)TT * 1024 * 2);
constexpr size_t OFF_KVLAT = al256(OFF_U + (size_t)TT * 384 * 2);
constexpr size_t OFF_QLAT = al256(OFF_KVLAT + (size_t)TT * 256 * 2);
constexpr size_t OFF_PHY = al256(OFF_QLAT + (size_t)TT * 512 * 2);
constexpr size_t OFF_PHYC = al256(OFF_PHY + (size_t)NBATCH * 1152 * SEQ * 2);
constexpr size_t OFF_Q = al256(OFF_PHYC + (size_t)NBATCH * 1152 * CTXL * 2);
constexpr size_t OFF_K = al256(OFF_Q + (size_t)64 * KEYS * 96 * 2);
constexpr size_t OFF_VT = al256(OFF_K + (size_t)64 * KEYS * 96 * 2);
constexpr size_t OFF_YS5PRE = al256(OFF_VT + (size_t)64 * 64 * KEYS * 2);
constexpr size_t OFF_YHY = al256(OFF_YS5PRE + (size_t)TT * 384 * 2);
constexpr size_t OFF_FILT = al256(OFF_YHY + (size_t)TT * 384 * 2);
constexpr size_t OFF_TAPSC = al256(OFF_FILT + (size_t)768 * 2 * SEQ * 8);
constexpr size_t OFF_E = al256(OFF_TAPSC + (size_t)768 * 2 * CTXL * 4);
constexpr size_t OFF_XC = al256(OFF_E + (size_t)NBATCH * 2 * 24 * 132 * 64 * 8);
constexpr size_t OFF_MOD = al256(OFF_XC + (size_t)TCTX * 1024 * 4);
constexpr size_t OFF_Z2 = al256(OFF_MOD + (size_t)2 * 9 * 6144 * 4);
constexpr size_t OFF_Z2C = al256(OFF_Z2 + (size_t)2 * SEQ * 64 * 4);
constexpr size_t OFF_S5A = al256(OFF_Z2C + (size_t)2 * CTXL * 64 * 4);
constexpr size_t OFF_S5A64 = al256(OFF_S5A + (size_t)2 * 2 * 24 * 64 * 8);
constexpr size_t OFF_S5B = al256(OFF_S5A64 + (size_t)2 * 2 * 24 * 64 * 8);
constexpr size_t OFF_S5C = al256(OFF_S5B + (size_t)2 * 2 * 24 * 64 * 16 * 8);
constexpr size_t OFF_ROPE = al256(OFF_S5C + (size_t)2 * 2 * 24 * 16 * 128 * 2);
constexpr size_t OFF_END = al256(OFF_ROPE + (size_t)SEQ * 16 * 8);
constexpr size_t OFF_YS5 = OFF_U, OFF_YMLA = OFF_QLAT, OFF_MERGED = OFF_Q, OFF_F = OFF_U, OFF_H2 = OFF_H1;
static_assert(OFF_END <= (size_t)1024 * 1024 * 1024, "workspace over 1 GiB");
static_assert(OFF_F + (size_t)TT * 2816 * 2 <= OFF_FILT, "f alias overruns");
static_assert(OFF_MERGED + (size_t)TT * 1024 * 2 <= OFF_VT, "merged alias overruns");

constexpr int SMEM_BYTES = 73728 + 2048;

struct Params {
  const float* in[41];
  float* out;
  char* ws;
  unsigned long long pad_;
};
enum { I_X = 0, I_C, I_CTX, I_CCTX, I_WMOD, I_BMOD, I_N1G, I_N2G, I_WIN, I_HCW, I_HCB, I_FW1, I_FB1, I_FW2, I_FB2, I_FW3, I_FFREQ,
       I_FDECAY, I_HBIAS, I_LAMRE, I_LAMIM, I_LOGSTEP, I_BRE, I_BIM, I_CRE, I_CIM, I_S5D, I_WGLU, I_GQ, I_WUQ, I_GKV, I_WUKV,
       I_WBRHY, I_WBRS5, I_WBRMLA, I_WO, I_WUP, I_FCW, I_FCB, I_WDOWN, I_FINALG };

DI int tidx() { int t = threadIdx.x; asm volatile("" : "+v"(t)); return t; }
DI int opaque_tid() { return tidx(); }
DI float sigmoidf_(float x) { return 1.f / (1.f + __expf(-x)); }
DI float siluf_(float x) { return x / (1.f + __expf(-x)); }
DI float geluf_(float x) { float z = 0.7978845608028654f * (x + 0.044715f * x * x * x); float t = 1.f - 2.f / (1.f + __expf(2.f * z)); return 0.5f * x * (1.f + t); }
DI float wave_sum(float v) { for (int o = 32; o > 0; o >>= 1) v += __shfl_xor(v, o); return v; }
DI float wave_max(float v) { for (int o = 32; o > 0; o >>= 1) v = fmaxf(v, __shfl_xor(v, o)); return v; }
DI void dsincos(double x, double& s, double& c) {
  const double TWO_PI = 6.283185307179586476925287;
  double r = x - TWO_PI * rint(x / TWO_PI);
  double r2 = r * r, ts = r, tc = 1.0; s = r; c = 1.0;
  for (int k = 1; k <= 15; ++k) { tc = -tc * r2 / (double)((2 * k - 1) * (2 * k)); c += tc; ts = -ts * r2 / (double)((2 * k) * (2 * k + 1)); s += ts; }
}
DI float2 twid(float f) { return make_float2(__builtin_amdgcn_cosf(f), __builtin_amdgcn_sinf(f)); }
DI float2 cmul(float2 a, float2 b) { return make_float2(a.x * b.x - a.y * b.y, a.x * b.y + a.y * b.x); }

struct Tok { int b, pos, ctx, mrow; };
DI Tok tokinfo(int t) { Tok k; if (t < TLAT) { k.b = t >> 13; k.pos = t & 8191; k.ctx = 0; k.mrow = k.b; } else { int u = t - TLAT; k.b = u >> 8; k.pos = u & 255; k.ctx = 1; k.mrow = 8; } return k; }

struct Stg { uint4 a0, a1, a2, a3, b0, b1, b2, b3; };
DI uint4 ld_or_zero(const h16* p, bool ok) { uint4 v = make_uint4(0, 0, 0, 0); if (ok) v = *reinterpret_cast<const uint4*>(p); return v; }
DI void g_load(Stg& s, const h16* __restrict__ Ap, const h16* __restrict__ Bp, long a32, long b32, int k0, int srow, int a_lo, int a_hi) {
  s.a0 = ld_or_zero(Ap + k0, srow >= a_lo && srow < a_hi);
  s.a1 = ld_or_zero(Ap + a32 + k0, srow + 32 >= a_lo && srow + 32 < a_hi);
  s.a2 = ld_or_zero(Ap + 2 * a32 + k0, srow + 64 >= a_lo && srow + 64 < a_hi);
  s.a3 = ld_or_zero(Ap + 3 * a32 + k0, srow + 96 >= a_lo && srow + 96 < a_hi);
  s.b0 = *reinterpret_cast<const uint4*>(Bp + k0); s.b1 = *reinterpret_cast<const uint4*>(Bp + b32 + k0);
  s.b2 = *reinterpret_cast<const uint4*>(Bp + 2 * b32 + k0); s.b3 = *reinterpret_cast<const uint4*>(Bp + 3 * b32 + k0);
}
DI void s_write(char* sw, const Stg& s) {
  *reinterpret_cast<uint4*>(sw) = s.a0; *reinterpret_cast<uint4*>(sw + 32 * 144) = s.a1; *reinterpret_cast<uint4*>(sw + 64 * 144) = s.a2; *reinterpret_cast<uint4*>(sw + 96 * 144) = s.a3;
  *reinterpret_cast<uint4*>(sw + 18432) = s.b0; *reinterpret_cast<uint4*>(sw + 18432 + 32 * 144) = s.b1; *reinterpret_cast<uint4*>(sw + 18432 + 64 * 144) = s.b2; *reinterpret_cast<uint4*>(sw + 18432 + 96 * 144) = s.b3;
}
DI void mma_step(f32x4 (&acc)[4][4], const char* sra, const char* srb) {
#pragma unroll
  for (int ks = 0; ks < 2; ++ks) {
    h16x8 af[4], bf[4];
#pragma unroll
    for (int m = 0; m < 4; ++m) af[m] = *reinterpret_cast<const h16x8*>(sra + m * 16 * 144 + ks * 64);
#pragma unroll
    for (int n = 0; n < 4; ++n) bf[n] = *reinterpret_cast<const h16x8*>(srb + n * 16 * 144 + ks * 64);
#pragma unroll
    for (int m = 0; m < 4; ++m)
#pragma unroll
      for (int n = 0; n < 4; ++n) acc[m][n] = __builtin_amdgcn_mfma_f32_16x16x32_f16(af[m], bf[n], acc[m][n], 0, 0, 0);
  }
}
DI void gemm_kloop(f32x4 (&acc)[4][4], const h16* __restrict__ A, long lda, int a_lo, int a_hi,
                   const h16* __restrict__ Bt, long ldb, int K, char* smem, int tid) {
  const int lane = tid & 63, wid = tid >> 6, wr = wid >> 1, wc = wid & 1, fr = lane & 15, fq = lane >> 4;
  Stg s0, s1;
  const int srow = tid >> 3, skc = tid & 7;
  const h16* Ap = A + (long)srow * lda + skc * 8; const h16* Bp = Bt + (long)srow * ldb + skc * 8;
  const long a32 = 32 * lda, b32 = 32 * ldb;
  char* sw = smem + srow * 144 + skc * 16;
  const char* sra = smem + (wr * 64 + fr) * 144 + fq * 16; const char* srb = smem + 18432 + (wc * 64 + fr) * 144 + fq * 16;
  const int nk = K >> 6;
  g_load(s0, Ap, Bp, a32, b32, 0, srow, a_lo, a_hi); g_load(s1, Ap, Bp, a32, b32, 64, srow, a_lo, a_hi);
  s_write(sw, s0); __syncthreads();
  for (int kt = 0; kt < nk; kt += 2) {
    if (kt + 2 < nk) g_load(s0, Ap, Bp, a32, b32, (kt + 2) << 6, srow, a_lo, a_hi);
    mma_step(acc, sra, srb);
    s_write(sw + 36864, s1);
    __syncthreads();
    if (kt + 3 < nk) g_load(s1, Ap, Bp, a32, b32, (kt + 3) << 6, srow, a_lo, a_hi);
    mma_step(acc, sra + 36864, srb + 36864);
    if (kt + 2 < nk) s_write(sw, s0);
    __syncthreads();
  }
}
struct TileWalk { int lb, nlb, m0, Mx, NT, nfull; };
DI TileWalk tw_init(int MT, int NT) { TileWalk w; w.lb = blockIdx.x >> 3; w.nlb = gridDim.x >> 3; w.Mx = MT >> 3; w.m0 = (blockIdx.x & 7) * w.Mx; w.NT = NT; w.nfull = (w.Mx >> 3) * 8 * NT; return w; }
DI int tw_count(const TileWalk& w) { return w.Mx * w.NT; }
DI void tw_decode(const TileWalk& w, int idx, int& mt, int& nt) {
  if (idx < w.nfull) { const int mg = idx / (8 * w.NT), r = idx % (8 * w.NT); nt = r >> 3; mt = w.m0 + mg * 8 + (r & 7); }
  else { const int rem = w.Mx & 7, r = idx - w.nfull; nt = r / rem; mt = w.m0 + (w.Mx & ~7) + r % rem; }
}
DI void acc_zero(f32x4 (&acc)[4][4]) {
#pragma unroll
  for (int m = 0; m < 4; ++m)
#pragma unroll
    for (int n = 0; n < 4; ++n) acc[m][n] = f32x4{0.f, 0.f, 0.f, 0.f};
}
DI void row_rms(const h16* __restrict__ A, long lda, int K, float* rs) {
  const int tid = tidx(), row = tid >> 1, half = tid & 1;
  const h16* p = A + (long)row * lda + half * (K >> 1);
  float ss = 0.f;
  for (int k = 0; k < (K >> 1); k += 8) {
    h16x8 v = *reinterpret_cast<const h16x8*>(p + k);
#pragma unroll
    for (int j = 0; j < 8; ++j) { float f = (float)v[j]; ss += f * f; }
  }
  ss += __shfl_xor(ss, 1);
  if (half == 0) rs[row] = rsqrtf(ss / (float)K + EPS);
}
DI int map_interleave(int n, int half) { int tile = n >> 7, r = n & 127, sub = r >> 4, fr = r & 15; int j = tile * 64 + (sub >> 1) * 16 + fr; return (sub & 1) ? half + j : j; }
DI int map_col(int mat, int n) {
  switch (mat) {
    case 0: if (n < 640) return n; if (n < 2304) return n + 32; if (n < 2336) return n - 2304 + 640; return -1;
    case 1: return 2336 + n;
    case 3: { int h = n >> 7, j = n & 127; return j < 96 ? h * 96 + j : -1; }
    case 4: return map_interleave(n, 384);
    case 9: return map_interleave(n, 2816);
    default: return n;
  }
}
struct MatDesc { const float* src; const float* scale; long dst; int K, Nmy, Nsrc; };
DI MatDesc get_mat(const Params& P, int layer, int mat) {
  MatDesc d; d.scale = nullptr;
  switch (mat) {
    case 0: d.src = P.in[I_WIN] + (long)layer * 1024 * 5408; d.dst = WT_WIN; d.K = 1024; d.Nmy = 2432; d.Nsrc = 5408; break;
    case 1: d.src = P.in[I_WIN] + (long)layer * 1024 * 5408; d.dst = WT_WGATE; d.K = 1024; d.Nmy = 3072; d.Nsrc = 5408; break;
    case 2: d.src = P.in[I_WUKV] + (long)layer * 256 * 1024; d.dst = WT_UKV; d.K = 256; d.Nmy = 1024; d.Nsrc = 1024; d.scale = P.in[I_GKV] + layer * 256; break;
    case 3: d.src = P.in[I_WUQ] + (long)layer * 512 * 768; d.dst = WT_UQ; d.K = 512; d.Nmy = 1024; d.Nsrc = 768; d.scale = P.in[I_GQ] + layer * 512; break;
    case 4: d.src = P.in[I_WGLU] + (long)layer * 384 * 768; d.dst = WT_GLU; d.K = 384; d.Nmy = 768; d.Nsrc = 768; break;
    case 5: d.src = P.in[I_WBRHY] + (long)layer * 384 * 1024; d.dst = WT_BRHY; d.K = 384; d.Nmy = 1024; d.Nsrc = 1024; break;
    case 6: d.src = P.in[I_WBRS5] + (long)layer * 384 * 1024; d.dst = WT_BRS5; d.K = 384; d.Nmy = 1024; d.Nsrc = 1024; break;
    case 7: d.src = P.in[I_WBRMLA] + (long)layer * 512 * 1024; d.dst = WT_BRMLA; d.K = 512; d.Nmy = 1024; d.Nsrc = 1024; break;
    case 8: d.src = P.in[I_WO] + (long)layer * 1024 * 1024; d.dst = WT_WO; d.K = 1024; d.Nmy = 1024; d.Nsrc = 1024; break;
    case 9: d.src = P.in[I_WUP] + (long)layer * 1024 * 5632; d.dst = WT_UP; d.K = 1024; d.Nmy = 5632; d.Nsrc = 5632; break;
    default: d.src = P.in[I_WDOWN] + (long)layer * 2816 * 1024; d.dst = WT_DOWN; d.K = 2816; d.Nmy = 1024; d.Nsrc = 1024; break;
  }
  return d;
}
constexpr int WT_TILES_PER_LAYER = 608 + 768 + 64 + 128 + 72 + 96 + 96 + 128 + 256 + 1408 + 704;
DI void item_wt(const Params& P, int item, char* smem) {
  const int layer = item / WT_TILES_PER_LAYER; int r = item % WT_TILES_PER_LAYER;
  const int cnt[11] = {608, 768, 64, 128, 72, 96, 96, 128, 256, 1408, 704};
  int mat = 0;
#pragma unroll
  for (int i = 0; i < 10; ++i) { if (mat == i && r >= cnt[i]) { r -= cnt[i]; mat = i + 1; } }
  MatDesc d = get_mat(P, layer, mat);
  const int kt = d.K >> 6, n0 = (r / kt) * 64, k0 = (r % kt) * 64;
  float* tile = reinterpret_cast<float*>(smem);
  h16* dst = reinterpret_cast<h16*>(P.ws + OFF_WT) + (long)layer * WT_LAYER + d.dst;
  const int tid = tidx(), lx = tid & 63, ly = tid >> 6;
  const int sc = map_col(mat, n0 + lx);
#pragma unroll 4
  for (int i = 0; i < 16; ++i) { int kk = i * 4 + ly; tile[kk * 65 + lx] = sc >= 0 ? d.src[(long)(k0 + kk) * d.Nsrc + sc] : 0.f; }
  __syncthreads();
  const float s = d.scale ? d.scale[k0 + lx] : 1.f;
#pragma unroll 4
  for (int i = 0; i < 16; ++i) { int nn = i * 4 + ly; dst[(long)(n0 + nn) * d.K + k0 + lx] = (h16)(tile[lx * 65 + nn] * s); }
  __syncthreads();
}
DI void item_mod(const Params& P, int item, char* smem) {
  const int layer = item / 96, n0 = (item % 96) * 64;
  float* s = reinterpret_cast<float*>(smem);
  float* part = s + 9 * 1024;
  const int tid = tidx(), lane = tid & 63, wid = tid >> 6;
  for (int i = tid; i < 9 * 1024; i += NTHREADS) { float v = i < 8192 ? P.in[I_C][i] : P.in[I_CCTX][i - 8192]; s[i] = siluf_(v); }
  __syncthreads();
  const float* w = P.in[I_WMOD] + (long)layer * 1024 * 6144 + n0 + lane;
  float acc[9];
#pragma unroll
  for (int r = 0; r < 9; ++r) acc[r] = 0.f;
  for (int k = wid * 256; k < wid * 256 + 256; ++k) {
    const float wv = w[(long)k * 6144];
#pragma unroll
    for (int r = 0; r < 9; ++r) acc[r] += s[r * 1024 + k] * wv;
  }
#pragma unroll
  for (int r = 0; r < 9; ++r) part[(wid * 9 + r) * 64 + lane] = acc[r];
  __syncthreads();
  float* mod = reinterpret_cast<float*>(P.ws + OFF_MOD) + (long)layer * 9 * 6144;
  for (int i = tid; i < 9 * 64; i += NTHREADS) {
    const int r = i >> 6, c = i & 63;
    mod[r * 6144 + n0 + c] = part[(0 * 9 + r) * 64 + c] + part[(1 * 9 + r) * 64 + c] + part[(2 * 9 + r) * 64 + c] + part[(3 * 9 + r) * 64 + c] + P.in[I_BMOD][layer * 6144 + n0 + c];
  }
  __syncthreads();
}
DI void item_hymlp(const Params& P, int item, char* smem) {
  const int layer = item / 132; int r = item % 132;
  const int isc = r >= 128; const int Lf = isc ? CTXL : SEQ; const int t0 = (isc ? r - 128 : r) * 64;
  float* z1 = reinterpret_cast<float*>(smem);
  const int tid = tidx(), tl = tid >> 2, h0 = (tid & 3) * 16; const int t = t0 + tl;
  const float* w1 = P.in[I_FW1] + layer * 17 * 64; const float* b1 = P.in[I_FB1] + layer * 64;
  const float* w2 = P.in[I_FW2] + layer * 64 * 64; const float* b2 = P.in[I_FB2] + layer * 64; const float* fq = P.in[I_FFREQ] + layer * 64;
  float feat[17]; feat[0] = (float)t / (float)Lf;
#pragma unroll
  for (int k = 1; k <= 8; ++k) { float rev = (float)((t * k) % Lf) / (float)Lf; feat[k] = __builtin_amdgcn_cosf(rev); feat[8 + k] = __builtin_amdgcn_sinf(rev); }
#pragma unroll 4
  for (int j = 0; j < 16; ++j) {
    const int h = h0 + j; float a = b1[h];
#pragma unroll
    for (int f = 0; f < 17; ++f) a += feat[f] * w1[f * 64 + h];
    z1[tl * 65 + h] = __sinf(fq[h] * a);
  }
  __syncthreads();
  float* z2 = isc ? reinterpret_cast<float*>(P.ws + OFF_Z2C) + (long)layer * CTXL * 64 : reinterpret_cast<float*>(P.ws + OFF_Z2) + (long)layer * SEQ * 64;
  float a2[16];
#pragma unroll
  for (int j = 0; j < 16; ++j) a2[j] = b2[h0 + j];
  for (int k = 0; k < 64; ++k) {
    const float zv = z1[tl * 65 + k];
#pragma unroll
    for (int j = 0; j < 16; ++j) a2[j] += zv * w2[k * 64 + h0 + j];
  }
#pragma unroll
  for (int j = 0; j < 16; ++j) z2[(long)t * 64 + h0 + j] = __sinf(fq[h0 + j] * a2[j]);
  __syncthreads();
}
DI void item_s5disc(const Params& P, int item) {
  const int layer = item / 12, dir = (item % 12) / 6, gb = item % 6;
  const int tid = tidx(), g = gb * 4 + (tid >> 6), n = tid & 63;
  const int ld = layer * 2 + dir; const long gi = (long)ld * 24 + g;
  const double lre = P.in[I_LAMRE][gi * 64 + n], lim = P.in[I_LAMIM][gi * 64 + n];
  const double step = exp((double)P.in[I_LOGSTEP][gi]);
  double sn, cs; dsincos(lim * step, sn, cs);
  const double mag = exp(lre * step);
  const double are = mag * cs, aim = mag * sn;
  const double nr = are - 1.0, ni = aim, den = lre * lre + lim * lim;
  const double fre = (nr * lre + ni * lim) / den, fim = (ni * lre - nr * lim) / den;
  float2* A = reinterpret_cast<float2*>(P.ws + OFF_S5A); float2* A64 = reinterpret_cast<float2*>(P.ws + OFF_S5A64);
  A[gi * 64 + n] = make_float2((float)are, (float)aim);
  double pr = are, pi = aim;
  for (int i = 0; i < 6; ++i) { double t = pr * pr - pi * pi; pi = 2.0 * pr * pi; pr = t; }
  A64[gi * 64 + n] = make_float2((float)pr, (float)pi);
  float2* Bb = reinterpret_cast<float2*>(P.ws + OFF_S5B) + (gi * 64 + n) * 16;
  const float* bre = P.in[I_BRE] + (gi * 64 + n) * 16; const float* bim = P.in[I_BIM] + (gi * 64 + n) * 16;
  for (int c = 0; c < 16; ++c) { double br = bre[c], bi = bim[c]; Bb[c] = make_float2((float)(fre * br - fim * bi), (float)(fre * bi + fim * br)); }
  h16* Ct = reinterpret_cast<h16*>(P.ws + OFF_S5C) + gi * 16 * 128;
  const float* cre = P.in[I_CRE] + gi * 16 * 64; const float* cim = P.in[I_CIM] + gi * 16 * 64;
  for (int c = 0; c < 16; ++c) { Ct[c * 128 + n] = (h16)cre[c * 64 + n]; Ct[c * 128 + 64 + n] = (h16)(-cim[c * 64 + n]); }
}
DI void item_rope(const Params& P, int item) {
  const int idx = item * NTHREADS + tidx(); const int pos = idx >> 4, i = idx & 15;
  const double inv[8] = {1.0, 0.31622776601683794, 0.1, 0.031622776601683794, 0.01, 0.0031622776601683794, 0.001, 0.00031622776601683794};
  double iv = 1.0;
#pragma unroll
  for (int k = 0; k < 8; ++k) if ((i & 7) == k) iv = inv[k];
  const double ang = (double)(i < 8 ? (pos >> 6) : (pos & 63)) * iv;
  double s, c; dsincos(ang, s, c);
  reinterpret_cast<float2*>(P.ws + OFF_ROPE)[idx] = make_float2((float)c, (float)s);
}
constexpr int PRO_N_WT = 2 * WT_TILES_PER_LAYER, PRO_N_MOD = 192, PRO_N_HY = 264, PRO_N_S5 = 24, PRO_N_ROPE = 512;
DI void phase_prologue(const Params& P, char* smem) {
  const int total = PRO_N_MOD + PRO_N_HY + PRO_N_S5 + PRO_N_ROPE + PRO_N_WT;
  for (int it = blockIdx.x; it < total; it += gridDim.x) {
    int i = it;
    if (i < PRO_N_MOD) { item_mod(P, i, smem); continue; } i -= PRO_N_MOD;
    if (i < PRO_N_HY) { item_hymlp(P, i, smem); continue; } i -= PRO_N_HY;
    if (i < PRO_N_S5) { item_s5disc(P, i); continue; } i -= PRO_N_S5;
    if (i < PRO_N_ROPE) { item_rope(P, i); continue; } i -= PRO_N_ROPE;
    item_wt(P, i, smem);
  }
}

DI const float* xrow_src(const Params& P, int layer_stage, int t) {
  if (t < TLAT) return (layer_stage == 0 ? P.in[I_X] : P.out) + (long)t * 1024;
  return (layer_stage == 0 ? P.in[I_CTX] : reinterpret_cast<const float*>(P.ws + OFF_XC)) + (long)(t - TLAT) * 1024;
}
DI float* xrow_dst(const Params& P, int t) {
  if (t < TLAT) return P.out + (long)t * 1024;
  return reinterpret_cast<float*>(P.ws + OFF_XC) + (long)(t - TLAT) * 1024;
}
DI void normmod_rows(const Params& P, int layer, int which, int stage, int ntok, int item, int nitems_stride) {
  const int tid = tidx(), lane = tid & 63, wid = tid >> 6;
  const float* g = P.in[which ? I_N2G : I_N1G] + layer * 1024;
  const float* mod = reinterpret_cast<const float*>(P.ws + OFF_MOD) + (long)layer * 9 * 6144;
  h16* H = reinterpret_cast<h16*>(P.ws + OFF_H1);
  for (int rg = item; rg * 4 < ntok; rg += nitems_stride) {
    const int t = rg * 4 + wid;
    const Tok k = tokinfo(t);
    const float* xr = xrow_src(P, stage, t);
    const float* sh = mod + k.mrow * 6144 + (which ? 3 : 0) * 1024; const float* sc = sh + 1024;
    float4 v[4]; float ss = 0.f;
#pragma unroll
    for (int i = 0; i < 4; ++i) { v[i] = *reinterpret_cast<const float4*>(xr + i * 256 + lane * 4); ss += v[i].x * v[i].x + v[i].y * v[i].y + v[i].z * v[i].z + v[i].w * v[i].w; }
    ss = wave_sum(ss);
    const float r = rsqrtf(ss * (1.f / 1024.f) + EPS);
#pragma unroll
    for (int i = 0; i < 4; ++i) {
      const int c = i * 256 + lane * 4;
      const float4 gg = *reinterpret_cast<const float4*>(g + c), s1 = *reinterpret_cast<const float4*>(sc + c), s0 = *reinterpret_cast<const float4*>(sh + c);
      h16x4 o;
      o[0] = (h16)(v[i].x * r * gg.x * (1.f + s1.x) + s0.x); o[1] = (h16)(v[i].y * r * gg.y * (1.f + s1.y) + s0.y);
      o[2] = (h16)(v[i].z * r * gg.z * (1.f + s1.z) + s0.z); o[3] = (h16)(v[i].w * r * gg.w * (1.f + s1.w) + s0.w);
      *reinterpret_cast<h16x4*>(H + (long)t * 1024 + c) = o;
    }
  }
}
DI void phase_final(const Params& P) {
  const int lane = tidx() & 63, wid = tidx() >> 6;
  const float* g = P.in[I_FINALG];
  for (int rg = blockIdx.x; rg * 4 < TLAT; rg += gridDim.x) {
    float* xr = P.out + (long)(rg * 4 + wid) * 1024;
    float4 v[4]; float ss = 0.f;
#pragma unroll
    for (int i = 0; i < 4; ++i) { v[i] = *reinterpret_cast<const float4*>(xr + i * 256 + lane * 4); ss += v[i].x * v[i].x + v[i].y * v[i].y + v[i].z * v[i].z + v[i].w * v[i].w; }
    ss = wave_sum(ss);
    const float r = rsqrtf(ss * (1.f / 1024.f) + EPS);
#pragma unroll
    for (int i = 0; i < 4; ++i) {
      const int c = i * 256 + lane * 4; const float4 gg = *reinterpret_cast<const float4*>(g + c);
      *reinterpret_cast<float4*>(xr + c) = make_float4(v[i].x * r * gg.x, v[i].y * r * gg.y, v[i].z * r * gg.z, v[i].w * r * gg.w);
    }
  }
}
template <int S> DI void fft_dif_pass(float2* X, int h) {
  const int hs = h >> (S - 1);
#pragma unroll 1
  for (int item = tidx(); item < (8192 >> S); item += NTHREADS) {
    const int j = item % hs, blk = item / hs, i0 = blk * 2 * h + j;
    float2 v[1 << S];
#pragma unroll
    for (int k = 0; k < (1 << S); ++k) v[k] = X[i0 + k * hs];
#pragma unroll
    for (int q = 0; q < S; ++q) {
      const int hq = h >> q, dist = 1 << (S - 1 - q);
#pragma unroll
      for (int k = 0; k < (1 << S); ++k) {
        if (k & dist) continue;
        const float2 a = v[k], b = v[k + dist];
        const int e = j + (k & (dist - 1)) * hs;
        v[k] = make_float2(a.x + b.x, a.y + b.y);
        v[k + dist] = cmul(make_float2(a.x - b.x, a.y - b.y), twid(-(float)e / (float)(2 * hq)));
      }
    }
#pragma unroll
    for (int k = 0; k < (1 << S); ++k) X[i0 + k * hs] = v[k];
  }
  __syncthreads();
}
template <int S> DI void fft_dit_pass(float2* X, int hs) {
  const int hmax = hs << (S - 1);
#pragma unroll 1
  for (int item = tidx(); item < (8192 >> S); item += NTHREADS) {
    const int j = item % hs, blk = item / hs, i0 = blk * 2 * hmax + j;
    float2 v[1 << S];
#pragma unroll
    for (int k = 0; k < (1 << S); ++k) v[k] = X[i0 + k * hs];
#pragma unroll
    for (int q = 0; q < S; ++q) {
      const int hq = hs << q, dist = 1 << q;
#pragma unroll
      for (int k = 0; k < (1 << S); ++k) {
        if (k & dist) continue;
        const int e = j + (k & (dist - 1)) * hs;
        const float2 a = v[k], b = cmul(v[k + dist], twid((float)e / (float)(2 * hq)));
        v[k] = make_float2(a.x + b.x, a.y + b.y);
        v[k + dist] = make_float2(a.x - b.x, a.y - b.y);
      }
    }
#pragma unroll
    for (int k = 0; k < (1 << S); ++k) X[i0 + k * hs] = v[k];
  }
  __syncthreads();
}
DI void fft_fwd(float2* X) { fft_dif_pass<3>(X, 4096); fft_dif_pass<3>(X, 512); fft_dif_pass<3>(X, 64); fft_dif_pass<2>(X, 8); fft_dif_pass<2>(X, 2); }
DI void fft_inv(float2* X) { fft_dit_pass<2>(X, 1); fft_dit_pass<2>(X, 4); fft_dit_pass<3>(X, 16); fft_dit_pass<3>(X, 128); fft_dit_pass<3>(X, 1024); }

DI float block_sum(float v, float* red) {
  v = wave_sum(v);
  __syncthreads();
  if ((tidx() & 63) == 0) red[tidx() >> 6] = v;
  __syncthreads();
  const float r = red[0] + red[1] + red[2] + red[3];
  __syncthreads();
  return r;
}
DI void item_filter(const Params& P, int layer, int oc, char* smem) {
  float2* X = reinterpret_cast<float2*>(smem); float* red = reinterpret_cast<float*>(smem + 65536);
  const int tid = tidx();
  const float* z2 = reinterpret_cast<const float*>(P.ws + OFF_Z2) + (long)layer * SEQ * 64;
  const float* w3 = P.in[I_FW3] + (long)layer * 64 * 1536; const float* dec = P.in[I_FDECAY] + layer * 1536;
  const int colf = oc, colb = 768 + oc;
  const float df = fabsf(dec[colf]), db = fabsf(dec[colb]);
  float lsum = 0.f;
#pragma unroll 2
  for (int i = 0; i < 32; ++i) {
    const int t = tid + 256 * i; const float* zr = z2 + (long)t * 64;
    float af = 0.f, ab = 0.f;
#pragma unroll 8
    for (int k = 0; k < 64; ++k) { const float z = zr[k]; af += z * w3[k * 1536 + colf]; ab += z * w3[k * 1536 + colb]; }
    const float tn = (float)t * (1.f / 8192.f);
    af *= __expf(-tn * df); ab *= __expf(-tn * db);
    lsum += fabsf(af) + fabsf(ab);
    X[t] = make_float2(af, ab);
  }
  const float nrm = block_sum(lsum, red);
  const float sc = 0.5f / 8192.f / nrm;
  float ev[32];
  float2* F = reinterpret_cast<float2*>(P.ws + OFF_FILT) + (long)oc * 2 * 8192;
#pragma unroll
  for (int i = 0; i < 32; ++i) {
    const int n = tid + 256 * i; const float lo = X[n].x; const float hi = n > 0 ? X[8192 - n].y : 0.f;
    ev[i] = (lo + hi) * sc; F[8192 + n] = make_float2((lo - hi) * sc, 0.f);
  }
  __syncthreads();
#pragma unroll
  for (int i = 0; i < 32; ++i) X[tid + 256 * i] = make_float2(ev[i], 0.f);
  __syncthreads();
  fft_fwd(X);
#pragma unroll 4
  for (int i = 0; i < 32; ++i) F[tid + 256 * i] = X[tid + 256 * i];
  __syncthreads();
#pragma unroll 4
  for (int i = 0; i < 32; ++i) { const int n = tid + 256 * i; const float d = F[8192 + n].x; const float2 w = twid(-(float)n * (1.f / 16384.f)); X[n] = make_float2(d * w.x, d * w.y); }
  __syncthreads();
  fft_fwd(X);
#pragma unroll 4
  for (int i = 0; i < 32; ++i) F[8192 + tid + 256 * i] = X[tid + 256 * i];
  __syncthreads();
}
DI void item_filter_ctx(const Params& P, int layer, int oc, char* smem) {
  float* red = reinterpret_cast<float*>(smem);
  const int t = tidx();
  const float* zr = reinterpret_cast<const float*>(P.ws + OFF_Z2C) + (long)layer * CTXL * 64 + t * 64;
  const float* w3 = P.in[I_FW3] + (long)layer * 64 * 1536; const float* dec = P.in[I_FDECAY] + layer * 1536;
  float af = 0.f, ab = 0.f;
  for (int k = 0; k < 64; ++k) { const float z = zr[k]; af += z * w3[k * 1536 + oc]; ab += z * w3[k * 1536 + 768 + oc]; }
  const float tn = (float)t * (1.f / 256.f);
  af *= __expf(-tn * fabsf(dec[oc])); ab *= __expf(-tn * fabsf(dec[768 + oc]));
  const float nrm = block_sum(fabsf(af) + fabsf(ab), red);
  float* T = reinterpret_cast<float*>(P.ws + OFF_TAPSC) + (long)oc * 512;
  T[t] = af / nrm; T[256 + t] = ab / nrm;
}

DI void phase_norm1(const Params& P, int layer, char* smem) {
  const int nfilt = 768 + (layer == 0 ? 768 : 0);
  for (int it = blockIdx.x; it < nfilt; it += gridDim.x) {
    if (it < 768) item_filter(P, layer, it, smem); else item_filter_ctx(P, layer, it - 768, smem);
  }
  normmod_rows(P, layer, 0, layer, TT, blockIdx.x, gridDim.x);
}

DI void phase_gemm_in(const Params& P, int layer, char* smem) {
  const int tid = tidx(), lane = tid & 63, wid = tid >> 6, wr = wid >> 1, wc = wid & 1, fr = lane & 15, fq = lane >> 4;
  const h16* H = reinterpret_cast<const h16*>(P.ws + OFF_H1);
  const h16* W = reinterpret_cast<const h16*>(P.ws + OFF_WT) + (long)layer * WT_LAYER + WT_WIN;
  h16* U = reinterpret_cast<h16*>(P.ws + OFF_U); h16* KV = reinterpret_cast<h16*>(P.ws + OFF_KVLAT); h16* QL = reinterpret_cast<h16*>(P.ws + OFF_QLAT);
  h16* PHY = reinterpret_cast<h16*>(P.ws + OFF_PHY); h16* PHYC = reinterpret_cast<h16*>(P.ws + OFF_PHYC); h16* Kb = reinterpret_cast<h16*>(P.ws + OFF_K);
  const float2* rope = reinterpret_cast<const float2*>(P.ws + OFF_ROPE);
  constexpr int NT = 19, MT = TT / 128;
  const TileWalk tw = tw_init(MT, NT);
  for (int tile = tw.lb; tile < tw_count(tw); tile += tw.nlb) {
    int mt, nt; tw_decode(tw, tile, mt, nt);
    f32x4 acc[4][4]; acc_zero(acc);
    gemm_kloop(acc, H + (long)mt * 128 * 1024, 1024, 0, 128, W + (long)nt * 128 * 1024, 1024, 1024, smem, opaque_tid());
    const int t0 = mt * 128; const Tok tk = tokinfo(t0);
    if (nt < 9) {
      h16* dst; int ld, cb;
      if (nt < 3) { dst = U; ld = 384; cb = nt * 128; } else if (nt < 5) { dst = KV; ld = 256; cb = (nt - 3) * 128; } else { dst = QL; ld = 512; cb = (nt - 5) * 128; }
#pragma unroll
      for (int m = 0; m < 4; ++m)
#pragma unroll
        for (int n = 0; n < 4; ++n)
#pragma unroll
          for (int j = 0; j < 4; ++j) dst[(long)(t0 + wr * 64 + m * 16 + fq * 4 + j) * ld + cb + wc * 64 + n * 16 + fr] = (h16)acc[m][n][j];
    } else if (nt < 18) {
      h16* base = tk.ctx ? PHYC + (long)tk.b * 1152 * CTXL : PHY + (long)tk.b * 1152 * SEQ; const int lp = tk.ctx ? CTXL : SEQ;
#pragma unroll
      for (int m = 0; m < 4; ++m)
#pragma unroll
        for (int n = 0; n < 4; ++n) {
          const int ch = (nt - 9) * 128 + wc * 64 + n * 16 + fr; const int pos = tk.pos + wr * 64 + m * 16 + fq * 4;
          h16x4 o; o[0] = (h16)acc[m][n][0]; o[1] = (h16)acc[m][n][1]; o[2] = (h16)acc[m][n][2]; o[3] = (h16)acc[m][n][3];
          *reinterpret_cast<h16x4*>(base + (long)ch * lp + pos) = o;
        }
    } else if (wc == 0) {
#pragma unroll
      for (int m = 0; m < 4; ++m)
#pragma unroll
        for (int j = 0; j < 4; ++j) {
          const int pos = tk.pos + wr * 64 + m * 16 + fq * 4 + j; const int key = tk.ctx ? SEQ + pos : pos;
          float x1 = acc[m][0][j], x2 = acc[m][1][j];
          if (!tk.ctx) { const float2 cs = rope[pos * 16 + fr]; const float y1 = x1 * cs.x - x2 * cs.y, y2 = x1 * cs.y + x2 * cs.x; x1 = y1; x2 = y2; }
#pragma unroll
          for (int h = 0; h < 8; ++h) { h16* kr = Kb + ((long)(tk.b * 8 + h) * KEYS + key) * 96 + 64; kr[fr] = (h16)x1; kr[16 + fr] = (h16)x2; }
        }
    }
  }
}
DI void item_kv(const Params& P, int layer, int tile, char* smem) {
  const int tid = tidx(), lane = tid & 63, wid = tid >> 6, wr = wid >> 1, wc = wid & 1, fr = lane & 15, fq = lane >> 4;
  const int mt = tile >> 3, hd = tile & 7; const int t0 = mt * 128; const Tok tk = tokinfo(t0);
  const h16* A = reinterpret_cast<const h16*>(P.ws + OFF_KVLAT) + (long)t0 * 256;
  const h16* W = reinterpret_cast<const h16*>(P.ws + OFF_WT) + (long)layer * WT_LAYER + WT_UKV + (long)hd * 128 * 256;
  float* rs = reinterpret_cast<float*>(smem + 73728);
  row_rms(A, 256, 256, rs);
  f32x4 acc[4][4]; acc_zero(acc);
  gemm_kloop(acc, A, 256, 0, 128, W, 256, 256, smem, opaque_tid());
  h16* Kb = reinterpret_cast<h16*>(P.ws + OFF_K) + (long)(tk.b * 8 + hd) * KEYS * 96;
  h16* Vt = reinterpret_cast<h16*>(P.ws + OFF_VT) + (long)(tk.b * 8 + hd) * 64 * KEYS;
  const int key0 = (tk.ctx ? SEQ : 0) + tk.pos;
#pragma unroll
  for (int m = 0; m < 4; ++m) {
    const int r0 = wr * 64 + m * 16 + fq * 4;
    const float s0 = rs[r0], s1 = rs[r0 + 1], s2 = rs[r0 + 2], s3 = rs[r0 + 3];
#pragma unroll
    for (int n = 0; n < 4; ++n) {
      const int col = n * 16 + fr;
      if (wc == 0) {
        Kb[(long)(key0 + r0 + 0) * 96 + col] = (h16)(acc[m][n][0] * s0); Kb[(long)(key0 + r0 + 1) * 96 + col] = (h16)(acc[m][n][1] * s1);
        Kb[(long)(key0 + r0 + 2) * 96 + col] = (h16)(acc[m][n][2] * s2); Kb[(long)(key0 + r0 + 3) * 96 + col] = (h16)(acc[m][n][3] * s3);
      } else {
        h16x4 o; o[0] = (h16)(acc[m][n][0] * s0); o[1] = (h16)(acc[m][n][1] * s1); o[2] = (h16)(acc[m][n][2] * s2); o[3] = (h16)(acc[m][n][3] * s3);
        *reinterpret_cast<h16x4*>(Vt + (long)col * KEYS + key0 + r0) = o;
      }
    }
  }
  __syncthreads();
}
DI void item_q(const Params& P, int layer, int tile, char* smem) {
  const int tid = tidx(), lane = tid & 63, wid = tid >> 6, wr = wid >> 1, wc = wid & 1, fr = lane & 15, fq = lane >> 4;
  const int mt = tile >> 3, hd = tile & 7; const int t0 = mt * 128; const Tok tk = tokinfo(t0);
  const h16* A = reinterpret_cast<const h16*>(P.ws + OFF_QLAT) + (long)t0 * 512;
  const h16* W = reinterpret_cast<const h16*>(P.ws + OFF_WT) + (long)layer * WT_LAYER + WT_UQ + (long)hd * 128 * 512;
  float* rs = reinterpret_cast<float*>(smem + 73728);
  row_rms(A, 512, 512, rs);
  f32x4 acc[4][4]; acc_zero(acc);
  gemm_kloop(acc, A, 512, 0, 128, W, 512, 512, smem, opaque_tid());
  h16* Qb = reinterpret_cast<h16*>(P.ws + OFF_Q) + (long)(tk.b * 8 + hd) * KEYS * 96;
  const float2* rope = reinterpret_cast<const float2*>(P.ws + OFF_ROPE);
  const int q0 = (tk.ctx ? SEQ : 0) + tk.pos;
#pragma unroll
  for (int m = 0; m < 4; ++m)
#pragma unroll
    for (int j = 0; j < 4; ++j) {
      const int r = wr * 64 + m * 16 + fq * 4 + j; const float s = rs[r] * QSCALE;
      h16* qr = Qb + (long)(q0 + r) * 96;
      if (wc == 0) {
#pragma unroll
        for (int n = 0; n < 4; ++n) qr[n * 16 + fr] = (h16)(acc[m][n][j] * s);
      } else {
        float x1 = acc[m][0][j], x2 = acc[m][1][j];
        if (!tk.ctx) { const float2 cs = rope[(tk.pos + r) * 16 + fr]; const float y1 = x1 * cs.x - x2 * cs.y, y2 = x1 * cs.y + x2 * cs.x; x1 = y1; x2 = y2; }
        qr[64 + fr] = (h16)(x1 * s); qr[80 + fr] = (h16)(x2 * s);
      }
    }
  __syncthreads();
}
DI int s5_chunk_base(int b, int dir, int si) {
  if (si < 4) { const int cc = dir ? 3 - si : si; return TLAT + b * CTXL + cc * 64; }
  const int lc = dir ? 127 - (si - 4) : si - 4; return b * SEQ + lc * 64;
}
DI void s5_stage_u(const h16* __restrict__ U, int tokbase, int g, float* us) {
  const int lane = tidx() & 63;
  const h16* p = U + (long)(tokbase + lane) * 384 + g * 16;
  const h16x8 v0 = *reinterpret_cast<const h16x8*>(p), v1 = *reinterpret_cast<const h16x8*>(p + 8);
#pragma unroll
  for (int j = 0; j < 8; ++j) { us[lane * 16 + j] = (float)v0[j]; us[lane * 16 + 8 + j] = (float)v1[j]; }
}
DI void item_s5_pass1(const Params& P, int layer, int wtask, char* smem) {
  const int lane = tidx() & 63, wid = tidx() >> 6;
  float* us = reinterpret_cast<float*>(smem + wid * 12800);
  const int si = wtask % 132; int r = wtask / 132; const int g = r % 24; r /= 24; const int dir = r & 1, b = r >> 1;
  const long gi = (long)(layer * 2 + dir) * 24 + g;
  const float2 a = reinterpret_cast<const float2*>(P.ws + OFF_S5A)[gi * 64 + lane];
  const float2* Bb = reinterpret_cast<const float2*>(P.ws + OFF_S5B) + (gi * 64 + lane) * 16;
  float bre[16], bim[16];
#pragma unroll
  for (int c = 0; c < 16; ++c) { const float2 v = Bb[c]; bre[c] = v.x; bim[c] = v.y; }
  s5_stage_u(reinterpret_cast<const h16*>(P.ws + OFF_U), s5_chunk_base(b, dir, si), g, us);
  float hr = 0.f, hi = 0.f;
#pragma unroll 4
  for (int s = 0; s < 64; ++s) {
    const int tau = dir ? 63 - s : s;
    const float4* up = reinterpret_cast<const float4*>(us + tau * 16);
    float br = 0.f, bi = 0.f;
#pragma unroll
    for (int q = 0; q < 4; ++q) { const float4 u = up[q];
      br += bre[q * 4] * u.x + bre[q * 4 + 1] * u.y + bre[q * 4 + 2] * u.z + bre[q * 4 + 3] * u.w;
      bi += bim[q * 4] * u.x + bim[q * 4 + 1] * u.y + bim[q * 4 + 2] * u.z + bim[q * 4 + 3] * u.w; }
    const float nr = a.x * hr - a.y * hi + br, ni = a.x * hi + a.y * hr + bi; hr = nr; hi = ni;
  }
  reinterpret_cast<float2*>(P.ws + OFF_E)[((long)((b * 2 + dir) * 24 + g) * 132 + si) * 64 + lane] = make_float2(hr, hi);
}

DI float hy_dw(const h16* __restrict__ p, int t, int Ls, float w0, float w1, float w2, float bias) {
  const float xm = t > 0 ? (float)p[t - 1] : 0.f, x0 = (float)p[t], xp = t + 1 < Ls ? (float)p[t + 1] : 0.f;
  return xm * w0 + x0 * w1 + xp * w2 + bias;
}
DI void item_hyena(const Params& P, int layer, int task, char* smem) {
  float2* X = reinterpret_cast<float2*>(smem);
  const int tid = tidx(); const int pair = task / 384, c = task % 384;
  const h16* PH0 = reinterpret_cast<const h16*>(P.ws + OFF_PHY) + (long)(2 * pair) * 1152 * SEQ;
  const h16* PH1 = PH0 + (long)1152 * SEQ;
  const float* cw = P.in[I_HCW] + layer * 3 * 1152; const float* cb = P.in[I_HCB] + layer * 1152;
  const float2* F = reinterpret_cast<const float2*>(P.ws + OFF_FILT);
  float2* SCR = reinterpret_cast<float2*>(P.ws + OFF_YS5PRE) + (long)blockIdx.x * 12288;
  float2* SCR2 = SCR + 8192;
  const float vw0 = cw[c], vw1 = cw[1152 + c], vw2 = cw[2304 + c], vbb = cb[c];
  const h16* pv0 = PH0 + (long)c * SEQ; const h16* pv1 = PH1 + (long)c * SEQ;
  float2 ye[16]; int tq;
#pragma unroll 1
  for (int o = 0; o < 2; ++o) {
    const float2* Te = F + (long)(o * 384 + c) * 2 * 8192; const float2* To = Te + 8192;
    float ts = 1.f / 16384.f; asm volatile("" : "+v"(ts));
{ tq = tid; asm volatile("" : "+v"(tq)); }
#pragma unroll 8
    for (int i = 0; i < 32; ++i) { const int t = tq + 256 * i;
      X[t] = o == 0 ? make_float2(hy_dw(pv0, t, SEQ, vw0, vw1, vw2, vbb), hy_dw(pv1, t, SEQ, vw0, vw1, vw2, vbb)) : SCR[t]; }
    __syncthreads();
    fft_fwd(X);
{ tq = tid; asm volatile("" : "+v"(tq)); }
#pragma unroll 8
    for (int i = 0; i < 32; ++i) { const int n = tq + 256 * i; X[n] = cmul(X[n], Te[n]); }
    __syncthreads();
    fft_inv(X);
{ tq = tid; asm volatile("" : "+v"(tq)); }
#pragma unroll
    for (int i = 0; i < 16; ++i) { ye[i] = X[tq + 256 * i]; SCR2[tq + 256 * i] = X[tq + 4096 + 256 * i]; }
    __syncthreads();
{ tq = tid; asm volatile("" : "+v"(tq)); }
#pragma unroll 8
    for (int i = 0; i < 32; ++i) { const int t = tq + 256 * i;
      const float2 zz = o == 0 ? make_float2(hy_dw(pv0, t, SEQ, vw0, vw1, vw2, vbb), hy_dw(pv1, t, SEQ, vw0, vw1, vw2, vbb)) : SCR[t];
      X[t] = cmul(zz, twid(-(float)t * ts)); }
    __syncthreads();
    fft_fwd(X);
{ tq = tid; asm volatile("" : "+v"(tq)); }
#pragma unroll 8
    for (int i = 0; i < 32; ++i) { const int n = tq + 256 * i; X[n] = cmul(X[n], To[n]); }
    __syncthreads();
    fft_inv(X);
    asm volatile("" : "+v"(ts));
{ tq = tid; asm volatile("" : "+v"(tq)); }
#pragma unroll
    for (int i = 0; i < 16; ++i) { const int t = tq + 256 * i; const float2 yo = cmul(X[t], twid((float)t * ts)); X[t] = make_float2(ye[i].x + yo.x, ye[i].y + yo.y); }
{ tq = tid; asm volatile("" : "+v"(tq)); }
#pragma unroll 2
    for (int i = 0; i < 16; ++i) { const int t = tq + 4096 + 256 * i; const float2 yo = cmul(X[t], twid((float)t * ts)); const float2 y2 = SCR2[tq + 256 * i]; X[t] = make_float2(y2.x + yo.x, y2.y + yo.y); }
    const int gc = (o + 1) * 384 + c;
    const float w0 = cw[gc], w1 = cw[1152 + gc], w2 = cw[2304 + gc], bb = cb[gc];
    const float bias = P.in[I_HBIAS][(layer * 2 + o) * 384 + c];
    const h16* pg0 = PH0 + (long)gc * SEQ; const h16* pg1 = PH1 + (long)gc * SEQ;
    h16* Y = reinterpret_cast<h16*>(P.ws + OFF_YHY);
{ tq = tid; asm volatile("" : "+v"(tq)); }
#pragma unroll 8
    for (int i = 0; i < 32; ++i) {
      const int t = tq + 256 * i;
      const float2 lc = X[t];
      const float2 zz = o == 0 ? make_float2(hy_dw(pv0, t, SEQ, vw0, vw1, vw2, vbb), hy_dw(pv1, t, SEQ, vw0, vw1, vw2, vbb)) : SCR[t];
      const float gx = hy_dw(pg0, t, SEQ, w0, w1, w2, bb), gy = hy_dw(pg1, t, SEQ, w0, w1, w2, bb);
      const float2 res = make_float2(gx * (lc.x + bias * zz.x), gy * (lc.y + bias * zz.y));
      if (o == 0) SCR[t] = res;
      else { Y[((long)(2 * pair) * SEQ + t) * 384 + c] = (h16)res.x; Y[((long)(2 * pair + 1) * SEQ + t) * 384 + c] = (h16)res.y; }
    }
    __syncthreads();
  }
}
DI void item_hyena_ctx(const Params& P, int layer, int task, char* smem) {
  float* su = reinterpret_cast<float*>(smem); float* sf = su + 256; float* sb = sf + 256;
  const int t = tidx(); const int b = task / 384, c = task % 384;
  const h16* PH = reinterpret_cast<const h16*>(P.ws + OFF_PHYC) + (long)b * 1152 * CTXL;
  const float* cw = P.in[I_HCW] + layer * 3 * 1152; const float* cb = P.in[I_HCB] + layer * 1152;
  float u = hy_dw(PH + (long)c * CTXL, t, CTXL, cw[c], cw[1152 + c], cw[2304 + c], cb[c]);
  for (int o = 0; o < 2; ++o) {
    const float* T = reinterpret_cast<const float*>(P.ws + OFF_TAPSC) + (long)(o * 384 + c) * 512;
    __syncthreads();
    su[t] = u; sf[t] = T[t]; sb[t] = T[256 + t];
    __syncthreads();
    float y = 0.f;
    for (int s = 0; s <= t; ++s) y += sf[t - s] * su[s];
    for (int s = t + 1; s < 256; ++s) y += sb[s - t] * su[s];
    const int gc = (o + 1) * 384 + c;
    const float gx = hy_dw(PH + (long)gc * CTXL, t, CTXL, cw[gc], cw[1152 + gc], cw[2304 + gc], cb[gc]);
    u = gx * (y + P.in[I_HBIAS][(layer * 2 + o) * 384 + c] * u);
  }
  reinterpret_cast<h16*>(P.ws + OFF_YHY)[((long)TLAT + b * CTXL + t) * 384 + c] = (h16)u;
  __syncthreads();
}

#ifndef PROBE_HY
#define PROBE_HY 0
#endif
#ifndef PROBE_S5
#define PROBE_S5 0
#endif
DI int first_item(int base) { const int g = (int)gridDim.x; return (((int)blockIdx.x - base) % g + g) % g; }
DI void phase_mix1(const Params& P, int layer, char* smem) {
  const int n_hy = 4 * 384, n_hyc = layer == 0 ? 8 * 384 : 0;
  const int n_kv = (TT / 128) * 8, n_q = (layer == 0 ? TT / 128 : TLAT / 128) * 8;
  const int n_s5 = (NBATCH * 2 * 24 * 132) / 4;
  const int g = gridDim.x;
#pragma unroll 1
  for (int rep = 0; rep < 1 + PROBE_HY; ++rep)
#pragma unroll 1
  for (int i = first_item(0); i < n_hy; i += g) item_hyena(P, layer, i, smem);
  asm volatile("" ::: "memory");
#pragma unroll 1
  for (int i = first_item(n_hy); i < n_kv; i += g) item_kv(P, layer, i, smem);
  asm volatile("" ::: "memory");
#pragma unroll 1
  for (int i = first_item(n_hy + n_kv); i < n_q; i += g) item_q(P, layer, i, smem);
  asm volatile("" ::: "memory");
#pragma unroll 1
  for (int rep = 0; rep < 1 + PROBE_S5; ++rep)
#pragma unroll 1
  for (int i = first_item(n_hy + n_kv + n_q); i < n_s5; i += g) { item_s5_pass1(P, layer, i * 4 + (tidx() >> 6), smem); __syncthreads(); }
  asm volatile("" ::: "memory");
#pragma unroll 1
  for (int i = first_item(n_hy + n_kv + n_q + n_s5); i < n_hyc; i += g) item_hyena_ctx(P, layer, i, smem);
}
DI int crow32(int r, int hi) { return (r & 3) + 8 * (r >> 2) + 4 * hi; }
DI void item_attn(const Params& P, int bh, int q0, int key_lo, int ntiles, char* smem) {
  const int tid = tidx(), lane = tid & 63, wid = tid >> 6, r32 = lane & 31, hi = lane >> 5;
  const h16* Qb = reinterpret_cast<const h16*>(P.ws + OFF_Q) + (long)bh * KEYS * 96;
  const h16* Kb = reinterpret_cast<const h16*>(P.ws + OFF_K) + (long)bh * KEYS * 96;
  const h16* Vt = reinterpret_cast<const h16*>(P.ws + OFF_VT) + (long)bh * 64 * KEYS;
  h16x8 qf[6];
  { const h16* qrow = Qb + (long)(q0 + wid * 32 + r32) * 96 + hi * 8;
#pragma unroll
    for (int ds = 0; ds < 6; ++ds) qf[ds] = *reinterpret_cast<const h16x8*>(qrow + ds * 16); }
  constexpr int KT_BYTES = 64 * 208, VT_BYTES = 64 * 136, BUF = KT_BYTES + VT_BYTES;
  uint4 kr[3]; uint4 vr[2];
  const int vdv0 = tid >> 3, vpart = tid & 7;
  auto gload = [&](int j) {
    const long key0 = key_lo + j * 64;
#pragma unroll
    for (int i = 0; i < 3; ++i) kr[i] = *reinterpret_cast<const uint4*>(Kb + key0 * 96 + (long)(tid + 256 * i) * 8);
#pragma unroll
    for (int i = 0; i < 2; ++i) vr[i] = *reinterpret_cast<const uint4*>(Vt + (long)(vdv0 + 32 * i) * KEYS + key0 + vpart * 8);
  };
  auto swrite = [&](int buf) {
    char* ks = smem + buf * BUF; char* vs = ks + KT_BYTES;
#pragma unroll
    for (int i = 0; i < 3; ++i) { const int c = tid + 256 * i; *reinterpret_cast<uint4*>(ks + (c / 12) * 208 + (c % 12) * 16) = kr[i]; }
#pragma unroll
    for (int i = 0; i < 2; ++i) { char* d = vs + (vdv0 + 32 * i) * 136 + vpart * 16;
      *reinterpret_cast<uint2*>(d) = make_uint2(vr[i].x, vr[i].y); *reinterpret_cast<uint2*>(d + 8) = make_uint2(vr[i].z, vr[i].w); }
  };
  f32x16 o0, o1;
#pragma unroll
  for (int r = 0; r < 16; ++r) { o0[r] = 0.f; o1[r] = 0.f; }
  float m_run = -1e30f, l_run = 0.f;
  gload(0); swrite(0); __syncthreads();
  for (int j = 0; j < ntiles; ++j) {
    if (j + 1 < ntiles) gload(j + 1);
    const char* ks = smem + (j & 1) * BUF; const char* vs = ks + KT_BYTES;
    f32x16 p0, p1;
#pragma unroll
    for (int r = 0; r < 16; ++r) { p0[r] = 0.f; p1[r] = 0.f; }
#pragma unroll
    for (int ds = 0; ds < 6; ++ds) {
      const h16x8 a0 = *reinterpret_cast<const h16x8*>(ks + r32 * 208 + (ds * 16 + hi * 8) * 2);
      const h16x8 a1 = *reinterpret_cast<const h16x8*>(ks + (32 + r32) * 208 + (ds * 16 + hi * 8) * 2);
      p0 = __builtin_amdgcn_mfma_f32_32x32x16_f16(a0, qf[ds], p0, 0, 0, 0);
      p1 = __builtin_amdgcn_mfma_f32_32x32x16_f16(a1, qf[ds], p1, 0, 0, 0);
    }
    float mx = p0[0];
#pragma unroll
    for (int r = 1; r < 16; ++r) mx = fmaxf(mx, p0[r]);
#pragma unroll
    for (int r = 0; r < 16; ++r) mx = fmaxf(mx, p1[r]);
    mx = fmaxf(mx, __shfl_xor(mx, 32));
    const float mnew = fmaxf(m_run, mx);
    const float alpha = __builtin_amdgcn_exp2f(m_run - mnew);
    m_run = mnew;
    float rsum = 0.f;
#pragma unroll
    for (int r = 0; r < 16; ++r) { p0[r] = __builtin_amdgcn_exp2f(p0[r] - mnew); rsum += p0[r]; }
#pragma unroll
    for (int r = 0; r < 16; ++r) { p1[r] = __builtin_amdgcn_exp2f(p1[r] - mnew); rsum += p1[r]; }
    l_run = l_run * alpha + rsum;
#pragma unroll
    for (int r = 0; r < 16; ++r) { o0[r] *= alpha; o1[r] *= alpha; }
#pragma unroll
    for (int kb = 0; kb < 2; ++kb)
#pragma unroll
      for (int s = 0; s < 2; ++s) {
        h16x8 pf;
#pragma unroll
        for (int e = 0; e < 8; ++e) pf[e] = (h16)(kb ? p1[8 * s + e] : p0[8 * s + e]);
        const int koff = (32 * kb + 16 * s + 4 * hi) * 2;
        {
          const h16x4 lo = *reinterpret_cast<const h16x4*>(vs + r32 * 136 + koff), hh = *reinterpret_cast<const h16x4*>(vs + r32 * 136 + koff + 16);
          const h16x8 af = __builtin_shufflevector(lo, hh, 0, 1, 2, 3, 4, 5, 6, 7);
          o0 = __builtin_amdgcn_mfma_f32_32x32x16_f16(af, pf, o0, 0, 0, 0);
        }
        {
          const h16x4 lo = *reinterpret_cast<const h16x4*>(vs + (32 + r32) * 136 + koff), hh = *reinterpret_cast<const h16x4*>(vs + (32 + r32) * 136 + koff + 16);
          const h16x8 af = __builtin_shufflevector(lo, hh, 0, 1, 2, 3, 4, 5, 6, 7);
          o1 = __builtin_amdgcn_mfma_f32_32x32x16_f16(af, pf, o1, 0, 0, 0);
        }
      }
    if (j + 1 < ntiles) swrite((j + 1) & 1);
    __syncthreads();
  }
  const float lt = l_run + __shfl_xor(l_run, 32);
  const float inv = 1.f / lt;
  const int b = bh >> 3, hd = bh & 7; const int q = q0 + wid * 32 + r32;
  const long tok = q < SEQ ? (long)b * SEQ + q : (long)TLAT + b * CTXL + (q - SEQ);
  h16* yr = reinterpret_cast<h16*>(P.ws + OFF_YMLA) + tok * 512 + hd * 64;
#pragma unroll
  for (int g = 0; g < 4; ++g) {
    h16x4 a, c;
#pragma unroll
    for (int e = 0; e < 4; ++e) { a[e] = (h16)(o0[4 * g + e] * inv); c[e] = (h16)(o1[4 * g + e] * inv); }
    *reinterpret_cast<h16x4*>(yr + 8 * g + 4 * hi) = a;
    *reinterpret_cast<h16x4*>(yr + 32 + 8 * g + 4 * hi) = c;
  }
}
DI void item_s5_pass3(const Params& P, int layer, int b, int g, int ck, char* smem) {
  const int lane = tidx() & 63, wid = tidx() >> 6, fr = lane & 15, fq = lane >> 4;
  float* us = reinterpret_cast<float*>(smem + wid * 12800); char* Hs = smem + wid * 12800 + 4096;
  const int tokbase = ck < 4 ? TLAT + b * CTXL + ck * 64 : b * SEQ + (ck - 4) * 64;
  s5_stage_u(reinterpret_cast<const h16*>(P.ws + OFF_U), tokbase, g, us);
  __syncthreads();
  f32x4 yacc[4];
#pragma unroll
  for (int i = 0; i < 4; ++i) yacc[i] = f32x4{0.f, 0.f, 0.f, 0.f};
#pragma unroll
  for (int dir = 0; dir < 2; ++dir) {
    const long gi = (long)(layer * 2 + dir) * 24 + g;
    const float2 a = reinterpret_cast<const float2*>(P.ws + OFF_S5A)[gi * 64 + lane];
    const float2 a64 = reinterpret_cast<const float2*>(P.ws + OFF_S5A64)[gi * 64 + lane];
    const float2* Bb = reinterpret_cast<const float2*>(P.ws + OFF_S5B) + (gi * 64 + lane) * 16;
    float bre[16], bim[16];
#pragma unroll
    for (int c = 0; c < 16; ++c) { const float2 v = Bb[c]; bre[c] = v.x; bim[c] = v.y; }
    const int si = ck < 4 ? (dir ? 3 - ck : ck) : 4 + (dir ? 127 - (ck - 4) : ck - 4);
    const float2* Ep = reinterpret_cast<const float2*>(P.ws + OFF_E) + ((long)((b * 2 + dir) * 24 + g) * 132) * 64 + lane;
    float hr = 0.f, hi = 0.f;
#pragma unroll 16
    for (int i = 0; i < si; ++i) { const float2 e = Ep[(long)i * 64]; const float nr = a64.x * hr - a64.y * hi + e.x, ni = a64.x * hi + a64.y * hr + e.y; hr = nr; hi = ni; }
    const h16* Ct = reinterpret_cast<const h16*>(P.ws + OFF_S5C) + gi * 16 * 128 + fr * 128 + fq * 8;
    h16x8 cf[4];
#pragma unroll
    for (int ks = 0; ks < 4; ++ks) cf[ks] = *reinterpret_cast<const h16x8*>(Ct + ks * 32);
#pragma unroll
    for (int half = 0; half < 2; ++half) {
#pragma unroll 4
      for (int s = 0; s < 32; ++s) {
        const int step = half * 32 + s; const int tau = dir ? 63 - step : step;
        const float4* up = reinterpret_cast<const float4*>(us + tau * 16);
        float br = 0.f, bi = 0.f;
#pragma unroll
        for (int q = 0; q < 4; ++q) { const float4 u = up[q];
          br += bre[q * 4] * u.x + bre[q * 4 + 1] * u.y + bre[q * 4 + 2] * u.z + bre[q * 4 + 3] * u.w;
          bi += bim[q * 4] * u.x + bim[q * 4 + 1] * u.y + bim[q * 4 + 2] * u.z + bim[q * 4 + 3] * u.w; }
        const float nr = a.x * hr - a.y * hi + br, ni = a.x * hi + a.y * hr + bi; hr = nr; hi = ni;
        h16* hrow = reinterpret_cast<h16*>(Hs + (tau & 31) * 272);
        hrow[lane] = (h16)hr; hrow[64 + lane] = (h16)hi;
      }
      __syncthreads();
      const int tb = dir ? 1 - half : half;
#pragma unroll
      for (int sb2 = 0; sb2 < 2; ++sb2)
#pragma unroll
        for (int ks = 0; ks < 4; ++ks) {
          const h16x8 bf = *reinterpret_cast<const h16x8*>(Hs + (sb2 * 16 + fr) * 272 + (ks * 32 + fq * 8) * 2);
          yacc[tb * 2 + sb2] = __builtin_amdgcn_mfma_f32_16x16x32_f16(cf[ks], bf, yacc[tb * 2 + sb2], 0, 0, 0);
        }
      __syncthreads();
    }
  }
  const float* dsk = P.in[I_S5D] + layer * 384 + g * 16 + fq * 4;
  h16* Y = reinterpret_cast<h16*>(P.ws + OFF_YS5PRE);
#pragma unroll
  for (int sbi = 0; sbi < 4; ++sbi) {
    const int tl = sbi * 16 + fr; h16x4 o;
#pragma unroll
    for (int j = 0; j < 4; ++j) o[j] = (h16)geluf_(yacc[sbi][j] + dsk[j] * us[tl * 16 + fq * 4 + j]);
    *reinterpret_cast<h16x4*>(Y + (long)(tokbase + tl) * 384 + g * 16 + fq * 4) = o;
  }
  __syncthreads();
}
DI void phase_mix2(const Params& P, int layer, char* smem) {
  if ((gridDim.x & 7) == 0) {
    const int xcd = blockIdx.x & 7, li = blockIdx.x >> 3, nloc = gridDim.x >> 3;
    for (int k = li; k < 512; k += nloc) item_attn(P, xcd + 8 * (k >> 6), (k & 63) * 128, 0, KEYS / 64, smem);
  } else {
    for (int k = blockIdx.x; k < 4096; k += gridDim.x) item_attn(P, k >> 6, (k & 63) * 128, 0, KEYS / 64, smem);
  }
  const int n_actx = layer == 0 ? 128 : 0;
  const int nck = layer == 0 ? 132 : 128;
  const int n_s5 = NBATCH * 24 * nck / 4;
  for (int it = blockIdx.x; it < n_actx + n_s5; it += gridDim.x) {
    if (it < n_actx) { item_attn(P, it >> 1, SEQ + (it & 1) * 128, SEQ, CTXL / 64, smem); continue; }
    const int w = (it - n_actx) * 4 + (tidx() >> 6);
    const int ck = w % nck + (layer == 0 ? 0 : 4); const int r = w / nck;
    item_s5_pass3(P, layer, r / 24, r % 24, ck, smem);
  }
}
DI void phase_glu(const Params& P, int layer, char* smem) {
  const int tid = tidx(), lane = tid & 63, wid = tid >> 6, wr = wid >> 1, wc = wid & 1, fr = lane & 15, fq = lane >> 4;
  const h16* A = reinterpret_cast<const h16*>(P.ws + OFF_YS5PRE);
  const h16* W = reinterpret_cast<const h16*>(P.ws + OFF_WT) + (long)layer * WT_LAYER + WT_GLU;
  h16* Y = reinterpret_cast<h16*>(P.ws + OFF_YS5);
  const int MT = (layer == 0 ? TT : TLAT) / 128;
  const TileWalk tw = tw_init(MT, 6);
  for (int tile = tw.lb; tile < tw_count(tw); tile += tw.nlb) {
    int mt, nt; tw_decode(tw, tile, mt, nt);
    f32x4 acc[4][4]; acc_zero(acc);
    gemm_kloop(acc, A + (long)mt * 128 * 384, 384, 0, 128, W + (long)nt * 128 * 384, 384, 384, smem, opaque_tid());
#pragma unroll
    for (int m = 0; m < 4; ++m)
#pragma unroll
      for (int np = 0; np < 2; ++np)
#pragma unroll
        for (int j = 0; j < 4; ++j) {
          const int row = mt * 128 + wr * 64 + m * 16 + fq * 4 + j, col = nt * 64 + wc * 32 + np * 16 + fr;
          Y[(long)row * 384 + col] = (h16)(acc[m][2 * np][j] * sigmoidf_(acc[m][2 * np + 1][j]));
        }
  }
}
DI void phase_merge(const Params& P, int layer, char* smem) {
  const h16* H = reinterpret_cast<const h16*>(P.ws + OFF_H1);
  const h16* WL = reinterpret_cast<const h16*>(P.ws + OFF_WT) + (long)layer * WT_LAYER;
  h16* Mg = reinterpret_cast<h16*>(P.ws + OFF_MERGED);
  const int MT = (layer == 0 ? TT : TLAT) / 128;
  const TileWalk tw = tw_init(MT, 8);
  for (int tile = tw.lb; tile < tw_count(tw); tile += tw.nlb) {
    int mt, nt; tw_decode(tw, tile, mt, nt);
    h16* Tmp = reinterpret_cast<h16*>(P.ws + OFF_YS5PRE) + (long)blockIdx.x * 16384;
#pragma unroll 1
    for (int br = 0; br < 3; ++br) {
      const h16* Ab; const h16* Wb; int Kb;
      if (br == 0) { Ab = reinterpret_cast<const h16*>(P.ws + OFF_YHY) + (long)mt * 128 * 384; Wb = WL + WT_BRHY + (long)nt * 128 * 384; Kb = 384; }
      else if (br == 1) { Ab = reinterpret_cast<const h16*>(P.ws + OFF_YS5) + (long)mt * 128 * 384; Wb = WL + WT_BRS5 + (long)nt * 128 * 384; Kb = 384; }
      else { Ab = reinterpret_cast<const h16*>(P.ws + OFF_YMLA) + (long)mt * 128 * 512; Wb = WL + WT_BRMLA + (long)nt * 128 * 512; Kb = 512; }
      {
        f32x4 acc[4][4]; acc_zero(acc);
        gemm_kloop(acc, Ab, Kb, 0, 128, Wb, Kb, Kb, smem, opaque_tid());
        const int tid = tidx();
#pragma unroll
        for (int m = 0; m < 4; ++m)
#pragma unroll
          for (int n = 0; n < 4; ++n) {
            h16x4 o; o[0] = (h16)acc[m][n][0]; o[1] = (h16)acc[m][n][1]; o[2] = (h16)acc[m][n][2]; o[3] = (h16)acc[m][n][3];
            *reinterpret_cast<h16x4*>(Tmp + ((m * 4 + n) * 256 + tid) * 4) = o;
          }
      }
      f32x4 acc[4][4]; acc_zero(acc);
      gemm_kloop(acc, H + (long)mt * 128 * 1024, 1024, 0, 128, WL + WT_WGATE + (long)(br * 1024 + nt * 128) * 1024, 1024, 1024, smem, opaque_tid());
      const int tid = tidx(), lane = tid & 63, wid = tid >> 6, wr = wid >> 1, wc = wid & 1, fr = lane & 15, fq = lane >> 4;
#pragma unroll
      for (int m = 0; m < 4; ++m)
#pragma unroll
        for (int n = 0; n < 4; ++n) {
          const h16x4 bv = *reinterpret_cast<const h16x4*>(Tmp + ((m * 4 + n) * 256 + tid) * 4);
#pragma unroll
          for (int j = 0; j < 4; ++j) {
            h16* dst = Mg + (long)(mt * 128 + wr * 64 + m * 16 + fq * 4 + j) * 1024 + nt * 128 + wc * 64 + n * 16 + fr;
            const float prev = br == 0 ? 0.f : (float)*dst;
            *dst = (h16)(prev + sigmoidf_(acc[m][n][j]) * (float)bv[j]);
          }
          __builtin_amdgcn_sched_barrier(0);
        }
    }
  }
}
DI void phase_resid(const Params& P, int layer, int stage_src, size_t a_off, int K, long w_off, int gate_idx, char* smem) {
  const int tid = tidx(), lane = tid & 63, wid = tid >> 6, wr = wid >> 1, wc = wid & 1, fr = lane & 15, fq = lane >> 4;
  const h16* A = reinterpret_cast<const h16*>(P.ws + a_off);
  const h16* W = reinterpret_cast<const h16*>(P.ws + OFF_WT) + (long)layer * WT_LAYER + w_off;
  const float* mod = reinterpret_cast<const float*>(P.ws + OFF_MOD) + (long)layer * 9 * 6144 + gate_idx * 1024;
  const int MT = (layer == 0 ? TT : TLAT) / 128;
  const TileWalk tw = tw_init(MT, 8);
  for (int tile = tw.lb; tile < tw_count(tw); tile += tw.nlb) {
    int mt, nt; tw_decode(tw, tile, mt, nt);
    f32x4 acc[4][4]; acc_zero(acc);
    gemm_kloop(acc, A + (long)mt * 128 * K, K, 0, 128, W + (long)nt * 128 * K, K, K, smem, opaque_tid());
    const Tok tk = tokinfo(mt * 128);
    const float* gp = mod + tk.mrow * 6144 + nt * 128 + wc * 64 + fr;
#pragma unroll
    for (int m = 0; m < 4; ++m)
#pragma unroll
      for (int j = 0; j < 4; ++j) {
        const int t = mt * 128 + wr * 64 + m * 16 + fq * 4 + j;
        const float* xs = xrow_src(P, stage_src, t) + nt * 128 + wc * 64 + fr; float* xd = xrow_dst(P, t) + nt * 128 + wc * 64 + fr;
#pragma unroll
        for (int n = 0; n < 4; ++n) xd[n * 16] = xs[n * 16] + gp[n * 16] * acc[m][n][j];
      }
  }
}
DI void phase_ffn_up(const Params& P, int layer, char* smem) {
  const int tid = tidx(), lane = tid & 63, wid = tid >> 6, wr = wid >> 1, wc = wid & 1, fr = lane & 15, fq = lane >> 4;
  const h16* H = reinterpret_cast<const h16*>(P.ws + OFF_H2);
  const h16* W = reinterpret_cast<const h16*>(P.ws + OFF_WT) + (long)layer * WT_LAYER + WT_UP;
  h16* F = reinterpret_cast<h16*>(P.ws + OFF_F);
  const float* cw = P.in[I_FCW] + (long)layer * 3 * 5632; const float* cb = P.in[I_FCB] + (long)layer * 5632;
  float* Zs = reinterpret_cast<float*>(smem);
  const int n_mt = 8 * 66 + (layer == 0 ? 8 * 3 : 0);
  const TileWalk tw = tw_init(n_mt, 44);
  for (int tile = tw.lb; tile < tw_count(tw); tile += tw.nlb) {
    int mi, nt; tw_decode(tw, tile, mi, nt);
    int seq0, Ls, ti;
    if (mi < 528) { seq0 = (mi / 66) * SEQ; Ls = SEQ; ti = mi % 66; } else { const int u = mi - 528; seq0 = TLAT + (u / 3) * CTXL; Ls = CTXL; ti = u % 3; }
    const int p0 = ti * 126 - 1;
    const int a_lo = ti == 0 ? 1 : 0, a_hi = min(128, Ls - p0);
    const int nout = min(126, Ls - ti * 126);
    f32x4 acc[4][4]; acc_zero(acc);
    gemm_kloop(acc, H + ((long)seq0 + p0) * 1024, 1024, a_lo, a_hi, W + (long)nt * 128 * 1024, 1024, 1024, smem, opaque_tid());
#pragma unroll
    for (int m = 0; m < 4; ++m)
#pragma unroll
      for (int n = 0; n < 4; ++n)
#pragma unroll
        for (int j = 0; j < 4; ++j) Zs[(wr * 64 + m * 16 + fq * 4 + j) * 132 + wc * 64 + n * 16 + fr] = acc[m][n][j];
    __syncthreads();
    {
      const int jc = tid & 63, rg = tid >> 6;
      const int ucol = (jc >> 5) * 64 + ((jc >> 4) & 1) * 32 + (jc & 15), gcol = ucol + 16;
      const int cu = nt * 64 + jc, cg = 2816 + cu;
      const float wu0 = cw[cu], wu1 = cw[5632 + cu], wu2 = cw[2 * 5632 + cu], bu = cb[cu];
      const float wg0 = cw[cg], wg1 = cw[5632 + cg], wg2 = cw[2 * 5632 + cg], bg = cb[cg];
      for (int r = 1 + rg; r <= nout; r += 4) {
        const float au = wu0 * Zs[(r - 1) * 132 + ucol] + wu1 * Zs[r * 132 + ucol] + wu2 * Zs[(r + 1) * 132 + ucol] + bu;
        const float ag = wg0 * Zs[(r - 1) * 132 + gcol] + wg1 * Zs[r * 132 + gcol] + wg2 * Zs[(r + 1) * 132 + gcol] + bg;
        F[((long)seq0 + p0 + r) * 2816 + cu] = (h16)(siluf_(au) * ag);
      }
    }
    __syncthreads();
  }
}
DI void phase_norm2(const Params& P, int layer) { normmod_rows(P, layer, 1, 1, layer == 0 ? TT : TLAT, blockIdx.x, gridDim.x); }

constexpr int N_PHASES = 22;
#ifndef PROBE_REPEAT
#define PROBE_REPEAT 0u
#endif
template <int PH> DI void run_phase_t(const Params& P, char* smem) {
  asm volatile("" ::: "memory");
  if constexpr (PH == 0) phase_prologue(P, smem);
  else if constexpr (PH == 21) phase_final(P);
  else {
    constexpr int layer = (PH - 1) / 10, s = (PH - 1) % 10;
    if constexpr (s == 0) phase_norm1(P, layer, smem);
    else if constexpr (s == 1) phase_gemm_in(P, layer, smem);
    else if constexpr (s == 2) phase_mix1(P, layer, smem);
    else if constexpr (s == 3) phase_mix2(P, layer, smem);
    else if constexpr (s == 4) phase_glu(P, layer, smem);
    else if constexpr (s == 5) phase_merge(P, layer, smem);
    else if constexpr (s == 6) phase_resid(P, layer, layer, OFF_MERGED, 1024, WT_WO, 2, smem);
    else if constexpr (s == 7) phase_norm2(P, layer);
    else if constexpr (s == 8) phase_ffn_up(P, layer, smem);
    else phase_resid(P, layer, 1, OFF_F, 2816, WT_DOWN, 5, smem);
  }
}
DI void run_phase(const Params& P, int ph, char* smem) {
  switch (ph) {
#define RP(i) case i: run_phase_t<i>(P, smem); break;
    RP(0) RP(1) RP(2) RP(3) RP(4) RP(5) RP(6) RP(7) RP(8) RP(9) RP(10) RP(11) RP(12) RP(13) RP(14) RP(15) RP(16) RP(17) RP(18) RP(19) RP(20) RP(21)
#undef RP
    default: break;
  }
}
#ifndef MULTI_LAUNCH
#define MULTI_LAUNCH 0
#endif
__global__ void __launch_bounds__(NTHREADS, 2) fwd_megakernel(Params P) {
  extern __shared__ __attribute__((aligned(16))) char smem[];
  cg::grid_group grid = cg::this_grid();
#define RP(i) run_phase_t<i>(P, smem); grid.sync(); if constexpr ((PROBE_REPEAT >> i) & 1) { run_phase_t<i>(P, smem); grid.sync(); }
  RP(0) RP(1) RP(2) RP(3) RP(4) RP(5) RP(6) RP(7) RP(8) RP(9) RP(10) RP(11) RP(12) RP(13) RP(14) RP(15) RP(16) RP(17) RP(18) RP(19) RP(20)
#undef RP
  run_phase_t<21>(P, smem);
}
#if MULTI_LAUNCH
__global__ void __launch_bounds__(NTHREADS, 2) fwd_phase_kernel(Params P, int ph) {
  extern __shared__ __attribute__((aligned(16))) char smem[];
  run_phase(P, ph, smem);
}
#endif

extern "C" void kernel_launch(void* const* d_in, const int* in_sizes, int n_in, void* d_out, int out_size, void* d_ws, size_t ws_size,
                              hipStream_t stream) {
  static int grid_blocks = 0;
  if (!grid_blocks) {
    int dev = 0, cus = 0, per_cu = 0;
    (void)hipGetDevice(&dev);
    (void)hipDeviceGetAttribute(&cus, hipDeviceAttributeMultiprocessorCount, dev);
    (void)hipFuncSetAttribute((const void*)fwd_megakernel, hipFuncAttributeMaxDynamicSharedMemorySize, SMEM_BYTES);
#if MULTI_LAUNCH
    (void)hipFuncSetAttribute((const void*)fwd_phase_kernel, hipFuncAttributeMaxDynamicSharedMemorySize, SMEM_BYTES);
#endif
    (void)hipOccupancyMaxActiveBlocksPerMultiprocessor(&per_cu, fwd_megakernel, NTHREADS, SMEM_BYTES);
    if (per_cu > 2) per_cu = 2;
    if (per_cu < 1) per_cu = 1;
    grid_blocks = cus * per_cu;
    if (ws_size < OFF_END) fprintf(stderr, "workspace too small: %zu < %zu\n", ws_size, (size_t)OFF_END);
  }
  Params p{};
  for (int i = 0; i < 41; ++i) p.in[i] = (const float*)d_in[i];
  p.out = (float*)d_out; p.ws = (char*)d_ws; p.pad_ = 0;
#if MULTI_LAUNCH
  for (int ph = 0; ph < N_PHASES; ++ph) hipLaunchKernelGGL(fwd_phase_kernel, dim3(grid_blocks), dim3(NTHREADS), SMEM_BYTES, stream, p, ph);
#else
  void* args[] = {&p};
  hipError_t e = hipLaunchCooperativeKernel((void*)fwd_megakernel, dim3(grid_blocks), dim3(NTHREADS), args, SMEM_BYTES, stream);
  if (e != hipSuccess) fprintf(stderr, "cooperative launch failed: %s (grid %d)\n", hipGetErrorString(e), grid_blocks);
#endif
}
```

```cpp
#include <hip/hip_runtime.h>
#include <hip/hip_cooperative_groups.h>
#include <cstdio>
namespace cg = cooperative_groups;

typedef _Float16 h16;
typedef _Float16 h16x8 __attribute__((ext_vector_type(8)));
typedef _Float16 h16x4 __attribute__((ext_vector_type(4)));
typedef float f32x4 __attribute__((ext_vector_type(4)));
typedef float f32x16 __attribute__((ext_vector_type(16)));
#define DI __device__ __forceinline__

constexpr int DM = 1024, NBATCH = 8, SEQ = 8192, CTXL = 256, TLAT = 65536, TCTX = 2048, TT = 67584;
constexpr int KEYS = SEQ + CTXL;
constexpr int NTHREADS = 256;
constexpr float EPS = 1e-6f;
constexpr float QSCALE = 0.10206207261596575f * 1.4426950408889634f;

constexpr int LD1 = 1088, LD2 = 2880;
constexpr long WT_WIN = 0, WT_WGATE = WT_WIN + 2432L * LD1, WT_UKV = WT_WGATE + 3072L * LD1, WT_UQ = WT_UKV + 1024L * 256,
               WT_GLU = WT_UQ + 1024L * 512, WT_BRHY = WT_GLU + 768L * 384, WT_BRS5 = WT_BRHY + 1024L * 384,
               WT_BRMLA = WT_BRS5 + 1024L * 384, WT_WO = WT_BRMLA + 1024L * 512, WT_UP = WT_WO + 1024L * LD1,
               WT_DOWN = WT_UP + 5632L * LD1, WT_LAYER = WT_DOWN + 1024L * LD2;
constexpr size_t al256(size_t x) { return (x + 255) / 256 * 256; }
constexpr size_t OFF_WT = 0;
constexpr size_t OFF_H1 = al256(OFF_WT + 2 * WT_LAYER * 2);
constexpr size_t OFF_U = al256(OFF_H1 + (size_t)TT * LD1 * 2);
constexpr size_t OFF_KVLAT = al256(OFF_U + (size_t)TT * 384 * 2);
constexpr size_t OFF_QLAT = al256(OFF_KVLAT + (size_t)TT * 256 * 2);
constexpr size_t OFF_PHY = al256(OFF_QLAT + (size_t)TT * 512 * 2);
constexpr size_t OFF_PHYC = al256(OFF_PHY + (size_t)NBATCH * 1152 * SEQ * 2);
constexpr size_t OFF_Q = al256(OFF_PHYC + (size_t)NBATCH * 1152 * CTXL * 2);
constexpr size_t OFF_K = al256(OFF_Q + (size_t)64 * KEYS * 96 * 2);
constexpr size_t OFF_VT = al256(OFF_K + (size_t)64 * KEYS * 96 * 2);
constexpr size_t OFF_YS5PRE = al256(OFF_VT + (size_t)64 * 64 * KEYS * 2);
constexpr size_t OFF_YHY = al256(OFF_YS5PRE + (size_t)TT * 384 * 2);
constexpr size_t OFF_FILT = al256(OFF_YHY + (size_t)TT * 384 * 2);
constexpr size_t OFF_TAPSC = al256(OFF_FILT + (size_t)768 * 2 * SEQ * 8);
constexpr size_t OFF_E = al256(OFF_TAPSC + (size_t)768 * 2 * CTXL * 4);
constexpr size_t OFF_XC = al256(OFF_E + (size_t)NBATCH * 2 * 24 * 132 * 64 * 8);
constexpr size_t OFF_MOD = al256(OFF_XC + (size_t)TCTX * 1024 * 4);
constexpr size_t OFF_Z2 = al256(OFF_MOD + (size_t)2 * 9 * 6144 * 4);
constexpr size_t OFF_Z2C = al256(OFF_Z2 + (size_t)2 * SEQ * 64 * 4);
constexpr size_t OFF_S5A = al256(OFF_Z2C + (size_t)2 * CTXL * 64 * 4);
constexpr size_t OFF_S5A64 = al256(OFF_S5A + (size_t)2 * 2 * 24 * 64 * 8);
constexpr size_t OFF_S5B = al256(OFF_S5A64 + (size_t)2 * 2 * 24 * 64 * 8);
constexpr size_t OFF_S5C = al256(OFF_S5B + (size_t)2 * 2 * 24 * 64 * 16 * 8);
constexpr size_t OFF_ROPE = al256(OFF_S5C + (size_t)2 * 2 * 24 * 16 * 128 * 2);
constexpr size_t OFF_END = al256(OFF_ROPE + (size_t)SEQ * 16 * 8);
constexpr size_t OFF_YS5 = OFF_U, OFF_YMLA = OFF_QLAT, OFF_MERGED = OFF_Q, OFF_F = OFF_U, OFF_H2 = OFF_H1;
static_assert(OFF_END <= (size_t)1024 * 1024 * 1024, "workspace over 1 GiB");
static_assert(OFF_F + (size_t)TT * LD2 * 2 <= OFF_FILT, "f alias overruns");
static_assert(OFF_MERGED + (size_t)TT * LD1 * 2 <= OFF_VT, "merged alias overruns");

constexpr int SMEM_BYTES = 73728 + 2048;

struct Params {
  const float* in[41];
  float* out;
  char* ws;
  unsigned long long pad_;
};
enum { I_X = 0, I_C, I_CTX, I_CCTX, I_WMOD, I_BMOD, I_N1G, I_N2G, I_WIN, I_HCW, I_HCB, I_FW1, I_FB1, I_FW2, I_FB2, I_FW3, I_FFREQ,
       I_FDECAY, I_HBIAS, I_LAMRE, I_LAMIM, I_LOGSTEP, I_BRE, I_BIM, I_CRE, I_CIM, I_S5D, I_WGLU, I_GQ, I_WUQ, I_GKV, I_WUKV,
       I_WBRHY, I_WBRS5, I_WBRMLA, I_WO, I_WUP, I_FCW, I_FCB, I_WDOWN, I_FINALG };

DI int tidx() { int t = threadIdx.x; asm volatile("" : "+v"(t)); return t; }
DI int opaque_tid() { return tidx(); }
DI float sigmoidf_(float x) { return 1.f / (1.f + __expf(-x)); }
DI float siluf_(float x) { return x / (1.f + __expf(-x)); }
DI float geluf_(float x) { float z = 0.7978845608028654f * (x + 0.044715f * x * x * x); float t = 1.f - 2.f / (1.f + __expf(2.f * z)); return 0.5f * x * (1.f + t); }
DI float wave_sum(float v) { for (int o = 32; o > 0; o >>= 1) v += __shfl_xor(v, o); return v; }
DI float wave_max(float v) { for (int o = 32; o > 0; o >>= 1) v = fmaxf(v, __shfl_xor(v, o)); return v; }
DI void dsincos(double x, double& s, double& c) {
  const double TWO_PI = 6.283185307179586476925287;
  double r = x - TWO_PI * rint(x / TWO_PI);
  double r2 = r * r, ts = r, tc = 1.0; s = r; c = 1.0;
  for (int k = 1; k <= 15; ++k) { tc = -tc * r2 / (double)((2 * k - 1) * (2 * k)); c += tc; ts = -ts * r2 / (double)((2 * k) * (2 * k + 1)); s += ts; }
}
DI float2 twid(float f) { return make_float2(__builtin_amdgcn_cosf(f), __builtin_amdgcn_sinf(f)); }
DI float2 cmul(float2 a, float2 b) { return make_float2(a.x * b.x - a.y * b.y, a.x * b.y + a.y * b.x); }

struct Tok { int b, pos, ctx, mrow; };
DI Tok tokinfo(int t) { Tok k; if (t < TLAT) { k.b = t >> 13; k.pos = t & 8191; k.ctx = 0; k.mrow = k.b; } else { int u = t - TLAT; k.b = u >> 8; k.pos = u & 255; k.ctx = 1; k.mrow = 8; } return k; }

struct Stg { uint4 a0, a1, a2, a3, b0, b1, b2, b3; };
DI void g_load(Stg& s, const h16* __restrict__ A0, const h16* __restrict__ A1, const h16* __restrict__ A2, const h16* __restrict__ A3,
               const h16* __restrict__ Bp, long b32, int k0) {
  s.a0 = *reinterpret_cast<const uint4*>(A0 + k0); s.a1 = *reinterpret_cast<const uint4*>(A1 + k0);
  s.a2 = *reinterpret_cast<const uint4*>(A2 + k0); s.a3 = *reinterpret_cast<const uint4*>(A3 + k0);
  s.b0 = *reinterpret_cast<const uint4*>(Bp + k0); s.b1 = *reinterpret_cast<const uint4*>(Bp + b32 + k0);
  s.b2 = *reinterpret_cast<const uint4*>(Bp + 2 * b32 + k0); s.b3 = *reinterpret_cast<const uint4*>(Bp + 3 * b32 + k0);
}
DI uint4 zsel(uint4 v, bool ok) { return ok ? v : make_uint4(0, 0, 0, 0); }
DI void s_write(char* sw, const Stg& s, int okm) {
  *reinterpret_cast<uint4*>(sw) = zsel(s.a0, okm & 1); *reinterpret_cast<uint4*>(sw + 32 * 128) = zsel(s.a1, okm & 2);
  *reinterpret_cast<uint4*>(sw + 64 * 128) = zsel(s.a2, okm & 4); *reinterpret_cast<uint4*>(sw + 96 * 128) = zsel(s.a3, okm & 8);
  *reinterpret_cast<uint4*>(sw + 16384) = s.b0; *reinterpret_cast<uint4*>(sw + 16384 + 32 * 128) = s.b1; *reinterpret_cast<uint4*>(sw + 16384 + 64 * 128) = s.b2; *reinterpret_cast<uint4*>(sw + 16384 + 96 * 128) = s.b3;
}
#ifndef PROBE_MFMA
#define PROBE_MFMA 0
#endif
#if PROBE_MFMA
DI void mma_step(f32x4 (&acc)[4][4], const char* sa, const char* sb, int o0, int o1, f32x4 (&dmy)[2][4]) {
#else
DI void mma_step(f32x4 (&acc)[4][4], const char* sa, const char* sb, int o0, int o1) {
#endif
#pragma unroll
  for (int ks = 0; ks < 2; ++ks) {
    h16x8 af[4], bf[4];
    const int o = ks ? o1 : o0;
#pragma unroll
    for (int m = 0; m < 4; ++m) af[m] = *reinterpret_cast<const h16x8*>(sa + m * 16 * 128 + o);
#pragma unroll
    for (int n = 0; n < 4; ++n) bf[n] = *reinterpret_cast<const h16x8*>(sb + n * 16 * 128 + o);
#pragma unroll
    for (int m = 0; m < 4; ++m)
#pragma unroll
      for (int n = 0; n < 4; ++n) acc[m][n] = __builtin_amdgcn_mfma_f32_16x16x32_f16(af[m], bf[n], acc[m][n], 0, 0, 0);
#if PROBE_MFMA
#pragma unroll
    for (int m = 0; m < 2; ++m)
#pragma unroll
      for (int n = 0; n < 4; ++n) dmy[m][n] = __builtin_amdgcn_mfma_f32_16x16x32_f16(af[m + 2], bf[n], dmy[m][n], 0, 0, 0);
#endif
  }
}
DI void gemm_kloop(f32x4 (&acc)[4][4], const h16* __restrict__ A, long lda, int a_lo, int a_hi,
                   const h16* __restrict__ Bt, long ldb, int K, char* smem, int tid) {
  const int lane = tid & 63, wid = tid >> 6, wr = wid >> 1, wc = wid & 1, fr = lane & 15, fq = lane >> 4;
#if PROBE_MFMA
  f32x4 dmy[2][4];
  for (int m = 0; m < 2; ++m) for (int n = 0; n < 4; ++n) dmy[m][n] = f32x4{0.f, 0.f, 0.f, 0.f};
#define MMA(a, b, c, d, e) mma_step(a, b, c, d, e, dmy)
#else
#define MMA(a, b, c, d, e) mma_step(a, b, c, d, e)
#endif
  Stg s0, s1;
  const int srow = tid >> 3, skc = tid & 7;
  int okm = 0;
  const h16* Ar[4];
#pragma unroll
  for (int i = 0; i < 4; ++i) { const int row = srow + 32 * i; const bool ok = row >= a_lo && row < a_hi; okm |= ok ? (1 << i) : 0;
    const int rc = min(max(row, a_lo), a_hi - 1); Ar[i] = A + (long)rc * lda + skc * 8; }
  const h16* Bp = Bt + (long)srow * ldb + skc * 8;
  const long b32 = 32 * ldb;
  char* sw = smem + srow * 128 + ((skc ^ ((srow >> 1) & 7)) << 4);
  const char* sra = smem + (wr * 64 + fr) * 128; const char* srb = smem + 16384 + (wc * 64 + fr) * 128;
  const int o0 = (fq ^ ((fr >> 1) & 7)) << 4, o1 = ((4 + fq) ^ ((fr >> 1) & 7)) << 4;
  const int nk = K >> 6;
  g_load(s0, Ar[0], Ar[1], Ar[2], Ar[3], Bp, b32, 0); g_load(s1, Ar[0], Ar[1], Ar[2], Ar[3], Bp, b32, 64);
  s_write(sw, s0, okm); __syncthreads();
  for (int kt = 0; kt + 2 < nk; kt += 2) {
    g_load(s0, Ar[0], Ar[1], Ar[2], Ar[3], Bp, b32, (kt + 2) << 6);
    __builtin_amdgcn_sched_barrier(0);
    MMA(acc, sra, srb, o0, o1);
    __builtin_amdgcn_sched_barrier(0);
    s_write(sw + 32768, s1, okm);
    __syncthreads();
    g_load(s1, Ar[0], Ar[1], Ar[2], Ar[3], Bp, b32, (kt + 3) << 6);
    __builtin_amdgcn_sched_barrier(0);
    MMA(acc, sra + 32768, srb + 32768, o0, o1);
    __builtin_amdgcn_sched_barrier(0);
    s_write(sw, s0, okm);
    __syncthreads();
  }
  MMA(acc, sra, srb, o0, o1);
  s_write(sw + 32768, s1, okm);
  __syncthreads();
  MMA(acc, sra + 32768, srb + 32768, o0, o1);
  __syncthreads();
#if PROBE_MFMA
  { float z = 0.f; asm volatile("" : "+v"(z)); for (int m = 0; m < 2; ++m) for (int n = 0; n < 4; ++n) acc[m][n] += dmy[m][n] * z; }
#endif
#undef MMA
}
struct TileWalk { int lb, nlb, m0, Mx, NT, nfull; };
DI TileWalk tw_init(int MT, int NT) { TileWalk w; w.lb = blockIdx.x >> 3; w.nlb = gridDim.x >> 3; w.Mx = MT >> 3; w.m0 = (blockIdx.x & 7) * w.Mx; w.NT = NT; w.nfull = (w.Mx >> 3) * 8 * NT; return w; }
DI int tw_count(const TileWalk& w) { return w.Mx * w.NT; }
DI void tw_decode(const TileWalk& w, int idx, int& mt, int& nt) {
  if (idx < w.nfull) { const int mg = idx / (8 * w.NT), r = idx % (8 * w.NT); nt = r >> 3; mt = w.m0 + mg * 8 + (r & 7); }
  else { const int rem = w.Mx & 7, r = idx - w.nfull; nt = r / rem; mt = w.m0 + (w.Mx & ~7) + r % rem; }
}
DI void stage_acc(const f32x4 (&acc)[4][4], float* Zs, int tid) {
  const int lane = tid & 63, wid = tid >> 6, wr = wid >> 1, wc = wid & 1, fr = lane & 15, fq = lane >> 4;
#pragma unroll
  for (int m = 0; m < 4; ++m)
#pragma unroll
    for (int n = 0; n < 4; ++n)
#pragma unroll
      for (int j = 0; j < 4; ++j) Zs[(wr * 64 + m * 16 + fq * 4 + j) * 132 + wc * 64 + n * 16 + fr] = acc[m][n][j];
  __syncthreads();
}
DI void stage_acc_t(const f32x4 (&acc)[4][4], float* Zs, int tid) {
  const int lane = tid & 63, wid = tid >> 6, wr = wid >> 1, wc = wid & 1, fr = lane & 15, fq = lane >> 4;
#pragma unroll
  for (int m = 0; m < 4; ++m)
#pragma unroll
    for (int n = 0; n < 4; ++n)
      *reinterpret_cast<float4*>(Zs + (wc * 64 + n * 16 + fr) * 132 + wr * 64 + m * 16 + fq * 4) = make_float4(acc[m][n][0], acc[m][n][1], acc[m][n][2], acc[m][n][3]);
  __syncthreads();
}
DI void copy_out_f16(const float* Zs, h16* __restrict__ dst, long row0, long ld, int cb, int tid) {
#pragma unroll
  for (int it = 0; it < 8; ++it) {
    const int chunk = it * 256 + tid, row = chunk >> 4, c8 = (chunk & 15) * 8;
    const float4 x0 = *reinterpret_cast<const float4*>(Zs + row * 132 + c8), x1 = *reinterpret_cast<const float4*>(Zs + row * 132 + c8 + 4);
    h16x8 o; o[0] = (h16)x0.x; o[1] = (h16)x0.y; o[2] = (h16)x0.z; o[3] = (h16)x0.w; o[4] = (h16)x1.x; o[5] = (h16)x1.y; o[6] = (h16)x1.z; o[7] = (h16)x1.w;
    *reinterpret_cast<h16x8*>(dst + (row0 + row) * ld + cb + c8) = o;
  }
}
DI void acc_zero(f32x4 (&acc)[4][4]) {
#pragma unroll
  for (int m = 0; m < 4; ++m)
#pragma unroll
    for (int n = 0; n < 4; ++n) acc[m][n] = f32x4{0.f, 0.f, 0.f, 0.f};
}
DI void row_rms(const h16* __restrict__ A, long lda, int K, float* rs) {
  const int tid = tidx(), row = tid >> 1, half = tid & 1;
  const h16* p = A + (long)row * lda + half * (K >> 1);
  float ss = 0.f;
  for (int k = 0; k < (K >> 1); k += 8) {
    h16x8 v = *reinterpret_cast<const h16x8*>(p + k);
#pragma unroll
    for (int j = 0; j < 8; ++j) { float f = (float)v[j]; ss += f * f; }
  }
  ss += __shfl_xor(ss, 1);
  if (half == 0) rs[row] = rsqrtf(ss / (float)K + EPS);
}
DI int map_interleave(int n, int half) { int tile = n >> 7, r = n & 127, sub = r >> 4, fr = r & 15; int j = tile * 64 + (sub >> 1) * 16 + fr; return (sub & 1) ? half + j : j; }
DI int map_col(int mat, int n) {
  switch (mat) {
    case 0: if (n < 640) return n; if (n < 2304) return n + 32; if (n < 2336) return n - 2304 + 640; return -1;
    case 1: return 2336 + n;
    case 3: { int h = n >> 7, j = n & 127; return j < 96 ? h * 96 + j : -1; }
    case 4: return map_interleave(n, 384);
    case 9: return map_interleave(n, 2816);
    default: return n;
  }
}
struct MatDesc { const float* src; const float* scale; long dst; int K, Nmy, Nsrc, ld; };
DI MatDesc get_mat(const Params& P, int layer, int mat) {
  MatDesc d; d.scale = nullptr;
  d.ld = (mat == 0 || mat == 1 || mat == 8 || mat == 9) ? LD1 : 0;
  switch (mat) {
    case 0: d.src = P.in[I_WIN] + (long)layer * 1024 * 5408; d.dst = WT_WIN; d.K = 1024; d.Nmy = 2432; d.Nsrc = 5408; break;
    case 1: d.src = P.in[I_WIN] + (long)layer * 1024 * 5408; d.dst = WT_WGATE; d.K = 1024; d.Nmy = 3072; d.Nsrc = 5408; break;
    case 2: d.src = P.in[I_WUKV] + (long)layer * 256 * 1024; d.dst = WT_UKV; d.K = 256; d.Nmy = 1024; d.Nsrc = 1024; d.scale = P.in[I_GKV] + layer * 256; break;
    case 3: d.src = P.in[I_WUQ] + (long)layer * 512 * 768; d.dst = WT_UQ; d.K = 512; d.Nmy = 1024; d.Nsrc = 768; d.scale = P.in[I_GQ] + layer * 512; break;
    case 4: d.src = P.in[I_WGLU] + (long)layer * 384 * 768; d.dst = WT_GLU; d.K = 384; d.Nmy = 768; d.Nsrc = 768; break;
    case 5: d.src = P.in[I_WBRHY] + (long)layer * 384 * 1024; d.dst = WT_BRHY; d.K = 384; d.Nmy = 1024; d.Nsrc = 1024; break;
    case 6: d.src = P.in[I_WBRS5] + (long)layer * 384 * 1024; d.dst = WT_BRS5; d.K = 384; d.Nmy = 1024; d.Nsrc = 1024; break;
    case 7: d.src = P.in[I_WBRMLA] + (long)layer * 512 * 1024; d.dst = WT_BRMLA; d.K = 512; d.Nmy = 1024; d.Nsrc = 1024; break;
    case 8: d.src = P.in[I_WO] + (long)layer * 1024 * 1024; d.dst = WT_WO; d.K = 1024; d.Nmy = 1024; d.Nsrc = 1024; break;
    case 9: d.src = P.in[I_WUP] + (long)layer * 1024 * 5632; d.dst = WT_UP; d.K = 1024; d.Nmy = 5632; d.Nsrc = 5632; break;
    default: d.src = P.in[I_WDOWN] + (long)layer * 2816 * 1024; d.dst = WT_DOWN; d.K = 2816; d.Nmy = 1024; d.Nsrc = 1024; d.ld = LD2; break;
  }
  if (d.ld == 0) d.ld = d.K;
  return d;
}
constexpr int WT_TILES_PER_LAYER = 608 + 768 + 64 + 128 + 72 + 96 + 96 + 128 + 256 + 1408 + 704;
DI void item_wt(const Params& P, int item, char* smem) {
  const int layer = item / WT_TILES_PER_LAYER; int r = item % WT_TILES_PER_LAYER;
  const int cnt[11] = {608, 768, 64, 128, 72, 96, 96, 128, 256, 1408, 704};
  int mat = 0;
#pragma unroll
  for (int i = 0; i < 10; ++i) { if (mat == i && r >= cnt[i]) { r -= cnt[i]; mat = i + 1; } }
  MatDesc d = get_mat(P, layer, mat);
  const int kt = d.K >> 6, n0 = (r / kt) * 64, k0 = (r % kt) * 64;
  float* tile = reinterpret_cast<float*>(smem);
  h16* dst = reinterpret_cast<h16*>(P.ws + OFF_WT) + (long)layer * WT_LAYER + d.dst;
  const int tid = tidx(), lx = tid & 63, ly = tid >> 6;
  const int sc = map_col(mat, n0 + lx);
#pragma unroll 4
  for (int i = 0; i < 16; ++i) { int kk = i * 4 + ly; tile[kk * 65 + lx] = sc >= 0 ? d.src[(long)(k0 + kk) * d.Nsrc + sc] : 0.f; }
  __syncthreads();
  const float s = d.scale ? d.scale[k0 + lx] : 1.f;
#pragma unroll 4
  for (int i = 0; i < 16; ++i) { int nn = i * 4 + ly; dst[(long)(n0 + nn) * d.ld + k0 + lx] = (h16)(tile[lx * 65 + nn] * s); }
  __syncthreads();
}
DI void item_mod(const Params& P, int item, char* smem) {
  const int layer = item / 96, n0 = (item % 96) * 64;
  float* s = reinterpret_cast<float*>(smem);
  float* part = s + 9 * 1024;
  const int tid = tidx(), lane = tid & 63, wid = tid >> 6;
  for (int i = tid; i < 9 * 1024; i += NTHREADS) { float v = i < 8192 ? P.in[I_C][i] : P.in[I_CCTX][i - 8192]; s[i] = siluf_(v); }
  __syncthreads();
  const float* w = P.in[I_WMOD] + (long)layer * 1024 * 6144 + n0 + lane;
  float acc[9];
#pragma unroll
  for (int r = 0; r < 9; ++r) acc[r] = 0.f;
  for (int k = wid * 256; k < wid * 256 + 256; ++k) {
    const float wv = w[(long)k * 6144];
#pragma unroll
    for (int r = 0; r < 9; ++r) acc[r] += s[r * 1024 + k] * wv;
  }
#pragma unroll
  for (int r = 0; r < 9; ++r) part[(wid * 9 + r) * 64 + lane] = acc[r];
  __syncthreads();
  float* mod = reinterpret_cast<float*>(P.ws + OFF_MOD) + (long)layer * 9 * 6144;
  for (int i = tid; i < 9 * 64; i += NTHREADS) {
    const int r = i >> 6, c = i & 63;
    mod[r * 6144 + n0 + c] = part[(0 * 9 + r) * 64 + c] + part[(1 * 9 + r) * 64 + c] + part[(2 * 9 + r) * 64 + c] + part[(3 * 9 + r) * 64 + c] + P.in[I_BMOD][layer * 6144 + n0 + c];
  }
  __syncthreads();
}
DI void item_hymlp(const Params& P, int item, char* smem) {
  const int layer = item / 132; int r = item % 132;
  const int isc = r >= 128; const int Lf = isc ? CTXL : SEQ; const int t0 = (isc ? r - 128 : r) * 64;
  float* z1 = reinterpret_cast<float*>(smem);
  const int tid = tidx(), tl = tid >> 2, h0 = (tid & 3) * 16; const int t = t0 + tl;
  const float* w1 = P.in[I_FW1] + layer * 17 * 64; const float* b1 = P.in[I_FB1] + layer * 64;
  const float* w2 = P.in[I_FW2] + layer * 64 * 64; const float* b2 = P.in[I_FB2] + layer * 64; const float* fq = P.in[I_FFREQ] + layer * 64;
  float feat[17]; feat[0] = (float)t / (float)Lf;
#pragma unroll
  for (int k = 1; k <= 8; ++k) { float rev = (float)((t * k) % Lf) / (float)Lf; feat[k] = __builtin_amdgcn_cosf(rev); feat[8 + k] = __builtin_amdgcn_sinf(rev); }
#pragma unroll 4
  for (int j = 0; j < 16; ++j) {
    const int h = h0 + j; float a = b1[h];
#pragma unroll
    for (int f = 0; f < 17; ++f) a += feat[f] * w1[f * 64 + h];
    z1[tl * 65 + h] = __sinf(fq[h] * a);
  }
  __syncthreads();
  float* z2 = isc ? reinterpret_cast<float*>(P.ws + OFF_Z2C) + (long)layer * CTXL * 64 : reinterpret_cast<float*>(P.ws + OFF_Z2) + (long)layer * SEQ * 64;
  float a2[16];
#pragma unroll
  for (int j = 0; j < 16; ++j) a2[j] = b2[h0 + j];
  for (int k = 0; k < 64; ++k) {
    const float zv = z1[tl * 65 + k];
#pragma unroll
    for (int j = 0; j < 16; ++j) a2[j] += zv * w2[k * 64 + h0 + j];
  }
#pragma unroll
  for (int j = 0; j < 16; ++j) z2[(long)t * 64 + h0 + j] = __sinf(fq[h0 + j] * a2[j]);
  __syncthreads();
}
DI void item_s5disc(const Params& P, int item) {
  const int layer = item / 12, dir = (item % 12) / 6, gb = item % 6;
  const int tid = tidx(), g = gb * 4 + (tid >> 6), n = tid & 63;
  const int ld = layer * 2 + dir; const long gi = (long)ld * 24 + g;
  const double lre = P.in[I_LAMRE][gi * 64 + n], lim = P.in[I_LAMIM][gi * 64 + n];
  const double step = exp((double)P.in[I_LOGSTEP][gi]);
  double sn, cs; dsincos(lim * step, sn, cs);
  const double mag = exp(lre * step);
  const double are = mag * cs, aim = mag * sn;
  const double nr = are - 1.0, ni = aim, den = lre * lre + lim * lim;
  const double fre = (nr * lre + ni * lim) / den, fim = (ni * lre - nr * lim) / den;
  float2* A = reinterpret_cast<float2*>(P.ws + OFF_S5A); float2* A64 = reinterpret_cast<float2*>(P.ws + OFF_S5A64);
  A[gi * 64 + n] = make_float2((float)are, (float)aim);
  double pr = are, pi = aim;
  for (int i = 0; i < 6; ++i) { double t = pr * pr - pi * pi; pi = 2.0 * pr * pi; pr = t; }
  A64[gi * 64 + n] = make_float2((float)pr, (float)pi);
  float2* Bb = reinterpret_cast<float2*>(P.ws + OFF_S5B) + (gi * 64 + n) * 16;
  const float* bre = P.in[I_BRE] + (gi * 64 + n) * 16; const float* bim = P.in[I_BIM] + (gi * 64 + n) * 16;
  for (int c = 0; c < 16; ++c) { double br = bre[c], bi = bim[c]; Bb[c] = make_float2((float)(fre * br - fim * bi), (float)(fre * bi + fim * br)); }
  h16* Ct = reinterpret_cast<h16*>(P.ws + OFF_S5C) + gi * 16 * 128;
  const float* cre = P.in[I_CRE] + gi * 16 * 64; const float* cim = P.in[I_CIM] + gi * 16 * 64;
  for (int c = 0; c < 16; ++c) { Ct[c * 128 + n] = (h16)cre[c * 64 + n]; Ct[c * 128 + 64 + n] = (h16)(-cim[c * 64 + n]); }
}
DI void item_rope(const Params& P, int item) {
  const int idx = item * NTHREADS + tidx(); const int pos = idx >> 4, i = idx & 15;
  const double inv[8] = {1.0, 0.31622776601683794, 0.1, 0.031622776601683794, 0.01, 0.0031622776601683794, 0.001, 0.00031622776601683794};
  double iv = 1.0;
#pragma unroll
  for (int k = 0; k < 8; ++k) if ((i & 7) == k) iv = inv[k];
  const double ang = (double)(i < 8 ? (pos >> 6) : (pos & 63)) * iv;
  double s, c; dsincos(ang, s, c);
  reinterpret_cast<float2*>(P.ws + OFF_ROPE)[idx] = make_float2((float)c, (float)s);
}
constexpr int PRO_N_WT = 2 * WT_TILES_PER_LAYER, PRO_N_MOD = 192, PRO_N_HY = 264, PRO_N_S5 = 24, PRO_N_ROPE = 512;
DI void phase_prologue(const Params& P, char* smem) {
  const int total = PRO_N_MOD + PRO_N_HY + PRO_N_S5 + PRO_N_ROPE + PRO_N_WT;
  for (int it = blockIdx.x; it < total; it += gridDim.x) {
    int i = it;
    if (i < PRO_N_MOD) { item_mod(P, i, smem); continue; } i -= PRO_N_MOD;
    if (i < PRO_N_HY) { item_hymlp(P, i, smem); continue; } i -= PRO_N_HY;
    if (i < PRO_N_S5) { item_s5disc(P, i); continue; } i -= PRO_N_S5;
    if (i < PRO_N_ROPE) { item_rope(P, i); continue; } i -= PRO_N_ROPE;
    item_wt(P, i, smem);
  }
}

DI const float* xrow_src(const Params& P, int layer_stage, int t) {
  if (t < TLAT) return (layer_stage == 0 ? P.in[I_X] : P.out) + (long)t * 1024;
  return (layer_stage == 0 ? P.in[I_CTX] : reinterpret_cast<const float*>(P.ws + OFF_XC)) + (long)(t - TLAT) * 1024;
}
DI float* xrow_dst(const Params& P, int t) {
  if (t < TLAT) return P.out + (long)t * 1024;
  return reinterpret_cast<float*>(P.ws + OFF_XC) + (long)(t - TLAT) * 1024;
}
DI void normmod_rows(const Params& P, int layer, int which, int stage, int ntok, int item, int nitems_stride) {
  const int tid = tidx(), lane = tid & 63, wid = tid >> 6;
  const float* g = P.in[which ? I_N2G : I_N1G] + layer * 1024;
  const float* mod = reinterpret_cast<const float*>(P.ws + OFF_MOD) + (long)layer * 9 * 6144;
  h16* H = reinterpret_cast<h16*>(P.ws + OFF_H1);
  for (int rg = item; rg * 4 < ntok; rg += nitems_stride) {
    const int t = rg * 4 + wid;
    const Tok k = tokinfo(t);
    const float* xr = xrow_src(P, stage, t);
    const float* sh = mod + k.mrow * 6144 + (which ? 3 : 0) * 1024; const float* sc = sh + 1024;
    float4 v[4]; float ss = 0.f;
#pragma unroll
    for (int i = 0; i < 4; ++i) { v[i] = *reinterpret_cast<const float4*>(xr + i * 256 + lane * 4); ss += v[i].x * v[i].x + v[i].y * v[i].y + v[i].z * v[i].z + v[i].w * v[i].w; }
    ss = wave_sum(ss);
    const float r = rsqrtf(ss * (1.f / 1024.f) + EPS);
#pragma unroll
    for (int i = 0; i < 4; ++i) {
      const int c = i * 256 + lane * 4;
      const float4 gg = *reinterpret_cast<const float4*>(g + c), s1 = *reinterpret_cast<const float4*>(sc + c), s0 = *reinterpret_cast<const float4*>(sh + c);
      h16x4 o;
      o[0] = (h16)(v[i].x * r * gg.x * (1.f + s1.x) + s0.x); o[1] = (h16)(v[i].y * r * gg.y * (1.f + s1.y) + s0.y);
      o[2] = (h16)(v[i].z * r * gg.z * (1.f + s1.z) + s0.z); o[3] = (h16)(v[i].w * r * gg.w * (1.f + s1.w) + s0.w);
      *reinterpret_cast<h16x4*>(H + (long)t * LD1 + c) = o;
    }
  }
}
DI void phase_final(const Params& P) {
  const int lane = tidx() & 63, wid = tidx() >> 6;
  const float* g = P.in[I_FINALG];
  for (int rg = blockIdx.x; rg * 4 < TLAT; rg += gridDim.x) {
    float* xr = P.out + (long)(rg * 4 + wid) * 1024;
    float4 v[4]; float ss = 0.f;
#pragma unroll
    for (int i = 0; i < 4; ++i) { v[i] = *reinterpret_cast<const float4*>(xr + i * 256 + lane * 4); ss += v[i].x * v[i].x + v[i].y * v[i].y + v[i].z * v[i].z + v[i].w * v[i].w; }
    ss = wave_sum(ss);
    const float r = rsqrtf(ss * (1.f / 1024.f) + EPS);
#pragma unroll
    for (int i = 0; i < 4; ++i) {
      const int c = i * 256 + lane * 4; const float4 gg = *reinterpret_cast<const float4*>(g + c);
      *reinterpret_cast<float4*>(xr + c) = make_float4(v[i].x * r * gg.x, v[i].y * r * gg.y, v[i].z * r * gg.z, v[i].w * r * gg.w);
    }
  }
}
DI float2 r8(int idx) { const float c = 0.70710678118654752f; return idx == 0 ? make_float2(1.f, 0.f) : idx == 1 ? make_float2(c, -c) : idx == 2 ? make_float2(0.f, -1.f) : make_float2(-c, -c); }
DI float2 cmul_r8(float2 w, int idx, bool cj) {
  if (idx == 0) return w;
  float2 r = r8(idx); if (cj) r.y = -r.y;
  return cmul(w, r);
}
template <int S> DI void fft_dif_pass(float2* X, int h) {
  const int hs = h >> (S - 1);
#pragma unroll 1
  for (int item = tidx(); item < (8192 >> S); item += NTHREADS) {
    const int j = item % hs, blk = item / hs, i0 = blk * 2 * h + j;
    float2 v[1 << S];
#pragma unroll
    for (int k = 0; k < (1 << S); ++k) v[k] = X[i0 + k * hs];
    float2 wp[S];
    wp[0] = twid(-(float)j / (float)(2 * h));
#pragma unroll
    for (int q = 1; q < S; ++q) wp[q] = cmul(wp[q - 1], wp[q - 1]);
#pragma unroll
    for (int q = 0; q < S; ++q) {
      const int dist = 1 << (S - 1 - q);
#pragma unroll
      for (int k = 0; k < (1 << S); ++k) {
        if (k & dist) continue;
        const float2 a = v[k], b = v[k + dist];
        const int m = k & (dist - 1);
        const float2 tw = cmul_r8(wp[q], m << (3 - (S - q)), false);
        v[k] = make_float2(a.x + b.x, a.y + b.y);
        v[k + dist] = cmul(make_float2(a.x - b.x, a.y - b.y), tw);
      }
    }
#pragma unroll
    for (int k = 0; k < (1 << S); ++k) X[i0 + k * hs] = v[k];
  }
  __syncthreads();
}
template <int S> DI void fft_dit_pass(float2* X, int hs) {
  const int hmax = hs << (S - 1);
#pragma unroll 1
  for (int item = tidx(); item < (8192 >> S); item += NTHREADS) {
    const int j = item % hs, blk = item / hs, i0 = blk * 2 * hmax + j;
    float2 v[1 << S];
#pragma unroll
    for (int k = 0; k < (1 << S); ++k) v[k] = X[i0 + k * hs];
    float2 bp[S];
    bp[S - 1] = twid((float)j / (float)(2 * hmax));
#pragma unroll
    for (int q = S - 2; q >= 0; --q) bp[q] = cmul(bp[q + 1], bp[q + 1]);
#pragma unroll
    for (int q = 0; q < S; ++q) {
      const int dist = 1 << q;
#pragma unroll
      for (int k = 0; k < (1 << S); ++k) {
        if (k & dist) continue;
        const int m = k & (dist - 1);
        const float2 tw = cmul_r8(bp[q], m << (3 - (q + 1)), true);
        const float2 a = v[k], b = cmul(v[k + dist], tw);
        v[k] = make_float2(a.x + b.x, a.y + b.y);
        v[k + dist] = make_float2(a.x - b.x, a.y - b.y);
      }
    }
#pragma unroll
    for (int k = 0; k < (1 << S); ++k) X[i0 + k * hs] = v[k];
  }
  __syncthreads();
}
DI void fft_fwd(float2* X) { fft_dif_pass<3>(X, 4096); fft_dif_pass<3>(X, 512); fft_dif_pass<3>(X, 64); fft_dif_pass<2>(X, 8); fft_dif_pass<2>(X, 2); }
DI void fft_inv(float2* X) { fft_dit_pass<2>(X, 1); fft_dit_pass<2>(X, 4); fft_dit_pass<3>(X, 16); fft_dit_pass<3>(X, 128); fft_dit_pass<3>(X, 1024); }

DI float block_sum(float v, float* red) {
  v = wave_sum(v);
  __syncthreads();
  if ((tidx() & 63) == 0) red[tidx() >> 6] = v;
  __syncthreads();
  const float r = red[0] + red[1] + red[2] + red[3];
  __syncthreads();
  return r;
}
DI void item_filter(const Params& P, int layer, int oc, char* smem) {
  float2* X = reinterpret_cast<float2*>(smem); float* red = reinterpret_cast<float*>(smem + 65536);
  const int tid = tidx();
  const float* z2 = reinterpret_cast<const float*>(P.ws + OFF_Z2) + (long)layer * SEQ * 64;
  const float* w3 = P.in[I_FW3] + (long)layer * 64 * 1536; const float* dec = P.in[I_FDECAY] + layer * 1536;
  const int colf = oc, colb = 768 + oc;
  const float df = fabsf(dec[colf]), db = fabsf(dec[colb]);
  float lsum = 0.f;
#pragma unroll 2
  for (int i = 0; i < 32; ++i) {
    const int t = tid + 256 * i; const float* zr = z2 + (long)t * 64;
    float af = 0.f, ab = 0.f;
#pragma unroll 8
    for (int k = 0; k < 64; ++k) { const float z = zr[k]; af += z * w3[k * 1536 + colf]; ab += z * w3[k * 1536 + colb]; }
    const float tn = (float)t * (1.f / 8192.f);
    af *= __expf(-tn * df); ab *= __expf(-tn * db);
    lsum += fabsf(af) + fabsf(ab);
    X[t] = make_float2(af, ab);
  }
  const float nrm = block_sum(lsum, red);
  const float sc = 0.5f / 8192.f / nrm;
  float ev[32];
  float2* F = reinterpret_cast<float2*>(P.ws + OFF_FILT) + (long)oc * 2 * 8192;
#pragma unroll
  for (int i = 0; i < 32; ++i) {
    const int n = tid + 256 * i; const float lo = X[n].x; const float hi = n > 0 ? X[8192 - n].y : 0.f;
    ev[i] = (lo + hi) * sc; F[8192 + n] = make_float2((lo - hi) * sc, 0.f);
  }
  __syncthreads();
#pragma unroll
  for (int i = 0; i < 32; ++i) X[tid + 256 * i] = make_float2(ev[i], 0.f);
  __syncthreads();
  fft_fwd(X);
#pragma unroll 4
  for (int i = 0; i < 32; ++i) F[tid + 256 * i] = X[tid + 256 * i];
  __syncthreads();
#pragma unroll 4
  for (int i = 0; i < 32; ++i) { const int n = tid + 256 * i; const float d = F[8192 + n].x; const float2 w = twid(-(float)n * (1.f / 16384.f)); X[n] = make_float2(d * w.x, d * w.y); }
  __syncthreads();
  fft_fwd(X);
#pragma unroll 4
  for (int i = 0; i < 32; ++i) F[8192 + tid + 256 * i] = X[tid + 256 * i];
  __syncthreads();
}
DI void item_filter_ctx(const Params& P, int layer, int oc, char* smem) {
  float* red = reinterpret_cast<float*>(smem);
  const int t = tidx();
  const float* zr = reinterpret_cast<const float*>(P.ws + OFF_Z2C) + (long)layer * CTXL * 64 + t * 64;
  const float* w3 = P.in[I_FW3] + (long)layer * 64 * 1536; const float* dec = P.in[I_FDECAY] + layer * 1536;
  float af = 0.f, ab = 0.f;
  for (int k = 0; k < 64; ++k) { const float z = zr[k]; af += z * w3[k * 1536 + oc]; ab += z * w3[k * 1536 + 768 + oc]; }
  const float tn = (float)t * (1.f / 256.f);
  af *= __expf(-tn * fabsf(dec[oc])); ab *= __expf(-tn * fabsf(dec[768 + oc]));
  const float nrm = block_sum(fabsf(af) + fabsf(ab), red);
  float* T = reinterpret_cast<float*>(P.ws + OFF_TAPSC) + (long)oc * 512;
  T[t] = af / nrm; T[256 + t] = ab / nrm;
}

DI void phase_norm1(const Params& P, int layer, char* smem) {
  const int nfilt = 768 + (layer == 0 ? 768 : 0);
  for (int it = blockIdx.x; it < nfilt; it += gridDim.x) {
    if (it < 768) item_filter(P, layer, it, smem); else item_filter_ctx(P, layer, it - 768, smem);
  }
  normmod_rows(P, layer, 0, layer, TT, blockIdx.x, gridDim.x);
}

DI void phase_gemm_in(const Params& P, int layer, char* smem) {
  const int tid = tidx(), lane = tid & 63, wid = tid >> 6, wr = wid >> 1, wc = wid & 1, fr = lane & 15, fq = lane >> 4;
  const h16* H = reinterpret_cast<const h16*>(P.ws + OFF_H1);
  const h16* W = reinterpret_cast<const h16*>(P.ws + OFF_WT) + (long)layer * WT_LAYER + WT_WIN;
  h16* U = reinterpret_cast<h16*>(P.ws + OFF_U); h16* KV = reinterpret_cast<h16*>(P.ws + OFF_KVLAT); h16* QL = reinterpret_cast<h16*>(P.ws + OFF_QLAT);
  h16* PHY = reinterpret_cast<h16*>(P.ws + OFF_PHY); h16* PHYC = reinterpret_cast<h16*>(P.ws + OFF_PHYC); h16* Kb = reinterpret_cast<h16*>(P.ws + OFF_K);
  const float2* rope = reinterpret_cast<const float2*>(P.ws + OFF_ROPE);
  constexpr int NT = 19, MT = TT / 128;
  const TileWalk tw = tw_init(MT, NT);
  for (int tile = tw.lb; tile < tw_count(tw); tile += tw.nlb) {
    int mt, nt; tw_decode(tw, tile, mt, nt);
    f32x4 acc[4][4]; acc_zero(acc);
    gemm_kloop(acc, H + (long)mt * 128 * LD1, LD1, 0, 128, W + (long)nt * 128 * LD1, LD1, 1024, smem, opaque_tid());
    const int t0 = mt * 128; const Tok tk = tokinfo(t0);
    if (nt < 18) {
      float* Zs = reinterpret_cast<float*>(smem);
      const int t2 = tidx();
      if (nt < 9) {
        stage_acc(acc, Zs, t2);
        h16* dst; int ld, cb;
        if (nt < 3) { dst = U; ld = 384; cb = nt * 128; } else if (nt < 5) { dst = KV; ld = 256; cb = (nt - 3) * 128; } else { dst = QL; ld = 512; cb = (nt - 5) * 128; }
        copy_out_f16(Zs, dst, t0, ld, cb, t2);
      } else {
        stage_acc_t(acc, Zs, t2);
        h16* base = tk.ctx ? PHYC + (long)tk.b * 1152 * CTXL : PHY + (long)tk.b * 1152 * SEQ; const int lp = tk.ctx ? CTXL : SEQ;
        copy_out_f16(Zs, base, (nt - 9) * 128, lp, tk.pos, t2);
      }
      __syncthreads();
    } else if (wc == 0) {
#pragma unroll
      for (int m = 0; m < 4; ++m)
#pragma unroll
        for (int j = 0; j < 4; ++j) {
          const int pos = tk.pos + wr * 64 + m * 16 + fq * 4 + j; const int key = tk.ctx ? SEQ + pos : pos;
          float x1 = acc[m][0][j], x2 = acc[m][1][j];
          if (!tk.ctx) { const float2 cs = rope[pos * 16 + fr]; const float y1 = x1 * cs.x - x2 * cs.y, y2 = x1 * cs.y + x2 * cs.x; x1 = y1; x2 = y2; }
#pragma unroll
          for (int h = 0; h < 8; ++h) { h16* kr = Kb + ((long)(tk.b * 8 + h) * KEYS + key) * 96 + 64; kr[fr] = (h16)x1; kr[16 + fr] = (h16)x2; }
        }
    }
  }
}
DI void item_kv(const Params& P, int layer, int tile, char* smem) {
  const int tid = tidx(), lane = tid & 63, wid = tid >> 6, wr = wid >> 1, wc = wid & 1, fr = lane & 15, fq = lane >> 4;
  const int mt = tile >> 3, hd = tile & 7; const int t0 = mt * 128; const Tok tk = tokinfo(t0);
  const h16* A = reinterpret_cast<const h16*>(P.ws + OFF_KVLAT) + (long)t0 * 256;
  const h16* W = reinterpret_cast<const h16*>(P.ws + OFF_WT) + (long)layer * WT_LAYER + WT_UKV + (long)hd * 128 * 256;
  float* rs = reinterpret_cast<float*>(smem + 73728);
  row_rms(A, 256, 256, rs);
  f32x4 acc[4][4]; acc_zero(acc);
  gemm_kloop(acc, A, 256, 0, 128, W, 256, 256, smem, opaque_tid());
  h16* Kb = reinterpret_cast<h16*>(P.ws + OFF_K) + (long)(tk.b * 8 + hd) * KEYS * 96;
  h16* Vt = reinterpret_cast<h16*>(P.ws + OFF_VT) + (long)(tk.b * 8 + hd) * 64 * KEYS;
  const int key0 = (tk.ctx ? SEQ : 0) + tk.pos;
#pragma unroll
  for (int m = 0; m < 4; ++m) {
    const int r0 = wr * 64 + m * 16 + fq * 4;
    const float s0 = rs[r0], s1 = rs[r0 + 1], s2 = rs[r0 + 2], s3 = rs[r0 + 3];
#pragma unroll
    for (int n = 0; n < 4; ++n) {
      const int col = n * 16 + fr;
      if (wc == 0) {
        Kb[(long)(key0 + r0 + 0) * 96 + col] = (h16)(acc[m][n][0] * s0); Kb[(long)(key0 + r0 + 1) * 96 + col] = (h16)(acc[m][n][1] * s1);
        Kb[(long)(key0 + r0 + 2) * 96 + col] = (h16)(acc[m][n][2] * s2); Kb[(long)(key0 + r0 + 3) * 96 + col] = (h16)(acc[m][n][3] * s3);
      } else {
        h16x4 o; o[0] = (h16)(acc[m][n][0] * s0); o[1] = (h16)(acc[m][n][1] * s1); o[2] = (h16)(acc[m][n][2] * s2); o[3] = (h16)(acc[m][n][3] * s3);
        *reinterpret_cast<h16x4*>(Vt + (long)col * KEYS + key0 + r0) = o;
      }
    }
  }
  __syncthreads();
}
DI void item_q(const Params& P, int layer, int tile, char* smem) {
  const int tid = tidx(), lane = tid & 63, wid = tid >> 6, wr = wid >> 1, wc = wid & 1, fr = lane & 15, fq = lane >> 4;
  const int mt = tile >> 3, hd = tile & 7; const int t0 = mt * 128; const Tok tk = tokinfo(t0);
  const h16* A = reinterpret_cast<const h16*>(P.ws + OFF_QLAT) + (long)t0 * 512;
  const h16* W = reinterpret_cast<const h16*>(P.ws + OFF_WT) + (long)layer * WT_LAYER + WT_UQ + (long)hd * 128 * 512;
  float* rs = reinterpret_cast<float*>(smem + 73728);
  row_rms(A, 512, 512, rs);
  f32x4 acc[4][4]; acc_zero(acc);
  gemm_kloop(acc, A, 512, 0, 128, W, 512, 512, smem, opaque_tid());
  h16* Qb = reinterpret_cast<h16*>(P.ws + OFF_Q) + (long)(tk.b * 8 + hd) * KEYS * 96;
  const float2* rope = reinterpret_cast<const float2*>(P.ws + OFF_ROPE);
  const int q0 = (tk.ctx ? SEQ : 0) + tk.pos;
#pragma unroll
  for (int m = 0; m < 4; ++m)
#pragma unroll
    for (int j = 0; j < 4; ++j) {
      const int r = wr * 64 + m * 16 + fq * 4 + j; const float s = rs[r] * QSCALE;
      h16* qr = Qb + (long)(q0 + r) * 96;
      if (wc == 0) {
#pragma unroll
        for (int n = 0; n < 4; ++n) qr[n * 16 + fr] = (h16)(acc[m][n][j] * s);
      } else {
        float x1 = acc[m][0][j], x2 = acc[m][1][j];
        if (!tk.ctx) { const float2 cs = rope[(tk.pos + r) * 16 + fr]; const float y1 = x1 * cs.x - x2 * cs.y, y2 = x1 * cs.y + x2 * cs.x; x1 = y1; x2 = y2; }
        qr[64 + fr] = (h16)(x1 * s); qr[80 + fr] = (h16)(x2 * s);
      }
    }
  __syncthreads();
}
DI int s5_chunk_base(int b, int dir, int si) {
  if (si < 4) { const int cc = dir ? 3 - si : si; return TLAT + b * CTXL + cc * 64; }
  const int lc = dir ? 127 - (si - 4) : si - 4; return b * SEQ + lc * 64;
}
DI void s5_stage_u(const h16* __restrict__ U, int tokbase, int g, float* us) {
  const int lane = tidx() & 63;
  const h16* p = U + (long)(tokbase + lane) * 384 + g * 16;
  const h16x8 v0 = *reinterpret_cast<const h16x8*>(p), v1 = *reinterpret_cast<const h16x8*>(p + 8);
#pragma unroll
  for (int j = 0; j < 8; ++j) { us[lane * 16 + j] = (float)v0[j]; us[lane * 16 + 8 + j] = (float)v1[j]; }
}
DI void item_s5_pass1(const Params& P, int layer, int wtask, char* smem) {
  const int lane = tidx() & 63, wid = tidx() >> 6;
  float* us = reinterpret_cast<float*>(smem + wid * 12800);
  const int si = wtask % 132; int r = wtask / 132; const int g = r % 24; r /= 24; const int dir = r & 1, b = r >> 1;
  const long gi = (long)(layer * 2 + dir) * 24 + g;
  const float2 a = reinterpret_cast<const float2*>(P.ws + OFF_S5A)[gi * 64 + lane];
  const float2* Bb = reinterpret_cast<const float2*>(P.ws + OFF_S5B) + (gi * 64 + lane) * 16;
  float bre[16], bim[16];
#pragma unroll
  for (int c = 0; c < 16; ++c) { const float2 v = Bb[c]; bre[c] = v.x; bim[c] = v.y; }
  s5_stage_u(reinterpret_cast<const h16*>(P.ws + OFF_U), s5_chunk_base(b, dir, si), g, us);
  float hr = 0.f, hi = 0.f;
#pragma unroll 4
  for (int s = 0; s < 64; ++s) {
    const int tau = dir ? 63 - s : s;
    const float4* up = reinterpret_cast<const float4*>(us + tau * 16);
    float br = 0.f, bi = 0.f;
#pragma unroll
    for (int q = 0; q < 4; ++q) { const float4 u = up[q];
      br += bre[q * 4] * u.x + bre[q * 4 + 1] * u.y + bre[q * 4 + 2] * u.z + bre[q * 4 + 3] * u.w;
      bi += bim[q * 4] * u.x + bim[q * 4 + 1] * u.y + bim[q * 4 + 2] * u.z + bim[q * 4 + 3] * u.w; }
    const float nr = a.x * hr - a.y * hi + br, ni = a.x * hi + a.y * hr + bi; hr = nr; hi = ni;
  }
  reinterpret_cast<float2*>(P.ws + OFF_E)[((long)((b * 2 + dir) * 24 + g) * 132 + si) * 64 + lane] = make_float2(hr, hi);
}

DI float hy_dw(const h16* __restrict__ p, int t, int Ls, float w0, float w1, float w2, float bias) {
  const float xm = t > 0 ? (float)p[t - 1] : 0.f, x0 = (float)p[t], xp = t + 1 < Ls ? (float)p[t + 1] : 0.f;
  return xm * w0 + x0 * w1 + xp * w2 + bias;
}
DI void item_hyena(const Params& P, int layer, int task, char* smem) {
  float2* X = reinterpret_cast<float2*>(smem);
  const int tid = tidx(); const int pair = task / 384, c = task % 384;
  const h16* PH0 = reinterpret_cast<const h16*>(P.ws + OFF_PHY) + (long)(2 * pair) * 1152 * SEQ;
  const h16* PH1 = PH0 + (long)1152 * SEQ;
  const float* cw = P.in[I_HCW] + layer * 3 * 1152; const float* cb = P.in[I_HCB] + layer * 1152;
  const float2* F = reinterpret_cast<const float2*>(P.ws + OFF_FILT);
  float2* SCR = reinterpret_cast<float2*>(P.ws + OFF_YS5PRE) + (long)blockIdx.x * 12288;
  float2* SCR2 = SCR + 8192;
  const float vw0 = cw[c], vw1 = cw[1152 + c], vw2 = cw[2304 + c], vbb = cb[c];
  const h16* pv0 = PH0 + (long)c * SEQ; const h16* pv1 = PH1 + (long)c * SEQ;
  float2 ye[16]; int tq;
#pragma unroll 1
  for (int o = 0; o < 2; ++o) {
    const float2* Te = F + (long)(o * 384 + c) * 2 * 8192; const float2* To = Te + 8192;
    float ts = 1.f / 16384.f; asm volatile("" : "+v"(ts));
{ tq = tid; asm volatile("" : "+v"(tq)); }
#pragma unroll 8
    for (int i = 0; i < 32; ++i) { const int t = tq + 256 * i;
      X[t] = o == 0 ? make_float2(hy_dw(pv0, t, SEQ, vw0, vw1, vw2, vbb), hy_dw(pv1, t, SEQ, vw0, vw1, vw2, vbb)) : SCR[t]; }
    __syncthreads();
    fft_fwd(X);
{ tq = tid; asm volatile("" : "+v"(tq)); }
#pragma unroll 8
    for (int i = 0; i < 32; ++i) { const int n = tq + 256 * i; X[n] = cmul(X[n], Te[n]); }
    __syncthreads();
    fft_inv(X);
{ tq = tid; asm volatile("" : "+v"(tq)); }
#pragma unroll
    for (int i = 0; i < 16; ++i) { ye[i] = X[tq + 256 * i]; SCR2[tq + 256 * i] = X[tq + 4096 + 256 * i]; }
    __syncthreads();
{ tq = tid; asm volatile("" : "+v"(tq)); }
#pragma unroll 8
    for (int i = 0; i < 32; ++i) { const int t = tq + 256 * i;
      const float2 zz = o == 0 ? make_float2(hy_dw(pv0, t, SEQ, vw0, vw1, vw2, vbb), hy_dw(pv1, t, SEQ, vw0, vw1, vw2, vbb)) : SCR[t];
      X[t] = cmul(zz, twid(-(float)t * ts)); }
    __syncthreads();
    fft_fwd(X);
{ tq = tid; asm volatile("" : "+v"(tq)); }
#pragma unroll 8
    for (int i = 0; i < 32; ++i) { const int n = tq + 256 * i; X[n] = cmul(X[n], To[n]); }
    __syncthreads();
    fft_inv(X);
    asm volatile("" : "+v"(ts));
{ tq = tid; asm volatile("" : "+v"(tq)); }
#pragma unroll
    for (int i = 0; i < 16; ++i) { const int t = tq + 256 * i; const float2 yo = cmul(X[t], twid((float)t * ts)); X[t] = make_float2(ye[i].x + yo.x, ye[i].y + yo.y); }
{ tq = tid; asm volatile("" : "+v"(tq)); }
#pragma unroll 2
    for (int i = 0; i < 16; ++i) { const int t = tq + 4096 + 256 * i; const float2 yo = cmul(X[t], twid((float)t * ts)); const float2 y2 = SCR2[tq + 256 * i]; X[t] = make_float2(y2.x + yo.x, y2.y + yo.y); }
    const int gc = (o + 1) * 384 + c;
    const float w0 = cw[gc], w1 = cw[1152 + gc], w2 = cw[2304 + gc], bb = cb[gc];
    const float bias = P.in[I_HBIAS][(layer * 2 + o) * 384 + c];
    const h16* pg0 = PH0 + (long)gc * SEQ; const h16* pg1 = PH1 + (long)gc * SEQ;
    h16* Y = reinterpret_cast<h16*>(P.ws + OFF_YHY);
{ tq = tid; asm volatile("" : "+v"(tq)); }
#pragma unroll 8
    for (int i = 0; i < 32; ++i) {
      const int t = tq + 256 * i;
      const float2 lc = X[t];
      const float2 zz = o == 0 ? make_float2(hy_dw(pv0, t, SEQ, vw0, vw1, vw2, vbb), hy_dw(pv1, t, SEQ, vw0, vw1, vw2, vbb)) : SCR[t];
      const float gx = hy_dw(pg0, t, SEQ, w0, w1, w2, bb), gy = hy_dw(pg1, t, SEQ, w0, w1, w2, bb);
      const float2 res = make_float2(gx * (lc.x + bias * zz.x), gy * (lc.y + bias * zz.y));
      if (o == 0) SCR[t] = res;
      else { Y[((long)(2 * pair) * SEQ + t) * 384 + c] = (h16)res.x; Y[((long)(2 * pair + 1) * SEQ + t) * 384 + c] = (h16)res.y; }
    }
    __syncthreads();
  }
}
DI void item_hyena_ctx(const Params& P, int layer, int task, char* smem) {
  float* su = reinterpret_cast<float*>(smem); float* sf = su + 256; float* sb = sf + 256;
  const int t = tidx(); const int b = task / 384, c = task % 384;
  const h16* PH = reinterpret_cast<const h16*>(P.ws + OFF_PHYC) + (long)b * 1152 * CTXL;
  const float* cw = P.in[I_HCW] + layer * 3 * 1152; const float* cb = P.in[I_HCB] + layer * 1152;
  float u = hy_dw(PH + (long)c * CTXL, t, CTXL, cw[c], cw[1152 + c], cw[2304 + c], cb[c]);
  for (int o = 0; o < 2; ++o) {
    const float* T = reinterpret_cast<const float*>(P.ws + OFF_TAPSC) + (long)(o * 384 + c) * 512;
    __syncthreads();
    su[t] = u; sf[t] = T[t]; sb[t] = T[256 + t];
    __syncthreads();
    float y = 0.f;
    for (int s = 0; s <= t; ++s) y += sf[t - s] * su[s];
    for (int s = t + 1; s < 256; ++s) y += sb[s - t] * su[s];
    const int gc = (o + 1) * 384 + c;
    const float gx = hy_dw(PH + (long)gc * CTXL, t, CTXL, cw[gc], cw[1152 + gc], cw[2304 + gc], cb[gc]);
    u = gx * (y + P.in[I_HBIAS][(layer * 2 + o) * 384 + c] * u);
  }
  reinterpret_cast<h16*>(P.ws + OFF_YHY)[((long)TLAT + b * CTXL + t) * 384 + c] = (h16)u;
  __syncthreads();
}

#ifndef PROBE_HY
#define PROBE_HY 0
#endif
#ifndef PROBE_S5
#define PROBE_S5 0
#endif
DI int first_item(int base) { const int g = (int)gridDim.x; return (((int)blockIdx.x - base) % g + g) % g; }
DI void phase_mix1(const Params& P, int layer, char* smem) {
  const int n_hy = 4 * 384, n_hyc = layer == 0 ? 8 * 384 : 0;
  const int n_kv = (TT / 128) * 8, n_q = (layer == 0 ? TT / 128 : TLAT / 128) * 8;
  const int n_s5 = (NBATCH * 2 * 24 * 132) / 4;
  const int g = gridDim.x;
#pragma unroll 1
  for (int rep = 0; rep < 1 + PROBE_HY; ++rep)
#pragma unroll 1
  for (int i = first_item(0); i < n_hy; i += g) item_hyena(P, layer, i, smem);
  asm volatile("" ::: "memory");
#pragma unroll 1
  for (int i = first_item(n_hy); i < n_kv; i += g) item_kv(P, layer, i, smem);
  asm volatile("" ::: "memory");
#pragma unroll 1
  for (int i = first_item(n_hy + n_kv); i < n_q; i += g) item_q(P, layer, i, smem);
  asm volatile("" ::: "memory");
#pragma unroll 1
  for (int rep = 0; rep < 1 + PROBE_S5; ++rep)
#pragma unroll 1
  for (int i = first_item(n_hy + n_kv + n_q); i < n_s5; i += g) { item_s5_pass1(P, layer, i * 4 + (tidx() >> 6), smem); __syncthreads(); }
  asm volatile("" ::: "memory");
#pragma unroll 1
  for (int i = first_item(n_hy + n_kv + n_q + n_s5); i < n_hyc; i += g) item_hyena_ctx(P, layer, i, smem);
}
DI int crow32(int r, int hi) { return (r & 3) + 8 * (r >> 2) + 4 * hi; }
DI void item_attn(const Params& P, int bh, int q0, int key_lo, int ntiles, char* smem) {
  const int tid = tidx(), lane = tid & 63, wid = tid >> 6, r32 = lane & 31, hi = lane >> 5;
  const h16* Qb = reinterpret_cast<const h16*>(P.ws + OFF_Q) + (long)bh * KEYS * 96;
  const h16* Kb = reinterpret_cast<const h16*>(P.ws + OFF_K) + (long)bh * KEYS * 96;
  const h16* Vt = reinterpret_cast<const h16*>(P.ws + OFF_VT) + (long)bh * 64 * KEYS;
  h16x8 qf[6];
  { const h16* qrow = Qb + (long)(q0 + wid * 32 + r32) * 96 + hi * 8;
#pragma unroll
    for (int ds = 0; ds < 6; ++ds) qf[ds] = *reinterpret_cast<const h16x8*>(qrow + ds * 16); }
  constexpr int KT_BYTES = 64 * 208, VT_BYTES = 64 * 136, BUF = KT_BYTES + VT_BYTES;
  uint4 kr[3]; uint4 vr[2];
  const int vdv0 = tid >> 3, vpart = tid & 7;
  auto gload = [&](int j) {
    const long key0 = key_lo + j * 64;
#pragma unroll
    for (int i = 0; i < 3; ++i) kr[i] = *reinterpret_cast<const uint4*>(Kb + key0 * 96 + (long)(tid + 256 * i) * 8);
#pragma unroll
    for (int i = 0; i < 2; ++i) vr[i] = *reinterpret_cast<const uint4*>(Vt + (long)(vdv0 + 32 * i) * KEYS + key0 + vpart * 8);
  };
  auto swrite = [&](int buf) {
    char* ks = smem + buf * BUF; char* vs = ks + KT_BYTES;
#pragma unroll
    for (int i = 0; i < 3; ++i) { const int c = tid + 256 * i; *reinterpret_cast<uint4*>(ks + (c / 12) * 208 + (c % 12) * 16) = kr[i]; }
#pragma unroll
    for (int i = 0; i < 2; ++i) { char* d = vs + (vdv0 + 32 * i) * 136 + vpart * 16;
      *reinterpret_cast<uint2*>(d) = make_uint2(vr[i].x, vr[i].y); *reinterpret_cast<uint2*>(d + 8) = make_uint2(vr[i].z, vr[i].w); }
  };
  f32x16 o0, o1;
#pragma unroll
  for (int r = 0; r < 16; ++r) { o0[r] = 0.f; o1[r] = 0.f; }
  float m_run = -1e30f, l_run = 0.f;
  gload(0); swrite(0); __syncthreads();
  for (int j = 0; j < ntiles; ++j) {
    if (j + 1 < ntiles) gload(j + 1);
    const char* ks = smem + (j & 1) * BUF; const char* vs = ks + KT_BYTES;
    f32x16 p0, p1;
#pragma unroll
    for (int r = 0; r < 16; ++r) { p0[r] = 0.f; p1[r] = 0.f; }
#pragma unroll
    for (int ds = 0; ds < 6; ++ds) {
      const h16x8 a0 = *reinterpret_cast<const h16x8*>(ks + r32 * 208 + (ds * 16 + hi * 8) * 2);
      const h16x8 a1 = *reinterpret_cast<const h16x8*>(ks + (32 + r32) * 208 + (ds * 16 + hi * 8) * 2);
      p0 = __builtin_amdgcn_mfma_f32_32x32x16_f16(a0, qf[ds], p0, 0, 0, 0);
      p1 = __builtin_amdgcn_mfma_f32_32x32x16_f16(a1, qf[ds], p1, 0, 0, 0);
    }
    float mx = p0[0];
#pragma unroll
    for (int r = 1; r < 16; ++r) mx = fmaxf(mx, p0[r]);
#pragma unroll
    for (int r = 0; r < 16; ++r) mx = fmaxf(mx, p1[r]);
    mx = fmaxf(mx, __shfl_xor(mx, 32));
    const float mnew = fmaxf(m_run, mx);
    const float alpha = __builtin_amdgcn_exp2f(m_run - mnew);
    m_run = mnew;
    float rsum = 0.f;
#pragma unroll
    for (int r = 0; r < 16; ++r) { p0[r] = __builtin_amdgcn_exp2f(p0[r] - mnew); rsum += p0[r]; }
#pragma unroll
    for (int r = 0; r < 16; ++r) { p1[r] = __builtin_amdgcn_exp2f(p1[r] - mnew); rsum += p1[r]; }
    l_run = l_run * alpha + rsum;
#pragma unroll
    for (int r = 0; r < 16; ++r) { o0[r] *= alpha; o1[r] *= alpha; }
#pragma unroll
    for (int kb = 0; kb < 2; ++kb)
#pragma unroll
      for (int s = 0; s < 2; ++s) {
        h16x8 pf;
#pragma unroll
        for (int e = 0; e < 8; ++e) pf[e] = (h16)(kb ? p1[8 * s + e] : p0[8 * s + e]);
        const int koff = (32 * kb + 16 * s + 4 * hi) * 2;
        {
          const h16x4 lo = *reinterpret_cast<const h16x4*>(vs + r32 * 136 + koff), hh = *reinterpret_cast<const h16x4*>(vs + r32 * 136 + koff + 16);
          const h16x8 af = __builtin_shufflevector(lo, hh, 0, 1, 2, 3, 4, 5, 6, 7);
          o0 = __builtin_amdgcn_mfma_f32_32x32x16_f16(af, pf, o0, 0, 0, 0);
        }
        {
          const h16x4 lo = *reinterpret_cast<const h16x4*>(vs + (32 + r32) * 136 + koff), hh = *reinterpret_cast<const h16x4*>(vs + (32 + r32) * 136 + koff + 16);
          const h16x8 af = __builtin_shufflevector(lo, hh, 0, 1, 2, 3, 4, 5, 6, 7);
          o1 = __builtin_amdgcn_mfma_f32_32x32x16_f16(af, pf, o1, 0, 0, 0);
        }
      }
    if (j + 1 < ntiles) swrite((j + 1) & 1);
    __syncthreads();
  }
  const float lt = l_run + __shfl_xor(l_run, 32);
  const float inv = 1.f / lt;
  const int b = bh >> 3, hd = bh & 7; const int q = q0 + wid * 32 + r32;
  const long tok = q < SEQ ? (long)b * SEQ + q : (long)TLAT + b * CTXL + (q - SEQ);
  h16* yr = reinterpret_cast<h16*>(P.ws + OFF_YMLA) + tok * 512 + hd * 64;
#pragma unroll
  for (int g = 0; g < 4; ++g) {
    h16x4 a, c;
#pragma unroll
    for (int e = 0; e < 4; ++e) { a[e] = (h16)(o0[4 * g + e] * inv); c[e] = (h16)(o1[4 * g + e] * inv); }
    *reinterpret_cast<h16x4*>(yr + 8 * g + 4 * hi) = a;
    *reinterpret_cast<h16x4*>(yr + 32 + 8 * g + 4 * hi) = c;
  }
}
DI void item_s5_pass3(const Params& P, int layer, int b, int g, int ck, char* smem) {
  const int lane = tidx() & 63, wid = tidx() >> 6, fr = lane & 15, fq = lane >> 4;
  float* us = reinterpret_cast<float*>(smem + wid * 12800); char* Hs = smem + wid * 12800 + 4096;
  const int tokbase = ck < 4 ? TLAT + b * CTXL + ck * 64 : b * SEQ + (ck - 4) * 64;
  s5_stage_u(reinterpret_cast<const h16*>(P.ws + OFF_U), tokbase, g, us);
  __syncthreads();
  f32x4 yacc[4];
#pragma unroll
  for (int i = 0; i < 4; ++i) yacc[i] = f32x4{0.f, 0.f, 0.f, 0.f};
#pragma unroll
  for (int dir = 0; dir < 2; ++dir) {
    const long gi = (long)(layer * 2 + dir) * 24 + g;
    const float2 a = reinterpret_cast<const float2*>(P.ws + OFF_S5A)[gi * 64 + lane];
    const float2 a64 = reinterpret_cast<const float2*>(P.ws + OFF_S5A64)[gi * 64 + lane];
    const float2* Bb = reinterpret_cast<const float2*>(P.ws + OFF_S5B) + (gi * 64 + lane) * 16;
    float bre[16], bim[16];
#pragma unroll
    for (int c = 0; c < 16; ++c) { const float2 v = Bb[c]; bre[c] = v.x; bim[c] = v.y; }
    const int si = ck < 4 ? (dir ? 3 - ck : ck) : 4 + (dir ? 127 - (ck - 4) : ck - 4);
    const float2* Ep = reinterpret_cast<const float2*>(P.ws + OFF_E) + ((long)((b * 2 + dir) * 24 + g) * 132) * 64 + lane;
    float hr = 0.f, hi = 0.f;
#pragma unroll 16
    for (int i = 0; i < si; ++i) { const float2 e = Ep[(long)i * 64]; const float nr = a64.x * hr - a64.y * hi + e.x, ni = a64.x * hi + a64.y * hr + e.y; hr = nr; hi = ni; }
    const h16* Ct = reinterpret_cast<const h16*>(P.ws + OFF_S5C) + gi * 16 * 128 + fr * 128 + fq * 8;
    h16x8 cf[4];
#pragma unroll
    for (int ks = 0; ks < 4; ++ks) cf[ks] = *reinterpret_cast<const h16x8*>(Ct + ks * 32);
#pragma unroll
    for (int half = 0; half < 2; ++half) {
#pragma unroll 4
      for (int s = 0; s < 32; ++s) {
        const int step = half * 32 + s; const int tau = dir ? 63 - step : step;
        const float4* up = reinterpret_cast<const float4*>(us + tau * 16);
        float br = 0.f, bi = 0.f;
#pragma unroll
        for (int q = 0; q < 4; ++q) { const float4 u = up[q];
          br += bre[q * 4] * u.x + bre[q * 4 + 1] * u.y + bre[q * 4 + 2] * u.z + bre[q * 4 + 3] * u.w;
          bi += bim[q * 4] * u.x + bim[q * 4 + 1] * u.y + bim[q * 4 + 2] * u.z + bim[q * 4 + 3] * u.w; }
        const float nr = a.x * hr - a.y * hi + br, ni = a.x * hi + a.y * hr + bi; hr = nr; hi = ni;
        h16* hrow = reinterpret_cast<h16*>(Hs + (tau & 31) * 272);
        hrow[lane] = (h16)hr; hrow[64 + lane] = (h16)hi;
      }
      __syncthreads();
      const int tb = dir ? 1 - half : half;
#pragma unroll
      for (int sb2 = 0; sb2 < 2; ++sb2)
#pragma unroll
        for (int ks = 0; ks < 4; ++ks) {
          const h16x8 bf = *reinterpret_cast<const h16x8*>(Hs + (sb2 * 16 + fr) * 272 + (ks * 32 + fq * 8) * 2);
          yacc[tb * 2 + sb2] = __builtin_amdgcn_mfma_f32_16x16x32_f16(cf[ks], bf, yacc[tb * 2 + sb2], 0, 0, 0);
        }
      __syncthreads();
    }
  }
  const float* dsk = P.in[I_S5D] + layer * 384 + g * 16 + fq * 4;
  h16* Y = reinterpret_cast<h16*>(P.ws + OFF_YS5PRE);
#pragma unroll
  for (int sbi = 0; sbi < 4; ++sbi) {
    const int tl = sbi * 16 + fr; h16x4 o;
#pragma unroll
    for (int j = 0; j < 4; ++j) o[j] = (h16)geluf_(yacc[sbi][j] + dsk[j] * us[tl * 16 + fq * 4 + j]);
    *reinterpret_cast<h16x4*>(Y + (long)(tokbase + tl) * 384 + g * 16 + fq * 4) = o;
  }
  __syncthreads();
}
DI void phase_mix2(const Params& P, int layer, char* smem) {
  if ((gridDim.x & 7) == 0) {
    const int xcd = blockIdx.x & 7, li = blockIdx.x >> 3, nloc = gridDim.x >> 3;
    for (int k = li; k < 512; k += nloc) item_attn(P, xcd + 8 * (k >> 6), (k & 63) * 128, 0, KEYS / 64, smem);
  } else {
    for (int k = blockIdx.x; k < 4096; k += gridDim.x) item_attn(P, k >> 6, (k & 63) * 128, 0, KEYS / 64, smem);
  }
  const int n_actx = layer == 0 ? 128 : 0;
  const int nck = layer == 0 ? 132 : 128;
  const int n_s5 = NBATCH * 24 * nck / 4;
  for (int it = blockIdx.x; it < n_actx + n_s5; it += gridDim.x) {
    if (it < n_actx) { item_attn(P, it >> 1, SEQ + (it & 1) * 128, SEQ, CTXL / 64, smem); continue; }
    const int w = (it - n_actx) * 4 + (tidx() >> 6);
    const int ck = w % nck + (layer == 0 ? 0 : 4); const int r = w / nck;
    item_s5_pass3(P, layer, r / 24, r % 24, ck, smem);
  }
}
DI void phase_glu(const Params& P, int layer, char* smem) {
  const int tid = tidx(), lane = tid & 63, wid = tid >> 6, wr = wid >> 1, wc = wid & 1, fr = lane & 15, fq = lane >> 4;
  const h16* A = reinterpret_cast<const h16*>(P.ws + OFF_YS5PRE);
  const h16* W = reinterpret_cast<const h16*>(P.ws + OFF_WT) + (long)layer * WT_LAYER + WT_GLU;
  h16* Y = reinterpret_cast<h16*>(P.ws + OFF_YS5);
  const int MT = (layer == 0 ? TT : TLAT) / 128;
  const TileWalk tw = tw_init(MT, 6);
  for (int tile = tw.lb; tile < tw_count(tw); tile += tw.nlb) {
    int mt, nt; tw_decode(tw, tile, mt, nt);
    f32x4 acc[4][4]; acc_zero(acc);
    gemm_kloop(acc, A + (long)mt * 128 * 384, 384, 0, 128, W + (long)nt * 128 * 384, 384, 384, smem, opaque_tid());
#pragma unroll
    for (int m = 0; m < 4; ++m)
#pragma unroll
      for (int np = 0; np < 2; ++np)
#pragma unroll
        for (int j = 0; j < 4; ++j) {
          const int row = mt * 128 + wr * 64 + m * 16 + fq * 4 + j, col = nt * 64 + wc * 32 + np * 16 + fr;
          Y[(long)row * 384 + col] = (h16)(acc[m][2 * np][j] * sigmoidf_(acc[m][2 * np + 1][j]));
        }
  }
}
DI void phase_merge(const Params& P, int layer, char* smem) {
  const h16* H = reinterpret_cast<const h16*>(P.ws + OFF_H1);
  const h16* WL = reinterpret_cast<const h16*>(P.ws + OFF_WT) + (long)layer * WT_LAYER;
  h16* Mg = reinterpret_cast<h16*>(P.ws + OFF_MERGED);
  const int MT = (layer == 0 ? TT : TLAT) / 128;
  const TileWalk tw = tw_init(MT, 8);
  for (int tile = tw.lb; tile < tw_count(tw); tile += tw.nlb) {
    int mt, nt; tw_decode(tw, tile, mt, nt);
    h16* Tmp = reinterpret_cast<h16*>(P.ws + OFF_YS5PRE) + (long)blockIdx.x * 16384;
#pragma unroll 1
    for (int br = 0; br < 3; ++br) {
      const h16* Ab; const h16* Wb; int Kb;
      if (br == 0) { Ab = reinterpret_cast<const h16*>(P.ws + OFF_YHY) + (long)mt * 128 * 384; Wb = WL + WT_BRHY + (long)nt * 128 * 384; Kb = 384; }
      else if (br == 1) { Ab = reinterpret_cast<const h16*>(P.ws + OFF_YS5) + (long)mt * 128 * 384; Wb = WL + WT_BRS5 + (long)nt * 128 * 384; Kb = 384; }
      else { Ab = reinterpret_cast<const h16*>(P.ws + OFF_YMLA) + (long)mt * 128 * 512; Wb = WL + WT_BRMLA + (long)nt * 128 * 512; Kb = 512; }
      {
        f32x4 acc[4][4]; acc_zero(acc);
        gemm_kloop(acc, Ab, Kb, 0, 128, Wb, Kb, Kb, smem, opaque_tid());
        const int tid = tidx();
#pragma unroll
        for (int m = 0; m < 4; ++m)
#pragma unroll
          for (int n = 0; n < 4; ++n) {
            h16x4 o; o[0] = (h16)acc[m][n][0]; o[1] = (h16)acc[m][n][1]; o[2] = (h16)acc[m][n][2]; o[3] = (h16)acc[m][n][3];
            *reinterpret_cast<h16x4*>(Tmp + ((m * 4 + n) * 256 + tid) * 4) = o;
          }
      }
      f32x4 acc[4][4]; acc_zero(acc);
      gemm_kloop(acc, H + (long)mt * 128 * LD1, LD1, 0, 128, WL + WT_WGATE + (long)(br * 1024 + nt * 128) * LD1, LD1, 1024, smem, opaque_tid());
      const int tid = tidx(), lane = tid & 63, wid = tid >> 6, wr = wid >> 1, wc = wid & 1, fr = lane & 15, fq = lane >> 4;
#pragma unroll
      for (int m = 0; m < 4; ++m)
#pragma unroll
        for (int n = 0; n < 4; ++n) {
          const h16x4 bv = *reinterpret_cast<const h16x4*>(Tmp + ((m * 4 + n) * 256 + tid) * 4);
#pragma unroll
          for (int j = 0; j < 4; ++j) {
            h16* dst = Mg + (long)(mt * 128 + wr * 64 + m * 16 + fq * 4 + j) * LD1 + nt * 128 + wc * 64 + n * 16 + fr;
            const float prev = br == 0 ? 0.f : (float)*dst;
            *dst = (h16)(prev + sigmoidf_(acc[m][n][j]) * (float)bv[j]);
          }
          __builtin_amdgcn_sched_barrier(0);
        }
    }
  }
}
DI void phase_resid(const Params& P, int layer, int stage_src, size_t a_off, int K, long w_off, int gate_idx, char* smem) {
  const int tid = tidx(), lane = tid & 63, wid = tid >> 6, wr = wid >> 1, wc = wid & 1, fr = lane & 15, fq = lane >> 4;
  const h16* A = reinterpret_cast<const h16*>(P.ws + a_off);
  const h16* W = reinterpret_cast<const h16*>(P.ws + OFF_WT) + (long)layer * WT_LAYER + w_off;
  const float* mod = reinterpret_cast<const float*>(P.ws + OFF_MOD) + (long)layer * 9 * 6144 + gate_idx * 1024;
  const int MT = (layer == 0 ? TT : TLAT) / 128;
  const TileWalk tw = tw_init(MT, 8);
  for (int tile = tw.lb; tile < tw_count(tw); tile += tw.nlb) {
    int mt, nt; tw_decode(tw, tile, mt, nt);
    f32x4 acc[4][4]; acc_zero(acc);
    const int ld = K == 1024 ? LD1 : LD2;
    gemm_kloop(acc, A + (long)mt * 128 * ld, ld, 0, 128, W + (long)nt * 128 * ld, ld, K, smem, opaque_tid());
    const Tok tk = tokinfo(mt * 128);
    float* Zs = reinterpret_cast<float*>(smem);
    const int t2 = tidx();
    stage_acc(acc, Zs, t2);
    const int c4 = (t2 & 31) * 4;
    const float4 g4 = *reinterpret_cast<const float4*>(mod + tk.mrow * 6144 + nt * 128 + c4);
#pragma unroll 4
    for (int it = 0; it < 16; ++it) {
      const int row = it * 8 + (t2 >> 5); const int t = mt * 128 + row;
      const float4 a4 = *reinterpret_cast<const float4*>(Zs + row * 132 + c4);
      const float4 x4 = *reinterpret_cast<const float4*>(xrow_src(P, stage_src, t) + nt * 128 + c4);
      *reinterpret_cast<float4*>(xrow_dst(P, t) + nt * 128 + c4) = make_float4(x4.x + g4.x * a4.x, x4.y + g4.y * a4.y, x4.z + g4.z * a4.z, x4.w + g4.w * a4.w);
    }
    __syncthreads();
  }
}
DI void phase_ffn_up(const Params& P, int layer, char* smem) {
  const int tid = tidx(), lane = tid & 63, wid = tid >> 6, wr = wid >> 1, wc = wid & 1, fr = lane & 15, fq = lane >> 4;
  const h16* H = reinterpret_cast<const h16*>(P.ws + OFF_H2);
  const h16* W = reinterpret_cast<const h16*>(P.ws + OFF_WT) + (long)layer * WT_LAYER + WT_UP;
  h16* F = reinterpret_cast<h16*>(P.ws + OFF_F);
  const float* cw = P.in[I_FCW] + (long)layer * 3 * 5632; const float* cb = P.in[I_FCB] + (long)layer * 5632;
  float* Zs = reinterpret_cast<float*>(smem);
  const int n_mt = 8 * 66 + (layer == 0 ? 8 * 3 : 0);
  const TileWalk tw = tw_init(n_mt, 44);
  for (int tile = tw.lb; tile < tw_count(tw); tile += tw.nlb) {
    int mi, nt; tw_decode(tw, tile, mi, nt);
    int seq0, Ls, ti;
    if (mi < 528) { seq0 = (mi / 66) * SEQ; Ls = SEQ; ti = mi % 66; } else { const int u = mi - 528; seq0 = TLAT + (u / 3) * CTXL; Ls = CTXL; ti = u % 3; }
    const int p0 = ti * 126 - 1;
    const int a_lo = ti == 0 ? 1 : 0, a_hi = min(128, Ls - p0);
    const int nout = min(126, Ls - ti * 126);
    f32x4 acc[4][4]; acc_zero(acc);
    gemm_kloop(acc, H + ((long)seq0 + p0) * LD1, LD1, a_lo, a_hi, W + (long)nt * 128 * LD1, LD1, 1024, smem, opaque_tid());
#pragma unroll
    for (int m = 0; m < 4; ++m)
#pragma unroll
      for (int n = 0; n < 4; ++n)
#pragma unroll
        for (int j = 0; j < 4; ++j) Zs[(wr * 64 + m * 16 + fq * 4 + j) * 132 + wc * 64 + n * 16 + fr] = acc[m][n][j];
    __syncthreads();
    {
      const int jc = tid & 63, rg = tid >> 6;
      const int ucol = (jc >> 5) * 64 + ((jc >> 4) & 1) * 32 + (jc & 15), gcol = ucol + 16;
      const int cu = nt * 64 + jc, cg = 2816 + cu;
      const float wu0 = cw[cu], wu1 = cw[5632 + cu], wu2 = cw[2 * 5632 + cu], bu = cb[cu];
      const float wg0 = cw[cg], wg1 = cw[5632 + cg], wg2 = cw[2 * 5632 + cg], bg = cb[cg];
      for (int r = 1 + rg; r <= nout; r += 4) {
        const float au = wu0 * Zs[(r - 1) * 132 + ucol] + wu1 * Zs[r * 132 + ucol] + wu2 * Zs[(r + 1) * 132 + ucol] + bu;
        const float ag = wg0 * Zs[(r - 1) * 132 + gcol] + wg1 * Zs[r * 132 + gcol] + wg2 * Zs[(r + 1) * 132 + gcol] + bg;
        F[((long)seq0 + p0 + r) * LD2 + cu] = (h16)(siluf_(au) * ag);
      }
    }
    __syncthreads();
  }
}
DI void phase_norm2(const Params& P, int layer) { normmod_rows(P, layer, 1, 1, layer == 0 ? TT : TLAT, blockIdx.x, gridDim.x); }

constexpr int N_PHASES = 22;
#ifndef PROBE_REPEAT
#define PROBE_REPEAT 0u
#endif
template <int PH> DI void run_phase_t(const Params& P, char* smem) {
  asm volatile("" ::: "memory");
  if constexpr (PH == 0) phase_prologue(P, smem);
  else if constexpr (PH == 21) phase_final(P);
  else {
    constexpr int layer = (PH - 1) / 10, s = (PH - 1) % 10;
    if constexpr (s == 0) phase_norm1(P, layer, smem);
    else if constexpr (s == 1) phase_gemm_in(P, layer, smem);
    else if constexpr (s == 2) phase_mix1(P, layer, smem);
    else if constexpr (s == 3) phase_mix2(P, layer, smem);
    else if constexpr (s == 4) phase_glu(P, layer, smem);
    else if constexpr (s == 5) phase_merge(P, layer, smem);
    else if constexpr (s == 6) phase_resid(P, layer, layer, OFF_MERGED, 1024, WT_WO, 2, smem);
    else if constexpr (s == 7) phase_norm2(P, layer);
    else if constexpr (s == 8) phase_ffn_up(P, layer, smem);
    else phase_resid(P, layer, 1, OFF_F, 2816, WT_DOWN, 5, smem);
  }
}
DI void run_phase(const Params& P, int ph, char* smem) {
  switch (ph) {
#define RP(i) case i: run_phase_t<i>(P, smem); break;
    RP(0) RP(1) RP(2) RP(3) RP(4) RP(5) RP(6) RP(7) RP(8) RP(9) RP(10) RP(11) RP(12) RP(13) RP(14) RP(15) RP(16) RP(17) RP(18) RP(19) RP(20) RP(21)
#undef RP
    default: break;
  }
}
#ifndef MULTI_LAUNCH
#define MULTI_LAUNCH 0
#endif
__global__ void __launch_bounds__(NTHREADS, 2) fwd_megakernel(Params P) {
  extern __shared__ __attribute__((aligned(16))) char smem[];
  cg::grid_group grid = cg::this_grid();
#define RP(i) run_phase_t<i>(P, smem); grid.sync(); if constexpr ((PROBE_REPEAT >> i) & 1) { run_phase_t<i>(P, smem); grid.sync(); }
  RP(0) RP(1) RP(2) RP(3) RP(4) RP(5) RP(6) RP(7) RP(8) RP(9) RP(10) RP(11) RP(12) RP(13) RP(14) RP(15) RP(16) RP(17) RP(18) RP(19) RP(20)
#undef RP
  run_phase_t<21>(P, smem);
}
#if MULTI_LAUNCH
__global__ void __launch_bounds__(NTHREADS, 2) fwd_phase_kernel(Params P, int ph) {
  extern __shared__ __attribute__((aligned(16))) char smem[];
  run_phase(P, ph, smem);
}
#endif

extern "C" void kernel_launch(void* const* d_in, const int* in_sizes, int n_in, void* d_out, int out_size, void* d_ws, size_t ws_size,
                              hipStream_t stream) {
  static int grid_blocks = 0;
  if (!grid_blocks) {
    int dev = 0, cus = 0, per_cu = 0;
    (void)hipGetDevice(&dev);
    (void)hipDeviceGetAttribute(&cus, hipDeviceAttributeMultiprocessorCount, dev);
    (void)hipFuncSetAttribute((const void*)fwd_megakernel, hipFuncAttributeMaxDynamicSharedMemorySize, SMEM_BYTES);
#if MULTI_LAUNCH
    (void)hipFuncSetAttribute((const void*)fwd_phase_kernel, hipFuncAttributeMaxDynamicSharedMemorySize, SMEM_BYTES);
#endif
    (void)hipOccupancyMaxActiveBlocksPerMultiprocessor(&per_cu, fwd_megakernel, NTHREADS, SMEM_BYTES);
    if (per_cu > 2) per_cu = 2;
    if (per_cu < 1) per_cu = 1;
#ifdef PROBE_FORCE2
    per_cu = 2;
#endif
    grid_blocks = cus * per_cu;
    if (ws_size < OFF_END) fprintf(stderr, "workspace too small: %zu < %zu\n", ws_size, (size_t)OFF_END);
  }
  Params p{};
  for (int i = 0; i < 41; ++i) p.in[i] = (const float*)d_in[i];
  p.out = (float*)d_out; p.ws = (char*)d_ws; p.pad_ = 0;
#if MULTI_LAUNCH
  for (int ph = 0; ph < N_PHASES; ++ph) hipLaunchKernelGGL(fwd_phase_kernel, dim3(grid_blocks), dim3(NTHREADS), SMEM_BYTES, stream, p, ph);
#else
  void* args[] = {&p};
  hipError_t e = hipLaunchCooperativeKernel((void*)fwd_megakernel, dim3(grid_blocks), dim3(NTHREADS), args, SMEM_BYTES, stream);
  if (e != hipSuccess) fprintf(stderr, "cooperative launch failed: %s (grid %d)\n", hipGetErrorString(e), grid_blocks);
#endif
}
```

```cpp
#include <hip/hip_runtime.h>
#include <hip/hip_cooperative_groups.h>
#include <cstdio>
namespace cg = cooperative_groups;

typedef _Float16 h16;
typedef _Float16 h16x8 __attribute__((ext_vector_type(8)));
typedef _Float16 h16x4 __attribute__((ext_vector_type(4)));
typedef float f32x4 __attribute__((ext_vector_type(4)));
typedef float f32x16 __attribute__((ext_vector_type(16)));
#define DI __device__ __forceinline__

constexpr int DM = 1024, NBATCH = 8, SEQ = 8192, CTXL = 256, TLAT = 65536, TCTX = 2048, TT = 67584;
constexpr int KEYS = SEQ + CTXL;
constexpr int NTHREADS = 256;
constexpr float EPS = 1e-6f;
constexpr float QSCALE = 0.10206207261596575f * 1.4426950408889634f;

constexpr int LD1 = 1088, LD2 = 2880;
constexpr long WT_WIN = 0, WT_WGATE = WT_WIN + 2432L * LD1, WT_UKV = WT_WGATE + 3072L * LD1, WT_UQ = WT_UKV + 1024L * 256,
               WT_GLU = WT_UQ + 1024L * 512, WT_BRHY = WT_GLU + 768L * 384, WT_BRS5 = WT_BRHY + 1024L * 384,
               WT_BRMLA = WT_BRS5 + 1024L * 384, WT_WO = WT_BRMLA + 1024L * 512, WT_UP = WT_WO + 1024L * LD1,
               WT_DOWN = WT_UP + 5632L * LD1, WT_LAYER = WT_DOWN + 1024L * LD2;
constexpr size_t al256(size_t x) { return (x + 255) / 256 * 256; }
constexpr size_t OFF_WT = 0;
constexpr size_t OFF_H1 = al256(OFF_WT + 2 * WT_LAYER * 2);
constexpr size_t OFF_U = al256(OFF_H1 + (size_t)TT * LD1 * 2);
constexpr size_t OFF_KVLAT = al256(OFF_U + (size_t)TT * 384 * 2);
constexpr size_t OFF_QLAT = al256(OFF_KVLAT + (size_t)TT * 256 * 2);
constexpr size_t OFF_PHY = al256(OFF_QLAT + (size_t)TT * 512 * 2);
constexpr size_t OFF_PHYC = al256(OFF_PHY + (size_t)NBATCH * 1152 * SEQ * 2);
constexpr size_t OFF_Q = al256(OFF_PHYC + (size_t)NBATCH * 1152 * CTXL * 2);
constexpr size_t OFF_K = al256(OFF_Q + (size_t)64 * KEYS * 96 * 2);
constexpr size_t OFF_VT = al256(OFF_K + (size_t)64 * KEYS * 96 * 2);
constexpr size_t OFF_YS5PRE = al256(OFF_VT + (size_t)64 * 64 * KEYS * 2);
constexpr size_t OFF_YHY = al256(OFF_YS5PRE + (size_t)TT * 384 * 2);
constexpr size_t OFF_FILT = al256(OFF_YHY + (size_t)TT * 384 * 2);
constexpr size_t OFF_TAPSC = al256(OFF_FILT + (size_t)768 * 2 * SEQ * 8);
constexpr size_t OFF_E = al256(OFF_TAPSC + (size_t)768 * 2 * CTXL * 4);
constexpr size_t OFF_XC = al256(OFF_E + (size_t)NBATCH * 2 * 24 * 132 * 64 * 8);
constexpr size_t OFF_MOD = al256(OFF_XC + (size_t)TCTX * 1024 * 4);
constexpr size_t OFF_Z2 = al256(OFF_MOD + (size_t)2 * 9 * 6144 * 4);
constexpr size_t OFF_Z2C = al256(OFF_Z2 + (size_t)2 * SEQ * 64 * 4);
constexpr size_t OFF_S5A = al256(OFF_Z2C + (size_t)2 * CTXL * 64 * 4);
constexpr size_t OFF_S5A64 = al256(OFF_S5A + (size_t)2 * 2 * 24 * 64 * 8);
constexpr size_t OFF_S5B = al256(OFF_S5A64 + (size_t)2 * 2 * 24 * 64 * 8);
constexpr size_t OFF_S5C = al256(OFF_S5B + (size_t)2 * 2 * 24 * 64 * 16 * 8);
constexpr size_t OFF_ROPE = al256(OFF_S5C + (size_t)2 * 2 * 24 * 16 * 128 * 2);
constexpr size_t OFF_END = al256(OFF_ROPE + (size_t)SEQ * 16 * 8);
constexpr size_t OFF_YS5 = OFF_U, OFF_YMLA = OFF_QLAT, OFF_MERGED = OFF_Q, OFF_F = OFF_U, OFF_H2 = OFF_H1;
static_assert(OFF_END <= (size_t)1024 * 1024 * 1024, "workspace over 1 GiB");
static_assert(OFF_F + (size_t)TT * LD2 * 2 <= OFF_FILT, "f alias overruns");
static_assert(OFF_MERGED + (size_t)TT * LD1 * 2 <= OFF_VT, "merged alias overruns");

constexpr int SMEM_BYTES = 73728 + 2048;

struct Params {
  const float* in[41];
  float* out;
  char* ws;
  unsigned long long pad_;
};
enum { I_X = 0, I_C, I_CTX, I_CCTX, I_WMOD, I_BMOD, I_N1G, I_N2G, I_WIN, I_HCW, I_HCB, I_FW1, I_FB1, I_FW2, I_FB2, I_FW3, I_FFREQ,
       I_FDECAY, I_HBIAS, I_LAMRE, I_LAMIM, I_LOGSTEP, I_BRE, I_BIM, I_CRE, I_CIM, I_S5D, I_WGLU, I_GQ, I_WUQ, I_GKV, I_WUKV,
       I_WBRHY, I_WBRS5, I_WBRMLA, I_WO, I_WUP, I_FCW, I_FCB, I_WDOWN, I_FINALG };

DI int tidx() { int t = threadIdx.x; asm volatile("" : "+v"(t)); return t; }
DI int opaque_tid() { return tidx(); }
DI float sigmoidf_(float x) { return 1.f / (1.f + __expf(-x)); }
DI float siluf_(float x) { return x / (1.f + __expf(-x)); }
DI float geluf_(float x) { float z = 0.7978845608028654f * (x + 0.044715f * x * x * x); float t = 1.f - 2.f / (1.f + __expf(2.f * z)); return 0.5f * x * (1.f + t); }
DI float wave_sum(float v) { for (int o = 32; o > 0; o >>= 1) v += __shfl_xor(v, o); return v; }
DI float wave_max(float v) { for (int o = 32; o > 0; o >>= 1) v = fmaxf(v, __shfl_xor(v, o)); return v; }
DI void dsincos(double x, double& s, double& c) {
  const double TWO_PI = 6.283185307179586476925287;
  double r = x - TWO_PI * rint(x / TWO_PI);
  double r2 = r * r, ts = r, tc = 1.0; s = r; c = 1.0;
  for (int k = 1; k <= 15; ++k) { tc = -tc * r2 / (double)((2 * k - 1) * (2 * k)); c += tc; ts = -ts * r2 / (double)((2 * k) * (2 * k + 1)); s += ts; }
}
DI float2 twid(float f) { return make_float2(__builtin_amdgcn_cosf(f), __builtin_amdgcn_sinf(f)); }
DI float2 cmul(float2 a, float2 b) { return make_float2(a.x * b.x - a.y * b.y, a.x * b.y + a.y * b.x); }

struct Tok { int b, pos, ctx, mrow; };
DI Tok tokinfo(int t) { Tok k; if (t < TLAT) { k.b = t >> 13; k.pos = t & 8191; k.ctx = 0; k.mrow = k.b; } else { int u = t - TLAT; k.b = u >> 8; k.pos = u & 255; k.ctx = 1; k.mrow = 8; } return k; }

struct Stg { uint4 a0, a1, a2, a3, b0, b1, b2, b3; };
DI void g_load(Stg& s, const h16* __restrict__ A0, const h16* __restrict__ A1, const h16* __restrict__ A2, const h16* __restrict__ A3,
               const h16* __restrict__ Bp, long b32, int k0) {
  s.a0 = *reinterpret_cast<const uint4*>(A0 + k0); s.a1 = *reinterpret_cast<const uint4*>(A1 + k0);
  s.a2 = *reinterpret_cast<const uint4*>(A2 + k0); s.a3 = *reinterpret_cast<const uint4*>(A3 + k0);
  s.b0 = *reinterpret_cast<const uint4*>(Bp + k0); s.b1 = *reinterpret_cast<const uint4*>(Bp + b32 + k0);
  s.b2 = *reinterpret_cast<const uint4*>(Bp + 2 * b32 + k0); s.b3 = *reinterpret_cast<const uint4*>(Bp + 3 * b32 + k0);
}
DI uint4 zsel(uint4 v, bool ok) { return ok ? v : make_uint4(0, 0, 0, 0); }
DI void s_write(char* sw, const Stg& s, int okm) {
  *reinterpret_cast<uint4*>(sw) = zsel(s.a0, okm & 1); *reinterpret_cast<uint4*>(sw + 32 * 128) = zsel(s.a1, okm & 2);
  *reinterpret_cast<uint4*>(sw + 64 * 128) = zsel(s.a2, okm & 4); *reinterpret_cast<uint4*>(sw + 96 * 128) = zsel(s.a3, okm & 8);
  *reinterpret_cast<uint4*>(sw + 16384) = s.b0; *reinterpret_cast<uint4*>(sw + 16384 + 32 * 128) = s.b1; *reinterpret_cast<uint4*>(sw + 16384 + 64 * 128) = s.b2; *reinterpret_cast<uint4*>(sw + 16384 + 96 * 128) = s.b3;
}
#ifndef PROBE_MFMA
#define PROBE_MFMA 0
#endif
#if PROBE_MFMA
DI void mma_step(f32x4 (&acc)[4][4], const char* sa, const char* sb, int o0, int o1, f32x4 (&dmy)[2][4]) {
#else
DI void mma_step(f32x4 (&acc)[4][4], const char* sa, const char* sb, int o0, int o1) {
#endif
#pragma unroll
  for (int ks = 0; ks < 2; ++ks) {
    h16x8 af[4], bf[4];
    const int o = ks ? o1 : o0;
#pragma unroll
    for (int m = 0; m < 4; ++m) af[m] = *reinterpret_cast<const h16x8*>(sa + m * 16 * 128 + o);
#pragma unroll
    for (int n = 0; n < 4; ++n) bf[n] = *reinterpret_cast<const h16x8*>(sb + n * 16 * 128 + o);
#pragma unroll
    for (int m = 0; m < 4; ++m)
#pragma unroll
      for (int n = 0; n < 4; ++n) acc[m][n] = __builtin_amdgcn_mfma_f32_16x16x32_f16(af[m], bf[n], acc[m][n], 0, 0, 0);
#if PROBE_MFMA
#pragma unroll
    for (int m = 0; m < 2; ++m)
#pragma unroll
      for (int n = 0; n < 4; ++n) dmy[m][n] = __builtin_amdgcn_mfma_f32_16x16x32_f16(af[m + 2], bf[n], dmy[m][n], 0, 0, 0);
#endif
  }
}
DI void gemm_kloop_body(f32x4 (&acc)[4][4], const h16* __restrict__ A, long lda, int a_lo, int a_hi,
                   const h16* __restrict__ Bt, long ldb, int K, char* smem, int tid) {
  const int lane = tid & 63, wid = tid >> 6, wr = wid >> 1, wc = wid & 1, fr = lane & 15, fq = lane >> 4;
#if PROBE_MFMA
  f32x4 dmy[2][4];
  for (int m = 0; m < 2; ++m) for (int n = 0; n < 4; ++n) dmy[m][n] = f32x4{0.f, 0.f, 0.f, 0.f};
#define MMA(a, b, c, d, e) mma_step(a, b, c, d, e, dmy)
#else
#define MMA(a, b, c, d, e) mma_step(a, b, c, d, e)
#endif
  Stg s0, s1;
  const int srow = tid >> 3, skc = tid & 7;
  int okm = 0;
  const h16* Ar[4];
#pragma unroll
  for (int i = 0; i < 4; ++i) { const int row = srow + 32 * i; const bool ok = row >= a_lo && row < a_hi; okm |= ok ? (1 << i) : 0;
    const int rc = min(max(row, a_lo), a_hi - 1); Ar[i] = A + (long)rc * lda + skc * 8; }
  const h16* Bp = Bt + (long)srow * ldb + skc * 8;
  const long b32 = 32 * ldb;
  char* sw = smem + srow * 128 + ((skc ^ ((srow >> 1) & 7)) << 4);
  const char* sra = smem + (wr * 64 + fr) * 128; const char* srb = smem + 16384 + (wc * 64 + fr) * 128;
  const int o0 = (fq ^ ((fr >> 1) & 7)) << 4, o1 = ((4 + fq) ^ ((fr >> 1) & 7)) << 4;
  const int nk = K >> 6;
  g_load(s0, Ar[0], Ar[1], Ar[2], Ar[3], Bp, b32, 0); g_load(s1, Ar[0], Ar[1], Ar[2], Ar[3], Bp, b32, 64);
  s_write(sw, s0, okm); __syncthreads();
  for (int kt = 0; kt + 2 < nk; kt += 2) {
    g_load(s0, Ar[0], Ar[1], Ar[2], Ar[3], Bp, b32, (kt + 2) << 6);
    __builtin_amdgcn_sched_barrier(0);
    MMA(acc, sra, srb, o0, o1);
    __builtin_amdgcn_sched_barrier(0);
    s_write(sw + 32768, s1, okm);
    __syncthreads();
    g_load(s1, Ar[0], Ar[1], Ar[2], Ar[3], Bp, b32, (kt + 3) << 6);
    __builtin_amdgcn_sched_barrier(0);
    MMA(acc, sra + 32768, srb + 32768, o0, o1);
    __builtin_amdgcn_sched_barrier(0);
    s_write(sw, s0, okm);
    __syncthreads();
  }
  MMA(acc, sra, srb, o0, o1);
  s_write(sw + 32768, s1, okm);
  __syncthreads();
  MMA(acc, sra + 32768, srb + 32768, o0, o1);
  __syncthreads();
#if PROBE_MFMA
  { float z = 0.f; asm volatile("" : "+v"(z)); for (int m = 0; m < 2; ++m) for (int n = 0; n < 4; ++n) acc[m][n] += dmy[m][n] * z; }
#endif
#undef MMA
}
#ifndef PROBE_KLOOP
#define PROBE_KLOOP 0
#endif
DI void gemm_kloop(f32x4 (&acc)[4][4], const h16* __restrict__ A, long lda, int a_lo, int a_hi,
                   const h16* __restrict__ Bt, long ldb, int K, char* smem, int tid) {
  gemm_kloop_body(acc, A, lda, a_lo, a_hi, Bt, ldb, K, smem, tid);
}
struct TileWalk { int lb, nlb, m0, Mx, NT, nfull; };
DI TileWalk tw_init(int MT, int NT) { TileWalk w; w.lb = blockIdx.x >> 3; w.nlb = gridDim.x >> 3; w.Mx = MT >> 3; w.m0 = (blockIdx.x & 7) * w.Mx; w.NT = NT; w.nfull = (w.Mx >> 3) * 8 * NT; return w; }
DI int tw_count(const TileWalk& w) { return w.Mx * w.NT; }
DI void tw_decode(const TileWalk& w, int idx, int& mt, int& nt) {
  if (idx < w.nfull) { const int mg = idx / (8 * w.NT), r = idx % (8 * w.NT); nt = r >> 3; mt = w.m0 + mg * 8 + (r & 7); }
  else { const int rem = w.Mx & 7, r = idx - w.nfull; nt = r / rem; mt = w.m0 + (w.Mx & ~7) + r % rem; }
}
DI void stage_acc(const f32x4 (&acc)[4][4], float* Zs, int tid) {
  const int lane = tid & 63, wid = tid >> 6, wr = wid >> 1, wc = wid & 1, fr = lane & 15, fq = lane >> 4;
#pragma unroll
  for (int m = 0; m < 4; ++m)
#pragma unroll
    for (int n = 0; n < 4; ++n)
#pragma unroll
      for (int j = 0; j < 4; ++j) Zs[(wr * 64 + m * 16 + fq * 4 + j) * 132 + wc * 64 + n * 16 + fr] = acc[m][n][j];
  __syncthreads();
}
DI void stage_acc_t(const f32x4 (&acc)[4][4], float* Zs, int tid) {
  const int lane = tid & 63, wid = tid >> 6, wr = wid >> 1, wc = wid & 1, fr = lane & 15, fq = lane >> 4;
#pragma unroll
  for (int m = 0; m < 4; ++m)
#pragma unroll
    for (int n = 0; n < 4; ++n)
      *reinterpret_cast<float4*>(Zs + (wc * 64 + n * 16 + fr) * 132 + wr * 64 + m * 16 + fq * 4) = make_float4(acc[m][n][0], acc[m][n][1], acc[m][n][2], acc[m][n][3]);
  __syncthreads();
}
DI void copy_out_f16(const float* Zs, h16* __restrict__ dst, long row0, long ld, int cb, int tid) {
#pragma unroll
  for (int it = 0; it < 8; ++it) {
    const int chunk = it * 256 + tid, row = chunk >> 4, c8 = (chunk & 15) * 8;
    const float4 x0 = *reinterpret_cast<const float4*>(Zs + row * 132 + c8), x1 = *reinterpret_cast<const float4*>(Zs + row * 132 + c8 + 4);
    h16x8 o; o[0] = (h16)x0.x; o[1] = (h16)x0.y; o[2] = (h16)x0.z; o[3] = (h16)x0.w; o[4] = (h16)x1.x; o[5] = (h16)x1.y; o[6] = (h16)x1.z; o[7] = (h16)x1.w;
    *reinterpret_cast<h16x8*>(dst + (row0 + row) * ld + cb + c8) = o;
  }
}
DI void acc_zero(f32x4 (&acc)[4][4]) {
#pragma unroll
  for (int m = 0; m < 4; ++m)
#pragma unroll
    for (int n = 0; n < 4; ++n) acc[m][n] = f32x4{0.f, 0.f, 0.f, 0.f};
}
DI void row_rms(const h16* __restrict__ A, long lda, int K, float* rs) {
  const int tid = tidx(), row = tid >> 1, half = tid & 1;
  const h16* p = A + (long)row * lda + half * (K >> 1);
  float ss = 0.f;
  for (int k = 0; k < (K >> 1); k += 8) {
    h16x8 v = *reinterpret_cast<const h16x8*>(p + k);
#pragma unroll
    for (int j = 0; j < 8; ++j) { float f = (float)v[j]; ss += f * f; }
  }
  ss += __shfl_xor(ss, 1);
  if (half == 0) rs[row] = rsqrtf(ss / (float)K + EPS);
}
DI int map_interleave(int n, int half) { int tile = n >> 7, r = n & 127, sub = r >> 4, fr = r & 15; int j = tile * 64 + (sub >> 1) * 16 + fr; return (sub & 1) ? half + j : j; }
DI int map_col(int mat, int n) {
  switch (mat) {
    case 0: if (n < 640) return n; if (n < 2304) return n + 32; if (n < 2336) return n - 2304 + 640; return -1;
    case 1: return 2336 + n;
    case 3: { int h = n >> 7, j = n & 127; return j < 96 ? h * 96 + j : -1; }
    case 4: return map_interleave(n, 384);
    case 9: return map_interleave(n, 2816);
    default: return n;
  }
}
struct MatDesc { const float* src; const float* scale; long dst; int K, Nmy, Nsrc, ld; };
DI MatDesc get_mat(const Params& P, int layer, int mat) {
  MatDesc d; d.scale = nullptr;
  d.ld = (mat == 0 || mat == 1 || mat == 8 || mat == 9) ? LD1 : 0;
  switch (mat) {
    case 0: d.src = P.in[I_WIN] + (long)layer * 1024 * 5408; d.dst = WT_WIN; d.K = 1024; d.Nmy = 2432; d.Nsrc = 5408; break;
    case 1: d.src = P.in[I_WIN] + (long)layer * 1024 * 5408; d.dst = WT_WGATE; d.K = 1024; d.Nmy = 3072; d.Nsrc = 5408; break;
    case 2: d.src = P.in[I_WUKV] + (long)layer * 256 * 1024; d.dst = WT_UKV; d.K = 256; d.Nmy = 1024; d.Nsrc = 1024; d.scale = P.in[I_GKV] + layer * 256; break;
    case 3: d.src = P.in[I_WUQ] + (long)layer * 512 * 768; d.dst = WT_UQ; d.K = 512; d.Nmy = 1024; d.Nsrc = 768; d.scale = P.in[I_GQ] + layer * 512; break;
    case 4: d.src = P.in[I_WGLU] + (long)layer * 384 * 768; d.dst = WT_GLU; d.K = 384; d.Nmy = 768; d.Nsrc = 768; break;
    case 5: d.src = P.in[I_WBRHY] + (long)layer * 384 * 1024; d.dst = WT_BRHY; d.K = 384; d.Nmy = 1024; d.Nsrc = 1024; break;
    case 6: d.src = P.in[I_WBRS5] + (long)layer * 384 * 1024; d.dst = WT_BRS5; d.K = 384; d.Nmy = 1024; d.Nsrc = 1024; break;
    case 7: d.src = P.in[I_WBRMLA] + (long)layer * 512 * 1024; d.dst = WT_BRMLA; d.K = 512; d.Nmy = 1024; d.Nsrc = 1024; break;
    case 8: d.src = P.in[I_WO] + (long)layer * 1024 * 1024; d.dst = WT_WO; d.K = 1024; d.Nmy = 1024; d.Nsrc = 1024; break;
    case 9: d.src = P.in[I_WUP] + (long)layer * 1024 * 5632; d.dst = WT_UP; d.K = 1024; d.Nmy = 5632; d.Nsrc = 5632; break;
    default: d.src = P.in[I_WDOWN] + (long)layer * 2816 * 1024; d.dst = WT_DOWN; d.K = 2816; d.Nmy = 1024; d.Nsrc = 1024; d.ld = LD2; break;
  }
  if (d.ld == 0) d.ld = d.K;
  return d;
}
constexpr int WT_TILES_PER_LAYER = 608 + 768 + 64 + 128 + 72 + 96 + 96 + 128 + 256 + 1408 + 704;
DI void item_wt(const Params& P, int item, char* smem) {
  const int layer = item / WT_TILES_PER_LAYER; int r = item % WT_TILES_PER_LAYER;
  const int cnt[11] = {608, 768, 64, 128, 72, 96, 96, 128, 256, 1408, 704};
  int mat = 0;
#pragma unroll
  for (int i = 0; i < 10; ++i) { if (mat == i && r >= cnt[i]) { r -= cnt[i]; mat = i + 1; } }
  MatDesc d = get_mat(P, layer, mat);
  const int kt = d.K >> 6, n0 = (r / kt) * 64, k0 = (r % kt) * 64;
  float* tile = reinterpret_cast<float*>(smem);
  h16* dst = reinterpret_cast<h16*>(P.ws + OFF_WT) + (long)layer * WT_LAYER + d.dst;
  const int tid = tidx(), lx = tid & 63, ly = tid >> 6;
  const int sc = map_col(mat, n0 + lx);
#pragma unroll 4
  for (int i = 0; i < 16; ++i) { int kk = i * 4 + ly; tile[kk * 65 + lx] = sc >= 0 ? d.src[(long)(k0 + kk) * d.Nsrc + sc] : 0.f; }
  __syncthreads();
  const float s = d.scale ? d.scale[k0 + lx] : 1.f;
#pragma unroll 4
  for (int i = 0; i < 16; ++i) { int nn = i * 4 + ly; dst[(long)(n0 + nn) * d.ld + k0 + lx] = (h16)(tile[lx * 65 + nn] * s); }
  __syncthreads();
}
DI void item_mod(const Params& P, int item, char* smem) {
  const int layer = item / 96, n0 = (item % 96) * 64;
  float* s = reinterpret_cast<float*>(smem);
  float* part = s + 9 * 1024;
  const int tid = tidx(), lane = tid & 63, wid = tid >> 6;
  for (int i = tid; i < 9 * 1024; i += NTHREADS) { float v = i < 8192 ? P.in[I_C][i] : P.in[I_CCTX][i - 8192]; s[i] = siluf_(v); }
  __syncthreads();
  const float* w = P.in[I_WMOD] + (long)layer * 1024 * 6144 + n0 + lane;
  float acc[9];
#pragma unroll
  for (int r = 0; r < 9; ++r) acc[r] = 0.f;
  for (int k = wid * 256; k < wid * 256 + 256; ++k) {
    const float wv = w[(long)k * 6144];
#pragma unroll
    for (int r = 0; r < 9; ++r) acc[r] += s[r * 1024 + k] * wv;
  }
#pragma unroll
  for (int r = 0; r < 9; ++r) part[(wid * 9 + r) * 64 + lane] = acc[r];
  __syncthreads();
  float* mod = reinterpret_cast<float*>(P.ws + OFF_MOD) + (long)layer * 9 * 6144;
  for (int i = tid; i < 9 * 64; i += NTHREADS) {
    const int r = i >> 6, c = i & 63;
    mod[r * 6144 + n0 + c] = part[(0 * 9 + r) * 64 + c] + part[(1 * 9 + r) * 64 + c] + part[(2 * 9 + r) * 64 + c] + part[(3 * 9 + r) * 64 + c] + P.in[I_BMOD][layer * 6144 + n0 + c];
  }
  __syncthreads();
}
DI void item_hymlp(const Params& P, int item, char* smem) {
  const int layer = item / 132; int r = item % 132;
  const int isc = r >= 128; const int Lf = isc ? CTXL : SEQ; const int t0 = (isc ? r - 128 : r) * 64;
  float* z1 = reinterpret_cast<float*>(smem);
  const int tid = tidx(), tl = tid >> 2, h0 = (tid & 3) * 16; const int t = t0 + tl;
  const float* w1 = P.in[I_FW1] + layer * 17 * 64; const float* b1 = P.in[I_FB1] + layer * 64;
  const float* w2 = P.in[I_FW2] + layer * 64 * 64; const float* b2 = P.in[I_FB2] + layer * 64; const float* fq = P.in[I_FFREQ] + layer * 64;
  float feat[17]; feat[0] = (float)t / (float)Lf;
#pragma unroll
  for (int k = 1; k <= 8; ++k) { float rev = (float)((t * k) % Lf) / (float)Lf; feat[k] = __builtin_amdgcn_cosf(rev); feat[8 + k] = __builtin_amdgcn_sinf(rev); }
#pragma unroll 4
  for (int j = 0; j < 16; ++j) {
    const int h = h0 + j; float a = b1[h];
#pragma unroll
    for (int f = 0; f < 17; ++f) a += feat[f] * w1[f * 64 + h];
    z1[tl * 65 + h] = __sinf(fq[h] * a);
  }
  __syncthreads();
  float* z2 = isc ? reinterpret_cast<float*>(P.ws + OFF_Z2C) + (long)layer * CTXL * 64 : reinterpret_cast<float*>(P.ws + OFF_Z2) + (long)layer * SEQ * 64;
  float a2[16];
#pragma unroll
  for (int j = 0; j < 16; ++j) a2[j] = b2[h0 + j];
  for (int k = 0; k < 64; ++k) {
    const float zv = z1[tl * 65 + k];
#pragma unroll
    for (int j = 0; j < 16; ++j) a2[j] += zv * w2[k * 64 + h0 + j];
  }
#pragma unroll
  for (int j = 0; j < 16; ++j) z2[(long)t * 64 + h0 + j] = __sinf(fq[h0 + j] * a2[j]);
  __syncthreads();
}
DI void item_s5disc(const Params& P, int item) {
  const int layer = item / 12, dir = (item % 12) / 6, gb = item % 6;
  const int tid = tidx(), g = gb * 4 + (tid >> 6), n = tid & 63;
  const int ld = layer * 2 + dir; const long gi = (long)ld * 24 + g;
  const double lre = P.in[I_LAMRE][gi * 64 + n], lim = P.in[I_LAMIM][gi * 64 + n];
  const double step = exp((double)P.in[I_LOGSTEP][gi]);
  double sn, cs; dsincos(lim * step, sn, cs);
  const double mag = exp(lre * step);
  const double are = mag * cs, aim = mag * sn;
  const double nr = are - 1.0, ni = aim, den = lre * lre + lim * lim;
  const double fre = (nr * lre + ni * lim) / den, fim = (ni * lre - nr * lim) / den;
  float2* A = reinterpret_cast<float2*>(P.ws + OFF_S5A); float2* A64 = reinterpret_cast<float2*>(P.ws + OFF_S5A64);
  A[gi * 64 + n] = make_float2((float)are, (float)aim);
  double pr = are, pi = aim;
  for (int i = 0; i < 6; ++i) { double t = pr * pr - pi * pi; pi = 2.0 * pr * pi; pr = t; }
  A64[gi * 64 + n] = make_float2((float)pr, (float)pi);
  float2* Bb = reinterpret_cast<float2*>(P.ws + OFF_S5B) + (gi * 64 + n) * 16;
  const float* bre = P.in[I_BRE] + (gi * 64 + n) * 16; const float* bim = P.in[I_BIM] + (gi * 64 + n) * 16;
  for (int c = 0; c < 16; ++c) { double br = bre[c], bi = bim[c]; Bb[c] = make_float2((float)(fre * br - fim * bi), (float)(fre * bi + fim * br)); }
  h16* Ct = reinterpret_cast<h16*>(P.ws + OFF_S5C) + gi * 16 * 128;
  const float* cre = P.in[I_CRE] + gi * 16 * 64; const float* cim = P.in[I_CIM] + gi * 16 * 64;
  for (int c = 0; c < 16; ++c) { Ct[c * 128 + n] = (h16)cre[c * 64 + n]; Ct[c * 128 + 64 + n] = (h16)(-cim[c * 64 + n]); }
}
DI void item_rope(const Params& P, int item) {
  const int idx = item * NTHREADS + tidx(); const int pos = idx >> 4, i = idx & 15;
  const double inv[8] = {1.0, 0.31622776601683794, 0.1, 0.031622776601683794, 0.01, 0.0031622776601683794, 0.001, 0.00031622776601683794};
  double iv = 1.0;
#pragma unroll
  for (int k = 0; k < 8; ++k) if ((i & 7) == k) iv = inv[k];
  const double ang = (double)(i < 8 ? (pos >> 6) : (pos & 63)) * iv;
  double s, c; dsincos(ang, s, c);
  reinterpret_cast<float2*>(P.ws + OFF_ROPE)[idx] = make_float2((float)c, (float)s);
}
constexpr int PRO_N_WT = 2 * WT_TILES_PER_LAYER, PRO_N_MOD = 192, PRO_N_HY = 264, PRO_N_S5 = 24, PRO_N_ROPE = 512;
DI void phase_prologue(const Params& P, char* smem) {
  const int total = PRO_N_MOD + PRO_N_HY + PRO_N_S5 + PRO_N_ROPE + PRO_N_WT;
  for (int it = blockIdx.x; it < total; it += gridDim.x) {
    int i = it;
    if (i < PRO_N_MOD) { item_mod(P, i, smem); continue; } i -= PRO_N_MOD;
    if (i < PRO_N_HY) { item_hymlp(P, i, smem); continue; } i -= PRO_N_HY;
    if (i < PRO_N_S5) { item_s5disc(P, i); continue; } i -= PRO_N_S5;
    if (i < PRO_N_ROPE) { item_rope(P, i); continue; } i -= PRO_N_ROPE;
    item_wt(P, i, smem);
  }
}

DI const float* xrow_src(const Params& P, int layer_stage, int t) {
  if (t < TLAT) return (layer_stage == 0 ? P.in[I_X] : P.out) + (long)t * 1024;
  return (layer_stage == 0 ? P.in[I_CTX] : reinterpret_cast<const float*>(P.ws + OFF_XC)) + (long)(t - TLAT) * 1024;
}
DI float* xrow_dst(const Params& P, int t) {
  if (t < TLAT) return P.out + (long)t * 1024;
  return reinterpret_cast<float*>(P.ws + OFF_XC) + (long)(t - TLAT) * 1024;
}
DI void normmod_rows(const Params& P, int layer, int which, int stage, int ntok, int item, int nitems_stride) {
  const int tid = tidx(), lane = tid & 63, wid = tid >> 6;
  const float* g = P.in[which ? I_N2G : I_N1G] + layer * 1024;
  const float* mod = reinterpret_cast<const float*>(P.ws + OFF_MOD) + (long)layer * 9 * 6144;
  h16* H = reinterpret_cast<h16*>(P.ws + OFF_H1);
  for (int rg = item; rg * 4 < ntok; rg += nitems_stride) {
    const int t = rg * 4 + wid;
    const Tok k = tokinfo(t);
    const float* xr = xrow_src(P, stage, t);
    const float* sh = mod + k.mrow * 6144 + (which ? 3 : 0) * 1024; const float* sc = sh + 1024;
    float4 v[4]; float ss = 0.f;
#pragma unroll
    for (int i = 0; i < 4; ++i) { v[i] = *reinterpret_cast<const float4*>(xr + i * 256 + lane * 4); ss += v[i].x * v[i].x + v[i].y * v[i].y + v[i].z * v[i].z + v[i].w * v[i].w; }
    ss = wave_sum(ss);
    const float r = rsqrtf(ss * (1.f / 1024.f) + EPS);
#pragma unroll
    for (int i = 0; i < 4; ++i) {
      const int c = i * 256 + lane * 4;
      const float4 gg = *reinterpret_cast<const float4*>(g + c), s1 = *reinterpret_cast<const float4*>(sc + c), s0 = *reinterpret_cast<const float4*>(sh + c);
      h16x4 o;
      o[0] = (h16)(v[i].x * r * gg.x * (1.f + s1.x) + s0.x); o[1] = (h16)(v[i].y * r * gg.y * (1.f + s1.y) + s0.y);
      o[2] = (h16)(v[i].z * r * gg.z * (1.f + s1.z) + s0.z); o[3] = (h16)(v[i].w * r * gg.w * (1.f + s1.w) + s0.w);
      *reinterpret_cast<h16x4*>(H + (long)t * LD1 + c) = o;
    }
  }
}
DI void phase_final(const Params& P) {
  const int lane = tidx() & 63, wid = tidx() >> 6;
  const float* g = P.in[I_FINALG];
  for (int rg = blockIdx.x; rg * 4 < TLAT; rg += gridDim.x) {
    float* xr = P.out + (long)(rg * 4 + wid) * 1024;
    float4 v[4]; float ss = 0.f;
#pragma unroll
    for (int i = 0; i < 4; ++i) { v[i] = *reinterpret_cast<const float4*>(xr + i * 256 + lane * 4); ss += v[i].x * v[i].x + v[i].y * v[i].y + v[i].z * v[i].z + v[i].w * v[i].w; }
    ss = wave_sum(ss);
    const float r = rsqrtf(ss * (1.f / 1024.f) + EPS);
#pragma unroll
    for (int i = 0; i < 4; ++i) {
      const int c = i * 256 + lane * 4; const float4 gg = *reinterpret_cast<const float4*>(g + c);
      *reinterpret_cast<float4*>(xr + c) = make_float4(v[i].x * r * gg.x, v[i].y * r * gg.y, v[i].z * r * gg.z, v[i].w * r * gg.w);
    }
  }
}
DI float2 r8(int idx) { const float c = 0.70710678118654752f; return idx == 0 ? make_float2(1.f, 0.f) : idx == 1 ? make_float2(c, -c) : idx == 2 ? make_float2(0.f, -1.f) : make_float2(-c, -c); }
DI float2 cmul_r8(float2 w, int idx, bool cj) {
  if (idx == 0) return w;
  float2 r = r8(idx); if (cj) r.y = -r.y;
  return cmul(w, r);
}
template <int S> DI void fft_dif_pass(float2* X, int h) {
  const int hs = h >> (S - 1);
#pragma unroll 1
  for (int item = tidx(); item < (8192 >> S); item += NTHREADS) {
    const int j = item % hs, blk = item / hs, i0 = blk * 2 * h + j;
    float2 v[1 << S];
#pragma unroll
    for (int k = 0; k < (1 << S); ++k) v[k] = X[i0 + k * hs];
    float2 wp[S];
    wp[0] = twid(-(float)j / (float)(2 * h));
#pragma unroll
    for (int q = 1; q < S; ++q) wp[q] = cmul(wp[q - 1], wp[q - 1]);
#pragma unroll
    for (int q = 0; q < S; ++q) {
      const int dist = 1 << (S - 1 - q);
#pragma unroll
      for (int k = 0; k < (1 << S); ++k) {
        if (k & dist) continue;
        const float2 a = v[k], b = v[k + dist];
        const int m = k & (dist - 1);
        const float2 tw = cmul_r8(wp[q], m << (3 - (S - q)), false);
        v[k] = make_float2(a.x + b.x, a.y + b.y);
        v[k + dist] = cmul(make_float2(a.x - b.x, a.y - b.y), tw);
      }
    }
#pragma unroll
    for (int k = 0; k < (1 << S); ++k) X[i0 + k * hs] = v[k];
  }
  __syncthreads();
}
template <int S> DI void fft_dit_pass(float2* X, int hs) {
  const int hmax = hs << (S - 1);
#pragma unroll 1
  for (int item = tidx(); item < (8192 >> S); item += NTHREADS) {
    const int j = item % hs, blk = item / hs, i0 = blk * 2 * hmax + j;
    float2 v[1 << S];
#pragma unroll
    for (int k = 0; k < (1 << S); ++k) v[k] = X[i0 + k * hs];
    float2 bp[S];
    bp[S - 1] = twid((float)j / (float)(2 * hmax));
#pragma unroll
    for (int q = S - 2; q >= 0; --q) bp[q] = cmul(bp[q + 1], bp[q + 1]);
#pragma unroll
    for (int q = 0; q < S; ++q) {
      const int dist = 1 << q;
#pragma unroll
      for (int k = 0; k < (1 << S); ++k) {
        if (k & dist) continue;
        const int m = k & (dist - 1);
        const float2 tw = cmul_r8(bp[q], m << (3 - (q + 1)), true);
        const float2 a = v[k], b = cmul(v[k + dist], tw);
        v[k] = make_float2(a.x + b.x, a.y + b.y);
        v[k + dist] = make_float2(a.x - b.x, a.y - b.y);
      }
    }
#pragma unroll
    for (int k = 0; k < (1 << S); ++k) X[i0 + k * hs] = v[k];
  }
  __syncthreads();
}
DI void fft_fwd(float2* X) { fft_dif_pass<3>(X, 4096); fft_dif_pass<3>(X, 512); fft_dif_pass<3>(X, 64); fft_dif_pass<2>(X, 8); fft_dif_pass<2>(X, 2); }
DI void fft_inv(float2* X) { fft_dit_pass<2>(X, 1); fft_dit_pass<2>(X, 4); fft_dit_pass<3>(X, 16); fft_dit_pass<3>(X, 128); fft_dit_pass<3>(X, 1024); }

DI float block_sum(float v, float* red) {
  v = wave_sum(v);
  __syncthreads();
  if ((tidx() & 63) == 0) red[tidx() >> 6] = v;
  __syncthreads();
  const float r = red[0] + red[1] + red[2] + red[3];
  __syncthreads();
  return r;
}
DI void item_filter(const Params& P, int layer, int oc, char* smem) {
  float2* X = reinterpret_cast<float2*>(smem); float* red = reinterpret_cast<float*>(smem + 65536);
  const int tid = tidx();
  const float* z2 = reinterpret_cast<const float*>(P.ws + OFF_Z2) + (long)layer * SEQ * 64;
  const float* w3 = P.in[I_FW3] + (long)layer * 64 * 1536; const float* dec = P.in[I_FDECAY] + layer * 1536;
  const int colf = oc, colb = 768 + oc;
  const float df = fabsf(dec[colf]), db = fabsf(dec[colb]);
  float lsum = 0.f;
#pragma unroll 2
  for (int i = 0; i < 32; ++i) {
    const int t = tid + 256 * i; const float* zr = z2 + (long)t * 64;
    float af = 0.f, ab = 0.f;
#pragma unroll 8
    for (int k = 0; k < 64; ++k) { const float z = zr[k]; af += z * w3[k * 1536 + colf]; ab += z * w3[k * 1536 + colb]; }
    const float tn = (float)t * (1.f / 8192.f);
    af *= __expf(-tn * df); ab *= __expf(-tn * db);
    lsum += fabsf(af) + fabsf(ab);
    X[t] = make_float2(af, ab);
  }
  const float nrm = block_sum(lsum, red);
  const float sc = 0.5f / 8192.f / nrm;
  float ev[32];
  float2* F = reinterpret_cast<float2*>(P.ws + OFF_FILT) + (long)oc * 2 * 8192;
#pragma unroll
  for (int i = 0; i < 32; ++i) {
    const int n = tid + 256 * i; const float lo = X[n].x; const float hi = n > 0 ? X[8192 - n].y : 0.f;
    ev[i] = (lo + hi) * sc; F[8192 + n] = make_float2((lo - hi) * sc, 0.f);
  }
  __syncthreads();
#pragma unroll
  for (int i = 0; i < 32; ++i) X[tid + 256 * i] = make_float2(ev[i], 0.f);
  __syncthreads();
  fft_fwd(X);
#pragma unroll 4
  for (int i = 0; i < 32; ++i) F[tid + 256 * i] = X[tid + 256 * i];
  __syncthreads();
#pragma unroll 4
  for (int i = 0; i < 32; ++i) { const int n = tid + 256 * i; const float d = F[8192 + n].x; const float2 w = twid(-(float)n * (1.f / 16384.f)); X[n] = make_float2(d * w.x, d * w.y); }
  __syncthreads();
  fft_fwd(X);
#pragma unroll 4
  for (int i = 0; i < 32; ++i) F[8192 + tid + 256 * i] = X[tid + 256 * i];
  __syncthreads();
}
DI void item_filter_ctx(const Params& P, int layer, int oc, char* smem) {
  float* red = reinterpret_cast<float*>(smem);
  const int t = tidx();
  const float* zr = reinterpret_cast<const float*>(P.ws + OFF_Z2C) + (long)layer * CTXL * 64 + t * 64;
  const float* w3 = P.in[I_FW3] + (long)layer * 64 * 1536; const float* dec = P.in[I_FDECAY] + layer * 1536;
  float af = 0.f, ab = 0.f;
  for (int k = 0; k < 64; ++k) { const float z = zr[k]; af += z * w3[k * 1536 + oc]; ab += z * w3[k * 1536 + 768 + oc]; }
  const float tn = (float)t * (1.f / 256.f);
  af *= __expf(-tn * fabsf(dec[oc])); ab *= __expf(-tn * fabsf(dec[768 + oc]));
  const float nrm = block_sum(fabsf(af) + fabsf(ab), red);
  float* T = reinterpret_cast<float*>(P.ws + OFF_TAPSC) + (long)oc * 512;
  T[t] = af / nrm; T[256 + t] = ab / nrm;
}

DI void phase_norm1(const Params& P, int layer, char* smem) {
  const int nfilt = 768 + (layer == 0 ? 768 : 0);
  for (int it = blockIdx.x; it < nfilt; it += gridDim.x) {
    if (it < 768) item_filter(P, layer, it, smem); else item_filter_ctx(P, layer, it - 768, smem);
  }
  normmod_rows(P, layer, 0, layer, TT, blockIdx.x, gridDim.x);
}

DI void phase_gemm_in(const Params& P, int layer, char* smem) {
  const int tid = tidx(), lane = tid & 63, wid = tid >> 6, wr = wid >> 1, wc = wid & 1, fr = lane & 15, fq = lane >> 4;
  const h16* H = reinterpret_cast<const h16*>(P.ws + OFF_H1);
  const h16* W = reinterpret_cast<const h16*>(P.ws + OFF_WT) + (long)layer * WT_LAYER + WT_WIN;
  h16* U = reinterpret_cast<h16*>(P.ws + OFF_U); h16* KV = reinterpret_cast<h16*>(P.ws + OFF_KVLAT); h16* QL = reinterpret_cast<h16*>(P.ws + OFF_QLAT);
  h16* PHY = reinterpret_cast<h16*>(P.ws + OFF_PHY); h16* PHYC = reinterpret_cast<h16*>(P.ws + OFF_PHYC); h16* Kb = reinterpret_cast<h16*>(P.ws + OFF_K);
  const float2* rope = reinterpret_cast<const float2*>(P.ws + OFF_ROPE);
  constexpr int NT = 19, MT = TT / 128;
  const TileWalk tw = tw_init(MT, NT);
  for (int tile = tw.lb; tile < tw_count(tw); tile += tw.nlb) {
    int mt, nt; tw_decode(tw, tile, mt, nt);
    f32x4 acc[4][4]; acc_zero(acc);
    gemm_kloop(acc, H + (long)mt * 128 * LD1, LD1, 0, 128, W + (long)nt * 128 * LD1, LD1, 1024, smem, opaque_tid());
    const int t0 = mt * 128; const Tok tk = tokinfo(t0);
    if (nt < 18) {
      float* Zs = reinterpret_cast<float*>(smem);
      const int t2 = tidx();
      if (nt < 9) {
        stage_acc(acc, Zs, t2);
        h16* dst; int ld, cb;
        if (nt < 3) { dst = U; ld = 384; cb = nt * 128; } else if (nt < 5) { dst = KV; ld = 256; cb = (nt - 3) * 128; } else { dst = QL; ld = 512; cb = (nt - 5) * 128; }
        copy_out_f16(Zs, dst, t0, ld, cb, t2);
      } else {
        stage_acc_t(acc, Zs, t2);
        h16* base = tk.ctx ? PHYC + (long)tk.b * 1152 * CTXL : PHY + (long)tk.b * 1152 * SEQ; const int lp = tk.ctx ? CTXL : SEQ;
        copy_out_f16(Zs, base, (nt - 9) * 128, lp, tk.pos, t2);
      }
      __syncthreads();
    } else if (wc == 0) {
#pragma unroll
      for (int m = 0; m < 4; ++m)
#pragma unroll
        for (int j = 0; j < 4; ++j) {
          const int pos = tk.pos + wr * 64 + m * 16 + fq * 4 + j; const int key = tk.ctx ? SEQ + pos : pos;
          float x1 = acc[m][0][j], x2 = acc[m][1][j];
          if (!tk.ctx) { const float2 cs = rope[pos * 16 + fr]; const float y1 = x1 * cs.x - x2 * cs.y, y2 = x1 * cs.y + x2 * cs.x; x1 = y1; x2 = y2; }
#pragma unroll
          for (int h = 0; h < 8; ++h) { h16* kr = Kb + ((long)(tk.b * 8 + h) * KEYS + key) * 96 + 64; kr[fr] = (h16)x1; kr[16 + fr] = (h16)x2; }
        }
    }
  }
}
DI void item_kv(const Params& P, int layer, int tile, char* smem) {
  const int tid = tidx(), lane = tid & 63, wid = tid >> 6, wr = wid >> 1, wc = wid & 1, fr = lane & 15, fq = lane >> 4;
  const int mt = tile >> 3, hd = tile & 7; const int t0 = mt * 128; const Tok tk = tokinfo(t0);
  const h16* A = reinterpret_cast<const h16*>(P.ws + OFF_KVLAT) + (long)t0 * 256;
  const h16* W = reinterpret_cast<const h16*>(P.ws + OFF_WT) + (long)layer * WT_LAYER + WT_UKV + (long)hd * 128 * 256;
  float* rs = reinterpret_cast<float*>(smem + 73728);
  row_rms(A, 256, 256, rs);
  f32x4 acc[4][4]; acc_zero(acc);
  gemm_kloop(acc, A, 256, 0, 128, W, 256, 256, smem, opaque_tid());
  h16* Kb = reinterpret_cast<h16*>(P.ws + OFF_K) + (long)(tk.b * 8 + hd) * KEYS * 96;
  h16* Vt = reinterpret_cast<h16*>(P.ws + OFF_VT) + (long)(tk.b * 8 + hd) * 64 * KEYS;
  const int key0 = (tk.ctx ? SEQ : 0) + tk.pos;
#pragma unroll
  for (int m = 0; m < 4; ++m) {
    const int r0 = wr * 64 + m * 16 + fq * 4;
    const float s0 = rs[r0], s1 = rs[r0 + 1], s2 = rs[r0 + 2], s3 = rs[r0 + 3];
#pragma unroll
    for (int n = 0; n < 4; ++n) {
      const int col = n * 16 + fr;
      if (wc == 0) {
        Kb[(long)(key0 + r0 + 0) * 96 + col] = (h16)(acc[m][n][0] * s0); Kb[(long)(key0 + r0 + 1) * 96 + col] = (h16)(acc[m][n][1] * s1);
        Kb[(long)(key0 + r0 + 2) * 96 + col] = (h16)(acc[m][n][2] * s2); Kb[(long)(key0 + r0 + 3) * 96 + col] = (h16)(acc[m][n][3] * s3);
      } else {
        h16x4 o; o[0] = (h16)(acc[m][n][0] * s0); o[1] = (h16)(acc[m][n][1] * s1); o[2] = (h16)(acc[m][n][2] * s2); o[3] = (h16)(acc[m][n][3] * s3);
        *reinterpret_cast<h16x4*>(Vt + (long)col * KEYS + key0 + r0) = o;
      }
    }
  }
  __syncthreads();
}
DI void item_q(const Params& P, int layer, int tile, char* smem) {
  const int tid = tidx(), lane = tid & 63, wid = tid >> 6, wr = wid >> 1, wc = wid & 1, fr = lane & 15, fq = lane >> 4;
  const int mt = tile >> 3, hd = tile & 7; const int t0 = mt * 128; const Tok tk = tokinfo(t0);
  const h16* A = reinterpret_cast<const h16*>(P.ws + OFF_QLAT) + (long)t0 * 512;
  const h16* W = reinterpret_cast<const h16*>(P.ws + OFF_WT) + (long)layer * WT_LAYER + WT_UQ + (long)hd * 128 * 512;
  float* rs = reinterpret_cast<float*>(smem + 73728);
  row_rms(A, 512, 512, rs);
  f32x4 acc[4][4]; acc_zero(acc);
  gemm_kloop(acc, A, 512, 0, 128, W, 512, 512, smem, opaque_tid());
  h16* Qb = reinterpret_cast<h16*>(P.ws + OFF_Q) + (long)(tk.b * 8 + hd) * KEYS * 96;
  const float2* rope = reinterpret_cast<const float2*>(P.ws + OFF_ROPE);
  const int q0 = (tk.ctx ? SEQ : 0) + tk.pos;
#pragma unroll
  for (int m = 0; m < 4; ++m)
#pragma unroll
    for (int j = 0; j < 4; ++j) {
      const int r = wr * 64 + m * 16 + fq * 4 + j; const float s = rs[r] * QSCALE;
      h16* qr = Qb + (long)(q0 + r) * 96;
      if (wc == 0) {
#pragma unroll
        for (int n = 0; n < 4; ++n) qr[n * 16 + fr] = (h16)(acc[m][n][j] * s);
      } else {
        float x1 = acc[m][0][j], x2 = acc[m][1][j];
        if (!tk.ctx) { const float2 cs = rope[(tk.pos + r) * 16 + fr]; const float y1 = x1 * cs.x - x2 * cs.y, y2 = x1 * cs.y + x2 * cs.x; x1 = y1; x2 = y2; }
        qr[64 + fr] = (h16)(x1 * s); qr[80 + fr] = (h16)(x2 * s);
      }
    }
  __syncthreads();
}
DI int s5_chunk_base(int b, int dir, int si) {
  if (si < 4) { const int cc = dir ? 3 - si : si; return TLAT + b * CTXL + cc * 64; }
  const int lc = dir ? 127 - (si - 4) : si - 4; return b * SEQ + lc * 64;
}
DI void s5_stage_u(const h16* __restrict__ U, int tokbase, int g, float* us) {
  const int lane = tidx() & 63;
  const h16* p = U + (long)(tokbase + lane) * 384 + g * 16;
  const h16x8 v0 = *reinterpret_cast<const h16x8*>(p), v1 = *reinterpret_cast<const h16x8*>(p + 8);
#pragma unroll
  for (int j = 0; j < 8; ++j) { us[lane * 16 + j] = (float)v0[j]; us[lane * 16 + 8 + j] = (float)v1[j]; }
}
DI void item_s5_pass1(const Params& P, int layer, int wtask, char* smem) {
  const int lane = tidx() & 63, wid = tidx() >> 6;
  float* us = reinterpret_cast<float*>(smem + wid * 12800);
  const int si = wtask % 132; int r = wtask / 132; const int g = r % 24; r /= 24; const int dir = r & 1, b = r >> 1;
  const long gi = (long)(layer * 2 + dir) * 24 + g;
  const float2 a = reinterpret_cast<const float2*>(P.ws + OFF_S5A)[gi * 64 + lane];
  const float2* Bb = reinterpret_cast<const float2*>(P.ws + OFF_S5B) + (gi * 64 + lane) * 16;
  float bre[16], bim[16];
#pragma unroll
  for (int c = 0; c < 16; ++c) { const float2 v = Bb[c]; bre[c] = v.x; bim[c] = v.y; }
  s5_stage_u(reinterpret_cast<const h16*>(P.ws + OFF_U), s5_chunk_base(b, dir, si), g, us);
  float hr = 0.f, hi = 0.f;
#pragma unroll 4
  for (int s = 0; s < 64; ++s) {
    const int tau = dir ? 63 - s : s;
    const float4* up = reinterpret_cast<const float4*>(us + tau * 16);
    float br = 0.f, bi = 0.f;
#pragma unroll
    for (int q = 0; q < 4; ++q) { const float4 u = up[q];
      br += bre[q * 4] * u.x + bre[q * 4 + 1] * u.y + bre[q * 4 + 2] * u.z + bre[q * 4 + 3] * u.w;
      bi += bim[q * 4] * u.x + bim[q * 4 + 1] * u.y + bim[q * 4 + 2] * u.z + bim[q * 4 + 3] * u.w; }
    const float nr = a.x * hr - a.y * hi + br, ni = a.x * hi + a.y * hr + bi; hr = nr; hi = ni;
  }
  reinterpret_cast<float2*>(P.ws + OFF_E)[((long)((b * 2 + dir) * 24 + g) * 132 + si) * 64 + lane] = make_float2(hr, hi);
}

DI float hy_dw(const h16* __restrict__ p, int t, int Ls, float w0, float w1, float w2, float bias) {
  const float xm = t > 0 ? (float)p[t - 1] : 0.f, x0 = (float)p[t], xp = t + 1 < Ls ? (float)p[t + 1] : 0.f;
  return xm * w0 + x0 * w1 + xp * w2 + bias;
}
DI void item_hyena(const Params& P, int layer, int task, char* smem) {
  float2* X = reinterpret_cast<float2*>(smem);
  const int tid = tidx(); const int pair = task / 384, c = task % 384;
  const h16* PH0 = reinterpret_cast<const h16*>(P.ws + OFF_PHY) + (long)(2 * pair) * 1152 * SEQ;
  const h16* PH1 = PH0 + (long)1152 * SEQ;
  const float* cw = P.in[I_HCW] + layer * 3 * 1152; const float* cb = P.in[I_HCB] + layer * 1152;
  const float2* F = reinterpret_cast<const float2*>(P.ws + OFF_FILT);
  float2* SCR = reinterpret_cast<float2*>(P.ws + OFF_YS5PRE) + (long)blockIdx.x * 12288;
  float2* SCR2 = SCR + 8192;
  const float vw0 = cw[c], vw1 = cw[1152 + c], vw2 = cw[2304 + c], vbb = cb[c];
  const h16* pv0 = PH0 + (long)c * SEQ; const h16* pv1 = PH1 + (long)c * SEQ;
  float2 ye[16]; int tq;
#pragma unroll 1
  for (int o = 0; o < 2; ++o) {
    const float2* Te = F + (long)(o * 384 + c) * 2 * 8192; const float2* To = Te + 8192;
    float ts = 1.f / 16384.f; asm volatile("" : "+v"(ts));
{ tq = tid; asm volatile("" : "+v"(tq)); }
#pragma unroll 8
    for (int i = 0; i < 32; ++i) { const int t = tq + 256 * i;
      X[t] = o == 0 ? make_float2(hy_dw(pv0, t, SEQ, vw0, vw1, vw2, vbb), hy_dw(pv1, t, SEQ, vw0, vw1, vw2, vbb)) : SCR[t]; }
    __syncthreads();
    fft_fwd(X);
{ tq = tid; asm volatile("" : "+v"(tq)); }
#pragma unroll 8
    for (int i = 0; i < 32; ++i) { const int n = tq + 256 * i; X[n] = cmul(X[n], Te[n]); }
    __syncthreads();
    fft_inv(X);
{ tq = tid; asm volatile("" : "+v"(tq)); }
#pragma unroll
    for (int i = 0; i < 16; ++i) { ye[i] = X[tq + 256 * i]; SCR2[tq + 256 * i] = X[tq + 4096 + 256 * i]; }
    __syncthreads();
{ tq = tid; asm volatile("" : "+v"(tq)); }
#pragma unroll 8
    for (int i = 0; i < 32; ++i) { const int t = tq + 256 * i;
      const float2 zz = o == 0 ? make_float2(hy_dw(pv0, t, SEQ, vw0, vw1, vw2, vbb), hy_dw(pv1, t, SEQ, vw0, vw1, vw2, vbb)) : SCR[t];
      X[t] = cmul(zz, twid(-(float)t * ts)); }
    __syncthreads();
    fft_fwd(X);
{ tq = tid; asm volatile("" : "+v"(tq)); }
#pragma unroll 8
    for (int i = 0; i < 32; ++i) { const int n = tq + 256 * i; X[n] = cmul(X[n], To[n]); }
    __syncthreads();
    fft_inv(X);
    asm volatile("" : "+v"(ts));
{ tq = tid; asm volatile("" : "+v"(tq)); }
#pragma unroll
    for (int i = 0; i < 16; ++i) { const int t = tq + 256 * i; const float2 yo = cmul(X[t], twid((float)t * ts)); X[t] = make_float2(ye[i].x + yo.x, ye[i].y + yo.y); }
{ tq = tid; asm volatile("" : "+v"(tq)); }
#pragma unroll 2
    for (int i = 0; i < 16; ++i) { const int t = tq + 4096 + 256 * i; const float2 yo = cmul(X[t], twid((float)t * ts)); const float2 y2 = SCR2[tq + 256 * i]; X[t] = make_float2(y2.x + yo.x, y2.y + yo.y); }
    const int gc = (o + 1) * 384 + c;
    const float w0 = cw[gc], w1 = cw[1152 + gc], w2 = cw[2304 + gc], bb = cb[gc];
    const float bias = P.in[I_HBIAS][(layer * 2 + o) * 384 + c];
    const h16* pg0 = PH0 + (long)gc * SEQ; const h16* pg1 = PH1 + (long)gc * SEQ;
    h16* Y = reinterpret_cast<h16*>(P.ws + OFF_YHY);
{ tq = tid; asm volatile("" : "+v"(tq)); }
#pragma unroll 8
    for (int i = 0; i < 32; ++i) {
      const int t = tq + 256 * i;
      const float2 lc = X[t];
      const float2 zz = o == 0 ? make_float2(hy_dw(pv0, t, SEQ, vw0, vw1, vw2, vbb), hy_dw(pv1, t, SEQ, vw0, vw1, vw2, vbb)) : SCR[t];
      const float gx = hy_dw(pg0, t, SEQ, w0, w1, w2, bb), gy = hy_dw(pg1, t, SEQ, w0, w1, w2, bb);
      const float2 res = make_float2(gx * (lc.x + bias * zz.x), gy * (lc.y + bias * zz.y));
      if (o == 0) SCR[t] = res;
      else { Y[((long)(2 * pair) * SEQ + t) * 384 + c] = (h16)res.x; Y[((long)(2 * pair + 1) * SEQ + t) * 384 + c] = (h16)res.y; }
    }
    __syncthreads();
  }
}
DI void item_hyena_ctx(const Params& P, int layer, int task, char* smem) {
  float* su = reinterpret_cast<float*>(smem); float* sf = su + 256; float* sb = sf + 256;
  const int t = tidx(); const int b = task / 384, c = task % 384;
  const h16* PH = reinterpret_cast<const h16*>(P.ws + OFF_PHYC) + (long)b * 1152 * CTXL;
  const float* cw = P.in[I_HCW] + layer * 3 * 1152; const float* cb = P.in[I_HCB] + layer * 1152;
  float u = hy_dw(PH + (long)c * CTXL, t, CTXL, cw[c], cw[1152 + c], cw[2304 + c], cb[c]);
  for (int o = 0; o < 2; ++o) {
    const float* T = reinterpret_cast<const float*>(P.ws + OFF_TAPSC) + (long)(o * 384 + c) * 512;
    __syncthreads();
    su[t] = u; sf[t] = T[t]; sb[t] = T[256 + t];
    __syncthreads();
    float y = 0.f;
    for (int s = 0; s <= t; ++s) y += sf[t - s] * su[s];
    for (int s = t + 1; s < 256; ++s) y += sb[s - t] * su[s];
    const int gc = (o + 1) * 384 + c;
    const float gx = hy_dw(PH + (long)gc * CTXL, t, CTXL, cw[gc], cw[1152 + gc], cw[2304 + gc], cb[gc]);
    u = gx * (y + P.in[I_HBIAS][(layer * 2 + o) * 384 + c] * u);
  }
  reinterpret_cast<h16*>(P.ws + OFF_YHY)[((long)TLAT + b * CTXL + t) * 384 + c] = (h16)u;
  __syncthreads();
}

#ifndef PROBE_HY
#define PROBE_HY 0
#endif
#ifndef PROBE_S5
#define PROBE_S5 0
#endif
DI int first_item(int base) { const int g = (int)gridDim.x; return (((int)blockIdx.x - base) % g + g) % g; }
DI void phase_mix1(const Params& P, int layer, char* smem) {
  const int n_hy = 4 * 384, n_hyc = layer == 0 ? 8 * 384 : 0;
  const int n_kv = (TT / 128) * 8, n_q = (layer == 0 ? TT / 128 : TLAT / 128) * 8;
  const int n_s5 = (NBATCH * 2 * 24 * 132) / 4;
  const int g = gridDim.x;
#pragma unroll 1
  for (int rep = 0; rep < 1 + PROBE_HY; ++rep)
#pragma unroll 1
  for (int i = first_item(0); i < n_hy; i += g) item_hyena(P, layer, i, smem);
  asm volatile("" ::: "memory");
#pragma unroll 1
  for (int i = first_item(n_hy); i < n_kv; i += g) item_kv(P, layer, i, smem);
  asm volatile("" ::: "memory");
#pragma unroll 1
  for (int i = first_item(n_hy + n_kv); i < n_q; i += g) item_q(P, layer, i, smem);
  asm volatile("" ::: "memory");
#pragma unroll 1
  for (int rep = 0; rep < 1 + PROBE_S5; ++rep)
#pragma unroll 1
  for (int i = first_item(n_hy + n_kv + n_q); i < n_s5; i += g) { item_s5_pass1(P, layer, i * 4 + (tidx() >> 6), smem); __syncthreads(); }
  asm volatile("" ::: "memory");
#pragma unroll 1
  for (int i = first_item(n_hy + n_kv + n_q + n_s5); i < n_hyc; i += g) item_hyena_ctx(P, layer, i, smem);
}
DI int crow32(int r, int hi) { return (r & 3) + 8 * (r >> 2) + 4 * hi; }
DI void item_attn(const Params& P, int bh, int q0, int key_lo, int ntiles, char* smem) {
  const int tid = tidx(), lane = tid & 63, wid = tid >> 6, r32 = lane & 31, hi = lane >> 5;
  const h16* Qb = reinterpret_cast<const h16*>(P.ws + OFF_Q) + (long)bh * KEYS * 96;
  const h16* Kb = reinterpret_cast<const h16*>(P.ws + OFF_K) + (long)bh * KEYS * 96;
  const h16* Vt = reinterpret_cast<const h16*>(P.ws + OFF_VT) + (long)bh * 64 * KEYS;
  h16x8 qf[6];
  { const h16* qrow = Qb + (long)(q0 + wid * 32 + r32) * 96 + hi * 8;
#pragma unroll
    for (int ds = 0; ds < 6; ++ds) qf[ds] = *reinterpret_cast<const h16x8*>(qrow + ds * 16); }
  constexpr int KT_BYTES = 64 * 208, VT_BYTES = 64 * 136, BUF = KT_BYTES + VT_BYTES;
  uint4 kr[3]; uint4 vr[2];
  const int vdv0 = tid >> 3, vpart = tid & 7;
  auto gload = [&](int j) {
    const long key0 = key_lo + j * 64;
#pragma unroll
    for (int i = 0; i < 3; ++i) kr[i] = *reinterpret_cast<const uint4*>(Kb + key0 * 96 + (long)(tid + 256 * i) * 8);
#pragma unroll
    for (int i = 0; i < 2; ++i) vr[i] = *reinterpret_cast<const uint4*>(Vt + (long)(vdv0 + 32 * i) * KEYS + key0 + vpart * 8);
  };
  auto swrite = [&](int buf) {
    char* ks = smem + buf * BUF; char* vs = ks + KT_BYTES;
#pragma unroll
    for (int i = 0; i < 3; ++i) { const int c = tid + 256 * i; *reinterpret_cast<uint4*>(ks + (c / 12) * 208 + (c % 12) * 16) = kr[i]; }
#pragma unroll
    for (int i = 0; i < 2; ++i) { char* d = vs + (vdv0 + 32 * i) * 136 + vpart * 16;
      *reinterpret_cast<uint2*>(d) = make_uint2(vr[i].x, vr[i].y); *reinterpret_cast<uint2*>(d + 8) = make_uint2(vr[i].z, vr[i].w); }
  };
  f32x16 o0, o1;
#pragma unroll
  for (int r = 0; r < 16; ++r) { o0[r] = 0.f; o1[r] = 0.f; }
  float m_run = -1e30f, l_run = 0.f;
  gload(0); swrite(0); __syncthreads();
  for (int j = 0; j < ntiles; ++j) {
    if (j + 1 < ntiles) gload(j + 1);
    const char* ks = smem + (j & 1) * BUF; const char* vs = ks + KT_BYTES;
    f32x16 p0, p1;
#pragma unroll
    for (int r = 0; r < 16; ++r) { p0[r] = 0.f; p1[r] = 0.f; }
#pragma unroll
    for (int ds = 0; ds < 6; ++ds) {
      const h16x8 a0 = *reinterpret_cast<const h16x8*>(ks + r32 * 208 + (ds * 16 + hi * 8) * 2);
      const h16x8 a1 = *reinterpret_cast<const h16x8*>(ks + (32 + r32) * 208 + (ds * 16 + hi * 8) * 2);
      p0 = __builtin_amdgcn_mfma_f32_32x32x16_f16(a0, qf[ds], p0, 0, 0, 0);
      p1 = __builtin_amdgcn_mfma_f32_32x32x16_f16(a1, qf[ds], p1, 0, 0, 0);
    }
    float mx = p0[0];
#pragma unroll
    for (int r = 1; r < 16; ++r) mx = fmaxf(mx, p0[r]);
#pragma unroll
    for (int r = 0; r < 16; ++r) mx = fmaxf(mx, p1[r]);
    mx = fmaxf(mx, __shfl_xor(mx, 32));
    const float mnew = fmaxf(m_run, mx);
    const float alpha = __builtin_amdgcn_exp2f(m_run - mnew);
    m_run = mnew;
    float rsum = 0.f;
#pragma unroll
    for (int r = 0; r < 16; ++r) { p0[r] = __builtin_amdgcn_exp2f(p0[r] - mnew); rsum += p0[r]; }
#pragma unroll
    for (int r = 0; r < 16; ++r) { p1[r] = __builtin_amdgcn_exp2f(p1[r] - mnew); rsum += p1[r]; }
    l_run = l_run * alpha + rsum;
    if (__any(alpha != 1.f)) {
#pragma unroll
      for (int r = 0; r < 16; ++r) { o0[r] *= alpha; o1[r] *= alpha; }
    }
#pragma unroll
    for (int kb = 0; kb < 2; ++kb)
#pragma unroll
      for (int s = 0; s < 2; ++s) {
        h16x8 pf;
#pragma unroll
        for (int e = 0; e < 8; ++e) pf[e] = (h16)(kb ? p1[8 * s + e] : p0[8 * s + e]);
        const int koff = (32 * kb + 16 * s + 4 * hi) * 2;
        {
          const h16x4 lo = *reinterpret_cast<const h16x4*>(vs + r32 * 136 + koff), hh = *reinterpret_cast<const h16x4*>(vs + r32 * 136 + koff + 16);
          const h16x8 af = __builtin_shufflevector(lo, hh, 0, 1, 2, 3, 4, 5, 6, 7);
          o0 = __builtin_amdgcn_mfma_f32_32x32x16_f16(af, pf, o0, 0, 0, 0);
        }
        {
          const h16x4 lo = *reinterpret_cast<const h16x4*>(vs + (32 + r32) * 136 + koff), hh = *reinterpret_cast<const h16x4*>(vs + (32 + r32) * 136 + koff + 16);
          const h16x8 af = __builtin_shufflevector(lo, hh, 0, 1, 2, 3, 4, 5, 6, 7);
          o1 = __builtin_amdgcn_mfma_f32_32x32x16_f16(af, pf, o1, 0, 0, 0);
        }
      }
    if (j + 1 < ntiles) swrite((j + 1) & 1);
    __syncthreads();
  }
  const float lt = l_run + __shfl_xor(l_run, 32);
  const float inv = 1.f / lt;
  const int b = bh >> 3, hd = bh & 7; const int q = q0 + wid * 32 + r32;
  const long tok = q < SEQ ? (long)b * SEQ + q : (long)TLAT + b * CTXL + (q - SEQ);
  h16* yr = reinterpret_cast<h16*>(P.ws + OFF_YMLA) + tok * 512 + hd * 64;
#pragma unroll
  for (int g = 0; g < 4; ++g) {
    h16x4 a, c;
#pragma unroll
    for (int e = 0; e < 4; ++e) { a[e] = (h16)(o0[4 * g + e] * inv); c[e] = (h16)(o1[4 * g + e] * inv); }
    *reinterpret_cast<h16x4*>(yr + 8 * g + 4 * hi) = a;
    *reinterpret_cast<h16x4*>(yr + 32 + 8 * g + 4 * hi) = c;
  }
}
DI void item_s5_pass3(const Params& P, int layer, int b, int g, int ck, char* smem) {
  const int lane = tidx() & 63, wid = tidx() >> 6, fr = lane & 15, fq = lane >> 4;
  float* us = reinterpret_cast<float*>(smem + wid * 12800); char* Hs = smem + wid * 12800 + 4096;
  const int tokbase = ck < 4 ? TLAT + b * CTXL + ck * 64 : b * SEQ + (ck - 4) * 64;
  s5_stage_u(reinterpret_cast<const h16*>(P.ws + OFF_U), tokbase, g, us);
  __syncthreads();
  f32x4 yacc[4];
#pragma unroll
  for (int i = 0; i < 4; ++i) yacc[i] = f32x4{0.f, 0.f, 0.f, 0.f};
#pragma unroll
  for (int dir = 0; dir < 2; ++dir) {
    const long gi = (long)(layer * 2 + dir) * 24 + g;
    const float2 a = reinterpret_cast<const float2*>(P.ws + OFF_S5A)[gi * 64 + lane];
    const float2 a64 = reinterpret_cast<const float2*>(P.ws + OFF_S5A64)[gi * 64 + lane];
    const float2* Bb = reinterpret_cast<const float2*>(P.ws + OFF_S5B) + (gi * 64 + lane) * 16;
    float bre[16], bim[16];
#pragma unroll
    for (int c = 0; c < 16; ++c) { const float2 v = Bb[c]; bre[c] = v.x; bim[c] = v.y; }
    const int si = ck < 4 ? (dir ? 3 - ck : ck) : 4 + (dir ? 127 - (ck - 4) : ck - 4);
    const float2* Ep = reinterpret_cast<const float2*>(P.ws + OFF_E) + ((long)((b * 2 + dir) * 24 + g) * 132) * 64 + lane;
    float hr = 0.f, hi = 0.f;
#pragma unroll 16
    for (int i = 0; i < si; ++i) { const float2 e = Ep[(long)i * 64]; const float nr = a64.x * hr - a64.y * hi + e.x, ni = a64.x * hi + a64.y * hr + e.y; hr = nr; hi = ni; }
    const h16* Ct = reinterpret_cast<const h16*>(P.ws + OFF_S5C) + gi * 16 * 128 + fr * 128 + fq * 8;
    h16x8 cf[4];
#pragma unroll
    for (int ks = 0; ks < 4; ++ks) cf[ks] = *reinterpret_cast<const h16x8*>(Ct + ks * 32);
#pragma unroll
    for (int half = 0; half < 2; ++half) {
#pragma unroll 4
      for (int s = 0; s < 32; ++s) {
        const int step = half * 32 + s; const int tau = dir ? 63 - step : step;
        const float4* up = reinterpret_cast<const float4*>(us + tau * 16);
        float br = 0.f, bi = 0.f;
#pragma unroll
        for (int q = 0; q < 4; ++q) { const float4 u = up[q];
          br += bre[q * 4] * u.x + bre[q * 4 + 1] * u.y + bre[q * 4 + 2] * u.z + bre[q * 4 + 3] * u.w;
          bi += bim[q * 4] * u.x + bim[q * 4 + 1] * u.y + bim[q * 4 + 2] * u.z + bim[q * 4 + 3] * u.w; }
        const float nr = a.x * hr - a.y * hi + br, ni = a.x * hi + a.y * hr + bi; hr = nr; hi = ni;
        h16* hrow = reinterpret_cast<h16*>(Hs + (tau & 31) * 272);
        hrow[lane] = (h16)hr; hrow[64 + lane] = (h16)hi;
      }
      __syncthreads();
      const int tb = dir ? 1 - half : half;
#pragma unroll
      for (int sb2 = 0; sb2 < 2; ++sb2)
#pragma unroll
        for (int ks = 0; ks < 4; ++ks) {
          const h16x8 bf = *reinterpret_cast<const h16x8*>(Hs + (sb2 * 16 + fr) * 272 + (ks * 32 + fq * 8) * 2);
          yacc[tb * 2 + sb2] = __builtin_amdgcn_mfma_f32_16x16x32_f16(cf[ks], bf, yacc[tb * 2 + sb2], 0, 0, 0);
        }
      __syncthreads();
    }
  }
  const float* dsk = P.in[I_S5D] + layer * 384 + g * 16 + fq * 4;
  h16* Y = reinterpret_cast<h16*>(P.ws + OFF_YS5PRE);
#pragma unroll
  for (int sbi = 0; sbi < 4; ++sbi) {
    const int tl = sbi * 16 + fr; h16x4 o;
#pragma unroll
    for (int j = 0; j < 4; ++j) o[j] = (h16)geluf_(yacc[sbi][j] + dsk[j] * us[tl * 16 + fq * 4 + j]);
    *reinterpret_cast<h16x4*>(Y + (long)(tokbase + tl) * 384 + g * 16 + fq * 4) = o;
  }
  __syncthreads();
}
DI void phase_mix2(const Params& P, int layer, char* smem) {
  if ((gridDim.x & 7) == 0) {
    const int xcd = blockIdx.x & 7, li = blockIdx.x >> 3, nloc = gridDim.x >> 3;
    for (int k = li; k < 512; k += nloc) item_attn(P, xcd + 8 * (k >> 6), (k & 63) * 128, 0, KEYS / 64, smem);
  } else {
    for (int k = blockIdx.x; k < 4096; k += gridDim.x) item_attn(P, k >> 6, (k & 63) * 128, 0, KEYS / 64, smem);
  }
  const int n_actx = layer == 0 ? 128 : 0;
  const int nck = layer == 0 ? 132 : 128;
  const int n_s5 = NBATCH * 24 * nck / 4;
  for (int it = blockIdx.x; it < n_actx + n_s5; it += gridDim.x) {
    if (it < n_actx) { item_attn(P, it >> 1, SEQ + (it & 1) * 128, SEQ, CTXL / 64, smem); continue; }
    const int w = (it - n_actx) * 4 + (tidx() >> 6);
    const int ck = w % nck + (layer == 0 ? 0 : 4); const int r = w / nck;
    item_s5_pass3(P, layer, r / 24, r % 24, ck, smem);
  }
}
DI void phase_glu(const Params& P, int layer, char* smem) {
  const int tid = tidx(), lane = tid & 63, wid = tid >> 6, wr = wid >> 1, wc = wid & 1, fr = lane & 15, fq = lane >> 4;
  const h16* A = reinterpret_cast<const h16*>(P.ws + OFF_YS5PRE);
  const h16* W = reinterpret_cast<const h16*>(P.ws + OFF_WT) + (long)layer * WT_LAYER + WT_GLU;
  h16* Y = reinterpret_cast<h16*>(P.ws + OFF_YS5);
  const int MT = (layer == 0 ? TT : TLAT) / 128;
  const TileWalk tw = tw_init(MT, 6);
  for (int tile = tw.lb; tile < tw_count(tw); tile += tw.nlb) {
    int mt, nt; tw_decode(tw, tile, mt, nt);
    f32x4 acc[4][4]; acc_zero(acc);
    gemm_kloop(acc, A + (long)mt * 128 * 384, 384, 0, 128, W + (long)nt * 128 * 384, 384, 384, smem, opaque_tid());
#pragma unroll
    for (int m = 0; m < 4; ++m)
#pragma unroll
      for (int np = 0; np < 2; ++np)
#pragma unroll
        for (int j = 0; j < 4; ++j) {
          const int row = mt * 128 + wr * 64 + m * 16 + fq * 4 + j, col = nt * 64 + wc * 32 + np * 16 + fr;
          Y[(long)row * 384 + col] = (h16)(acc[m][2 * np][j] * sigmoidf_(acc[m][2 * np + 1][j]));
        }
  }
}
DI void phase_merge(const Params& P, int layer, char* smem) {
  const h16* H = reinterpret_cast<const h16*>(P.ws + OFF_H1);
  const h16* WL = reinterpret_cast<const h16*>(P.ws + OFF_WT) + (long)layer * WT_LAYER;
  h16* Mg = reinterpret_cast<h16*>(P.ws + OFF_MERGED);
  const int MT = (layer == 0 ? TT : TLAT) / 128;
  const TileWalk tw = tw_init(MT, 8);
  for (int tile = tw.lb; tile < tw_count(tw); tile += tw.nlb) {
    int mt, nt; tw_decode(tw, tile, mt, nt);
    h16* Tmp = reinterpret_cast<h16*>(P.ws + OFF_YS5PRE) + (long)blockIdx.x * 16384;
#pragma unroll 1
    for (int br = 0; br < 3; ++br) {
      const h16* Ab; const h16* Wb; int Kb;
      if (br == 0) { Ab = reinterpret_cast<const h16*>(P.ws + OFF_YHY) + (long)mt * 128 * 384; Wb = WL + WT_BRHY + (long)nt * 128 * 384; Kb = 384; }
      else if (br == 1) { Ab = reinterpret_cast<const h16*>(P.ws + OFF_YS5) + (long)mt * 128 * 384; Wb = WL + WT_BRS5 + (long)nt * 128 * 384; Kb = 384; }
      else { Ab = reinterpret_cast<const h16*>(P.ws + OFF_YMLA) + (long)mt * 128 * 512; Wb = WL + WT_BRMLA + (long)nt * 128 * 512; Kb = 512; }
      {
        f32x4 acc[4][4]; acc_zero(acc);
        gemm_kloop(acc, Ab, Kb, 0, 128, Wb, Kb, Kb, smem, opaque_tid());
        const int tid = tidx();
#pragma unroll
        for (int m = 0; m < 4; ++m)
#pragma unroll
          for (int n = 0; n < 4; ++n) {
            h16x4 o; o[0] = (h16)acc[m][n][0]; o[1] = (h16)acc[m][n][1]; o[2] = (h16)acc[m][n][2]; o[3] = (h16)acc[m][n][3];
            *reinterpret_cast<h16x4*>(Tmp + ((m * 4 + n) * 256 + tid) * 4) = o;
          }
      }
      f32x4 acc[4][4]; acc_zero(acc);
      gemm_kloop(acc, H + (long)mt * 128 * LD1, LD1, 0, 128, WL + WT_WGATE + (long)(br * 1024 + nt * 128) * LD1, LD1, 1024, smem, opaque_tid());
      const int tid = tidx(), lane = tid & 63, wid = tid >> 6, wr = wid >> 1, wc = wid & 1, fr = lane & 15, fq = lane >> 4;
#pragma unroll
      for (int m = 0; m < 4; ++m)
#pragma unroll
        for (int n = 0; n < 4; ++n) {
          const h16x4 bv = *reinterpret_cast<const h16x4*>(Tmp + ((m * 4 + n) * 256 + tid) * 4);
#pragma unroll
          for (int j = 0; j < 4; ++j) {
            h16* dst = Mg + (long)(mt * 128 + wr * 64 + m * 16 + fq * 4 + j) * LD1 + nt * 128 + wc * 64 + n * 16 + fr;
            const float prev = br == 0 ? 0.f : (float)*dst;
            *dst = (h16)(prev + sigmoidf_(acc[m][n][j]) * (float)bv[j]);
          }
          __builtin_amdgcn_sched_barrier(0);
        }
    }
  }
}
DI void phase_resid(const Params& P, int layer, int stage_src, size_t a_off, int K, long w_off, int gate_idx, char* smem) {
  const int tid = tidx(), lane = tid & 63, wid = tid >> 6, wr = wid >> 1, wc = wid & 1, fr = lane & 15, fq = lane >> 4;
  const h16* A = reinterpret_cast<const h16*>(P.ws + a_off);
  const h16* W = reinterpret_cast<const h16*>(P.ws + OFF_WT) + (long)layer * WT_LAYER + w_off;
  const float* mod = reinterpret_cast<const float*>(P.ws + OFF_MOD) + (long)layer * 9 * 6144 + gate_idx * 1024;
  const int MT = (layer == 0 ? TT : TLAT) / 128;
  const TileWalk tw = tw_init(MT, 8);
  for (int tile = tw.lb; tile < tw_count(tw); tile += tw.nlb) {
    int mt, nt; tw_decode(tw, tile, mt, nt);
    f32x4 acc[4][4]; acc_zero(acc);
    const int ld = K == 1024 ? LD1 : LD2;
    gemm_kloop(acc, A + (long)mt * 128 * ld, ld, 0, 128, W + (long)nt * 128 * ld, ld, K, smem, opaque_tid());
    const Tok tk = tokinfo(mt * 128);
    float* Zs = reinterpret_cast<float*>(smem);
    const int t2 = tidx();
    stage_acc(acc, Zs, t2);
    const int c4 = (t2 & 31) * 4;
    const float4 g4 = *reinterpret_cast<const float4*>(mod + tk.mrow * 6144 + nt * 128 + c4);
#pragma unroll 4
    for (int it = 0; it < 16; ++it) {
      const int row = it * 8 + (t2 >> 5); const int t = mt * 128 + row;
      const float4 a4 = *reinterpret_cast<const float4*>(Zs + row * 132 + c4);
      const float4 x4 = *reinterpret_cast<const float4*>(xrow_src(P, stage_src, t) + nt * 128 + c4);
      *reinterpret_cast<float4*>(xrow_dst(P, t) + nt * 128 + c4) = make_float4(x4.x + g4.x * a4.x, x4.y + g4.y * a4.y, x4.z + g4.z * a4.z, x4.w + g4.w * a4.w);
    }
    __syncthreads();
  }
}
DI void phase_ffn_up(const Params& P, int layer, char* smem) {
  const int tid = tidx(), lane = tid & 63, wid = tid >> 6, wr = wid >> 1, wc = wid & 1, fr = lane & 15, fq = lane >> 4;
  const h16* H = reinterpret_cast<const h16*>(P.ws + OFF_H2);
  const h16* W = reinterpret_cast<const h16*>(P.ws + OFF_WT) + (long)layer * WT_LAYER + WT_UP;
  h16* F = reinterpret_cast<h16*>(P.ws + OFF_F);
  const float* cw = P.in[I_FCW] + (long)layer * 3 * 5632; const float* cb = P.in[I_FCB] + (long)layer * 5632;
  float* Zs = reinterpret_cast<float*>(smem);
  const int n_mt = 8 * 66 + (layer == 0 ? 8 * 3 : 0);
  const TileWalk tw = tw_init(n_mt, 44);
  for (int tile = tw.lb; tile < tw_count(tw); tile += tw.nlb) {
    int mi, nt; tw_decode(tw, tile, mi, nt);
    int seq0, Ls, ti;
    if (mi < 528) { seq0 = (mi / 66) * SEQ; Ls = SEQ; ti = mi % 66; } else { const int u = mi - 528; seq0 = TLAT + (u / 3) * CTXL; Ls = CTXL; ti = u % 3; }
    const int p0 = ti * 126 - 1;
    const int a_lo = ti == 0 ? 1 : 0, a_hi = min(128, Ls - p0);
    const int nout = min(126, Ls - ti * 126);
    f32x4 acc[4][4]; acc_zero(acc);
    gemm_kloop(acc, H + ((long)seq0 + p0) * LD1, LD1, a_lo, a_hi, W + (long)nt * 128 * LD1, LD1, 1024, smem, opaque_tid());
#pragma unroll
    for (int m = 0; m < 4; ++m)
#pragma unroll
      for (int n = 0; n < 4; ++n)
#pragma unroll
        for (int j = 0; j < 4; ++j) Zs[(wr * 64 + m * 16 + fq * 4 + j) * 132 + wc * 64 + n * 16 + fr] = acc[m][n][j];
    __syncthreads();
    {
      const int jc = tid & 63, rg = tid >> 6;
      const int ucol = (jc >> 5) * 64 + ((jc >> 4) & 1) * 32 + (jc & 15), gcol = ucol + 16;
      const int cu = nt * 64 + jc, cg = 2816 + cu;
      const float wu0 = cw[cu], wu1 = cw[5632 + cu], wu2 = cw[2 * 5632 + cu], bu = cb[cu];
      const float wg0 = cw[cg], wg1 = cw[5632 + cg], wg2 = cw[2 * 5632 + cg], bg = cb[cg];
      for (int r = 1 + rg; r <= nout; r += 4) {
        const float au = wu0 * Zs[(r - 1) * 132 + ucol] + wu1 * Zs[r * 132 + ucol] + wu2 * Zs[(r + 1) * 132 + ucol] + bu;
        const float ag = wg0 * Zs[(r - 1) * 132 + gcol] + wg1 * Zs[r * 132 + gcol] + wg2 * Zs[(r + 1) * 132 + gcol] + bg;
        F[((long)seq0 + p0 + r) * LD2 + cu] = (h16)(siluf_(au) * ag);
      }
    }
    __syncthreads();
  }
}
DI void phase_norm2(const Params& P, int layer) { normmod_rows(P, layer, 1, 1, layer == 0 ? TT : TLAT, blockIdx.x, gridDim.x); }

constexpr int N_PHASES = 22;
#ifndef PROBE_REPEAT
#define PROBE_REPEAT 0u
#endif
template <int PH> DI void run_phase_t(const Params& P, char* smem) {
  asm volatile("" ::: "memory");
  if constexpr (PH == 0) phase_prologue(P, smem);
  else if constexpr (PH == 21) phase_final(P);
  else {
    constexpr int layer = (PH - 1) / 10, s = (PH - 1) % 10;
    if constexpr (s == 0) phase_norm1(P, layer, smem);
    else if constexpr (s == 1) phase_gemm_in(P, layer, smem);
    else if constexpr (s == 2) phase_mix1(P, layer, smem);
    else if constexpr (s == 3) phase_mix2(P, layer, smem);
    else if constexpr (s == 4) phase_glu(P, layer, smem);
    else if constexpr (s == 5) phase_merge(P, layer, smem);
    else if constexpr (s == 6) phase_resid(P, layer, layer, OFF_MERGED, 1024, WT_WO, 2, smem);
    else if constexpr (s == 7) phase_norm2(P, layer);
    else if constexpr (s == 8) phase_ffn_up(P, layer, smem);
    else phase_resid(P, layer, 1, OFF_F, 2816, WT_DOWN, 5, smem);
  }
}
DI void run_phase(const Params& P, int ph, char* smem) {
  switch (ph) {
#define RP(i) case i: run_phase_t<i>(P, smem); break;
    RP(0) RP(1) RP(2) RP(3) RP(4) RP(5) RP(6) RP(7) RP(8) RP(9) RP(10) RP(11) RP(12) RP(13) RP(14) RP(15) RP(16) RP(17) RP(18) RP(19) RP(20) RP(21)
#undef RP
    default: break;
  }
}
#ifndef MULTI_LAUNCH
#define MULTI_LAUNCH 0
#endif
__global__ void __launch_bounds__(NTHREADS, 2) fwd_megakernel(Params P) {
  extern __shared__ __attribute__((aligned(16))) char smem[];
  cg::grid_group grid = cg::this_grid();
#define RP(i) run_phase_t<i>(P, smem); grid.sync(); if constexpr ((PROBE_REPEAT >> i) & 1) { run_phase_t<i>(P, smem); grid.sync(); }
  RP(0) RP(1) RP(2) RP(3) RP(4) RP(5) RP(6) RP(7) RP(8) RP(9) RP(10) RP(11) RP(12) RP(13) RP(14) RP(15) RP(16) RP(17) RP(18) RP(19) RP(20)
#undef RP
  run_phase_t<21>(P, smem);
}
#if MULTI_LAUNCH
__global__ void __launch_bounds__(NTHREADS, 2) fwd_phase_kernel(Params P, int ph) {
  extern __shared__ __attribute__((aligned(16))) char smem[];
  run_phase(P, ph, smem);
}
#endif

extern "C" void kernel_launch(void* const* d_in, const int* in_sizes, int n_in, void* d_out, int out_size, void* d_ws, size_t ws_size,
                              hipStream_t stream) {
  static int grid_blocks = 0;
  if (!grid_blocks) {
    int dev = 0, cus = 0, per_cu = 0;
    (void)hipGetDevice(&dev);
    (void)hipDeviceGetAttribute(&cus, hipDeviceAttributeMultiprocessorCount, dev);
    (void)hipFuncSetAttribute((const void*)fwd_megakernel, hipFuncAttributeMaxDynamicSharedMemorySize, SMEM_BYTES);
#if MULTI_LAUNCH
    (void)hipFuncSetAttribute((const void*)fwd_phase_kernel, hipFuncAttributeMaxDynamicSharedMemorySize, SMEM_BYTES);
#endif
    (void)hipOccupancyMaxActiveBlocksPerMultiprocessor(&per_cu, fwd_megakernel, NTHREADS, SMEM_BYTES);
    if (per_cu > 2) per_cu = 2;
    if (per_cu < 1) per_cu = 1;
#ifdef PROBE_FORCE2
    per_cu = 2;
#endif
    grid_blocks = cus * per_cu;
    if (ws_size < OFF_END) fprintf(stderr, "workspace too small: %zu < %zu\n", ws_size, (size_t)OFF_END);
  }
  Params p{};
  for (int i = 0; i < 41; ++i) p.in[i] = (const float*)d_in[i];
  p.out = (float*)d_out; p.ws = (char*)d_ws; p.pad_ = 0;
#if MULTI_LAUNCH
  for (int ph = 0; ph < N_PHASES; ++ph) hipLaunchKernelGGL(fwd_phase_kernel, dim3(grid_blocks), dim3(NTHREADS), SMEM_BYTES, stream, p, ph);
#else
  void* args[] = {&p};
  hipError_t e = hipLaunchCooperativeKernel((void*)fwd_megakernel, dim3(grid_blocks), dim3(NTHREADS), args, SMEM_BYTES, stream);
  if (e != hipSuccess) fprintf(stderr, "cooperative launch failed: %s (grid %d)\n", hipGetErrorString(e), grid_blocks);
#endif
}
```

```cpp
#include <hip/hip_runtime.h>
#include <hip/hip_cooperative_groups.h>
#include <cstdio>
namespace cg = cooperative_groups;

typedef _Float16 h16;
typedef _Float16 h16x8 __attribute__((ext_vector_type(8)));
typedef _Float16 h16x4 __attribute__((ext_vector_type(4)));
typedef float f32x4 __attribute__((ext_vector_type(4)));
typedef float f32x16 __attribute__((ext_vector_type(16)));
#define DI __device__ __forceinline__

constexpr int DM = 1024, NBATCH = 8, SEQ = 8192, CTXL = 256, TLAT = 65536, TCTX = 2048, TT = 67584;
constexpr int KEYS = SEQ + CTXL;
constexpr int NTHREADS = 256;
constexpr float EPS = 1e-6f;
constexpr float QSCALE = 0.10206207261596575f * 1.4426950408889634f;

constexpr int LD1 = 1088, LD2 = 2880;
constexpr long WT_WIN = 0, WT_WGATE = WT_WIN + 2432L * LD1, WT_UKV = WT_WGATE + 3072L * LD1, WT_UQ = WT_UKV + 1024L * 256,
               WT_GLU = WT_UQ + 1024L * 512, WT_BRHY = WT_GLU + 768L * 384, WT_BRS5 = WT_BRHY + 1024L * 384,
               WT_BRMLA = WT_BRS5 + 1024L * 384, WT_WO = WT_BRMLA + 1024L * 512, WT_UP = WT_WO + 1024L * LD1,
               WT_DOWN = WT_UP + 5632L * LD1, WT_LAYER = WT_DOWN + 1024L * LD2;
constexpr size_t al256(size_t x) { return (x + 255) / 256 * 256; }
constexpr size_t OFF_WT = 0;
constexpr size_t OFF_H1 = al256(OFF_WT + 2 * WT_LAYER * 2);
constexpr size_t OFF_U = al256(OFF_H1 + (size_t)TT * LD1 * 2);
constexpr size_t OFF_KVLAT = al256(OFF_U + (size_t)TT * 384 * 2);
constexpr size_t OFF_QLAT = al256(OFF_KVLAT + (size_t)TT * 256 * 2);
constexpr size_t OFF_PHY = al256(OFF_QLAT + (size_t)TT * 512 * 2);
constexpr size_t OFF_PHYC = al256(OFF_PHY + (size_t)NBATCH * 1152 * SEQ * 2);
constexpr size_t OFF_Q = al256(OFF_PHYC + (size_t)NBATCH * 1152 * CTXL * 2);
constexpr size_t OFF_K = al256(OFF_Q + (size_t)64 * KEYS * 96 * 2);
constexpr size_t OFF_VT = al256(OFF_K + (size_t)64 * KEYS * 96 * 2);
constexpr size_t OFF_YS5PRE = al256(OFF_VT + (size_t)64 * 64 * KEYS * 2);
constexpr size_t OFF_YHY = al256(OFF_YS5PRE + (size_t)TT * 384 * 2);
constexpr size_t OFF_FILT = al256(OFF_YHY + (size_t)TT * 384 * 2);
constexpr size_t OFF_TAPSC = al256(OFF_FILT + (size_t)768 * 2 * SEQ * 8);
constexpr size_t OFF_E = al256(OFF_TAPSC + (size_t)768 * 2 * CTXL * 4);
constexpr size_t OFF_XC = al256(OFF_E + (size_t)NBATCH * 2 * 24 * 132 * 64 * 8);
constexpr size_t OFF_MOD = al256(OFF_XC + (size_t)TCTX * 1024 * 4);
constexpr size_t OFF_Z2 = al256(OFF_MOD + (size_t)2 * 9 * 6144 * 4);
constexpr size_t OFF_Z2C = al256(OFF_Z2 + (size_t)2 * SEQ * 64 * 4);
constexpr size_t OFF_S5A = al256(OFF_Z2C + (size_t)2 * CTXL * 64 * 4);
constexpr size_t OFF_S5A64 = al256(OFF_S5A + (size_t)2 * 2 * 24 * 64 * 8);
constexpr size_t OFF_S5B = al256(OFF_S5A64 + (size_t)2 * 2 * 24 * 64 * 8);
constexpr size_t OFF_S5C = al256(OFF_S5B + (size_t)2 * 2 * 24 * 64 * 16 * 8);
constexpr size_t OFF_ROPE = al256(OFF_S5C + (size_t)2 * 2 * 24 * 16 * 128 * 2);
constexpr size_t OFF_BAR = al256(OFF_ROPE + (size_t)SEQ * 16 * 8);
constexpr size_t OFF_END = al256(OFF_BAR + (size_t)3456 * 4);
constexpr size_t OFF_YS5 = OFF_U, OFF_YMLA = OFF_QLAT, OFF_MERGED = OFF_Q, OFF_F = OFF_U, OFF_H2 = OFF_H1;
static_assert(OFF_END <= (size_t)1024 * 1024 * 1024, "workspace over 1 GiB");
static_assert(OFF_F + (size_t)TT * LD2 * 2 <= OFF_FILT, "f alias overruns");
static_assert(OFF_MERGED + (size_t)TT * LD1 * 2 <= OFF_VT, "merged alias overruns");

constexpr int SMEM_BYTES = 73728 + 2048;

struct Params {
  const float* in[41];
  float* out;
  char* ws;
  unsigned long long pad_;
};
enum { I_X = 0, I_C, I_CTX, I_CCTX, I_WMOD, I_BMOD, I_N1G, I_N2G, I_WIN, I_HCW, I_HCB, I_FW1, I_FB1, I_FW2, I_FB2, I_FW3, I_FFREQ,
       I_FDECAY, I_HBIAS, I_LAMRE, I_LAMIM, I_LOGSTEP, I_BRE, I_BIM, I_CRE, I_CIM, I_S5D, I_WGLU, I_GQ, I_WUQ, I_GKV, I_WUKV,
       I_WBRHY, I_WBRS5, I_WBRMLA, I_WO, I_WUP, I_FCW, I_FCB, I_WDOWN, I_FINALG };

DI int tidx() { int t = threadIdx.x; asm volatile("" : "+v"(t)); return t; }
DI int opaque_tid() { return tidx(); }
DI float sigmoidf_(float x) { return 1.f / (1.f + __expf(-x)); }
DI float siluf_(float x) { return x / (1.f + __expf(-x)); }
DI float geluf_(float x) { float z = 0.7978845608028654f * (x + 0.044715f * x * x * x); float t = 1.f - 2.f / (1.f + __expf(2.f * z)); return 0.5f * x * (1.f + t); }
DI float wave_sum(float v) { for (int o = 32; o > 0; o >>= 1) v += __shfl_xor(v, o); return v; }
DI float wave_max(float v) { for (int o = 32; o > 0; o >>= 1) v = fmaxf(v, __shfl_xor(v, o)); return v; }
DI void dsincos(double x, double& s, double& c) {
  const double TWO_PI = 6.283185307179586476925287;
  double r = x - TWO_PI * rint(x / TWO_PI);
  double r2 = r * r, ts = r, tc = 1.0; s = r; c = 1.0;
  for (int k = 1; k <= 15; ++k) { tc = -tc * r2 / (double)((2 * k - 1) * (2 * k)); c += tc; ts = -ts * r2 / (double)((2 * k) * (2 * k + 1)); s += ts; }
}
DI float2 twid(float f) { return make_float2(__builtin_amdgcn_cosf(f), __builtin_amdgcn_sinf(f)); }
DI float2 cmul(float2 a, float2 b) { return make_float2(a.x * b.x - a.y * b.y, a.x * b.y + a.y * b.x); }

struct Tok { int b, pos, ctx, mrow; };
DI Tok tokinfo(int t) { Tok k; if (t < TLAT) { k.b = t >> 13; k.pos = t & 8191; k.ctx = 0; k.mrow = k.b; } else { int u = t - TLAT; k.b = u >> 8; k.pos = u & 255; k.ctx = 1; k.mrow = 8; } return k; }

struct Stg { uint4 a0, a1, a2, a3, b0, b1, b2, b3; };
DI void g_load(Stg& s, const h16* __restrict__ A0, const h16* __restrict__ A1, const h16* __restrict__ A2, const h16* __restrict__ A3,
               const h16* __restrict__ Bp, long b32, int k0) {
  s.a0 = *reinterpret_cast<const uint4*>(A0 + k0); s.a1 = *reinterpret_cast<const uint4*>(A1 + k0);
  s.a2 = *reinterpret_cast<const uint4*>(A2 + k0); s.a3 = *reinterpret_cast<const uint4*>(A3 + k0);
  s.b0 = *reinterpret_cast<const uint4*>(Bp + k0); s.b1 = *reinterpret_cast<const uint4*>(Bp + b32 + k0);
  s.b2 = *reinterpret_cast<const uint4*>(Bp + 2 * b32 + k0); s.b3 = *reinterpret_cast<const uint4*>(Bp + 3 * b32 + k0);
}
DI uint4 zsel(uint4 v, bool ok) { return ok ? v : make_uint4(0, 0, 0, 0); }
DI void s_write(char* sw, const Stg& s, int okm) {
  *reinterpret_cast<uint4*>(sw) = zsel(s.a0, okm & 1); *reinterpret_cast<uint4*>(sw + 32 * 128) = zsel(s.a1, okm & 2);
  *reinterpret_cast<uint4*>(sw + 64 * 128) = zsel(s.a2, okm & 4); *reinterpret_cast<uint4*>(sw + 96 * 128) = zsel(s.a3, okm & 8);
  *reinterpret_cast<uint4*>(sw + 16384) = s.b0; *reinterpret_cast<uint4*>(sw + 16384 + 32 * 128) = s.b1; *reinterpret_cast<uint4*>(sw + 16384 + 64 * 128) = s.b2; *reinterpret_cast<uint4*>(sw + 16384 + 96 * 128) = s.b3;
}
#ifndef PROBE_MFMA
#define PROBE_MFMA 0
#endif
#if PROBE_MFMA
DI void mma_step(f32x4 (&acc)[4][4], const char* sa, const char* sb, int o0, int o1, f32x4 (&dmy)[2][4]) {
#else
DI void mma_step(f32x4 (&acc)[4][4], const char* sa, const char* sb, int o0, int o1) {
#endif
#pragma unroll
  for (int ks = 0; ks < 2; ++ks) {
    h16x8 af[4], bf[4];
    const int o = ks ? o1 : o0;
#pragma unroll
    for (int m = 0; m < 4; ++m) af[m] = *reinterpret_cast<const h16x8*>(sa + m * 16 * 128 + o);
#pragma unroll
    for (int n = 0; n < 4; ++n) bf[n] = *reinterpret_cast<const h16x8*>(sb + n * 16 * 128 + o);
#pragma unroll
    for (int m = 0; m < 4; ++m)
#pragma unroll
      for (int n = 0; n < 4; ++n) acc[m][n] = __builtin_amdgcn_mfma_f32_16x16x32_f16(af[m], bf[n], acc[m][n], 0, 0, 0);
#if PROBE_MFMA
#pragma unroll
    for (int m = 0; m < 2; ++m)
#pragma unroll
      for (int n = 0; n < 4; ++n) dmy[m][n] = __builtin_amdgcn_mfma_f32_16x16x32_f16(af[m + 2], bf[n], dmy[m][n], 0, 0, 0);
#endif
  }
}
DI void gemm_kloop_body(f32x4 (&acc)[4][4], const h16* __restrict__ A, long lda, int a_lo, int a_hi,
                   const h16* __restrict__ Bt, long ldb, int K, char* smem, int tid) {
  const int lane = tid & 63, wid = tid >> 6, wr = wid >> 1, wc = wid & 1, fr = lane & 15, fq = lane >> 4;
#if PROBE_MFMA
  f32x4 dmy[2][4];
  for (int m = 0; m < 2; ++m) for (int n = 0; n < 4; ++n) dmy[m][n] = f32x4{0.f, 0.f, 0.f, 0.f};
#define MMA(a, b, c, d, e) mma_step(a, b, c, d, e, dmy)
#else
#define MMA(a, b, c, d, e) mma_step(a, b, c, d, e)
#endif
  Stg s0, s1;
  const int srow = tid >> 3, skc = tid & 7;
  int okm = 0;
  const h16* Ar[4];
#pragma unroll
  for (int i = 0; i < 4; ++i) { const int row = srow + 32 * i; const bool ok = row >= a_lo && row < a_hi; okm |= ok ? (1 << i) : 0;
    const int rc = min(max(row, a_lo), a_hi - 1); Ar[i] = A + (long)rc * lda + skc * 8; }
  const h16* Bp = Bt + (long)srow * ldb + skc * 8;
  const long b32 = 32 * ldb;
  char* sw = smem + srow * 128 + ((skc ^ ((srow >> 1) & 7)) << 4);
  const char* sra = smem + (wr * 64 + fr) * 128; const char* srb = smem + 16384 + (wc * 64 + fr) * 128;
  const int o0 = (fq ^ ((fr >> 1) & 7)) << 4, o1 = ((4 + fq) ^ ((fr >> 1) & 7)) << 4;
  const int nk = K >> 6;
  g_load(s0, Ar[0], Ar[1], Ar[2], Ar[3], Bp, b32, 0); g_load(s1, Ar[0], Ar[1], Ar[2], Ar[3], Bp, b32, 64);
  s_write(sw, s0, okm); __syncthreads();
  for (int kt = 0; kt + 2 < nk; kt += 2) {
    g_load(s0, Ar[0], Ar[1], Ar[2], Ar[3], Bp, b32, (kt + 2) << 6);
    __builtin_amdgcn_sched_barrier(0);
    MMA(acc, sra, srb, o0, o1);
    __builtin_amdgcn_sched_barrier(0);
    s_write(sw + 32768, s1, okm);
    __syncthreads();
    g_load(s1, Ar[0], Ar[1], Ar[2], Ar[3], Bp, b32, (kt + 3) << 6);
    __builtin_amdgcn_sched_barrier(0);
    MMA(acc, sra + 32768, srb + 32768, o0, o1);
    __builtin_amdgcn_sched_barrier(0);
    s_write(sw, s0, okm);
    __syncthreads();
  }
  MMA(acc, sra, srb, o0, o1);
  s_write(sw + 32768, s1, okm);
  __syncthreads();
  MMA(acc, sra + 32768, srb + 32768, o0, o1);
  __syncthreads();
#if PROBE_MFMA
  { float z = 0.f; asm volatile("" : "+v"(z)); for (int m = 0; m < 2; ++m) for (int n = 0; n < 4; ++n) acc[m][n] += dmy[m][n] * z; }
#endif
#undef MMA
}
#ifndef PROBE_KLOOP
#define PROBE_KLOOP 0
#endif
DI void gemm_kloop(f32x4 (&acc)[4][4], const h16* __restrict__ A, long lda, int a_lo, int a_hi,
                   const h16* __restrict__ Bt, long ldb, int K, char* smem, int tid) {
  gemm_kloop_body(acc, A, lda, a_lo, a_hi, Bt, ldb, K, smem, tid);
}
struct TileWalk { int lb, nlb, m0, Mx, NT, nfull; };
DI TileWalk tw_init(int MT, int NT) { TileWalk w; w.lb = blockIdx.x >> 3; w.nlb = gridDim.x >> 3; w.Mx = MT >> 3; w.m0 = (blockIdx.x & 7) * w.Mx; w.NT = NT; w.nfull = (w.Mx >> 3) * 8 * NT; return w; }
DI int tw_count(const TileWalk& w) { return w.Mx * w.NT; }
DI void tw_decode(const TileWalk& w, int idx, int& mt, int& nt) {
  if (idx < w.nfull) { const int mg = idx / (8 * w.NT), r = idx % (8 * w.NT); nt = r >> 3; mt = w.m0 + mg * 8 + (r & 7); }
  else { const int rem = w.Mx & 7, r = idx - w.nfull; nt = r / rem; mt = w.m0 + (w.Mx & ~7) + r % rem; }
}
DI void stage_acc(const f32x4 (&acc)[4][4], float* Zs, int tid) {
  const int lane = tid & 63, wid = tid >> 6, wr = wid >> 1, wc = wid & 1, fr = lane & 15, fq = lane >> 4;
#pragma unroll
  for (int m = 0; m < 4; ++m)
#pragma unroll
    for (int n = 0; n < 4; ++n)
#pragma unroll
      for (int j = 0; j < 4; ++j) Zs[(wr * 64 + m * 16 + fq * 4 + j) * 132 + wc * 64 + n * 16 + fr] = acc[m][n][j];
  __syncthreads();
}
DI void stage_acc_t(const f32x4 (&acc)[4][4], float* Zs, int tid) {
  const int lane = tid & 63, wid = tid >> 6, wr = wid >> 1, wc = wid & 1, fr = lane & 15, fq = lane >> 4;
#pragma unroll
  for (int m = 0; m < 4; ++m)
#pragma unroll
    for (int n = 0; n < 4; ++n)
      *reinterpret_cast<float4*>(Zs + (wc * 64 + n * 16 + fr) * 132 + wr * 64 + m * 16 + fq * 4) = make_float4(acc[m][n][0], acc[m][n][1], acc[m][n][2], acc[m][n][3]);
  __syncthreads();
}
DI void copy_out_f16(const float* Zs, h16* __restrict__ dst, long row0, long ld, int cb, int tid) {
#pragma unroll
  for (int it = 0; it < 8; ++it) {
    const int chunk = it * 256 + tid, row = chunk >> 4, c8 = (chunk & 15) * 8;
    const float4 x0 = *reinterpret_cast<const float4*>(Zs + row * 132 + c8), x1 = *reinterpret_cast<const float4*>(Zs + row * 132 + c8 + 4);
    h16x8 o; o[0] = (h16)x0.x; o[1] = (h16)x0.y; o[2] = (h16)x0.z; o[3] = (h16)x0.w; o[4] = (h16)x1.x; o[5] = (h16)x1.y; o[6] = (h16)x1.z; o[7] = (h16)x1.w;
    *reinterpret_cast<h16x8*>(dst + (row0 + row) * ld + cb + c8) = o;
  }
}
DI void acc_zero(f32x4 (&acc)[4][4]) {
#pragma unroll
  for (int m = 0; m < 4; ++m)
#pragma unroll
    for (int n = 0; n < 4; ++n) acc[m][n] = f32x4{0.f, 0.f, 0.f, 0.f};
}
DI void row_rms(const h16* __restrict__ A, long lda, int K, float* rs) {
  const int tid = tidx(), row = tid >> 1, half = tid & 1;
  const h16* p = A + (long)row * lda + half * (K >> 1);
  float ss = 0.f;
  for (int k = 0; k < (K >> 1); k += 8) {
    h16x8 v = *reinterpret_cast<const h16x8*>(p + k);
#pragma unroll
    for (int j = 0; j < 8; ++j) { float f = (float)v[j]; ss += f * f; }
  }
  ss += __shfl_xor(ss, 1);
  if (half == 0) rs[row] = rsqrtf(ss / (float)K + EPS);
}
DI int map_interleave(int n, int half) { int tile = n >> 7, r = n & 127, sub = r >> 4, fr = r & 15; int j = tile * 64 + (sub >> 1) * 16 + fr; return (sub & 1) ? half + j : j; }
DI int map_col(int mat, int n) {
  switch (mat) {
    case 0: if (n < 640) return n; if (n < 2304) return n + 32; if (n < 2336) return n - 2304 + 640; return -1;
    case 1: return 2336 + n;
    case 3: { int h = n >> 7, j = n & 127; return j < 96 ? h * 96 + j : -1; }
    case 4: return map_interleave(n, 384);
    case 9: return map_interleave(n, 2816);
    default: return n;
  }
}
struct MatDesc { const float* src; const float* scale; long dst; int K, Nmy, Nsrc, ld; };
DI MatDesc get_mat(const Params& P, int layer, int mat) {
  MatDesc d; d.scale = nullptr;
  d.ld = (mat == 0 || mat == 1 || mat == 8 || mat == 9) ? LD1 : 0;
  switch (mat) {
    case 0: d.src = P.in[I_WIN] + (long)layer * 1024 * 5408; d.dst = WT_WIN; d.K = 1024; d.Nmy = 2432; d.Nsrc = 5408; break;
    case 1: d.src = P.in[I_WIN] + (long)layer * 1024 * 5408; d.dst = WT_WGATE; d.K = 1024; d.Nmy = 3072; d.Nsrc = 5408; break;
    case 2: d.src = P.in[I_WUKV] + (long)layer * 256 * 1024; d.dst = WT_UKV; d.K = 256; d.Nmy = 1024; d.Nsrc = 1024; d.scale = P.in[I_GKV] + layer * 256; break;
    case 3: d.src = P.in[I_WUQ] + (long)layer * 512 * 768; d.dst = WT_UQ; d.K = 512; d.Nmy = 1024; d.Nsrc = 768; d.scale = P.in[I_GQ] + layer * 512; break;
    case 4: d.src = P.in[I_WGLU] + (long)layer * 384 * 768; d.dst = WT_GLU; d.K = 384; d.Nmy = 768; d.Nsrc = 768; break;
    case 5: d.src = P.in[I_WBRHY] + (long)layer * 384 * 1024; d.dst = WT_BRHY; d.K = 384; d.Nmy = 1024; d.Nsrc = 1024; break;
    case 6: d.src = P.in[I_WBRS5] + (long)layer * 384 * 1024; d.dst = WT_BRS5; d.K = 384; d.Nmy = 1024; d.Nsrc = 1024; break;
    case 7: d.src = P.in[I_WBRMLA] + (long)layer * 512 * 1024; d.dst = WT_BRMLA; d.K = 512; d.Nmy = 1024; d.Nsrc = 1024; break;
    case 8: d.src = P.in[I_WO] + (long)layer * 1024 * 1024; d.dst = WT_WO; d.K = 1024; d.Nmy = 1024; d.Nsrc = 1024; break;
    case 9: d.src = P.in[I_WUP] + (long)layer * 1024 * 5632; d.dst = WT_UP; d.K = 1024; d.Nmy = 5632; d.Nsrc = 5632; break;
    default: d.src = P.in[I_WDOWN] + (long)layer * 2816 * 1024; d.dst = WT_DOWN; d.K = 2816; d.Nmy = 1024; d.Nsrc = 1024; d.ld = LD2; break;
  }
  if (d.ld == 0) d.ld = d.K;
  return d;
}
constexpr int WT_TILES_PER_LAYER = 608 + 768 + 64 + 128 + 72 + 96 + 96 + 128 + 256 + 1408 + 704;
DI void item_wt(const Params& P, int item, char* smem) {
  const int layer = item / WT_TILES_PER_LAYER; int r = item % WT_TILES_PER_LAYER;
  const int cnt[11] = {608, 768, 64, 128, 72, 96, 96, 128, 256, 1408, 704};
  int mat = 0;
#pragma unroll
  for (int i = 0; i < 10; ++i) { if (mat == i && r >= cnt[i]) { r -= cnt[i]; mat = i + 1; } }
  MatDesc d = get_mat(P, layer, mat);
  const int kt = d.K >> 6, n0 = (r / kt) * 64, k0 = (r % kt) * 64;
  float* tile = reinterpret_cast<float*>(smem);
  h16* dst = reinterpret_cast<h16*>(P.ws + OFF_WT) + (long)layer * WT_LAYER + d.dst;
  const int tid = tidx(), lx = tid & 63, ly = tid >> 6;
  const int sc = map_col(mat, n0 + lx);
#pragma unroll 4
  for (int i = 0; i < 16; ++i) { int kk = i * 4 + ly; tile[kk * 65 + lx] = sc >= 0 ? d.src[(long)(k0 + kk) * d.Nsrc + sc] : 0.f; }
  __syncthreads();
  const float s = d.scale ? d.scale[k0 + lx] : 1.f;
#pragma unroll 4
  for (int i = 0; i < 16; ++i) { int nn = i * 4 + ly; dst[(long)(n0 + nn) * d.ld + k0 + lx] = (h16)(tile[lx * 65 + nn] * s); }
  __syncthreads();
}
DI void item_mod(const Params& P, int item, char* smem) {
  const int layer = item / 96, n0 = (item % 96) * 64;
  float* s = reinterpret_cast<float*>(smem);
  float* part = s + 9 * 1024;
  const int tid = tidx(), lane = tid & 63, wid = tid >> 6;
  for (int i = tid; i < 9 * 1024; i += NTHREADS) { float v = i < 8192 ? P.in[I_C][i] : P.in[I_CCTX][i - 8192]; s[i] = siluf_(v); }
  __syncthreads();
  const float* w = P.in[I_WMOD] + (long)layer * 1024 * 6144 + n0 + lane;
  float acc[9];
#pragma unroll
  for (int r = 0; r < 9; ++r) acc[r] = 0.f;
  for (int k = wid * 256; k < wid * 256 + 256; ++k) {
    const float wv = w[(long)k * 6144];
#pragma unroll
    for (int r = 0; r < 9; ++r) acc[r] += s[r * 1024 + k] * wv;
  }
#pragma unroll
  for (int r = 0; r < 9; ++r) part[(wid * 9 + r) * 64 + lane] = acc[r];
  __syncthreads();
  float* mod = reinterpret_cast<float*>(P.ws + OFF_MOD) + (long)layer * 9 * 6144;
  for (int i = tid; i < 9 * 64; i += NTHREADS) {
    const int r = i >> 6, c = i & 63;
    mod[r * 6144 + n0 + c] = part[(0 * 9 + r) * 64 + c] + part[(1 * 9 + r) * 64 + c] + part[(2 * 9 + r) * 64 + c] + part[(3 * 9 + r) * 64 + c] + P.in[I_BMOD][layer * 6144 + n0 + c];
  }
  __syncthreads();
}
DI void item_hymlp(const Params& P, int item, char* smem) {
  const int layer = item / 132; int r = item % 132;
  const int isc = r >= 128; const int Lf = isc ? CTXL : SEQ; const int t0 = (isc ? r - 128 : r) * 64;
  float* z1 = reinterpret_cast<float*>(smem);
  const int tid = tidx(), tl = tid >> 2, h0 = (tid & 3) * 16; const int t = t0 + tl;
  const float* w1 = P.in[I_FW1] + layer * 17 * 64; const float* b1 = P.in[I_FB1] + layer * 64;
  const float* w2 = P.in[I_FW2] + layer * 64 * 64; const float* b2 = P.in[I_FB2] + layer * 64; const float* fq = P.in[I_FFREQ] + layer * 64;
  float feat[17]; feat[0] = (float)t / (float)Lf;
#pragma unroll
  for (int k = 1; k <= 8; ++k) { float rev = (float)((t * k) % Lf) / (float)Lf; feat[k] = __builtin_amdgcn_cosf(rev); feat[8 + k] = __builtin_amdgcn_sinf(rev); }
#pragma unroll 4
  for (int j = 0; j < 16; ++j) {
    const int h = h0 + j; float a = b1[h];
#pragma unroll
    for (int f = 0; f < 17; ++f) a += feat[f] * w1[f * 64 + h];
    z1[tl * 65 + h] = __sinf(fq[h] * a);
  }
  __syncthreads();
  float* z2 = isc ? reinterpret_cast<float*>(P.ws + OFF_Z2C) + (long)layer * CTXL * 64 : reinterpret_cast<float*>(P.ws + OFF_Z2) + (long)layer * SEQ * 64;
  float a2[16];
#pragma unroll
  for (int j = 0; j < 16; ++j) a2[j] = b2[h0 + j];
  for (int k = 0; k < 64; ++k) {
    const float zv = z1[tl * 65 + k];
#pragma unroll
    for (int j = 0; j < 16; ++j) a2[j] += zv * w2[k * 64 + h0 + j];
  }
#pragma unroll
  for (int j = 0; j < 16; ++j) z2[(long)t * 64 + h0 + j] = __sinf(fq[h0 + j] * a2[j]);
  __syncthreads();
}
DI void item_s5disc(const Params& P, int item) {
  const int layer = item / 12, dir = (item % 12) / 6, gb = item % 6;
  const int tid = tidx(), g = gb * 4 + (tid >> 6), n = tid & 63;
  const int ld = layer * 2 + dir; const long gi = (long)ld * 24 + g;
  const double lre = P.in[I_LAMRE][gi * 64 + n], lim = P.in[I_LAMIM][gi * 64 + n];
  const double step = exp((double)P.in[I_LOGSTEP][gi]);
  double sn, cs; dsincos(lim * step, sn, cs);
  const double mag = exp(lre * step);
  const double are = mag * cs, aim = mag * sn;
  const double nr = are - 1.0, ni = aim, den = lre * lre + lim * lim;
  const double fre = (nr * lre + ni * lim) / den, fim = (ni * lre - nr * lim) / den;
  float2* A = reinterpret_cast<float2*>(P.ws + OFF_S5A); float2* A64 = reinterpret_cast<float2*>(P.ws + OFF_S5A64);
  A[gi * 64 + n] = make_float2((float)are, (float)aim);
  double pr = are, pi = aim;
  for (int i = 0; i < 6; ++i) { double t = pr * pr - pi * pi; pi = 2.0 * pr * pi; pr = t; }
  A64[gi * 64 + n] = make_float2((float)pr, (float)pi);
  float2* Bb = reinterpret_cast<float2*>(P.ws + OFF_S5B) + (gi * 64 + n) * 16;
  const float* bre = P.in[I_BRE] + (gi * 64 + n) * 16; const float* bim = P.in[I_BIM] + (gi * 64 + n) * 16;
  for (int c = 0; c < 16; ++c) { double br = bre[c], bi = bim[c]; Bb[c] = make_float2((float)(fre * br - fim * bi), (float)(fre * bi + fim * br)); }
  h16* Ct = reinterpret_cast<h16*>(P.ws + OFF_S5C) + gi * 16 * 128;
  const float* cre = P.in[I_CRE] + gi * 16 * 64; const float* cim = P.in[I_CIM] + gi * 16 * 64;
  for (int c = 0; c < 16; ++c) { Ct[c * 128 + n] = (h16)cre[c * 64 + n]; Ct[c * 128 + 64 + n] = (h16)(-cim[c * 64 + n]); }
}
DI void item_rope(const Params& P, int item) {
  const int idx = item * NTHREADS + tidx(); const int pos = idx >> 4, i = idx & 15;
  const double inv[8] = {1.0, 0.31622776601683794, 0.1, 0.031622776601683794, 0.01, 0.0031622776601683794, 0.001, 0.00031622776601683794};
  double iv = 1.0;
#pragma unroll
  for (int k = 0; k < 8; ++k) if ((i & 7) == k) iv = inv[k];
  const double ang = (double)(i < 8 ? (pos >> 6) : (pos & 63)) * iv;
  double s, c; dsincos(ang, s, c);
  reinterpret_cast<float2*>(P.ws + OFF_ROPE)[idx] = make_float2((float)c, (float)s);
}
constexpr int PRO_N_WT = 2 * WT_TILES_PER_LAYER, PRO_N_MOD = 192, PRO_N_HY = 264, PRO_N_S5 = 24, PRO_N_ROPE = 512;
DI void phase_prologue(const Params& P, char* smem) {
  const int total = PRO_N_MOD + PRO_N_HY + PRO_N_S5 + PRO_N_ROPE + PRO_N_WT;
  for (int it = blockIdx.x; it < total; it += gridDim.x) {
    int i = it;
    if (i < PRO_N_MOD) { item_mod(P, i, smem); continue; } i -= PRO_N_MOD;
    if (i < PRO_N_HY) { item_hymlp(P, i, smem); continue; } i -= PRO_N_HY;
    if (i < PRO_N_S5) { item_s5disc(P, i); continue; } i -= PRO_N_S5;
    if (i < PRO_N_ROPE) { item_rope(P, i); continue; } i -= PRO_N_ROPE;
    item_wt(P, i, smem);
  }
}

DI const float* xrow_src(const Params& P, int layer_stage, int t) {
  if (t < TLAT) return (layer_stage == 0 ? P.in[I_X] : P.out) + (long)t * 1024;
  return (layer_stage == 0 ? P.in[I_CTX] : reinterpret_cast<const float*>(P.ws + OFF_XC)) + (long)(t - TLAT) * 1024;
}
DI float* xrow_dst(const Params& P, int t) {
  if (t < TLAT) return P.out + (long)t * 1024;
  return reinterpret_cast<float*>(P.ws + OFF_XC) + (long)(t - TLAT) * 1024;
}
DI void normmod_rows(const Params& P, int layer, int which, int stage, int ntok, int item, int nitems_stride) {
  const int tid = tidx(), lane = tid & 63, wid = tid >> 6;
  const float* g = P.in[which ? I_N2G : I_N1G] + layer * 1024;
  const float* mod = reinterpret_cast<const float*>(P.ws + OFF_MOD) + (long)layer * 9 * 6144;
  h16* H = reinterpret_cast<h16*>(P.ws + OFF_H1);
  for (int rg = item; rg * 4 < ntok; rg += nitems_stride) {
    const int t = rg * 4 + wid;
    const Tok k = tokinfo(t);
    const float* xr = xrow_src(P, stage, t);
    const float* sh = mod + k.mrow * 6144 + (which ? 3 : 0) * 1024; const float* sc = sh + 1024;
    float4 v[4]; float ss = 0.f;
#pragma unroll
    for (int i = 0; i < 4; ++i) { v[i] = *reinterpret_cast<const float4*>(xr + i * 256 + lane * 4); ss += v[i].x * v[i].x + v[i].y * v[i].y + v[i].z * v[i].z + v[i].w * v[i].w; }
    ss = wave_sum(ss);
    const float r = rsqrtf(ss * (1.f / 1024.f) + EPS);
#pragma unroll
    for (int i = 0; i < 4; ++i) {
      const int c = i * 256 + lane * 4;
      const float4 gg = *reinterpret_cast<const float4*>(g + c), s1 = *reinterpret_cast<const float4*>(sc + c), s0 = *reinterpret_cast<const float4*>(sh + c);
      h16x4 o;
      o[0] = (h16)(v[i].x * r * gg.x * (1.f + s1.x) + s0.x); o[1] = (h16)(v[i].y * r * gg.y * (1.f + s1.y) + s0.y);
      o[2] = (h16)(v[i].z * r * gg.z * (1.f + s1.z) + s0.z); o[3] = (h16)(v[i].w * r * gg.w * (1.f + s1.w) + s0.w);
      *reinterpret_cast<h16x4*>(H + (long)t * LD1 + c) = o;
    }
  }
}
DI void phase_final(const Params& P) {
  const int lane = tidx() & 63, wid = tidx() >> 6;
  const float* g = P.in[I_FINALG];
  for (int rg = blockIdx.x; rg * 4 < TLAT; rg += gridDim.x) {
    float* xr = P.out + (long)(rg * 4 + wid) * 1024;
    float4 v[4]; float ss = 0.f;
#pragma unroll
    for (int i = 0; i < 4; ++i) { v[i] = *reinterpret_cast<const float4*>(xr + i * 256 + lane * 4); ss += v[i].x * v[i].x + v[i].y * v[i].y + v[i].z * v[i].z + v[i].w * v[i].w; }
    ss = wave_sum(ss);
    const float r = rsqrtf(ss * (1.f / 1024.f) + EPS);
#pragma unroll
    for (int i = 0; i < 4; ++i) {
      const int c = i * 256 + lane * 4; const float4 gg = *reinterpret_cast<const float4*>(g + c);
      *reinterpret_cast<float4*>(xr + c) = make_float4(v[i].x * r * gg.x, v[i].y * r * gg.y, v[i].z * r * gg.z, v[i].w * r * gg.w);
    }
  }
}
DI float2 r8(int idx) { const float c = 0.70710678118654752f; return idx == 0 ? make_float2(1.f, 0.f) : idx == 1 ? make_float2(c, -c) : idx == 2 ? make_float2(0.f, -1.f) : make_float2(-c, -c); }
DI float2 cmul_r8(float2 w, int idx, bool cj) {
  if (idx == 0) return w;
  float2 r = r8(idx); if (cj) r.y = -r.y;
  return cmul(w, r);
}
template <int S> DI void fft_dif_pass(float2* X, int h) {
  const int hs = h >> (S - 1);
#pragma unroll 1
  for (int item = tidx(); item < (8192 >> S); item += NTHREADS) {
    const int j = item % hs, blk = item / hs, i0 = blk * 2 * h + j;
    float2 v[1 << S];
#pragma unroll
    for (int k = 0; k < (1 << S); ++k) v[k] = X[i0 + k * hs];
    float2 wp[S];
    wp[0] = twid(-(float)j / (float)(2 * h));
#pragma unroll
    for (int q = 1; q < S; ++q) wp[q] = cmul(wp[q - 1], wp[q - 1]);
#pragma unroll
    for (int q = 0; q < S; ++q) {
      const int dist = 1 << (S - 1 - q);
#pragma unroll
      for (int k = 0; k < (1 << S); ++k) {
        if (k & dist) continue;
        const float2 a = v[k], b = v[k + dist];
        const int m = k & (dist - 1);
        const float2 tw = cmul_r8(wp[q], m << (3 - (S - q)), false);
        v[k] = make_float2(a.x + b.x, a.y + b.y);
        v[k + dist] = cmul(make_float2(a.x - b.x, a.y - b.y), tw);
      }
    }
#pragma unroll
    for (int k = 0; k < (1 << S); ++k) X[i0 + k * hs] = v[k];
  }
  __syncthreads();
}
template <int S> DI void fft_dit_pass(float2* X, int hs) {
  const int hmax = hs << (S - 1);
#pragma unroll 1
  for (int item = tidx(); item < (8192 >> S); item += NTHREADS) {
    const int j = item % hs, blk = item / hs, i0 = blk * 2 * hmax + j;
    float2 v[1 << S];
#pragma unroll
    for (int k = 0; k < (1 << S); ++k) v[k] = X[i0 + k * hs];
    float2 bp[S];
    bp[S - 1] = twid((float)j / (float)(2 * hmax));
#pragma unroll
    for (int q = S - 2; q >= 0; --q) bp[q] = cmul(bp[q + 1], bp[q + 1]);
#pragma unroll
    for (int q = 0; q < S; ++q) {
      const int dist = 1 << q;
#pragma unroll
      for (int k = 0; k < (1 << S); ++k) {
        if (k & dist) continue;
        const int m = k & (dist - 1);
        const float2 tw = cmul_r8(bp[q], m << (3 - (q + 1)), true);
        const float2 a = v[k], b = cmul(v[k + dist], tw);
        v[k] = make_float2(a.x + b.x, a.y + b.y);
        v[k + dist] = make_float2(a.x - b.x, a.y - b.y);
      }
    }
#pragma unroll
    for (int k = 0; k < (1 << S); ++k) X[i0 + k * hs] = v[k];
  }
  __syncthreads();
}
DI void fft_fwd(float2* X) { fft_dif_pass<3>(X, 4096); fft_dif_pass<3>(X, 512); fft_dif_pass<3>(X, 64); fft_dif_pass<2>(X, 8); fft_dif_pass<2>(X, 2); }
DI void fft_inv(float2* X) { fft_dit_pass<2>(X, 1); fft_dit_pass<2>(X, 4); fft_dit_pass<3>(X, 16); fft_dit_pass<3>(X, 128); fft_dit_pass<3>(X, 1024); }

DI float block_sum(float v, float* red) {
  v = wave_sum(v);
  __syncthreads();
  if ((tidx() & 63) == 0) red[tidx() >> 6] = v;
  __syncthreads();
  const float r = red[0] + red[1] + red[2] + red[3];
  __syncthreads();
  return r;
}
DI void item_filter(const Params& P, int layer, int oc, char* smem) {
  float2* X = reinterpret_cast<float2*>(smem); float* red = reinterpret_cast<float*>(smem + 65536);
  const int tid = tidx();
  const float* z2 = reinterpret_cast<const float*>(P.ws + OFF_Z2) + (long)layer * SEQ * 64;
  const float* w3 = P.in[I_FW3] + (long)layer * 64 * 1536; const float* dec = P.in[I_FDECAY] + layer * 1536;
  const int colf = oc, colb = 768 + oc;
  const float df = fabsf(dec[colf]), db = fabsf(dec[colb]);
  float lsum = 0.f;
#pragma unroll 2
  for (int i = 0; i < 32; ++i) {
    const int t = tid + 256 * i; const float* zr = z2 + (long)t * 64;
    float af = 0.f, ab = 0.f;
#pragma unroll 8
    for (int k = 0; k < 64; ++k) { const float z = zr[k]; af += z * w3[k * 1536 + colf]; ab += z * w3[k * 1536 + colb]; }
    const float tn = (float)t * (1.f / 8192.f);
    af *= __expf(-tn * df); ab *= __expf(-tn * db);
    lsum += fabsf(af) + fabsf(ab);
    X[t] = make_float2(af, ab);
  }
  const float nrm = block_sum(lsum, red);
  const float sc = 0.5f / 8192.f / nrm;
  float ev[32];
  float2* F = reinterpret_cast<float2*>(P.ws + OFF_FILT) + (long)oc * 2 * 8192;
#pragma unroll
  for (int i = 0; i < 32; ++i) {
    const int n = tid + 256 * i; const float lo = X[n].x; const float hi = n > 0 ? X[8192 - n].y : 0.f;
    ev[i] = (lo + hi) * sc; F[8192 + n] = make_float2((lo - hi) * sc, 0.f);
  }
  __syncthreads();
#pragma unroll
  for (int i = 0; i < 32; ++i) X[tid + 256 * i] = make_float2(ev[i], 0.f);
  __syncthreads();
  fft_fwd(X);
#pragma unroll 4
  for (int i = 0; i < 32; ++i) F[tid + 256 * i] = X[tid + 256 * i];
  __syncthreads();
#pragma unroll 4
  for (int i = 0; i < 32; ++i) { const int n = tid + 256 * i; const float d = F[8192 + n].x; const float2 w = twid(-(float)n * (1.f / 16384.f)); X[n] = make_float2(d * w.x, d * w.y); }
  __syncthreads();
  fft_fwd(X);
#pragma unroll 4
  for (int i = 0; i < 32; ++i) F[8192 + tid + 256 * i] = X[tid + 256 * i];
  __syncthreads();
}
DI void item_filter_ctx(const Params& P, int layer, int oc, char* smem) {
  float* red = reinterpret_cast<float*>(smem);
  const int t = tidx();
  const float* zr = reinterpret_cast<const float*>(P.ws + OFF_Z2C) + (long)layer * CTXL * 64 + t * 64;
  const float* w3 = P.in[I_FW3] + (long)layer * 64 * 1536; const float* dec = P.in[I_FDECAY] + layer * 1536;
  float af = 0.f, ab = 0.f;
  for (int k = 0; k < 64; ++k) { const float z = zr[k]; af += z * w3[k * 1536 + oc]; ab += z * w3[k * 1536 + 768 + oc]; }
  const float tn = (float)t * (1.f / 256.f);
  af *= __expf(-tn * fabsf(dec[oc])); ab *= __expf(-tn * fabsf(dec[768 + oc]));
  const float nrm = block_sum(fabsf(af) + fabsf(ab), red);
  float* T = reinterpret_cast<float*>(P.ws + OFF_TAPSC) + (long)oc * 512;
  T[t] = af / nrm; T[256 + t] = ab / nrm;
}

DI void phase_norm1(const Params& P, int layer, char* smem) {
  const int nfilt = 768 + (layer == 0 ? 768 : 0);
  for (int it = blockIdx.x; it < nfilt; it += gridDim.x) {
    if (it < 768) item_filter(P, layer, it, smem); else item_filter_ctx(P, layer, it - 768, smem);
  }
  normmod_rows(P, layer, 0, layer, TT, blockIdx.x, gridDim.x);
}

DI void phase_gemm_in(const Params& P, int layer, char* smem) {
  const int tid = tidx(), lane = tid & 63, wid = tid >> 6, wr = wid >> 1, wc = wid & 1, fr = lane & 15, fq = lane >> 4;
  const h16* H = reinterpret_cast<const h16*>(P.ws + OFF_H1);
  const h16* W = reinterpret_cast<const h16*>(P.ws + OFF_WT) + (long)layer * WT_LAYER + WT_WIN;
  h16* U = reinterpret_cast<h16*>(P.ws + OFF_U); h16* KV = reinterpret_cast<h16*>(P.ws + OFF_KVLAT); h16* QL = reinterpret_cast<h16*>(P.ws + OFF_QLAT);
  h16* PHY = reinterpret_cast<h16*>(P.ws + OFF_PHY); h16* PHYC = reinterpret_cast<h16*>(P.ws + OFF_PHYC); h16* Kb = reinterpret_cast<h16*>(P.ws + OFF_K);
  const float2* rope = reinterpret_cast<const float2*>(P.ws + OFF_ROPE);
  constexpr int NT = 19, MT = TT / 128;
  const TileWalk tw = tw_init(MT, NT);
  for (int tile = tw.lb; tile < tw_count(tw); tile += tw.nlb) {
    int mt, nt; tw_decode(tw, tile, mt, nt);
    f32x4 acc[4][4]; acc_zero(acc);
    gemm_kloop(acc, H + (long)mt * 128 * LD1, LD1, 0, 128, W + (long)nt * 128 * LD1, LD1, 1024, smem, opaque_tid());
    const int t0 = mt * 128; const Tok tk = tokinfo(t0);
    if (nt < 18) {
      float* Zs = reinterpret_cast<float*>(smem);
      const int t2 = tidx();
      if (nt < 9) {
        stage_acc(acc, Zs, t2);
        h16* dst; int ld, cb;
        if (nt < 3) { dst = U; ld = 384; cb = nt * 128; } else if (nt < 5) { dst = KV; ld = 256; cb = (nt - 3) * 128; } else { dst = QL; ld = 512; cb = (nt - 5) * 128; }
        copy_out_f16(Zs, dst, t0, ld, cb, t2);
      } else {
        stage_acc_t(acc, Zs, t2);
        h16* base = tk.ctx ? PHYC + (long)tk.b * 1152 * CTXL : PHY + (long)tk.b * 1152 * SEQ; const int lp = tk.ctx ? CTXL : SEQ;
        copy_out_f16(Zs, base, (nt - 9) * 128, lp, tk.pos, t2);
      }
      __syncthreads();
    } else if (wc == 0) {
#pragma unroll
      for (int m = 0; m < 4; ++m)
#pragma unroll
        for (int j = 0; j < 4; ++j) {
          const int pos = tk.pos + wr * 64 + m * 16 + fq * 4 + j; const int key = tk.ctx ? SEQ + pos : pos;
          float x1 = acc[m][0][j], x2 = acc[m][1][j];
          if (!tk.ctx) { const float2 cs = rope[pos * 16 + fr]; const float y1 = x1 * cs.x - x2 * cs.y, y2 = x1 * cs.y + x2 * cs.x; x1 = y1; x2 = y2; }
#pragma unroll
          for (int h = 0; h < 8; ++h) { h16* kr = Kb + ((long)(tk.b * 8 + h) * KEYS + key) * 96 + 64; kr[fr] = (h16)x1; kr[16 + fr] = (h16)x2; }
        }
    }
  }
}
DI void item_kv(const Params& P, int layer, int tile, char* smem) {
  const int tid = tidx(), lane = tid & 63, wid = tid >> 6, wr = wid >> 1, wc = wid & 1, fr = lane & 15, fq = lane >> 4;
  const int mt = tile >> 3, hd = tile & 7; const int t0 = mt * 128; const Tok tk = tokinfo(t0);
  const h16* A = reinterpret_cast<const h16*>(P.ws + OFF_KVLAT) + (long)t0 * 256;
  const h16* W = reinterpret_cast<const h16*>(P.ws + OFF_WT) + (long)layer * WT_LAYER + WT_UKV + (long)hd * 128 * 256;
  float* rs = reinterpret_cast<float*>(smem + 73728);
  row_rms(A, 256, 256, rs);
  f32x4 acc[4][4]; acc_zero(acc);
  gemm_kloop(acc, A, 256, 0, 128, W, 256, 256, smem, opaque_tid());
  h16* Kb = reinterpret_cast<h16*>(P.ws + OFF_K) + (long)(tk.b * 8 + hd) * KEYS * 96;
  h16* Vt = reinterpret_cast<h16*>(P.ws + OFF_VT) + (long)(tk.b * 8 + hd) * 64 * KEYS;
  const int key0 = (tk.ctx ? SEQ : 0) + tk.pos;
#pragma unroll
  for (int m = 0; m < 4; ++m) {
    const int r0 = wr * 64 + m * 16 + fq * 4;
    const float s0 = rs[r0], s1 = rs[r0 + 1], s2 = rs[r0 + 2], s3 = rs[r0 + 3];
#pragma unroll
    for (int n = 0; n < 4; ++n) {
      const int col = n * 16 + fr;
      if (wc == 0) {
        Kb[(long)(key0 + r0 + 0) * 96 + col] = (h16)(acc[m][n][0] * s0); Kb[(long)(key0 + r0 + 1) * 96 + col] = (h16)(acc[m][n][1] * s1);
        Kb[(long)(key0 + r0 + 2) * 96 + col] = (h16)(acc[m][n][2] * s2); Kb[(long)(key0 + r0 + 3) * 96 + col] = (h16)(acc[m][n][3] * s3);
      } else {
        h16x4 o; o[0] = (h16)(acc[m][n][0] * s0); o[1] = (h16)(acc[m][n][1] * s1); o[2] = (h16)(acc[m][n][2] * s2); o[3] = (h16)(acc[m][n][3] * s3);
        *reinterpret_cast<h16x4*>(Vt + (long)col * KEYS + key0 + r0) = o;
      }
    }
  }
  __syncthreads();
}
DI void item_q(const Params& P, int layer, int tile, char* smem) {
  const int tid = tidx(), lane = tid & 63, wid = tid >> 6, wr = wid >> 1, wc = wid & 1, fr = lane & 15, fq = lane >> 4;
  const int mt = tile >> 3, hd = tile & 7; const int t0 = mt * 128; const Tok tk = tokinfo(t0);
  const h16* A = reinterpret_cast<const h16*>(P.ws + OFF_QLAT) + (long)t0 * 512;
  const h16* W = reinterpret_cast<const h16*>(P.ws + OFF_WT) + (long)layer * WT_LAYER + WT_UQ + (long)hd * 128 * 512;
  float* rs = reinterpret_cast<float*>(smem + 73728);
  row_rms(A, 512, 512, rs);
  f32x4 acc[4][4]; acc_zero(acc);
  gemm_kloop(acc, A, 512, 0, 128, W, 512, 512, smem, opaque_tid());
  h16* Qb = reinterpret_cast<h16*>(P.ws + OFF_Q) + (long)(tk.b * 8 + hd) * KEYS * 96;
  const float2* rope = reinterpret_cast<const float2*>(P.ws + OFF_ROPE);
  const int q0 = (tk.ctx ? SEQ : 0) + tk.pos;
#pragma unroll
  for (int m = 0; m < 4; ++m)
#pragma unroll
    for (int j = 0; j < 4; ++j) {
      const int r = wr * 64 + m * 16 + fq * 4 + j; const float s = rs[r] * QSCALE;
      h16* qr = Qb + (long)(q0 + r) * 96;
      if (wc == 0) {
#pragma unroll
        for (int n = 0; n < 4; ++n) qr[n * 16 + fr] = (h16)(acc[m][n][j] * s);
      } else {
        float x1 = acc[m][0][j], x2 = acc[m][1][j];
        if (!tk.ctx) { const float2 cs = rope[(tk.pos + r) * 16 + fr]; const float y1 = x1 * cs.x - x2 * cs.y, y2 = x1 * cs.y + x2 * cs.x; x1 = y1; x2 = y2; }
        qr[64 + fr] = (h16)(x1 * s); qr[80 + fr] = (h16)(x2 * s);
      }
    }
  __syncthreads();
}
DI int s5_chunk_base(int b, int dir, int si) {
  if (si < 4) { const int cc = dir ? 3 - si : si; return TLAT + b * CTXL + cc * 64; }
  const int lc = dir ? 127 - (si - 4) : si - 4; return b * SEQ + lc * 64;
}
DI void s5_stage_u(const h16* __restrict__ U, int tokbase, int g, float* us) {
  const int lane = tidx() & 63;
  const h16* p = U + (long)(tokbase + lane) * 384 + g * 16;
  const h16x8 v0 = *reinterpret_cast<const h16x8*>(p), v1 = *reinterpret_cast<const h16x8*>(p + 8);
#pragma unroll
  for (int j = 0; j < 8; ++j) { us[lane * 16 + j] = (float)v0[j]; us[lane * 16 + 8 + j] = (float)v1[j]; }
}
DI void item_s5_pass1(const Params& P, int layer, int wtask, char* smem) {
  const int lane = tidx() & 63, wid = tidx() >> 6;
  float* us = reinterpret_cast<float*>(smem + wid * 12800);
  const int si = wtask % 132; int r = wtask / 132; const int g = r % 24; r /= 24; const int dir = r & 1, b = r >> 1;
  const long gi = (long)(layer * 2 + dir) * 24 + g;
  const float2 a = reinterpret_cast<const float2*>(P.ws + OFF_S5A)[gi * 64 + lane];
  const float2* Bb = reinterpret_cast<const float2*>(P.ws + OFF_S5B) + (gi * 64 + lane) * 16;
  float bre[16], bim[16];
#pragma unroll
  for (int c = 0; c < 16; ++c) { const float2 v = Bb[c]; bre[c] = v.x; bim[c] = v.y; }
  s5_stage_u(reinterpret_cast<const h16*>(P.ws + OFF_U), s5_chunk_base(b, dir, si), g, us);
  float hr = 0.f, hi = 0.f;
#pragma unroll 4
  for (int s = 0; s < 64; ++s) {
    const int tau = dir ? 63 - s : s;
    const float4* up = reinterpret_cast<const float4*>(us + tau * 16);
    float br = 0.f, bi = 0.f;
#pragma unroll
    for (int q = 0; q < 4; ++q) { const float4 u = up[q];
      br += bre[q * 4] * u.x + bre[q * 4 + 1] * u.y + bre[q * 4 + 2] * u.z + bre[q * 4 + 3] * u.w;
      bi += bim[q * 4] * u.x + bim[q * 4 + 1] * u.y + bim[q * 4 + 2] * u.z + bim[q * 4 + 3] * u.w; }
    const float nr = a.x * hr - a.y * hi + br, ni = a.x * hi + a.y * hr + bi; hr = nr; hi = ni;
  }
  reinterpret_cast<float2*>(P.ws + OFF_E)[((long)((b * 2 + dir) * 24 + g) * 132 + si) * 64 + lane] = make_float2(hr, hi);
}

DI float hy_dw(const h16* __restrict__ p, int t, int Ls, float w0, float w1, float w2, float bias) {
  const float xm = t > 0 ? (float)p[t - 1] : 0.f, x0 = (float)p[t], xp = t + 1 < Ls ? (float)p[t + 1] : 0.f;
  return xm * w0 + x0 * w1 + xp * w2 + bias;
}
DI void item_hyena(const Params& P, int layer, int task, char* smem) {
  float2* X = reinterpret_cast<float2*>(smem);
  const int tid = tidx(); const int pair = task / 384, c = task % 384;
  const h16* PH0 = reinterpret_cast<const h16*>(P.ws + OFF_PHY) + (long)(2 * pair) * 1152 * SEQ;
  const h16* PH1 = PH0 + (long)1152 * SEQ;
  const float* cw = P.in[I_HCW] + layer * 3 * 1152; const float* cb = P.in[I_HCB] + layer * 1152;
  const float2* F = reinterpret_cast<const float2*>(P.ws + OFF_FILT);
  float2* SCR = reinterpret_cast<float2*>(P.ws + OFF_YS5PRE) + (long)blockIdx.x * 12288;
  float2* SCR2 = SCR + 8192;
  const float vw0 = cw[c], vw1 = cw[1152 + c], vw2 = cw[2304 + c], vbb = cb[c];
  const h16* pv0 = PH0 + (long)c * SEQ; const h16* pv1 = PH1 + (long)c * SEQ;
  float2 ye[16]; int tq;
#pragma unroll 1
  for (int o = 0; o < 2; ++o) {
    const float2* Te = F + (long)(o * 384 + c) * 2 * 8192; const float2* To = Te + 8192;
    float ts = 1.f / 16384.f; asm volatile("" : "+v"(ts));
{ tq = tid; asm volatile("" : "+v"(tq)); }
#pragma unroll 8
    for (int i = 0; i < 32; ++i) { const int t = tq + 256 * i;
      X[t] = o == 0 ? make_float2(hy_dw(pv0, t, SEQ, vw0, vw1, vw2, vbb), hy_dw(pv1, t, SEQ, vw0, vw1, vw2, vbb)) : SCR[t]; }
    __syncthreads();
    fft_fwd(X);
{ tq = tid; asm volatile("" : "+v"(tq)); }
#pragma unroll 8
    for (int i = 0; i < 32; ++i) { const int n = tq + 256 * i; X[n] = cmul(X[n], Te[n]); }
    __syncthreads();
    fft_inv(X);
{ tq = tid; asm volatile("" : "+v"(tq)); }
#pragma unroll
    for (int i = 0; i < 16; ++i) { ye[i] = X[tq + 256 * i]; SCR2[tq + 256 * i] = X[tq + 4096 + 256 * i]; }
    __syncthreads();
{ tq = tid; asm volatile("" : "+v"(tq)); }
#pragma unroll 8
    for (int i = 0; i < 32; ++i) { const int t = tq + 256 * i;
      const float2 zz = o == 0 ? make_float2(hy_dw(pv0, t, SEQ, vw0, vw1, vw2, vbb), hy_dw(pv1, t, SEQ, vw0, vw1, vw2, vbb)) : SCR[t];
      X[t] = cmul(zz, twid(-(float)t * ts)); }
    __syncthreads();
    fft_fwd(X);
{ tq = tid; asm volatile("" : "+v"(tq)); }
#pragma unroll 8
    for (int i = 0; i < 32; ++i) { const int n = tq + 256 * i; X[n] = cmul(X[n], To[n]); }
    __syncthreads();
    fft_inv(X);
    asm volatile("" : "+v"(ts));
{ tq = tid; asm volatile("" : "+v"(tq)); }
#pragma unroll
    for (int i = 0; i < 16; ++i) { const int t = tq + 256 * i; const float2 yo = cmul(X[t], twid((float)t * ts)); X[t] = make_float2(ye[i].x + yo.x, ye[i].y + yo.y); }
{ tq = tid; asm volatile("" : "+v"(tq)); }
#pragma unroll 2
    for (int i = 0; i < 16; ++i) { const int t = tq + 4096 + 256 * i; const float2 yo = cmul(X[t], twid((float)t * ts)); const float2 y2 = SCR2[tq + 256 * i]; X[t] = make_float2(y2.x + yo.x, y2.y + yo.y); }
    const int gc = (o + 1) * 384 + c;
    const float w0 = cw[gc], w1 = cw[1152 + gc], w2 = cw[2304 + gc], bb = cb[gc];
    const float bias = P.in[I_HBIAS][(layer * 2 + o) * 384 + c];
    const h16* pg0 = PH0 + (long)gc * SEQ; const h16* pg1 = PH1 + (long)gc * SEQ;
    h16* Y = reinterpret_cast<h16*>(P.ws + OFF_YHY);
{ tq = tid; asm volatile("" : "+v"(tq)); }
#pragma unroll 8
    for (int i = 0; i < 32; ++i) {
      const int t = tq + 256 * i;
      const float2 lc = X[t];
      const float2 zz = o == 0 ? make_float2(hy_dw(pv0, t, SEQ, vw0, vw1, vw2, vbb), hy_dw(pv1, t, SEQ, vw0, vw1, vw2, vbb)) : SCR[t];
      const float gx = hy_dw(pg0, t, SEQ, w0, w1, w2, bb), gy = hy_dw(pg1, t, SEQ, w0, w1, w2, bb);
      const float2 res = make_float2(gx * (lc.x + bias * zz.x), gy * (lc.y + bias * zz.y));
      if (o == 0) SCR[t] = res;
      else { Y[((long)(2 * pair) * SEQ + t) * 384 + c] = (h16)res.x; Y[((long)(2 * pair + 1) * SEQ + t) * 384 + c] = (h16)res.y; }
    }
    __syncthreads();
  }
}
DI void item_hyena_ctx(const Params& P, int layer, int task, char* smem) {
  float* su = reinterpret_cast<float*>(smem); float* sf = su + 256; float* sb = sf + 256;
  const int t = tidx(); const int b = task / 384, c = task % 384;
  const h16* PH = reinterpret_cast<const h16*>(P.ws + OFF_PHYC) + (long)b * 1152 * CTXL;
  const float* cw = P.in[I_HCW] + layer * 3 * 1152; const float* cb = P.in[I_HCB] + layer * 1152;
  float u = hy_dw(PH + (long)c * CTXL, t, CTXL, cw[c], cw[1152 + c], cw[2304 + c], cb[c]);
  for (int o = 0; o < 2; ++o) {
    const float* T = reinterpret_cast<const float*>(P.ws + OFF_TAPSC) + (long)(o * 384 + c) * 512;
    __syncthreads();
    su[t] = u; sf[t] = T[t]; sb[t] = T[256 + t];
    __syncthreads();
    float y = 0.f;
    for (int s = 0; s <= t; ++s) y += sf[t - s] * su[s];
    for (int s = t + 1; s < 256; ++s) y += sb[s - t] * su[s];
    const int gc = (o + 1) * 384 + c;
    const float gx = hy_dw(PH + (long)gc * CTXL, t, CTXL, cw[gc], cw[1152 + gc], cw[2304 + gc], cb[gc]);
    u = gx * (y + P.in[I_HBIAS][(layer * 2 + o) * 384 + c] * u);
  }
  reinterpret_cast<h16*>(P.ws + OFF_YHY)[((long)TLAT + b * CTXL + t) * 384 + c] = (h16)u;
  __syncthreads();
}

#ifndef PROBE_HY
#define PROBE_HY 0
#endif
#ifndef PROBE_S5
#define PROBE_S5 0
#endif
DI int first_item(int base) { const int g = (int)gridDim.x; return (((int)blockIdx.x - base) % g + g) % g; }
DI void phase_mix1(const Params& P, int layer, char* smem) {
  const int n_hy = 4 * 384, n_hyc = layer == 0 ? 8 * 384 : 0;
  const int n_kv = (TT / 128) * 8, n_q = (layer == 0 ? TT / 128 : TLAT / 128) * 8;
  const int n_s5 = (NBATCH * 2 * 24 * 132) / 4;
  const int g = gridDim.x;
#pragma unroll 1
  for (int rep = 0; rep < 1 + PROBE_HY; ++rep)
#pragma unroll 1
  for (int i = first_item(0); i < n_hy; i += g) item_hyena(P, layer, i, smem);
  asm volatile("" ::: "memory");
#pragma unroll 1
  for (int i = first_item(n_hy); i < n_kv; i += g) item_kv(P, layer, i, smem);
  asm volatile("" ::: "memory");
#pragma unroll 1
  for (int i = first_item(n_hy + n_kv); i < n_q; i += g) item_q(P, layer, i, smem);
  asm volatile("" ::: "memory");
#pragma unroll 1
  for (int rep = 0; rep < 1 + PROBE_S5; ++rep)
#pragma unroll 1
  for (int i = first_item(n_hy + n_kv + n_q); i < n_s5; i += g) { item_s5_pass1(P, layer, i * 4 + (tidx() >> 6), smem); __syncthreads(); }
  asm volatile("" ::: "memory");
#pragma unroll 1
  for (int i = first_item(n_hy + n_kv + n_q + n_s5); i < n_hyc; i += g) item_hyena_ctx(P, layer, i, smem);
}
DI int crow32(int r, int hi) { return (r & 3) + 8 * (r >> 2) + 4 * hi; }
DI void item_attn(const Params& P, int bh, int q0, int key_lo, int ntiles, char* smem) {
  const int tid = tidx(), lane = tid & 63, wid = tid >> 6, r32 = lane & 31, hi = lane >> 5;
  const h16* Qb = reinterpret_cast<const h16*>(P.ws + OFF_Q) + (long)bh * KEYS * 96;
  const h16* Kb = reinterpret_cast<const h16*>(P.ws + OFF_K) + (long)bh * KEYS * 96;
  const h16* Vt = reinterpret_cast<const h16*>(P.ws + OFF_VT) + (long)bh * 64 * KEYS;
  h16x8 qf[6];
  { const h16* qrow = Qb + (long)(q0 + wid * 32 + r32) * 96 + hi * 8;
#pragma unroll
    for (int ds = 0; ds < 6; ++ds) qf[ds] = *reinterpret_cast<const h16x8*>(qrow + ds * 16); }
  constexpr int KT_BYTES = 64 * 208, VT_BYTES = 64 * 136, BUF = KT_BYTES + VT_BYTES;
  uint4 kr[3]; uint4 vr[2];
  const int vdv0 = tid >> 3, vpart = tid & 7;
  auto gload = [&](int j) {
    const long key0 = key_lo + j * 64;
#pragma unroll
    for (int i = 0; i < 3; ++i) kr[i] = *reinterpret_cast<const uint4*>(Kb + key0 * 96 + (long)(tid + 256 * i) * 8);
#pragma unroll
    for (int i = 0; i < 2; ++i) vr[i] = *reinterpret_cast<const uint4*>(Vt + (long)(vdv0 + 32 * i) * KEYS + key0 + vpart * 8);
  };
  auto swrite = [&](int buf) {
    char* ks = smem + buf * BUF; char* vs = ks + KT_BYTES;
#pragma unroll
    for (int i = 0; i < 3; ++i) { const int c = tid + 256 * i; *reinterpret_cast<uint4*>(ks + (c / 12) * 208 + (c % 12) * 16) = kr[i]; }
#pragma unroll
    for (int i = 0; i < 2; ++i) { char* d = vs + (vdv0 + 32 * i) * 136 + vpart * 16;
      *reinterpret_cast<uint2*>(d) = make_uint2(vr[i].x, vr[i].y); *reinterpret_cast<uint2*>(d + 8) = make_uint2(vr[i].z, vr[i].w); }
  };
  f32x16 o0, o1;
#pragma unroll
  for (int r = 0; r < 16; ++r) { o0[r] = 0.f; o1[r] = 0.f; }
  float m_run = -1e30f, l_run = 0.f;
  gload(0); swrite(0); __syncthreads();
  for (int j = 0; j < ntiles; ++j) {
    if (j + 1 < ntiles) gload(j + 1);
    const char* ks = smem + (j & 1) * BUF; const char* vs = ks + KT_BYTES;
    f32x16 p0, p1;
#pragma unroll
    for (int r = 0; r < 16; ++r) { p0[r] = 0.f; p1[r] = 0.f; }
#pragma unroll
    for (int ds = 0; ds < 6; ++ds) {
      const h16x8 a0 = *reinterpret_cast<const h16x8*>(ks + r32 * 208 + (ds * 16 + hi * 8) * 2);
      const h16x8 a1 = *reinterpret_cast<const h16x8*>(ks + (32 + r32) * 208 + (ds * 16 + hi * 8) * 2);
      p0 = __builtin_amdgcn_mfma_f32_32x32x16_f16(a0, qf[ds], p0, 0, 0, 0);
      p1 = __builtin_amdgcn_mfma_f32_32x32x16_f16(a1, qf[ds], p1, 0, 0, 0);
    }
    float mx = p0[0];
#pragma unroll
    for (int r = 1; r < 16; ++r) mx = fmaxf(mx, p0[r]);
#pragma unroll
    for (int r = 0; r < 16; ++r) mx = fmaxf(mx, p1[r]);
    mx = fmaxf(mx, __shfl_xor(mx, 32));
    const float mnew = fmaxf(m_run, mx);
    const float alpha = __builtin_amdgcn_exp2f(m_run - mnew);
    m_run = mnew;
    float rsum = 0.f;
#pragma unroll
    for (int r = 0; r < 16; ++r) { p0[r] = __builtin_amdgcn_exp2f(p0[r] - mnew); rsum += p0[r]; }
#pragma unroll
    for (int r = 0; r < 16; ++r) { p1[r] = __builtin_amdgcn_exp2f(p1[r] - mnew); rsum += p1[r]; }
    l_run = l_run * alpha + rsum;
    if (__any(alpha != 1.f)) {
#pragma unroll
      for (int r = 0; r < 16; ++r) { o0[r] *= alpha; o1[r] *= alpha; }
    }
#pragma unroll
    for (int kb = 0; kb < 2; ++kb)
#pragma unroll
      for (int s = 0; s < 2; ++s) {
        h16x8 pf;
#pragma unroll
        for (int e = 0; e < 8; ++e) pf[e] = (h16)(kb ? p1[8 * s + e] : p0[8 * s + e]);
        const int koff = (32 * kb + 16 * s + 4 * hi) * 2;
        {
          const h16x4 lo = *reinterpret_cast<const h16x4*>(vs + r32 * 136 + koff), hh = *reinterpret_cast<const h16x4*>(vs + r32 * 136 + koff + 16);
          const h16x8 af = __builtin_shufflevector(lo, hh, 0, 1, 2, 3, 4, 5, 6, 7);
          o0 = __builtin_amdgcn_mfma_f32_32x32x16_f16(af, pf, o0, 0, 0, 0);
        }
        {
          const h16x4 lo = *reinterpret_cast<const h16x4*>(vs + (32 + r32) * 136 + koff), hh = *reinterpret_cast<const h16x4*>(vs + (32 + r32) * 136 + koff + 16);
          const h16x8 af = __builtin_shufflevector(lo, hh, 0, 1, 2, 3, 4, 5, 6, 7);
          o1 = __builtin_amdgcn_mfma_f32_32x32x16_f16(af, pf, o1, 0, 0, 0);
        }
      }
    if (j + 1 < ntiles) swrite((j + 1) & 1);
    __syncthreads();
  }
  const float lt = l_run + __shfl_xor(l_run, 32);
  const float inv = 1.f / lt;
  const int b = bh >> 3, hd = bh & 7; const int q = q0 + wid * 32 + r32;
  const long tok = q < SEQ ? (long)b * SEQ + q : (long)TLAT + b * CTXL + (q - SEQ);
  h16* yr = reinterpret_cast<h16*>(P.ws + OFF_YMLA) + tok * 512 + hd * 64;
#pragma unroll
  for (int g = 0; g < 4; ++g) {
    h16x4 a, c;
#pragma unroll
    for (int e = 0; e < 4; ++e) { a[e] = (h16)(o0[4 * g + e] * inv); c[e] = (h16)(o1[4 * g + e] * inv); }
    *reinterpret_cast<h16x4*>(yr + 8 * g + 4 * hi) = a;
    *reinterpret_cast<h16x4*>(yr + 32 + 8 * g + 4 * hi) = c;
  }
}
DI void item_s5_pass3(const Params& P, int layer, int b, int g, int ck, char* smem) {
  const int lane = tidx() & 63, wid = tidx() >> 6, fr = lane & 15, fq = lane >> 4;
  float* us = reinterpret_cast<float*>(smem + wid * 12800); char* Hs = smem + wid * 12800 + 4096;
  const int tokbase = ck < 4 ? TLAT + b * CTXL + ck * 64 : b * SEQ + (ck - 4) * 64;
  s5_stage_u(reinterpret_cast<const h16*>(P.ws + OFF_U), tokbase, g, us);
  __syncthreads();
  f32x4 yacc[4];
#pragma unroll
  for (int i = 0; i < 4; ++i) yacc[i] = f32x4{0.f, 0.f, 0.f, 0.f};
#pragma unroll
  for (int dir = 0; dir < 2; ++dir) {
    const long gi = (long)(layer * 2 + dir) * 24 + g;
    const float2 a = reinterpret_cast<const float2*>(P.ws + OFF_S5A)[gi * 64 + lane];
    const float2 a64 = reinterpret_cast<const float2*>(P.ws + OFF_S5A64)[gi * 64 + lane];
    const float2* Bb = reinterpret_cast<const float2*>(P.ws + OFF_S5B) + (gi * 64 + lane) * 16;
    float bre[16], bim[16];
#pragma unroll
    for (int c = 0; c < 16; ++c) { const float2 v = Bb[c]; bre[c] = v.x; bim[c] = v.y; }
    const int si = ck < 4 ? (dir ? 3 - ck : ck) : 4 + (dir ? 127 - (ck - 4) : ck - 4);
    const float2* Ep = reinterpret_cast<const float2*>(P.ws + OFF_E) + ((long)((b * 2 + dir) * 24 + g) * 132) * 64 + lane;
    float hr = 0.f, hi = 0.f;
#pragma unroll 16
    for (int i = 0; i < si; ++i) { const float2 e = Ep[(long)i * 64]; const float nr = a64.x * hr - a64.y * hi + e.x, ni = a64.x * hi + a64.y * hr + e.y; hr = nr; hi = ni; }
    const h16* Ct = reinterpret_cast<const h16*>(P.ws + OFF_S5C) + gi * 16 * 128 + fr * 128 + fq * 8;
    h16x8 cf[4];
#pragma unroll
    for (int ks = 0; ks < 4; ++ks) cf[ks] = *reinterpret_cast<const h16x8*>(Ct + ks * 32);
#pragma unroll
    for (int half = 0; half < 2; ++half) {
#pragma unroll 4
      for (int s = 0; s < 32; ++s) {
        const int step = half * 32 + s; const int tau = dir ? 63 - step : step;
        const float4* up = reinterpret_cast<const float4*>(us + tau * 16);
        float br = 0.f, bi = 0.f;
#pragma unroll
        for (int q = 0; q < 4; ++q) { const float4 u = up[q];
          br += bre[q * 4] * u.x + bre[q * 4 + 1] * u.y + bre[q * 4 + 2] * u.z + bre[q * 4 + 3] * u.w;
          bi += bim[q * 4] * u.x + bim[q * 4 + 1] * u.y + bim[q * 4 + 2] * u.z + bim[q * 4 + 3] * u.w; }
        const float nr = a.x * hr - a.y * hi + br, ni = a.x * hi + a.y * hr + bi; hr = nr; hi = ni;
        h16* hrow = reinterpret_cast<h16*>(Hs + (tau & 31) * 272);
        hrow[lane] = (h16)hr; hrow[64 + lane] = (h16)hi;
      }
      __syncthreads();
      const int tb = dir ? 1 - half : half;
#pragma unroll
      for (int sb2 = 0; sb2 < 2; ++sb2)
#pragma unroll
        for (int ks = 0; ks < 4; ++ks) {
          const h16x8 bf = *reinterpret_cast<const h16x8*>(Hs + (sb2 * 16 + fr) * 272 + (ks * 32 + fq * 8) * 2);
          yacc[tb * 2 + sb2] = __builtin_amdgcn_mfma_f32_16x16x32_f16(cf[ks], bf, yacc[tb * 2 + sb2], 0, 0, 0);
        }
      __syncthreads();
    }
  }
  const float* dsk = P.in[I_S5D] + layer * 384 + g * 16 + fq * 4;
  h16* Y = reinterpret_cast<h16*>(P.ws + OFF_YS5PRE);
#pragma unroll
  for (int sbi = 0; sbi < 4; ++sbi) {
    const int tl = sbi * 16 + fr; h16x4 o;
#pragma unroll
    for (int j = 0; j < 4; ++j) o[j] = (h16)geluf_(yacc[sbi][j] + dsk[j] * us[tl * 16 + fq * 4 + j]);
    *reinterpret_cast<h16x4*>(Y + (long)(tokbase + tl) * 384 + g * 16 + fq * 4) = o;
  }
  __syncthreads();
}
DI void phase_mix2(const Params& P, int layer, char* smem) {
  if ((gridDim.x & 7) == 0) {
    const int xcd = blockIdx.x & 7, li = blockIdx.x >> 3, nloc = gridDim.x >> 3;
    for (int k = li; k < 512; k += nloc) item_attn(P, xcd + 8 * (k >> 6), (k & 63) * 128, 0, KEYS / 64, smem);
  } else {
    for (int k = blockIdx.x; k < 4096; k += gridDim.x) item_attn(P, k >> 6, (k & 63) * 128, 0, KEYS / 64, smem);
  }
  const int n_actx = layer == 0 ? 128 : 0;
  const int nck = layer == 0 ? 132 : 128;
  const int n_s5 = NBATCH * 24 * nck / 4;
  for (int it = blockIdx.x; it < n_actx + n_s5; it += gridDim.x) {
    if (it < n_actx) { item_attn(P, it >> 1, SEQ + (it & 1) * 128, SEQ, CTXL / 64, smem); continue; }
    const int w = (it - n_actx) * 4 + (tidx() >> 6);
    const int ck = w % nck + (layer == 0 ? 0 : 4); const int r = w / nck;
    item_s5_pass3(P, layer, r / 24, r % 24, ck, smem);
  }
}
DI void phase_glu(const Params& P, int layer, char* smem) {
  const int tid = tidx(), lane = tid & 63, wid = tid >> 6, wr = wid >> 1, wc = wid & 1, fr = lane & 15, fq = lane >> 4;
  const h16* A = reinterpret_cast<const h16*>(P.ws + OFF_YS5PRE);
  const h16* W = reinterpret_cast<const h16*>(P.ws + OFF_WT) + (long)layer * WT_LAYER + WT_GLU;
  h16* Y = reinterpret_cast<h16*>(P.ws + OFF_YS5);
  const int MT = (layer == 0 ? TT : TLAT) / 128;
  const TileWalk tw = tw_init(MT, 6);
  for (int tile = tw.lb; tile < tw_count(tw); tile += tw.nlb) {
    int mt, nt; tw_decode(tw, tile, mt, nt);
    f32x4 acc[4][4]; acc_zero(acc);
    gemm_kloop(acc, A + (long)mt * 128 * 384, 384, 0, 128, W + (long)nt * 128 * 384, 384, 384, smem, opaque_tid());
#pragma unroll
    for (int m = 0; m < 4; ++m)
#pragma unroll
      for (int np = 0; np < 2; ++np)
#pragma unroll
        for (int j = 0; j < 4; ++j) {
          const int row = mt * 128 + wr * 64 + m * 16 + fq * 4 + j, col = nt * 64 + wc * 32 + np * 16 + fr;
          Y[(long)row * 384 + col] = (h16)(acc[m][2 * np][j] * sigmoidf_(acc[m][2 * np + 1][j]));
        }
  }
}
DI void phase_merge(const Params& P, int layer, char* smem) {
  const h16* H = reinterpret_cast<const h16*>(P.ws + OFF_H1);
  const h16* WL = reinterpret_cast<const h16*>(P.ws + OFF_WT) + (long)layer * WT_LAYER;
  h16* Mg = reinterpret_cast<h16*>(P.ws + OFF_MERGED);
  const int MT = (layer == 0 ? TT : TLAT) / 128;
  const TileWalk tw = tw_init(MT, 8);
  for (int tile = tw.lb; tile < tw_count(tw); tile += tw.nlb) {
    int mt, nt; tw_decode(tw, tile, mt, nt);
    h16* Tmp = reinterpret_cast<h16*>(P.ws + OFF_YS5PRE) + (long)blockIdx.x * 16384;
#pragma unroll 1
    for (int br = 0; br < 3; ++br) {
      const h16* Ab; const h16* Wb; int Kb;
      if (br == 0) { Ab = reinterpret_cast<const h16*>(P.ws + OFF_YHY) + (long)mt * 128 * 384; Wb = WL + WT_BRHY + (long)nt * 128 * 384; Kb = 384; }
      else if (br == 1) { Ab = reinterpret_cast<const h16*>(P.ws + OFF_YS5) + (long)mt * 128 * 384; Wb = WL + WT_BRS5 + (long)nt * 128 * 384; Kb = 384; }
      else { Ab = reinterpret_cast<const h16*>(P.ws + OFF_YMLA) + (long)mt * 128 * 512; Wb = WL + WT_BRMLA + (long)nt * 128 * 512; Kb = 512; }
      {
        f32x4 acc[4][4]; acc_zero(acc);
        gemm_kloop(acc, Ab, Kb, 0, 128, Wb, Kb, Kb, smem, opaque_tid());
        const int tid = tidx();
#pragma unroll
        for (int m = 0; m < 4; ++m)
#pragma unroll
          for (int n = 0; n < 4; ++n) {
            h16x4 o; o[0] = (h16)acc[m][n][0]; o[1] = (h16)acc[m][n][1]; o[2] = (h16)acc[m][n][2]; o[3] = (h16)acc[m][n][3];
            *reinterpret_cast<h16x4*>(Tmp + ((m * 4 + n) * 256 + tid) * 4) = o;
          }
      }
      f32x4 acc[4][4]; acc_zero(acc);
      gemm_kloop(acc, H + (long)mt * 128 * LD1, LD1, 0, 128, WL + WT_WGATE + (long)(br * 1024 + nt * 128) * LD1, LD1, 1024, smem, opaque_tid());
      const int tid = tidx(), lane = tid & 63, wid = tid >> 6, wr = wid >> 1, wc = wid & 1, fr = lane & 15, fq = lane >> 4;
#pragma unroll
      for (int m = 0; m < 4; ++m)
#pragma unroll
        for (int n = 0; n < 4; ++n) {
          const h16x4 bv = *reinterpret_cast<const h16x4*>(Tmp + ((m * 4 + n) * 256 + tid) * 4);
#pragma unroll
          for (int j = 0; j < 4; ++j) {
            h16* dst = Mg + (long)(mt * 128 + wr * 64 + m * 16 + fq * 4 + j) * LD1 + nt * 128 + wc * 64 + n * 16 + fr;
            const float prev = br == 0 ? 0.f : (float)*dst;
            *dst = (h16)(prev + sigmoidf_(acc[m][n][j]) * (float)bv[j]);
          }
          __builtin_amdgcn_sched_barrier(0);
        }
    }
  }
}
DI void phase_resid(const Params& P, int layer, int stage_src, size_t a_off, int K, long w_off, int gate_idx, char* smem) {
  const int tid = tidx(), lane = tid & 63, wid = tid >> 6, wr = wid >> 1, wc = wid & 1, fr = lane & 15, fq = lane >> 4;
  const h16* A = reinterpret_cast<const h16*>(P.ws + a_off);
  const h16* W = reinterpret_cast<const h16*>(P.ws + OFF_WT) + (long)layer * WT_LAYER + w_off;
  const float* mod = reinterpret_cast<const float*>(P.ws + OFF_MOD) + (long)layer * 9 * 6144 + gate_idx * 1024;
  const int MT = (layer == 0 ? TT : TLAT) / 128;
  const TileWalk tw = tw_init(MT, 8);
  for (int tile = tw.lb; tile < tw_count(tw); tile += tw.nlb) {
    int mt, nt; tw_decode(tw, tile, mt, nt);
    f32x4 acc[4][4]; acc_zero(acc);
    const int ld = K == 1024 ? LD1 : LD2;
    gemm_kloop(acc, A + (long)mt * 128 * ld, ld, 0, 128, W + (long)nt * 128 * ld, ld, K, smem, opaque_tid());
    const Tok tk = tokinfo(mt * 128);
    float* Zs = reinterpret_cast<float*>(smem);
    const int t2 = tidx();
    stage_acc(acc, Zs, t2);
    const int c4 = (t2 & 31) * 4;
    const float4 g4 = *reinterpret_cast<const float4*>(mod + tk.mrow * 6144 + nt * 128 + c4);
#pragma unroll 4
    for (int it = 0; it < 16; ++it) {
      const int row = it * 8 + (t2 >> 5); const int t = mt * 128 + row;
      const float4 a4 = *reinterpret_cast<const float4*>(Zs + row * 132 + c4);
      const float4 x4 = *reinterpret_cast<const float4*>(xrow_src(P, stage_src, t) + nt * 128 + c4);
      *reinterpret_cast<float4*>(xrow_dst(P, t) + nt * 128 + c4) = make_float4(x4.x + g4.x * a4.x, x4.y + g4.y * a4.y, x4.z + g4.z * a4.z, x4.w + g4.w * a4.w);
    }
    __syncthreads();
  }
}
DI void phase_ffn_up(const Params& P, int layer, char* smem) {
  const int tid = tidx(), lane = tid & 63, wid = tid >> 6, wr = wid >> 1, wc = wid & 1, fr = lane & 15, fq = lane >> 4;
  const h16* H = reinterpret_cast<const h16*>(P.ws + OFF_H2);
  const h16* W = reinterpret_cast<const h16*>(P.ws + OFF_WT) + (long)layer * WT_LAYER + WT_UP;
  h16* F = reinterpret_cast<h16*>(P.ws + OFF_F);
  const float* cw = P.in[I_FCW] + (long)layer * 3 * 5632; const float* cb = P.in[I_FCB] + (long)layer * 5632;
  float* Zs = reinterpret_cast<float*>(smem);
  const int n_mt = 8 * 66 + (layer == 0 ? 8 * 3 : 0);
  const TileWalk tw = tw_init(n_mt, 44);
  for (int tile = tw.lb; tile < tw_count(tw); tile += tw.nlb) {
    int mi, nt; tw_decode(tw, tile, mi, nt);
    int seq0, Ls, ti;
    if (mi < 528) { seq0 = (mi / 66) * SEQ; Ls = SEQ; ti = mi % 66; } else { const int u = mi - 528; seq0 = TLAT + (u / 3) * CTXL; Ls = CTXL; ti = u % 3; }
    const int p0 = ti * 126 - 1;
    const int a_lo = ti == 0 ? 1 : 0, a_hi = min(128, Ls - p0);
    const int nout = min(126, Ls - ti * 126);
    f32x4 acc[4][4]; acc_zero(acc);
    gemm_kloop(acc, H + ((long)seq0 + p0) * LD1, LD1, a_lo, a_hi, W + (long)nt * 128 * LD1, LD1, 1024, smem, opaque_tid());
#pragma unroll
    for (int m = 0; m < 4; ++m)
#pragma unroll
      for (int n = 0; n < 4; ++n)
#pragma unroll
        for (int j = 0; j < 4; ++j) Zs[(wr * 64 + m * 16 + fq * 4 + j) * 132 + wc * 64 + n * 16 + fr] = acc[m][n][j];
    __syncthreads();
    {
      const int jc = tid & 63, rg = tid >> 6;
      const int ucol = (jc >> 5) * 64 + ((jc >> 4) & 1) * 32 + (jc & 15), gcol = ucol + 16;
      const int cu = nt * 64 + jc, cg = 2816 + cu;
      const float wu0 = cw[cu], wu1 = cw[5632 + cu], wu2 = cw[2 * 5632 + cu], bu = cb[cu];
      const float wg0 = cw[cg], wg1 = cw[5632 + cg], wg2 = cw[2 * 5632 + cg], bg = cb[cg];
      for (int r = 1 + rg; r <= nout; r += 4) {
        const float au = wu0 * Zs[(r - 1) * 132 + ucol] + wu1 * Zs[r * 132 + ucol] + wu2 * Zs[(r + 1) * 132 + ucol] + bu;
        const float ag = wg0 * Zs[(r - 1) * 132 + gcol] + wg1 * Zs[r * 132 + gcol] + wg2 * Zs[(r + 1) * 132 + gcol] + bg;
        F[((long)seq0 + p0 + r) * LD2 + cu] = (h16)(siluf_(au) * ag);
      }
    }
    __syncthreads();
  }
}
DI void phase_norm2(const Params& P, int layer) { normmod_rows(P, layer, 1, 1, layer == 0 ? TT : TLAT, blockIdx.x, gridDim.x); }

constexpr int N_PHASES = 22;
#ifndef PROBE_REPEAT
#define PROBE_REPEAT 0u
#endif
template <int PH> DI void run_phase_t(const Params& P, char* smem) {
  asm volatile("" ::: "memory");
  if constexpr (PH == 0) phase_prologue(P, smem);
  else if constexpr (PH == 21) phase_final(P);
  else {
    constexpr int layer = (PH - 1) / 10, s = (PH - 1) % 10;
    if constexpr (s == 0) phase_norm1(P, layer, smem);
    else if constexpr (s == 1) phase_gemm_in(P, layer, smem);
    else if constexpr (s == 2) phase_mix1(P, layer, smem);
    else if constexpr (s == 3) phase_mix2(P, layer, smem);
    else if constexpr (s == 4) phase_glu(P, layer, smem);
    else if constexpr (s == 5) phase_merge(P, layer, smem);
    else if constexpr (s == 6) phase_resid(P, layer, layer, OFF_MERGED, 1024, WT_WO, 2, smem);
    else if constexpr (s == 7) phase_norm2(P, layer);
    else if constexpr (s == 8) phase_ffn_up(P, layer, smem);
    else phase_resid(P, layer, 1, OFF_F, 2816, WT_DOWN, 5, smem);
  }
}
DI void run_phase(const Params& P, int ph, char* smem) {
  switch (ph) {
#define RP(i) case i: run_phase_t<i>(P, smem); break;
    RP(0) RP(1) RP(2) RP(3) RP(4) RP(5) RP(6) RP(7) RP(8) RP(9) RP(10) RP(11) RP(12) RP(13) RP(14) RP(15) RP(16) RP(17) RP(18) RP(19) RP(20) RP(21)
#undef RP
    default: break;
  }
}
#ifndef MULTI_LAUNCH
#define MULTI_LAUNCH 0
#endif
#define XB_TMO      128
#define XB_XCNT(j)  (256  + 64 * (j))
#define XB_XSUB(j)  (1280 + 64 * (j))
#define XB_XGEN(j)  (2304 + 64 * (j))
#define XB_TOP      3328
#define XB_TOPGEN   3392
#define XCD_BAR_WORDS 3456
#define XB_SPIN_CAP (1u << 22)
#define LAS __attribute__((address_space(3)))
DI unsigned xb_ld(unsigned* p)              { return __hip_atomic_load(p, __ATOMIC_RELAXED, __HIP_MEMORY_SCOPE_AGENT); }
DI unsigned xb_add(unsigned* p, unsigned v) { return __hip_atomic_fetch_add(p, v, __ATOMIC_RELAXED, __HIP_MEMORY_SCOPE_AGENT); }
DI unsigned xb_xcc_id() { return (unsigned)__builtin_amdgcn_s_getreg((3 << 11) | 20) & 0xFu; }
#define XB_SPIN(cond, bar) do { unsigned _sp = 0; while (cond) { __builtin_amdgcn_s_sleep(1); \
    if ((++_sp & 255u) == 0u) { if (xb_ld(&(bar)[XB_TMO])) break; if (_sp > XB_SPIN_CAP) { atomicAdd(&(bar)[XB_TMO], 1u); break; } } } } while (0)
struct XcdBarrier { unsigned* bar; unsigned x; volatile LAS unsigned* st; };
DI XcdBarrier xcd_barrier_post(unsigned* bar, volatile LAS unsigned* st) {
  XcdBarrier b; b.bar = bar; b.x = xb_xcc_id(); b.st = st;
  if (threadIdx.x == 0) (void)xb_add(&bar[XB_XCNT(b.x)], 1u);
  return b;
}
DI void xcd_barrier_complete(unsigned* bar, unsigned x, unsigned& nloc, unsigned& nx) {
  const unsigned G = gridDim.x * gridDim.y * gridDim.z;
  unsigned sum, cnt, mine, sp = 0u;
  for (;;) {
    sum = 0u; cnt = 0u; mine = 0u;
#pragma unroll
    for (unsigned j = 0; j < 16; ++j) { const unsigned c = xb_ld(&bar[XB_XCNT(j)]); sum += c; cnt += (c > 0u) ? 1u : 0u; mine = (j == x) ? c : mine; }
    if (sum == G) break;
    __builtin_amdgcn_s_sleep(1);
    if ((++sp & 255u) == 0u) { if (xb_ld(&bar[XB_TMO])) break; if (sp > XB_SPIN_CAP) { atomicAdd(&bar[XB_TMO], 1u); break; } }
  }
  nloc = mine > 0u ? mine : 1u; nx = cnt > 0u ? cnt : 1u;
}
DI void xcd_barrier(const XcdBarrier& b) {
  asm volatile("s_waitcnt vmcnt(0)" ::: "memory");
  __syncthreads();
  if (threadIdx.x == 0) {
    unsigned* bar = b.bar;
    __builtin_amdgcn_s_waitcnt(0);
    unsigned nloc = b.st[0], nx = b.st[1];
    if (nloc == 0u) { xcd_barrier_complete(bar, b.x, nloc, nx); b.st[0] = nloc; b.st[1] = nx; }
    const unsigned old = xb_add(&bar[XB_XSUB(b.x)], 1u);
    const unsigned gen = old / nloc;
    if (old + 1u == (gen + 1u) * nloc) {
      __builtin_amdgcn_fence(__ATOMIC_RELEASE, "agent");
      asm volatile("s_waitcnt vmcnt(0)" ::: "memory");
      const unsigned og = xb_add(&bar[XB_TOP], 1u);
      const unsigned tg = og / nx;
      if (og + 1u == (tg + 1u) * nx) xb_add(&bar[XB_TOPGEN], 1u);
      else XB_SPIN(xb_ld(&bar[XB_TOPGEN]) == tg, bar);
      __builtin_amdgcn_fence(__ATOMIC_ACQUIRE, "agent");
      xb_add(&bar[XB_XGEN(b.x)], 1u);
      asm volatile("s_waitcnt vmcnt(0)" ::: "memory");
    } else {
      XB_SPIN(xb_ld(&bar[XB_XGEN(b.x)]) == gen, bar);
      __builtin_amdgcn_fence(__ATOMIC_ACQUIRE, "agent");
      asm volatile("s_waitcnt vmcnt(0)" ::: "memory");
    }
  }
  __syncthreads();
}
__global__ void __launch_bounds__(NTHREADS, 2) fwd_megakernel(Params P) {
  extern __shared__ __attribute__((aligned(16))) char smem[];
  cg::grid_group grid = cg::this_grid();
  volatile LAS unsigned* st = (volatile LAS unsigned*)(smem + SMEM_BYTES - 16);
  if (threadIdx.x == 0) { st[0] = 0u; st[1] = 0u; st[2] = 0u; st[3] = 0u; }
  __syncthreads();
  const XcdBarrier xb = xcd_barrier_post(reinterpret_cast<unsigned*>(P.ws + OFF_BAR), st);
  run_phase_t<0>(P, smem); grid.sync();
#define RP(i) run_phase_t<i>(P, smem); xcd_barrier(xb); if constexpr ((PROBE_REPEAT >> i) & 1) { run_phase_t<i>(P, smem); xcd_barrier(xb); }
  RP(1) RP(2) RP(3) RP(4) RP(5) RP(6) RP(7) RP(8) RP(9) RP(10) RP(11) RP(12) RP(13) RP(14) RP(15) RP(16) RP(17) RP(18) RP(19) RP(20)
#undef RP
#ifdef PROBE_SYNC
  for (int i = 0; i < PROBE_SYNC; ++i) xcd_barrier(xb);
#endif
  run_phase_t<21>(P, smem);
}
#if MULTI_LAUNCH
__global__ void __launch_bounds__(NTHREADS, 2) fwd_phase_kernel(Params P, int ph) {
  extern __shared__ __attribute__((aligned(16))) char smem[];
  run_phase(P, ph, smem);
}
#endif

extern "C" void kernel_launch(void* const* d_in, const int* in_sizes, int n_in, void* d_out, int out_size, void* d_ws, size_t ws_size,
                              hipStream_t stream) {
  static int grid_blocks = 0;
  if (!grid_blocks) {
    int dev = 0, cus = 0, per_cu = 0;
    (void)hipGetDevice(&dev);
    (void)hipDeviceGetAttribute(&cus, hipDeviceAttributeMultiprocessorCount, dev);
    (void)hipFuncSetAttribute((const void*)fwd_megakernel, hipFuncAttributeMaxDynamicSharedMemorySize, SMEM_BYTES);
#if MULTI_LAUNCH
    (void)hipFuncSetAttribute((const void*)fwd_phase_kernel, hipFuncAttributeMaxDynamicSharedMemorySize, SMEM_BYTES);
#endif
    (void)hipOccupancyMaxActiveBlocksPerMultiprocessor(&per_cu, fwd_megakernel, NTHREADS, SMEM_BYTES);
    if (per_cu > 2) per_cu = 2;
    if (per_cu < 1) per_cu = 1;
#ifdef PROBE_FORCE2
    per_cu = 2;
#endif
    grid_blocks = cus * per_cu;
    if (ws_size < OFF_END) fprintf(stderr, "workspace too small: %zu < %zu\n", ws_size, (size_t)OFF_END);
  }
  Params p{};
  for (int i = 0; i < 41; ++i) p.in[i] = (const float*)d_in[i];
  p.out = (float*)d_out; p.ws = (char*)d_ws; p.pad_ = 0;
#if MULTI_LAUNCH
  for (int ph = 0; ph < N_PHASES; ++ph) hipLaunchKernelGGL(fwd_phase_kernel, dim3(grid_blocks), dim3(NTHREADS), SMEM_BYTES, stream, p, ph);
#else
  (void)hipMemsetAsync((char*)d_ws + OFF_BAR, 0, XCD_BAR_WORDS * 4, stream);
  void* args[] = {&p};
  hipError_t e = hipLaunchCooperativeKernel((void*)fwd_megakernel, dim3(grid_blocks), dim3(NTHREADS), args, SMEM_BYTES, stream);
  if (e != hipSuccess) fprintf(stderr, "cooperative launch failed: %s (grid %d)\n", hipGetErrorString(e), grid_blocks);
#endif
}
```

```cpp
#include <hip/hip_runtime.h>
#include <hip/hip_cooperative_groups.h>
#include <cstdio>
namespace cg = cooperative_groups;

typedef _Float16 h16;
typedef _Float16 h16x8 __attribute__((ext_vector_type(8)));
typedef _Float16 h16x4 __attribute__((ext_vector_type(4)));
typedef float f32x4 __attribute__((ext_vector_type(4)));
typedef float f32x16 __attribute__((ext_vector_type(16)));
#define DI __device__ __forceinline__

constexpr int DM = 1024, NBATCH = 8, SEQ = 8192, CTXL = 256, TLAT = 65536, TCTX = 2048, TT = 67584;
constexpr int KEYS = SEQ + CTXL;
constexpr int NTHREADS = 256;
constexpr float EPS = 1e-6f;
constexpr float QSCALE = 0.10206207261596575f * 1.4426950408889634f;

constexpr int LD1 = 1088, LD2 = 2880;
constexpr long WT_WIN = 0, WT_WGATE = WT_WIN + 2432L * LD1, WT_UKV = WT_WGATE + 3072L * LD1, WT_UQ = WT_UKV + 1024L * 256,
               WT_GLU = WT_UQ + 1024L * 512, WT_BRHY = WT_GLU + 768L * 384, WT_BRS5 = WT_BRHY + 1024L * 384,
               WT_BRMLA = WT_BRS5 + 1024L * 384, WT_WO = WT_BRMLA + 1024L * 512, WT_UP = WT_WO + 1024L * LD1,
               WT_DOWN = WT_UP + 5632L * LD1, WT_LAYER = WT_DOWN + 1024L * LD2;
constexpr size_t al256(size_t x) { return (x + 255) / 256 * 256; }
constexpr size_t OFF_WT = 0;
constexpr size_t OFF_H1 = al256(OFF_WT + 2 * WT_LAYER * 2);
constexpr size_t OFF_U = al256(OFF_H1 + (size_t)TT * LD1 * 2);
constexpr size_t OFF_KVLAT = al256(OFF_U + (size_t)TT * 384 * 2);
constexpr size_t OFF_QLAT = al256(OFF_KVLAT + (size_t)TT * 256 * 2);
constexpr size_t OFF_PHY = al256(OFF_QLAT + (size_t)TT * 512 * 2);
constexpr size_t OFF_PHYC = al256(OFF_PHY + (size_t)NBATCH * 1152 * SEQ * 2);
constexpr size_t OFF_Q = al256(OFF_PHYC + (size_t)NBATCH * 1152 * CTXL * 2);
constexpr size_t OFF_K = al256(OFF_Q + (size_t)64 * KEYS * 96 * 2);
constexpr size_t OFF_VT = al256(OFF_K + (size_t)64 * KEYS * 96 * 2);
constexpr size_t OFF_YS5PRE = al256(OFF_VT + (size_t)64 * 64 * KEYS * 2);
constexpr size_t OFF_YHY = al256(OFF_YS5PRE + (size_t)TT * 384 * 2);
constexpr size_t OFF_FILT = al256(OFF_YHY + (size_t)TT * 384 * 2);
constexpr size_t OFF_TAPSC = al256(OFF_FILT + (size_t)768 * 2 * SEQ * 8);
constexpr size_t OFF_E = al256(OFF_TAPSC + (size_t)768 * 2 * CTXL * 4);
constexpr size_t OFF_XC = al256(OFF_E + (size_t)NBATCH * 2 * 24 * 132 * 64 * 8);
constexpr size_t OFF_MOD = al256(OFF_XC + (size_t)TCTX * 1024 * 4);
constexpr size_t OFF_Z2 = al256(OFF_MOD + (size_t)2 * 9 * 6144 * 4);
constexpr size_t OFF_Z2C = al256(OFF_Z2 + (size_t)2 * SEQ * 64 * 4);
constexpr size_t OFF_S5A = al256(OFF_Z2C + (size_t)2 * CTXL * 64 * 4);
constexpr size_t OFF_S5A64 = al256(OFF_S5A + (size_t)2 * 2 * 24 * 64 * 8);
constexpr size_t OFF_S5B = al256(OFF_S5A64 + (size_t)2 * 2 * 24 * 64 * 8);
constexpr size_t OFF_S5C = al256(OFF_S5B + (size_t)2 * 2 * 24 * 64 * 16 * 8);
constexpr size_t OFF_ROPE = al256(OFF_S5C + (size_t)2 * 2 * 24 * 16 * 128 * 2);
constexpr size_t OFF_BAR = al256(OFF_ROPE + (size_t)SEQ * 16 * 8);
constexpr size_t OFF_END = al256(OFF_BAR + (size_t)3456 * 4);
constexpr size_t OFF_YS5 = OFF_U, OFF_YMLA = OFF_QLAT, OFF_MERGED = OFF_Q, OFF_F = OFF_U, OFF_H2 = OFF_H1;
static_assert(OFF_END <= (size_t)1024 * 1024 * 1024, "workspace over 1 GiB");
static_assert(OFF_F + (size_t)TT * LD2 * 2 <= OFF_FILT, "f alias overruns");
static_assert(OFF_MERGED + (size_t)TT * LD1 * 2 <= OFF_VT, "merged alias overruns");

constexpr int SMEM_BYTES = 73728 + 2048;

struct Params {
  const float* in[41];
  float* out;
  char* ws;
  unsigned long long pad_;
};
enum { I_X = 0, I_C, I_CTX, I_CCTX, I_WMOD, I_BMOD, I_N1G, I_N2G, I_WIN, I_HCW, I_HCB, I_FW1, I_FB1, I_FW2, I_FB2, I_FW3, I_FFREQ,
       I_FDECAY, I_HBIAS, I_LAMRE, I_LAMIM, I_LOGSTEP, I_BRE, I_BIM, I_CRE, I_CIM, I_S5D, I_WGLU, I_GQ, I_WUQ, I_GKV, I_WUKV,
       I_WBRHY, I_WBRS5, I_WBRMLA, I_WO, I_WUP, I_FCW, I_FCB, I_WDOWN, I_FINALG };

DI int tidx() { int t = threadIdx.x; asm volatile("" : "+v"(t)); return t; }
DI int opaque_tid() { return tidx(); }
DI float sigmoidf_(float x) { return 1.f / (1.f + __expf(-x)); }
DI float siluf_(float x) { return x / (1.f + __expf(-x)); }
DI float geluf_(float x) { float z = 0.7978845608028654f * (x + 0.044715f * x * x * x); float t = 1.f - 2.f / (1.f + __expf(2.f * z)); return 0.5f * x * (1.f + t); }
DI float wave_sum(float v) { for (int o = 32; o > 0; o >>= 1) v += __shfl_xor(v, o); return v; }
DI float wave_max(float v) { for (int o = 32; o > 0; o >>= 1) v = fmaxf(v, __shfl_xor(v, o)); return v; }
DI void dsincos(double x, double& s, double& c) {
  const double TWO_PI = 6.283185307179586476925287;
  double r = x - TWO_PI * rint(x / TWO_PI);
  double r2 = r * r, ts = r, tc = 1.0; s = r; c = 1.0;
  for (int k = 1; k <= 15; ++k) { tc = -tc * r2 / (double)((2 * k - 1) * (2 * k)); c += tc; ts = -ts * r2 / (double)((2 * k) * (2 * k + 1)); s += ts; }
}
DI float2 twid(float f) { return make_float2(__builtin_amdgcn_cosf(f), __builtin_amdgcn_sinf(f)); }
DI float2 cmul(float2 a, float2 b) { return make_float2(a.x * b.x - a.y * b.y, a.x * b.y + a.y * b.x); }

struct Tok { int b, pos, ctx, mrow; };
DI Tok tokinfo(int t) { Tok k; if (t < TLAT) { k.b = t >> 13; k.pos = t & 8191; k.ctx = 0; k.mrow = k.b; } else { int u = t - TLAT; k.b = u >> 8; k.pos = u & 255; k.ctx = 1; k.mrow = 8; } return k; }

struct Stg { uint4 a0, a1, a2, a3, b0, b1, b2, b3; };
DI void g_load(Stg& s, const h16* __restrict__ A0, const h16* __restrict__ A1, const h16* __restrict__ A2, const h16* __restrict__ A3,
               const h16* __restrict__ Bp, long b32, int k0) {
  s.a0 = *reinterpret_cast<const uint4*>(A0 + k0); s.a1 = *reinterpret_cast<const uint4*>(A1 + k0);
  s.a2 = *reinterpret_cast<const uint4*>(A2 + k0); s.a3 = *reinterpret_cast<const uint4*>(A3 + k0);
  s.b0 = *reinterpret_cast<const uint4*>(Bp + k0); s.b1 = *reinterpret_cast<const uint4*>(Bp + b32 + k0);
  s.b2 = *reinterpret_cast<const uint4*>(Bp + 2 * b32 + k0); s.b3 = *reinterpret_cast<const uint4*>(Bp + 3 * b32 + k0);
}
DI uint4 zsel(uint4 v, bool ok) { return ok ? v : make_uint4(0, 0, 0, 0); }
DI void s_write(char* sw, const Stg& s, int okm) {
  *reinterpret_cast<uint4*>(sw) = zsel(s.a0, okm & 1); *reinterpret_cast<uint4*>(sw + 32 * 128) = zsel(s.a1, okm & 2);
  *reinterpret_cast<uint4*>(sw + 64 * 128) = zsel(s.a2, okm & 4); *reinterpret_cast<uint4*>(sw + 96 * 128) = zsel(s.a3, okm & 8);
  *reinterpret_cast<uint4*>(sw + 16384) = s.b0; *reinterpret_cast<uint4*>(sw + 16384 + 32 * 128) = s.b1; *reinterpret_cast<uint4*>(sw + 16384 + 64 * 128) = s.b2; *reinterpret_cast<uint4*>(sw + 16384 + 96 * 128) = s.b3;
}
#ifndef PROBE_MFMA
#define PROBE_MFMA 0
#endif
#if PROBE_MFMA
DI void mma_step(f32x4 (&acc)[4][4], const char* sa, const char* sb, int o0, int o1, f32x4 (&dmy)[2][4]) {
#else
DI void mma_step(f32x4 (&acc)[4][4], const char* sa, const char* sb, int o0, int o1) {
#endif
#pragma unroll
  for (int ks = 0; ks < 2; ++ks) {
    h16x8 af[4], bf[4];
    const int o = ks ? o1 : o0;
#pragma unroll
    for (int m = 0; m < 4; ++m) af[m] = *reinterpret_cast<const h16x8*>(sa + m * 16 * 128 + o);
#pragma unroll
    for (int n = 0; n < 4; ++n) bf[n] = *reinterpret_cast<const h16x8*>(sb + n * 16 * 128 + o);
#pragma unroll
    for (int m = 0; m < 4; ++m)
#pragma unroll
      for (int n = 0; n < 4; ++n) acc[m][n] = __builtin_amdgcn_mfma_f32_16x16x32_f16(af[m], bf[n], acc[m][n], 0, 0, 0);
#if PROBE_MFMA
#pragma unroll
    for (int m = 0; m < 2; ++m)
#pragma unroll
      for (int n = 0; n < 4; ++n) dmy[m][n] = __builtin_amdgcn_mfma_f32_16x16x32_f16(af[m + 2], bf[n], dmy[m][n], 0, 0, 0);
#endif
  }
}
DI void gemm_kloop_body(f32x4 (&acc)[4][4], const h16* __restrict__ A, long lda, int a_lo, int a_hi,
                   const h16* __restrict__ Bt, long ldb, int K, char* smem, int tid) {
  const int lane = tid & 63, wid = tid >> 6, wr = wid >> 1, wc = wid & 1, fr = lane & 15, fq = lane >> 4;
#if PROBE_MFMA
  f32x4 dmy[2][4];
  for (int m = 0; m < 2; ++m) for (int n = 0; n < 4; ++n) dmy[m][n] = f32x4{0.f, 0.f, 0.f, 0.f};
#define MMA(a, b, c, d, e) mma_step(a, b, c, d, e, dmy)
#else
#define MMA(a, b, c, d, e) mma_step(a, b, c, d, e)
#endif
  Stg s0, s1;
  const int srow = tid >> 3, skc = tid & 7;
  int okm = 0;
  const h16* Ar[4];
#pragma unroll
  for (int i = 0; i < 4; ++i) { const int row = srow + 32 * i; const bool ok = row >= a_lo && row < a_hi; okm |= ok ? (1 << i) : 0;
    const int rc = min(max(row, a_lo), a_hi - 1); Ar[i] = A + (long)rc * lda + skc * 8; }
  const h16* Bp = Bt + (long)srow * ldb + skc * 8;
  const long b32 = 32 * ldb;
  char* sw = smem + srow * 128 + ((skc ^ ((srow >> 1) & 7)) << 4);
  const char* sra = smem + (wr * 64 + fr) * 128; const char* srb = smem + 16384 + (wc * 64 + fr) * 128;
  const int o0 = (fq ^ ((fr >> 1) & 7)) << 4, o1 = ((4 + fq) ^ ((fr >> 1) & 7)) << 4;
  const int nk = K >> 6;
  g_load(s0, Ar[0], Ar[1], Ar[2], Ar[3], Bp, b32, 0); g_load(s1, Ar[0], Ar[1], Ar[2], Ar[3], Bp, b32, 64);
  s_write(sw, s0, okm); __syncthreads();
  for (int kt = 0; kt + 2 < nk; kt += 2) {
    g_load(s0, Ar[0], Ar[1], Ar[2], Ar[3], Bp, b32, (kt + 2) << 6);
    __builtin_amdgcn_sched_barrier(0);
    MMA(acc, sra, srb, o0, o1);
    __builtin_amdgcn_sched_barrier(0);
    s_write(sw + 32768, s1, okm);
    __syncthreads();
    g_load(s1, Ar[0], Ar[1], Ar[2], Ar[3], Bp, b32, (kt + 3) << 6);
    __builtin_amdgcn_sched_barrier(0);
    MMA(acc, sra + 32768, srb + 32768, o0, o1);
    __builtin_amdgcn_sched_barrier(0);
    s_write(sw, s0, okm);
    __syncthreads();
  }
  MMA(acc, sra, srb, o0, o1);
  s_write(sw + 32768, s1, okm);
  __syncthreads();
  MMA(acc, sra + 32768, srb + 32768, o0, o1);
  __syncthreads();
#if PROBE_MFMA
  { float z = 0.f; asm volatile("" : "+v"(z)); for (int m = 0; m < 2; ++m) for (int n = 0; n < 4; ++n) acc[m][n] += dmy[m][n] * z; }
#endif
#undef MMA
}
#ifndef PROBE_KLOOP
#define PROBE_KLOOP 0
#endif
DI void gemm_kloop(f32x4 (&acc)[4][4], const h16* __restrict__ A, long lda, int a_lo, int a_hi,
                   const h16* __restrict__ Bt, long ldb, int K, char* smem, int tid) {
  gemm_kloop_body(acc, A, lda, a_lo, a_hi, Bt, ldb, K, smem, tid);
}
struct TileWalk { int lb, nlb, m0, Mx, NT, nfull; };
DI TileWalk tw_init(int MT, int NT) { TileWalk w; w.lb = blockIdx.x >> 3; w.nlb = gridDim.x >> 3; w.Mx = MT >> 3; w.m0 = (blockIdx.x & 7) * w.Mx; w.NT = NT; w.nfull = (w.Mx >> 3) * 8 * NT; return w; }
DI int tw_count(const TileWalk& w) { return w.Mx * w.NT; }
DI void tw_decode(const TileWalk& w, int idx, int& mt, int& nt) {
  if (idx < w.nfull) { const int mg = idx / (8 * w.NT), r = idx % (8 * w.NT); nt = r >> 3; mt = w.m0 + mg * 8 + (r & 7); }
  else { const int rem = w.Mx & 7, r = idx - w.nfull; nt = r / rem; mt = w.m0 + (w.Mx & ~7) + r % rem; }
}
DI void stage_acc(const f32x4 (&acc)[4][4], float* Zs, int tid) {
  const int lane = tid & 63, wid = tid >> 6, wr = wid >> 1, wc = wid & 1, fr = lane & 15, fq = lane >> 4;
#pragma unroll
  for (int m = 0; m < 4; ++m)
#pragma unroll
    for (int n = 0; n < 4; ++n)
#pragma unroll
      for (int j = 0; j < 4; ++j) Zs[(wr * 64 + m * 16 + fq * 4 + j) * 132 + wc * 64 + n * 16 + fr] = acc[m][n][j];
  __syncthreads();
}
DI void stage_acc_t(const f32x4 (&acc)[4][4], float* Zs, int tid) {
  const int lane = tid & 63, wid = tid >> 6, wr = wid >> 1, wc = wid & 1, fr = lane & 15, fq = lane >> 4;
#pragma unroll
  for (int m = 0; m < 4; ++m)
#pragma unroll
    for (int n = 0; n < 4; ++n)
      *reinterpret_cast<float4*>(Zs + (wc * 64 + n * 16 + fr) * 132 + wr * 64 + m * 16 + fq * 4) = make_float4(acc[m][n][0], acc[m][n][1], acc[m][n][2], acc[m][n][3]);
  __syncthreads();
}
DI void copy_out_f16(const float* Zs, h16* __restrict__ dst, long row0, long ld, int cb, int tid) {
#pragma unroll
  for (int it = 0; it < 8; ++it) {
    const int chunk = it * 256 + tid, row = chunk >> 4, c8 = (chunk & 15) * 8;
    const float4 x0 = *reinterpret_cast<const float4*>(Zs + row * 132 + c8), x1 = *reinterpret_cast<const float4*>(Zs + row * 132 + c8 + 4);
    h16x8 o; o[0] = (h16)x0.x; o[1] = (h16)x0.y; o[2] = (h16)x0.z; o[3] = (h16)x0.w; o[4] = (h16)x1.x; o[5] = (h16)x1.y; o[6] = (h16)x1.z; o[7] = (h16)x1.w;
    *reinterpret_cast<h16x8*>(dst + (row0 + row) * ld + cb + c8) = o;
  }
}
DI void acc_zero(f32x4 (&acc)[4][4]) {
#pragma unroll
  for (int m = 0; m < 4; ++m)
#pragma unroll
    for (int n = 0; n < 4; ++n) acc[m][n] = f32x4{0.f, 0.f, 0.f, 0.f};
}
DI void row_rms(const h16* __restrict__ A, long lda, int K, float* rs) {
  const int tid = tidx(), row = tid >> 1, half = tid & 1;
  const h16* p = A + (long)row * lda + half * (K >> 1);
  float ss = 0.f;
  for (int k = 0; k < (K >> 1); k += 8) {
    h16x8 v = *reinterpret_cast<const h16x8*>(p + k);
#pragma unroll
    for (int j = 0; j < 8; ++j) { float f = (float)v[j]; ss += f * f; }
  }
  ss += __shfl_xor(ss, 1);
  if (half == 0) rs[row] = rsqrtf(ss / (float)K + EPS);
}
DI int map_interleave(int n, int half) { int tile = n >> 7, r = n & 127, sub = r >> 4, fr = r & 15; int j = tile * 64 + (sub >> 1) * 16 + fr; return (sub & 1) ? half + j : j; }
DI int map_col(int mat, int n) {
  switch (mat) {
    case 0: if (n < 640) return n; if (n < 2304) return n + 32; if (n < 2336) return n - 2304 + 640; return -1;
    case 1: return 2336 + n;
    case 3: { int h = n >> 7, j = n & 127; return j < 96 ? h * 96 + j : -1; }
    case 4: return map_interleave(n, 384);
    case 9: return map_interleave(n, 2816);
    default: return n;
  }
}
struct MatDesc { const float* src; const float* scale; long dst; int K, Nmy, Nsrc, ld; };
DI MatDesc get_mat(const Params& P, int layer, int mat) {
  MatDesc d; d.scale = nullptr;
  d.ld = (mat == 0 || mat == 1 || mat == 8 || mat == 9) ? LD1 : 0;
  switch (mat) {
    case 0: d.src = P.in[I_WIN] + (long)layer * 1024 * 5408; d.dst = WT_WIN; d.K = 1024; d.Nmy = 2432; d.Nsrc = 5408; break;
    case 1: d.src = P.in[I_WIN] + (long)layer * 1024 * 5408; d.dst = WT_WGATE; d.K = 1024; d.Nmy = 3072; d.Nsrc = 5408; break;
    case 2: d.src = P.in[I_WUKV] + (long)layer * 256 * 1024; d.dst = WT_UKV; d.K = 256; d.Nmy = 1024; d.Nsrc = 1024; d.scale = P.in[I_GKV] + layer * 256; break;
    case 3: d.src = P.in[I_WUQ] + (long)layer * 512 * 768; d.dst = WT_UQ; d.K = 512; d.Nmy = 1024; d.Nsrc = 768; d.scale = P.in[I_GQ] + layer * 512; break;
    case 4: d.src = P.in[I_WGLU] + (long)layer * 384 * 768; d.dst = WT_GLU; d.K = 384; d.Nmy = 768; d.Nsrc = 768; break;
    case 5: d.src = P.in[I_WBRHY] + (long)layer * 384 * 1024; d.dst = WT_BRHY; d.K = 384; d.Nmy = 1024; d.Nsrc = 1024; break;
    case 6: d.src = P.in[I_WBRS5] + (long)layer * 384 * 1024; d.dst = WT_BRS5; d.K = 384; d.Nmy = 1024; d.Nsrc = 1024; break;
    case 7: d.src = P.in[I_WBRMLA] + (long)layer * 512 * 1024; d.dst = WT_BRMLA; d.K = 512; d.Nmy = 1024; d.Nsrc = 1024; break;
    case 8: d.src = P.in[I_WO] + (long)layer * 1024 * 1024; d.dst = WT_WO; d.K = 1024; d.Nmy = 1024; d.Nsrc = 1024; break;
    case 9: d.src = P.in[I_WUP] + (long)layer * 1024 * 5632; d.dst = WT_UP; d.K = 1024; d.Nmy = 5632; d.Nsrc = 5632; break;
    default: d.src = P.in[I_WDOWN] + (long)layer * 2816 * 1024; d.dst = WT_DOWN; d.K = 2816; d.Nmy = 1024; d.Nsrc = 1024; d.ld = LD2; break;
  }
  if (d.ld == 0) d.ld = d.K;
  return d;
}
constexpr int WT_TILES_PER_LAYER = 608 + 768 + 64 + 128 + 72 + 96 + 96 + 128 + 256 + 1408 + 704;
DI void item_wt(const Params& P, int item, char* smem) {
  const int layer = item / WT_TILES_PER_LAYER; int r = item % WT_TILES_PER_LAYER;
  const int cnt[11] = {608, 768, 64, 128, 72, 96, 96, 128, 256, 1408, 704};
  int mat = 0;
#pragma unroll
  for (int i = 0; i < 10; ++i) { if (mat == i && r >= cnt[i]) { r -= cnt[i]; mat = i + 1; } }
  MatDesc d = get_mat(P, layer, mat);
  const int kt = d.K >> 6, n0 = (r / kt) * 64, k0 = (r % kt) * 64;
  float* tile = reinterpret_cast<float*>(smem);
  h16* dst = reinterpret_cast<h16*>(P.ws + OFF_WT) + (long)layer * WT_LAYER + d.dst;
  const int tid = tidx(), lx = tid & 63, ly = tid >> 6;
  const int sc = map_col(mat, n0 + lx);
#pragma unroll 4
  for (int i = 0; i < 16; ++i) { int kk = i * 4 + ly; tile[kk * 65 + lx] = sc >= 0 ? d.src[(long)(k0 + kk) * d.Nsrc + sc] : 0.f; }
  __syncthreads();
  const float s = d.scale ? d.scale[k0 + lx] : 1.f;
#pragma unroll 4
  for (int i = 0; i < 16; ++i) { int nn = i * 4 + ly; dst[(long)(n0 + nn) * d.ld + k0 + lx] = (h16)(tile[lx * 65 + nn] * s); }
  __syncthreads();
}
DI void item_mod(const Params& P, int item, char* smem) {
  const int layer = item / 96, n0 = (item % 96) * 64;
  float* s = reinterpret_cast<float*>(smem);
  float* part = s + 9 * 1024;
  const int tid = tidx(), lane = tid & 63, wid = tid >> 6;
  for (int i = tid; i < 9 * 1024; i += NTHREADS) { float v = i < 8192 ? P.in[I_C][i] : P.in[I_CCTX][i - 8192]; s[i] = siluf_(v); }
  __syncthreads();
  const float* w = P.in[I_WMOD] + (long)layer * 1024 * 6144 + n0 + lane;
  float acc[9];
#pragma unroll
  for (int r = 0; r < 9; ++r) acc[r] = 0.f;
  for (int k = wid * 256; k < wid * 256 + 256; ++k) {
    const float wv = w[(long)k * 6144];
#pragma unroll
    for (int r = 0; r < 9; ++r) acc[r] += s[r * 1024 + k] * wv;
  }
#pragma unroll
  for (int r = 0; r < 9; ++r) part[(wid * 9 + r) * 64 + lane] = acc[r];
  __syncthreads();
  float* mod = reinterpret_cast<float*>(P.ws + OFF_MOD) + (long)layer * 9 * 6144;
  for (int i = tid; i < 9 * 64; i += NTHREADS) {
    const int r = i >> 6, c = i & 63;
    mod[r * 6144 + n0 + c] = part[(0 * 9 + r) * 64 + c] + part[(1 * 9 + r) * 64 + c] + part[(2 * 9 + r) * 64 + c] + part[(3 * 9 + r) * 64 + c] + P.in[I_BMOD][layer * 6144 + n0 + c];
  }
  __syncthreads();
}
DI void item_hymlp(const Params& P, int item, char* smem) {
  const int layer = item / 132; int r = item % 132;
  const int isc = r >= 128; const int Lf = isc ? CTXL : SEQ; const int t0 = (isc ? r - 128 : r) * 64;
  float* z1 = reinterpret_cast<float*>(smem);
  const int tid = tidx(), tl = tid >> 2, h0 = (tid & 3) * 16; const int t = t0 + tl;
  const float* w1 = P.in[I_FW1] + layer * 17 * 64; const float* b1 = P.in[I_FB1] + layer * 64;
  const float* w2 = P.in[I_FW2] + layer * 64 * 64; const float* b2 = P.in[I_FB2] + layer * 64; const float* fq = P.in[I_FFREQ] + layer * 64;
  float feat[17]; feat[0] = (float)t / (float)Lf;
#pragma unroll
  for (int k = 1; k <= 8; ++k) { float rev = (float)((t * k) % Lf) / (float)Lf; feat[k] = __builtin_amdgcn_cosf(rev); feat[8 + k] = __builtin_amdgcn_sinf(rev); }
#pragma unroll 4
  for (int j = 0; j < 16; ++j) {
    const int h = h0 + j; float a = b1[h];
#pragma unroll
    for (int f = 0; f < 17; ++f) a += feat[f] * w1[f * 64 + h];
    z1[tl * 65 + h] = __sinf(fq[h] * a);
  }
  __syncthreads();
  float* z2 = isc ? reinterpret_cast<float*>(P.ws + OFF_Z2C) + (long)layer * CTXL * 64 : reinterpret_cast<float*>(P.ws + OFF_Z2) + (long)layer * SEQ * 64;
  float a2[16];
#pragma unroll
  for (int j = 0; j < 16; ++j) a2[j] = b2[h0 + j];
  for (int k = 0; k < 64; ++k) {
    const float zv = z1[tl * 65 + k];
#pragma unroll
    for (int j = 0; j < 16; ++j) a2[j] += zv * w2[k * 64 + h0 + j];
  }
#pragma unroll
  for (int j = 0; j < 16; ++j) z2[(long)t * 64 + h0 + j] = __sinf(fq[h0 + j] * a2[j]);
  __syncthreads();
}
DI void item_s5disc(const Params& P, int item) {
  const int layer = item / 12, dir = (item % 12) / 6, gb = item % 6;
  const int tid = tidx(), g = gb * 4 + (tid >> 6), n = tid & 63;
  const int ld = layer * 2 + dir; const long gi = (long)ld * 24 + g;
  const double lre = P.in[I_LAMRE][gi * 64 + n], lim = P.in[I_LAMIM][gi * 64 + n];
  const double step = exp((double)P.in[I_LOGSTEP][gi]);
  double sn, cs; dsincos(lim * step, sn, cs);
  const double mag = exp(lre * step);
  const double are = mag * cs, aim = mag * sn;
  const double nr = are - 1.0, ni = aim, den = lre * lre + lim * lim;
  const double fre = (nr * lre + ni * lim) / den, fim = (ni * lre - nr * lim) / den;
  float2* A = reinterpret_cast<float2*>(P.ws + OFF_S5A); float2* A64 = reinterpret_cast<float2*>(P.ws + OFF_S5A64);
  A[gi * 64 + n] = make_float2((float)are, (float)aim);
  double pr = are, pi = aim;
  for (int i = 0; i < 6; ++i) { double t = pr * pr - pi * pi; pi = 2.0 * pr * pi; pr = t; }
  A64[gi * 64 + n] = make_float2((float)pr, (float)pi);
  float2* Bb = reinterpret_cast<float2*>(P.ws + OFF_S5B) + (gi * 64 + n) * 16;
  const float* bre = P.in[I_BRE] + (gi * 64 + n) * 16; const float* bim = P.in[I_BIM] + (gi * 64 + n) * 16;
  for (int c = 0; c < 16; ++c) { double br = bre[c], bi = bim[c]; Bb[c] = make_float2((float)(fre * br - fim * bi), (float)(fre * bi + fim * br)); }
  h16* Ct = reinterpret_cast<h16*>(P.ws + OFF_S5C) + gi * 16 * 128;
  const float* cre = P.in[I_CRE] + gi * 16 * 64; const float* cim = P.in[I_CIM] + gi * 16 * 64;
  for (int c = 0; c < 16; ++c) { Ct[c * 128 + n] = (h16)cre[c * 64 + n]; Ct[c * 128 + 64 + n] = (h16)(-cim[c * 64 + n]); }
}
DI void item_rope(const Params& P, int item) {
  const int idx = item * NTHREADS + tidx(); const int pos = idx >> 4, i = idx & 15;
  const double inv[8] = {1.0, 0.31622776601683794, 0.1, 0.031622776601683794, 0.01, 0.0031622776601683794, 0.001, 0.00031622776601683794};
  double iv = 1.0;
#pragma unroll
  for (int k = 0; k < 8; ++k) if ((i & 7) == k) iv = inv[k];
  const double ang = (double)(i < 8 ? (pos >> 6) : (pos & 63)) * iv;
  double s, c; dsincos(ang, s, c);
  reinterpret_cast<float2*>(P.ws + OFF_ROPE)[idx] = make_float2((float)c, (float)s);
}
constexpr int PRO_N_WT = 2 * WT_TILES_PER_LAYER, PRO_N_MOD = 192, PRO_N_HY = 264, PRO_N_S5 = 24, PRO_N_ROPE = 512;
DI void phase_prologue(const Params& P, char* smem) {
  const int total = PRO_N_MOD + PRO_N_HY + PRO_N_S5 + PRO_N_ROPE + PRO_N_WT;
  for (int it = blockIdx.x; it < total; it += gridDim.x) {
    int i = it;
    if (i < PRO_N_MOD) { item_mod(P, i, smem); continue; } i -= PRO_N_MOD;
    if (i < PRO_N_HY) { item_hymlp(P, i, smem); continue; } i -= PRO_N_HY;
    if (i < PRO_N_S5) { item_s5disc(P, i); continue; } i -= PRO_N_S5;
    if (i < PRO_N_ROPE) { item_rope(P, i); continue; } i -= PRO_N_ROPE;
    item_wt(P, i, smem);
  }
}

DI const float* xrow_src(const Params& P, int layer_stage, int t) {
  if (t < TLAT) return (layer_stage == 0 ? P.in[I_X] : P.out) + (long)t * 1024;
  return (layer_stage == 0 ? P.in[I_CTX] : reinterpret_cast<const float*>(P.ws + OFF_XC)) + (long)(t - TLAT) * 1024;
}
DI float* xrow_dst(const Params& P, int t) {
  if (t < TLAT) return P.out + (long)t * 1024;
  return reinterpret_cast<float*>(P.ws + OFF_XC) + (long)(t - TLAT) * 1024;
}
DI void normmod_rows(const Params& P, int layer, int which, int stage, int ntok, int item, int nitems_stride) {
  const int tid = tidx(), lane = tid & 63, wid = tid >> 6;
  const float* g = P.in[which ? I_N2G : I_N1G] + layer * 1024;
  const float* mod = reinterpret_cast<const float*>(P.ws + OFF_MOD) + (long)layer * 9 * 6144;
  h16* H = reinterpret_cast<h16*>(P.ws + OFF_H1);
  for (int rg = item; rg * 4 < ntok; rg += nitems_stride) {
    const int t = rg * 4 + wid;
    const Tok k = tokinfo(t);
    const float* xr = xrow_src(P, stage, t);
    const float* sh = mod + k.mrow * 6144 + (which ? 3 : 0) * 1024; const float* sc = sh + 1024;
    float4 v[4]; float ss = 0.f;
#pragma unroll
    for (int i = 0; i < 4; ++i) { v[i] = *reinterpret_cast<const float4*>(xr + i * 256 + lane * 4); ss += v[i].x * v[i].x + v[i].y * v[i].y + v[i].z * v[i].z + v[i].w * v[i].w; }
    ss = wave_sum(ss);
    const float r = rsqrtf(ss * (1.f / 1024.f) + EPS);
#pragma unroll
    for (int i = 0; i < 4; ++i) {
      const int c = i * 256 + lane * 4;
      const float4 gg = *reinterpret_cast<const float4*>(g + c), s1 = *reinterpret_cast<const float4*>(sc + c), s0 = *reinterpret_cast<const float4*>(sh + c);
      h16x4 o;
      o[0] = (h16)(v[i].x * r * gg.x * (1.f + s1.x) + s0.x); o[1] = (h16)(v[i].y * r * gg.y * (1.f + s1.y) + s0.y);
      o[2] = (h16)(v[i].z * r * gg.z * (1.f + s1.z) + s0.z); o[3] = (h16)(v[i].w * r * gg.w * (1.f + s1.w) + s0.w);
      *reinterpret_cast<h16x4*>(H + (long)t * LD1 + c) = o;
    }
  }
}
DI void phase_final(const Params& P) {
  const int lane = tidx() & 63, wid = tidx() >> 6;
  const float* g = P.in[I_FINALG];
  for (int rg = blockIdx.x; rg * 4 < TLAT; rg += gridDim.x) {
    float* xr = P.out + (long)(rg * 4 + wid) * 1024;
    float4 v[4]; float ss = 0.f;
#pragma unroll
    for (int i = 0; i < 4; ++i) { v[i] = *reinterpret_cast<const float4*>(xr + i * 256 + lane * 4); ss += v[i].x * v[i].x + v[i].y * v[i].y + v[i].z * v[i].z + v[i].w * v[i].w; }
    ss = wave_sum(ss);
    const float r = rsqrtf(ss * (1.f / 1024.f) + EPS);
#pragma unroll
    for (int i = 0; i < 4; ++i) {
      const int c = i * 256 + lane * 4; const float4 gg = *reinterpret_cast<const float4*>(g + c);
      *reinterpret_cast<float4*>(xr + c) = make_float4(v[i].x * r * gg.x, v[i].y * r * gg.y, v[i].z * r * gg.z, v[i].w * r * gg.w);
    }
  }
}
DI float2 r8(int idx) { const float c = 0.70710678118654752f; return idx == 0 ? make_float2(1.f, 0.f) : idx == 1 ? make_float2(c, -c) : idx == 2 ? make_float2(0.f, -1.f) : make_float2(-c, -c); }
DI float2 cmul_r8(float2 w, int idx, bool cj) {
  if (idx == 0) return w;
  float2 r = r8(idx); if (cj) r.y = -r.y;
  return cmul(w, r);
}
template <int S> DI void fft_dif_pass(float2* X, int h) {
  const int hs = h >> (S - 1);
#pragma unroll 1
  for (int item = tidx(); item < (8192 >> S); item += NTHREADS) {
    const int j = item % hs, blk = item / hs, i0 = blk * 2 * h + j;
    float2 v[1 << S];
#pragma unroll
    for (int k = 0; k < (1 << S); ++k) v[k] = X[i0 + k * hs];
    float2 wp[S];
    wp[0] = twid(-(float)j / (float)(2 * h));
#pragma unroll
    for (int q = 1; q < S; ++q) wp[q] = cmul(wp[q - 1], wp[q - 1]);
#pragma unroll
    for (int q = 0; q < S; ++q) {
      const int dist = 1 << (S - 1 - q);
#pragma unroll
      for (int k = 0; k < (1 << S); ++k) {
        if (k & dist) continue;
        const float2 a = v[k], b = v[k + dist];
        const int m = k & (dist - 1);
        const float2 tw = cmul_r8(wp[q], m << (3 - (S - q)), false);
        v[k] = make_float2(a.x + b.x, a.y + b.y);
        v[k + dist] = cmul(make_float2(a.x - b.x, a.y - b.y), tw);
      }
    }
#pragma unroll
    for (int k = 0; k < (1 << S); ++k) X[i0 + k * hs] = v[k];
  }
  __syncthreads();
}
template <int S> DI void fft_dit_pass(float2* X, int hs) {
  const int hmax = hs << (S - 1);
#pragma unroll 1
  for (int item = tidx(); item < (8192 >> S); item += NTHREADS) {
    const int j = item % hs, blk = item / hs, i0 = blk * 2 * hmax + j;
    float2 v[1 << S];
#pragma unroll
    for (int k = 0; k < (1 << S); ++k) v[k] = X[i0 + k * hs];
    float2 bp[S];
    bp[S - 1] = twid((float)j / (float)(2 * hmax));
#pragma unroll
    for (int q = S - 2; q >= 0; --q) bp[q] = cmul(bp[q + 1], bp[q + 1]);
#pragma unroll
    for (int q = 0; q < S; ++q) {
      const int dist = 1 << q;
#pragma unroll
      for (int k = 0; k < (1 << S); ++k) {
        if (k & dist) continue;
        const int m = k & (dist - 1);
        const float2 tw = cmul_r8(bp[q], m << (3 - (q + 1)), true);
        const float2 a = v[k], b = cmul(v[k + dist], tw);
        v[k] = make_float2(a.x + b.x, a.y + b.y);
        v[k + dist] = make_float2(a.x - b.x, a.y - b.y);
      }
    }
#pragma unroll
    for (int k = 0; k < (1 << S); ++k) X[i0 + k * hs] = v[k];
  }
  __syncthreads();
}
DI void fft_fwd1(float2* X) { fft_dif_pass<3>(X, 4096); fft_dif_pass<3>(X, 512); fft_dif_pass<3>(X, 64); fft_dif_pass<2>(X, 8); fft_dif_pass<2>(X, 2); }
DI void fft_inv(float2* X) { fft_dit_pass<2>(X, 1); fft_dit_pass<2>(X, 4); fft_dit_pass<3>(X, 16); fft_dit_pass<3>(X, 128); fft_dit_pass<3>(X, 1024); }
#ifndef PROBE_FFT
#define PROBE_FFT 0
#endif
DI void fft_fwd(float2* X) {
#if PROBE_FFT
  fft_fwd1(X); fft_inv(X);
  for (int i = tidx(); i < 8192; i += NTHREADS) { float2 v = X[i]; X[i] = make_float2(v.x * (1.f / 8192.f), v.y * (1.f / 8192.f)); }
  __syncthreads();
#endif
  fft_fwd1(X);
}

DI float block_sum(float v, float* red) {
  v = wave_sum(v);
  __syncthreads();
  if ((tidx() & 63) == 0) red[tidx() >> 6] = v;
  __syncthreads();
  const float r = red[0] + red[1] + red[2] + red[3];
  __syncthreads();
  return r;
}
DI void item_filter(const Params& P, int layer, int oc, char* smem) {
  float2* X = reinterpret_cast<float2*>(smem); float* red = reinterpret_cast<float*>(smem + 65536);
  const int tid = tidx();
  const float* z2 = reinterpret_cast<const float*>(P.ws + OFF_Z2) + (long)layer * SEQ * 64;
  const float* w3 = P.in[I_FW3] + (long)layer * 64 * 1536; const float* dec = P.in[I_FDECAY] + layer * 1536;
  const int colf = oc, colb = 768 + oc;
  const float df = fabsf(dec[colf]), db = fabsf(dec[colb]);
  float lsum = 0.f;
#pragma unroll 2
  for (int i = 0; i < 32; ++i) {
    const int t = tid + 256 * i; const float* zr = z2 + (long)t * 64;
    float af = 0.f, ab = 0.f;
#pragma unroll 8
    for (int k = 0; k < 64; ++k) { const float z = zr[k]; af += z * w3[k * 1536 + colf]; ab += z * w3[k * 1536 + colb]; }
    const float tn = (float)t * (1.f / 8192.f);
    af *= __expf(-tn * df); ab *= __expf(-tn * db);
    lsum += fabsf(af) + fabsf(ab);
    X[t] = make_float2(af, ab);
  }
  const float nrm = block_sum(lsum, red);
  const float sc = 0.5f / 8192.f / nrm;
  float ev[32];
  float2* F = reinterpret_cast<float2*>(P.ws + OFF_FILT) + (long)oc * 2 * 8192;
#pragma unroll
  for (int i = 0; i < 32; ++i) {
    const int n = tid + 256 * i; const float lo = X[n].x; const float hi = n > 0 ? X[8192 - n].y : 0.f;
    ev[i] = (lo + hi) * sc; F[8192 + n] = make_float2((lo - hi) * sc, 0.f);
  }
  __syncthreads();
#pragma unroll
  for (int i = 0; i < 32; ++i) X[tid + 256 * i] = make_float2(ev[i], 0.f);
  __syncthreads();
  fft_fwd(X);
#pragma unroll 4
  for (int i = 0; i < 32; ++i) F[tid + 256 * i] = X[tid + 256 * i];
  __syncthreads();
#pragma unroll 4
  for (int i = 0; i < 32; ++i) { const int n = tid + 256 * i; const float d = F[8192 + n].x; const float2 w = twid(-(float)n * (1.f / 16384.f)); X[n] = make_float2(d * w.x, d * w.y); }
  __syncthreads();
  fft_fwd(X);
#pragma unroll 4
  for (int i = 0; i < 32; ++i) F[8192 + tid + 256 * i] = X[tid + 256 * i];
  __syncthreads();
}
DI void item_filter_ctx(const Params& P, int layer, int oc, char* smem) {
  float* red = reinterpret_cast<float*>(smem);
  const int t = tidx();
  const float* zr = reinterpret_cast<const float*>(P.ws + OFF_Z2C) + (long)layer * CTXL * 64 + t * 64;
  const float* w3 = P.in[I_FW3] + (long)layer * 64 * 1536; const float* dec = P.in[I_FDECAY] + layer * 1536;
  float af = 0.f, ab = 0.f;
  for (int k = 0; k < 64; ++k) { const float z = zr[k]; af += z * w3[k * 1536 + oc]; ab += z * w3[k * 1536 + 768 + oc]; }
  const float tn = (float)t * (1.f / 256.f);
  af *= __expf(-tn * fabsf(dec[oc])); ab *= __expf(-tn * fabsf(dec[768 + oc]));
  const float nrm = block_sum(fabsf(af) + fabsf(ab), red);
  float* T = reinterpret_cast<float*>(P.ws + OFF_TAPSC) + (long)oc * 512;
  T[t] = af / nrm; T[256 + t] = ab / nrm;
}

DI void phase_norm1(const Params& P, int layer, char* smem) {
  const int nfilt = 768 + (layer == 0 ? 768 : 0);
  for (int it = blockIdx.x; it < nfilt; it += gridDim.x) {
    if (it < 768) item_filter(P, layer, it, smem); else item_filter_ctx(P, layer, it - 768, smem);
  }
  normmod_rows(P, layer, 0, layer, TT, blockIdx.x, gridDim.x);
}

DI void phase_gemm_in(const Params& P, int layer, char* smem) {
  const int tid = tidx(), lane = tid & 63, wid = tid >> 6, wr = wid >> 1, wc = wid & 1, fr = lane & 15, fq = lane >> 4;
  const h16* H = reinterpret_cast<const h16*>(P.ws + OFF_H1);
  const h16* W = reinterpret_cast<const h16*>(P.ws + OFF_WT) + (long)layer * WT_LAYER + WT_WIN;
  h16* U = reinterpret_cast<h16*>(P.ws + OFF_U); h16* KV = reinterpret_cast<h16*>(P.ws + OFF_KVLAT); h16* QL = reinterpret_cast<h16*>(P.ws + OFF_QLAT);
  h16* PHY = reinterpret_cast<h16*>(P.ws + OFF_PHY); h16* PHYC = reinterpret_cast<h16*>(P.ws + OFF_PHYC); h16* Kb = reinterpret_cast<h16*>(P.ws + OFF_K);
  const float2* rope = reinterpret_cast<const float2*>(P.ws + OFF_ROPE);
  constexpr int NT = 19, MT = TT / 128;
  const TileWalk tw = tw_init(MT, NT);
  for (int tile = tw.lb; tile < tw_count(tw); tile += tw.nlb) {
    int mt, nt; tw_decode(tw, tile, mt, nt);
    f32x4 acc[4][4]; acc_zero(acc);
    gemm_kloop(acc, H + (long)mt * 128 * LD1, LD1, 0, 128, W + (long)nt * 128 * LD1, LD1, 1024, smem, opaque_tid());
    const int t0 = mt * 128; const Tok tk = tokinfo(t0);
    if (nt < 18) {
      float* Zs = reinterpret_cast<float*>(smem);
      const int t2 = tidx();
      if (nt < 9) {
        stage_acc(acc, Zs, t2);
        h16* dst; int ld, cb;
        if (nt < 3) { dst = U; ld = 384; cb = nt * 128; } else if (nt < 5) { dst = KV; ld = 256; cb = (nt - 3) * 128; } else { dst = QL; ld = 512; cb = (nt - 5) * 128; }
        copy_out_f16(Zs, dst, t0, ld, cb, t2);
      } else {
        stage_acc_t(acc, Zs, t2);
        h16* base = tk.ctx ? PHYC + (long)tk.b * 1152 * CTXL : PHY + (long)tk.b * 1152 * SEQ; const int lp = tk.ctx ? CTXL : SEQ;
        copy_out_f16(Zs, base, (nt - 9) * 128, lp, tk.pos, t2);
      }
      __syncthreads();
    } else if (wc == 0) {
#pragma unroll
      for (int m = 0; m < 4; ++m)
#pragma unroll
        for (int j = 0; j < 4; ++j) {
          const int pos = tk.pos + wr * 64 + m * 16 + fq * 4 + j; const int key = tk.ctx ? SEQ + pos : pos;
          float x1 = acc[m][0][j], x2 = acc[m][1][j];
          if (!tk.ctx) { const float2 cs = rope[pos * 16 + fr]; const float y1 = x1 * cs.x - x2 * cs.y, y2 = x1 * cs.y + x2 * cs.x; x1 = y1; x2 = y2; }
#pragma unroll
          for (int h = 0; h < 8; ++h) { h16* kr = Kb + ((long)(tk.b * 8 + h) * KEYS + key) * 96 + 64; kr[fr] = (h16)x1; kr[16 + fr] = (h16)x2; }
        }
    }
  }
}
DI void item_kv(const Params& P, int layer, int tile, char* smem) {
  const int tid = tidx(), lane = tid & 63, wid = tid >> 6, wr = wid >> 1, wc = wid & 1, fr = lane & 15, fq = lane >> 4;
  const int mt = tile >> 3, hd = tile & 7; const int t0 = mt * 128; const Tok tk = tokinfo(t0);
  const h16* A = reinterpret_cast<const h16*>(P.ws + OFF_KVLAT) + (long)t0 * 256;
  const h16* W = reinterpret_cast<const h16*>(P.ws + OFF_WT) + (long)layer * WT_LAYER + WT_UKV + (long)hd * 128 * 256;
  float* rs = reinterpret_cast<float*>(smem + 73728);
  row_rms(A, 256, 256, rs);
  f32x4 acc[4][4]; acc_zero(acc);
  gemm_kloop(acc, A, 256, 0, 128, W, 256, 256, smem, opaque_tid());
  h16* Kb = reinterpret_cast<h16*>(P.ws + OFF_K) + (long)(tk.b * 8 + hd) * KEYS * 96;
  h16* Vt = reinterpret_cast<h16*>(P.ws + OFF_VT) + (long)(tk.b * 8 + hd) * 64 * KEYS;
  const int key0 = (tk.ctx ? SEQ : 0) + tk.pos;
#pragma unroll
  for (int m = 0; m < 4; ++m) {
    const int r0 = wr * 64 + m * 16 + fq * 4;
    const float s0 = rs[r0], s1 = rs[r0 + 1], s2 = rs[r0 + 2], s3 = rs[r0 + 3];
#pragma unroll
    for (int n = 0; n < 4; ++n) {
      const int col = n * 16 + fr;
      if (wc == 0) {
        Kb[(long)(key0 + r0 + 0) * 96 + col] = (h16)(acc[m][n][0] * s0); Kb[(long)(key0 + r0 + 1) * 96 + col] = (h16)(acc[m][n][1] * s1);
        Kb[(long)(key0 + r0 + 2) * 96 + col] = (h16)(acc[m][n][2] * s2); Kb[(long)(key0 + r0 + 3) * 96 + col] = (h16)(acc[m][n][3] * s3);
      } else {
        h16x4 o; o[0] = (h16)(acc[m][n][0] * s0); o[1] = (h16)(acc[m][n][1] * s1); o[2] = (h16)(acc[m][n][2] * s2); o[3] = (h16)(acc[m][n][3] * s3);
        *reinterpret_cast<h16x4*>(Vt + (long)col * KEYS + key0 + r0) = o;
      }
    }
  }
  __syncthreads();
}
DI void item_q(const Params& P, int layer, int tile, char* smem) {
  const int tid = tidx(), lane = tid & 63, wid = tid >> 6, wr = wid >> 1, wc = wid & 1, fr = lane & 15, fq = lane >> 4;
  const int mt = tile >> 3, hd = tile & 7; const int t0 = mt * 128; const Tok tk = tokinfo(t0);
  const h16* A = reinterpret_cast<const h16*>(P.ws + OFF_QLAT) + (long)t0 * 512;
  const h16* W = reinterpret_cast<const h16*>(P.ws + OFF_WT) + (long)layer * WT_LAYER + WT_UQ + (long)hd * 128 * 512;
  float* rs = reinterpret_cast<float*>(smem + 73728);
  row_rms(A, 512, 512, rs);
  f32x4 acc[4][4]; acc_zero(acc);
  gemm_kloop(acc, A, 512, 0, 128, W, 512, 512, smem, opaque_tid());
  h16* Qb = reinterpret_cast<h16*>(P.ws + OFF_Q) + (long)(tk.b * 8 + hd) * KEYS * 96;
  const float2* rope = reinterpret_cast<const float2*>(P.ws + OFF_ROPE);
  const int q0 = (tk.ctx ? SEQ : 0) + tk.pos;
#pragma unroll
  for (int m = 0; m < 4; ++m)
#pragma unroll
    for (int j = 0; j < 4; ++j) {
      const int r = wr * 64 + m * 16 + fq * 4 + j; const float s = rs[r] * QSCALE;
      h16* qr = Qb + (long)(q0 + r) * 96;
      if (wc == 0) {
#pragma unroll
        for (int n = 0; n < 4; ++n) qr[n * 16 + fr] = (h16)(acc[m][n][j] * s);
      } else {
        float x1 = acc[m][0][j], x2 = acc[m][1][j];
        if (!tk.ctx) { const float2 cs = rope[(tk.pos + r) * 16 + fr]; const float y1 = x1 * cs.x - x2 * cs.y, y2 = x1 * cs.y + x2 * cs.x; x1 = y1; x2 = y2; }
        qr[64 + fr] = (h16)(x1 * s); qr[80 + fr] = (h16)(x2 * s);
      }
    }
  __syncthreads();
}
DI int s5_chunk_base(int b, int dir, int si) {
  if (si < 4) { const int cc = dir ? 3 - si : si; return TLAT + b * CTXL + cc * 64; }
  const int lc = dir ? 127 - (si - 4) : si - 4; return b * SEQ + lc * 64;
}
DI void s5_stage_u(const h16* __restrict__ U, int tokbase, int g, float* us) {
  const int lane = tidx() & 63;
  const h16* p = U + (long)(tokbase + lane) * 384 + g * 16;
  const h16x8 v0 = *reinterpret_cast<const h16x8*>(p), v1 = *reinterpret_cast<const h16x8*>(p + 8);
#pragma unroll
  for (int j = 0; j < 8; ++j) { us[lane * 16 + j] = (float)v0[j]; us[lane * 16 + 8 + j] = (float)v1[j]; }
}
DI void item_s5_pass1(const Params& P, int layer, int wtask, char* smem) {
  const int lane = tidx() & 63, wid = tidx() >> 6;
  float* us = reinterpret_cast<float*>(smem + wid * 12800);
  const int si = wtask % 132; int r = wtask / 132; const int g = r % 24; r /= 24; const int dir = r & 1, b = r >> 1;
  const long gi = (long)(layer * 2 + dir) * 24 + g;
  const float2 a = reinterpret_cast<const float2*>(P.ws + OFF_S5A)[gi * 64 + lane];
  const float2* Bb = reinterpret_cast<const float2*>(P.ws + OFF_S5B) + (gi * 64 + lane) * 16;
  float bre[16], bim[16];
#pragma unroll
  for (int c = 0; c < 16; ++c) { const float2 v = Bb[c]; bre[c] = v.x; bim[c] = v.y; }
  s5_stage_u(reinterpret_cast<const h16*>(P.ws + OFF_U), s5_chunk_base(b, dir, si), g, us);
  float hr = 0.f, hi = 0.f;
#pragma unroll 4
  for (int s = 0; s < 64; ++s) {
    const int tau = dir ? 63 - s : s;
    const float4* up = reinterpret_cast<const float4*>(us + tau * 16);
    float br = 0.f, bi = 0.f;
#pragma unroll
    for (int q = 0; q < 4; ++q) { const float4 u = up[q];
      br += bre[q * 4] * u.x + bre[q * 4 + 1] * u.y + bre[q * 4 + 2] * u.z + bre[q * 4 + 3] * u.w;
      bi += bim[q * 4] * u.x + bim[q * 4 + 1] * u.y + bim[q * 4 + 2] * u.z + bim[q * 4 + 3] * u.w; }
    const float nr = a.x * hr - a.y * hi + br, ni = a.x * hi + a.y * hr + bi; hr = nr; hi = ni;
  }
  reinterpret_cast<float2*>(P.ws + OFF_E)[((long)((b * 2 + dir) * 24 + g) * 132 + si) * 64 + lane] = make_float2(hr, hi);
}

DI float hy_dw(const h16* __restrict__ p, int t, int Ls, float w0, float w1, float w2, float bias) {
  const float xm_ = (float)p[max(t - 1, 0)], x0 = (float)p[t], xp_ = (float)p[min(t + 1, Ls - 1)];
  const float xm = t > 0 ? xm_ : 0.f, xp = t + 1 < Ls ? xp_ : 0.f;
  return xm * w0 + x0 * w1 + xp * w2 + bias;
}
DI void item_hyena(const Params& P, int layer, int task, char* smem) {
  float2* X = reinterpret_cast<float2*>(smem);
  const int tid = tidx(); const int pair = task / 384, c = task % 384;
  const h16* PH0 = reinterpret_cast<const h16*>(P.ws + OFF_PHY) + (long)(2 * pair) * 1152 * SEQ;
  const h16* PH1 = PH0 + (long)1152 * SEQ;
  const float* cw = P.in[I_HCW] + layer * 3 * 1152; const float* cb = P.in[I_HCB] + layer * 1152;
  const float2* F = reinterpret_cast<const float2*>(P.ws + OFF_FILT);
  float2* SCR = reinterpret_cast<float2*>(P.ws + OFF_YS5PRE) + (long)blockIdx.x * 12288;
  float2* SCR2 = SCR + 8192;
  const float vw0 = cw[c], vw1 = cw[1152 + c], vw2 = cw[2304 + c], vbb = cb[c];
  const h16* pv0 = PH0 + (long)c * SEQ; const h16* pv1 = PH1 + (long)c * SEQ;
  float2 ye[16]; int tq;
#pragma unroll 1
  for (int o = 0; o < 2; ++o) {
    const float2* Te = F + (long)(o * 384 + c) * 2 * 8192; const float2* To = Te + 8192;
    float ts = 1.f / 16384.f; asm volatile("" : "+v"(ts));
{ tq = tid; asm volatile("" : "+v"(tq)); }
    if (o == 0) {
#pragma unroll 8
      for (int i = 0; i < 32; ++i) { const int t = tq + 256 * i; const float2 v = make_float2(hy_dw(pv0, t, SEQ, vw0, vw1, vw2, vbb), hy_dw(pv1, t, SEQ, vw0, vw1, vw2, vbb)); X[t] = v; SCR[t] = v; }
    } else {
#pragma unroll 16
      for (int i = 0; i < 32; ++i) { const int t = tq + 256 * i; X[t] = SCR[t]; }
    }
    __syncthreads();
    fft_fwd(X);
{ tq = tid; asm volatile("" : "+v"(tq)); }
#pragma unroll 8
    for (int i = 0; i < 32; ++i) { const int n = tq + 256 * i; X[n] = cmul(X[n], Te[n]); }
    __syncthreads();
    fft_inv(X);
{ tq = tid; asm volatile("" : "+v"(tq)); }
#pragma unroll
    for (int i = 0; i < 16; ++i) { ye[i] = X[tq + 256 * i]; SCR2[tq + 256 * i] = X[tq + 4096 + 256 * i]; }
    __syncthreads();
{ tq = tid; asm volatile("" : "+v"(tq)); }
#pragma unroll 16
    for (int i = 0; i < 32; ++i) { const int t = tq + 256 * i; X[t] = cmul(SCR[t], twid(-(float)t * ts)); }
    __syncthreads();
    fft_fwd(X);
{ tq = tid; asm volatile("" : "+v"(tq)); }
#pragma unroll 8
    for (int i = 0; i < 32; ++i) { const int n = tq + 256 * i; X[n] = cmul(X[n], To[n]); }
    __syncthreads();
    fft_inv(X);
    asm volatile("" : "+v"(ts));
{ tq = tid; asm volatile("" : "+v"(tq)); }
#pragma unroll
    for (int i = 0; i < 16; ++i) { const int t = tq + 256 * i; const float2 yo = cmul(X[t], twid((float)t * ts)); X[t] = make_float2(ye[i].x + yo.x, ye[i].y + yo.y); }
{ tq = tid; asm volatile("" : "+v"(tq)); }
#pragma unroll 2
    for (int i = 0; i < 16; ++i) { const int t = tq + 4096 + 256 * i; const float2 yo = cmul(X[t], twid((float)t * ts)); const float2 y2 = SCR2[tq + 256 * i]; X[t] = make_float2(y2.x + yo.x, y2.y + yo.y); }
    const int gc = (o + 1) * 384 + c;
    const float w0 = cw[gc], w1 = cw[1152 + gc], w2 = cw[2304 + gc], bb = cb[gc];
    const float bias = P.in[I_HBIAS][(layer * 2 + o) * 384 + c];
    const h16* pg0 = PH0 + (long)gc * SEQ; const h16* pg1 = PH1 + (long)gc * SEQ;
    h16* Y = reinterpret_cast<h16*>(P.ws + OFF_YHY);
{ tq = tid; asm volatile("" : "+v"(tq)); }
    if (o == 0) {
#pragma unroll 8
      for (int i = 0; i < 32; ++i) {
        const int t = tq + 256 * i;
        const float2 lc = X[t];
        const float2 zz = SCR[t];
        const float gx = hy_dw(pg0, t, SEQ, w0, w1, w2, bb), gy = hy_dw(pg1, t, SEQ, w0, w1, w2, bb);
        SCR[t] = make_float2(gx * (lc.x + bias * zz.x), gy * (lc.y + bias * zz.y));
      }
    } else {
#pragma unroll 8
      for (int i = 0; i < 32; ++i) {
        const int t = tq + 256 * i;
        const float2 lc = X[t];
        const float2 zz = SCR[t];
        const float gx = hy_dw(pg0, t, SEQ, w0, w1, w2, bb), gy = hy_dw(pg1, t, SEQ, w0, w1, w2, bb);
        Y[((long)(2 * pair) * SEQ + t) * 384 + c] = (h16)(gx * (lc.x + bias * zz.x)); Y[((long)(2 * pair + 1) * SEQ + t) * 384 + c] = (h16)(gy * (lc.y + bias * zz.y));
      }
    }
    __syncthreads();
  }
}
DI void item_hyena_ctx(const Params& P, int layer, int task, char* smem) {
  float* su = reinterpret_cast<float*>(smem); float* sf = su + 256; float* sb = sf + 256;
  const int t = tidx(); const int b = task / 384, c = task % 384;
  const h16* PH = reinterpret_cast<const h16*>(P.ws + OFF_PHYC) + (long)b * 1152 * CTXL;
  const float* cw = P.in[I_HCW] + layer * 3 * 1152; const float* cb = P.in[I_HCB] + layer * 1152;
  float u = hy_dw(PH + (long)c * CTXL, t, CTXL, cw[c], cw[1152 + c], cw[2304 + c], cb[c]);
  for (int o = 0; o < 2; ++o) {
    const float* T = reinterpret_cast<const float*>(P.ws + OFF_TAPSC) + (long)(o * 384 + c) * 512;
    __syncthreads();
    su[t] = u; sf[t] = T[t]; sb[t] = T[256 + t];
    __syncthreads();
    float y = 0.f;
    for (int s = 0; s <= t; ++s) y += sf[t - s] * su[s];
    for (int s = t + 1; s < 256; ++s) y += sb[s - t] * su[s];
    const int gc = (o + 1) * 384 + c;
    const float gx = hy_dw(PH + (long)gc * CTXL, t, CTXL, cw[gc], cw[1152 + gc], cw[2304 + gc], cb[gc]);
    u = gx * (y + P.in[I_HBIAS][(layer * 2 + o) * 384 + c] * u);
  }
  reinterpret_cast<h16*>(P.ws + OFF_YHY)[((long)TLAT + b * CTXL + t) * 384 + c] = (h16)u;
  __syncthreads();
}

#ifndef PROBE_HY
#define PROBE_HY 0
#endif
#ifndef PROBE_S5
#define PROBE_S5 0
#endif
DI int first_item(int base) { const int g = (int)gridDim.x; return (((int)blockIdx.x - base) % g + g) % g; }
DI void phase_mix1(const Params& P, int layer, char* smem) {
  const int n_hy = 4 * 384, n_hyc = layer == 0 ? 8 * 384 : 0;
  const int n_kv = (TT / 128) * 8, n_q = (layer == 0 ? TT / 128 : TLAT / 128) * 8;
  const int n_s5 = (NBATCH * 2 * 24 * 132) / 4;
  const int g = gridDim.x;
#pragma unroll 1
  for (int rep = 0; rep < 1 + PROBE_HY; ++rep)
#pragma unroll 1
  for (int i = first_item(0); i < n_hy; i += g) item_hyena(P, layer, i, smem);
  asm volatile("" ::: "memory");
#pragma unroll 1
  for (int i = first_item(n_hy); i < n_kv; i += g) item_kv(P, layer, i, smem);
  asm volatile("" ::: "memory");
#pragma unroll 1
  for (int i = first_item(n_hy + n_kv); i < n_q; i += g) item_q(P, layer, i, smem);
  asm volatile("" ::: "memory");
#pragma unroll 1
  for (int rep = 0; rep < 1 + PROBE_S5; ++rep)
#pragma unroll 1
  for (int i = first_item(n_hy + n_kv + n_q); i < n_s5; i += g) { item_s5_pass1(P, layer, i * 4 + (tidx() >> 6), smem); __syncthreads(); }
  asm volatile("" ::: "memory");
#pragma unroll 1
  for (int i = first_item(n_hy + n_kv + n_q + n_s5); i < n_hyc; i += g) item_hyena_ctx(P, layer, i, smem);
}
DI int crow32(int r, int hi) { return (r & 3) + 8 * (r >> 2) + 4 * hi; }
DI void item_attn(const Params& P, int bh, int q0, int key_lo, int ntiles, char* smem) {
  const int tid = tidx(), lane = tid & 63, wid = tid >> 6, r32 = lane & 31, hi = lane >> 5;
  const h16* Qb = reinterpret_cast<const h16*>(P.ws + OFF_Q) + (long)bh * KEYS * 96;
  const h16* Kb = reinterpret_cast<const h16*>(P.ws + OFF_K) + (long)bh * KEYS * 96;
  const h16* Vt = reinterpret_cast<const h16*>(P.ws + OFF_VT) + (long)bh * 64 * KEYS;
  h16x8 qf[6];
  { const h16* qrow = Qb + (long)(q0 + wid * 32 + r32) * 96 + hi * 8;
#pragma unroll
    for (int ds = 0; ds < 6; ++ds) qf[ds] = *reinterpret_cast<const h16x8*>(qrow + ds * 16); }
  constexpr int KT_BYTES = 64 * 208, VT_BYTES = 64 * 136, BUF = KT_BYTES + VT_BYTES;
  uint4 kr[3]; uint4 vr[2];
  const int vdv0 = tid >> 3, vpart = tid & 7;
  auto gload = [&](int j) {
    const long key0 = key_lo + j * 64;
#pragma unroll
    for (int i = 0; i < 3; ++i) kr[i] = *reinterpret_cast<const uint4*>(Kb + key0 * 96 + (long)(tid + 256 * i) * 8);
#pragma unroll
    for (int i = 0; i < 2; ++i) vr[i] = *reinterpret_cast<const uint4*>(Vt + (long)(vdv0 + 32 * i) * KEYS + key0 + vpart * 8);
  };
  auto swrite = [&](int buf) {
    char* ks = smem + buf * BUF; char* vs = ks + KT_BYTES;
#pragma unroll
    for (int i = 0; i < 3; ++i) { const int c = tid + 256 * i; *reinterpret_cast<uint4*>(ks + (c / 12) * 208 + (c % 12) * 16) = kr[i]; }
#pragma unroll
    for (int i = 0; i < 2; ++i) { char* d = vs + (vdv0 + 32 * i) * 136 + vpart * 16;
      *reinterpret_cast<uint2*>(d) = make_uint2(vr[i].x, vr[i].y); *reinterpret_cast<uint2*>(d + 8) = make_uint2(vr[i].z, vr[i].w); }
  };
  f32x16 o0, o1;
#pragma unroll
  for (int r = 0; r < 16; ++r) { o0[r] = 0.f; o1[r] = 0.f; }
  float m_run = -1e30f, l_run = 0.f;
  gload(0); swrite(0); __syncthreads();
  for (int j = 0; j < ntiles; ++j) {
    if (j + 1 < ntiles) gload(j + 1);
    const char* ks = smem + (j & 1) * BUF; const char* vs = ks + KT_BYTES;
    f32x16 p0, p1;
#pragma unroll
    for (int r = 0; r < 16; ++r) { p0[r] = 0.f; p1[r] = 0.f; }
#pragma unroll
    for (int ds = 0; ds < 6; ++ds) {
      const h16x8 a0 = *reinterpret_cast<const h16x8*>(ks + r32 * 208 + (ds * 16 + hi * 8) * 2);
      const h16x8 a1 = *reinterpret_cast<const h16x8*>(ks + (32 + r32) * 208 + (ds * 16 + hi * 8) * 2);
      p0 = __builtin_amdgcn_mfma_f32_32x32x16_f16(a0, qf[ds], p0, 0, 0, 0);
      p1 = __builtin_amdgcn_mfma_f32_32x32x16_f16(a1, qf[ds], p1, 0, 0, 0);
    }
    float mx = p0[0];
#pragma unroll
    for (int r = 1; r < 16; ++r) mx = fmaxf(mx, p0[r]);
#pragma unroll
    for (int r = 0; r < 16; ++r) mx = fmaxf(mx, p1[r]);
    mx = fmaxf(mx, __shfl_xor(mx, 32));
    const float mnew = fmaxf(m_run, mx);
    const float alpha = __builtin_amdgcn_exp2f(m_run - mnew);
    m_run = mnew;
    float rsum = 0.f;
#pragma unroll
    for (int r = 0; r < 16; ++r) { p0[r] = __builtin_amdgcn_exp2f(p0[r] - mnew); rsum += p0[r]; }
#pragma unroll
    for (int r = 0; r < 16; ++r) { p1[r] = __builtin_amdgcn_exp2f(p1[r] - mnew); rsum += p1[r]; }
    l_run = l_run * alpha + rsum;
    if (__any(alpha != 1.f)) {
#pragma unroll
      for (int r = 0; r < 16; ++r) { o0[r] *= alpha; o1[r] *= alpha; }
    }
#pragma unroll
    for (int kb = 0; kb < 2; ++kb)
#pragma unroll
      for (int s = 0; s < 2; ++s) {
        h16x8 pf;
#pragma unroll
        for (int e = 0; e < 8; ++e) pf[e] = (h16)(kb ? p1[8 * s + e] : p0[8 * s + e]);
        const int koff = (32 * kb + 16 * s + 4 * hi) * 2;
        {
          const h16x4 lo = *reinterpret_cast<const h16x4*>(vs + r32 * 136 + koff), hh = *reinterpret_cast<const h16x4*>(vs + r32 * 136 + koff + 16);
          const h16x8 af = __builtin_shufflevector(lo, hh, 0, 1, 2, 3, 4, 5, 6, 7);
          o0 = __builtin_amdgcn_mfma_f32_32x32x16_f16(af, pf, o0, 0, 0, 0);
        }
        {
          const h16x4 lo = *reinterpret_cast<const h16x4*>(vs + (32 + r32) * 136 + koff), hh = *reinterpret_cast<const h16x4*>(vs + (32 + r32) * 136 + koff + 16);
          const h16x8 af = __builtin_shufflevector(lo, hh, 0, 1, 2, 3, 4, 5, 6, 7);
          o1 = __builtin_amdgcn_mfma_f32_32x32x16_f16(af, pf, o1, 0, 0, 0);
        }
      }
    if (j + 1 < ntiles) swrite((j + 1) & 1);
    __syncthreads();
  }
  const float lt = l_run + __shfl_xor(l_run, 32);
  const float inv = 1.f / lt;
  const int b = bh >> 3, hd = bh & 7; const int q = q0 + wid * 32 + r32;
  const long tok = q < SEQ ? (long)b * SEQ + q : (long)TLAT + b * CTXL + (q - SEQ);
  h16* yr = reinterpret_cast<h16*>(P.ws + OFF_YMLA) + tok * 512 + hd * 64;
#pragma unroll
  for (int g = 0; g < 4; ++g) {
    h16x4 a, c;
#pragma unroll
    for (int e = 0; e < 4; ++e) { a[e] = (h16)(o0[4 * g + e] * inv); c[e] = (h16)(o1[4 * g + e] * inv); }
    *reinterpret_cast<h16x4*>(yr + 8 * g + 4 * hi) = a;
    *reinterpret_cast<h16x4*>(yr + 32 + 8 * g + 4 * hi) = c;
  }
}
DI void item_s5_pass3(const Params& P, int layer, int b, int g, int ck, char* smem) {
  const int lane = tidx() & 63, wid = tidx() >> 6, fr = lane & 15, fq = lane >> 4;
  float* us = reinterpret_cast<float*>(smem + wid * 12800); char* Hs = smem + wid * 12800 + 4096;
  const int tokbase = ck < 4 ? TLAT + b * CTXL + ck * 64 : b * SEQ + (ck - 4) * 64;
  s5_stage_u(reinterpret_cast<const h16*>(P.ws + OFF_U), tokbase, g, us);
  __syncthreads();
  f32x4 yacc[4];
#pragma unroll
  for (int i = 0; i < 4; ++i) yacc[i] = f32x4{0.f, 0.f, 0.f, 0.f};
#pragma unroll
  for (int dir = 0; dir < 2; ++dir) {
    const long gi = (long)(layer * 2 + dir) * 24 + g;
    const float2 a = reinterpret_cast<const float2*>(P.ws + OFF_S5A)[gi * 64 + lane];
    const float2 a64 = reinterpret_cast<const float2*>(P.ws + OFF_S5A64)[gi * 64 + lane];
    const float2* Bb = reinterpret_cast<const float2*>(P.ws + OFF_S5B) + (gi * 64 + lane) * 16;
    float bre[16], bim[16];
#pragma unroll
    for (int c = 0; c < 16; ++c) { const float2 v = Bb[c]; bre[c] = v.x; bim[c] = v.y; }
    const int si = ck < 4 ? (dir ? 3 - ck : ck) : 4 + (dir ? 127 - (ck - 4) : ck - 4);
    const float2* Ep = reinterpret_cast<const float2*>(P.ws + OFF_E) + ((long)((b * 2 + dir) * 24 + g) * 132) * 64 + lane;
    float hr = 0.f, hi = 0.f;
#pragma unroll 16
    for (int i = 0; i < si; ++i) { const float2 e = Ep[(long)i * 64]; const float nr = a64.x * hr - a64.y * hi + e.x, ni = a64.x * hi + a64.y * hr + e.y; hr = nr; hi = ni; }
    const h16* Ct = reinterpret_cast<const h16*>(P.ws + OFF_S5C) + gi * 16 * 128 + fr * 128 + fq * 8;
    h16x8 cf[4];
#pragma unroll
    for (int ks = 0; ks < 4; ++ks) cf[ks] = *reinterpret_cast<const h16x8*>(Ct + ks * 32);
#pragma unroll
    for (int half = 0; half < 2; ++half) {
#pragma unroll 4
      for (int s = 0; s < 32; ++s) {
        const int step = half * 32 + s; const int tau = dir ? 63 - step : step;
        const float4* up = reinterpret_cast<const float4*>(us + tau * 16);
        float br = 0.f, bi = 0.f;
#pragma unroll
        for (int q = 0; q < 4; ++q) { const float4 u = up[q];
          br += bre[q * 4] * u.x + bre[q * 4 + 1] * u.y + bre[q * 4 + 2] * u.z + bre[q * 4 + 3] * u.w;
          bi += bim[q * 4] * u.x + bim[q * 4 + 1] * u.y + bim[q * 4 + 2] * u.z + bim[q * 4 + 3] * u.w; }
        const float nr = a.x * hr - a.y * hi + br, ni = a.x * hi + a.y * hr + bi; hr = nr; hi = ni;
        h16* hrow = reinterpret_cast<h16*>(Hs + (tau & 31) * 272);
        hrow[lane] = (h16)hr; hrow[64 + lane] = (h16)hi;
      }
      __syncthreads();
      const int tb = dir ? 1 - half : half;
#pragma unroll
      for (int sb2 = 0; sb2 < 2; ++sb2)
#pragma unroll
        for (int ks = 0; ks < 4; ++ks) {
          const h16x8 bf = *reinterpret_cast<const h16x8*>(Hs + (sb2 * 16 + fr) * 272 + (ks * 32 + fq * 8) * 2);
          yacc[tb * 2 + sb2] = __builtin_amdgcn_mfma_f32_16x16x32_f16(cf[ks], bf, yacc[tb * 2 + sb2], 0, 0, 0);
        }
      __syncthreads();
    }
  }
  const float* dsk = P.in[I_S5D] + layer * 384 + g * 16 + fq * 4;
  h16* Y = reinterpret_cast<h16*>(P.ws + OFF_YS5PRE);
#pragma unroll
  for (int sbi = 0; sbi < 4; ++sbi) {
    const int tl = sbi * 16 + fr; h16x4 o;
#pragma unroll
    for (int j = 0; j < 4; ++j) o[j] = (h16)geluf_(yacc[sbi][j] + dsk[j] * us[tl * 16 + fq * 4 + j]);
    *reinterpret_cast<h16x4*>(Y + (long)(tokbase + tl) * 384 + g * 16 + fq * 4) = o;
  }
  __syncthreads();
}
DI void phase_mix2(const Params& P, int layer, char* smem) {
  if ((gridDim.x & 7) == 0) {
    const int xcd = blockIdx.x & 7, li = blockIdx.x >> 3, nloc = gridDim.x >> 3;
    for (int k = li; k < 512; k += nloc) item_attn(P, xcd + 8 * (k >> 6), (k & 63) * 128, 0, KEYS / 64, smem);
  } else {
    for (int k = blockIdx.x; k < 4096; k += gridDim.x) item_attn(P, k >> 6, (k & 63) * 128, 0, KEYS / 64, smem);
  }
  const int n_actx = layer == 0 ? 128 : 0;
  const int nck = layer == 0 ? 132 : 128;
  const int n_s5 = NBATCH * 24 * nck / 4;
  for (int it = blockIdx.x; it < n_actx + n_s5; it += gridDim.x) {
    if (it < n_actx) { item_attn(P, it >> 1, SEQ + (it & 1) * 128, SEQ, CTXL / 64, smem); continue; }
    const int w = (it - n_actx) * 4 + (tidx() >> 6);
    const int ck = w % nck + (layer == 0 ? 0 : 4); const int r = w / nck;
    item_s5_pass3(P, layer, r / 24, r % 24, ck, smem);
  }
}
DI void phase_glu(const Params& P, int layer, char* smem) {
  const int tid = tidx(), lane = tid & 63, wid = tid >> 6, wr = wid >> 1, wc = wid & 1, fr = lane & 15, fq = lane >> 4;
  const h16* A = reinterpret_cast<const h16*>(P.ws + OFF_YS5PRE);
  const h16* W = reinterpret_cast<const h16*>(P.ws + OFF_WT) + (long)layer * WT_LAYER + WT_GLU;
  h16* Y = reinterpret_cast<h16*>(P.ws + OFF_YS5);
  const int MT = (layer == 0 ? TT : TLAT) / 128;
  const TileWalk tw = tw_init(MT, 6);
  for (int tile = tw.lb; tile < tw_count(tw); tile += tw.nlb) {
    int mt, nt; tw_decode(tw, tile, mt, nt);
    f32x4 acc[4][4]; acc_zero(acc);
    gemm_kloop(acc, A + (long)mt * 128 * 384, 384, 0, 128, W + (long)nt * 128 * 384, 384, 384, smem, opaque_tid());
#pragma unroll
    for (int m = 0; m < 4; ++m)
#pragma unroll
      for (int np = 0; np < 2; ++np)
#pragma unroll
        for (int j = 0; j < 4; ++j) {
          const int row = mt * 128 + wr * 64 + m * 16 + fq * 4 + j, col = nt * 64 + wc * 32 + np * 16 + fr;
          Y[(long)row * 384 + col] = (h16)(acc[m][2 * np][j] * sigmoidf_(acc[m][2 * np + 1][j]));
        }
  }
}
DI void phase_merge(const Params& P, int layer, char* smem) {
  const h16* H = reinterpret_cast<const h16*>(P.ws + OFF_H1);
  const h16* WL = reinterpret_cast<const h16*>(P.ws + OFF_WT) + (long)layer * WT_LAYER;
  h16* Mg = reinterpret_cast<h16*>(P.ws + OFF_MERGED);
  const int MT = (layer == 0 ? TT : TLAT) / 128;
  const TileWalk tw = tw_init(MT, 8);
  for (int tile = tw.lb; tile < tw_count(tw); tile += tw.nlb) {
    int mt, nt; tw_decode(tw, tile, mt, nt);
    h16* Tmp = reinterpret_cast<h16*>(P.ws + OFF_YS5PRE) + (long)blockIdx.x * 16384;
#pragma unroll 1
    for (int br = 0; br < 3; ++br) {
      const h16* Ab; const h16* Wb; int Kb;
      if (br == 0) { Ab = reinterpret_cast<const h16*>(P.ws + OFF_YHY) + (long)mt * 128 * 384; Wb = WL + WT_BRHY + (long)nt * 128 * 384; Kb = 384; }
      else if (br == 1) { Ab = reinterpret_cast<const h16*>(P.ws + OFF_YS5) + (long)mt * 128 * 384; Wb = WL + WT_BRS5 + (long)nt * 128 * 384; Kb = 384; }
      else { Ab = reinterpret_cast<const h16*>(P.ws + OFF_YMLA) + (long)mt * 128 * 512; Wb = WL + WT_BRMLA + (long)nt * 128 * 512; Kb = 512; }
      {
        f32x4 acc[4][4]; acc_zero(acc);
        gemm_kloop(acc, Ab, Kb, 0, 128, Wb, Kb, Kb, smem, opaque_tid());
        const int tid = tidx();
#pragma unroll
        for (int m = 0; m < 4; ++m)
#pragma unroll
          for (int n = 0; n < 4; ++n) {
            h16x4 o; o[0] = (h16)acc[m][n][0]; o[1] = (h16)acc[m][n][1]; o[2] = (h16)acc[m][n][2]; o[3] = (h16)acc[m][n][3];
            *reinterpret_cast<h16x4*>(Tmp + ((m * 4 + n) * 256 + tid) * 4) = o;
          }
      }
      f32x4 acc[4][4]; acc_zero(acc);
      gemm_kloop(acc, H + (long)mt * 128 * LD1, LD1, 0, 128, WL + WT_WGATE + (long)(br * 1024 + nt * 128) * LD1, LD1, 1024, smem, opaque_tid());
      const int tid = tidx(), lane = tid & 63, wid = tid >> 6, wr = wid >> 1, wc = wid & 1, fr = lane & 15, fq = lane >> 4;
#pragma unroll
      for (int m = 0; m < 4; ++m)
#pragma unroll
        for (int n = 0; n < 4; ++n) {
          const h16x4 bv = *reinterpret_cast<const h16x4*>(Tmp + ((m * 4 + n) * 256 + tid) * 4);
#pragma unroll
          for (int j = 0; j < 4; ++j) {
            h16* dst = Mg + (long)(mt * 128 + wr * 64 + m * 16 + fq * 4 + j) * LD1 + nt * 128 + wc * 64 + n * 16 + fr;
            const float prev = br == 0 ? 0.f : (float)*dst;
            *dst = (h16)(prev + sigmoidf_(acc[m][n][j]) * (float)bv[j]);
          }
          __builtin_amdgcn_sched_barrier(0);
        }
    }
  }
}
DI void phase_resid(const Params& P, int layer, int stage_src, size_t a_off, int K, long w_off, int gate_idx, char* smem) {
  const int tid = tidx(), lane = tid & 63, wid = tid >> 6, wr = wid >> 1, wc = wid & 1, fr = lane & 15, fq = lane >> 4;
  const h16* A = reinterpret_cast<const h16*>(P.ws + a_off);
  const h16* W = reinterpret_cast<const h16*>(P.ws + OFF_WT) + (long)layer * WT_LAYER + w_off;
  const float* mod = reinterpret_cast<const float*>(P.ws + OFF_MOD) + (long)layer * 9 * 6144 + gate_idx * 1024;
  const int MT = (layer == 0 ? TT : TLAT) / 128;
  const TileWalk tw = tw_init(MT, 8);
  for (int tile = tw.lb; tile < tw_count(tw); tile += tw.nlb) {
    int mt, nt; tw_decode(tw, tile, mt, nt);
    f32x4 acc[4][4]; acc_zero(acc);
    const int ld = K == 1024 ? LD1 : LD2;
    gemm_kloop(acc, A + (long)mt * 128 * ld, ld, 0, 128, W + (long)nt * 128 * ld, ld, K, smem, opaque_tid());
    const Tok tk = tokinfo(mt * 128);
    float* Zs = reinterpret_cast<float*>(smem);
    const int t2 = tidx();
    stage_acc(acc, Zs, t2);
    const int c4 = (t2 & 31) * 4;
    const float4 g4 = *reinterpret_cast<const float4*>(mod + tk.mrow * 6144 + nt * 128 + c4);
#pragma unroll 4
    for (int it = 0; it < 16; ++it) {
      const int row = it * 8 + (t2 >> 5); const int t = mt * 128 + row;
      const float4 a4 = *reinterpret_cast<const float4*>(Zs + row * 132 + c4);
      const float4 x4 = *reinterpret_cast<const float4*>(xrow_src(P, stage_src, t) + nt * 128 + c4);
      *reinterpret_cast<float4*>(xrow_dst(P, t) + nt * 128 + c4) = make_float4(x4.x + g4.x * a4.x, x4.y + g4.y * a4.y, x4.z + g4.z * a4.z, x4.w + g4.w * a4.w);
    }
    __syncthreads();
  }
}
DI void phase_ffn_up(const Params& P, int layer, char* smem) {
  const int tid = tidx(), lane = tid & 63, wid = tid >> 6, wr = wid >> 1, wc = wid & 1, fr = lane & 15, fq = lane >> 4;
  const h16* H = reinterpret_cast<const h16*>(P.ws + OFF_H2);
  const h16* W = reinterpret_cast<const h16*>(P.ws + OFF_WT) + (long)layer * WT_LAYER + WT_UP;
  h16* F = reinterpret_cast<h16*>(P.ws + OFF_F);
  const float* cw = P.in[I_FCW] + (long)layer * 3 * 5632; const float* cb = P.in[I_FCB] + (long)layer * 5632;
  float* Zs = reinterpret_cast<float*>(smem);
  const int n_mt = 8 * 66 + (layer == 0 ? 8 * 3 : 0);
  const TileWalk tw = tw_init(n_mt, 44);
  for (int tile = tw.lb; tile < tw_count(tw); tile += tw.nlb) {
    int mi, nt; tw_decode(tw, tile, mi, nt);
    int seq0, Ls, ti;
    if (mi < 528) { seq0 = (mi / 66) * SEQ; Ls = SEQ; ti = mi % 66; } else { const int u = mi - 528; seq0 = TLAT + (u / 3) * CTXL; Ls = CTXL; ti = u % 3; }
    const int p0 = ti * 126 - 1;
    const int a_lo = ti == 0 ? 1 : 0, a_hi = min(128, Ls - p0);
    const int nout = min(126, Ls - ti * 126);
    f32x4 acc[4][4]; acc_zero(acc);
    gemm_kloop(acc, H + ((long)seq0 + p0) * LD1, LD1, a_lo, a_hi, W + (long)nt * 128 * LD1, LD1, 1024, smem, opaque_tid());
#pragma unroll
    for (int m = 0; m < 4; ++m)
#pragma unroll
      for (int n = 0; n < 4; ++n)
#pragma unroll
        for (int j = 0; j < 4; ++j) Zs[(wr * 64 + m * 16 + fq * 4 + j) * 132 + wc * 64 + n * 16 + fr] = acc[m][n][j];
    __syncthreads();
    {
      const int jc = tid & 63, rg = tid >> 6;
      const int ucol = (jc >> 5) * 64 + ((jc >> 4) & 1) * 32 + (jc & 15), gcol = ucol + 16;
      const int cu = nt * 64 + jc, cg = 2816 + cu;
      const float wu0 = cw[cu], wu1 = cw[5632 + cu], wu2 = cw[2 * 5632 + cu], bu = cb[cu];
      const float wg0 = cw[cg], wg1 = cw[5632 + cg], wg2 = cw[2 * 5632 + cg], bg = cb[cg];
      for (int r = 1 + rg; r <= nout; r += 4) {
        const float au = wu0 * Zs[(r - 1) * 132 + ucol] + wu1 * Zs[r * 132 + ucol] + wu2 * Zs[(r + 1) * 132 + ucol] + bu;
        const float ag = wg0 * Zs[(r - 1) * 132 + gcol] + wg1 * Zs[r * 132 + gcol] + wg2 * Zs[(r + 1) * 132 + gcol] + bg;
        F[((long)seq0 + p0 + r) * LD2 + cu] = (h16)(siluf_(au) * ag);
      }
    }
    __syncthreads();
  }
}
DI void phase_norm2(const Params& P, int layer) { normmod_rows(P, layer, 1, 1, layer == 0 ? TT : TLAT, blockIdx.x, gridDim.x); }

constexpr int N_PHASES = 22;
#ifndef PROBE_REPEAT
#define PROBE_REPEAT 0u
#endif
template <int PH> DI void run_phase_t(const Params& P, char* smem) {
  asm volatile("" ::: "memory");
  if constexpr (PH == 0) phase_prologue(P, smem);
  else if constexpr (PH == 21) phase_final(P);
  else {
    constexpr int layer = (PH - 1) / 10, s = (PH - 1) % 10;
    if constexpr (s == 0) phase_norm1(P, layer, smem);
    else if constexpr (s == 1) phase_gemm_in(P, layer, smem);
    else if constexpr (s == 2) phase_mix1(P, layer, smem);
    else if constexpr (s == 3) phase_mix2(P, layer, smem);
    else if constexpr (s == 4) phase_glu(P, layer, smem);
    else if constexpr (s == 5) phase_merge(P, layer, smem);
    else if constexpr (s == 6) phase_resid(P, layer, layer, OFF_MERGED, 1024, WT_WO, 2, smem);
    else if constexpr (s == 7) phase_norm2(P, layer);
    else if constexpr (s == 8) phase_ffn_up(P, layer, smem);
    else phase_resid(P, layer, 1, OFF_F, 2816, WT_DOWN, 5, smem);
  }
}
DI void run_phase(const Params& P, int ph, char* smem) {
  switch (ph) {
#define RP(i) case i: run_phase_t<i>(P, smem); break;
    RP(0) RP(1) RP(2) RP(3) RP(4) RP(5) RP(6) RP(7) RP(8) RP(9) RP(10) RP(11) RP(12) RP(13) RP(14) RP(15) RP(16) RP(17) RP(18) RP(19) RP(20) RP(21)
#undef RP
    default: break;
  }
}
#ifndef MULTI_LAUNCH
#define MULTI_LAUNCH 0
#endif
#define XB_TMO      128
#define XB_XCNT(j)  (256  + 64 * (j))
#define XB_XSUB(j)  (1280 + 64 * (j))
#define XB_XGEN(j)  (2304 + 64 * (j))
#define XB_TOP      3328
#define XB_TOPGEN   3392
#define XCD_BAR_WORDS 3456
#define XB_SPIN_CAP (1u << 22)
#define LAS __attribute__((address_space(3)))
DI unsigned xb_ld(unsigned* p)              { return __hip_atomic_load(p, __ATOMIC_RELAXED, __HIP_MEMORY_SCOPE_AGENT); }
DI unsigned xb_add(unsigned* p, unsigned v) { return __hip_atomic_fetch_add(p, v, __ATOMIC_RELAXED, __HIP_MEMORY_SCOPE_AGENT); }
DI unsigned xb_xcc_id() { return (unsigned)__builtin_amdgcn_s_getreg((3 << 11) | 20) & 0xFu; }
#define XB_SPIN(cond, bar) do { unsigned _sp = 0; while (cond) { __builtin_amdgcn_s_sleep(1); \
    if ((++_sp & 255u) == 0u) { if (xb_ld(&(bar)[XB_TMO])) break; if (_sp > XB_SPIN_CAP) { atomicAdd(&(bar)[XB_TMO], 1u); break; } } } } while (0)
struct XcdBarrier { unsigned* bar; unsigned x; volatile LAS unsigned* st; };
DI XcdBarrier xcd_barrier_post(unsigned* bar, volatile LAS unsigned* st) {
  XcdBarrier b; b.bar = bar; b.x = xb_xcc_id(); b.st = st;
  if (threadIdx.x == 0) (void)xb_add(&bar[XB_XCNT(b.x)], 1u);
  return b;
}
DI void xcd_barrier_complete(unsigned* bar, unsigned x, unsigned& nloc, unsigned& nx) {
  const unsigned G = gridDim.x * gridDim.y * gridDim.z;
  unsigned sum, cnt, mine, sp = 0u;
  for (;;) {
    sum = 0u; cnt = 0u; mine = 0u;
#pragma unroll
    for (unsigned j = 0; j < 16; ++j) { const unsigned c = xb_ld(&bar[XB_XCNT(j)]); sum += c; cnt += (c > 0u) ? 1u : 0u; mine = (j == x) ? c : mine; }
    if (sum == G) break;
    __builtin_amdgcn_s_sleep(1);
    if ((++sp & 255u) == 0u) { if (xb_ld(&bar[XB_TMO])) break; if (sp > XB_SPIN_CAP) { atomicAdd(&bar[XB_TMO], 1u); break; } }
  }
  nloc = mine > 0u ? mine : 1u; nx = cnt > 0u ? cnt : 1u;
}
DI void xcd_barrier(const XcdBarrier& b) {
  asm volatile("s_waitcnt vmcnt(0)" ::: "memory");
  __syncthreads();
  if (threadIdx.x == 0) {
    unsigned* bar = b.bar;
    __builtin_amdgcn_s_waitcnt(0);
    unsigned nloc = b.st[0], nx = b.st[1];
    if (nloc == 0u) { xcd_barrier_complete(bar, b.x, nloc, nx); b.st[0] = nloc; b.st[1] = nx; }
    const unsigned old = xb_add(&bar[XB_XSUB(b.x)], 1u);
    const unsigned gen = old / nloc;
    if (old + 1u == (gen + 1u) * nloc) {
      __builtin_amdgcn_fence(__ATOMIC_RELEASE, "agent");
      asm volatile("s_waitcnt vmcnt(0)" ::: "memory");
      const unsigned og = xb_add(&bar[XB_TOP], 1u);
      const unsigned tg = og / nx;
      if (og + 1u == (tg + 1u) * nx) xb_add(&bar[XB_TOPGEN], 1u);
      else XB_SPIN(xb_ld(&bar[XB_TOPGEN]) == tg, bar);
      __builtin_amdgcn_fence(__ATOMIC_ACQUIRE, "agent");
      xb_add(&bar[XB_XGEN(b.x)], 1u);
      asm volatile("s_waitcnt vmcnt(0)" ::: "memory");
    } else {
      XB_SPIN(xb_ld(&bar[XB_XGEN(b.x)]) == gen, bar);
      __builtin_amdgcn_fence(__ATOMIC_ACQUIRE, "agent");
      asm volatile("s_waitcnt vmcnt(0)" ::: "memory");
    }
  }
  __syncthreads();
}
__global__ void __launch_bounds__(NTHREADS, 2) fwd_megakernel(Params P) {
  extern __shared__ __attribute__((aligned(16))) char smem[];
  cg::grid_group grid = cg::this_grid();
  volatile LAS unsigned* st = (volatile LAS unsigned*)(smem + SMEM_BYTES - 16);
  if (threadIdx.x == 0) { st[0] = 0u; st[1] = 0u; st[2] = 0u; st[3] = 0u; }
  __syncthreads();
  const XcdBarrier xb = xcd_barrier_post(reinterpret_cast<unsigned*>(P.ws + OFF_BAR), st);
  run_phase_t<0>(P, smem); grid.sync();
#define RP(i) run_phase_t<i>(P, smem); xcd_barrier(xb); if constexpr ((PROBE_REPEAT >> i) & 1) { run_phase_t<i>(P, smem); xcd_barrier(xb); }
  RP(1) RP(2) RP(3) RP(4) RP(5) RP(6) RP(7) RP(8) RP(9) RP(10) RP(11) RP(12) RP(13) RP(14) RP(15) RP(16) RP(17) RP(18) RP(19) RP(20)
#undef RP
#ifdef PROBE_SYNC
  for (int i = 0; i < PROBE_SYNC; ++i) xcd_barrier(xb);
#endif
  run_phase_t<21>(P, smem);
}
#if MULTI_LAUNCH
__global__ void __launch_bounds__(NTHREADS, 2) fwd_phase_kernel(Params P, int ph) {
  extern __shared__ __attribute__((aligned(16))) char smem[];
  run_phase(P, ph, smem);
}
#endif

extern "C" void kernel_launch(void* const* d_in, const int* in_sizes, int n_in, void* d_out, int out_size, void* d_ws, size_t ws_size,
                              hipStream_t stream) {
  static int grid_blocks = 0;
  if (!grid_blocks) {
    int dev = 0, cus = 0, per_cu = 0;
    (void)hipGetDevice(&dev);
    (void)hipDeviceGetAttribute(&cus, hipDeviceAttributeMultiprocessorCount, dev);
    (void)hipFuncSetAttribute((const void*)fwd_megakernel, hipFuncAttributeMaxDynamicSharedMemorySize, SMEM_BYTES);
#if MULTI_LAUNCH
    (void)hipFuncSetAttribute((const void*)fwd_phase_kernel, hipFuncAttributeMaxDynamicSharedMemorySize, SMEM_BYTES);
#endif
    (void)hipOccupancyMaxActiveBlocksPerMultiprocessor(&per_cu, fwd_megakernel, NTHREADS, SMEM_BYTES);
    if (per_cu > 2) per_cu = 2;
    if (per_cu < 1) per_cu = 1;
#ifdef PROBE_FORCE2
    per_cu = 2;
#endif
    grid_blocks = cus * per_cu;
    if (ws_size < OFF_END) fprintf(stderr, "workspace too small: %zu < %zu\n", ws_size, (size_t)OFF_END);
  }
  Params p{};
  for (int i = 0; i < 41; ++i) p.in[i] = (const float*)d_in[i];
  p.out = (float*)d_out; p.ws = (char*)d_ws; p.pad_ = 0;
#if MULTI_LAUNCH
  for (int ph = 0; ph < N_PHASES; ++ph) hipLaunchKernelGGL(fwd_phase_kernel, dim3(grid_blocks), dim3(NTHREADS), SMEM_BYTES, stream, p, ph);
#else
  (void)hipMemsetAsync((char*)d_ws + OFF_BAR, 0, XCD_BAR_WORDS * 4, stream);
  void* args[] = {&p};
  hipError_t e = hipLaunchCooperativeKernel((void*)fwd_megakernel, dim3(grid_blocks), dim3(NTHREADS), args, SMEM_BYTES, stream);
  if (e != hipSuccess) fprintf(stderr, "cooperative launch failed: %s (grid %d)\n", hipGetErrorString(e), grid_blocks);
#endif
}
```

```cpp
#include <hip/hip_runtime.h>
#include <hip/hip_cooperative_groups.h>
#include <cstdio>
namespace cg = cooperative_groups;

typedef _Float16 h16;
typedef _Float16 h16x8 __attribute__((ext_vector_type(8)));
typedef _Float16 h16x4 __attribute__((ext_vector_type(4)));
typedef float f32x4 __attribute__((ext_vector_type(4)));
typedef float f32x16 __attribute__((ext_vector_type(16)));
#define DI __device__ __forceinline__

constexpr int DM = 1024, NBATCH = 8, SEQ = 8192, CTXL = 256, TLAT = 65536, TCTX = 2048, TT = 67584;
constexpr int KEYS = SEQ + CTXL;
constexpr int NTHREADS = 256;
constexpr float EPS = 1e-6f;
constexpr float QSCALE = 0.10206207261596575f * 1.4426950408889634f;

constexpr int LD1 = 1088, LD2 = 2880;
constexpr long WT_WIN = 0, WT_WGATE = WT_WIN + 2432L * LD1, WT_UKV = WT_WGATE + 3072L * LD1, WT_UQ = WT_UKV + 1024L * 256,
               WT_GLU = WT_UQ + 1024L * 512, WT_BRHY = WT_GLU + 768L * 384, WT_BRS5 = WT_BRHY + 1024L * 384,
               WT_BRMLA = WT_BRS5 + 1024L * 384, WT_WO = WT_BRMLA + 1024L * 512, WT_UP = WT_WO + 1024L * LD1,
               WT_DOWN = WT_UP + 5632L * LD1, WT_LAYER = WT_DOWN + 1024L * LD2;
constexpr size_t al256(size_t x) { return (x + 255) / 256 * 256; }
constexpr size_t OFF_WT = 0;
constexpr size_t OFF_H1 = al256(OFF_WT + 2 * WT_LAYER * 2);
constexpr size_t OFF_U = al256(OFF_H1 + (size_t)TT * LD1 * 2);
constexpr size_t OFF_KVLAT = al256(OFF_U + (size_t)TT * 384 * 2);
constexpr size_t OFF_QLAT = al256(OFF_KVLAT + (size_t)TT * 256 * 2);
constexpr size_t OFF_PHY = al256(OFF_QLAT + (size_t)TT * 512 * 2);
constexpr size_t OFF_PHYC = al256(OFF_PHY + (size_t)NBATCH * 1152 * SEQ * 2);
constexpr size_t OFF_Q = al256(OFF_PHYC + (size_t)NBATCH * 1152 * CTXL * 2);
constexpr size_t OFF_K = al256(OFF_Q + (size_t)64 * KEYS * 96 * 2);
constexpr size_t OFF_VT = al256(OFF_K + (size_t)64 * KEYS * 96 * 2);
constexpr size_t OFF_YS5PRE = al256(OFF_VT + (size_t)64 * 64 * KEYS * 2);
constexpr size_t OFF_YHY = al256(OFF_YS5PRE + (size_t)TT * 384 * 2);
constexpr size_t OFF_FILT = al256(OFF_YHY + (size_t)TT * 384 * 2);
constexpr size_t OFF_TAPSC = al256(OFF_FILT + (size_t)768 * 2 * SEQ * 8);
constexpr size_t OFF_E = al256(OFF_TAPSC + (size_t)768 * 2 * CTXL * 4);
constexpr size_t OFF_XC = al256(OFF_E + (size_t)NBATCH * 2 * 24 * 132 * 64 * 8);
constexpr size_t OFF_MOD = al256(OFF_XC + (size_t)TCTX * 1024 * 4);
constexpr size_t OFF_Z2 = al256(OFF_MOD + (size_t)2 * 9 * 6144 * 4);
constexpr size_t OFF_Z2C = al256(OFF_Z2 + (size_t)2 * SEQ * 64 * 4);
constexpr size_t OFF_S5A = al256(OFF_Z2C + (size_t)2 * CTXL * 64 * 4);
constexpr size_t OFF_S5A64 = al256(OFF_S5A + (size_t)2 * 2 * 24 * 64 * 8);
constexpr size_t OFF_S5B = al256(OFF_S5A64 + (size_t)2 * 2 * 24 * 64 * 8);
constexpr size_t OFF_S5C = al256(OFF_S5B + (size_t)2 * 2 * 24 * 64 * 16 * 8);
constexpr size_t OFF_ROPE = al256(OFF_S5C + (size_t)2 * 2 * 24 * 16 * 128 * 2);
constexpr size_t OFF_BAR = al256(OFF_ROPE + (size_t)SEQ * 16 * 8);
constexpr size_t OFF_END = al256(OFF_BAR + (size_t)3456 * 4);
constexpr size_t OFF_YS5 = OFF_U, OFF_YMLA = OFF_QLAT, OFF_MERGED = OFF_Q, OFF_F = OFF_U, OFF_H2 = OFF_H1;
static_assert(OFF_END <= (size_t)1024 * 1024 * 1024, "workspace over 1 GiB");
static_assert(OFF_F + (size_t)TT * LD2 * 2 <= OFF_FILT, "f alias overruns");
static_assert(OFF_MERGED + (size_t)TT * LD1 * 2 <= OFF_VT, "merged alias overruns");

constexpr int SMEM_BYTES = 73728 + 2048;

struct Params {
  const float* in[41];
  float* out;
  char* ws;
  unsigned long long pad_;
};
enum { I_X = 0, I_C, I_CTX, I_CCTX, I_WMOD, I_BMOD, I_N1G, I_N2G, I_WIN, I_HCW, I_HCB, I_FW1, I_FB1, I_FW2, I_FB2, I_FW3, I_FFREQ,
       I_FDECAY, I_HBIAS, I_LAMRE, I_LAMIM, I_LOGSTEP, I_BRE, I_BIM, I_CRE, I_CIM, I_S5D, I_WGLU, I_GQ, I_WUQ, I_GKV, I_WUKV,
       I_WBRHY, I_WBRS5, I_WBRMLA, I_WO, I_WUP, I_FCW, I_FCB, I_WDOWN, I_FINALG };

DI int tidx() { int t = threadIdx.x; asm volatile("" : "+v"(t)); return t; }
DI int opaque_tid() { return tidx(); }
DI float sigmoidf_(float x) { return 1.f / (1.f + __expf(-x)); }
DI float siluf_(float x) { return x / (1.f + __expf(-x)); }
DI float geluf_(float x) { float z = 0.7978845608028654f * (x + 0.044715f * x * x * x); float t = 1.f - 2.f / (1.f + __expf(2.f * z)); return 0.5f * x * (1.f + t); }
DI float wave_sum(float v) { for (int o = 32; o > 0; o >>= 1) v += __shfl_xor(v, o); return v; }
DI float wave_max(float v) { for (int o = 32; o > 0; o >>= 1) v = fmaxf(v, __shfl_xor(v, o)); return v; }
DI void dsincos(double x, double& s, double& c) {
  const double TWO_PI = 6.283185307179586476925287;
  double r = x - TWO_PI * rint(x / TWO_PI);
  double r2 = r * r, ts = r, tc = 1.0; s = r; c = 1.0;
  for (int k = 1; k <= 15; ++k) { tc = -tc * r2 / (double)((2 * k - 1) * (2 * k)); c += tc; ts = -ts * r2 / (double)((2 * k) * (2 * k + 1)); s += ts; }
}
DI float2 twid(float f) { return make_float2(__builtin_amdgcn_cosf(f), __builtin_amdgcn_sinf(f)); }
DI float2 cmul(float2 a, float2 b) { return make_float2(a.x * b.x - a.y * b.y, a.x * b.y + a.y * b.x); }

struct Tok { int b, pos, ctx, mrow; };
DI Tok tokinfo(int t) { Tok k; if (t < TLAT) { k.b = t >> 13; k.pos = t & 8191; k.ctx = 0; k.mrow = k.b; } else { int u = t - TLAT; k.b = u >> 8; k.pos = u & 255; k.ctx = 1; k.mrow = 8; } return k; }

struct Stg { uint4 a0, a1, a2, a3, b0, b1, b2, b3; };
DI void g_load(Stg& s, const h16* __restrict__ A0, const h16* __restrict__ A1, const h16* __restrict__ A2, const h16* __restrict__ A3,
               const h16* __restrict__ Bp, long b32, int k0) {
  s.a0 = *reinterpret_cast<const uint4*>(A0 + k0); s.a1 = *reinterpret_cast<const uint4*>(A1 + k0);
  s.a2 = *reinterpret_cast<const uint4*>(A2 + k0); s.a3 = *reinterpret_cast<const uint4*>(A3 + k0);
  s.b0 = *reinterpret_cast<const uint4*>(Bp + k0); s.b1 = *reinterpret_cast<const uint4*>(Bp + b32 + k0);
  s.b2 = *reinterpret_cast<const uint4*>(Bp + 2 * b32 + k0); s.b3 = *reinterpret_cast<const uint4*>(Bp + 3 * b32 + k0);
}
DI uint4 zsel(uint4 v, bool ok) { return ok ? v : make_uint4(0, 0, 0, 0); }
DI void s_write(char* sw, const Stg& s, int okm) {
  *reinterpret_cast<uint4*>(sw) = zsel(s.a0, okm & 1); *reinterpret_cast<uint4*>(sw + 32 * 128) = zsel(s.a1, okm & 2);
  *reinterpret_cast<uint4*>(sw + 64 * 128) = zsel(s.a2, okm & 4); *reinterpret_cast<uint4*>(sw + 96 * 128) = zsel(s.a3, okm & 8);
  *reinterpret_cast<uint4*>(sw + 16384) = s.b0; *reinterpret_cast<uint4*>(sw + 16384 + 32 * 128) = s.b1; *reinterpret_cast<uint4*>(sw + 16384 + 64 * 128) = s.b2; *reinterpret_cast<uint4*>(sw + 16384 + 96 * 128) = s.b3;
}
#ifndef PROBE_MFMA
#define PROBE_MFMA 0
#endif
#if PROBE_MFMA
DI void mma_step(f32x4 (&acc)[4][4], const char* sa, const char* sb, int o0, int o1, f32x4 (&dmy)[2][4]) {
#else
DI void mma_step(f32x4 (&acc)[4][4], const char* sa, const char* sb, int o0, int o1) {
#endif
#pragma unroll
  for (int ks = 0; ks < 2; ++ks) {
    h16x8 af[4], bf[4];
    const int o = ks ? o1 : o0;
#pragma unroll
    for (int m = 0; m < 4; ++m) af[m] = *reinterpret_cast<const h16x8*>(sa + m * 16 * 128 + o);
#pragma unroll
    for (int n = 0; n < 4; ++n) bf[n] = *reinterpret_cast<const h16x8*>(sb + n * 16 * 128 + o);
#pragma unroll
    for (int m = 0; m < 4; ++m)
#pragma unroll
      for (int n = 0; n < 4; ++n) acc[m][n] = __builtin_amdgcn_mfma_f32_16x16x32_f16(af[m], bf[n], acc[m][n], 0, 0, 0);
#if PROBE_MFMA
#pragma unroll
    for (int m = 0; m < 2; ++m)
#pragma unroll
      for (int n = 0; n < 4; ++n) dmy[m][n] = __builtin_amdgcn_mfma_f32_16x16x32_f16(af[m + 2], bf[n], dmy[m][n], 0, 0, 0);
#endif
  }
}
DI void gemm_kloop_body(f32x4 (&acc)[4][4], const h16* __restrict__ A, long lda, int a_lo, int a_hi,
                   const h16* __restrict__ Bt, long ldb, int K, char* smem, int tid) {
  const int lane = tid & 63, wid = tid >> 6, wr = wid >> 1, wc = wid & 1, fr = lane & 15, fq = lane >> 4;
#if PROBE_MFMA
  f32x4 dmy[2][4];
  for (int m = 0; m < 2; ++m) for (int n = 0; n < 4; ++n) dmy[m][n] = f32x4{0.f, 0.f, 0.f, 0.f};
#define MMA(a, b, c, d, e) mma_step(a, b, c, d, e, dmy)
#else
#define MMA(a, b, c, d, e) mma_step(a, b, c, d, e)
#endif
  Stg s0, s1;
  const int srow = tid >> 3, skc = tid & 7;
  int okm = 0;
  const h16* Ar[4];
#pragma unroll
  for (int i = 0; i < 4; ++i) { const int row = srow + 32 * i; const bool ok = row >= a_lo && row < a_hi; okm |= ok ? (1 << i) : 0;
    const int rc = min(max(row, a_lo), a_hi - 1); Ar[i] = A + (long)rc * lda + skc * 8; }
  const h16* Bp = Bt + (long)srow * ldb + skc * 8;
  const long b32 = 32 * ldb;
  char* sw = smem + srow * 128 + ((skc ^ ((srow >> 1) & 7)) << 4);
  const char* sra = smem + (wr * 64 + fr) * 128; const char* srb = smem + 16384 + (wc * 64 + fr) * 128;
  const int o0 = (fq ^ ((fr >> 1) & 7)) << 4, o1 = ((4 + fq) ^ ((fr >> 1) & 7)) << 4;
  const int nk = K >> 6;
  g_load(s0, Ar[0], Ar[1], Ar[2], Ar[3], Bp, b32, 0); g_load(s1, Ar[0], Ar[1], Ar[2], Ar[3], Bp, b32, 64);
  s_write(sw, s0, okm); __syncthreads();
  for (int kt = 0; kt + 2 < nk; kt += 2) {
    g_load(s0, Ar[0], Ar[1], Ar[2], Ar[3], Bp, b32, (kt + 2) << 6);
    __builtin_amdgcn_sched_barrier(0);
    MMA(acc, sra, srb, o0, o1);
    __builtin_amdgcn_sched_barrier(0);
    s_write(sw + 32768, s1, okm);
    __syncthreads();
    g_load(s1, Ar[0], Ar[1], Ar[2], Ar[3], Bp, b32, (kt + 3) << 6);
    __builtin_amdgcn_sched_barrier(0);
    MMA(acc, sra + 32768, srb + 32768, o0, o1);
    __builtin_amdgcn_sched_barrier(0);
    s_write(sw, s0, okm);
    __syncthreads();
  }
  MMA(acc, sra, srb, o0, o1);
  s_write(sw + 32768, s1, okm);
  __syncthreads();
  MMA(acc, sra + 32768, srb + 32768, o0, o1);
  __syncthreads();
#if PROBE_MFMA
  { float z = 0.f; asm volatile("" : "+v"(z)); for (int m = 0; m < 2; ++m) for (int n = 0; n < 4; ++n) acc[m][n] += dmy[m][n] * z; }
#endif
#undef MMA
}
#ifndef PROBE_KLOOP
#define PROBE_KLOOP 0
#endif
DI void gemm_kloop(f32x4 (&acc)[4][4], const h16* __restrict__ A, long lda, int a_lo, int a_hi,
                   const h16* __restrict__ Bt, long ldb, int K, char* smem, int tid) {
  gemm_kloop_body(acc, A, lda, a_lo, a_hi, Bt, ldb, K, smem, tid);
}
struct TileWalk { int lb, nlb, m0, Mx, NT, nfull; };
DI TileWalk tw_init(int MT, int NT) { TileWalk w; w.lb = blockIdx.x >> 3; w.nlb = gridDim.x >> 3; w.Mx = MT >> 3; w.m0 = (blockIdx.x & 7) * w.Mx; w.NT = NT; w.nfull = (w.Mx >> 3) * 8 * NT; return w; }
DI int tw_count(const TileWalk& w) { return w.Mx * w.NT; }
DI void tw_decode(const TileWalk& w, int idx, int& mt, int& nt) {
  if (idx < w.nfull) { const int mg = idx / (8 * w.NT), r = idx % (8 * w.NT); nt = r >> 3; mt = w.m0 + mg * 8 + (r & 7); }
  else { const int rem = w.Mx & 7, r = idx - w.nfull; nt = r / rem; mt = w.m0 + (w.Mx & ~7) + r % rem; }
}
DI void stage_acc(const f32x4 (&acc)[4][4], float* Zs, int tid) {
  const int lane = tid & 63, wid = tid >> 6, wr = wid >> 1, wc = wid & 1, fr = lane & 15, fq = lane >> 4;
#pragma unroll
  for (int m = 0; m < 4; ++m)
#pragma unroll
    for (int n = 0; n < 4; ++n)
#pragma unroll
      for (int j = 0; j < 4; ++j) Zs[(wr * 64 + m * 16 + fq * 4 + j) * 132 + wc * 64 + n * 16 + fr] = acc[m][n][j];
  __syncthreads();
}
DI void stage_acc_t(const f32x4 (&acc)[4][4], float* Zs, int tid) {
  const int lane = tid & 63, wid = tid >> 6, wr = wid >> 1, wc = wid & 1, fr = lane & 15, fq = lane >> 4;
#pragma unroll
  for (int m = 0; m < 4; ++m)
#pragma unroll
    for (int n = 0; n < 4; ++n)
      *reinterpret_cast<float4*>(Zs + (wc * 64 + n * 16 + fr) * 132 + wr * 64 + m * 16 + fq * 4) = make_float4(acc[m][n][0], acc[m][n][1], acc[m][n][2], acc[m][n][3]);
  __syncthreads();
}
DI void copy_out_f16(const float* Zs, h16* __restrict__ dst, long row0, long ld, int cb, int tid) {
#pragma unroll
  for (int it = 0; it < 8; ++it) {
    const int chunk = it * 256 + tid, row = chunk >> 4, c8 = (chunk & 15) * 8;
    const float4 x0 = *reinterpret_cast<const float4*>(Zs + row * 132 + c8), x1 = *reinterpret_cast<const float4*>(Zs + row * 132 + c8 + 4);
    h16x8 o; o[0] = (h16)x0.x; o[1] = (h16)x0.y; o[2] = (h16)x0.z; o[3] = (h16)x0.w; o[4] = (h16)x1.x; o[5] = (h16)x1.y; o[6] = (h16)x1.z; o[7] = (h16)x1.w;
    *reinterpret_cast<h16x8*>(dst + (row0 + row) * ld + cb + c8) = o;
  }
}
DI void acc_zero(f32x4 (&acc)[4][4]) {
#pragma unroll
  for (int m = 0; m < 4; ++m)
#pragma unroll
    for (int n = 0; n < 4; ++n) acc[m][n] = f32x4{0.f, 0.f, 0.f, 0.f};
}
DI void row_rms(const h16* __restrict__ A, long lda, int K, float* rs) {
  const int tid = tidx(), row = tid >> 1, half = tid & 1;
  const h16* p = A + (long)row * lda + half * (K >> 1);
  float ss = 0.f;
  for (int k = 0; k < (K >> 1); k += 8) {
    h16x8 v = *reinterpret_cast<const h16x8*>(p + k);
#pragma unroll
    for (int j = 0; j < 8; ++j) { float f = (float)v[j]; ss += f * f; }
  }
  ss += __shfl_xor(ss, 1);
  if (half == 0) rs[row] = rsqrtf(ss / (float)K + EPS);
}
DI int map_interleave(int n, int half) { int tile = n >> 7, r = n & 127, sub = r >> 4, fr = r & 15; int j = tile * 64 + (sub >> 1) * 16 + fr; return (sub & 1) ? half + j : j; }
DI int map_col(int mat, int n) {
  switch (mat) {
    case 0: if (n < 640) return n; if (n < 2304) return n + 32; if (n < 2336) return n - 2304 + 640; return -1;
    case 1: return 2336 + n;
    case 3: { int h = n >> 7, j = n & 127; return j < 96 ? h * 96 + j : -1; }
    case 4: return map_interleave(n, 384);
    case 9: return map_interleave(n, 2816);
    default: return n;
  }
}
struct MatDesc { const float* src; const float* scale; long dst; int K, Nmy, Nsrc, ld; };
DI MatDesc get_mat(const Params& P, int layer, int mat) {
  MatDesc d; d.scale = nullptr;
  d.ld = (mat == 0 || mat == 1 || mat == 8 || mat == 9) ? LD1 : 0;
  switch (mat) {
    case 0: d.src = P.in[I_WIN] + (long)layer * 1024 * 5408; d.dst = WT_WIN; d.K = 1024; d.Nmy = 2432; d.Nsrc = 5408; break;
    case 1: d.src = P.in[I_WIN] + (long)layer * 1024 * 5408; d.dst = WT_WGATE; d.K = 1024; d.Nmy = 3072; d.Nsrc = 5408; break;
    case 2: d.src = P.in[I_WUKV] + (long)layer * 256 * 1024; d.dst = WT_UKV; d.K = 256; d.Nmy = 1024; d.Nsrc = 1024; d.scale = P.in[I_GKV] + layer * 256; break;
    case 3: d.src = P.in[I_WUQ] + (long)layer * 512 * 768; d.dst = WT_UQ; d.K = 512; d.Nmy = 1024; d.Nsrc = 768; d.scale = P.in[I_GQ] + layer * 512; break;
    case 4: d.src = P.in[I_WGLU] + (long)layer * 384 * 768; d.dst = WT_GLU; d.K = 384; d.Nmy = 768; d.Nsrc = 768; break;
    case 5: d.src = P.in[I_WBRHY] + (long)layer * 384 * 1024; d.dst = WT_BRHY; d.K = 384; d.Nmy = 1024; d.Nsrc = 1024; break;
    case 6: d.src = P.in[I_WBRS5] + (long)layer * 384 * 1024; d.dst = WT_BRS5; d.K = 384; d.Nmy = 1024; d.Nsrc = 1024; break;
    case 7: d.src = P.in[I_WBRMLA] + (long)layer * 512 * 1024; d.dst = WT_BRMLA; d.K = 512; d.Nmy = 1024; d.Nsrc = 1024; break;
    case 8: d.src = P.in[I_WO] + (long)layer * 1024 * 1024; d.dst = WT_WO; d.K = 1024; d.Nmy = 1024; d.Nsrc = 1024; break;
    case 9: d.src = P.in[I_WUP] + (long)layer * 1024 * 5632; d.dst = WT_UP; d.K = 1024; d.Nmy = 5632; d.Nsrc = 5632; break;
    default: d.src = P.in[I_WDOWN] + (long)layer * 2816 * 1024; d.dst = WT_DOWN; d.K = 2816; d.Nmy = 1024; d.Nsrc = 1024; d.ld = LD2; break;
  }
  if (d.ld == 0) d.ld = d.K;
  return d;
}
constexpr int WT_TILES_PER_LAYER = 608 + 768 + 64 + 128 + 72 + 96 + 96 + 128 + 256 + 1408 + 704;
DI void item_wt(const Params& P, int item, char* smem) {
  const int layer = item / WT_TILES_PER_LAYER; int r = item % WT_TILES_PER_LAYER;
  const int cnt[11] = {608, 768, 64, 128, 72, 96, 96, 128, 256, 1408, 704};
  int mat = 0;
#pragma unroll
  for (int i = 0; i < 10; ++i) { if (mat == i && r >= cnt[i]) { r -= cnt[i]; mat = i + 1; } }
  MatDesc d = get_mat(P, layer, mat);
  const int kt = d.K >> 6, n0 = (r / kt) * 64, k0 = (r % kt) * 64;
  float* tile = reinterpret_cast<float*>(smem);
  h16* dst = reinterpret_cast<h16*>(P.ws + OFF_WT) + (long)layer * WT_LAYER + d.dst;
  const int tid = tidx(), lx = tid & 63, ly = tid >> 6;
  const int sc = map_col(mat, n0 + lx);
#pragma unroll 4
  for (int i = 0; i < 16; ++i) { int kk = i * 4 + ly; tile[kk * 65 + lx] = sc >= 0 ? d.src[(long)(k0 + kk) * d.Nsrc + sc] : 0.f; }
  __syncthreads();
  const float s = d.scale ? d.scale[k0 + lx] : 1.f;
#pragma unroll 4
  for (int i = 0; i < 16; ++i) { int nn = i * 4 + ly; dst[(long)(n0 + nn) * d.ld + k0 + lx] = (h16)(tile[lx * 65 + nn] * s); }
  __syncthreads();
}
DI void item_mod(const Params& P, int item, char* smem) {
  const int layer = item / 96, n0 = (item % 96) * 64;
  float* s = reinterpret_cast<float*>(smem);
  float* part = s + 9 * 1024;
  const int tid = tidx(), lane = tid & 63, wid = tid >> 6;
  for (int i = tid; i < 9 * 1024; i += NTHREADS) { float v = i < 8192 ? P.in[I_C][i] : P.in[I_CCTX][i - 8192]; s[i] = siluf_(v); }
  __syncthreads();
  const float* w = P.in[I_WMOD] + (long)layer * 1024 * 6144 + n0 + lane;
  float acc[9];
#pragma unroll
  for (int r = 0; r < 9; ++r) acc[r] = 0.f;
  for (int k = wid * 256; k < wid * 256 + 256; ++k) {
    const float wv = w[(long)k * 6144];
#pragma unroll
    for (int r = 0; r < 9; ++r) acc[r] += s[r * 1024 + k] * wv;
  }
#pragma unroll
  for (int r = 0; r < 9; ++r) part[(wid * 9 + r) * 64 + lane] = acc[r];
  __syncthreads();
  float* mod = reinterpret_cast<float*>(P.ws + OFF_MOD) + (long)layer * 9 * 6144;
  for (int i = tid; i < 9 * 64; i += NTHREADS) {
    const int r = i >> 6, c = i & 63;
    mod[r * 6144 + n0 + c] = part[(0 * 9 + r) * 64 + c] + part[(1 * 9 + r) * 64 + c] + part[(2 * 9 + r) * 64 + c] + part[(3 * 9 + r) * 64 + c] + P.in[I_BMOD][layer * 6144 + n0 + c];
  }
  __syncthreads();
}
DI void item_hymlp(const Params& P, int item, char* smem) {
  const int layer = item / 132; int r = item % 132;
  const int isc = r >= 128; const int Lf = isc ? CTXL : SEQ; const int t0 = (isc ? r - 128 : r) * 64;
  float* z1 = reinterpret_cast<float*>(smem);
  const int tid = tidx(), tl = tid >> 2, h0 = (tid & 3) * 16; const int t = t0 + tl;
  const float* w1 = P.in[I_FW1] + layer * 17 * 64; const float* b1 = P.in[I_FB1] + layer * 64;
  const float* w2 = P.in[I_FW2] + layer * 64 * 64; const float* b2 = P.in[I_FB2] + layer * 64; const float* fq = P.in[I_FFREQ] + layer * 64;
  float feat[17]; feat[0] = (float)t / (float)Lf;
#pragma unroll
  for (int k = 1; k <= 8; ++k) { float rev = (float)((t * k) % Lf) / (float)Lf; feat[k] = __builtin_amdgcn_cosf(rev); feat[8 + k] = __builtin_amdgcn_sinf(rev); }
#pragma unroll 4
  for (int j = 0; j < 16; ++j) {
    const int h = h0 + j; float a = b1[h];
#pragma unroll
    for (int f = 0; f < 17; ++f) a += feat[f] * w1[f * 64 + h];
    z1[tl * 65 + h] = __sinf(fq[h] * a);
  }
  __syncthreads();
  float* z2 = isc ? reinterpret_cast<float*>(P.ws + OFF_Z2C) + (long)layer * CTXL * 64 : reinterpret_cast<float*>(P.ws + OFF_Z2) + (long)layer * SEQ * 64;
  float a2[16];
#pragma unroll
  for (int j = 0; j < 16; ++j) a2[j] = b2[h0 + j];
  for (int k = 0; k < 64; ++k) {
    const float zv = z1[tl * 65 + k];
#pragma unroll
    for (int j = 0; j < 16; ++j) a2[j] += zv * w2[k * 64 + h0 + j];
  }
#pragma unroll
  for (int j = 0; j < 16; ++j) z2[(long)t * 64 + h0 + j] = __sinf(fq[h0 + j] * a2[j]);
  __syncthreads();
}
DI void item_s5disc(const Params& P, int item) {
  const int layer = item / 12, dir = (item % 12) / 6, gb = item % 6;
  const int tid = tidx(), g = gb * 4 + (tid >> 6), n = tid & 63;
  const int ld = layer * 2 + dir; const long gi = (long)ld * 24 + g;
  const double lre = P.in[I_LAMRE][gi * 64 + n], lim = P.in[I_LAMIM][gi * 64 + n];
  const double step = exp((double)P.in[I_LOGSTEP][gi]);
  double sn, cs; dsincos(lim * step, sn, cs);
  const double mag = exp(lre * step);
  const double are = mag * cs, aim = mag * sn;
  const double nr = are - 1.0, ni = aim, den = lre * lre + lim * lim;
  const double fre = (nr * lre + ni * lim) / den, fim = (ni * lre - nr * lim) / den;
  float2* A = reinterpret_cast<float2*>(P.ws + OFF_S5A); float2* A64 = reinterpret_cast<float2*>(P.ws + OFF_S5A64);
  A[gi * 64 + n] = make_float2((float)are, (float)aim);
  double pr = are, pi = aim;
  for (int i = 0; i < 6; ++i) { double t = pr * pr - pi * pi; pi = 2.0 * pr * pi; pr = t; }
  A64[gi * 64 + n] = make_float2((float)pr, (float)pi);
  float2* Bb = reinterpret_cast<float2*>(P.ws + OFF_S5B) + (gi * 64 + n) * 16;
  const float* bre = P.in[I_BRE] + (gi * 64 + n) * 16; const float* bim = P.in[I_BIM] + (gi * 64 + n) * 16;
  for (int c = 0; c < 16; ++c) { double br = bre[c], bi = bim[c]; Bb[c] = make_float2((float)(fre * br - fim * bi), (float)(fre * bi + fim * br)); }
  h16* Ct = reinterpret_cast<h16*>(P.ws + OFF_S5C) + gi * 16 * 128;
  const float* cre = P.in[I_CRE] + gi * 16 * 64; const float* cim = P.in[I_CIM] + gi * 16 * 64;
  for (int c = 0; c < 16; ++c) { Ct[c * 128 + n] = (h16)cre[c * 64 + n]; Ct[c * 128 + 64 + n] = (h16)(-cim[c * 64 + n]); }
}
DI void item_rope(const Params& P, int item) {
  const int idx = item * NTHREADS + tidx(); const int pos = idx >> 4, i = idx & 15;
  const double inv[8] = {1.0, 0.31622776601683794, 0.1, 0.031622776601683794, 0.01, 0.0031622776601683794, 0.001, 0.00031622776601683794};
  double iv = 1.0;
#pragma unroll
  for (int k = 0; k < 8; ++k) if ((i & 7) == k) iv = inv[k];
  const double ang = (double)(i < 8 ? (pos >> 6) : (pos & 63)) * iv;
  double s, c; dsincos(ang, s, c);
  reinterpret_cast<float2*>(P.ws + OFF_ROPE)[idx] = make_float2((float)c, (float)s);
}
constexpr int PRO_N_WT = 2 * WT_TILES_PER_LAYER, PRO_N_MOD = 192, PRO_N_HY = 264, PRO_N_S5 = 24, PRO_N_ROPE = 512;
DI void phase_prologue(const Params& P, char* smem) {
  const int total = PRO_N_MOD + PRO_N_HY + PRO_N_S5 + PRO_N_ROPE + PRO_N_WT;
  for (int it = blockIdx.x; it < total; it += gridDim.x) {
    int i = it;
    if (i < PRO_N_MOD) { item_mod(P, i, smem); continue; } i -= PRO_N_MOD;
    if (i < PRO_N_HY) { item_hymlp(P, i, smem); continue; } i -= PRO_N_HY;
    if (i < PRO_N_S5) { item_s5disc(P, i); continue; } i -= PRO_N_S5;
    if (i < PRO_N_ROPE) { item_rope(P, i); continue; } i -= PRO_N_ROPE;
    item_wt(P, i, smem);
  }
}

DI const float* xrow_src(const Params& P, int layer_stage, int t) {
  if (t < TLAT) return (layer_stage == 0 ? P.in[I_X] : P.out) + (long)t * 1024;
  return (layer_stage == 0 ? P.in[I_CTX] : reinterpret_cast<const float*>(P.ws + OFF_XC)) + (long)(t - TLAT) * 1024;
}
DI float* xrow_dst(const Params& P, int t) {
  if (t < TLAT) return P.out + (long)t * 1024;
  return reinterpret_cast<float*>(P.ws + OFF_XC) + (long)(t - TLAT) * 1024;
}
DI void normmod_rows(const Params& P, int layer, int which, int stage, int ntok, int item, int nitems_stride) {
  const int tid = tidx(), lane = tid & 63, wid = tid >> 6;
  const float* g = P.in[which ? I_N2G : I_N1G] + layer * 1024;
  const float* mod = reinterpret_cast<const float*>(P.ws + OFF_MOD) + (long)layer * 9 * 6144;
  h16* H = reinterpret_cast<h16*>(P.ws + OFF_H1);
  for (int rg = item; rg * 4 < ntok; rg += nitems_stride) {
    const int t = rg * 4 + wid;
    const Tok k = tokinfo(t);
    const float* xr = xrow_src(P, stage, t);
    const float* sh = mod + k.mrow * 6144 + (which ? 3 : 0) * 1024; const float* sc = sh + 1024;
    float4 v[4]; float ss = 0.f;
#pragma unroll
    for (int i = 0; i < 4; ++i) { v[i] = *reinterpret_cast<const float4*>(xr + i * 256 + lane * 4); ss += v[i].x * v[i].x + v[i].y * v[i].y + v[i].z * v[i].z + v[i].w * v[i].w; }
    ss = wave_sum(ss);
    const float r = rsqrtf(ss * (1.f / 1024.f) + EPS);
#pragma unroll
    for (int i = 0; i < 4; ++i) {
      const int c = i * 256 + lane * 4;
      const float4 gg = *reinterpret_cast<const float4*>(g + c), s1 = *reinterpret_cast<const float4*>(sc + c), s0 = *reinterpret_cast<const float4*>(sh + c);
      h16x4 o;
      o[0] = (h16)(v[i].x * r * gg.x * (1.f + s1.x) + s0.x); o[1] = (h16)(v[i].y * r * gg.y * (1.f + s1.y) + s0.y);
      o[2] = (h16)(v[i].z * r * gg.z * (1.f + s1.z) + s0.z); o[3] = (h16)(v[i].w * r * gg.w * (1.f + s1.w) + s0.w);
      *reinterpret_cast<h16x4*>(H + (long)t * LD1 + c) = o;
    }
  }
}
DI void phase_final(const Params& P) {
  const int lane = tidx() & 63, wid = tidx() >> 6;
  const float* g = P.in[I_FINALG];
  for (int rg = blockIdx.x; rg * 4 < TLAT; rg += gridDim.x) {
    float* xr = P.out + (long)(rg * 4 + wid) * 1024;
    float4 v[4]; float ss = 0.f;
#pragma unroll
    for (int i = 0; i < 4; ++i) { v[i] = *reinterpret_cast<const float4*>(xr + i * 256 + lane * 4); ss += v[i].x * v[i].x + v[i].y * v[i].y + v[i].z * v[i].z + v[i].w * v[i].w; }
    ss = wave_sum(ss);
    const float r = rsqrtf(ss * (1.f / 1024.f) + EPS);
#pragma unroll
    for (int i = 0; i < 4; ++i) {
      const int c = i * 256 + lane * 4; const float4 gg = *reinterpret_cast<const float4*>(g + c);
      *reinterpret_cast<float4*>(xr + c) = make_float4(v[i].x * r * gg.x, v[i].y * r * gg.y, v[i].z * r * gg.z, v[i].w * r * gg.w);
    }
  }
}
DI float2 r8(int idx) { const float c = 0.70710678118654752f; return idx == 0 ? make_float2(1.f, 0.f) : idx == 1 ? make_float2(c, -c) : idx == 2 ? make_float2(0.f, -1.f) : make_float2(-c, -c); }
DI float2 cmul_r8(float2 w, int idx, bool cj) {
  if (idx == 0) return w;
  float2 r = r8(idx); if (cj) r.y = -r.y;
  return cmul(w, r);
}
template <int S> DI void fft_dif_pass(float2* X, int h) {
  const int hs = h >> (S - 1);
#pragma unroll 1
  for (int item = tidx(); item < (8192 >> S); item += NTHREADS) {
    const int j = item % hs, blk = item / hs, i0 = blk * 2 * h + j;
    float2 v[1 << S];
#pragma unroll
    for (int k = 0; k < (1 << S); ++k) v[k] = X[i0 + k * hs];
    float2 wp[S];
    wp[0] = twid(-(float)j / (float)(2 * h));
#pragma unroll
    for (int q = 1; q < S; ++q) wp[q] = cmul(wp[q - 1], wp[q - 1]);
#pragma unroll
    for (int q = 0; q < S; ++q) {
      const int dist = 1 << (S - 1 - q);
#pragma unroll
      for (int k = 0; k < (1 << S); ++k) {
        if (k & dist) continue;
        const float2 a = v[k], b = v[k + dist];
        const int m = k & (dist - 1);
        const float2 tw = cmul_r8(wp[q], m << (3 - (S - q)), false);
        v[k] = make_float2(a.x + b.x, a.y + b.y);
        v[k + dist] = cmul(make_float2(a.x - b.x, a.y - b.y), tw);
      }
    }
#pragma unroll
    for (int k = 0; k < (1 << S); ++k) X[i0 + k * hs] = v[k];
  }
  __syncthreads();
}
template <int S> DI void fft_dit_pass(float2* X, int hs) {
  const int hmax = hs << (S - 1);
#pragma unroll 1
  for (int item = tidx(); item < (8192 >> S); item += NTHREADS) {
    const int j = item % hs, blk = item / hs, i0 = blk * 2 * hmax + j;
    float2 v[1 << S];
#pragma unroll
    for (int k = 0; k < (1 << S); ++k) v[k] = X[i0 + k * hs];
    float2 bp[S];
    bp[S - 1] = twid((float)j / (float)(2 * hmax));
#pragma unroll
    for (int q = S - 2; q >= 0; --q) bp[q] = cmul(bp[q + 1], bp[q + 1]);
#pragma unroll
    for (int q = 0; q < S; ++q) {
      const int dist = 1 << q;
#pragma unroll
      for (int k = 0; k < (1 << S); ++k) {
        if (k & dist) continue;
        const int m = k & (dist - 1);
        const float2 tw = cmul_r8(bp[q], m << (3 - (q + 1)), true);
        const float2 a = v[k], b = cmul(v[k + dist], tw);
        v[k] = make_float2(a.x + b.x, a.y + b.y);
        v[k + dist] = make_float2(a.x - b.x, a.y - b.y);
      }
    }
#pragma unroll
    for (int k = 0; k < (1 << S); ++k) X[i0 + k * hs] = v[k];
  }
  __syncthreads();
}
DI void fft_fwd1(float2* X) { fft_dif_pass<3>(X, 4096); fft_dif_pass<3>(X, 512); fft_dif_pass<3>(X, 64); fft_dif_pass<2>(X, 8); fft_dif_pass<2>(X, 2); }
DI void fft_inv(float2* X) { fft_dit_pass<2>(X, 1); fft_dit_pass<2>(X, 4); fft_dit_pass<3>(X, 16); fft_dit_pass<3>(X, 128); fft_dit_pass<3>(X, 1024); }
#ifndef PROBE_FFT
#define PROBE_FFT 0
#endif
DI void fft_fwd(float2* X) {
#if PROBE_FFT
  fft_fwd1(X); fft_inv(X);
  for (int i = tidx(); i < 8192; i += NTHREADS) { float2 v = X[i]; X[i] = make_float2(v.x * (1.f / 8192.f), v.y * (1.f / 8192.f)); }
  __syncthreads();
#endif
  fft_fwd1(X);
}

DI float block_sum(float v, float* red) {
  v = wave_sum(v);
  __syncthreads();
  if ((tidx() & 63) == 0) red[tidx() >> 6] = v;
  __syncthreads();
  const float r = red[0] + red[1] + red[2] + red[3];
  __syncthreads();
  return r;
}
DI void item_filter(const Params& P, int layer, int oc, char* smem) {
  float2* X = reinterpret_cast<float2*>(smem); float* red = reinterpret_cast<float*>(smem + 65536);
  const int tid = tidx();
  const float* z2 = reinterpret_cast<const float*>(P.ws + OFF_Z2) + (long)layer * SEQ * 64;
  const float* w3 = P.in[I_FW3] + (long)layer * 64 * 1536; const float* dec = P.in[I_FDECAY] + layer * 1536;
  const int colf = oc, colb = 768 + oc;
  const float df = fabsf(dec[colf]), db = fabsf(dec[colb]);
  float lsum = 0.f;
#pragma unroll 2
  for (int i = 0; i < 32; ++i) {
    const int t = tid + 256 * i; const float* zr = z2 + (long)t * 64;
    float af = 0.f, ab = 0.f;
#pragma unroll 8
    for (int k = 0; k < 64; ++k) { const float z = zr[k]; af += z * w3[k * 1536 + colf]; ab += z * w3[k * 1536 + colb]; }
    const float tn = (float)t * (1.f / 8192.f);
    af *= __expf(-tn * df); ab *= __expf(-tn * db);
    lsum += fabsf(af) + fabsf(ab);
    X[t] = make_float2(af, ab);
  }
  const float nrm = block_sum(lsum, red);
  const float sc = 0.5f / 8192.f / nrm;
  float ev[32];
  float2* F = reinterpret_cast<float2*>(P.ws + OFF_FILT) + (long)oc * 2 * 8192;
#pragma unroll
  for (int i = 0; i < 32; ++i) {
    const int n = tid + 256 * i; const float lo = X[n].x; const float hi = n > 0 ? X[8192 - n].y : 0.f;
    ev[i] = (lo + hi) * sc; F[8192 + n] = make_float2((lo - hi) * sc, 0.f);
  }
  __syncthreads();
#pragma unroll
  for (int i = 0; i < 32; ++i) X[tid + 256 * i] = make_float2(ev[i], 0.f);
  __syncthreads();
  fft_fwd(X);
#pragma unroll 4
  for (int i = 0; i < 32; ++i) F[tid + 256 * i] = X[tid + 256 * i];
  __syncthreads();
#pragma unroll 4
  for (int i = 0; i < 32; ++i) { const int n = tid + 256 * i; const float d = F[8192 + n].x; const float2 w = twid(-(float)n * (1.f / 16384.f)); X[n] = make_float2(d * w.x, d * w.y); }
  __syncthreads();
  fft_fwd(X);
#pragma unroll 4
  for (int i = 0; i < 32; ++i) F[8192 + tid + 256 * i] = X[tid + 256 * i];
  __syncthreads();
}
DI void item_filter_ctx(const Params& P, int layer, int oc, char* smem) {
  float* red = reinterpret_cast<float*>(smem);
  const int t = tidx();
  const float* zr = reinterpret_cast<const float*>(P.ws + OFF_Z2C) + (long)layer * CTXL * 64 + t * 64;
  const float* w3 = P.in[I_FW3] + (long)layer * 64 * 1536; const float* dec = P.in[I_FDECAY] + layer * 1536;
  float af = 0.f, ab = 0.f;
  for (int k = 0; k < 64; ++k) { const float z = zr[k]; af += z * w3[k * 1536 + oc]; ab += z * w3[k * 1536 + 768 + oc]; }
  const float tn = (float)t * (1.f / 256.f);
  af *= __expf(-tn * fabsf(dec[oc])); ab *= __expf(-tn * fabsf(dec[768 + oc]));
  const float nrm = block_sum(fabsf(af) + fabsf(ab), red);
  float* T = reinterpret_cast<float*>(P.ws + OFF_TAPSC) + (long)oc * 512;
  T[t] = af / nrm; T[256 + t] = ab / nrm;
}

DI void phase_norm1(const Params& P, int layer, char* smem) {
  const int nfilt = 768 + (layer == 0 ? 768 : 0);
  for (int it = blockIdx.x; it < nfilt; it += gridDim.x) {
    if (it < 768) item_filter(P, layer, it, smem); else item_filter_ctx(P, layer, it - 768, smem);
  }
  normmod_rows(P, layer, 0, layer, TT, blockIdx.x, gridDim.x);
}

DI void phase_gemm_in(const Params& P, int layer, char* smem) {
  const int tid = tidx(), lane = tid & 63, wid = tid >> 6, wr = wid >> 1, wc = wid & 1, fr = lane & 15, fq = lane >> 4;
  const h16* H = reinterpret_cast<const h16*>(P.ws + OFF_H1);
  const h16* W = reinterpret_cast<const h16*>(P.ws + OFF_WT) + (long)layer * WT_LAYER + WT_WIN;
  h16* U = reinterpret_cast<h16*>(P.ws + OFF_U); h16* KV = reinterpret_cast<h16*>(P.ws + OFF_KVLAT); h16* QL = reinterpret_cast<h16*>(P.ws + OFF_QLAT);
  h16* PHY = reinterpret_cast<h16*>(P.ws + OFF_PHY); h16* PHYC = reinterpret_cast<h16*>(P.ws + OFF_PHYC); h16* Kb = reinterpret_cast<h16*>(P.ws + OFF_K);
  const float2* rope = reinterpret_cast<const float2*>(P.ws + OFF_ROPE);
  constexpr int NT = 19, MT = TT / 128;
  const TileWalk tw = tw_init(MT, NT);
  for (int tile = tw.lb; tile < tw_count(tw); tile += tw.nlb) {
    int mt, nt; tw_decode(tw, tile, mt, nt);
    f32x4 acc[4][4]; acc_zero(acc);
    gemm_kloop(acc, H + (long)mt * 128 * LD1, LD1, 0, 128, W + (long)nt * 128 * LD1, LD1, 1024, smem, opaque_tid());
    const int t0 = mt * 128; const Tok tk = tokinfo(t0);
    if (nt < 18) {
      float* Zs = reinterpret_cast<float*>(smem);
      const int t2 = tidx();
      if (nt < 9) {
        stage_acc(acc, Zs, t2);
        h16* dst; int ld, cb;
        if (nt < 3) { dst = U; ld = 384; cb = nt * 128; } else if (nt < 5) { dst = KV; ld = 256; cb = (nt - 3) * 128; } else { dst = QL; ld = 512; cb = (nt - 5) * 128; }
        copy_out_f16(Zs, dst, t0, ld, cb, t2);
      } else {
        stage_acc_t(acc, Zs, t2);
        h16* base = tk.ctx ? PHYC + (long)tk.b * 1152 * CTXL : PHY + (long)tk.b * 1152 * SEQ; const int lp = tk.ctx ? CTXL : SEQ;
        copy_out_f16(Zs, base, (nt - 9) * 128, lp, tk.pos, t2);
      }
      __syncthreads();
    } else {
      h16* R = reinterpret_cast<h16*>(smem);
      if (wc == 0) {
#pragma unroll
        for (int m = 0; m < 4; ++m)
#pragma unroll
          for (int j = 0; j < 4; ++j) {
            const int row = wr * 64 + m * 16 + fq * 4 + j; const int pos = tk.pos + row;
            float x1 = acc[m][0][j], x2 = acc[m][1][j];
            if (!tk.ctx) { const float2 cs = rope[pos * 16 + fr]; const float y1 = x1 * cs.x - x2 * cs.y, y2 = x1 * cs.y + x2 * cs.x; x1 = y1; x2 = y2; }
            R[row * 32 + fr] = (h16)x1; R[row * 32 + 16 + fr] = (h16)x2;
          }
      }
      __syncthreads();
      {
        const int t2 = tidx(); const int key0 = (tk.ctx ? SEQ : 0) + tk.pos;
#pragma unroll
        for (int it = 0; it < 2; ++it) {
          const int chunk = it * 256 + t2, row = chunk >> 2, part = chunk & 3;
          const uint4 v = *reinterpret_cast<const uint4*>(R + row * 32 + part * 8);
#pragma unroll
          for (int h = 0; h < 8; ++h) *reinterpret_cast<uint4*>(Kb + ((long)(tk.b * 8 + h) * KEYS + key0 + row) * 96 + 64 + part * 8) = v;
        }
      }
      __syncthreads();
    }
  }
}
DI void item_kv(const Params& P, int layer, int tile, char* smem) {
  const int tid = tidx(), lane = tid & 63, wid = tid >> 6, wr = wid >> 1, wc = wid & 1, fr = lane & 15, fq = lane >> 4;
  const int mt = tile >> 3, hd = tile & 7; const int t0 = mt * 128; const Tok tk = tokinfo(t0);
  const h16* A = reinterpret_cast<const h16*>(P.ws + OFF_KVLAT) + (long)t0 * 256;
  const h16* W = reinterpret_cast<const h16*>(P.ws + OFF_WT) + (long)layer * WT_LAYER + WT_UKV + (long)hd * 128 * 256;
  float* rs = reinterpret_cast<float*>(smem + 73728);
  row_rms(A, 256, 256, rs);
  f32x4 acc[4][4]; acc_zero(acc);
  gemm_kloop(acc, A, 256, 0, 128, W, 256, 256, smem, opaque_tid());
  h16* Kb = reinterpret_cast<h16*>(P.ws + OFF_K) + (long)(tk.b * 8 + hd) * KEYS * 96;
  h16* Vt = reinterpret_cast<h16*>(P.ws + OFF_VT) + (long)(tk.b * 8 + hd) * 64 * KEYS;
  const int key0 = (tk.ctx ? SEQ : 0) + tk.pos;
#pragma unroll
  for (int m = 0; m < 4; ++m) {
    const int r0 = wr * 64 + m * 16 + fq * 4;
    const float s0 = rs[r0], s1 = rs[r0 + 1], s2 = rs[r0 + 2], s3 = rs[r0 + 3];
#pragma unroll
    for (int n = 0; n < 4; ++n) {
      const int col = n * 16 + fr;
      if (wc == 0) {
        Kb[(long)(key0 + r0 + 0) * 96 + col] = (h16)(acc[m][n][0] * s0); Kb[(long)(key0 + r0 + 1) * 96 + col] = (h16)(acc[m][n][1] * s1);
        Kb[(long)(key0 + r0 + 2) * 96 + col] = (h16)(acc[m][n][2] * s2); Kb[(long)(key0 + r0 + 3) * 96 + col] = (h16)(acc[m][n][3] * s3);
      } else {
        h16x4 o; o[0] = (h16)(acc[m][n][0] * s0); o[1] = (h16)(acc[m][n][1] * s1); o[2] = (h16)(acc[m][n][2] * s2); o[3] = (h16)(acc[m][n][3] * s3);
        *reinterpret_cast<h16x4*>(Vt + (long)col * KEYS + key0 + r0) = o;
      }
    }
  }
  __syncthreads();
}
DI void item_q(const Params& P, int layer, int tile, char* smem) {
  const int tid = tidx(), lane = tid & 63, wid = tid >> 6, wr = wid >> 1, wc = wid & 1, fr = lane & 15, fq = lane >> 4;
  const int mt = tile >> 3, hd = tile & 7; const int t0 = mt * 128; const Tok tk = tokinfo(t0);
  const h16* A = reinterpret_cast<const h16*>(P.ws + OFF_QLAT) + (long)t0 * 512;
  const h16* W = reinterpret_cast<const h16*>(P.ws + OFF_WT) + (long)layer * WT_LAYER + WT_UQ + (long)hd * 128 * 512;
  float* rs = reinterpret_cast<float*>(smem + 73728);
  row_rms(A, 512, 512, rs);
  f32x4 acc[4][4]; acc_zero(acc);
  gemm_kloop(acc, A, 512, 0, 128, W, 512, 512, smem, opaque_tid());
  h16* Qb = reinterpret_cast<h16*>(P.ws + OFF_Q) + (long)(tk.b * 8 + hd) * KEYS * 96;
  const float2* rope = reinterpret_cast<const float2*>(P.ws + OFF_ROPE);
  const int q0 = (tk.ctx ? SEQ : 0) + tk.pos;
#pragma unroll
  for (int m = 0; m < 4; ++m)
#pragma unroll
    for (int j = 0; j < 4; ++j) {
      const int r = wr * 64 + m * 16 + fq * 4 + j; const float s = rs[r] * QSCALE;
      h16* qr = Qb + (long)(q0 + r) * 96;
      if (wc == 0) {
#pragma unroll
        for (int n = 0; n < 4; ++n) qr[n * 16 + fr] = (h16)(acc[m][n][j] * s);
      } else {
        float x1 = acc[m][0][j], x2 = acc[m][1][j];
        if (!tk.ctx) { const float2 cs = rope[(tk.pos + r) * 16 + fr]; const float y1 = x1 * cs.x - x2 * cs.y, y2 = x1 * cs.y + x2 * cs.x; x1 = y1; x2 = y2; }
        qr[64 + fr] = (h16)(x1 * s); qr[80 + fr] = (h16)(x2 * s);
      }
    }
  __syncthreads();
}
DI int s5_chunk_base(int b, int dir, int si) {
  if (si < 4) { const int cc = dir ? 3 - si : si; return TLAT + b * CTXL + cc * 64; }
  const int lc = dir ? 127 - (si - 4) : si - 4; return b * SEQ + lc * 64;
}
DI void s5_stage_u(const h16* __restrict__ U, int tokbase, int g, float* us) {
  const int lane = tidx() & 63;
  const h16* p = U + (long)(tokbase + lane) * 384 + g * 16;
  const h16x8 v0 = *reinterpret_cast<const h16x8*>(p), v1 = *reinterpret_cast<const h16x8*>(p + 8);
#pragma unroll
  for (int j = 0; j < 8; ++j) { us[lane * 16 + j] = (float)v0[j]; us[lane * 16 + 8 + j] = (float)v1[j]; }
}
DI void item_s5_pass1(const Params& P, int layer, int wtask, char* smem) {
  const int lane = tidx() & 63, wid = tidx() >> 6;
  float* us = reinterpret_cast<float*>(smem + wid * 12800);
  const int si = wtask % 132; int r = wtask / 132; const int g = r % 24; r /= 24; const int dir = r & 1, b = r >> 1;
  const long gi = (long)(layer * 2 + dir) * 24 + g;
  const float2 a = reinterpret_cast<const float2*>(P.ws + OFF_S5A)[gi * 64 + lane];
  const float2* Bb = reinterpret_cast<const float2*>(P.ws + OFF_S5B) + (gi * 64 + lane) * 16;
  float bre[16], bim[16];
#pragma unroll
  for (int c = 0; c < 16; ++c) { const float2 v = Bb[c]; bre[c] = v.x; bim[c] = v.y; }
  s5_stage_u(reinterpret_cast<const h16*>(P.ws + OFF_U), s5_chunk_base(b, dir, si), g, us);
  float hr = 0.f, hi = 0.f;
#pragma unroll 4
  for (int s = 0; s < 64; ++s) {
    const int tau = dir ? 63 - s : s;
    const float4* up = reinterpret_cast<const float4*>(us + tau * 16);
    float br = 0.f, bi = 0.f;
#pragma unroll
    for (int q = 0; q < 4; ++q) { const float4 u = up[q];
      br += bre[q * 4] * u.x + bre[q * 4 + 1] * u.y + bre[q * 4 + 2] * u.z + bre[q * 4 + 3] * u.w;
      bi += bim[q * 4] * u.x + bim[q * 4 + 1] * u.y + bim[q * 4 + 2] * u.z + bim[q * 4 + 3] * u.w; }
    const float nr = a.x * hr - a.y * hi + br, ni = a.x * hi + a.y * hr + bi; hr = nr; hi = ni;
  }
  reinterpret_cast<float2*>(P.ws + OFF_E)[((long)((b * 2 + dir) * 24 + g) * 132 + si) * 64 + lane] = make_float2(hr, hi);
}

DI float hy_dw(const h16* __restrict__ p, int t, int Ls, float w0, float w1, float w2, float bias) {
  const float xm_ = (float)p[max(t - 1, 0)], x0 = (float)p[t], xp_ = (float)p[min(t + 1, Ls - 1)];
  const float xm = t > 0 ? xm_ : 0.f, xp = t + 1 < Ls ? xp_ : 0.f;
  return xm * w0 + x0 * w1 + xp * w2 + bias;
}
DI void item_hyena(const Params& P, int layer, int task, char* smem) {
  float2* X = reinterpret_cast<float2*>(smem);
  const int tid = tidx(); const int pair = task / 384, c = task % 384;
  const h16* PH0 = reinterpret_cast<const h16*>(P.ws + OFF_PHY) + (long)(2 * pair) * 1152 * SEQ;
  const h16* PH1 = PH0 + (long)1152 * SEQ;
  const float* cw = P.in[I_HCW] + layer * 3 * 1152; const float* cb = P.in[I_HCB] + layer * 1152;
  const float2* F = reinterpret_cast<const float2*>(P.ws + OFF_FILT);
  float2* SCR = reinterpret_cast<float2*>(P.ws + OFF_YS5PRE) + (long)blockIdx.x * 12288;
  float2* SCR2 = SCR + 8192;
  const float vw0 = cw[c], vw1 = cw[1152 + c], vw2 = cw[2304 + c], vbb = cb[c];
  const h16* pv0 = PH0 + (long)c * SEQ; const h16* pv1 = PH1 + (long)c * SEQ;
  float2 ye[16]; int tq;
#pragma unroll 1
  for (int o = 0; o < 2; ++o) {
    const float2* Te = F + (long)(o * 384 + c) * 2 * 8192; const float2* To = Te + 8192;
    float ts = 1.f / 16384.f; asm volatile("" : "+v"(ts));
{ tq = tid; asm volatile("" : "+v"(tq)); }
    if (o == 0) {
#pragma unroll 8
      for (int i = 0; i < 32; ++i) { const int t = tq + 256 * i; const float2 v = make_float2(hy_dw(pv0, t, SEQ, vw0, vw1, vw2, vbb), hy_dw(pv1, t, SEQ, vw0, vw1, vw2, vbb)); X[t] = v; SCR[t] = v; }
    } else {
#pragma unroll 16
      for (int i = 0; i < 32; ++i) { const int t = tq + 256 * i; X[t] = SCR[t]; }
    }
    __syncthreads();
    fft_fwd(X);
{ tq = tid; asm volatile("" : "+v"(tq)); }
#pragma unroll 8
    for (int i = 0; i < 32; ++i) { const int n = tq + 256 * i; X[n] = cmul(X[n], Te[n]); }
    __syncthreads();
    fft_inv(X);
{ tq = tid; asm volatile("" : "+v"(tq)); }
#pragma unroll
    for (int i = 0; i < 16; ++i) { ye[i] = X[tq + 256 * i]; SCR2[tq + 256 * i] = X[tq + 4096 + 256 * i]; }
    __syncthreads();
{ tq = tid; asm volatile("" : "+v"(tq)); }
#pragma unroll 16
    for (int i = 0; i < 32; ++i) { const int t = tq + 256 * i; X[t] = cmul(SCR[t], twid(-(float)t * ts)); }
    __syncthreads();
    fft_fwd(X);
{ tq = tid; asm volatile("" : "+v"(tq)); }
#pragma unroll 8
    for (int i = 0; i < 32; ++i) { const int n = tq + 256 * i; X[n] = cmul(X[n], To[n]); }
    __syncthreads();
    fft_inv(X);
    asm volatile("" : "+v"(ts));
{ tq = tid; asm volatile("" : "+v"(tq)); }
#pragma unroll
    for (int i = 0; i < 16; ++i) { const int t = tq + 256 * i; const float2 yo = cmul(X[t], twid((float)t * ts)); X[t] = make_float2(ye[i].x + yo.x, ye[i].y + yo.y); }
{ tq = tid; asm volatile("" : "+v"(tq)); }
#pragma unroll 2
    for (int i = 0; i < 16; ++i) { const int t = tq + 4096 + 256 * i; const float2 yo = cmul(X[t], twid((float)t * ts)); const float2 y2 = SCR2[tq + 256 * i]; X[t] = make_float2(y2.x + yo.x, y2.y + yo.y); }
    const int gc = (o + 1) * 384 + c;
    const float w0 = cw[gc], w1 = cw[1152 + gc], w2 = cw[2304 + gc], bb = cb[gc];
    const float bias = P.in[I_HBIAS][(layer * 2 + o) * 384 + c];
    const h16* pg0 = PH0 + (long)gc * SEQ; const h16* pg1 = PH1 + (long)gc * SEQ;
    h16* Y = reinterpret_cast<h16*>(P.ws + OFF_YHY);
{ tq = tid; asm volatile("" : "+v"(tq)); }
    if (o == 0) {
#pragma unroll 8
      for (int i = 0; i < 32; ++i) {
        const int t = tq + 256 * i;
        const float2 lc = X[t];
        const float2 zz = SCR[t];
        const float gx = hy_dw(pg0, t, SEQ, w0, w1, w2, bb), gy = hy_dw(pg1, t, SEQ, w0, w1, w2, bb);
        SCR[t] = make_float2(gx * (lc.x + bias * zz.x), gy * (lc.y + bias * zz.y));
      }
    } else {
#pragma unroll 8
      for (int i = 0; i < 32; ++i) {
        const int t = tq + 256 * i;
        const float2 lc = X[t];
        const float2 zz = SCR[t];
        const float gx = hy_dw(pg0, t, SEQ, w0, w1, w2, bb), gy = hy_dw(pg1, t, SEQ, w0, w1, w2, bb);
        Y[((long)(2 * pair) * SEQ + t) * 384 + c] = (h16)(gx * (lc.x + bias * zz.x)); Y[((long)(2 * pair + 1) * SEQ + t) * 384 + c] = (h16)(gy * (lc.y + bias * zz.y));
      }
    }
    __syncthreads();
  }
}
DI void item_hyena_ctx(const Params& P, int layer, int task, char* smem) {
  float* su = reinterpret_cast<float*>(smem); float* sf = su + 256; float* sb = sf + 256;
  const int t = tidx(); const int b = task / 384, c = task % 384;
  const h16* PH = reinterpret_cast<const h16*>(P.ws + OFF_PHYC) + (long)b * 1152 * CTXL;
  const float* cw = P.in[I_HCW] + layer * 3 * 1152; const float* cb = P.in[I_HCB] + layer * 1152;
  float u = hy_dw(PH + (long)c * CTXL, t, CTXL, cw[c], cw[1152 + c], cw[2304 + c], cb[c]);
  for (int o = 0; o < 2; ++o) {
    const float* T = reinterpret_cast<const float*>(P.ws + OFF_TAPSC) + (long)(o * 384 + c) * 512;
    __syncthreads();
    su[t] = u; sf[t] = T[t]; sb[t] = T[256 + t];
    __syncthreads();
    float y = 0.f;
    for (int s = 0; s <= t; ++s) y += sf[t - s] * su[s];
    for (int s = t + 1; s < 256; ++s) y += sb[s - t] * su[s];
    const int gc = (o + 1) * 384 + c;
    const float gx = hy_dw(PH + (long)gc * CTXL, t, CTXL, cw[gc], cw[1152 + gc], cw[2304 + gc], cb[gc]);
    u = gx * (y + P.in[I_HBIAS][(layer * 2 + o) * 384 + c] * u);
  }
  reinterpret_cast<h16*>(P.ws + OFF_YHY)[((long)TLAT + b * CTXL + t) * 384 + c] = (h16)u;
  __syncthreads();
}

#ifndef PROBE_HY
#define PROBE_HY 0
#endif
#ifndef PROBE_S5
#define PROBE_S5 0
#endif
DI int first_item(int base) { const int g = (int)gridDim.x; return (((int)blockIdx.x - base) % g + g) % g; }
DI void phase_mix1(const Params& P, int layer, char* smem) {
  const int n_hy = 4 * 384, n_hyc = layer == 0 ? 8 * 384 : 0;
  const int n_kv = (TT / 128) * 8, n_q = (layer == 0 ? TT / 128 : TLAT / 128) * 8;
  const int n_s5 = (NBATCH * 2 * 24 * 132) / 4;
  const int g = gridDim.x;
#pragma unroll 1
  for (int rep = 0; rep < 1 + PROBE_HY; ++rep)
#pragma unroll 1
  for (int i = first_item(0); i < n_hy; i += g) item_hyena(P, layer, i, smem);
  asm volatile("" ::: "memory");
#pragma unroll 1
  for (int i = first_item(n_hy); i < n_kv; i += g) item_kv(P, layer, i, smem);
  asm volatile("" ::: "memory");
#pragma unroll 1
  for (int i = first_item(n_hy + n_kv); i < n_q; i += g) item_q(P, layer, i, smem);
  asm volatile("" ::: "memory");
#pragma unroll 1
  for (int rep = 0; rep < 1 + PROBE_S5; ++rep)
#pragma unroll 1
  for (int i = first_item(n_hy + n_kv + n_q); i < n_s5; i += g) { item_s5_pass1(P, layer, i * 4 + (tidx() >> 6), smem); __syncthreads(); }
  asm volatile("" ::: "memory");
#pragma unroll 1
  for (int i = first_item(n_hy + n_kv + n_q + n_s5); i < n_hyc; i += g) item_hyena_ctx(P, layer, i, smem);
}
DI int crow32(int r, int hi) { return (r & 3) + 8 * (r >> 2) + 4 * hi; }
DI void item_attn(const Params& P, int bh, int q0, int key_lo, int ntiles, char* smem) {
  const int tid = tidx(), lane = tid & 63, wid = tid >> 6, r32 = lane & 31, hi = lane >> 5;
  const h16* Qb = reinterpret_cast<const h16*>(P.ws + OFF_Q) + (long)bh * KEYS * 96;
  const h16* Kb = reinterpret_cast<const h16*>(P.ws + OFF_K) + (long)bh * KEYS * 96;
  const h16* Vt = reinterpret_cast<const h16*>(P.ws + OFF_VT) + (long)bh * 64 * KEYS;
  h16x8 qf[6];
  { const h16* qrow = Qb + (long)(q0 + wid * 32 + r32) * 96 + hi * 8;
#pragma unroll
    for (int ds = 0; ds < 6; ++ds) qf[ds] = *reinterpret_cast<const h16x8*>(qrow + ds * 16); }
  constexpr int KT_BYTES = 64 * 208, VT_BYTES = 64 * 136, BUF = KT_BYTES + VT_BYTES;
  uint4 kr[3]; uint4 vr[2];
  const int vdv0 = tid >> 3, vpart = tid & 7;
  auto gload = [&](int j) {
    const long key0 = key_lo + j * 64;
#pragma unroll
    for (int i = 0; i < 3; ++i) kr[i] = *reinterpret_cast<const uint4*>(Kb + key0 * 96 + (long)(tid + 256 * i) * 8);
#pragma unroll
    for (int i = 0; i < 2; ++i) vr[i] = *reinterpret_cast<const uint4*>(Vt + (long)(vdv0 + 32 * i) * KEYS + key0 + vpart * 8);
  };
  auto swrite = [&](int buf) {
    char* ks = smem + buf * BUF; char* vs = ks + KT_BYTES;
#pragma unroll
    for (int i = 0; i < 3; ++i) { const int c = tid + 256 * i; *reinterpret_cast<uint4*>(ks + (c / 12) * 208 + (c % 12) * 16) = kr[i]; }
#pragma unroll
    for (int i = 0; i < 2; ++i) { char* d = vs + (vdv0 + 32 * i) * 136 + vpart * 16;
      *reinterpret_cast<uint2*>(d) = make_uint2(vr[i].x, vr[i].y); *reinterpret_cast<uint2*>(d + 8) = make_uint2(vr[i].z, vr[i].w); }
  };
  f32x16 o0, o1;
#pragma unroll
  for (int r = 0; r < 16; ++r) { o0[r] = 0.f; o1[r] = 0.f; }
  float m_run = -1e30f, l_run = 0.f;
  gload(0); swrite(0); __syncthreads();
  for (int j = 0; j < ntiles; ++j) {
    if (j + 1 < ntiles) gload(j + 1);
    const char* ks = smem + (j & 1) * BUF; const char* vs = ks + KT_BYTES;
    f32x16 p0, p1;
#pragma unroll
    for (int r = 0; r < 16; ++r) { p0[r] = 0.f; p1[r] = 0.f; }
#pragma unroll
    for (int ds = 0; ds < 6; ++ds) {
      const h16x8 a0 = *reinterpret_cast<const h16x8*>(ks + r32 * 208 + (ds * 16 + hi * 8) * 2);
      const h16x8 a1 = *reinterpret_cast<const h16x8*>(ks + (32 + r32) * 208 + (ds * 16 + hi * 8) * 2);
      p0 = __builtin_amdgcn_mfma_f32_32x32x16_f16(a0, qf[ds], p0, 0, 0, 0);
      p1 = __builtin_amdgcn_mfma_f32_32x32x16_f16(a1, qf[ds], p1, 0, 0, 0);
    }
    float mx = p0[0];
#pragma unroll
    for (int r = 1; r < 16; ++r) mx = fmaxf(mx, p0[r]);
#pragma unroll
    for (int r = 0; r < 16; ++r) mx = fmaxf(mx, p1[r]);
    mx = fmaxf(mx, __shfl_xor(mx, 32));
    const float mnew = fmaxf(m_run, mx);
    const float alpha = __builtin_amdgcn_exp2f(m_run - mnew);
    m_run = mnew;
    float rsum = 0.f;
#pragma unroll
    for (int r = 0; r < 16; ++r) { p0[r] = __builtin_amdgcn_exp2f(p0[r] - mnew); rsum += p0[r]; }
#pragma unroll
    for (int r = 0; r < 16; ++r) { p1[r] = __builtin_amdgcn_exp2f(p1[r] - mnew); rsum += p1[r]; }
    l_run = l_run * alpha + rsum;
    if (__any(alpha != 1.f)) {
#pragma unroll
      for (int r = 0; r < 16; ++r) { o0[r] *= alpha; o1[r] *= alpha; }
    }
#pragma unroll
    for (int kb = 0; kb < 2; ++kb)
#pragma unroll
      for (int s = 0; s < 2; ++s) {
        h16x8 pf;
#pragma unroll
        for (int e = 0; e < 8; ++e) pf[e] = (h16)(kb ? p1[8 * s + e] : p0[8 * s + e]);
        const int koff = (32 * kb + 16 * s + 4 * hi) * 2;
        {
          const h16x4 lo = *reinterpret_cast<const h16x4*>(vs + r32 * 136 + koff), hh = *reinterpret_cast<const h16x4*>(vs + r32 * 136 + koff + 16);
          const h16x8 af = __builtin_shufflevector(lo, hh, 0, 1, 2, 3, 4, 5, 6, 7);
          o0 = __builtin_amdgcn_mfma_f32_32x32x16_f16(af, pf, o0, 0, 0, 0);
        }
        {
          const h16x4 lo = *reinterpret_cast<const h16x4*>(vs + (32 + r32) * 136 + koff), hh = *reinterpret_cast<const h16x4*>(vs + (32 + r32) * 136 + koff + 16);
          const h16x8 af = __builtin_shufflevector(lo, hh, 0, 1, 2, 3, 4, 5, 6, 7);
          o1 = __builtin_amdgcn_mfma_f32_32x32x16_f16(af, pf, o1, 0, 0, 0);
        }
      }
    if (j + 1 < ntiles) swrite((j + 1) & 1);
    __syncthreads();
  }
  const float lt = l_run + __shfl_xor(l_run, 32);
  const float inv = 1.f / lt;
  const int b = bh >> 3, hd = bh & 7; const int q = q0 + wid * 32 + r32;
  const long tok = q < SEQ ? (long)b * SEQ + q : (long)TLAT + b * CTXL + (q - SEQ);
  h16* yr = reinterpret_cast<h16*>(P.ws + OFF_YMLA) + tok * 512 + hd * 64;
#pragma unroll
  for (int g = 0; g < 4; ++g) {
    h16x4 a, c;
#pragma unroll
    for (int e = 0; e < 4; ++e) { a[e] = (h16)(o0[4 * g + e] * inv); c[e] = (h16)(o1[4 * g + e] * inv); }
    *reinterpret_cast<h16x4*>(yr + 8 * g + 4 * hi) = a;
    *reinterpret_cast<h16x4*>(yr + 32 + 8 * g + 4 * hi) = c;
  }
}
DI void item_s5_pass3(const Params& P, int layer, int b, int g, int ck, char* smem) {
  const int lane = tidx() & 63, wid = tidx() >> 6, fr = lane & 15, fq = lane >> 4;
  float* us = reinterpret_cast<float*>(smem + wid * 12800); char* Hs = smem + wid * 12800 + 4096;
  const int tokbase = ck < 4 ? TLAT + b * CTXL + ck * 64 : b * SEQ + (ck - 4) * 64;
  s5_stage_u(reinterpret_cast<const h16*>(P.ws + OFF_U), tokbase, g, us);
  __syncthreads();
  f32x4 yacc[4];
#pragma unroll
  for (int i = 0; i < 4; ++i) yacc[i] = f32x4{0.f, 0.f, 0.f, 0.f};
#pragma unroll
  for (int dir = 0; dir < 2; ++dir) {
    const long gi = (long)(layer * 2 + dir) * 24 + g;
    const float2 a = reinterpret_cast<const float2*>(P.ws + OFF_S5A)[gi * 64 + lane];
    const float2 a64 = reinterpret_cast<const float2*>(P.ws + OFF_S5A64)[gi * 64 + lane];
    const float2* Bb = reinterpret_cast<const float2*>(P.ws + OFF_S5B) + (gi * 64 + lane) * 16;
    float bre[16], bim[16];
#pragma unroll
    for (int c = 0; c < 16; ++c) { const float2 v = Bb[c]; bre[c] = v.x; bim[c] = v.y; }
    const int si = ck < 4 ? (dir ? 3 - ck : ck) : 4 + (dir ? 127 - (ck - 4) : ck - 4);
    const float2* Ep = reinterpret_cast<const float2*>(P.ws + OFF_E) + ((long)((b * 2 + dir) * 24 + g) * 132) * 64 + lane;
    float hr = 0.f, hi = 0.f;
#pragma unroll 16
    for (int i = 0; i < si; ++i) { const float2 e = Ep[(long)i * 64]; const float nr = a64.x * hr - a64.y * hi + e.x, ni = a64.x * hi + a64.y * hr + e.y; hr = nr; hi = ni; }
    const h16* Ct = reinterpret_cast<const h16*>(P.ws + OFF_S5C) + gi * 16 * 128 + fr * 128 + fq * 8;
    h16x8 cf[4];
#pragma unroll
    for (int ks = 0; ks < 4; ++ks) cf[ks] = *reinterpret_cast<const h16x8*>(Ct + ks * 32);
#pragma unroll
    for (int half = 0; half < 2; ++half) {
#pragma unroll 4
      for (int s = 0; s < 32; ++s) {
        const int step = half * 32 + s; const int tau = dir ? 63 - step : step;
        const float4* up = reinterpret_cast<const float4*>(us + tau * 16);
        float br = 0.f, bi = 0.f;
#pragma unroll
        for (int q = 0; q < 4; ++q) { const float4 u = up[q];
          br += bre[q * 4] * u.x + bre[q * 4 + 1] * u.y + bre[q * 4 + 2] * u.z + bre[q * 4 + 3] * u.w;
          bi += bim[q * 4] * u.x + bim[q * 4 + 1] * u.y + bim[q * 4 + 2] * u.z + bim[q * 4 + 3] * u.w; }
        const float nr = a.x * hr - a.y * hi + br, ni = a.x * hi + a.y * hr + bi; hr = nr; hi = ni;
        h16* hrow = reinterpret_cast<h16*>(Hs + (tau & 31) * 272);
        hrow[lane] = (h16)hr; hrow[64 + lane] = (h16)hi;
      }
      __syncthreads();
      const int tb = dir ? 1 - half : half;
#pragma unroll
      for (int sb2 = 0; sb2 < 2; ++sb2)
#pragma unroll
        for (int ks = 0; ks < 4; ++ks) {
          const h16x8 bf = *reinterpret_cast<const h16x8*>(Hs + (sb2 * 16 + fr) * 272 + (ks * 32 + fq * 8) * 2);
          yacc[tb * 2 + sb2] = __builtin_amdgcn_mfma_f32_16x16x32_f16(cf[ks], bf, yacc[tb * 2 + sb2], 0, 0, 0);
        }
      __syncthreads();
    }
  }
  const float* dsk = P.in[I_S5D] + layer * 384 + g * 16 + fq * 4;
  h16* Y = reinterpret_cast<h16*>(P.ws + OFF_YS5PRE);
#pragma unroll
  for (int sbi = 0; sbi < 4; ++sbi) {
    const int tl = sbi * 16 + fr; h16x4 o;
#pragma unroll
    for (int j = 0; j < 4; ++j) o[j] = (h16)geluf_(yacc[sbi][j] + dsk[j] * us[tl * 16 + fq * 4 + j]);
    *reinterpret_cast<h16x4*>(Y + (long)(tokbase + tl) * 384 + g * 16 + fq * 4) = o;
  }
  __syncthreads();
}
DI void phase_mix2(const Params& P, int layer, char* smem) {
  if ((gridDim.x & 7) == 0) {
    const int xcd = blockIdx.x & 7, li = blockIdx.x >> 3, nloc = gridDim.x >> 3;
    for (int k = li; k < 512; k += nloc) item_attn(P, xcd + 8 * (k >> 6), (k & 63) * 128, 0, KEYS / 64, smem);
  } else {
    for (int k = blockIdx.x; k < 4096; k += gridDim.x) item_attn(P, k >> 6, (k & 63) * 128, 0, KEYS / 64, smem);
  }
  const int n_actx = layer == 0 ? 128 : 0;
  const int nck = layer == 0 ? 132 : 128;
  const int n_s5 = NBATCH * 24 * nck / 4;
  for (int it = blockIdx.x; it < n_actx + n_s5; it += gridDim.x) {
    if (it < n_actx) { item_attn(P, it >> 1, SEQ + (it & 1) * 128, SEQ, CTXL / 64, smem); continue; }
    const int w = (it - n_actx) * 4 + (tidx() >> 6);
    const int ck = w % nck + (layer == 0 ? 0 : 4); const int r = w / nck;
    item_s5_pass3(P, layer, r / 24, r % 24, ck, smem);
  }
}
DI void phase_glu(const Params& P, int layer, char* smem) {
  const int tid = tidx(), lane = tid & 63, wid = tid >> 6, wr = wid >> 1, wc = wid & 1, fr = lane & 15, fq = lane >> 4;
  const h16* A = reinterpret_cast<const h16*>(P.ws + OFF_YS5PRE);
  const h16* W = reinterpret_cast<const h16*>(P.ws + OFF_WT) + (long)layer * WT_LAYER + WT_GLU;
  h16* Y = reinterpret_cast<h16*>(P.ws + OFF_YS5);
  const int MT = (layer == 0 ? TT : TLAT) / 128;
  const TileWalk tw = tw_init(MT, 6);
  for (int tile = tw.lb; tile < tw_count(tw); tile += tw.nlb) {
    int mt, nt; tw_decode(tw, tile, mt, nt);
    f32x4 acc[4][4]; acc_zero(acc);
    gemm_kloop(acc, A + (long)mt * 128 * 384, 384, 0, 128, W + (long)nt * 128 * 384, 384, 384, smem, opaque_tid());
#pragma unroll
    for (int m = 0; m < 4; ++m)
#pragma unroll
      for (int np = 0; np < 2; ++np)
#pragma unroll
        for (int j = 0; j < 4; ++j) {
          const int row = mt * 128 + wr * 64 + m * 16 + fq * 4 + j, col = nt * 64 + wc * 32 + np * 16 + fr;
          Y[(long)row * 384 + col] = (h16)(acc[m][2 * np][j] * sigmoidf_(acc[m][2 * np + 1][j]));
        }
  }
}
DI void phase_merge(const Params& P, int layer, char* smem) {
  const h16* H = reinterpret_cast<const h16*>(P.ws + OFF_H1);
  const h16* WL = reinterpret_cast<const h16*>(P.ws + OFF_WT) + (long)layer * WT_LAYER;
  h16* Mg = reinterpret_cast<h16*>(P.ws + OFF_MERGED);
  const int MT = (layer == 0 ? TT : TLAT) / 128;
  const TileWalk tw = tw_init(MT, 8);
  for (int tile = tw.lb; tile < tw_count(tw); tile += tw.nlb) {
    int mt, nt; tw_decode(tw, tile, mt, nt);
    h16* Tmp = reinterpret_cast<h16*>(P.ws + OFF_YS5PRE) + (long)blockIdx.x * 32768;
    h16* Run = Tmp + 16384;
#pragma unroll 1
    for (int br = 0; br < 3; ++br) {
      const h16* Ab; const h16* Wb; int Kb;
      if (br == 0) { Ab = reinterpret_cast<const h16*>(P.ws + OFF_YHY) + (long)mt * 128 * 384; Wb = WL + WT_BRHY + (long)nt * 128 * 384; Kb = 384; }
      else if (br == 1) { Ab = reinterpret_cast<const h16*>(P.ws + OFF_YS5) + (long)mt * 128 * 384; Wb = WL + WT_BRS5 + (long)nt * 128 * 384; Kb = 384; }
      else { Ab = reinterpret_cast<const h16*>(P.ws + OFF_YMLA) + (long)mt * 128 * 512; Wb = WL + WT_BRMLA + (long)nt * 128 * 512; Kb = 512; }
      {
        f32x4 acc[4][4]; acc_zero(acc);
        gemm_kloop(acc, Ab, Kb, 0, 128, Wb, Kb, Kb, smem, opaque_tid());
        const int tid = tidx();
#pragma unroll
        for (int m = 0; m < 4; ++m)
#pragma unroll
          for (int n = 0; n < 4; ++n) {
            h16x4 o; o[0] = (h16)acc[m][n][0]; o[1] = (h16)acc[m][n][1]; o[2] = (h16)acc[m][n][2]; o[3] = (h16)acc[m][n][3];
            *reinterpret_cast<h16x4*>(Tmp + ((m * 4 + n) * 256 + tid) * 4) = o;
          }
      }
      f32x4 acc[4][4]; acc_zero(acc);
      gemm_kloop(acc, H + (long)mt * 128 * LD1, LD1, 0, 128, WL + WT_WGATE + (long)(br * 1024 + nt * 128) * LD1, LD1, 1024, smem, opaque_tid());
      const int tid = tidx();
      h16x4 bv[16], rv[16];
#pragma unroll
      for (int q = 0; q < 16; ++q) bv[q] = *reinterpret_cast<const h16x4*>(Tmp + (q * 256 + tid) * 4);
      if (br > 0) {
#pragma unroll
        for (int q = 0; q < 16; ++q) rv[q] = *reinterpret_cast<const h16x4*>(Run + (q * 256 + tid) * 4);
      } else {
#pragma unroll
        for (int q = 0; q < 16; ++q) rv[q] = h16x4{(h16)0.f, (h16)0.f, (h16)0.f, (h16)0.f};
      }
#pragma unroll
      for (int m = 0; m < 4; ++m)
#pragma unroll
        for (int n = 0; n < 4; ++n)
#pragma unroll
          for (int j = 0; j < 4; ++j) acc[m][n][j] = (float)rv[m * 4 + n][j] + sigmoidf_(acc[m][n][j]) * (float)bv[m * 4 + n][j];
      if (br < 2) {
#pragma unroll
        for (int m = 0; m < 4; ++m)
#pragma unroll
          for (int n = 0; n < 4; ++n) {
            h16x4 o; o[0] = (h16)acc[m][n][0]; o[1] = (h16)acc[m][n][1]; o[2] = (h16)acc[m][n][2]; o[3] = (h16)acc[m][n][3];
            *reinterpret_cast<h16x4*>(Run + ((m * 4 + n) * 256 + tid) * 4) = o;
          }
      } else {
        float* Zs = reinterpret_cast<float*>(smem);
        stage_acc(acc, Zs, tid);
        copy_out_f16(Zs, Mg, (long)mt * 128, LD1, nt * 128, tid);
        __syncthreads();
      }
    }
  }
}
DI void phase_resid(const Params& P, int layer, int stage_src, size_t a_off, int K, long w_off, int gate_idx, char* smem) {
  const int tid = tidx(), lane = tid & 63, wid = tid >> 6, wr = wid >> 1, wc = wid & 1, fr = lane & 15, fq = lane >> 4;
  const h16* A = reinterpret_cast<const h16*>(P.ws + a_off);
  const h16* W = reinterpret_cast<const h16*>(P.ws + OFF_WT) + (long)layer * WT_LAYER + w_off;
  const float* mod = reinterpret_cast<const float*>(P.ws + OFF_MOD) + (long)layer * 9 * 6144 + gate_idx * 1024;
  const int MT = (layer == 0 ? TT : TLAT) / 128;
  const TileWalk tw = tw_init(MT, 8);
  for (int tile = tw.lb; tile < tw_count(tw); tile += tw.nlb) {
    int mt, nt; tw_decode(tw, tile, mt, nt);
    f32x4 acc[4][4]; acc_zero(acc);
    const int ld = K == 1024 ? LD1 : LD2;
    gemm_kloop(acc, A + (long)mt * 128 * ld, ld, 0, 128, W + (long)nt * 128 * ld, ld, K, smem, opaque_tid());
    const Tok tk = tokinfo(mt * 128);
    float* Zs = reinterpret_cast<float*>(smem);
    const int t2 = tidx();
    stage_acc(acc, Zs, t2);
    const int c4 = (t2 & 31) * 4;
    const float4 g4 = *reinterpret_cast<const float4*>(mod + tk.mrow * 6144 + nt * 128 + c4);
#pragma unroll 4
    for (int it = 0; it < 16; ++it) {
      const int row = it * 8 + (t2 >> 5); const int t = mt * 128 + row;
      const float4 a4 = *reinterpret_cast<const float4*>(Zs + row * 132 + c4);
      const float4 x4 = *reinterpret_cast<const float4*>(xrow_src(P, stage_src, t) + nt * 128 + c4);
      *reinterpret_cast<float4*>(xrow_dst(P, t) + nt * 128 + c4) = make_float4(x4.x + g4.x * a4.x, x4.y + g4.y * a4.y, x4.z + g4.z * a4.z, x4.w + g4.w * a4.w);
    }
    __syncthreads();
  }
}
DI void phase_ffn_up(const Params& P, int layer, char* smem) {
  const int tid = tidx(), lane = tid & 63, wid = tid >> 6, wr = wid >> 1, wc = wid & 1, fr = lane & 15, fq = lane >> 4;
  const h16* H = reinterpret_cast<const h16*>(P.ws + OFF_H2);
  const h16* W = reinterpret_cast<const h16*>(P.ws + OFF_WT) + (long)layer * WT_LAYER + WT_UP;
  h16* F = reinterpret_cast<h16*>(P.ws + OFF_F);
  const float* cw = P.in[I_FCW] + (long)layer * 3 * 5632; const float* cb = P.in[I_FCB] + (long)layer * 5632;
  float* Zs = reinterpret_cast<float*>(smem);
  const int n_mt = 8 * 66 + (layer == 0 ? 8 * 3 : 0);
  const TileWalk tw = tw_init(n_mt, 44);
  for (int tile = tw.lb; tile < tw_count(tw); tile += tw.nlb) {
    int mi, nt; tw_decode(tw, tile, mi, nt);
    int seq0, Ls, ti;
    if (mi < 528) { seq0 = (mi / 66) * SEQ; Ls = SEQ; ti = mi % 66; } else { const int u = mi - 528; seq0 = TLAT + (u / 3) * CTXL; Ls = CTXL; ti = u % 3; }
    const int p0 = ti * 126 - 1;
    const int a_lo = ti == 0 ? 1 : 0, a_hi = min(128, Ls - p0);
    const int nout = min(126, Ls - ti * 126);
    f32x4 acc[4][4]; acc_zero(acc);
    gemm_kloop(acc, H + ((long)seq0 + p0) * LD1, LD1, a_lo, a_hi, W + (long)nt * 128 * LD1, LD1, 1024, smem, opaque_tid());
#pragma unroll
    for (int m = 0; m < 4; ++m)
#pragma unroll
      for (int n = 0; n < 4; ++n)
#pragma unroll
        for (int j = 0; j < 4; ++j) Zs[(wr * 64 + m * 16 + fq * 4 + j) * 132 + wc * 64 + n * 16 + fr] = acc[m][n][j];
    __syncthreads();
    {
      const int jc = tid & 63, rg = tid >> 6;
      const int ucol = (jc >> 5) * 64 + ((jc >> 4) & 1) * 32 + (jc & 15), gcol = ucol + 16;
      const int cu = nt * 64 + jc, cg = 2816 + cu;
      const float wu0 = cw[cu], wu1 = cw[5632 + cu], wu2 = cw[2 * 5632 + cu], bu = cb[cu];
      const float wg0 = cw[cg], wg1 = cw[5632 + cg], wg2 = cw[2 * 5632 + cg], bg = cb[cg];
      for (int r = 1 + rg; r <= nout; r += 4) {
        const float au = wu0 * Zs[(r - 1) * 132 + ucol] + wu1 * Zs[r * 132 + ucol] + wu2 * Zs[(r + 1) * 132 + ucol] + bu;
        const float ag = wg0 * Zs[(r - 1) * 132 + gcol] + wg1 * Zs[r * 132 + gcol] + wg2 * Zs[(r + 1) * 132 + gcol] + bg;
        F[((long)seq0 + p0 + r) * LD2 + cu] = (h16)(siluf_(au) * ag);
      }
    }
    __syncthreads();
  }
}
DI void phase_norm2(const Params& P, int layer) { normmod_rows(P, layer, 1, 1, layer == 0 ? TT : TLAT, blockIdx.x, gridDim.x); }

constexpr int N_PHASES = 22;
#ifndef PROBE_REPEAT
#define PROBE_REPEAT 0u
#endif
template <int PH> DI void run_phase_t(const Params& P, char* smem) {
  asm volatile("" ::: "memory");
  if constexpr (PH == 0) phase_prologue(P, smem);
  else if constexpr (PH == 21) phase_final(P);
  else {
    constexpr int layer = (PH - 1) / 10, s = (PH - 1) % 10;
    if constexpr (s == 0) phase_norm1(P, layer, smem);
    else if constexpr (s == 1) phase_gemm_in(P, layer, smem);
    else if constexpr (s == 2) phase_mix1(P, layer, smem);
    else if constexpr (s == 3) phase_mix2(P, layer, smem);
    else if constexpr (s == 4) phase_glu(P, layer, smem);
    else if constexpr (s == 5) phase_merge(P, layer, smem);
    else if constexpr (s == 6) phase_resid(P, layer, layer, OFF_MERGED, 1024, WT_WO, 2, smem);
    else if constexpr (s == 7) phase_norm2(P, layer);
    else if constexpr (s == 8) phase_ffn_up(P, layer, smem);
    else phase_resid(P, layer, 1, OFF_F, 2816, WT_DOWN, 5, smem);
  }
}
DI void run_phase(const Params& P, int ph, char* smem) {
  switch (ph) {
#define RP(i) case i: run_phase_t<i>(P, smem); break;
    RP(0) RP(1) RP(2) RP(3) RP(4) RP(5) RP(6) RP(7) RP(8) RP(9) RP(10) RP(11) RP(12) RP(13) RP(14) RP(15) RP(16) RP(17) RP(18) RP(19) RP(20) RP(21)
#undef RP
    default: break;
  }
}
#ifndef MULTI_LAUNCH
#define MULTI_LAUNCH 0
#endif
#define XB_TMO      128
#define XB_XCNT(j)  (256  + 64 * (j))
#define XB_XSUB(j)  (1280 + 64 * (j))
#define XB_XGEN(j)  (2304 + 64 * (j))
#define XB_TOP      3328
#define XB_TOPGEN   3392
#define XCD_BAR_WORDS 3456
#define XB_SPIN_CAP (1u << 22)
#define LAS __attribute__((address_space(3)))
DI unsigned xb_ld(unsigned* p)              { return __hip_atomic_load(p, __ATOMIC_RELAXED, __HIP_MEMORY_SCOPE_AGENT); }
DI unsigned xb_add(unsigned* p, unsigned v) { return __hip_atomic_fetch_add(p, v, __ATOMIC_RELAXED, __HIP_MEMORY_SCOPE_AGENT); }
DI unsigned xb_xcc_id() { return (unsigned)__builtin_amdgcn_s_getreg((3 << 11) | 20) & 0xFu; }
#define XB_SPIN(cond, bar) do { unsigned _sp = 0; while (cond) { __builtin_amdgcn_s_sleep(1); \
    if ((++_sp & 255u) == 0u) { if (xb_ld(&(bar)[XB_TMO])) break; if (_sp > XB_SPIN_CAP) { atomicAdd(&(bar)[XB_TMO], 1u); break; } } } } while (0)
struct XcdBarrier { unsigned* bar; unsigned x; volatile LAS unsigned* st; };
DI XcdBarrier xcd_barrier_post(unsigned* bar, volatile LAS unsigned* st) {
  XcdBarrier b; b.bar = bar; b.x = xb_xcc_id(); b.st = st;
  if (threadIdx.x == 0) (void)xb_add(&bar[XB_XCNT(b.x)], 1u);
  return b;
}
DI void xcd_barrier_complete(unsigned* bar, unsigned x, unsigned& nloc, unsigned& nx) {
  const unsigned G = gridDim.x * gridDim.y * gridDim.z;
  unsigned sum, cnt, mine, sp = 0u;
  for (;;) {
    sum = 0u; cnt = 0u; mine = 0u;
#pragma unroll
    for (unsigned j = 0; j < 16; ++j) { const unsigned c = xb_ld(&bar[XB_XCNT(j)]); sum += c; cnt += (c > 0u) ? 1u : 0u; mine = (j == x) ? c : mine; }
    if (sum == G) break;
    __builtin_amdgcn_s_sleep(1);
    if ((++sp & 255u) == 0u) { if (xb_ld(&bar[XB_TMO])) break; if (sp > XB_SPIN_CAP) { atomicAdd(&bar[XB_TMO], 1u); break; } }
  }
  nloc = mine > 0u ? mine : 1u; nx = cnt > 0u ? cnt : 1u;
}
DI void xcd_barrier(const XcdBarrier& b) {
  asm volatile("s_waitcnt vmcnt(0)" ::: "memory");
  __syncthreads();
  if (threadIdx.x == 0) {
    unsigned* bar = b.bar;
    __builtin_amdgcn_s_waitcnt(0);
    unsigned nloc = b.st[0], nx = b.st[1];
    if (nloc == 0u) { xcd_barrier_complete(bar, b.x, nloc, nx); b.st[0] = nloc; b.st[1] = nx; }
    const unsigned old = xb_add(&bar[XB_XSUB(b.x)], 1u);
    const unsigned gen = old / nloc;
    if (old + 1u == (gen + 1u) * nloc) {
      __builtin_amdgcn_fence(__ATOMIC_RELEASE, "agent");
      asm volatile("s_waitcnt vmcnt(0)" ::: "memory");
      const unsigned og = xb_add(&bar[XB_TOP], 1u);
      const unsigned tg = og / nx;
      if (og + 1u == (tg + 1u) * nx) xb_add(&bar[XB_TOPGEN], 1u);
      else XB_SPIN(xb_ld(&bar[XB_TOPGEN]) == tg, bar);
      __builtin_amdgcn_fence(__ATOMIC_ACQUIRE, "agent");
      xb_add(&bar[XB_XGEN(b.x)], 1u);
      asm volatile("s_waitcnt vmcnt(0)" ::: "memory");
    } else {
      XB_SPIN(xb_ld(&bar[XB_XGEN(b.x)]) == gen, bar);
      __builtin_amdgcn_fence(__ATOMIC_ACQUIRE, "agent");
      asm volatile("s_waitcnt vmcnt(0)" ::: "memory");
    }
  }
  __syncthreads();
}
__global__ void __launch_bounds__(NTHREADS, 2) fwd_megakernel(Params P) {
  extern __shared__ __attribute__((aligned(16))) char smem[];
  cg::grid_group grid = cg::this_grid();
  volatile LAS unsigned* st = (volatile LAS unsigned*)(smem + SMEM_BYTES - 16);
  if (threadIdx.x == 0) { st[0] = 0u; st[1] = 0u; st[2] = 0u; st[3] = 0u; }
  __syncthreads();
  const XcdBarrier xb = xcd_barrier_post(reinterpret_cast<unsigned*>(P.ws + OFF_BAR), st);
  run_phase_t<0>(P, smem); grid.sync();
#define RP(i) run_phase_t<i>(P, smem); xcd_barrier(xb); if constexpr ((PROBE_REPEAT >> i) & 1) { run_phase_t<i>(P, smem); xcd_barrier(xb); }
  RP(1) RP(2) RP(3) RP(4) RP(5) RP(6) RP(7) RP(8) RP(9) RP(10) RP(11) RP(12) RP(13) RP(14) RP(15) RP(16) RP(17) RP(18) RP(19) RP(20)
#undef RP
#ifdef PROBE_SYNC
  for (int i = 0; i < PROBE_SYNC; ++i) xcd_barrier(xb);
#endif
  run_phase_t<21>(P, smem);
}
#if MULTI_LAUNCH
__global__ void __launch_bounds__(NTHREADS, 2) fwd_phase_kernel(Params P, int ph) {
  extern __shared__ __attribute__((aligned(16))) char smem[];
  run_phase(P, ph, smem);
}
#endif

extern "C" void kernel_launch(void* const* d_in, const int* in_sizes, int n_in, void* d_out, int out_size, void* d_ws, size_t ws_size,
                              hipStream_t stream) {
  static int grid_blocks = 0;
  if (!grid_blocks) {
    int dev = 0, cus = 0, per_cu = 0;
    (void)hipGetDevice(&dev);
    (void)hipDeviceGetAttribute(&cus, hipDeviceAttributeMultiprocessorCount, dev);
    (void)hipFuncSetAttribute((const void*)fwd_megakernel, hipFuncAttributeMaxDynamicSharedMemorySize, SMEM_BYTES);
#if MULTI_LAUNCH
    (void)hipFuncSetAttribute((const void*)fwd_phase_kernel, hipFuncAttributeMaxDynamicSharedMemorySize, SMEM_BYTES);
#endif
    (void)hipOccupancyMaxActiveBlocksPerMultiprocessor(&per_cu, fwd_megakernel, NTHREADS, SMEM_BYTES);
    if (per_cu > 2) per_cu = 2;
    if (per_cu < 1) per_cu = 1;
#ifdef PROBE_FORCE2
    per_cu = 2;
#endif
    grid_blocks = cus * per_cu;
    if (ws_size < OFF_END) fprintf(stderr, "workspace too small: %zu < %zu\n", ws_size, (size_t)OFF_END);
  }
  Params p{};
  for (int i = 0; i < 41; ++i) p.in[i] = (const float*)d_in[i];
  p.out = (float*)d_out; p.ws = (char*)d_ws; p.pad_ = 0;
#if MULTI_LAUNCH
  for (int ph = 0; ph < N_PHASES; ++ph) hipLaunchKernelGGL(fwd_phase_kernel, dim3(grid_blocks), dim3(NTHREADS), SMEM_BYTES, stream, p, ph);
#else
  (void)hipMemsetAsync((char*)d_ws + OFF_BAR, 0, XCD_BAR_WORDS * 4, stream);
  void* args[] = {&p};
  hipError_t e = hipLaunchCooperativeKernel((void*)fwd_megakernel, dim3(grid_blocks), dim3(NTHREADS), args, SMEM_BYTES, stream);
  if (e != hipSuccess) fprintf(stderr, "cooperative launch failed: %s (grid %d)\n", hipGetErrorString(e), grid_blocks);
#endif
}
```

```cpp
#include <hip/hip_runtime.h>
#include <hip/hip_cooperative_groups.h>
#include <cstdio>
namespace cg = cooperative_groups;

typedef _Float16 h16;
typedef _Float16 h16x8 __attribute__((ext_vector_type(8)));
typedef _Float16 h16x4 __attribute__((ext_vector_type(4)));
typedef float f32x4 __attribute__((ext_vector_type(4)));
typedef float f32x16 __attribute__((ext_vector_type(16)));
#define DI __device__ __forceinline__

constexpr int DM = 1024, NBATCH = 8, SEQ = 8192, CTXL = 256, TLAT = 65536, TCTX = 2048, TT = 67584;
constexpr int KEYS = SEQ + CTXL;
constexpr int NTHREADS = 256;
constexpr float EPS = 1e-6f;
constexpr float QSCALE = 0.10206207261596575f * 1.4426950408889634f;

constexpr int LD1 = 1088, LD2 = 2880;
constexpr long WT_WIN = 0, WT_WGATE = WT_WIN + 2432L * LD1, WT_UKV = WT_WGATE + 3072L * LD1, WT_UQ = WT_UKV + 1024L * 256,
               WT_GLU = WT_UQ + 1024L * 512, WT_BRHY = WT_GLU + 768L * 384, WT_BRS5 = WT_BRHY + 1024L * 384,
               WT_BRMLA = WT_BRS5 + 1024L * 384, WT_WO = WT_BRMLA + 1024L * 512, WT_UP = WT_WO + 1024L * LD1,
               WT_DOWN = WT_UP + 5632L * LD1, WT_LAYER = WT_DOWN + 1024L * LD2;
constexpr size_t al256(size_t x) { return (x + 255) / 256 * 256; }
constexpr size_t OFF_WT = 0;
constexpr size_t OFF_H1 = al256(OFF_WT + 2 * WT_LAYER * 2);
constexpr size_t OFF_U = al256(OFF_H1 + (size_t)TT * LD1 * 2);
constexpr size_t OFF_KVLAT = al256(OFF_U + (size_t)TT * 384 * 2);
constexpr size_t OFF_QLAT = al256(OFF_KVLAT + (size_t)TT * 256 * 2);
constexpr size_t OFF_PHY = al256(OFF_QLAT + (size_t)TT * 512 * 2);
constexpr size_t OFF_PHYC = al256(OFF_PHY + (size_t)NBATCH * 1152 * SEQ * 2);
constexpr size_t OFF_Q = al256(OFF_PHYC + (size_t)NBATCH * 1152 * CTXL * 2);
constexpr size_t OFF_K = al256(OFF_Q + (size_t)64 * KEYS * 96 * 2);
constexpr size_t OFF_VT = al256(OFF_K + (size_t)64 * KEYS * 96 * 2);
constexpr size_t OFF_YS5PRE = al256(OFF_VT + (size_t)64 * 64 * KEYS * 2);
constexpr size_t OFF_YHY = al256(OFF_YS5PRE + (size_t)TT * 384 * 2);
constexpr size_t OFF_FILT = al256(OFF_YHY + (size_t)TT * 384 * 2);
constexpr size_t OFF_TAPSC = al256(OFF_FILT + (size_t)768 * 2 * SEQ * 8);
constexpr size_t OFF_E = al256(OFF_TAPSC + (size_t)768 * 2 * CTXL * 4);
constexpr size_t OFF_XC = al256(OFF_E + (size_t)NBATCH * 2 * 24 * 132 * 64 * 8);
constexpr size_t OFF_MOD = al256(OFF_XC + (size_t)TCTX * 1024 * 4);
constexpr size_t OFF_Z2 = al256(OFF_MOD + (size_t)2 * 9 * 6144 * 4);
constexpr size_t OFF_Z2C = al256(OFF_Z2 + (size_t)2 * SEQ * 64 * 4);
constexpr size_t OFF_S5A = al256(OFF_Z2C + (size_t)2 * CTXL * 64 * 4);
constexpr size_t OFF_S5A64 = al256(OFF_S5A + (size_t)2 * 2 * 24 * 64 * 8);
constexpr size_t OFF_S5B = al256(OFF_S5A64 + (size_t)2 * 2 * 24 * 64 * 8);
constexpr size_t OFF_S5C = al256(OFF_S5B + (size_t)2 * 2 * 24 * 64 * 16 * 8);
constexpr size_t OFF_ROPE = al256(OFF_S5C + (size_t)2 * 2 * 24 * 16 * 128 * 2);
constexpr size_t OFF_BAR = al256(OFF_ROPE + (size_t)SEQ * 16 * 8);
constexpr size_t OFF_END = al256(OFF_BAR + (size_t)3456 * 4);
constexpr size_t OFF_YS5 = OFF_U, OFF_YMLA = OFF_QLAT, OFF_MERGED = OFF_Q, OFF_F = OFF_U, OFF_H2 = OFF_H1;
static_assert(OFF_END <= (size_t)1024 * 1024 * 1024, "workspace over 1 GiB");
static_assert(OFF_F + (size_t)TT * LD2 * 2 <= OFF_FILT, "f alias overruns");
static_assert(OFF_MERGED + (size_t)TT * LD1 * 2 <= OFF_VT, "merged alias overruns");

constexpr int SMEM_BYTES = 73728 + 2048;

struct Params {
  const float* in[41];
  float* out;
  char* ws;
  unsigned long long pad_;
};
enum { I_X = 0, I_C, I_CTX, I_CCTX, I_WMOD, I_BMOD, I_N1G, I_N2G, I_WIN, I_HCW, I_HCB, I_FW1, I_FB1, I_FW2, I_FB2, I_FW3, I_FFREQ,
       I_FDECAY, I_HBIAS, I_LAMRE, I_LAMIM, I_LOGSTEP, I_BRE, I_BIM, I_CRE, I_CIM, I_S5D, I_WGLU, I_GQ, I_WUQ, I_GKV, I_WUKV,
       I_WBRHY, I_WBRS5, I_WBRMLA, I_WO, I_WUP, I_FCW, I_FCB, I_WDOWN, I_FINALG };

DI int tidx() { int t = threadIdx.x; asm volatile("" : "+v"(t)); return t; }
DI int opaque_tid() { return tidx(); }
DI float sigmoidf_(float x) { return 1.f / (1.f + __expf(-x)); }
DI float siluf_(float x) { return x / (1.f + __expf(-x)); }
DI float geluf_(float x) { float z = 0.7978845608028654f * (x + 0.044715f * x * x * x); float t = 1.f - 2.f / (1.f + __expf(2.f * z)); return 0.5f * x * (1.f + t); }
DI float wave_sum(float v) { for (int o = 32; o > 0; o >>= 1) v += __shfl_xor(v, o); return v; }
DI float wave_max(float v) { for (int o = 32; o > 0; o >>= 1) v = fmaxf(v, __shfl_xor(v, o)); return v; }
DI void dsincos(double x, double& s, double& c) {
  const double TWO_PI = 6.283185307179586476925287;
  double r = x - TWO_PI * rint(x / TWO_PI);
  double r2 = r * r, ts = r, tc = 1.0; s = r; c = 1.0;
  for (int k = 1; k <= 15; ++k) { tc = -tc * r2 / (double)((2 * k - 1) * (2 * k)); c += tc; ts = -ts * r2 / (double)((2 * k) * (2 * k + 1)); s += ts; }
}
DI float2 twid(float f) { return make_float2(__builtin_amdgcn_cosf(f), __builtin_amdgcn_sinf(f)); }
DI float2 cmul(float2 a, float2 b) { return make_float2(a.x * b.x - a.y * b.y, a.x * b.y + a.y * b.x); }

struct Tok { int b, pos, ctx, mrow; };
DI Tok tokinfo(int t) { Tok k; if (t < TLAT) { k.b = t >> 13; k.pos = t & 8191; k.ctx = 0; k.mrow = k.b; } else { int u = t - TLAT; k.b = u >> 8; k.pos = u & 255; k.ctx = 1; k.mrow = 8; } return k; }

struct Stg { uint4 a0, a1, a2, a3, b0, b1, b2, b3; };
DI void g_load(Stg& s, const h16* __restrict__ A0, const h16* __restrict__ A1, const h16* __restrict__ A2, const h16* __restrict__ A3,
               const h16* __restrict__ Bp, long b32, int k0) {
  s.a0 = *reinterpret_cast<const uint4*>(A0 + k0); s.a1 = *reinterpret_cast<const uint4*>(A1 + k0);
  s.a2 = *reinterpret_cast<const uint4*>(A2 + k0); s.a3 = *reinterpret_cast<const uint4*>(A3 + k0);
  s.b0 = *reinterpret_cast<const uint4*>(Bp + k0); s.b1 = *reinterpret_cast<const uint4*>(Bp + b32 + k0);
  s.b2 = *reinterpret_cast<const uint4*>(Bp + 2 * b32 + k0); s.b3 = *reinterpret_cast<const uint4*>(Bp + 3 * b32 + k0);
}
DI uint4 zsel(uint4 v, bool ok) { return ok ? v : make_uint4(0, 0, 0, 0); }
DI void s_write(char* sw, const Stg& s, int okm) {
  *reinterpret_cast<uint4*>(sw) = zsel(s.a0, okm & 1); *reinterpret_cast<uint4*>(sw + 32 * 128) = zsel(s.a1, okm & 2);
  *reinterpret_cast<uint4*>(sw + 64 * 128) = zsel(s.a2, okm & 4); *reinterpret_cast<uint4*>(sw + 96 * 128) = zsel(s.a3, okm & 8);
  *reinterpret_cast<uint4*>(sw + 16384) = s.b0; *reinterpret_cast<uint4*>(sw + 16384 + 32 * 128) = s.b1; *reinterpret_cast<uint4*>(sw + 16384 + 64 * 128) = s.b2; *reinterpret_cast<uint4*>(sw + 16384 + 96 * 128) = s.b3;
}
#ifndef PROBE_MFMA
#define PROBE_MFMA 0
#endif
#if PROBE_MFMA
DI void mma_step(f32x4 (&acc)[4][4], const char* sa, const char* sb, int o0, int o1, f32x4 (&dmy)[2][4]) {
#else
DI void mma_step(f32x4 (&acc)[4][4], const char* sa, const char* sb, int o0, int o1) {
#endif
#pragma unroll
  for (int ks = 0; ks < 2; ++ks) {
    h16x8 af[4], bf[4];
    const int o = ks ? o1 : o0;
#pragma unroll
    for (int m = 0; m < 4; ++m) af[m] = *reinterpret_cast<const h16x8*>(sa + m * 16 * 128 + o);
#pragma unroll
    for (int n = 0; n < 4; ++n) bf[n] = *reinterpret_cast<const h16x8*>(sb + n * 16 * 128 + o);
#pragma unroll
    for (int m = 0; m < 4; ++m)
#pragma unroll
      for (int n = 0; n < 4; ++n) acc[m][n] = __builtin_amdgcn_mfma_f32_16x16x32_f16(af[m], bf[n], acc[m][n], 0, 0, 0);
#if PROBE_MFMA
#pragma unroll
    for (int m = 0; m < 2; ++m)
#pragma unroll
      for (int n = 0; n < 4; ++n) dmy[m][n] = __builtin_amdgcn_mfma_f32_16x16x32_f16(af[m + 2], bf[n], dmy[m][n], 0, 0, 0);
#endif
  }
}
DI void gemm_kloop_body(f32x4 (&acc)[4][4], const h16* __restrict__ A, long lda, int a_lo, int a_hi,
                   const h16* __restrict__ Bt, long ldb, int K, char* smem, int tid) {
  const int lane = tid & 63, wid = tid >> 6, wr = wid >> 1, wc = wid & 1, fr = lane & 15, fq = lane >> 4;
#if PROBE_MFMA
  f32x4 dmy[2][4];
  for (int m = 0; m < 2; ++m) for (int n = 0; n < 4; ++n) dmy[m][n] = f32x4{0.f, 0.f, 0.f, 0.f};
#define MMA(a, b, c, d, e) mma_step(a, b, c, d, e, dmy)
#else
#define MMA(a, b, c, d, e) mma_step(a, b, c, d, e)
#endif
  Stg s0, s1;
  const int srow = tid >> 3, skc = tid & 7;
  int okm = 0;
  const h16* Ar[4];
#pragma unroll
  for (int i = 0; i < 4; ++i) { const int row = srow + 32 * i; const bool ok = row >= a_lo && row < a_hi; okm |= ok ? (1 << i) : 0;
    const int rc = min(max(row, a_lo), a_hi - 1); Ar[i] = A + (long)rc * lda + skc * 8; }
  const h16* Bp = Bt + (long)srow * ldb + skc * 8;
  const long b32 = 32 * ldb;
  char* sw = smem + srow * 128 + ((skc ^ ((srow >> 1) & 7)) << 4);
  const char* sra = smem + (wr * 64 + fr) * 128; const char* srb = smem + 16384 + (wc * 64 + fr) * 128;
  const int o0 = (fq ^ ((fr >> 1) & 7)) << 4, o1 = ((4 + fq) ^ ((fr >> 1) & 7)) << 4;
  const int nk = K >> 6;
  g_load(s0, Ar[0], Ar[1], Ar[2], Ar[3], Bp, b32, 0); g_load(s1, Ar[0], Ar[1], Ar[2], Ar[3], Bp, b32, 64);
  s_write(sw, s0, okm); __syncthreads();
  for (int kt = 0; kt + 2 < nk; kt += 2) {
    g_load(s0, Ar[0], Ar[1], Ar[2], Ar[3], Bp, b32, (kt + 2) << 6);
    __builtin_amdgcn_sched_barrier(0);
    MMA(acc, sra, srb, o0, o1);
    __builtin_amdgcn_sched_barrier(0);
    s_write(sw + 32768, s1, okm);
    __syncthreads();
    g_load(s1, Ar[0], Ar[1], Ar[2], Ar[3], Bp, b32, (kt + 3) << 6);
    __builtin_amdgcn_sched_barrier(0);
    MMA(acc, sra + 32768, srb + 32768, o0, o1);
    __builtin_amdgcn_sched_barrier(0);
    s_write(sw, s0, okm);
    __syncthreads();
  }
  MMA(acc, sra, srb, o0, o1);
  s_write(sw + 32768, s1, okm);
  __syncthreads();
  MMA(acc, sra + 32768, srb + 32768, o0, o1);
  __syncthreads();
#if PROBE_MFMA
  { float z = 0.f; asm volatile("" : "+v"(z)); for (int m = 0; m < 2; ++m) for (int n = 0; n < 4; ++n) acc[m][n] += dmy[m][n] * z; }
#endif
#undef MMA
}
#ifndef PROBE_KLOOP
#define PROBE_KLOOP 0
#endif
DI void gemm_kloop(f32x4 (&acc)[4][4], const h16* __restrict__ A, long lda, int a_lo, int a_hi,
                   const h16* __restrict__ Bt, long ldb, int K, char* smem, int tid) {
  gemm_kloop_body(acc, A, lda, a_lo, a_hi, Bt, ldb, K, smem, tid);
}
struct TileWalk { int lb, nlb, m0, Mx, NT, nfull; };
DI TileWalk tw_init(int MT, int NT) { TileWalk w; w.lb = blockIdx.x >> 3; w.nlb = gridDim.x >> 3; w.Mx = MT >> 3; w.m0 = (blockIdx.x & 7) * w.Mx; w.NT = NT; w.nfull = (w.Mx >> 3) * 8 * NT; return w; }
DI int tw_count(const TileWalk& w) { return w.Mx * w.NT; }
DI void tw_decode(const TileWalk& w, int idx, int& mt, int& nt) {
  if (idx < w.nfull) { const int mg = idx / (8 * w.NT), r = idx % (8 * w.NT); nt = r >> 3; mt = w.m0 + mg * 8 + (r & 7); }
  else { const int rem = w.Mx & 7, r = idx - w.nfull; nt = r / rem; mt = w.m0 + (w.Mx & ~7) + r % rem; }
}
DI void stage_acc(const f32x4 (&acc)[4][4], float* Zs, int tid) {
  const int lane = tid & 63, wid = tid >> 6, wr = wid >> 1, wc = wid & 1, fr = lane & 15, fq = lane >> 4;
#pragma unroll
  for (int m = 0; m < 4; ++m)
#pragma unroll
    for (int n = 0; n < 4; ++n)
#pragma unroll
      for (int j = 0; j < 4; ++j) Zs[(wr * 64 + m * 16 + fq * 4 + j) * 132 + wc * 64 + n * 16 + fr] = acc[m][n][j];
  __syncthreads();
}
DI void stage_acc_t(const f32x4 (&acc)[4][4], float* Zs, int tid) {
  const int lane = tid & 63, wid = tid >> 6, wr = wid >> 1, wc = wid & 1, fr = lane & 15, fq = lane >> 4;
#pragma unroll
  for (int m = 0; m < 4; ++m)
#pragma unroll
    for (int n = 0; n < 4; ++n)
      *reinterpret_cast<float4*>(Zs + (wc * 64 + n * 16 + fr) * 132 + wr * 64 + m * 16 + fq * 4) = make_float4(acc[m][n][0], acc[m][n][1], acc[m][n][2], acc[m][n][3]);
  __syncthreads();
}
DI void copy_out_f16(const float* Zs, h16* __restrict__ dst, long row0, long ld, int cb, int tid) {
#pragma unroll
  for (int it = 0; it < 8; ++it) {
    const int chunk = it * 256 + tid, row = chunk >> 4, c8 = (chunk & 15) * 8;
    const float4 x0 = *reinterpret_cast<const float4*>(Zs + row * 132 + c8), x1 = *reinterpret_cast<const float4*>(Zs + row * 132 + c8 + 4);
    h16x8 o; o[0] = (h16)x0.x; o[1] = (h16)x0.y; o[2] = (h16)x0.z; o[3] = (h16)x0.w; o[4] = (h16)x1.x; o[5] = (h16)x1.y; o[6] = (h16)x1.z; o[7] = (h16)x1.w;
    *reinterpret_cast<h16x8*>(dst + (row0 + row) * ld + cb + c8) = o;
  }
}
DI void acc_zero(f32x4 (&acc)[4][4]) {
#pragma unroll
  for (int m = 0; m < 4; ++m)
#pragma unroll
    for (int n = 0; n < 4; ++n) acc[m][n] = f32x4{0.f, 0.f, 0.f, 0.f};
}
DI void row_rms(const h16* __restrict__ A, long lda, int K, float* rs) {
  const int tid = tidx(), row = tid >> 1, half = tid & 1;
  const h16* p = A + (long)row * lda + half * (K >> 1);
  float ss = 0.f;
  for (int k = 0; k < (K >> 1); k += 8) {
    h16x8 v = *reinterpret_cast<const h16x8*>(p + k);
#pragma unroll
    for (int j = 0; j < 8; ++j) { float f = (float)v[j]; ss += f * f; }
  }
  ss += __shfl_xor(ss, 1);
  if (half == 0) rs[row] = rsqrtf(ss / (float)K + EPS);
}
DI int map_interleave(int n, int half) { int tile = n >> 7, r = n & 127, sub = r >> 4, fr = r & 15; int j = tile * 64 + (sub >> 1) * 16 + fr; return (sub & 1) ? half + j : j; }
DI int map_col(int mat, int n) {
  switch (mat) {
    case 0: if (n < 640) return n; if (n < 2304) return n + 32; if (n < 2336) return n - 2304 + 640; return -1;
    case 1: return 2336 + n;
    case 3: { int h = n >> 7, j = n & 127; return j < 96 ? h * 96 + j : -1; }
    case 4: return map_interleave(n, 384);
    case 9: return map_interleave(n, 2816);
    default: return n;
  }
}
struct MatDesc { const float* src; const float* scale; long dst; int K, Nmy, Nsrc, ld; };
DI MatDesc get_mat(const Params& P, int layer, int mat) {
  MatDesc d; d.scale = nullptr;
  d.ld = (mat == 0 || mat == 1 || mat == 8 || mat == 9) ? LD1 : 0;
  switch (mat) {
    case 0: d.src = P.in[I_WIN] + (long)layer * 1024 * 5408; d.dst = WT_WIN; d.K = 1024; d.Nmy = 2432; d.Nsrc = 5408; break;
    case 1: d.src = P.in[I_WIN] + (long)layer * 1024 * 5408; d.dst = WT_WGATE; d.K = 1024; d.Nmy = 3072; d.Nsrc = 5408; break;
    case 2: d.src = P.in[I_WUKV] + (long)layer * 256 * 1024; d.dst = WT_UKV; d.K = 256; d.Nmy = 1024; d.Nsrc = 1024; d.scale = P.in[I_GKV] + layer * 256; break;
    case 3: d.src = P.in[I_WUQ] + (long)layer * 512 * 768; d.dst = WT_UQ; d.K = 512; d.Nmy = 1024; d.Nsrc = 768; d.scale = P.in[I_GQ] + layer * 512; break;
    case 4: d.src = P.in[I_WGLU] + (long)layer * 384 * 768; d.dst = WT_GLU; d.K = 384; d.Nmy = 768; d.Nsrc = 768; break;
    case 5: d.src = P.in[I_WBRHY] + (long)layer * 384 * 1024; d.dst = WT_BRHY; d.K = 384; d.Nmy = 1024; d.Nsrc = 1024; break;
    case 6: d.src = P.in[I_WBRS5] + (long)layer * 384 * 1024; d.dst = WT_BRS5; d.K = 384; d.Nmy = 1024; d.Nsrc = 1024; break;
    case 7: d.src = P.in[I_WBRMLA] + (long)layer * 512 * 1024; d.dst = WT_BRMLA; d.K = 512; d.Nmy = 1024; d.Nsrc = 1024; break;
    case 8: d.src = P.in[I_WO] + (long)layer * 1024 * 1024; d.dst = WT_WO; d.K = 1024; d.Nmy = 1024; d.Nsrc = 1024; break;
    case 9: d.src = P.in[I_WUP] + (long)layer * 1024 * 5632; d.dst = WT_UP; d.K = 1024; d.Nmy = 5632; d.Nsrc = 5632; break;
    default: d.src = P.in[I_WDOWN] + (long)layer * 2816 * 1024; d.dst = WT_DOWN; d.K = 2816; d.Nmy = 1024; d.Nsrc = 1024; d.ld = LD2; break;
  }
  if (d.ld == 0) d.ld = d.K;
  return d;
}
constexpr int WT_TILES_PER_LAYER = 608 + 768 + 64 + 128 + 72 + 96 + 96 + 128 + 256 + 1408 + 704;
DI void item_wt(const Params& P, int item, char* smem) {
  const int layer = item / WT_TILES_PER_LAYER; int r = item % WT_TILES_PER_LAYER;
  const int cnt[11] = {608, 768, 64, 128, 72, 96, 96, 128, 256, 1408, 704};
  int mat = 0;
#pragma unroll
  for (int i = 0; i < 10; ++i) { if (mat == i && r >= cnt[i]) { r -= cnt[i]; mat = i + 1; } }
  MatDesc d = get_mat(P, layer, mat);
  const int kt = d.K >> 6, n0 = (r / kt) * 64, k0 = (r % kt) * 64;
  float* tile = reinterpret_cast<float*>(smem);
  h16* dst = reinterpret_cast<h16*>(P.ws + OFF_WT) + (long)layer * WT_LAYER + d.dst;
  const int tid = tidx(), lx = tid & 63, ly = tid >> 6;
  const int sc = map_col(mat, n0 + lx);
#pragma unroll 4
  for (int i = 0; i < 16; ++i) { int kk = i * 4 + ly; tile[kk * 65 + lx] = sc >= 0 ? d.src[(long)(k0 + kk) * d.Nsrc + sc] : 0.f; }
  __syncthreads();
  const float s = d.scale ? d.scale[k0 + lx] : 1.f;
#pragma unroll 4
  for (int i = 0; i < 16; ++i) { int nn = i * 4 + ly; dst[(long)(n0 + nn) * d.ld + k0 + lx] = (h16)(tile[lx * 65 + nn] * s); }
  __syncthreads();
}
DI void item_mod(const Params& P, int item, char* smem) {
  const int layer = item / 96, n0 = (item % 96) * 64;
  float* s = reinterpret_cast<float*>(smem);
  float* part = s + 9 * 1024;
  const int tid = tidx(), lane = tid & 63, wid = tid >> 6;
  for (int i = tid; i < 9 * 1024; i += NTHREADS) { float v = i < 8192 ? P.in[I_C][i] : P.in[I_CCTX][i - 8192]; s[i] = siluf_(v); }
  __syncthreads();
  const float* w = P.in[I_WMOD] + (long)layer * 1024 * 6144 + n0 + lane;
  float acc[9];
#pragma unroll
  for (int r = 0; r < 9; ++r) acc[r] = 0.f;
  for (int k = wid * 256; k < wid * 256 + 256; ++k) {
    const float wv = w[(long)k * 6144];
#pragma unroll
    for (int r = 0; r < 9; ++r) acc[r] += s[r * 1024 + k] * wv;
  }
#pragma unroll
  for (int r = 0; r < 9; ++r) part[(wid * 9 + r) * 64 + lane] = acc[r];
  __syncthreads();
  float* mod = reinterpret_cast<float*>(P.ws + OFF_MOD) + (long)layer * 9 * 6144;
  for (int i = tid; i < 9 * 64; i += NTHREADS) {
    const int r = i >> 6, c = i & 63;
    mod[r * 6144 + n0 + c] = part[(0 * 9 + r) * 64 + c] + part[(1 * 9 + r) * 64 + c] + part[(2 * 9 + r) * 64 + c] + part[(3 * 9 + r) * 64 + c] + P.in[I_BMOD][layer * 6144 + n0 + c];
  }
  __syncthreads();
}
DI void item_hymlp(const Params& P, int item, char* smem) {
  const int layer = item / 132; int r = item % 132;
  const int isc = r >= 128; const int Lf = isc ? CTXL : SEQ; const int t0 = (isc ? r - 128 : r) * 64;
  float* z1 = reinterpret_cast<float*>(smem);
  const int tid = tidx(), tl = tid >> 2, h0 = (tid & 3) * 16; const int t = t0 + tl;
  const float* w1 = P.in[I_FW1] + layer * 17 * 64; const float* b1 = P.in[I_FB1] + layer * 64;
  const float* w2 = P.in[I_FW2] + layer * 64 * 64; const float* b2 = P.in[I_FB2] + layer * 64; const float* fq = P.in[I_FFREQ] + layer * 64;
  float feat[17]; feat[0] = (float)t / (float)Lf;
#pragma unroll
  for (int k = 1; k <= 8; ++k) { float rev = (float)((t * k) % Lf) / (float)Lf; feat[k] = __builtin_amdgcn_cosf(rev); feat[8 + k] = __builtin_amdgcn_sinf(rev); }
#pragma unroll 4
  for (int j = 0; j < 16; ++j) {
    const int h = h0 + j; float a = b1[h];
#pragma unroll
    for (int f = 0; f < 17; ++f) a += feat[f] * w1[f * 64 + h];
    z1[tl * 65 + h] = __sinf(fq[h] * a);
  }
  __syncthreads();
  float* z2 = isc ? reinterpret_cast<float*>(P.ws + OFF_Z2C) + (long)layer * CTXL * 64 : reinterpret_cast<float*>(P.ws + OFF_Z2) + (long)layer * SEQ * 64;
  float a2[16];
#pragma unroll
  for (int j = 0; j < 16; ++j) a2[j] = b2[h0 + j];
  for (int k = 0; k < 64; ++k) {
    const float zv = z1[tl * 65 + k];
#pragma unroll
    for (int j = 0; j < 16; ++j) a2[j] += zv * w2[k * 64 + h0 + j];
  }
#pragma unroll
  for (int j = 0; j < 16; ++j) z2[(long)t * 64 + h0 + j] = __sinf(fq[h0 + j] * a2[j]);
  __syncthreads();
}
DI void item_s5disc(const Params& P, int item) {
  const int layer = item / 12, dir = (item % 12) / 6, gb = item % 6;
  const int tid = tidx(), g = gb * 4 + (tid >> 6), n = tid & 63;
  const int ld = layer * 2 + dir; const long gi = (long)ld * 24 + g;
  const double lre = P.in[I_LAMRE][gi * 64 + n], lim = P.in[I_LAMIM][gi * 64 + n];
  const double step = exp((double)P.in[I_LOGSTEP][gi]);
  double sn, cs; dsincos(lim * step, sn, cs);
  const double mag = exp(lre * step);
  const double are = mag * cs, aim = mag * sn;
  const double nr = are - 1.0, ni = aim, den = lre * lre + lim * lim;
  const double fre = (nr * lre + ni * lim) / den, fim = (ni * lre - nr * lim) / den;
  float2* A = reinterpret_cast<float2*>(P.ws + OFF_S5A); float2* A64 = reinterpret_cast<float2*>(P.ws + OFF_S5A64);
  A[gi * 64 + n] = make_float2((float)are, (float)aim);
  double pr = are, pi = aim;
  for (int i = 0; i < 6; ++i) { double t = pr * pr - pi * pi; pi = 2.0 * pr * pi; pr = t; }
  A64[gi * 64 + n] = make_float2((float)pr, (float)pi);
  float2* Bb = reinterpret_cast<float2*>(P.ws + OFF_S5B) + (gi * 64 + n) * 16;
  const float* bre = P.in[I_BRE] + (gi * 64 + n) * 16; const float* bim = P.in[I_BIM] + (gi * 64 + n) * 16;
  for (int c = 0; c < 16; ++c) { double br = bre[c], bi = bim[c]; Bb[c] = make_float2((float)(fre * br - fim * bi), (float)(fre * bi + fim * br)); }
  h16* Ct = reinterpret_cast<h16*>(P.ws + OFF_S5C) + gi * 16 * 128;
  const float* cre = P.in[I_CRE] + gi * 16 * 64; const float* cim = P.in[I_CIM] + gi * 16 * 64;
  for (int c = 0; c < 16; ++c) { Ct[c * 128 + n] = (h16)cre[c * 64 + n]; Ct[c * 128 + 64 + n] = (h16)(-cim[c * 64 + n]); }
}
DI void item_rope(const Params& P, int item) {
  const int idx = item * NTHREADS + tidx(); const int pos = idx >> 4, i = idx & 15;
  const double inv[8] = {1.0, 0.31622776601683794, 0.1, 0.031622776601683794, 0.01, 0.0031622776601683794, 0.001, 0.00031622776601683794};
  double iv = 1.0;
#pragma unroll
  for (int k = 0; k < 8; ++k) if ((i & 7) == k) iv = inv[k];
  const double ang = (double)(i < 8 ? (pos >> 6) : (pos & 63)) * iv;
  double s, c; dsincos(ang, s, c);
  reinterpret_cast<float2*>(P.ws + OFF_ROPE)[idx] = make_float2((float)c, (float)s);
}
constexpr int PRO_N_WT = 2 * WT_TILES_PER_LAYER, PRO_N_MOD = 192, PRO_N_HY = 264, PRO_N_S5 = 24, PRO_N_ROPE = 512;
DI void phase_prologue(const Params& P, char* smem) {
  const int total = PRO_N_MOD + PRO_N_HY + PRO_N_S5 + PRO_N_ROPE + PRO_N_WT;
  for (int it = blockIdx.x; it < total; it += gridDim.x) {
    int i = it;
    if (i < PRO_N_MOD) { item_mod(P, i, smem); continue; } i -= PRO_N_MOD;
    if (i < PRO_N_HY) { item_hymlp(P, i, smem); continue; } i -= PRO_N_HY;
    if (i < PRO_N_S5) { item_s5disc(P, i); continue; } i -= PRO_N_S5;
    if (i < PRO_N_ROPE) { item_rope(P, i); continue; } i -= PRO_N_ROPE;
    item_wt(P, i, smem);
  }
}

DI const float* xrow_src(const Params& P, int layer_stage, int t) {
  if (t < TLAT) return (layer_stage == 0 ? P.in[I_X] : P.out) + (long)t * 1024;
  return (layer_stage == 0 ? P.in[I_CTX] : reinterpret_cast<const float*>(P.ws + OFF_XC)) + (long)(t - TLAT) * 1024;
}
DI float* xrow_dst(const Params& P, int t) {
  if (t < TLAT) return P.out + (long)t * 1024;
  return reinterpret_cast<float*>(P.ws + OFF_XC) + (long)(t - TLAT) * 1024;
}
DI void normmod_rows(const Params& P, int layer, int which, int stage, int ntok, int item, int nitems_stride) {
  const int tid = tidx(), lane = tid & 63, wid = tid >> 6;
  const float* g = P.in[which ? I_N2G : I_N1G] + layer * 1024;
  const float* mod = reinterpret_cast<const float*>(P.ws + OFF_MOD) + (long)layer * 9 * 6144;
  h16* H = reinterpret_cast<h16*>(P.ws + OFF_H1);
  for (int rg = item; rg * 4 < ntok; rg += nitems_stride) {
    const int t = rg * 4 + wid;
    const Tok k = tokinfo(t);
    const float* xr = xrow_src(P, stage, t);
    const float* sh = mod + k.mrow * 6144 + (which ? 3 : 0) * 1024; const float* sc = sh + 1024;
    float4 v[4]; float ss = 0.f;
#pragma unroll
    for (int i = 0; i < 4; ++i) { v[i] = *reinterpret_cast<const float4*>(xr + i * 256 + lane * 4); ss += v[i].x * v[i].x + v[i].y * v[i].y + v[i].z * v[i].z + v[i].w * v[i].w; }
    ss = wave_sum(ss);
    const float r = rsqrtf(ss * (1.f / 1024.f) + EPS);
#pragma unroll
    for (int i = 0; i < 4; ++i) {
      const int c = i * 256 + lane * 4;
      const float4 gg = *reinterpret_cast<const float4*>(g + c), s1 = *reinterpret_cast<const float4*>(sc + c), s0 = *reinterpret_cast<const float4*>(sh + c);
      h16x4 o;
      o[0] = (h16)(v[i].x * r * gg.x * (1.f + s1.x) + s0.x); o[1] = (h16)(v[i].y * r * gg.y * (1.f + s1.y) + s0.y);
      o[2] = (h16)(v[i].z * r * gg.z * (1.f + s1.z) + s0.z); o[3] = (h16)(v[i].w * r * gg.w * (1.f + s1.w) + s0.w);
      *reinterpret_cast<h16x4*>(H + (long)t * LD1 + c) = o;
    }
  }
}
DI void phase_final(const Params& P) {
  const int lane = tidx() & 63, wid = tidx() >> 6;
  const float* g = P.in[I_FINALG];
  for (int rg = blockIdx.x; rg * 4 < TLAT; rg += gridDim.x) {
    float* xr = P.out + (long)(rg * 4 + wid) * 1024;
    float4 v[4]; float ss = 0.f;
#pragma unroll
    for (int i = 0; i < 4; ++i) { v[i] = *reinterpret_cast<const float4*>(xr + i * 256 + lane * 4); ss += v[i].x * v[i].x + v[i].y * v[i].y + v[i].z * v[i].z + v[i].w * v[i].w; }
    ss = wave_sum(ss);
    const float r = rsqrtf(ss * (1.f / 1024.f) + EPS);
#pragma unroll
    for (int i = 0; i < 4; ++i) {
      const int c = i * 256 + lane * 4; const float4 gg = *reinterpret_cast<const float4*>(g + c);
      *reinterpret_cast<float4*>(xr + c) = make_float4(v[i].x * r * gg.x, v[i].y * r * gg.y, v[i].z * r * gg.z, v[i].w * r * gg.w);
    }
  }
}
DI float2 r8(int idx) { const float c = 0.70710678118654752f; return idx == 0 ? make_float2(1.f, 0.f) : idx == 1 ? make_float2(c, -c) : idx == 2 ? make_float2(0.f, -1.f) : make_float2(-c, -c); }
DI float2 cmul_r8(float2 w, int idx, bool cj) {
  if (idx == 0) return w;
  float2 r = r8(idx); if (cj) r.y = -r.y;
  return cmul(w, r);
}
template <int S> DI void fft_dif_pass(float2* X, int h) {
  const int hs = h >> (S - 1);
#pragma unroll 1
  for (int item = tidx(); item < (8192 >> S); item += NTHREADS) {
    const int j = item % hs, blk = item / hs, i0 = blk * 2 * h + j;
    float2 v[1 << S];
#pragma unroll
    for (int k = 0; k < (1 << S); ++k) v[k] = X[i0 + k * hs];
    float2 wp[S];
    wp[0] = twid(-(float)j / (float)(2 * h));
#pragma unroll
    for (int q = 1; q < S; ++q) wp[q] = cmul(wp[q - 1], wp[q - 1]);
#pragma unroll
    for (int q = 0; q < S; ++q) {
      const int dist = 1 << (S - 1 - q);
#pragma unroll
      for (int k = 0; k < (1 << S); ++k) {
        if (k & dist) continue;
        const float2 a = v[k], b = v[k + dist];
        const int m = k & (dist - 1);
        const float2 tw = cmul_r8(wp[q], m << (3 - (S - q)), false);
        v[k] = make_float2(a.x + b.x, a.y + b.y);
        v[k + dist] = cmul(make_float2(a.x - b.x, a.y - b.y), tw);
      }
    }
#pragma unroll
    for (int k = 0; k < (1 << S); ++k) X[i0 + k * hs] = v[k];
  }
  __syncthreads();
}
template <int S> DI void fft_dit_pass(float2* X, int hs) {
  const int hmax = hs << (S - 1);
#pragma unroll 1
  for (int item = tidx(); item < (8192 >> S); item += NTHREADS) {
    const int j = item % hs, blk = item / hs, i0 = blk * 2 * hmax + j;
    float2 v[1 << S];
#pragma unroll
    for (int k = 0; k < (1 << S); ++k) v[k] = X[i0 + k * hs];
    float2 bp[S];
    bp[S - 1] = twid((float)j / (float)(2 * hmax));
#pragma unroll
    for (int q = S - 2; q >= 0; --q) bp[q] = cmul(bp[q + 1], bp[q + 1]);
#pragma unroll
    for (int q = 0; q < S; ++q) {
      const int dist = 1 << q;
#pragma unroll
      for (int k = 0; k < (1 << S); ++k) {
        if (k & dist) continue;
        const int m = k & (dist - 1);
        const float2 tw = cmul_r8(bp[q], m << (3 - (q + 1)), true);
        const float2 a = v[k], b = cmul(v[k + dist], tw);
        v[k] = make_float2(a.x + b.x, a.y + b.y);
        v[k + dist] = make_float2(a.x - b.x, a.y - b.y);
      }
    }
#pragma unroll
    for (int k = 0; k < (1 << S); ++k) X[i0 + k * hs] = v[k];
  }
  __syncthreads();
}
DI void fft_fwd1(float2* X) { fft_dif_pass<3>(X, 4096); fft_dif_pass<3>(X, 512); fft_dif_pass<3>(X, 64); fft_dif_pass<2>(X, 8); fft_dif_pass<2>(X, 2); }
DI void fft_inv(float2* X) { fft_dit_pass<2>(X, 1); fft_dit_pass<2>(X, 4); fft_dit_pass<3>(X, 16); fft_dit_pass<3>(X, 128); fft_dit_pass<3>(X, 1024); }
#ifndef PROBE_FFT
#define PROBE_FFT 0
#endif
DI void fft_fwd(float2* X) {
#if PROBE_FFT
  fft_fwd1(X); fft_inv(X);
  for (int i = tidx(); i < 8192; i += NTHREADS) { float2 v = X[i]; X[i] = make_float2(v.x * (1.f / 8192.f), v.y * (1.f / 8192.f)); }
  __syncthreads();
#endif
  fft_fwd1(X);
}

DI float block_sum(float v, float* red) {
  v = wave_sum(v);
  __syncthreads();
  if ((tidx() & 63) == 0) red[tidx() >> 6] = v;
  __syncthreads();
  const float r = red[0] + red[1] + red[2] + red[3];
  __syncthreads();
  return r;
}
DI void item_filter(const Params& P, int layer, int oc, char* smem) {
  float2* X = reinterpret_cast<float2*>(smem); float* red = reinterpret_cast<float*>(smem + 65536);
  const int tid = tidx();
  const float* z2 = reinterpret_cast<const float*>(P.ws + OFF_Z2) + (long)layer * SEQ * 64;
  const float* w3 = P.in[I_FW3] + (long)layer * 64 * 1536; const float* dec = P.in[I_FDECAY] + layer * 1536;
  const int colf = oc, colb = 768 + oc;
  const float df = fabsf(dec[colf]), db = fabsf(dec[colb]);
  float lsum = 0.f;
#pragma unroll 2
  for (int i = 0; i < 32; ++i) {
    const int t = tid + 256 * i; const float* zr = z2 + (long)t * 64;
    float af = 0.f, ab = 0.f;
#pragma unroll 8
    for (int k = 0; k < 64; ++k) { const float z = zr[k]; af += z * w3[k * 1536 + colf]; ab += z * w3[k * 1536 + colb]; }
    const float tn = (float)t * (1.f / 8192.f);
    af *= __expf(-tn * df); ab *= __expf(-tn * db);
    lsum += fabsf(af) + fabsf(ab);
    X[t] = make_float2(af, ab);
  }
  const float nrm = block_sum(lsum, red);
  const float sc = 0.5f / 8192.f / nrm;
  float ev[32];
  float2* F = reinterpret_cast<float2*>(P.ws + OFF_FILT) + (long)oc * 2 * 8192;
#pragma unroll
  for (int i = 0; i < 32; ++i) {
    const int n = tid + 256 * i; const float lo = X[n].x; const float hi = n > 0 ? X[8192 - n].y : 0.f;
    ev[i] = (lo + hi) * sc; F[8192 + n] = make_float2((lo - hi) * sc, 0.f);
  }
  __syncthreads();
#pragma unroll
  for (int i = 0; i < 32; ++i) X[tid + 256 * i] = make_float2(ev[i], 0.f);
  __syncthreads();
  fft_fwd(X);
#pragma unroll 4
  for (int i = 0; i < 32; ++i) F[tid + 256 * i] = X[tid + 256 * i];
  __syncthreads();
#pragma unroll 4
  for (int i = 0; i < 32; ++i) { const int n = tid + 256 * i; const float d = F[8192 + n].x; const float2 w = twid(-(float)n * (1.f / 16384.f)); X[n] = make_float2(d * w.x, d * w.y); }
  __syncthreads();
  fft_fwd(X);
#pragma unroll 4
  for (int i = 0; i < 32; ++i) F[8192 + tid + 256 * i] = X[tid + 256 * i];
  __syncthreads();
}
DI void item_filter_ctx(const Params& P, int layer, int oc, char* smem) {
  float* red = reinterpret_cast<float*>(smem);
  const int t = tidx();
  const float* zr = reinterpret_cast<const float*>(P.ws + OFF_Z2C) + (long)layer * CTXL * 64 + t * 64;
  const float* w3 = P.in[I_FW3] + (long)layer * 64 * 1536; const float* dec = P.in[I_FDECAY] + layer * 1536;
  float af = 0.f, ab = 0.f;
  for (int k = 0; k < 64; ++k) { const float z = zr[k]; af += z * w3[k * 1536 + oc]; ab += z * w3[k * 1536 + 768 + oc]; }
  const float tn = (float)t * (1.f / 256.f);
  af *= __expf(-tn * fabsf(dec[oc])); ab *= __expf(-tn * fabsf(dec[768 + oc]));
  const float nrm = block_sum(fabsf(af) + fabsf(ab), red);
  float* T = reinterpret_cast<float*>(P.ws + OFF_TAPSC) + (long)oc * 512;
  T[t] = af / nrm; T[256 + t] = ab / nrm;
}

DI void phase_norm1(const Params& P, int layer, char* smem) {
  const int nfilt = 768 + (layer == 0 ? 768 : 0);
  for (int it = blockIdx.x; it < nfilt; it += gridDim.x) {
    if (it < 768) item_filter(P, layer, it, smem); else item_filter_ctx(P, layer, it - 768, smem);
  }
  normmod_rows(P, layer, 0, layer, TT, blockIdx.x, gridDim.x);
}

DI void phase_gemm_in(const Params& P, int layer, char* smem) {
  const int tid = tidx(), lane = tid & 63, wid = tid >> 6, wr = wid >> 1, wc = wid & 1, fr = lane & 15, fq = lane >> 4;
  const h16* H = reinterpret_cast<const h16*>(P.ws + OFF_H1);
  const h16* W = reinterpret_cast<const h16*>(P.ws + OFF_WT) + (long)layer * WT_LAYER + WT_WIN;
  h16* U = reinterpret_cast<h16*>(P.ws + OFF_U); h16* KV = reinterpret_cast<h16*>(P.ws + OFF_KVLAT); h16* QL = reinterpret_cast<h16*>(P.ws + OFF_QLAT);
  h16* PHY = reinterpret_cast<h16*>(P.ws + OFF_PHY); h16* PHYC = reinterpret_cast<h16*>(P.ws + OFF_PHYC); h16* Kb = reinterpret_cast<h16*>(P.ws + OFF_K);
  const float2* rope = reinterpret_cast<const float2*>(P.ws + OFF_ROPE);
  constexpr int NT = 19, MT = TT / 128;
  const TileWalk tw = tw_init(MT, NT);
  for (int tile = tw.lb; tile < tw_count(tw); tile += tw.nlb) {
    int mt, nt; tw_decode(tw, tile, mt, nt);
    f32x4 acc[4][4]; acc_zero(acc);
    gemm_kloop(acc, H + (long)mt * 128 * LD1, LD1, 0, 128, W + (long)nt * 128 * LD1, LD1, 1024, smem, opaque_tid());
    const int t0 = mt * 128; const Tok tk = tokinfo(t0);
    if (nt < 18) {
      float* Zs = reinterpret_cast<float*>(smem);
      const int t2 = tidx();
      if (nt < 9) {
        stage_acc(acc, Zs, t2);
        h16* dst; int ld, cb;
        if (nt < 3) { dst = U; ld = 384; cb = nt * 128; } else if (nt < 5) { dst = KV; ld = 256; cb = (nt - 3) * 128; } else { dst = QL; ld = 512; cb = (nt - 5) * 128; }
        copy_out_f16(Zs, dst, t0, ld, cb, t2);
      } else {
        stage_acc_t(acc, Zs, t2);
        h16* base = tk.ctx ? PHYC + (long)tk.b * 1152 * CTXL : PHY + (long)tk.b * 1152 * SEQ; const int lp = tk.ctx ? CTXL : SEQ;
        copy_out_f16(Zs, base, (nt - 9) * 128, lp, tk.pos, t2);
      }
      __syncthreads();
    } else {
      h16* R = reinterpret_cast<h16*>(smem);
      if (wc == 0) {
#pragma unroll
        for (int m = 0; m < 4; ++m)
#pragma unroll
          for (int j = 0; j < 4; ++j) {
            const int row = wr * 64 + m * 16 + fq * 4 + j; const int pos = tk.pos + row;
            float x1 = acc[m][0][j], x2 = acc[m][1][j];
            if (!tk.ctx) { const float2 cs = rope[pos * 16 + fr]; const float y1 = x1 * cs.x - x2 * cs.y, y2 = x1 * cs.y + x2 * cs.x; x1 = y1; x2 = y2; }
            R[row * 32 + fr] = (h16)x1; R[row * 32 + 16 + fr] = (h16)x2;
          }
      }
      __syncthreads();
      {
        const int t2 = tidx(); const int key0 = (tk.ctx ? SEQ : 0) + tk.pos;
#pragma unroll
        for (int it = 0; it < 2; ++it) {
          const int chunk = it * 256 + t2, row = chunk >> 2, part = chunk & 3;
          const uint4 v = *reinterpret_cast<const uint4*>(R + row * 32 + part * 8);
#pragma unroll
          for (int h = 0; h < 8; ++h) *reinterpret_cast<uint4*>(Kb + ((long)(tk.b * 8 + h) * KEYS + key0 + row) * 96 + 64 + part * 8) = v;
        }
      }
      __syncthreads();
    }
  }
}
DI void item_kv(const Params& P, int layer, int tile, char* smem) {
  const int tid = tidx(), lane = tid & 63, wid = tid >> 6, wr = wid >> 1, wc = wid & 1, fr = lane & 15, fq = lane >> 4;
  const int mt = tile >> 3, hd = tile & 7; const int t0 = mt * 128; const Tok tk = tokinfo(t0);
  const h16* A = reinterpret_cast<const h16*>(P.ws + OFF_KVLAT) + (long)t0 * 256;
  const h16* W = reinterpret_cast<const h16*>(P.ws + OFF_WT) + (long)layer * WT_LAYER + WT_UKV + (long)hd * 128 * 256;
  float* rs = reinterpret_cast<float*>(smem + 73728);
  row_rms(A, 256, 256, rs);
  f32x4 acc[4][4]; acc_zero(acc);
  gemm_kloop(acc, A, 256, 0, 128, W, 256, 256, smem, opaque_tid());
  h16* Kb = reinterpret_cast<h16*>(P.ws + OFF_K) + (long)(tk.b * 8 + hd) * KEYS * 96;
  h16* Vt = reinterpret_cast<h16*>(P.ws + OFF_VT) + (long)(tk.b * 8 + hd) * 64 * KEYS;
  const int key0 = (tk.ctx ? SEQ : 0) + tk.pos;
#pragma unroll
  for (int m = 0; m < 4; ++m) {
    const int r0 = wr * 64 + m * 16 + fq * 4;
    const float s0 = rs[r0], s1 = rs[r0 + 1], s2 = rs[r0 + 2], s3 = rs[r0 + 3];
#pragma unroll
    for (int n = 0; n < 4; ++n) {
      acc[m][n][0] *= s0; acc[m][n][1] *= s1; acc[m][n][2] *= s2; acc[m][n][3] *= s3;
      if (wc == 1) {
        h16x4 o; o[0] = (h16)acc[m][n][0]; o[1] = (h16)acc[m][n][1]; o[2] = (h16)acc[m][n][2]; o[3] = (h16)acc[m][n][3];
        *reinterpret_cast<h16x4*>(Vt + (long)(n * 16 + fr) * KEYS + key0 + r0) = o;
      }
    }
  }
  {
    float* Zs = reinterpret_cast<float*>(smem);
    const int t2 = tidx();
    stage_acc(acc, Zs, t2);
#pragma unroll
    for (int it = 0; it < 4; ++it) {
      const int chunk = it * 256 + t2, row = chunk >> 3, c8 = (chunk & 7) * 8;
      const float4 x0 = *reinterpret_cast<const float4*>(Zs + row * 132 + c8), x1 = *reinterpret_cast<const float4*>(Zs + row * 132 + c8 + 4);
      h16x8 o; o[0] = (h16)x0.x; o[1] = (h16)x0.y; o[2] = (h16)x0.z; o[3] = (h16)x0.w; o[4] = (h16)x1.x; o[5] = (h16)x1.y; o[6] = (h16)x1.z; o[7] = (h16)x1.w;
      *reinterpret_cast<h16x8*>(Kb + (long)(key0 + row) * 96 + c8) = o;
    }
  }
  __syncthreads();
}
DI void item_q(const Params& P, int layer, int tile, char* smem) {
  const int tid = tidx(), lane = tid & 63, wid = tid >> 6, wr = wid >> 1, wc = wid & 1, fr = lane & 15, fq = lane >> 4;
  const int mt = tile >> 3, hd = tile & 7; const int t0 = mt * 128; const Tok tk = tokinfo(t0);
  const h16* A = reinterpret_cast<const h16*>(P.ws + OFF_QLAT) + (long)t0 * 512;
  const h16* W = reinterpret_cast<const h16*>(P.ws + OFF_WT) + (long)layer * WT_LAYER + WT_UQ + (long)hd * 128 * 512;
  float* rs = reinterpret_cast<float*>(smem + 73728);
  row_rms(A, 512, 512, rs);
  f32x4 acc[4][4]; acc_zero(acc);
  gemm_kloop(acc, A, 512, 0, 128, W, 512, 512, smem, opaque_tid());
  h16* Qb = reinterpret_cast<h16*>(P.ws + OFF_Q) + (long)(tk.b * 8 + hd) * KEYS * 96;
  const float2* rope = reinterpret_cast<const float2*>(P.ws + OFF_ROPE);
  const int q0 = (tk.ctx ? SEQ : 0) + tk.pos;
#pragma unroll
  for (int m = 0; m < 4; ++m)
#pragma unroll
    for (int j = 0; j < 4; ++j) {
      const int r = wr * 64 + m * 16 + fq * 4 + j; const float s = rs[r] * QSCALE;
      if (wc == 0) {
#pragma unroll
        for (int n = 0; n < 4; ++n) acc[m][n][j] *= s;
      } else {
        float x1 = acc[m][0][j], x2 = acc[m][1][j];
        if (!tk.ctx) { const float2 cs = rope[(tk.pos + r) * 16 + fr]; const float y1 = x1 * cs.x - x2 * cs.y, y2 = x1 * cs.y + x2 * cs.x; x1 = y1; x2 = y2; }
        acc[m][0][j] = x1 * s; acc[m][1][j] = x2 * s;
      }
    }
  {
    float* Zs = reinterpret_cast<float*>(smem);
    const int t2 = tidx();
    stage_acc(acc, Zs, t2);
#pragma unroll
    for (int it = 0; it < 6; ++it) {
      const int chunk = it * 256 + t2, row = chunk / 12, c8 = (chunk % 12) * 8;
      const float4 x0 = *reinterpret_cast<const float4*>(Zs + row * 132 + c8), x1 = *reinterpret_cast<const float4*>(Zs + row * 132 + c8 + 4);
      h16x8 o; o[0] = (h16)x0.x; o[1] = (h16)x0.y; o[2] = (h16)x0.z; o[3] = (h16)x0.w; o[4] = (h16)x1.x; o[5] = (h16)x1.y; o[6] = (h16)x1.z; o[7] = (h16)x1.w;
      *reinterpret_cast<h16x8*>(Qb + (long)(q0 + row) * 96 + c8) = o;
    }
  }
  __syncthreads();
}
DI int s5_chunk_base(int b, int dir, int si) {
  if (si < 4) { const int cc = dir ? 3 - si : si; return TLAT + b * CTXL + cc * 64; }
  const int lc = dir ? 127 - (si - 4) : si - 4; return b * SEQ + lc * 64;
}
DI void s5_stage_u(const h16* __restrict__ U, int tokbase, int g, float* us) {
  const int lane = tidx() & 63;
  const h16* p = U + (long)(tokbase + lane) * 384 + g * 16;
  const h16x8 v0 = *reinterpret_cast<const h16x8*>(p), v1 = *reinterpret_cast<const h16x8*>(p + 8);
#pragma unroll
  for (int j = 0; j < 8; ++j) { us[lane * 16 + j] = (float)v0[j]; us[lane * 16 + 8 + j] = (float)v1[j]; }
}
DI void item_s5_pass1(const Params& P, int layer, int wtask, char* smem) {
  const int lane = tidx() & 63, wid = tidx() >> 6;
  float* us = reinterpret_cast<float*>(smem + wid * 12800);
  const int si = wtask % 132; int r = wtask / 132; const int g = r % 24; r /= 24; const int dir = r & 1, b = r >> 1;
  const long gi = (long)(layer * 2 + dir) * 24 + g;
  const float2 a = reinterpret_cast<const float2*>(P.ws + OFF_S5A)[gi * 64 + lane];
  const float2* Bb = reinterpret_cast<const float2*>(P.ws + OFF_S5B) + (gi * 64 + lane) * 16;
  float bre[16], bim[16];
#pragma unroll
  for (int c = 0; c < 16; ++c) { const float2 v = Bb[c]; bre[c] = v.x; bim[c] = v.y; }
  s5_stage_u(reinterpret_cast<const h16*>(P.ws + OFF_U), s5_chunk_base(b, dir, si), g, us);
  float hr = 0.f, hi = 0.f;
#pragma unroll 4
  for (int s = 0; s < 64; ++s) {
    const int tau = dir ? 63 - s : s;
    const float4* up = reinterpret_cast<const float4*>(us + tau * 16);
    float br = 0.f, bi = 0.f;
#pragma unroll
    for (int q = 0; q < 4; ++q) { const float4 u = up[q];
      br += bre[q * 4] * u.x + bre[q * 4 + 1] * u.y + bre[q * 4 + 2] * u.z + bre[q * 4 + 3] * u.w;
      bi += bim[q * 4] * u.x + bim[q * 4 + 1] * u.y + bim[q * 4 + 2] * u.z + bim[q * 4 + 3] * u.w; }
    const float nr = a.x * hr - a.y * hi + br, ni = a.x * hi + a.y * hr + bi; hr = nr; hi = ni;
  }
  reinterpret_cast<float2*>(P.ws + OFF_E)[((long)((b * 2 + dir) * 24 + g) * 132 + si) * 64 + lane] = make_float2(hr, hi);
}

DI float hy_dw(const h16* __restrict__ p, int t, int Ls, float w0, float w1, float w2, float bias) {
  const float xm_ = (float)p[max(t - 1, 0)], x0 = (float)p[t], xp_ = (float)p[min(t + 1, Ls - 1)];
  const float xm = t > 0 ? xm_ : 0.f, xp = t + 1 < Ls ? xp_ : 0.f;
  return xm * w0 + x0 * w1 + xp * w2 + bias;
}
DI void item_hyena(const Params& P, int layer, int task, char* smem) {
  float2* X = reinterpret_cast<float2*>(smem);
  const int tid = tidx(); const int pair = task / 384, c = task % 384;
  const h16* PH0 = reinterpret_cast<const h16*>(P.ws + OFF_PHY) + (long)(2 * pair) * 1152 * SEQ;
  const h16* PH1 = PH0 + (long)1152 * SEQ;
  const float* cw = P.in[I_HCW] + layer * 3 * 1152; const float* cb = P.in[I_HCB] + layer * 1152;
  const float2* F = reinterpret_cast<const float2*>(P.ws + OFF_FILT);
  float2* SCR = reinterpret_cast<float2*>(P.ws + OFF_YS5PRE) + (long)blockIdx.x * 12288;
  float2* SCR2 = SCR + 8192;
  const float vw0 = cw[c], vw1 = cw[1152 + c], vw2 = cw[2304 + c], vbb = cb[c];
  const h16* pv0 = PH0 + (long)c * SEQ; const h16* pv1 = PH1 + (long)c * SEQ;
  float2 ye[16]; int tq;
#pragma unroll 1
  for (int o = 0; o < 2; ++o) {
    const float2* Te = F + (long)(o * 384 + c) * 2 * 8192; const float2* To = Te + 8192;
    float ts = 1.f / 16384.f; asm volatile("" : "+v"(ts));
{ tq = tid; asm volatile("" : "+v"(tq)); }
    if (o == 0) {
#pragma unroll 8
      for (int i = 0; i < 32; ++i) { const int t = tq + 256 * i; const float2 v = make_float2(hy_dw(pv0, t, SEQ, vw0, vw1, vw2, vbb), hy_dw(pv1, t, SEQ, vw0, vw1, vw2, vbb)); X[t] = v; SCR[t] = v; }
    } else {
#pragma unroll 16
      for (int i = 0; i < 32; ++i) { const int t = tq + 256 * i; X[t] = SCR[t]; }
    }
    __syncthreads();
    fft_fwd(X);
{ tq = tid; asm volatile("" : "+v"(tq)); }
#pragma unroll 8
    for (int i = 0; i < 32; ++i) { const int n = tq + 256 * i; X[n] = cmul(X[n], Te[n]); }
    __syncthreads();
    fft_inv(X);
{ tq = tid; asm volatile("" : "+v"(tq)); }
#pragma unroll
    for (int i = 0; i < 16; ++i) { ye[i] = X[tq + 256 * i]; SCR2[tq + 256 * i] = X[tq + 4096 + 256 * i]; }
    __syncthreads();
{ tq = tid; asm volatile("" : "+v"(tq)); }
#pragma unroll 16
    for (int i = 0; i < 32; ++i) { const int t = tq + 256 * i; X[t] = cmul(SCR[t], twid(-(float)t * ts)); }
    __syncthreads();
    fft_fwd(X);
{ tq = tid; asm volatile("" : "+v"(tq)); }
#pragma unroll 8
    for (int i = 0; i < 32; ++i) { const int n = tq + 256 * i; X[n] = cmul(X[n], To[n]); }
    __syncthreads();
    fft_inv(X);
    asm volatile("" : "+v"(ts));
{ tq = tid; asm volatile("" : "+v"(tq)); }
#pragma unroll
    for (int i = 0; i < 16; ++i) { const int t = tq + 256 * i; const float2 yo = cmul(X[t], twid((float)t * ts)); X[t] = make_float2(ye[i].x + yo.x, ye[i].y + yo.y); }
{ tq = tid; asm volatile("" : "+v"(tq)); }
#pragma unroll 2
    for (int i = 0; i < 16; ++i) { const int t = tq + 4096 + 256 * i; const float2 yo = cmul(X[t], twid((float)t * ts)); const float2 y2 = SCR2[tq + 256 * i]; X[t] = make_float2(y2.x + yo.x, y2.y + yo.y); }
    const int gc = (o + 1) * 384 + c;
    const float w0 = cw[gc], w1 = cw[1152 + gc], w2 = cw[2304 + gc], bb = cb[gc];
    const float bias = P.in[I_HBIAS][(layer * 2 + o) * 384 + c];
    const h16* pg0 = PH0 + (long)gc * SEQ; const h16* pg1 = PH1 + (long)gc * SEQ;
{ tq = tid; asm volatile("" : "+v"(tq)); }
    if (o == 0) {
#pragma unroll 8
      for (int i = 0; i < 32; ++i) {
        const int t = tq + 256 * i;
        const float2 lc = X[t];
        const float2 zz = SCR[t];
        const float gx = hy_dw(pg0, t, SEQ, w0, w1, w2, bb), gy = hy_dw(pg1, t, SEQ, w0, w1, w2, bb);
        SCR[t] = make_float2(gx * (lc.x + bias * zz.x), gy * (lc.y + bias * zz.y));
      }
    } else {
#pragma unroll 8
      for (int i = 0; i < 32; ++i) {
        const int t = tq + 256 * i;
        const float2 lc = X[t];
        const float2 zz = SCR[t];
        const float gx = hy_dw(pg0, t, SEQ, w0, w1, w2, bb), gy = hy_dw(pg1, t, SEQ, w0, w1, w2, bb);
        const_cast<h16*>(pv0)[t] = (h16)(gx * (lc.x + bias * zz.x)); const_cast<h16*>(pv1)[t] = (h16)(gy * (lc.y + bias * zz.y));
      }
    }
    __syncthreads();
  }
}
DI void item_hyena_ctx(const Params& P, int layer, int task, char* smem) {
  float* su = reinterpret_cast<float*>(smem); float* sf = su + 256; float* sb = sf + 256;
  const int t = tidx(); const int b = task / 384, c = task % 384;
  const h16* PH = reinterpret_cast<const h16*>(P.ws + OFF_PHYC) + (long)b * 1152 * CTXL;
  const float* cw = P.in[I_HCW] + layer * 3 * 1152; const float* cb = P.in[I_HCB] + layer * 1152;
  float u = hy_dw(PH + (long)c * CTXL, t, CTXL, cw[c], cw[1152 + c], cw[2304 + c], cb[c]);
  for (int o = 0; o < 2; ++o) {
    const float* T = reinterpret_cast<const float*>(P.ws + OFF_TAPSC) + (long)(o * 384 + c) * 512;
    __syncthreads();
    su[t] = u; sf[t] = T[t]; sb[t] = T[256 + t];
    __syncthreads();
    float y = 0.f;
    for (int s = 0; s <= t; ++s) y += sf[t - s] * su[s];
    for (int s = t + 1; s < 256; ++s) y += sb[s - t] * su[s];
    const int gc = (o + 1) * 384 + c;
    const float gx = hy_dw(PH + (long)gc * CTXL, t, CTXL, cw[gc], cw[1152 + gc], cw[2304 + gc], cb[gc]);
    u = gx * (y + P.in[I_HBIAS][(layer * 2 + o) * 384 + c] * u);
  }
  reinterpret_cast<h16*>(P.ws + OFF_YHY)[((long)TLAT + b * CTXL + t) * 384 + c] = (h16)u;
  __syncthreads();
}

#ifndef PROBE_HY
#define PROBE_HY 0
#endif
#ifndef PROBE_S5
#define PROBE_S5 0
#endif
DI int first_item(int base) { const int g = (int)gridDim.x; return (((int)blockIdx.x - base) % g + g) % g; }
DI void phase_mix1(const Params& P, int layer, char* smem) {
  const int n_hy = 4 * 384, n_hyc = layer == 0 ? 8 * 384 : 0;
  const int n_kv = (TT / 128) * 8, n_q = (layer == 0 ? TT / 128 : TLAT / 128) * 8;
  const int n_s5 = (NBATCH * 2 * 24 * 132) / 4;
  const int g = gridDim.x;
#pragma unroll 1
  for (int rep = 0; rep < 1 + PROBE_HY; ++rep)
#pragma unroll 1
  for (int i = first_item(0); i < n_hy; i += g) item_hyena(P, layer, i, smem);
  asm volatile("" ::: "memory");
#pragma unroll 1
  for (int i = first_item(n_hy); i < n_kv; i += g) item_kv(P, layer, i, smem);
  asm volatile("" ::: "memory");
#pragma unroll 1
  for (int i = first_item(n_hy + n_kv); i < n_q; i += g) item_q(P, layer, i, smem);
  asm volatile("" ::: "memory");
#pragma unroll 1
  for (int rep = 0; rep < 1 + PROBE_S5; ++rep)
#pragma unroll 1
  for (int i = first_item(n_hy + n_kv + n_q); i < n_s5; i += g) { item_s5_pass1(P, layer, i * 4 + (tidx() >> 6), smem); __syncthreads(); }
  asm volatile("" ::: "memory");
#pragma unroll 1
  for (int i = first_item(n_hy + n_kv + n_q + n_s5); i < n_hyc; i += g) item_hyena_ctx(P, layer, i, smem);
}
DI int crow32(int r, int hi) { return (r & 3) + 8 * (r >> 2) + 4 * hi; }
DI void item_attn(const Params& P, int bh, int q0, int key_lo, int ntiles, char* smem) {
  const int tid = tidx(), lane = tid & 63, wid = tid >> 6, r32 = lane & 31, hi = lane >> 5;
  const h16* Qb = reinterpret_cast<const h16*>(P.ws + OFF_Q) + (long)bh * KEYS * 96;
  const h16* Kb = reinterpret_cast<const h16*>(P.ws + OFF_K) + (long)bh * KEYS * 96;
  const h16* Vt = reinterpret_cast<const h16*>(P.ws + OFF_VT) + (long)bh * 64 * KEYS;
  h16x8 qf[6];
  { const h16* qrow = Qb + (long)(q0 + wid * 32 + r32) * 96 + hi * 8;
#pragma unroll
    for (int ds = 0; ds < 6; ++ds) qf[ds] = *reinterpret_cast<const h16x8*>(qrow + ds * 16); }
  constexpr int KT_BYTES = 64 * 208, VT_BYTES = 64 * 136, BUF = KT_BYTES + VT_BYTES;
  uint4 kr[3]; uint4 vr[2];
  const int vdv0 = tid >> 3, vpart = tid & 7;
  auto gload = [&](int j) {
    const long key0 = key_lo + j * 64;
#pragma unroll
    for (int i = 0; i < 3; ++i) kr[i] = *reinterpret_cast<const uint4*>(Kb + key0 * 96 + (long)(tid + 256 * i) * 8);
#pragma unroll
    for (int i = 0; i < 2; ++i) vr[i] = *reinterpret_cast<const uint4*>(Vt + (long)(vdv0 + 32 * i) * KEYS + key0 + vpart * 8);
  };
  auto swrite = [&](int buf) {
    char* ks = smem + buf * BUF; char* vs = ks + KT_BYTES;
#pragma unroll
    for (int i = 0; i < 3; ++i) { const int c = tid + 256 * i; *reinterpret_cast<uint4*>(ks + (c / 12) * 208 + (c % 12) * 16) = kr[i]; }
#pragma unroll
    for (int i = 0; i < 2; ++i) { char* d = vs + (vdv0 + 32 * i) * 136 + vpart * 16;
      *reinterpret_cast<uint2*>(d) = make_uint2(vr[i].x, vr[i].y); *reinterpret_cast<uint2*>(d + 8) = make_uint2(vr[i].z, vr[i].w); }
  };
  f32x16 o0, o1;
#pragma unroll
  for (int r = 0; r < 16; ++r) { o0[r] = 0.f; o1[r] = 0.f; }
  float m_run = -1e30f, l_run = 0.f;
  gload(0); swrite(0); __syncthreads();
  for (int j = 0; j < ntiles; ++j) {
    if (j + 1 < ntiles) gload(j + 1);
    const char* ks = smem + (j & 1) * BUF; const char* vs = ks + KT_BYTES;
    f32x16 p0, p1;
#pragma unroll
    for (int r = 0; r < 16; ++r) { p0[r] = 0.f; p1[r] = 0.f; }
#pragma unroll
    for (int ds = 0; ds < 6; ++ds) {
      const h16x8 a0 = *reinterpret_cast<const h16x8*>(ks + r32 * 208 + (ds * 16 + hi * 8) * 2);
      const h16x8 a1 = *reinterpret_cast<const h16x8*>(ks + (32 + r32) * 208 + (ds * 16 + hi * 8) * 2);
      p0 = __builtin_amdgcn_mfma_f32_32x32x16_f16(a0, qf[ds], p0, 0, 0, 0);
      p1 = __builtin_amdgcn_mfma_f32_32x32x16_f16(a1, qf[ds], p1, 0, 0, 0);
    }
    float mx = p0[0];
#pragma unroll
    for (int r = 1; r < 16; ++r) mx = fmaxf(mx, p0[r]);
#pragma unroll
    for (int r = 0; r < 16; ++r) mx = fmaxf(mx, p1[r]);
    mx = fmaxf(mx, __shfl_xor(mx, 32));
    const float mnew = fmaxf(m_run, mx);
    const float alpha = __builtin_amdgcn_exp2f(m_run - mnew);
    m_run = mnew;
    float rsum = 0.f;
#pragma unroll
    for (int r = 0; r < 16; ++r) { p0[r] = __builtin_amdgcn_exp2f(p0[r] - mnew); rsum += p0[r]; }
#pragma unroll
    for (int r = 0; r < 16; ++r) { p1[r] = __builtin_amdgcn_exp2f(p1[r] - mnew); rsum += p1[r]; }
    l_run = l_run * alpha + rsum;
    if (__any(alpha != 1.f)) {
#pragma unroll
      for (int r = 0; r < 16; ++r) { o0[r] *= alpha; o1[r] *= alpha; }
    }
#pragma unroll
    for (int kb = 0; kb < 2; ++kb)
#pragma unroll
      for (int s = 0; s < 2; ++s) {
        h16x8 pf;
#pragma unroll
        for (int e = 0; e < 8; ++e) pf[e] = (h16)(kb ? p1[8 * s + e] : p0[8 * s + e]);
        const int koff = (32 * kb + 16 * s + 4 * hi) * 2;
        {
          const h16x4 lo = *reinterpret_cast<const h16x4*>(vs + r32 * 136 + koff), hh = *reinterpret_cast<const h16x4*>(vs + r32 * 136 + koff + 16);
          const h16x8 af = __builtin_shufflevector(lo, hh, 0, 1, 2, 3, 4, 5, 6, 7);
          o0 = __builtin_amdgcn_mfma_f32_32x32x16_f16(af, pf, o0, 0, 0, 0);
        }
        {
          const h16x4 lo = *reinterpret_cast<const h16x4*>(vs + (32 + r32) * 136 + koff), hh = *reinterpret_cast<const h16x4*>(vs + (32 + r32) * 136 + koff + 16);
          const h16x8 af = __builtin_shufflevector(lo, hh, 0, 1, 2, 3, 4, 5, 6, 7);
          o1 = __builtin_amdgcn_mfma_f32_32x32x16_f16(af, pf, o1, 0, 0, 0);
        }
      }
    if (j + 1 < ntiles) swrite((j + 1) & 1);
    __syncthreads();
  }
  const float lt = l_run + __shfl_xor(l_run, 32);
  const float inv = 1.f / lt;
  const int b = bh >> 3, hd = bh & 7; const int q = q0 + wid * 32 + r32;
  const long tok = q < SEQ ? (long)b * SEQ + q : (long)TLAT + b * CTXL + (q - SEQ);
  h16* yr = reinterpret_cast<h16*>(P.ws + OFF_YMLA) + tok * 512 + hd * 64;
#pragma unroll
  for (int g = 0; g < 4; ++g) {
    h16x4 a, c;
#pragma unroll
    for (int e = 0; e < 4; ++e) { a[e] = (h16)(o0[4 * g + e] * inv); c[e] = (h16)(o1[4 * g + e] * inv); }
    *reinterpret_cast<h16x4*>(yr + 8 * g + 4 * hi) = a;
    *reinterpret_cast<h16x4*>(yr + 32 + 8 * g + 4 * hi) = c;
  }
}
DI void item_s5_pass3(const Params& P, int layer, int b, int g, int ck, char* smem) {
  const int lane = tidx() & 63, wid = tidx() >> 6, fr = lane & 15, fq = lane >> 4;
  float* us = reinterpret_cast<float*>(smem + wid * 12800); char* Hs = smem + wid * 12800 + 4096;
  const int tokbase = ck < 4 ? TLAT + b * CTXL + ck * 64 : b * SEQ + (ck - 4) * 64;
  s5_stage_u(reinterpret_cast<const h16*>(P.ws + OFF_U), tokbase, g, us);
  __syncthreads();
  f32x4 yacc[4];
#pragma unroll
  for (int i = 0; i < 4; ++i) yacc[i] = f32x4{0.f, 0.f, 0.f, 0.f};
#pragma unroll
  for (int dir = 0; dir < 2; ++dir) {
    const long gi = (long)(layer * 2 + dir) * 24 + g;
    const float2 a = reinterpret_cast<const float2*>(P.ws + OFF_S5A)[gi * 64 + lane];
    const float2 a64 = reinterpret_cast<const float2*>(P.ws + OFF_S5A64)[gi * 64 + lane];
    const float2* Bb = reinterpret_cast<const float2*>(P.ws + OFF_S5B) + (gi * 64 + lane) * 16;
    float bre[16], bim[16];
#pragma unroll
    for (int c = 0; c < 16; ++c) { const float2 v = Bb[c]; bre[c] = v.x; bim[c] = v.y; }
    const int si = ck < 4 ? (dir ? 3 - ck : ck) : 4 + (dir ? 127 - (ck - 4) : ck - 4);
    const float2* Ep = reinterpret_cast<const float2*>(P.ws + OFF_E) + ((long)((b * 2 + dir) * 24 + g) * 132) * 64 + lane;
    float hr = 0.f, hi = 0.f;
#pragma unroll 16
    for (int i = 0; i < si; ++i) { const float2 e = Ep[(long)i * 64]; const float nr = a64.x * hr - a64.y * hi + e.x, ni = a64.x * hi + a64.y * hr + e.y; hr = nr; hi = ni; }
    const h16* Ct = reinterpret_cast<const h16*>(P.ws + OFF_S5C) + gi * 16 * 128 + fr * 128 + fq * 8;
    h16x8 cf[4];
#pragma unroll
    for (int ks = 0; ks < 4; ++ks) cf[ks] = *reinterpret_cast<const h16x8*>(Ct + ks * 32);
#pragma unroll
    for (int half = 0; half < 2; ++half) {
#pragma unroll 4
      for (int s = 0; s < 32; ++s) {
        const int step = half * 32 + s; const int tau = dir ? 63 - step : step;
        const float4* up = reinterpret_cast<const float4*>(us + tau * 16);
        float br = 0.f, bi = 0.f;
#pragma unroll
        for (int q = 0; q < 4; ++q) { const float4 u = up[q];
          br += bre[q * 4] * u.x + bre[q * 4 + 1] * u.y + bre[q * 4 + 2] * u.z + bre[q * 4 + 3] * u.w;
          bi += bim[q * 4] * u.x + bim[q * 4 + 1] * u.y + bim[q * 4 + 2] * u.z + bim[q * 4 + 3] * u.w; }
        const float nr = a.x * hr - a.y * hi + br, ni = a.x * hi + a.y * hr + bi; hr = nr; hi = ni;
        h16* hrow = reinterpret_cast<h16*>(Hs + (tau & 31) * 272);
        hrow[lane] = (h16)hr; hrow[64 + lane] = (h16)hi;
      }
      __syncthreads();
      const int tb = dir ? 1 - half : half;
#pragma unroll
      for (int sb2 = 0; sb2 < 2; ++sb2)
#pragma unroll
        for (int ks = 0; ks < 4; ++ks) {
          const h16x8 bf = *reinterpret_cast<const h16x8*>(Hs + (sb2 * 16 + fr) * 272 + (ks * 32 + fq * 8) * 2);
          yacc[tb * 2 + sb2] = __builtin_amdgcn_mfma_f32_16x16x32_f16(cf[ks], bf, yacc[tb * 2 + sb2], 0, 0, 0);
        }
      __syncthreads();
    }
  }
  const float* dsk = P.in[I_S5D] + layer * 384 + g * 16 + fq * 4;
  h16* Y = reinterpret_cast<h16*>(P.ws + OFF_YS5PRE);
#pragma unroll
  for (int sbi = 0; sbi < 4; ++sbi) {
    const int tl = sbi * 16 + fr; h16x4 o;
#pragma unroll
    for (int j = 0; j < 4; ++j) o[j] = (h16)geluf_(yacc[sbi][j] + dsk[j] * us[tl * 16 + fq * 4 + j]);
    *reinterpret_cast<h16x4*>(Y + (long)(tokbase + tl) * 384 + g * 16 + fq * 4) = o;
  }
  __syncthreads();
}
DI void phase_mix2(const Params& P, int layer, char* smem) {
  if ((gridDim.x & 7) == 0) {
    const int xcd = blockIdx.x & 7, li = blockIdx.x >> 3, nloc = gridDim.x >> 3;
    for (int k = li; k < 512; k += nloc) item_attn(P, xcd + 8 * (k >> 6), (k & 63) * 128, 0, KEYS / 64, smem);
  } else {
    for (int k = blockIdx.x; k < 4096; k += gridDim.x) item_attn(P, k >> 6, (k & 63) * 128, 0, KEYS / 64, smem);
  }
  const int n_actx = layer == 0 ? 128 : 0;
  const int nck = layer == 0 ? 132 : 128;
  const int n_s5 = NBATCH * 24 * nck / 4;
  for (int it = blockIdx.x; it < n_actx + n_s5; it += gridDim.x) {
    if (it < n_actx) { item_attn(P, it >> 1, SEQ + (it & 1) * 128, SEQ, CTXL / 64, smem); continue; }
    const int w = (it - n_actx) * 4 + (tidx() >> 6);
    const int ck = w % nck + (layer == 0 ? 0 : 4); const int r = w / nck;
    item_s5_pass3(P, layer, r / 24, r % 24, ck, smem);
  }
}
DI void item_yhy_transpose(const Params& P, int item, char* smem) {
  h16* T = reinterpret_cast<h16*>(smem);
  const int tid = tidx();
  const int tt = item & 127, ct = (item >> 7) % 6, b = item / (128 * 6);
  const h16* src = reinterpret_cast<const h16*>(P.ws + OFF_PHY) + ((long)b * 1152 + ct * 64) * SEQ + tt * 64;
  h16* dst = reinterpret_cast<h16*>(P.ws + OFF_YHY) + ((long)b * SEQ + tt * 64) * 384 + ct * 64;
#pragma unroll
  for (int i = 0; i < 2; ++i) {
    const int chunk = tid + 256 * i, cr = chunk >> 3, tp = (chunk & 7) * 8;
    const h16x8 v = *reinterpret_cast<const h16x8*>(src + (long)cr * SEQ + tp);
#pragma unroll
    for (int e = 0; e < 8; ++e) T[cr * 66 + tp + e] = v[e];
  }
  __syncthreads();
#pragma unroll
  for (int i = 0; i < 2; ++i) {
    const int chunk = tid + 256 * i, tr = chunk >> 3, cp = (chunk & 7) * 8;
    h16x8 o;
#pragma unroll
    for (int e = 0; e < 8; ++e) o[e] = T[(cp + e) * 66 + tr];
    *reinterpret_cast<h16x8*>(dst + (long)tr * 384 + cp) = o;
  }
  __syncthreads();
}
DI void phase_glu(const Params& P, int layer, char* smem) {
  const int tid = tidx(), lane = tid & 63, wid = tid >> 6, wr = wid >> 1, wc = wid & 1, fr = lane & 15, fq = lane >> 4;
  const h16* A = reinterpret_cast<const h16*>(P.ws + OFF_YS5PRE);
  const h16* W = reinterpret_cast<const h16*>(P.ws + OFF_WT) + (long)layer * WT_LAYER + WT_GLU;
  h16* Y = reinterpret_cast<h16*>(P.ws + OFF_YS5);
#pragma unroll 1
  for (int it = blockIdx.x; it < NBATCH * 6 * 128; it += gridDim.x) item_yhy_transpose(P, it, smem);
  asm volatile("" ::: "memory");
  const int MT = (layer == 0 ? TT : TLAT) / 128;
  const TileWalk tw = tw_init(MT, 6);
  for (int tile = tw.lb; tile < tw_count(tw); tile += tw.nlb) {
    int mt, nt; tw_decode(tw, tile, mt, nt);
    f32x4 acc[4][4]; acc_zero(acc);
    gemm_kloop(acc, A + (long)mt * 128 * 384, 384, 0, 128, W + (long)nt * 128 * 384, 384, 384, smem, opaque_tid());
#pragma unroll
    for (int m = 0; m < 4; ++m)
#pragma unroll
      for (int np = 0; np < 2; ++np)
#pragma unroll
        for (int j = 0; j < 4; ++j) {
          const int row = mt * 128 + wr * 64 + m * 16 + fq * 4 + j, col = nt * 64 + wc * 32 + np * 16 + fr;
          Y[(long)row * 384 + col] = (h16)(acc[m][2 * np][j] * sigmoidf_(acc[m][2 * np + 1][j]));
        }
  }
}
DI void phase_merge(const Params& P, int layer, char* smem) {
  const h16* H = reinterpret_cast<const h16*>(P.ws + OFF_H1);
  const h16* WL = reinterpret_cast<const h16*>(P.ws + OFF_WT) + (long)layer * WT_LAYER;
  h16* Mg = reinterpret_cast<h16*>(P.ws + OFF_MERGED);
  const int MT = (layer == 0 ? TT : TLAT) / 128;
  const TileWalk tw = tw_init(MT, 8);
  for (int tile = tw.lb; tile < tw_count(tw); tile += tw.nlb) {
    int mt, nt; tw_decode(tw, tile, mt, nt);
    h16* Tmp = reinterpret_cast<h16*>(P.ws + OFF_YS5PRE) + (long)blockIdx.x * 32768;
    h16* Run = Tmp + 16384;
#pragma unroll 1
    for (int br = 0; br < 3; ++br) {
      const h16* Ab; const h16* Wb; int Kb;
      if (br == 0) { Ab = reinterpret_cast<const h16*>(P.ws + OFF_YHY) + (long)mt * 128 * 384; Wb = WL + WT_BRHY + (long)nt * 128 * 384; Kb = 384; }
      else if (br == 1) { Ab = reinterpret_cast<const h16*>(P.ws + OFF_YS5) + (long)mt * 128 * 384; Wb = WL + WT_BRS5 + (long)nt * 128 * 384; Kb = 384; }
      else { Ab = reinterpret_cast<const h16*>(P.ws + OFF_YMLA) + (long)mt * 128 * 512; Wb = WL + WT_BRMLA + (long)nt * 128 * 512; Kb = 512; }
      {
        f32x4 acc[4][4]; acc_zero(acc);
        gemm_kloop(acc, Ab, Kb, 0, 128, Wb, Kb, Kb, smem, opaque_tid());
        const int tid = tidx();
#pragma unroll
        for (int m = 0; m < 4; ++m)
#pragma unroll
          for (int n = 0; n < 4; ++n) {
            h16x4 o; o[0] = (h16)acc[m][n][0]; o[1] = (h16)acc[m][n][1]; o[2] = (h16)acc[m][n][2]; o[3] = (h16)acc[m][n][3];
            *reinterpret_cast<h16x4*>(Tmp + ((m * 4 + n) * 256 + tid) * 4) = o;
          }
      }
      f32x4 acc[4][4]; acc_zero(acc);
      gemm_kloop(acc, H + (long)mt * 128 * LD1, LD1, 0, 128, WL + WT_WGATE + (long)(br * 1024 + nt * 128) * LD1, LD1, 1024, smem, opaque_tid());
      const int tid = tidx();
      h16x4 bv[16], rv[16];
#pragma unroll
      for (int q = 0; q < 16; ++q) bv[q] = *reinterpret_cast<const h16x4*>(Tmp + (q * 256 + tid) * 4);
      if (br > 0) {
#pragma unroll
        for (int q = 0; q < 16; ++q) rv[q] = *reinterpret_cast<const h16x4*>(Run + (q * 256 + tid) * 4);
      } else {
#pragma unroll
        for (int q = 0; q < 16; ++q) rv[q] = h16x4{(h16)0.f, (h16)0.f, (h16)0.f, (h16)0.f};
      }
#pragma unroll
      for (int m = 0; m < 4; ++m)
#pragma unroll
        for (int n = 0; n < 4; ++n)
#pragma unroll
          for (int j = 0; j < 4; ++j) acc[m][n][j] = (float)rv[m * 4 + n][j] + sigmoidf_(acc[m][n][j]) * (float)bv[m * 4 + n][j];
      if (br < 2) {
#pragma unroll
        for (int m = 0; m < 4; ++m)
#pragma unroll
          for (int n = 0; n < 4; ++n) {
            h16x4 o; o[0] = (h16)acc[m][n][0]; o[1] = (h16)acc[m][n][1]; o[2] = (h16)acc[m][n][2]; o[3] = (h16)acc[m][n][3];
            *reinterpret_cast<h16x4*>(Run + ((m * 4 + n) * 256 + tid) * 4) = o;
          }
      } else {
        float* Zs = reinterpret_cast<float*>(smem);
        stage_acc(acc, Zs, tid);
        copy_out_f16(Zs, Mg, (long)mt * 128, LD1, nt * 128, tid);
        __syncthreads();
      }
    }
  }
}
DI void phase_resid(const Params& P, int layer, int stage_src, size_t a_off, int K, long w_off, int gate_idx, char* smem) {
  const int tid = tidx(), lane = tid & 63, wid = tid >> 6, wr = wid >> 1, wc = wid & 1, fr = lane & 15, fq = lane >> 4;
  const h16* A = reinterpret_cast<const h16*>(P.ws + a_off);
  const h16* W = reinterpret_cast<const h16*>(P.ws + OFF_WT) + (long)layer * WT_LAYER + w_off;
  const float* mod = reinterpret_cast<const float*>(P.ws + OFF_MOD) + (long)layer * 9 * 6144 + gate_idx * 1024;
  const int MT = (layer == 0 ? TT : TLAT) / 128;
  const TileWalk tw = tw_init(MT, 8);
  for (int tile = tw.lb; tile < tw_count(tw); tile += tw.nlb) {
    int mt, nt; tw_decode(tw, tile, mt, nt);
    f32x4 acc[4][4]; acc_zero(acc);
    const int ld = K == 1024 ? LD1 : LD2;
    gemm_kloop(acc, A + (long)mt * 128 * ld, ld, 0, 128, W + (long)nt * 128 * ld, ld, K, smem, opaque_tid());
    const Tok tk = tokinfo(mt * 128);
    float* Zs = reinterpret_cast<float*>(smem);
    const int t2 = tidx();
    stage_acc(acc, Zs, t2);
    const int c4 = (t2 & 31) * 4;
    const float4 g4 = *reinterpret_cast<const float4*>(mod + tk.mrow * 6144 + nt * 128 + c4);
#pragma unroll 4
    for (int it = 0; it < 16; ++it) {
      const int row = it * 8 + (t2 >> 5); const int t = mt * 128 + row;
      const float4 a4 = *reinterpret_cast<const float4*>(Zs + row * 132 + c4);
      const float4 x4 = *reinterpret_cast<const float4*>(xrow_src(P, stage_src, t) + nt * 128 + c4);
      *reinterpret_cast<float4*>(xrow_dst(P, t) + nt * 128 + c4) = make_float4(x4.x + g4.x * a4.x, x4.y + g4.y * a4.y, x4.z + g4.z * a4.z, x4.w + g4.w * a4.w);
    }
    __syncthreads();
  }
}
DI void phase_ffn_up(const Params& P, int layer, char* smem) {
  const int tid = tidx(), lane = tid & 63, wid = tid >> 6, wr = wid >> 1, wc = wid & 1, fr = lane & 15, fq = lane >> 4;
  const h16* H = reinterpret_cast<const h16*>(P.ws + OFF_H2);
  const h16* W = reinterpret_cast<const h16*>(P.ws + OFF_WT) + (long)layer * WT_LAYER + WT_UP;
  h16* F = reinterpret_cast<h16*>(P.ws + OFF_F);
  const float* cw = P.in[I_FCW] + (long)layer * 3 * 5632; const float* cb = P.in[I_FCB] + (long)layer * 5632;
  float* Zs = reinterpret_cast<float*>(smem);
  const int n_mt = 8 * 66 + (layer == 0 ? 8 * 3 : 0);
  const TileWalk tw = tw_init(n_mt, 44);
  for (int tile = tw.lb; tile < tw_count(tw); tile += tw.nlb) {
    int mi, nt; tw_decode(tw, tile, mi, nt);
    int seq0, Ls, ti;
    if (mi < 528) { seq0 = (mi / 66) * SEQ; Ls = SEQ; ti = mi % 66; } else { const int u = mi - 528; seq0 = TLAT + (u / 3) * CTXL; Ls = CTXL; ti = u % 3; }
    const int p0 = ti * 126 - 1;
    const int a_lo = ti == 0 ? 1 : 0, a_hi = min(128, Ls - p0);
    const int nout = min(126, Ls - ti * 126);
    f32x4 acc[4][4]; acc_zero(acc);
    gemm_kloop(acc, H + ((long)seq0 + p0) * LD1, LD1, a_lo, a_hi, W + (long)nt * 128 * LD1, LD1, 1024, smem, opaque_tid());
#pragma unroll
    for (int m = 0; m < 4; ++m)
#pragma unroll
      for (int n = 0; n < 4; ++n)
#pragma unroll
        for (int j = 0; j < 4; ++j) Zs[(wr * 64 + m * 16 + fq * 4 + j) * 132 + wc * 64 + n * 16 + fr] = acc[m][n][j];
    __syncthreads();
    {
      const int jc = tid & 63, rg = tid >> 6;
      const int ucol = (jc >> 5) * 64 + ((jc >> 4) & 1) * 32 + (jc & 15), gcol = ucol + 16;
      const int cu = nt * 64 + jc, cg = 2816 + cu;
      const float wu0 = cw[cu], wu1 = cw[5632 + cu], wu2 = cw[2 * 5632 + cu], bu = cb[cu];
      const float wg0 = cw[cg], wg1 = cw[5632 + cg], wg2 = cw[2 * 5632 + cg], bg = cb[cg];
      for (int r = 1 + rg; r <= nout; r += 4) {
        const float au = wu0 * Zs[(r - 1) * 132 + ucol] + wu1 * Zs[r * 132 + ucol] + wu2 * Zs[(r + 1) * 132 + ucol] + bu;
        const float ag = wg0 * Zs[(r - 1) * 132 + gcol] + wg1 * Zs[r * 132 + gcol] + wg2 * Zs[(r + 1) * 132 + gcol] + bg;
        F[((long)seq0 + p0 + r) * LD2 + cu] = (h16)(siluf_(au) * ag);
      }
    }
    __syncthreads();
  }
}
DI void phase_norm2(const Params& P, int layer) { normmod_rows(P, layer, 1, 1, layer == 0 ? TT : TLAT, blockIdx.x, gridDim.x); }

constexpr int N_PHASES = 22;
#ifndef PROBE_REPEAT
#define PROBE_REPEAT 0u
#endif
template <int PH> DI void run_phase_t(const Params& P, char* smem) {
  asm volatile("" ::: "memory");
  if constexpr (PH == 0) phase_prologue(P, smem);
  else if constexpr (PH == 21) phase_final(P);
  else {
    constexpr int layer = (PH - 1) / 10, s = (PH - 1) % 10;
    if constexpr (s == 0) phase_norm1(P, layer, smem);
    else if constexpr (s == 1) phase_gemm_in(P, layer, smem);
    else if constexpr (s == 2) phase_mix1(P, layer, smem);
    else if constexpr (s == 3) phase_mix2(P, layer, smem);
    else if constexpr (s == 4) phase_glu(P, layer, smem);
    else if constexpr (s == 5) phase_merge(P, layer, smem);
    else if constexpr (s == 6) phase_resid(P, layer, layer, OFF_MERGED, 1024, WT_WO, 2, smem);
    else if constexpr (s == 7) phase_norm2(P, layer);
    else if constexpr (s == 8) phase_ffn_up(P, layer, smem);
    else phase_resid(P, layer, 1, OFF_F, 2816, WT_DOWN, 5, smem);
  }
}
DI void run_phase(const Params& P, int ph, char* smem) {
  switch (ph) {
#define RP(i) case i: run_phase_t<i>(P, smem); break;
    RP(0) RP(1) RP(2) RP(3) RP(4) RP(5) RP(6) RP(7) RP(8) RP(9) RP(10) RP(11) RP(12) RP(13) RP(14) RP(15) RP(16) RP(17) RP(18) RP(19) RP(20) RP(21)
#undef RP
    default: break;
  }
}
#ifndef MULTI_LAUNCH
#define MULTI_LAUNCH 0
#endif
#define XB_TMO      128
#define XB_XCNT(j)  (256  + 64 * (j))
#define XB_XSUB(j)  (1280 + 64 * (j))
#define XB_XGEN(j)  (2304 + 64 * (j))
#define XB_TOP      3328
#define XB_TOPGEN   3392
#define XCD_BAR_WORDS 3456
#define XB_SPIN_CAP (1u << 22)
#define LAS __attribute__((address_space(3)))
DI unsigned xb_ld(unsigned* p)              { return __hip_atomic_load(p, __ATOMIC_RELAXED, __HIP_MEMORY_SCOPE_AGENT); }
DI unsigned xb_add(unsigned* p, unsigned v) { return __hip_atomic_fetch_add(p, v, __ATOMIC_RELAXED, __HIP_MEMORY_SCOPE_AGENT); }
DI unsigned xb_xcc_id() { return (unsigned)__builtin_amdgcn_s_getreg((3 << 11) | 20) & 0xFu; }
#define XB_SPIN(cond, bar) do { unsigned _sp = 0; while (cond) { __builtin_amdgcn_s_sleep(1); \
    if ((++_sp & 255u) == 0u) { if (xb_ld(&(bar)[XB_TMO])) break; if (_sp > XB_SPIN_CAP) { atomicAdd(&(bar)[XB_TMO], 1u); break; } } } } while (0)
struct XcdBarrier { unsigned* bar; unsigned x; volatile LAS unsigned* st; };
DI XcdBarrier xcd_barrier_post(unsigned* bar, volatile LAS unsigned* st) {
  XcdBarrier b; b.bar = bar; b.x = xb_xcc_id(); b.st = st;
  if (threadIdx.x == 0) (void)xb_add(&bar[XB_XCNT(b.x)], 1u);
  return b;
}
DI void xcd_barrier_complete(unsigned* bar, unsigned x, unsigned& nloc, unsigned& nx) {
  const unsigned G = gridDim.x * gridDim.y * gridDim.z;
  unsigned sum, cnt, mine, sp = 0u;
  for (;;) {
    sum = 0u; cnt = 0u; mine = 0u;
#pragma unroll
    for (unsigned j = 0; j < 16; ++j) { const unsigned c = xb_ld(&bar[XB_XCNT(j)]); sum += c; cnt += (c > 0u) ? 1u : 0u; mine = (j == x) ? c : mine; }
    if (sum == G) break;
    __builtin_amdgcn_s_sleep(1);
    if ((++sp & 255u) == 0u) { if (xb_ld(&bar[XB_TMO])) break; if (sp > XB_SPIN_CAP) { atomicAdd(&bar[XB_TMO], 1u); break; } }
  }
  nloc = mine > 0u ? mine : 1u; nx = cnt > 0u ? cnt : 1u;
}
DI void xcd_barrier(const XcdBarrier& b) {
  asm volatile("s_waitcnt vmcnt(0)" ::: "memory");
  __syncthreads();
  if (threadIdx.x == 0) {
    unsigned* bar = b.bar;
    __builtin_amdgcn_s_waitcnt(0);
    unsigned nloc = b.st[0], nx = b.st[1];
    if (nloc == 0u) { xcd_barrier_complete(bar, b.x, nloc, nx); b.st[0] = nloc; b.st[1] = nx; }
    const unsigned old = xb_add(&bar[XB_XSUB(b.x)], 1u);
    const unsigned gen = old / nloc;
    if (old + 1u == (gen + 1u) * nloc) {
      __builtin_amdgcn_fence(__ATOMIC_RELEASE, "agent");
      asm volatile("s_waitcnt vmcnt(0)" ::: "memory");
      const unsigned og = xb_add(&bar[XB_TOP], 1u);
      const unsigned tg = og / nx;
      if (og + 1u == (tg + 1u) * nx) xb_add(&bar[XB_TOPGEN], 1u);
      else XB_SPIN(xb_ld(&bar[XB_TOPGEN]) == tg, bar);
      __builtin_amdgcn_fence(__ATOMIC_ACQUIRE, "agent");
      xb_add(&bar[XB_XGEN(b.x)], 1u);
      asm volatile("s_waitcnt vmcnt(0)" ::: "memory");
    } else {
      XB_SPIN(xb_ld(&bar[XB_XGEN(b.x)]) == gen, bar);
      __builtin_amdgcn_fence(__ATOMIC_ACQUIRE, "agent");
      asm volatile("s_waitcnt vmcnt(0)" ::: "memory");
    }
  }
  __syncthreads();
}
__global__ void __launch_bounds__(NTHREADS, 2) fwd_megakernel(Params P) {
  extern __shared__ __attribute__((aligned(16))) char smem[];
  cg::grid_group grid = cg::this_grid();
  volatile LAS unsigned* st = (volatile LAS unsigned*)(smem + SMEM_BYTES - 16);
  if (threadIdx.x == 0) { st[0] = 0u; st[1] = 0u; st[2] = 0u; st[3] = 0u; }
  __syncthreads();
  const XcdBarrier xb = xcd_barrier_post(reinterpret_cast<unsigned*>(P.ws + OFF_BAR), st);
  run_phase_t<0>(P, smem); grid.sync();
#define RP(i) run_phase_t<i>(P, smem); xcd_barrier(xb); if constexpr ((PROBE_REPEAT >> i) & 1) { run_phase_t<i>(P, smem); xcd_barrier(xb); }
  RP(1) RP(2) RP(3) RP(4) RP(5) RP(6) RP(7) RP(8) RP(9) RP(10) RP(11) RP(12) RP(13) RP(14) RP(15) RP(16) RP(17) RP(18) RP(19) RP(20)
#undef RP
#ifdef PROBE_SYNC
  for (int i = 0; i < PROBE_SYNC; ++i) xcd_barrier(xb);
#endif
  run_phase_t<21>(P, smem);
}
#if MULTI_LAUNCH
__global__ void __launch_bounds__(NTHREADS, 2) fwd_phase_kernel(Params P, int ph) {
  extern __shared__ __attribute__((aligned(16))) char smem[];
  run_phase(P, ph, smem);
}
#endif

extern "C" void kernel_launch(void* const* d_in, const int* in_sizes, int n_in, void* d_out, int out_size, void* d_ws, size_t ws_size,
                              hipStream_t stream) {
  static int grid_blocks = 0;
  if (!grid_blocks) {
    int dev = 0, cus = 0, per_cu = 0;
    (void)hipGetDevice(&dev);
    (void)hipDeviceGetAttribute(&cus, hipDeviceAttributeMultiprocessorCount, dev);
    (void)hipFuncSetAttribute((const void*)fwd_megakernel, hipFuncAttributeMaxDynamicSharedMemorySize, SMEM_BYTES);
#if MULTI_LAUNCH
    (void)hipFuncSetAttribute((const void*)fwd_phase_kernel, hipFuncAttributeMaxDynamicSharedMemorySize, SMEM_BYTES);
#endif
    (void)hipOccupancyMaxActiveBlocksPerMultiprocessor(&per_cu, fwd_megakernel, NTHREADS, SMEM_BYTES);
    if (per_cu > 2) per_cu = 2;
    if (per_cu < 1) per_cu = 1;
#ifdef PROBE_FORCE2
    per_cu = 2;
#endif
    grid_blocks = cus * per_cu;
    if (ws_size < OFF_END) fprintf(stderr, "workspace too small: %zu < %zu\n", ws_size, (size_t)OFF_END);
  }
  Params p{};
  for (int i = 0; i < 41; ++i) p.in[i] = (const float*)d_in[i];
  p.out = (float*)d_out; p.ws = (char*)d_ws; p.pad_ = 0;
#if MULTI_LAUNCH
  for (int ph = 0; ph < N_PHASES; ++ph) hipLaunchKernelGGL(fwd_phase_kernel, dim3(grid_blocks), dim3(NTHREADS), SMEM_BYTES, stream, p, ph);
#else
  (void)hipMemsetAsync((char*)d_ws + OFF_BAR, 0, XCD_BAR_WORDS * 4, stream);
  void* args[] = {&p};
  hipError_t e = hipLaunchCooperativeKernel((void*)fwd_megakernel, dim3(grid_blocks), dim3(NTHREADS), args, SMEM_BYTES, stream);
  if (e != hipSuccess) fprintf(stderr, "cooperative launch failed: %s (grid %d)\n", hipGetErrorString(e), grid_blocks);
#endif
}
```

```cpp
#include <hip/hip_runtime.h>
#include <hip/hip_cooperative_groups.h>
#include <cstdio>
namespace cg = cooperative_groups;

typedef _Float16 h16;
typedef _Float16 h16x8 __attribute__((ext_vector_type(8)));
typedef _Float16 h16x4 __attribute__((ext_vector_type(4)));
typedef float f32x4 __attribute__((ext_vector_type(4)));
typedef float f32x16 __attribute__((ext_vector_type(16)));
#define DI __device__ __forceinline__

constexpr int DM = 1024, NBATCH = 8, SEQ = 8192, CTXL = 256, TLAT = 65536, TCTX = 2048, TT = 67584;
constexpr int KEYS = SEQ + CTXL;
constexpr int NTHREADS = 256;
constexpr float EPS = 1e-6f;
constexpr float QSCALE = 0.10206207261596575f * 1.4426950408889634f;

constexpr int LD1 = 1088, LD2 = 2880;
constexpr long WT_WIN = 0, WT_WGATE = WT_WIN + 2432L * LD1, WT_UKV = WT_WGATE + 3072L * LD1, WT_UQ = WT_UKV + 1024L * 256,
               WT_GLU = WT_UQ + 1024L * 512, WT_BRHY = WT_GLU + 768L * 384, WT_BRS5 = WT_BRHY + 1024L * 384,
               WT_BRMLA = WT_BRS5 + 1024L * 384, WT_WO = WT_BRMLA + 1024L * 512, WT_UP = WT_WO + 1024L * LD1,
               WT_DOWN = WT_UP + 5632L * LD1, WT_LAYER = WT_DOWN + 1024L * LD2;
constexpr size_t al256(size_t x) { return (x + 255) / 256 * 256; }
constexpr size_t OFF_WT = 0;
constexpr size_t OFF_H1 = al256(OFF_WT + 2 * WT_LAYER * 2);
constexpr size_t OFF_U = al256(OFF_H1 + (size_t)TT * LD1 * 2);
constexpr size_t OFF_KVLAT = al256(OFF_U + (size_t)TT * 384 * 2);
constexpr size_t OFF_QLAT = al256(OFF_KVLAT + (size_t)TT * 256 * 2);
constexpr size_t OFF_PHY = al256(OFF_QLAT + (size_t)TT * 512 * 2);
constexpr size_t OFF_PHYC = al256(OFF_PHY + (size_t)NBATCH * 1152 * SEQ * 2);
constexpr size_t OFF_Q = al256(OFF_PHYC + (size_t)NBATCH * 1152 * CTXL * 2);
constexpr size_t OFF_K = al256(OFF_Q + (size_t)64 * KEYS * 96 * 2);
constexpr size_t OFF_VT = al256(OFF_K + (size_t)64 * KEYS * 96 * 2);
constexpr size_t OFF_YS5PRE = al256(OFF_VT + (size_t)64 * 64 * KEYS * 2);
constexpr size_t OFF_YHY = al256(OFF_YS5PRE + (size_t)TT * 384 * 2);
constexpr size_t OFF_FILT = al256(OFF_YHY + (size_t)TT * 384 * 2);
constexpr size_t OFF_TAPSC = al256(OFF_FILT + (size_t)768 * 2 * SEQ * 8);
constexpr size_t OFF_E = al256(OFF_TAPSC + (size_t)768 * 2 * CTXL * 4);
constexpr size_t OFF_XC = al256(OFF_E + (size_t)NBATCH * 2 * 24 * 132 * 64 * 8);
constexpr size_t OFF_MOD = al256(OFF_XC + (size_t)TCTX * 1024 * 4);
constexpr size_t OFF_Z2 = al256(OFF_MOD + (size_t)2 * 9 * 6144 * 4);
constexpr size_t OFF_Z2C = al256(OFF_Z2 + (size_t)2 * SEQ * 64 * 4);
constexpr size_t OFF_S5A = al256(OFF_Z2C + (size_t)2 * CTXL * 64 * 4);
constexpr size_t OFF_S5A64 = al256(OFF_S5A + (size_t)2 * 2 * 24 * 64 * 8);
constexpr size_t OFF_S5B = al256(OFF_S5A64 + (size_t)2 * 2 * 24 * 64 * 8);
constexpr size_t OFF_S5C = al256(OFF_S5B + (size_t)2 * 2 * 24 * 64 * 16 * 8);
constexpr size_t OFF_ROPE = al256(OFF_S5C + (size_t)2 * 2 * 24 * 16 * 128 * 2);
constexpr size_t OFF_BAR = al256(OFF_ROPE + (size_t)SEQ * 16 * 8);
constexpr size_t OFF_END = al256(OFF_BAR + (size_t)3456 * 4);
constexpr size_t OFF_YS5 = OFF_U, OFF_YMLA = OFF_QLAT, OFF_MERGED = OFF_Q, OFF_F = OFF_U, OFF_H2 = OFF_H1;
static_assert(OFF_END <= (size_t)1024 * 1024 * 1024, "workspace over 1 GiB");
static_assert(OFF_F + (size_t)TT * LD2 * 2 <= OFF_FILT, "f alias overruns");
static_assert(OFF_MERGED + (size_t)TT * LD1 * 2 <= OFF_VT, "merged alias overruns");

constexpr int SMEM_BYTES = 73728 + 2048;

struct Params {
  const float* in[41];
  float* out;
  char* ws;
  unsigned long long pad_;
};
enum { I_X = 0, I_C, I_CTX, I_CCTX, I_WMOD, I_BMOD, I_N1G, I_N2G, I_WIN, I_HCW, I_HCB, I_FW1, I_FB1, I_FW2, I_FB2, I_FW3, I_FFREQ,
       I_FDECAY, I_HBIAS, I_LAMRE, I_LAMIM, I_LOGSTEP, I_BRE, I_BIM, I_CRE, I_CIM, I_S5D, I_WGLU, I_GQ, I_WUQ, I_GKV, I_WUKV,
       I_WBRHY, I_WBRS5, I_WBRMLA, I_WO, I_WUP, I_FCW, I_FCB, I_WDOWN, I_FINALG };

DI int tidx() { int t = threadIdx.x; asm volatile("" : "+v"(t)); return t; }
DI int opaque_tid() { return tidx(); }
DI float sigmoidf_(float x) { return 1.f / (1.f + __expf(-x)); }
DI float siluf_(float x) { return x / (1.f + __expf(-x)); }
DI float geluf_(float x) { float z = 0.7978845608028654f * (x + 0.044715f * x * x * x); float t = 1.f - 2.f / (1.f + __expf(2.f * z)); return 0.5f * x * (1.f + t); }
DI float wave_sum(float v) { for (int o = 32; o > 0; o >>= 1) v += __shfl_xor(v, o); return v; }
DI float wave_max(float v) { for (int o = 32; o > 0; o >>= 1) v = fmaxf(v, __shfl_xor(v, o)); return v; }
DI void dsincos(double x, double& s, double& c) {
  const double TWO_PI = 6.283185307179586476925287;
  double r = x - TWO_PI * rint(x / TWO_PI);
  double r2 = r * r, ts = r, tc = 1.0; s = r; c = 1.0;
  for (int k = 1; k <= 15; ++k) { tc = -tc * r2 / (double)((2 * k - 1) * (2 * k)); c += tc; ts = -ts * r2 / (double)((2 * k) * (2 * k + 1)); s += ts; }
}
DI float2 twid(float f) { return make_float2(__builtin_amdgcn_cosf(f), __builtin_amdgcn_sinf(f)); }
DI float2 cmul(float2 a, float2 b) { return make_float2(a.x * b.x - a.y * b.y, a.x * b.y + a.y * b.x); }

struct Tok { int b, pos, ctx, mrow; };
DI Tok tokinfo(int t) { Tok k; if (t < TLAT) { k.b = t >> 13; k.pos = t & 8191; k.ctx = 0; k.mrow = k.b; } else { int u = t - TLAT; k.b = u >> 8; k.pos = u & 255; k.ctx = 1; k.mrow = 8; } return k; }

struct Stg { uint4 a0, a1, a2, a3, b0, b1, b2, b3; };
DI void g_load(Stg& s, const h16* __restrict__ A0, const h16* __restrict__ A1, const h16* __restrict__ A2, const h16* __restrict__ A3,
               const h16* __restrict__ Bp, long b32, int k0) {
  s.a0 = *reinterpret_cast<const uint4*>(A0 + k0); s.a1 = *reinterpret_cast<const uint4*>(A1 + k0);
  s.a2 = *reinterpret_cast<const uint4*>(A2 + k0); s.a3 = *reinterpret_cast<const uint4*>(A3 + k0);
  s.b0 = *reinterpret_cast<const uint4*>(Bp + k0); s.b1 = *reinterpret_cast<const uint4*>(Bp + b32 + k0);
  s.b2 = *reinterpret_cast<const uint4*>(Bp + 2 * b32 + k0); s.b3 = *reinterpret_cast<const uint4*>(Bp + 3 * b32 + k0);
}
DI uint4 zsel(uint4 v, bool ok) { return ok ? v : make_uint4(0, 0, 0, 0); }
DI void s_write(char* sw, const Stg& s, int okm) {
  *reinterpret_cast<uint4*>(sw) = zsel(s.a0, okm & 1); *reinterpret_cast<uint4*>(sw + 32 * 128) = zsel(s.a1, okm & 2);
  *reinterpret_cast<uint4*>(sw + 64 * 128) = zsel(s.a2, okm & 4); *reinterpret_cast<uint4*>(sw + 96 * 128) = zsel(s.a3, okm & 8);
  *reinterpret_cast<uint4*>(sw + 16384) = s.b0; *reinterpret_cast<uint4*>(sw + 16384 + 32 * 128) = s.b1; *reinterpret_cast<uint4*>(sw + 16384 + 64 * 128) = s.b2; *reinterpret_cast<uint4*>(sw + 16384 + 96 * 128) = s.b3;
}
#ifndef PROBE_MFMA
#define PROBE_MFMA 0
#endif
#if PROBE_MFMA
DI void mma_step(f32x4 (&acc)[4][4], const char* sa, const char* sb, int o0, int o1, f32x4 (&dmy)[2][4]) {
#else
DI void mma_step(f32x4 (&acc)[4][4], const char* sa, const char* sb, int o0, int o1) {
#endif
#pragma unroll
  for (int ks = 0; ks < 2; ++ks) {
    h16x8 af[4], bf[4];
    const int o = ks ? o1 : o0;
#pragma unroll
    for (int m = 0; m < 4; ++m) af[m] = *reinterpret_cast<const h16x8*>(sa + m * 16 * 128 + o);
#pragma unroll
    for (int n = 0; n < 4; ++n) bf[n] = *reinterpret_cast<const h16x8*>(sb + n * 16 * 128 + o);
#pragma unroll
    for (int m = 0; m < 4; ++m)
#pragma unroll
      for (int n = 0; n < 4; ++n) acc[m][n] = __builtin_amdgcn_mfma_f32_16x16x32_f16(af[m], bf[n], acc[m][n], 0, 0, 0);
#if PROBE_MFMA
#pragma unroll
    for (int m = 0; m < 2; ++m)
#pragma unroll
      for (int n = 0; n < 4; ++n) dmy[m][n] = __builtin_amdgcn_mfma_f32_16x16x32_f16(af[m + 2], bf[n], dmy[m][n], 0, 0, 0);
#endif
  }
}
DI void gemm_kloop_body(f32x4 (&acc)[4][4], const h16* __restrict__ A, long lda, int a_lo, int a_hi,
                   const h16* __restrict__ Bt, long ldb, int K, char* smem, int tid) {
  const int lane = tid & 63, wid = tid >> 6, wr = wid >> 1, wc = wid & 1, fr = lane & 15, fq = lane >> 4;
#if PROBE_MFMA
  f32x4 dmy[2][4];
  for (int m = 0; m < 2; ++m) for (int n = 0; n < 4; ++n) dmy[m][n] = f32x4{0.f, 0.f, 0.f, 0.f};
#define MMA(a, b, c, d, e) mma_step(a, b, c, d, e, dmy)
#else
#define MMA(a, b, c, d, e) mma_step(a, b, c, d, e)
#endif
  Stg s0, s1;
  const int srow = tid >> 3, skc = tid & 7;
  int okm = 0;
  const h16* Ar[4];
#pragma unroll
  for (int i = 0; i < 4; ++i) { const int row = srow + 32 * i; const bool ok = row >= a_lo && row < a_hi; okm |= ok ? (1 << i) : 0;
    const int rc = min(max(row, a_lo), a_hi - 1); Ar[i] = A + (long)rc * lda + skc * 8; }
  const h16* Bp = Bt + (long)srow * ldb + skc * 8;
  const long b32 = 32 * ldb;
  char* sw = smem + srow * 128 + ((skc ^ ((srow >> 1) & 7)) << 4);
  const char* sra = smem + (wr * 64 + fr) * 128; const char* srb = smem + 16384 + (wc * 64 + fr) * 128;
  const int o0 = (fq ^ ((fr >> 1) & 7)) << 4, o1 = ((4 + fq) ^ ((fr >> 1) & 7)) << 4;
  const int nk = K >> 6;
  g_load(s0, Ar[0], Ar[1], Ar[2], Ar[3], Bp, b32, 0); g_load(s1, Ar[0], Ar[1], Ar[2], Ar[3], Bp, b32, 64);
  s_write(sw, s0, okm); __syncthreads();
  for (int kt = 0; kt + 2 < nk; kt += 2) {
    g_load(s0, Ar[0], Ar[1], Ar[2], Ar[3], Bp, b32, (kt + 2) << 6);
    __builtin_amdgcn_sched_barrier(0);
    MMA(acc, sra, srb, o0, o1);
    __builtin_amdgcn_sched_barrier(0);
    s_write(sw + 32768, s1, okm);
    __syncthreads();
    g_load(s1, Ar[0], Ar[1], Ar[2], Ar[3], Bp, b32, (kt + 3) << 6);
    __builtin_amdgcn_sched_barrier(0);
    MMA(acc, sra + 32768, srb + 32768, o0, o1);
    __builtin_amdgcn_sched_barrier(0);
    s_write(sw, s0, okm);
    __syncthreads();
  }
  MMA(acc, sra, srb, o0, o1);
  s_write(sw + 32768, s1, okm);
  __syncthreads();
  MMA(acc, sra + 32768, srb + 32768, o0, o1);
  __syncthreads();
#if PROBE_MFMA
  { float z = 0.f; asm volatile("" : "+v"(z)); for (int m = 0; m < 2; ++m) for (int n = 0; n < 4; ++n) acc[m][n] += dmy[m][n] * z; }
#endif
#undef MMA
}
#ifndef PROBE_KLOOP
#define PROBE_KLOOP 0
#endif
DI void gemm_kloop(f32x4 (&acc)[4][4], const h16* __restrict__ A, long lda, int a_lo, int a_hi,
                   const h16* __restrict__ Bt, long ldb, int K, char* smem, int tid) {
  gemm_kloop_body(acc, A, lda, a_lo, a_hi, Bt, ldb, K, smem, tid);
}
struct TileWalk { int lb, nlb, m0, Mx, NT, nfull; };
DI TileWalk tw_init(int MT, int NT) { TileWalk w; w.lb = blockIdx.x >> 3; w.nlb = gridDim.x >> 3; w.Mx = MT >> 3; w.m0 = (blockIdx.x & 7) * w.Mx; w.NT = NT; w.nfull = (w.Mx >> 3) * 8 * NT; return w; }
DI int tw_count(const TileWalk& w) { return w.Mx * w.NT; }
DI void tw_decode(const TileWalk& w, int idx, int& mt, int& nt) {
  if (idx < w.nfull) { const int mg = idx / (8 * w.NT), r = idx % (8 * w.NT); nt = r >> 3; mt = w.m0 + mg * 8 + (r & 7); }
  else { const int rem = w.Mx & 7, r = idx - w.nfull; nt = r / rem; mt = w.m0 + (w.Mx & ~7) + r % rem; }
}
DI void stage_acc(const f32x4 (&acc)[4][4], float* Zs, int tid) {
  const int lane = tid & 63, wid = tid >> 6, wr = wid >> 1, wc = wid & 1, fr = lane & 15, fq = lane >> 4;
#pragma unroll
  for (int m = 0; m < 4; ++m)
#pragma unroll
    for (int n = 0; n < 4; ++n)
#pragma unroll
      for (int j = 0; j < 4; ++j) Zs[(wr * 64 + m * 16 + fq * 4 + j) * 132 + wc * 64 + n * 16 + fr] = acc[m][n][j];
  __syncthreads();
}
DI void stage_acc_t(const f32x4 (&acc)[4][4], float* Zs, int tid) {
  const int lane = tid & 63, wid = tid >> 6, wr = wid >> 1, wc = wid & 1, fr = lane & 15, fq = lane >> 4;
#pragma unroll
  for (int m = 0; m < 4; ++m)
#pragma unroll
    for (int n = 0; n < 4; ++n)
      *reinterpret_cast<float4*>(Zs + (wc * 64 + n * 16 + fr) * 132 + wr * 64 + m * 16 + fq * 4) = make_float4(acc[m][n][0], acc[m][n][1], acc[m][n][2], acc[m][n][3]);
  __syncthreads();
}
DI void copy_out_f16(const float* Zs, h16* __restrict__ dst, long row0, long ld, int cb, int tid) {
#pragma unroll
  for (int it = 0; it < 8; ++it) {
    const int chunk = it * 256 + tid, row = chunk >> 4, c8 = (chunk & 15) * 8;
    const float4 x0 = *reinterpret_cast<const float4*>(Zs + row * 132 + c8), x1 = *reinterpret_cast<const float4*>(Zs + row * 132 + c8 + 4);
    h16x8 o; o[0] = (h16)x0.x; o[1] = (h16)x0.y; o[2] = (h16)x0.z; o[3] = (h16)x0.w; o[4] = (h16)x1.x; o[5] = (h16)x1.y; o[6] = (h16)x1.z; o[7] = (h16)x1.w;
    *reinterpret_cast<h16x8*>(dst + (row0 + row) * ld + cb + c8) = o;
  }
}
DI void acc_zero(f32x4 (&acc)[4][4]) {
#pragma unroll
  for (int m = 0; m < 4; ++m)
#pragma unroll
    for (int n = 0; n < 4; ++n) acc[m][n] = f32x4{0.f, 0.f, 0.f, 0.f};
}
DI void row_rms(const h16* __restrict__ A, long lda, int K, float* rs) {
  const int tid = tidx(), row = tid >> 1, half = tid & 1;
  const h16* p = A + (long)row * lda + half * (K >> 1);
  float ss = 0.f;
  for (int k = 0; k < (K >> 1); k += 8) {
    h16x8 v = *reinterpret_cast<const h16x8*>(p + k);
#pragma unroll
    for (int j = 0; j < 8; ++j) { float f = (float)v[j]; ss += f * f; }
  }
  ss += __shfl_xor(ss, 1);
  if (half == 0) rs[row] = rsqrtf(ss / (float)K + EPS);
}
DI int map_interleave(int n, int half) { int tile = n >> 7, r = n & 127, sub = r >> 4, fr = r & 15; int j = tile * 64 + (sub >> 1) * 16 + fr; return (sub & 1) ? half + j : j; }
DI int map_col(int mat, int n) {
  switch (mat) {
    case 0: if (n < 640) return n; if (n < 2304) return n + 32; if (n < 2336) return n - 2304 + 640; return -1;
    case 1: return 2336 + n;
    case 3: { int h = n >> 7, j = n & 127; return j < 96 ? h * 96 + j : -1; }
    case 4: return map_interleave(n, 384);
    case 9: return map_interleave(n, 2816);
    default: return n;
  }
}
struct MatDesc { const float* src; const float* scale; long dst; int K, Nmy, Nsrc, ld; };
DI MatDesc get_mat(const Params& P, int layer, int mat) {
  MatDesc d; d.scale = nullptr;
  d.ld = (mat == 0 || mat == 1 || mat == 8 || mat == 9) ? LD1 : 0;
  switch (mat) {
    case 0: d.src = P.in[I_WIN] + (long)layer * 1024 * 5408; d.dst = WT_WIN; d.K = 1024; d.Nmy = 2432; d.Nsrc = 5408; break;
    case 1: d.src = P.in[I_WIN] + (long)layer * 1024 * 5408; d.dst = WT_WGATE; d.K = 1024; d.Nmy = 3072; d.Nsrc = 5408; break;
    case 2: d.src = P.in[I_WUKV] + (long)layer * 256 * 1024; d.dst = WT_UKV; d.K = 256; d.Nmy = 1024; d.Nsrc = 1024; d.scale = P.in[I_GKV] + layer * 256; break;
    case 3: d.src = P.in[I_WUQ] + (long)layer * 512 * 768; d.dst = WT_UQ; d.K = 512; d.Nmy = 1024; d.Nsrc = 768; d.scale = P.in[I_GQ] + layer * 512; break;
    case 4: d.src = P.in[I_WGLU] + (long)layer * 384 * 768; d.dst = WT_GLU; d.K = 384; d.Nmy = 768; d.Nsrc = 768; break;
    case 5: d.src = P.in[I_WBRHY] + (long)layer * 384 * 1024; d.dst = WT_BRHY; d.K = 384; d.Nmy = 1024; d.Nsrc = 1024; break;
    case 6: d.src = P.in[I_WBRS5] + (long)layer * 384 * 1024; d.dst = WT_BRS5; d.K = 384; d.Nmy = 1024; d.Nsrc = 1024; break;
    case 7: d.src = P.in[I_WBRMLA] + (long)layer * 512 * 1024; d.dst = WT_BRMLA; d.K = 512; d.Nmy = 1024; d.Nsrc = 1024; break;
    case 8: d.src = P.in[I_WO] + (long)layer * 1024 * 1024; d.dst = WT_WO; d.K = 1024; d.Nmy = 1024; d.Nsrc = 1024; break;
    case 9: d.src = P.in[I_WUP] + (long)layer * 1024 * 5632; d.dst = WT_UP; d.K = 1024; d.Nmy = 5632; d.Nsrc = 5632; break;
    default: d.src = P.in[I_WDOWN] + (long)layer * 2816 * 1024; d.dst = WT_DOWN; d.K = 2816; d.Nmy = 1024; d.Nsrc = 1024; d.ld = LD2; break;
  }
  if (d.ld == 0) d.ld = d.K;
  return d;
}
constexpr int WT_TILES_PER_LAYER = 608 + 768 + 64 + 128 + 72 + 96 + 96 + 128 + 256 + 1408 + 704;
DI void item_wt(const Params& P, int item, char* smem) {
  const int layer = item / WT_TILES_PER_LAYER; int r = item % WT_TILES_PER_LAYER;
  const int cnt[11] = {608, 768, 64, 128, 72, 96, 96, 128, 256, 1408, 704};
  int mat = 0;
#pragma unroll
  for (int i = 0; i < 10; ++i) { if (mat == i && r >= cnt[i]) { r -= cnt[i]; mat = i + 1; } }
  MatDesc d = get_mat(P, layer, mat);
  const int kt = d.K >> 6, n0 = (r / kt) * 64, k0 = (r % kt) * 64;
  float* tile = reinterpret_cast<float*>(smem);
  h16* dst = reinterpret_cast<h16*>(P.ws + OFF_WT) + (long)layer * WT_LAYER + d.dst;
  const int tid = tidx(), lx = tid & 63, ly = tid >> 6;
  const int sc = map_col(mat, n0 + lx);
#pragma unroll 4
  for (int i = 0; i < 16; ++i) { int kk = i * 4 + ly; tile[kk * 65 + lx] = sc >= 0 ? d.src[(long)(k0 + kk) * d.Nsrc + sc] : 0.f; }
  __syncthreads();
  const float s = d.scale ? d.scale[k0 + lx] : 1.f;
#pragma unroll 4
  for (int i = 0; i < 16; ++i) { int nn = i * 4 + ly; dst[(long)(n0 + nn) * d.ld + k0 + lx] = (h16)(tile[lx * 65 + nn] * s); }
  __syncthreads();
}
DI void item_mod(const Params& P, int item, char* smem) {
  const int layer = item / 96, n0 = (item % 96) * 64;
  float* s = reinterpret_cast<float*>(smem);
  float* part = s + 9 * 1024;
  const int tid = tidx(), lane = tid & 63, wid = tid >> 6;
  for (int i = tid; i < 9 * 1024; i += NTHREADS) { float v = i < 8192 ? P.in[I_C][i] : P.in[I_CCTX][i - 8192]; s[i] = siluf_(v); }
  __syncthreads();
  const float* w = P.in[I_WMOD] + (long)layer * 1024 * 6144 + n0 + lane;
  float acc[9];
#pragma unroll
  for (int r = 0; r < 9; ++r) acc[r] = 0.f;
#pragma unroll 32
  for (int k = wid * 256; k < wid * 256 + 256; ++k) {
    const float wv = w[(long)k * 6144];
#pragma unroll
    for (int r = 0; r < 9; ++r) acc[r] += s[r * 1024 + k] * wv;
  }
#pragma unroll
  for (int r = 0; r < 9; ++r) part[(wid * 9 + r) * 64 + lane] = acc[r];
  __syncthreads();
  float* mod = reinterpret_cast<float*>(P.ws + OFF_MOD) + (long)layer * 9 * 6144;
  for (int i = tid; i < 9 * 64; i += NTHREADS) {
    const int r = i >> 6, c = i & 63;
    mod[r * 6144 + n0 + c] = part[(0 * 9 + r) * 64 + c] + part[(1 * 9 + r) * 64 + c] + part[(2 * 9 + r) * 64 + c] + part[(3 * 9 + r) * 64 + c] + P.in[I_BMOD][layer * 6144 + n0 + c];
  }
  __syncthreads();
}
DI void item_hymlp(const Params& P, int item, char* smem) {
  const int layer = item / 132; int r = item % 132;
  const int isc = r >= 128; const int Lf = isc ? CTXL : SEQ; const int t0 = (isc ? r - 128 : r) * 64;
  float* z1 = reinterpret_cast<float*>(smem);
  const int tid = tidx(), tl = tid >> 2, h0 = (tid & 3) * 16; const int t = t0 + tl;
  const float* w1 = P.in[I_FW1] + layer * 17 * 64; const float* b1 = P.in[I_FB1] + layer * 64;
  const float* w2 = P.in[I_FW2] + layer * 64 * 64; const float* b2 = P.in[I_FB2] + layer * 64; const float* fq = P.in[I_FFREQ] + layer * 64;
  float feat[17]; feat[0] = (float)t / (float)Lf;
#pragma unroll
  for (int k = 1; k <= 8; ++k) { float rev = (float)((t * k) % Lf) / (float)Lf; feat[k] = __builtin_amdgcn_cosf(rev); feat[8 + k] = __builtin_amdgcn_sinf(rev); }
#pragma unroll 4
  for (int j = 0; j < 16; ++j) {
    const int h = h0 + j; float a = b1[h];
#pragma unroll
    for (int f = 0; f < 17; ++f) a += feat[f] * w1[f * 64 + h];
    z1[tl * 65 + h] = __sinf(fq[h] * a);
  }
  __syncthreads();
  float* z2 = isc ? reinterpret_cast<float*>(P.ws + OFF_Z2C) + (long)layer * CTXL * 64 : reinterpret_cast<float*>(P.ws + OFF_Z2) + (long)layer * SEQ * 64;
  float a2[16];
#pragma unroll
  for (int j = 0; j < 16; ++j) a2[j] = b2[h0 + j];
  for (int k = 0; k < 64; ++k) {
    const float zv = z1[tl * 65 + k];
#pragma unroll
    for (int j = 0; j < 16; ++j) a2[j] += zv * w2[k * 64 + h0 + j];
  }
#pragma unroll
  for (int j = 0; j < 16; ++j) z2[(long)t * 64 + h0 + j] = __sinf(fq[h0 + j] * a2[j]);
  __syncthreads();
}
DI void item_s5disc(const Params& P, int item) {
  const int layer = item / 12, dir = (item % 12) / 6, gb = item % 6;
  const int tid = tidx(), g = gb * 4 + (tid >> 6), n = tid & 63;
  const int ld = layer * 2 + dir; const long gi = (long)ld * 24 + g;
  const double lre = P.in[I_LAMRE][gi * 64 + n], lim = P.in[I_LAMIM][gi * 64 + n];
  const double step = exp((double)P.in[I_LOGSTEP][gi]);
  double sn, cs; dsincos(lim * step, sn, cs);
  const double mag = exp(lre * step);
  const double are = mag * cs, aim = mag * sn;
  const double nr = are - 1.0, ni = aim, den = lre * lre + lim * lim;
  const double fre = (nr * lre + ni * lim) / den, fim = (ni * lre - nr * lim) / den;
  float2* A = reinterpret_cast<float2*>(P.ws + OFF_S5A); float2* A64 = reinterpret_cast<float2*>(P.ws + OFF_S5A64);
  A[gi * 64 + n] = make_float2((float)are, (float)aim);
  double pr = are, pi = aim;
  for (int i = 0; i < 6; ++i) { double t = pr * pr - pi * pi; pi = 2.0 * pr * pi; pr = t; }
  A64[gi * 64 + n] = make_float2((float)pr, (float)pi);
  float2* Bb = reinterpret_cast<float2*>(P.ws + OFF_S5B) + (gi * 64 + n) * 16;
  const float* bre = P.in[I_BRE] + (gi * 64 + n) * 16; const float* bim = P.in[I_BIM] + (gi * 64 + n) * 16;
  for (int c = 0; c < 16; ++c) { double br = bre[c], bi = bim[c]; Bb[c] = make_float2((float)(fre * br - fim * bi), (float)(fre * bi + fim * br)); }
  h16* Ct = reinterpret_cast<h16*>(P.ws + OFF_S5C) + gi * 16 * 128;
  const float* cre = P.in[I_CRE] + gi * 16 * 64; const float* cim = P.in[I_CIM] + gi * 16 * 64;
  for (int c = 0; c < 16; ++c) { Ct[c * 128 + n] = (h16)cre[c * 64 + n]; Ct[c * 128 + 64 + n] = (h16)(-cim[c * 64 + n]); }
}
DI void item_rope(const Params& P, int item) {
  const int idx = item * NTHREADS + tidx(); const int pos = idx >> 4, i = idx & 15;
  const double inv[8] = {1.0, 0.31622776601683794, 0.1, 0.031622776601683794, 0.01, 0.0031622776601683794, 0.001, 0.00031622776601683794};
  double iv = 1.0;
#pragma unroll
  for (int k = 0; k < 8; ++k) if ((i & 7) == k) iv = inv[k];
  const double ang = (double)(i < 8 ? (pos >> 6) : (pos & 63)) * iv;
  double s, c; dsincos(ang, s, c);
  reinterpret_cast<float2*>(P.ws + OFF_ROPE)[idx] = make_float2((float)c, (float)s);
}
constexpr int PRO_N_WT = 2 * WT_TILES_PER_LAYER, PRO_N_MOD = 192, PRO_N_HY = 264, PRO_N_S5 = 24, PRO_N_ROPE = 512;
DI void phase_prologue(const Params& P, char* smem) {
  const int total = PRO_N_MOD + PRO_N_HY + PRO_N_S5 + PRO_N_ROPE + PRO_N_WT;
  for (int it = blockIdx.x; it < total; it += gridDim.x) {
    int i = it;
    if (i < PRO_N_MOD) { item_mod(P, i, smem); continue; } i -= PRO_N_MOD;
    if (i < PRO_N_HY) { item_hymlp(P, i, smem); continue; } i -= PRO_N_HY;
    if (i < PRO_N_S5) { item_s5disc(P, i); continue; } i -= PRO_N_S5;
    if (i < PRO_N_ROPE) { item_rope(P, i); continue; } i -= PRO_N_ROPE;
    item_wt(P, i, smem);
  }
}

DI const float* xrow_src(const Params& P, int layer_stage, int t) {
  if (t < TLAT) return (layer_stage == 0 ? P.in[I_X] : P.out) + (long)t * 1024;
  return (layer_stage == 0 ? P.in[I_CTX] : reinterpret_cast<const float*>(P.ws + OFF_XC)) + (long)(t - TLAT) * 1024;
}
DI float* xrow_dst(const Params& P, int t) {
  if (t < TLAT) return P.out + (long)t * 1024;
  return reinterpret_cast<float*>(P.ws + OFF_XC) + (long)(t - TLAT) * 1024;
}
DI void normmod_rows(const Params& P, int layer, int which, int stage, int ntok, int item, int nitems_stride) {
  const int tid = tidx(), lane = tid & 63, wid = tid >> 6;
  const float* g = P.in[which ? I_N2G : I_N1G] + layer * 1024;
  const float* mod = reinterpret_cast<const float*>(P.ws + OFF_MOD) + (long)layer * 9 * 6144;
  h16* H = reinterpret_cast<h16*>(P.ws + OFF_H1);
  for (int rg = item; rg * 4 < ntok; rg += nitems_stride) {
    const int t = rg * 4 + wid;
    const Tok k = tokinfo(t);
    const float* xr = xrow_src(P, stage, t);
    const float* sh = mod + k.mrow * 6144 + (which ? 3 : 0) * 1024; const float* sc = sh + 1024;
    float4 v[4]; float ss = 0.f;
#pragma unroll
    for (int i = 0; i < 4; ++i) { v[i] = *reinterpret_cast<const float4*>(xr + i * 256 + lane * 4); ss += v[i].x * v[i].x + v[i].y * v[i].y + v[i].z * v[i].z + v[i].w * v[i].w; }
    ss = wave_sum(ss);
    const float r = rsqrtf(ss * (1.f / 1024.f) + EPS);
#pragma unroll
    for (int i = 0; i < 4; ++i) {
      const int c = i * 256 + lane * 4;
      const float4 gg = *reinterpret_cast<const float4*>(g + c), s1 = *reinterpret_cast<const float4*>(sc + c), s0 = *reinterpret_cast<const float4*>(sh + c);
      h16x4 o;
      o[0] = (h16)(v[i].x * r * gg.x * (1.f + s1.x) + s0.x); o[1] = (h16)(v[i].y * r * gg.y * (1.f + s1.y) + s0.y);
      o[2] = (h16)(v[i].z * r * gg.z * (1.f + s1.z) + s0.z); o[3] = (h16)(v[i].w * r * gg.w * (1.f + s1.w) + s0.w);
      *reinterpret_cast<h16x4*>(H + (long)t * LD1 + c) = o;
    }
  }
}
DI void phase_final(const Params& P) {
  const int lane = tidx() & 63, wid = tidx() >> 6;
  const float* g = P.in[I_FINALG];
  for (int rg = blockIdx.x; rg * 4 < TLAT; rg += gridDim.x) {
    float* xr = P.out + (long)(rg * 4 + wid) * 1024;
    float4 v[4]; float ss = 0.f;
#pragma unroll
    for (int i = 0; i < 4; ++i) { v[i] = *reinterpret_cast<const float4*>(xr + i * 256 + lane * 4); ss += v[i].x * v[i].x + v[i].y * v[i].y + v[i].z * v[i].z + v[i].w * v[i].w; }
    ss = wave_sum(ss);
    const float r = rsqrtf(ss * (1.f / 1024.f) + EPS);
#pragma unroll
    for (int i = 0; i < 4; ++i) {
      const int c = i * 256 + lane * 4; const float4 gg = *reinterpret_cast<const float4*>(g + c);
      *reinterpret_cast<float4*>(xr + c) = make_float4(v[i].x * r * gg.x, v[i].y * r * gg.y, v[i].z * r * gg.z, v[i].w * r * gg.w);
    }
  }
}
DI float2 r8(int idx) { const float c = 0.70710678118654752f; return idx == 0 ? make_float2(1.f, 0.f) : idx == 1 ? make_float2(c, -c) : idx == 2 ? make_float2(0.f, -1.f) : make_float2(-c, -c); }
DI float2 cmul_r8(float2 w, int idx, bool cj) {
  if (idx == 0) return w;
  float2 r = r8(idx); if (cj) r.y = -r.y;
  return cmul(w, r);
}
template <int S> DI void fft_dif_pass(float2* X, int h) {
  const int hs = h >> (S - 1);
#pragma unroll 1
  for (int item = tidx(); item < (8192 >> S); item += NTHREADS) {
    const int j = item % hs, blk = item / hs, i0 = blk * 2 * h + j;
    float2 v[1 << S];
#pragma unroll
    for (int k = 0; k < (1 << S); ++k) v[k] = X[i0 + k * hs];
    float2 wp[S];
    wp[0] = twid(-(float)j / (float)(2 * h));
#pragma unroll
    for (int q = 1; q < S; ++q) wp[q] = cmul(wp[q - 1], wp[q - 1]);
#pragma unroll
    for (int q = 0; q < S; ++q) {
      const int dist = 1 << (S - 1 - q);
#pragma unroll
      for (int k = 0; k < (1 << S); ++k) {
        if (k & dist) continue;
        const float2 a = v[k], b = v[k + dist];
        const int m = k & (dist - 1);
        const float2 tw = cmul_r8(wp[q], m << (3 - (S - q)), false);
        v[k] = make_float2(a.x + b.x, a.y + b.y);
        v[k + dist] = cmul(make_float2(a.x - b.x, a.y - b.y), tw);
      }
    }
#pragma unroll
    for (int k = 0; k < (1 << S); ++k) X[i0 + k * hs] = v[k];
  }
  __syncthreads();
}
template <int S> DI void fft_dit_pass(float2* X, int hs) {
  const int hmax = hs << (S - 1);
#pragma unroll 1
  for (int item = tidx(); item < (8192 >> S); item += NTHREADS) {
    const int j = item % hs, blk = item / hs, i0 = blk * 2 * hmax + j;
    float2 v[1 << S];
#pragma unroll
    for (int k = 0; k < (1 << S); ++k) v[k] = X[i0 + k * hs];
    float2 bp[S];
    bp[S - 1] = twid((float)j / (float)(2 * hmax));
#pragma unroll
    for (int q = S - 2; q >= 0; --q) bp[q] = cmul(bp[q + 1], bp[q + 1]);
#pragma unroll
    for (int q = 0; q < S; ++q) {
      const int dist = 1 << q;
#pragma unroll
      for (int k = 0; k < (1 << S); ++k) {
        if (k & dist) continue;
        const int m = k & (dist - 1);
        const float2 tw = cmul_r8(bp[q], m << (3 - (q + 1)), true);
        const float2 a = v[k], b = cmul(v[k + dist], tw);
        v[k] = make_float2(a.x + b.x, a.y + b.y);
        v[k + dist] = make_float2(a.x - b.x, a.y - b.y);
      }
    }
#pragma unroll
    for (int k = 0; k < (1 << S); ++k) X[i0 + k * hs] = v[k];
  }
  __syncthreads();
}
DI void fft_fwd1(float2* X) { fft_dif_pass<3>(X, 4096); fft_dif_pass<3>(X, 512); fft_dif_pass<3>(X, 64); fft_dif_pass<2>(X, 8); fft_dif_pass<2>(X, 2); }
DI void fft_inv(float2* X) { fft_dit_pass<2>(X, 1); fft_dit_pass<2>(X, 4); fft_dit_pass<3>(X, 16); fft_dit_pass<3>(X, 128); fft_dit_pass<3>(X, 1024); }
#ifndef PROBE_FFT
#define PROBE_FFT 0
#endif
DI void fft_fwd(float2* X) {
#if PROBE_FFT
  fft_fwd1(X); fft_inv(X);
  for (int i = tidx(); i < 8192; i += NTHREADS) { float2 v = X[i]; X[i] = make_float2(v.x * (1.f / 8192.f), v.y * (1.f / 8192.f)); }
  __syncthreads();
#endif
  fft_fwd1(X);
}

DI float block_sum(float v, float* red) {
  v = wave_sum(v);
  __syncthreads();
  if ((tidx() & 63) == 0) red[tidx() >> 6] = v;
  __syncthreads();
  const float r = red[0] + red[1] + red[2] + red[3];
  __syncthreads();
  return r;
}
DI void item_filter(const Params& P, int layer, int oc, char* smem) {
  float2* X = reinterpret_cast<float2*>(smem); float* red = reinterpret_cast<float*>(smem + 65536);
  const int tid = tidx();
  const float* z2 = reinterpret_cast<const float*>(P.ws + OFF_Z2) + (long)layer * SEQ * 64;
  const float* w3 = P.in[I_FW3] + (long)layer * 64 * 1536; const float* dec = P.in[I_FDECAY] + layer * 1536;
  const int colf = oc, colb = 768 + oc;
  const float df = fabsf(dec[colf]), db = fabsf(dec[colb]);
  float lsum = 0.f;
#pragma unroll 2
  for (int i = 0; i < 32; ++i) {
    const int t = tid + 256 * i; const float* zr = z2 + (long)t * 64;
    float af = 0.f, ab = 0.f;
#pragma unroll 8
    for (int k = 0; k < 64; ++k) { const float z = zr[k]; af += z * w3[k * 1536 + colf]; ab += z * w3[k * 1536 + colb]; }
    const float tn = (float)t * (1.f / 8192.f);
    af *= __expf(-tn * df); ab *= __expf(-tn * db);
    lsum += fabsf(af) + fabsf(ab);
    X[t] = make_float2(af, ab);
  }
  const float nrm = block_sum(lsum, red);
  const float sc = 0.5f / 8192.f / nrm;
  float ev[32];
  float2* F = reinterpret_cast<float2*>(P.ws + OFF_FILT) + (long)oc * 2 * 8192;
#pragma unroll
  for (int i = 0; i < 32; ++i) {
    const int n = tid + 256 * i; const float lo = X[n].x; const float hi = n > 0 ? X[8192 - n].y : 0.f;
    ev[i] = (lo + hi) * sc; F[8192 + n] = make_float2((lo - hi) * sc, 0.f);
  }
  __syncthreads();
#pragma unroll
  for (int i = 0; i < 32; ++i) X[tid + 256 * i] = make_float2(ev[i], 0.f);
  __syncthreads();
  fft_fwd(X);
#pragma unroll 4
  for (int i = 0; i < 32; ++i) F[tid + 256 * i] = X[tid + 256 * i];
  __syncthreads();
#pragma unroll 4
  for (int i = 0; i < 32; ++i) { const int n = tid + 256 * i; const float d = F[8192 + n].x; const float2 w = twid(-(float)n * (1.f / 16384.f)); X[n] = make_float2(d * w.x, d * w.y); }
  __syncthreads();
  fft_fwd(X);
#pragma unroll 4
  for (int i = 0; i < 32; ++i) F[8192 + tid + 256 * i] = X[tid + 256 * i];
  __syncthreads();
}
DI void item_filter_ctx(const Params& P, int layer, int oc, char* smem) {
  float* red = reinterpret_cast<float*>(smem);
  const int t = tidx();
  const float* zr = reinterpret_cast<const float*>(P.ws + OFF_Z2C) + (long)layer * CTXL * 64 + t * 64;
  const float* w3 = P.in[I_FW3] + (long)layer * 64 * 1536; const float* dec = P.in[I_FDECAY] + layer * 1536;
  float af = 0.f, ab = 0.f;
  for (int k = 0; k < 64; ++k) { const float z = zr[k]; af += z * w3[k * 1536 + oc]; ab += z * w3[k * 1536 + 768 + oc]; }
  const float tn = (float)t * (1.f / 256.f);
  af *= __expf(-tn * fabsf(dec[oc])); ab *= __expf(-tn * fabsf(dec[768 + oc]));
  const float nrm = block_sum(fabsf(af) + fabsf(ab), red);
  float* T = reinterpret_cast<float*>(P.ws + OFF_TAPSC) + (long)oc * 512;
  T[t] = af / nrm; T[256 + t] = ab / nrm;
}

DI void phase_norm1(const Params& P, int layer, char* smem) {
  const int nfilt = 768 + (layer == 0 ? 768 : 0);
  for (int it = blockIdx.x; it < nfilt; it += gridDim.x) {
    if (it < 768) item_filter(P, layer, it, smem); else item_filter_ctx(P, layer, it - 768, smem);
  }
  normmod_rows(P, layer, 0, layer, TT, blockIdx.x, gridDim.x);
}

DI void phase_gemm_in(const Params& P, int layer, char* smem) {
  const int tid = tidx(), lane = tid & 63, wid = tid >> 6, wr = wid >> 1, wc = wid & 1, fr = lane & 15, fq = lane >> 4;
  const h16* H = reinterpret_cast<const h16*>(P.ws + OFF_H1);
  const h16* W = reinterpret_cast<const h16*>(P.ws + OFF_WT) + (long)layer * WT_LAYER + WT_WIN;
  h16* U = reinterpret_cast<h16*>(P.ws + OFF_U); h16* KV = reinterpret_cast<h16*>(P.ws + OFF_KVLAT); h16* QL = reinterpret_cast<h16*>(P.ws + OFF_QLAT);
  h16* PHY = reinterpret_cast<h16*>(P.ws + OFF_PHY); h16* PHYC = reinterpret_cast<h16*>(P.ws + OFF_PHYC); h16* Kb = reinterpret_cast<h16*>(P.ws + OFF_K);
  const float2* rope = reinterpret_cast<const float2*>(P.ws + OFF_ROPE);
  constexpr int NT = 19, MT = TT / 128;
  const TileWalk tw = tw_init(MT, NT);
  for (int tile = tw.lb; tile < tw_count(tw); tile += tw.nlb) {
    int mt, nt; tw_decode(tw, tile, mt, nt);
    f32x4 acc[4][4]; acc_zero(acc);
    gemm_kloop(acc, H + (long)mt * 128 * LD1, LD1, 0, 128, W + (long)nt * 128 * LD1, LD1, 1024, smem, opaque_tid());
    const int t0 = mt * 128; const Tok tk = tokinfo(t0);
    if (nt < 18) {
      float* Zs = reinterpret_cast<float*>(smem);
      const int t2 = tidx();
      if (nt < 9) {
        stage_acc(acc, Zs, t2);
        h16* dst; int ld, cb;
        if (nt < 3) { dst = U; ld = 384; cb = nt * 128; } else if (nt < 5) { dst = KV; ld = 256; cb = (nt - 3) * 128; } else { dst = QL; ld = 512; cb = (nt - 5) * 128; }
        copy_out_f16(Zs, dst, t0, ld, cb, t2);
      } else {
        stage_acc_t(acc, Zs, t2);
        h16* base = tk.ctx ? PHYC + (long)tk.b * 1152 * CTXL : PHY + (long)tk.b * 1152 * SEQ; const int lp = tk.ctx ? CTXL : SEQ;
        copy_out_f16(Zs, base, (nt - 9) * 128, lp, tk.pos, t2);
      }
      __syncthreads();
    } else {
      h16* R = reinterpret_cast<h16*>(smem);
      if (wc == 0) {
#pragma unroll
        for (int m = 0; m < 4; ++m)
#pragma unroll
          for (int j = 0; j < 4; ++j) {
            const int row = wr * 64 + m * 16 + fq * 4 + j; const int pos = tk.pos + row;
            float x1 = acc[m][0][j], x2 = acc[m][1][j];
            if (!tk.ctx) { const float2 cs = rope[pos * 16 + fr]; const float y1 = x1 * cs.x - x2 * cs.y, y2 = x1 * cs.y + x2 * cs.x; x1 = y1; x2 = y2; }
            R[row * 32 + fr] = (h16)x1; R[row * 32 + 16 + fr] = (h16)x2;
          }
      }
      __syncthreads();
      {
        const int t2 = tidx(); const int key0 = (tk.ctx ? SEQ : 0) + tk.pos;
#pragma unroll
        for (int it = 0; it < 2; ++it) {
          const int chunk = it * 256 + t2, row = chunk >> 2, part = chunk & 3;
          const uint4 v = *reinterpret_cast<const uint4*>(R + row * 32 + part * 8);
#pragma unroll
          for (int h = 0; h < 8; ++h) *reinterpret_cast<uint4*>(Kb + ((long)(tk.b * 8 + h) * KEYS + key0 + row) * 96 + 64 + part * 8) = v;
        }
      }
      __syncthreads();
    }
  }
}
DI void item_kv(const Params& P, int layer, int tile, char* smem) {
  const int tid = tidx(), lane = tid & 63, wid = tid >> 6, wr = wid >> 1, wc = wid & 1, fr = lane & 15, fq = lane >> 4;
  const int mt = tile >> 3, hd = tile & 7; const int t0 = mt * 128; const Tok tk = tokinfo(t0);
  const h16* A = reinterpret_cast<const h16*>(P.ws + OFF_KVLAT) + (long)t0 * 256;
  const h16* W = reinterpret_cast<const h16*>(P.ws + OFF_WT) + (long)layer * WT_LAYER + WT_UKV + (long)hd * 128 * 256;
  float* rs = reinterpret_cast<float*>(smem + 73728);
  row_rms(A, 256, 256, rs);
  f32x4 acc[4][4]; acc_zero(acc);
  gemm_kloop(acc, A, 256, 0, 128, W, 256, 256, smem, opaque_tid());
  h16* Kb = reinterpret_cast<h16*>(P.ws + OFF_K) + (long)(tk.b * 8 + hd) * KEYS * 96;
  h16* Vt = reinterpret_cast<h16*>(P.ws + OFF_VT) + (long)(tk.b * 8 + hd) * 64 * KEYS;
  const int key0 = (tk.ctx ? SEQ : 0) + tk.pos;
#pragma unroll
  for (int m = 0; m < 4; ++m) {
    const int r0 = wr * 64 + m * 16 + fq * 4;
    const float s0 = rs[r0], s1 = rs[r0 + 1], s2 = rs[r0 + 2], s3 = rs[r0 + 3];
#pragma unroll
    for (int n = 0; n < 4; ++n) {
      acc[m][n][0] *= s0; acc[m][n][1] *= s1; acc[m][n][2] *= s2; acc[m][n][3] *= s3;
      if (wc == 1) {
        h16x4 o; o[0] = (h16)acc[m][n][0]; o[1] = (h16)acc[m][n][1]; o[2] = (h16)acc[m][n][2]; o[3] = (h16)acc[m][n][3];
        *reinterpret_cast<h16x4*>(Vt + (long)(n * 16 + fr) * KEYS + key0 + r0) = o;
      }
    }
  }
  {
    float* Zs = reinterpret_cast<float*>(smem);
    const int t2 = tidx();
    stage_acc(acc, Zs, t2);
#pragma unroll
    for (int it = 0; it < 4; ++it) {
      const int chunk = it * 256 + t2, row = chunk >> 3, c8 = (chunk & 7) * 8;
      const float4 x0 = *reinterpret_cast<const float4*>(Zs + row * 132 + c8), x1 = *reinterpret_cast<const float4*>(Zs + row * 132 + c8 + 4);
      h16x8 o; o[0] = (h16)x0.x; o[1] = (h16)x0.y; o[2] = (h16)x0.z; o[3] = (h16)x0.w; o[4] = (h16)x1.x; o[5] = (h16)x1.y; o[6] = (h16)x1.z; o[7] = (h16)x1.w;
      *reinterpret_cast<h16x8*>(Kb + (long)(key0 + row) * 96 + c8) = o;
    }
  }
  __syncthreads();
}
DI void item_q(const Params& P, int layer, int tile, char* smem) {
  const int tid = tidx(), lane = tid & 63, wid = tid >> 6, wr = wid >> 1, wc = wid & 1, fr = lane & 15, fq = lane >> 4;
  const int mt = tile >> 3, hd = tile & 7; const int t0 = mt * 128; const Tok tk = tokinfo(t0);
  const h16* A = reinterpret_cast<const h16*>(P.ws + OFF_QLAT) + (long)t0 * 512;
  const h16* W = reinterpret_cast<const h16*>(P.ws + OFF_WT) + (long)layer * WT_LAYER + WT_UQ + (long)hd * 128 * 512;
  float* rs = reinterpret_cast<float*>(smem + 73728);
  row_rms(A, 512, 512, rs);
  f32x4 acc[4][4]; acc_zero(acc);
  gemm_kloop(acc, A, 512, 0, 128, W, 512, 512, smem, opaque_tid());
  h16* Qb = reinterpret_cast<h16*>(P.ws + OFF_Q) + (long)(tk.b * 8 + hd) * KEYS * 96;
  const float2* rope = reinterpret_cast<const float2*>(P.ws + OFF_ROPE);
  const int q0 = (tk.ctx ? SEQ : 0) + tk.pos;
#pragma unroll
  for (int m = 0; m < 4; ++m)
#pragma unroll
    for (int j = 0; j < 4; ++j) {
      const int r = wr * 64 + m * 16 + fq * 4 + j; const float s = rs[r] * QSCALE;
      if (wc == 0) {
#pragma unroll
        for (int n = 0; n < 4; ++n) acc[m][n][j] *= s;
      } else {
        float x1 = acc[m][0][j], x2 = acc[m][1][j];
        if (!tk.ctx) { const float2 cs = rope[(tk.pos + r) * 16 + fr]; const float y1 = x1 * cs.x - x2 * cs.y, y2 = x1 * cs.y + x2 * cs.x; x1 = y1; x2 = y2; }
        acc[m][0][j] = x1 * s; acc[m][1][j] = x2 * s;
      }
    }
  {
    float* Zs = reinterpret_cast<float*>(smem);
    const int t2 = tidx();
    stage_acc(acc, Zs, t2);
#pragma unroll
    for (int it = 0; it < 6; ++it) {
      const int chunk = it * 256 + t2, row = chunk / 12, c8 = (chunk % 12) * 8;
      const float4 x0 = *reinterpret_cast<const float4*>(Zs + row * 132 + c8), x1 = *reinterpret_cast<const float4*>(Zs + row * 132 + c8 + 4);
      h16x8 o; o[0] = (h16)x0.x; o[1] = (h16)x0.y; o[2] = (h16)x0.z; o[3] = (h16)x0.w; o[4] = (h16)x1.x; o[5] = (h16)x1.y; o[6] = (h16)x1.z; o[7] = (h16)x1.w;
      *reinterpret_cast<h16x8*>(Qb + (long)(q0 + row) * 96 + c8) = o;
    }
  }
  __syncthreads();
}
DI int s5_chunk_base(int b, int dir, int si) {
  if (si < 4) { const int cc = dir ? 3 - si : si; return TLAT + b * CTXL + cc * 64; }
  const int lc = dir ? 127 - (si - 4) : si - 4; return b * SEQ + lc * 64;
}
DI void s5_stage_u(const h16* __restrict__ U, int tokbase, int g, float* us) {
  const int lane = tidx() & 63;
  const h16* p = U + (long)(tokbase + lane) * 384 + g * 16;
  const h16x8 v0 = *reinterpret_cast<const h16x8*>(p), v1 = *reinterpret_cast<const h16x8*>(p + 8);
#pragma unroll
  for (int j = 0; j < 8; ++j) { us[lane * 16 + j] = (float)v0[j]; us[lane * 16 + 8 + j] = (float)v1[j]; }
}
DI void item_s5_pass1(const Params& P, int layer, int wtask, char* smem) {
  const int lane = tidx() & 63, wid = tidx() >> 6;
  float* us = reinterpret_cast<float*>(smem + wid * 12800);
  const int si = wtask % 132; int r = wtask / 132; const int g = r % 24; r /= 24; const int dir = r & 1, b = r >> 1;
  const long gi = (long)(layer * 2 + dir) * 24 + g;
  const float2 a = reinterpret_cast<const float2*>(P.ws + OFF_S5A)[gi * 64 + lane];
  const float2* Bb = reinterpret_cast<const float2*>(P.ws + OFF_S5B) + (gi * 64 + lane) * 16;
  float bre[16], bim[16];
#pragma unroll
  for (int c = 0; c < 16; ++c) { const float2 v = Bb[c]; bre[c] = v.x; bim[c] = v.y; }
  s5_stage_u(reinterpret_cast<const h16*>(P.ws + OFF_U), s5_chunk_base(b, dir, si), g, us);
  float hr = 0.f, hi = 0.f;
#pragma unroll 4
  for (int s = 0; s < 64; ++s) {
    const int tau = dir ? 63 - s : s;
    const float4* up = reinterpret_cast<const float4*>(us + tau * 16);
    float br = 0.f, bi = 0.f;
#pragma unroll
    for (int q = 0; q < 4; ++q) { const float4 u = up[q];
      br += bre[q * 4] * u.x + bre[q * 4 + 1] * u.y + bre[q * 4 + 2] * u.z + bre[q * 4 + 3] * u.w;
      bi += bim[q * 4] * u.x + bim[q * 4 + 1] * u.y + bim[q * 4 + 2] * u.z + bim[q * 4 + 3] * u.w; }
    const float nr = a.x * hr - a.y * hi + br, ni = a.x * hi + a.y * hr + bi; hr = nr; hi = ni;
  }
  reinterpret_cast<float2*>(P.ws + OFF_E)[((long)((b * 2 + dir) * 24 + g) * 132 + si) * 64 + lane] = make_float2(hr, hi);
}

DI float hy_dw(const h16* __restrict__ p, int t, int Ls, float w0, float w1, float w2, float bias) {
  const float xm_ = (float)p[max(t - 1, 0)], x0 = (float)p[t], xp_ = (float)p[min(t + 1, Ls - 1)];
  const float xm = t > 0 ? xm_ : 0.f, xp = t + 1 < Ls ? xp_ : 0.f;
  return xm * w0 + x0 * w1 + xp * w2 + bias;
}
DI void item_hyena(const Params& P, int layer, int task, char* smem) {
  float2* X = reinterpret_cast<float2*>(smem);
  const int tid = tidx(); const int pair = task / 384, c = task % 384;
  const h16* PH0 = reinterpret_cast<const h16*>(P.ws + OFF_PHY) + (long)(2 * pair) * 1152 * SEQ;
  const h16* PH1 = PH0 + (long)1152 * SEQ;
  const float* cw = P.in[I_HCW] + layer * 3 * 1152; const float* cb = P.in[I_HCB] + layer * 1152;
  const float2* F = reinterpret_cast<const float2*>(P.ws + OFF_FILT);
  float2* SCR = reinterpret_cast<float2*>(P.ws + OFF_YS5PRE) + (long)blockIdx.x * 12288;
  float2* SCR2 = SCR + 8192;
  const float vw0 = cw[c], vw1 = cw[1152 + c], vw2 = cw[2304 + c], vbb = cb[c];
  const h16* pv0 = PH0 + (long)c * SEQ; const h16* pv1 = PH1 + (long)c * SEQ;
  float2 ye[16]; int tq;
#pragma unroll 1
  for (int o = 0; o < 2; ++o) {
    const float2* Te = F + (long)(o * 384 + c) * 2 * 8192; const float2* To = Te + 8192;
    float ts = 1.f / 16384.f; asm volatile("" : "+v"(ts));
{ tq = tid; asm volatile("" : "+v"(tq)); }
    if (o == 0) {
#pragma unroll 8
      for (int i = 0; i < 32; ++i) { const int t = tq + 256 * i; const float2 v = make_float2(hy_dw(pv0, t, SEQ, vw0, vw1, vw2, vbb), hy_dw(pv1, t, SEQ, vw0, vw1, vw2, vbb)); X[t] = v; SCR[t] = v; }
    } else {
#pragma unroll 16
      for (int i = 0; i < 32; ++i) { const int t = tq + 256 * i; X[t] = SCR[t]; }
    }
    __syncthreads();
    fft_fwd(X);
{ tq = tid; asm volatile("" : "+v"(tq)); }
#pragma unroll 8
    for (int i = 0; i < 32; ++i) { const int n = tq + 256 * i; X[n] = cmul(X[n], Te[n]); }
    __syncthreads();
    fft_inv(X);
{ tq = tid; asm volatile("" : "+v"(tq)); }
#pragma unroll
    for (int i = 0; i < 16; ++i) { ye[i] = X[tq + 256 * i]; SCR2[tq + 256 * i] = X[tq + 4096 + 256 * i]; }
    __syncthreads();
{ tq = tid; asm volatile("" : "+v"(tq)); }
#pragma unroll 16
    for (int i = 0; i < 32; ++i) { const int t = tq + 256 * i; X[t] = cmul(SCR[t], twid(-(float)t * ts)); }
    __syncthreads();
    fft_fwd(X);
{ tq = tid; asm volatile("" : "+v"(tq)); }
#pragma unroll 8
    for (int i = 0; i < 32; ++i) { const int n = tq + 256 * i; X[n] = cmul(X[n], To[n]); }
    __syncthreads();
    fft_inv(X);
    asm volatile("" : "+v"(ts));
{ tq = tid; asm volatile("" : "+v"(tq)); }
#pragma unroll
    for (int i = 0; i < 16; ++i) { const int t = tq + 256 * i; const float2 yo = cmul(X[t], twid((float)t * ts)); X[t] = make_float2(ye[i].x + yo.x, ye[i].y + yo.y); }
{ tq = tid; asm volatile("" : "+v"(tq)); }
#pragma unroll 2
    for (int i = 0; i < 16; ++i) { const int t = tq + 4096 + 256 * i; const float2 yo = cmul(X[t], twid((float)t * ts)); const float2 y2 = SCR2[tq + 256 * i]; X[t] = make_float2(y2.x + yo.x, y2.y + yo.y); }
    const int gc = (o + 1) * 384 + c;
    const float w0 = cw[gc], w1 = cw[1152 + gc], w2 = cw[2304 + gc], bb = cb[gc];
    const float bias = P.in[I_HBIAS][(layer * 2 + o) * 384 + c];
    const h16* pg0 = PH0 + (long)gc * SEQ; const h16* pg1 = PH1 + (long)gc * SEQ;
{ tq = tid; asm volatile("" : "+v"(tq)); }
    if (o == 0) {
#pragma unroll 8
      for (int i = 0; i < 32; ++i) {
        const int t = tq + 256 * i;
        const float2 lc = X[t];
        const float2 zz = SCR[t];
        const float gx = hy_dw(pg0, t, SEQ, w0, w1, w2, bb), gy = hy_dw(pg1, t, SEQ, w0, w1, w2, bb);
        SCR[t] = make_float2(gx * (lc.x + bias * zz.x), gy * (lc.y + bias * zz.y));
      }
    } else {
#pragma unroll 8
      for (int i = 0; i < 32; ++i) {
        const int t = tq + 256 * i;
        const float2 lc = X[t];
        const float2 zz = SCR[t];
        const float gx = hy_dw(pg0, t, SEQ, w0, w1, w2, bb), gy = hy_dw(pg1, t, SEQ, w0, w1, w2, bb);
        const_cast<h16*>(pv0)[t] = (h16)(gx * (lc.x + bias * zz.x)); const_cast<h16*>(pv1)[t] = (h16)(gy * (lc.y + bias * zz.y));
      }
    }
    __syncthreads();
  }
}
DI void item_hyena_ctx(const Params& P, int layer, int task, char* smem) {
  float* su = reinterpret_cast<float*>(smem); float* sf = su + 256; float* sb = sf + 256;
  const int t = tidx(); const int b = task / 384, c = task % 384;
  const h16* PH = reinterpret_cast<const h16*>(P.ws + OFF_PHYC) + (long)b * 1152 * CTXL;
  const float* cw = P.in[I_HCW] + layer * 3 * 1152; const float* cb = P.in[I_HCB] + layer * 1152;
  float u = hy_dw(PH + (long)c * CTXL, t, CTXL, cw[c], cw[1152 + c], cw[2304 + c], cb[c]);
  for (int o = 0; o < 2; ++o) {
    const float* T = reinterpret_cast<const float*>(P.ws + OFF_TAPSC) + (long)(o * 384 + c) * 512;
    __syncthreads();
    su[t] = u; sf[t] = T[t]; sb[t] = T[256 + t];
    __syncthreads();
    float y = 0.f;
    for (int s = 0; s <= t; ++s) y += sf[t - s] * su[s];
    for (int s = t + 1; s < 256; ++s) y += sb[s - t] * su[s];
    const int gc = (o + 1) * 384 + c;
    const float gx = hy_dw(PH + (long)gc * CTXL, t, CTXL, cw[gc], cw[1152 + gc], cw[2304 + gc], cb[gc]);
    u = gx * (y + P.in[I_HBIAS][(layer * 2 + o) * 384 + c] * u);
  }
  reinterpret_cast<h16*>(P.ws + OFF_YHY)[((long)TLAT + b * CTXL + t) * 384 + c] = (h16)u;
  __syncthreads();
}

#ifndef PROBE_HY
#define PROBE_HY 0
#endif
#ifndef PROBE_S5
#define PROBE_S5 0
#endif
DI int first_item(int base) { const int g = (int)gridDim.x; return (((int)blockIdx.x - base) % g + g) % g; }
DI void phase_mix1(const Params& P, int layer, char* smem) {
  const int n_hy = 4 * 384, n_hyc = layer == 0 ? 8 * 384 : 0;
  const int n_kv = (TT / 128) * 8, n_q = (layer == 0 ? TT / 128 : TLAT / 128) * 8;
  const int n_s5 = (NBATCH * 2 * 24 * 132) / 4;
  const int g = gridDim.x;
#pragma unroll 1
  for (int rep = 0; rep < 1 + PROBE_HY; ++rep)
#pragma unroll 1
  for (int i = first_item(0); i < n_hy; i += g) item_hyena(P, layer, i, smem);
  asm volatile("" ::: "memory");
#pragma unroll 1
  for (int i = first_item(n_hy); i < n_kv; i += g) item_kv(P, layer, i, smem);
  asm volatile("" ::: "memory");
#pragma unroll 1
  for (int i = first_item(n_hy + n_kv); i < n_q; i += g) item_q(P, layer, i, smem);
  asm volatile("" ::: "memory");
#pragma unroll 1
  for (int rep = 0; rep < 1 + PROBE_S5; ++rep)
#pragma unroll 1
  for (int i = first_item(n_hy + n_kv + n_q); i < n_s5; i += g) { item_s5_pass1(P, layer, i * 4 + (tidx() >> 6), smem); __syncthreads(); }
  asm volatile("" ::: "memory");
#pragma unroll 1
  for (int i = first_item(n_hy + n_kv + n_q + n_s5); i < n_hyc; i += g) item_hyena_ctx(P, layer, i, smem);
}
DI int crow32(int r, int hi) { return (r & 3) + 8 * (r >> 2) + 4 * hi; }
DI void item_attn(const Params& P, int bh, int q0, int key_lo, int ntiles, char* smem) {
  const int tid = tidx(), lane = tid & 63, wid = tid >> 6, r32 = lane & 31, hi = lane >> 5;
  const h16* Qb = reinterpret_cast<const h16*>(P.ws + OFF_Q) + (long)bh * KEYS * 96;
  const h16* Kb = reinterpret_cast<const h16*>(P.ws + OFF_K) + (long)bh * KEYS * 96;
  const h16* Vt = reinterpret_cast<const h16*>(P.ws + OFF_VT) + (long)bh * 64 * KEYS;
  h16x8 qf[6];
  { const h16* qrow = Qb + (long)(q0 + wid * 32 + r32) * 96 + hi * 8;
#pragma unroll
    for (int ds = 0; ds < 6; ++ds) qf[ds] = *reinterpret_cast<const h16x8*>(qrow + ds * 16); }
  constexpr int KT_BYTES = 64 * 208, VT_BYTES = 64 * 136, BUF = KT_BYTES + VT_BYTES;
  uint4 kr[3]; uint4 vr[2];
  const int vdv0 = tid >> 3, vpart = tid & 7;
  auto gload = [&](int j) {
    const long key0 = key_lo + j * 64;
#pragma unroll
    for (int i = 0; i < 3; ++i) kr[i] = *reinterpret_cast<const uint4*>(Kb + key0 * 96 + (long)(tid + 256 * i) * 8);
#pragma unroll
    for (int i = 0; i < 2; ++i) vr[i] = *reinterpret_cast<const uint4*>(Vt + (long)(vdv0 + 32 * i) * KEYS + key0 + vpart * 8);
  };
  auto swrite = [&](int buf) {
    char* ks = smem + buf * BUF; char* vs = ks + KT_BYTES;
#pragma unroll
    for (int i = 0; i < 3; ++i) { const int c = tid + 256 * i; *reinterpret_cast<uint4*>(ks + (c / 12) * 208 + (c % 12) * 16) = kr[i]; }
#pragma unroll
    for (int i = 0; i < 2; ++i) { char* d = vs + (vdv0 + 32 * i) * 136 + vpart * 16;
      *reinterpret_cast<uint2*>(d) = make_uint2(vr[i].x, vr[i].y); *reinterpret_cast<uint2*>(d + 8) = make_uint2(vr[i].z, vr[i].w); }
  };
  f32x16 o0, o1;
#pragma unroll
  for (int r = 0; r < 16; ++r) { o0[r] = 0.f; o1[r] = 0.f; }
  float m_run = -1e30f, l_run = 0.f;
  gload(0); swrite(0); __syncthreads();
  for (int j = 0; j < ntiles; ++j) {
    if (j + 1 < ntiles) gload(j + 1);
    const char* ks = smem + (j & 1) * BUF; const char* vs = ks + KT_BYTES;
    f32x16 p0, p1;
#pragma unroll
    for (int r = 0; r < 16; ++r) { p0[r] = 0.f; p1[r] = 0.f; }
#pragma unroll
    for (int ds = 0; ds < 6; ++ds) {
      const h16x8 a0 = *reinterpret_cast<const h16x8*>(ks + r32 * 208 + (ds * 16 + hi * 8) * 2);
      const h16x8 a1 = *reinterpret_cast<const h16x8*>(ks + (32 + r32) * 208 + (ds * 16 + hi * 8) * 2);
      p0 = __builtin_amdgcn_mfma_f32_32x32x16_f16(a0, qf[ds], p0, 0, 0, 0);
      p1 = __builtin_amdgcn_mfma_f32_32x32x16_f16(a1, qf[ds], p1, 0, 0, 0);
    }
    float mx = p0[0];
#pragma unroll
    for (int r = 1; r < 16; ++r) mx = fmaxf(mx, p0[r]);
#pragma unroll
    for (int r = 0; r < 16; ++r) mx = fmaxf(mx, p1[r]);
    mx = fmaxf(mx, __shfl_xor(mx, 32));
    const float mnew = fmaxf(m_run, mx);
    const float alpha = __builtin_amdgcn_exp2f(m_run - mnew);
    m_run = mnew;
    float rsum = 0.f;
#pragma unroll
    for (int r = 0; r < 16; ++r) { p0[r] = __builtin_amdgcn_exp2f(p0[r] - mnew); rsum += p0[r]; }
#pragma unroll
    for (int r = 0; r < 16; ++r) { p1[r] = __builtin_amdgcn_exp2f(p1[r] - mnew); rsum += p1[r]; }
    l_run = l_run * alpha + rsum;
    if (__any(alpha != 1.f)) {
#pragma unroll
      for (int r = 0; r < 16; ++r) { o0[r] *= alpha; o1[r] *= alpha; }
    }
#pragma unroll
    for (int kb = 0; kb < 2; ++kb)
#pragma unroll
      for (int s = 0; s < 2; ++s) {
        h16x8 pf;
#pragma unroll
        for (int e = 0; e < 8; ++e) pf[e] = (h16)(kb ? p1[8 * s + e] : p0[8 * s + e]);
        const int koff = (32 * kb + 16 * s + 4 * hi) * 2;
        {
          const h16x4 lo = *reinterpret_cast<const h16x4*>(vs + r32 * 136 + koff), hh = *reinterpret_cast<const h16x4*>(vs + r32 * 136 + koff + 16);
          const h16x8 af = __builtin_shufflevector(lo, hh, 0, 1, 2, 3, 4, 5, 6, 7);
          o0 = __builtin_amdgcn_mfma_f32_32x32x16_f16(af, pf, o0, 0, 0, 0);
        }
        {
          const h16x4 lo = *reinterpret_cast<const h16x4*>(vs + (32 + r32) * 136 + koff), hh = *reinterpret_cast<const h16x4*>(vs + (32 + r32) * 136 + koff + 16);
          const h16x8 af = __builtin_shufflevector(lo, hh, 0, 1, 2, 3, 4, 5, 6, 7);
          o1 = __builtin_amdgcn_mfma_f32_32x32x16_f16(af, pf, o1, 0, 0, 0);
        }
      }
    if (j + 1 < ntiles) swrite((j + 1) & 1);
    __syncthreads();
  }
  const float lt = l_run + __shfl_xor(l_run, 32);
  const float inv = 1.f / lt;
  {
    h16* Os = reinterpret_cast<h16*>(smem);
    h16* orow = Os + (wid * 32 + r32) * 72;
#pragma unroll
    for (int g = 0; g < 4; ++g) {
      h16x4 a, c;
#pragma unroll
      for (int e = 0; e < 4; ++e) { a[e] = (h16)(o0[4 * g + e] * inv); c[e] = (h16)(o1[4 * g + e] * inv); }
      *reinterpret_cast<h16x4*>(orow + 8 * g + 4 * hi) = a;
      *reinterpret_cast<h16x4*>(orow + 32 + 8 * g + 4 * hi) = c;
    }
    __syncthreads();
    const int b = bh >> 3, hd = bh & 7;
    const long tok0 = q0 < SEQ ? (long)b * SEQ + q0 : (long)TLAT + b * CTXL + (q0 - SEQ);
    h16* yb = reinterpret_cast<h16*>(P.ws + OFF_YMLA) + tok0 * 512 + hd * 64;
#pragma unroll
    for (int it = 0; it < 4; ++it) {
      const int chunk = it * 256 + tid, row = chunk >> 3, c8 = (chunk & 7) * 8;
      *reinterpret_cast<uint4*>(yb + (long)row * 512 + c8) = *reinterpret_cast<const uint4*>(Os + row * 72 + c8);
    }
    __syncthreads();
  }
}
DI void item_s5_pass3(const Params& P, int layer, int b, int g, int ck, char* smem) {
  const int lane = tidx() & 63, wid = tidx() >> 6, fr = lane & 15, fq = lane >> 4;
  float* us = reinterpret_cast<float*>(smem + wid * 12800); char* Hs = smem + wid * 12800 + 4096;
  const int tokbase = ck < 4 ? TLAT + b * CTXL + ck * 64 : b * SEQ + (ck - 4) * 64;
  s5_stage_u(reinterpret_cast<const h16*>(P.ws + OFF_U), tokbase, g, us);
  __syncthreads();
  f32x4 yacc[4];
#pragma unroll
  for (int i = 0; i < 4; ++i) yacc[i] = f32x4{0.f, 0.f, 0.f, 0.f};
#pragma unroll
  for (int dir = 0; dir < 2; ++dir) {
    const long gi = (long)(layer * 2 + dir) * 24 + g;
    const float2 a = reinterpret_cast<const float2*>(P.ws + OFF_S5A)[gi * 64 + lane];
    const float2 a64 = reinterpret_cast<const float2*>(P.ws + OFF_S5A64)[gi * 64 + lane];
    const float2* Bb = reinterpret_cast<const float2*>(P.ws + OFF_S5B) + (gi * 64 + lane) * 16;
    float bre[16], bim[16];
#pragma unroll
    for (int c = 0; c < 16; ++c) { const float2 v = Bb[c]; bre[c] = v.x; bim[c] = v.y; }
    const int si = ck < 4 ? (dir ? 3 - ck : ck) : 4 + (dir ? 127 - (ck - 4) : ck - 4);
    const float2* Ep = reinterpret_cast<const float2*>(P.ws + OFF_E) + ((long)((b * 2 + dir) * 24 + g) * 132) * 64 + lane;
    float hr = 0.f, hi = 0.f;
#pragma unroll 16
    for (int i = 0; i < si; ++i) { const float2 e = Ep[(long)i * 64]; const float nr = a64.x * hr - a64.y * hi + e.x, ni = a64.x * hi + a64.y * hr + e.y; hr = nr; hi = ni; }
    const h16* Ct = reinterpret_cast<const h16*>(P.ws + OFF_S5C) + gi * 16 * 128 + fr * 128 + fq * 8;
    h16x8 cf[4];
#pragma unroll
    for (int ks = 0; ks < 4; ++ks) cf[ks] = *reinterpret_cast<const h16x8*>(Ct + ks * 32);
#pragma unroll
    for (int half = 0; half < 2; ++half) {
#pragma unroll 4
      for (int s = 0; s < 32; ++s) {
        const int step = half * 32 + s; const int tau = dir ? 63 - step : step;
        const float4* up = reinterpret_cast<const float4*>(us + tau * 16);
        float br = 0.f, bi = 0.f;
#pragma unroll
        for (int q = 0; q < 4; ++q) { const float4 u = up[q];
          br += bre[q * 4] * u.x + bre[q * 4 + 1] * u.y + bre[q * 4 + 2] * u.z + bre[q * 4 + 3] * u.w;
          bi += bim[q * 4] * u.x + bim[q * 4 + 1] * u.y + bim[q * 4 + 2] * u.z + bim[q * 4 + 3] * u.w; }
        const float nr = a.x * hr - a.y * hi + br, ni = a.x * hi + a.y * hr + bi; hr = nr; hi = ni;
        h16* hrow = reinterpret_cast<h16*>(Hs + (tau & 31) * 272);
        hrow[lane] = (h16)hr; hrow[64 + lane] = (h16)hi;
      }
      __syncthreads();
      const int tb = dir ? 1 - half : half;
#pragma unroll
      for (int sb2 = 0; sb2 < 2; ++sb2)
#pragma unroll
        for (int ks = 0; ks < 4; ++ks) {
          const h16x8 bf = *reinterpret_cast<const h16x8*>(Hs + (sb2 * 16 + fr) * 272 + (ks * 32 + fq * 8) * 2);
          yacc[tb * 2 + sb2] = __builtin_amdgcn_mfma_f32_16x16x32_f16(cf[ks], bf, yacc[tb * 2 + sb2], 0, 0, 0);
        }
      __syncthreads();
    }
  }
  const float* dsk = P.in[I_S5D] + layer * 384 + g * 16 + fq * 4;
  h16* Y = reinterpret_cast<h16*>(P.ws + OFF_YS5PRE);
#pragma unroll
  for (int sbi = 0; sbi < 4; ++sbi) {
    const int tl = sbi * 16 + fr; h16x4 o;
#pragma unroll
    for (int j = 0; j < 4; ++j) o[j] = (h16)geluf_(yacc[sbi][j] + dsk[j] * us[tl * 16 + fq * 4 + j]);
    *reinterpret_cast<h16x4*>(Y + (long)(tokbase + tl) * 384 + g * 16 + fq * 4) = o;
  }
  __syncthreads();
}
DI void phase_mix2(const Params& P, int layer, char* smem) {
  if ((gridDim.x & 7) == 0) {
    const int xcd = blockIdx.x & 7, li = blockIdx.x >> 3, nloc = gridDim.x >> 3;
    for (int k = li; k < 512; k += nloc) item_attn(P, xcd + 8 * (k >> 6), (k & 63) * 128, 0, KEYS / 64, smem);
  } else {
    for (int k = blockIdx.x; k < 4096; k += gridDim.x) item_attn(P, k >> 6, (k & 63) * 128, 0, KEYS / 64, smem);
  }
  const int n_actx = layer == 0 ? 128 : 0;
  const int nck = layer == 0 ? 132 : 128;
  const int n_s5 = NBATCH * 24 * nck / 4;
  for (int it = blockIdx.x; it < n_actx + n_s5; it += gridDim.x) {
    if (it < n_actx) { item_attn(P, it >> 1, SEQ + (it & 1) * 128, SEQ, CTXL / 64, smem); continue; }
    const int w = (it - n_actx) * 4 + (tidx() >> 6);
    const int ck = w % nck + (layer == 0 ? 0 : 4); const int r = w / nck;
    item_s5_pass3(P, layer, r / 24, r % 24, ck, smem);
  }
}
DI void item_yhy_transpose(const Params& P, int item, char* smem) {
  h16* T = reinterpret_cast<h16*>(smem);
  const int tid = tidx();
  const int tt = item & 127, ct = (item >> 7) % 6, b = item / (128 * 6);
  const h16* src = reinterpret_cast<const h16*>(P.ws + OFF_PHY) + ((long)b * 1152 + ct * 64) * SEQ + tt * 64;
  h16* dst = reinterpret_cast<h16*>(P.ws + OFF_YHY) + ((long)b * SEQ + tt * 64) * 384 + ct * 64;
#pragma unroll
  for (int i = 0; i < 2; ++i) {
    const int chunk = tid + 256 * i, cr = chunk >> 3, tp = (chunk & 7) * 8;
    const h16x8 v = *reinterpret_cast<const h16x8*>(src + (long)cr * SEQ + tp);
#pragma unroll
    for (int e = 0; e < 8; ++e) T[cr * 66 + tp + e] = v[e];
  }
  __syncthreads();
#pragma unroll
  for (int i = 0; i < 2; ++i) {
    const int chunk = tid + 256 * i, tr = chunk >> 3, cp = (chunk & 7) * 8;
    h16x8 o;
#pragma unroll
    for (int e = 0; e < 8; ++e) o[e] = T[(cp + e) * 66 + tr];
    *reinterpret_cast<h16x8*>(dst + (long)tr * 384 + cp) = o;
  }
  __syncthreads();
}
DI void phase_glu(const Params& P, int layer, char* smem) {
  const int tid = tidx(), lane = tid & 63, wid = tid >> 6, wr = wid >> 1, wc = wid & 1, fr = lane & 15, fq = lane >> 4;
  const h16* A = reinterpret_cast<const h16*>(P.ws + OFF_YS5PRE);
  const h16* W = reinterpret_cast<const h16*>(P.ws + OFF_WT) + (long)layer * WT_LAYER + WT_GLU;
  h16* Y = reinterpret_cast<h16*>(P.ws + OFF_YS5);
#pragma unroll 1
  for (int it = blockIdx.x; it < NBATCH * 6 * 128; it += gridDim.x) item_yhy_transpose(P, it, smem);
  asm volatile("" ::: "memory");
  const int MT = (layer == 0 ? TT : TLAT) / 128;
  const TileWalk tw = tw_init(MT, 6);
  for (int tile = tw.lb; tile < tw_count(tw); tile += tw.nlb) {
    int mt, nt; tw_decode(tw, tile, mt, nt);
    f32x4 acc[4][4]; acc_zero(acc);
    gemm_kloop(acc, A + (long)mt * 128 * 384, 384, 0, 128, W + (long)nt * 128 * 384, 384, 384, smem, opaque_tid());
    {
      float* Zs = reinterpret_cast<float*>(smem);
#pragma unroll
      for (int m = 0; m < 4; ++m)
#pragma unroll
        for (int np = 0; np < 2; ++np)
#pragma unroll
          for (int j = 0; j < 4; ++j)
            Zs[(wr * 64 + m * 16 + fq * 4 + j) * 132 + wc * 32 + np * 16 + fr] = acc[m][2 * np][j] * sigmoidf_(acc[m][2 * np + 1][j]);
      __syncthreads();
      const int t2 = tidx();
#pragma unroll
      for (int it = 0; it < 4; ++it) {
        const int chunk = it * 256 + t2, row = chunk >> 3, c8 = (chunk & 7) * 8;
        const float4 x0 = *reinterpret_cast<const float4*>(Zs + row * 132 + c8), x1 = *reinterpret_cast<const float4*>(Zs + row * 132 + c8 + 4);
        h16x8 o; o[0] = (h16)x0.x; o[1] = (h16)x0.y; o[2] = (h16)x0.z; o[3] = (h16)x0.w; o[4] = (h16)x1.x; o[5] = (h16)x1.y; o[6] = (h16)x1.z; o[7] = (h16)x1.w;
        *reinterpret_cast<h16x8*>(Y + (long)(mt * 128 + row) * 384 + nt * 64 + c8) = o;
      }
      __syncthreads();
    }
  }
}
DI void phase_merge(const Params& P, int layer, char* smem) {
  const h16* H = reinterpret_cast<const h16*>(P.ws + OFF_H1);
  const h16* WL = reinterpret_cast<const h16*>(P.ws + OFF_WT) + (long)layer * WT_LAYER;
  h16* Mg = reinterpret_cast<h16*>(P.ws + OFF_MERGED);
  const int MT = (layer == 0 ? TT : TLAT) / 128;
  const TileWalk tw = tw_init(MT, 8);
  for (int tile = tw.lb; tile < tw_count(tw); tile += tw.nlb) {
    int mt, nt; tw_decode(tw, tile, mt, nt);
    h16* Tmp = reinterpret_cast<h16*>(P.ws + OFF_YS5PRE) + (long)blockIdx.x * 32768;
    h16* Run = Tmp + 16384;
#pragma unroll 1
    for (int br = 0; br < 3; ++br) {
      const h16* Ab; const h16* Wb; int Kb;
      if (br == 0) { Ab = reinterpret_cast<const h16*>(P.ws + OFF_YHY) + (long)mt * 128 * 384; Wb = WL + WT_BRHY + (long)nt * 128 * 384; Kb = 384; }
      else if (br == 1) { Ab = reinterpret_cast<const h16*>(P.ws + OFF_YS5) + (long)mt * 128 * 384; Wb = WL + WT_BRS5 + (long)nt * 128 * 384; Kb = 384; }
      else { Ab = reinterpret_cast<const h16*>(P.ws + OFF_YMLA) + (long)mt * 128 * 512; Wb = WL + WT_BRMLA + (long)nt * 128 * 512; Kb = 512; }
      {
        f32x4 acc[4][4]; acc_zero(acc);
        gemm_kloop(acc, Ab, Kb, 0, 128, Wb, Kb, Kb, smem, opaque_tid());
        const int tid = tidx();
#pragma unroll
        for (int m = 0; m < 4; ++m)
#pragma unroll
          for (int n = 0; n < 4; ++n) {
            h16x4 o; o[0] = (h16)acc[m][n][0]; o[1] = (h16)acc[m][n][1]; o[2] = (h16)acc[m][n][2]; o[3] = (h16)acc[m][n][3];
            *reinterpret_cast<h16x4*>(Tmp + ((m * 4 + n) * 256 + tid) * 4) = o;
          }
      }
      f32x4 acc[4][4]; acc_zero(acc);
      gemm_kloop(acc, H + (long)mt * 128 * LD1, LD1, 0, 128, WL + WT_WGATE + (long)(br * 1024 + nt * 128) * LD1, LD1, 1024, smem, opaque_tid());
      const int tid = tidx();
      h16x4 bv[16], rv[16];
#pragma unroll
      for (int q = 0; q < 16; ++q) bv[q] = *reinterpret_cast<const h16x4*>(Tmp + (q * 256 + tid) * 4);
      if (br > 0) {
#pragma unroll
        for (int q = 0; q < 16; ++q) rv[q] = *reinterpret_cast<const h16x4*>(Run + (q * 256 + tid) * 4);
      } else {
#pragma unroll
        for (int q = 0; q < 16; ++q) rv[q] = h16x4{(h16)0.f, (h16)0.f, (h16)0.f, (h16)0.f};
      }
#pragma unroll
      for (int m = 0; m < 4; ++m)
#pragma unroll
        for (int n = 0; n < 4; ++n)
#pragma unroll
          for (int j = 0; j < 4; ++j) acc[m][n][j] = (float)rv[m * 4 + n][j] + sigmoidf_(acc[m][n][j]) * (float)bv[m * 4 + n][j];
      if (br < 2) {
#pragma unroll
        for (int m = 0; m < 4; ++m)
#pragma unroll
          for (int n = 0; n < 4; ++n) {
            h16x4 o; o[0] = (h16)acc[m][n][0]; o[1] = (h16)acc[m][n][1]; o[2] = (h16)acc[m][n][2]; o[3] = (h16)acc[m][n][3];
            *reinterpret_cast<h16x4*>(Run + ((m * 4 + n) * 256 + tid) * 4) = o;
          }
      } else {
        float* Zs = reinterpret_cast<float*>(smem);
        stage_acc(acc, Zs, tid);
        copy_out_f16(Zs, Mg, (long)mt * 128, LD1, nt * 128, tid);
        __syncthreads();
      }
    }
  }
}
DI void phase_resid(const Params& P, int layer, int stage_src, size_t a_off, int K, long w_off, int gate_idx, char* smem) {
  const int tid = tidx(), lane = tid & 63, wid = tid >> 6, wr = wid >> 1, wc = wid & 1, fr = lane & 15, fq = lane >> 4;
  const h16* A = reinterpret_cast<const h16*>(P.ws + a_off);
  const h16* W = reinterpret_cast<const h16*>(P.ws + OFF_WT) + (long)layer * WT_LAYER + w_off;
  const float* mod = reinterpret_cast<const float*>(P.ws + OFF_MOD) + (long)layer * 9 * 6144 + gate_idx * 1024;
  const int MT = (layer == 0 ? TT : TLAT) / 128;
  const TileWalk tw = tw_init(MT, 8);
  for (int tile = tw.lb; tile < tw_count(tw); tile += tw.nlb) {
    int mt, nt; tw_decode(tw, tile, mt, nt);
    f32x4 acc[4][4]; acc_zero(acc);
    const int ld = K == 1024 ? LD1 : LD2;
    gemm_kloop(acc, A + (long)mt * 128 * ld, ld, 0, 128, W + (long)nt * 128 * ld, ld, K, smem, opaque_tid());
    const Tok tk = tokinfo(mt * 128);
    float* Zs = reinterpret_cast<float*>(smem);
    const int t2 = tidx();
    stage_acc(acc, Zs, t2);
    const int c4 = (t2 & 31) * 4;
    const float4 g4 = *reinterpret_cast<const float4*>(mod + tk.mrow * 6144 + nt * 128 + c4);
#pragma unroll 4
    for (int it = 0; it < 16; ++it) {
      const int row = it * 8 + (t2 >> 5); const int t = mt * 128 + row;
      const float4 a4 = *reinterpret_cast<const float4*>(Zs + row * 132 + c4);
      const float4 x4 = *reinterpret_cast<const float4*>(xrow_src(P, stage_src, t) + nt * 128 + c4);
      *reinterpret_cast<float4*>(xrow_dst(P, t) + nt * 128 + c4) = make_float4(x4.x + g4.x * a4.x, x4.y + g4.y * a4.y, x4.z + g4.z * a4.z, x4.w + g4.w * a4.w);
    }
    __syncthreads();
  }
}
DI void phase_ffn_up(const Params& P, int layer, char* smem) {
  const int tid = tidx(), lane = tid & 63, wid = tid >> 6, wr = wid >> 1, wc = wid & 1, fr = lane & 15, fq = lane >> 4;
  const h16* H = reinterpret_cast<const h16*>(P.ws + OFF_H2);
  const h16* W = reinterpret_cast<const h16*>(P.ws + OFF_WT) + (long)layer * WT_LAYER + WT_UP;
  h16* F = reinterpret_cast<h16*>(P.ws + OFF_F);
  const float* cw = P.in[I_FCW] + (long)layer * 3 * 5632; const float* cb = P.in[I_FCB] + (long)layer * 5632;
  float* Zs = reinterpret_cast<float*>(smem);
  const int n_mt = 8 * 66 + (layer == 0 ? 8 * 3 : 0);
  const TileWalk tw = tw_init(n_mt, 44);
  for (int tile = tw.lb; tile < tw_count(tw); tile += tw.nlb) {
    int mi, nt; tw_decode(tw, tile, mi, nt);
    int seq0, Ls, ti;
    if (mi < 528) { seq0 = (mi / 66) * SEQ; Ls = SEQ; ti = mi % 66; } else { const int u = mi - 528; seq0 = TLAT + (u / 3) * CTXL; Ls = CTXL; ti = u % 3; }
    const int p0 = ti * 126 - 1;
    const int a_lo = ti == 0 ? 1 : 0, a_hi = min(128, Ls - p0);
    const int nout = min(126, Ls - ti * 126);
    f32x4 acc[4][4]; acc_zero(acc);
    gemm_kloop(acc, H + ((long)seq0 + p0) * LD1, LD1, a_lo, a_hi, W + (long)nt * 128 * LD1, LD1, 1024, smem, opaque_tid());
#pragma unroll
    for (int m = 0; m < 4; ++m)
#pragma unroll
      for (int n = 0; n < 4; ++n)
#pragma unroll
        for (int j = 0; j < 4; ++j) Zs[(wr * 64 + m * 16 + fq * 4 + j) * 132 + wc * 64 + n * 16 + fr] = acc[m][n][j];
    __syncthreads();
    {
      const int jc = tid & 63, rg = tid >> 6;
      const int ucol = (jc >> 5) * 64 + ((jc >> 4) & 1) * 32 + (jc & 15), gcol = ucol + 16;
      const int cu = nt * 64 + jc, cg = 2816 + cu;
      const float wu0 = cw[cu], wu1 = cw[5632 + cu], wu2 = cw[2 * 5632 + cu], bu = cb[cu];
      const float wg0 = cw[cg], wg1 = cw[5632 + cg], wg2 = cw[2 * 5632 + cg], bg = cb[cg];
      for (int r = 1 + rg; r <= nout; r += 4) {
        const float au = wu0 * Zs[(r - 1) * 132 + ucol] + wu1 * Zs[r * 132 + ucol] + wu2 * Zs[(r + 1) * 132 + ucol] + bu;
        const float ag = wg0 * Zs[(r - 1) * 132 + gcol] + wg1 * Zs[r * 132 + gcol] + wg2 * Zs[(r + 1) * 132 + gcol] + bg;
        F[((long)seq0 + p0 + r) * LD2 + cu] = (h16)(siluf_(au) * ag);
      }
    }
    __syncthreads();
  }
}
DI void phase_norm2(const Params& P, int layer) { normmod_rows(P, layer, 1, 1, layer == 0 ? TT : TLAT, blockIdx.x, gridDim.x); }

constexpr int N_PHASES = 22;
#ifndef PROBE_REPEAT
#define PROBE_REPEAT 0u
#endif
template <int PH> DI void run_phase_t(const Params& P, char* smem) {
  asm volatile("" ::: "memory");
  if constexpr (PH == 0) phase_prologue(P, smem);
  else if constexpr (PH == 21) phase_final(P);
  else {
    constexpr int layer = (PH - 1) / 10, s = (PH - 1) % 10;
    if constexpr (s == 0) phase_norm1(P, layer, smem);
    else if constexpr (s == 1) phase_gemm_in(P, layer, smem);
    else if constexpr (s == 2) phase_mix1(P, layer, smem);
    else if constexpr (s == 3) phase_mix2(P, layer, smem);
    else if constexpr (s == 4) phase_glu(P, layer, smem);
    else if constexpr (s == 5) phase_merge(P, layer, smem);
    else if constexpr (s == 6) phase_resid(P, layer, layer, OFF_MERGED, 1024, WT_WO, 2, smem);
    else if constexpr (s == 7) phase_norm2(P, layer);
    else if constexpr (s == 8) phase_ffn_up(P, layer, smem);
    else phase_resid(P, layer, 1, OFF_F, 2816, WT_DOWN, 5, smem);
  }
}
DI void run_phase(const Params& P, int ph, char* smem) {
  switch (ph) {
#define RP(i) case i: run_phase_t<i>(P, smem); break;
    RP(0) RP(1) RP(2) RP(3) RP(4) RP(5) RP(6) RP(7) RP(8) RP(9) RP(10) RP(11) RP(12) RP(13) RP(14) RP(15) RP(16) RP(17) RP(18) RP(19) RP(20) RP(21)
#undef RP
    default: break;
  }
}
#ifndef MULTI_LAUNCH
#define MULTI_LAUNCH 0
#endif
#define XB_TMO      128
#define XB_XCNT(j)  (256  + 64 * (j))
#define XB_XSUB(j)  (1280 + 64 * (j))
#define XB_XGEN(j)  (2304 + 64 * (j))
#define XB_TOP      3328
#define XB_TOPGEN   3392
#define XCD_BAR_WORDS 3456
#define XB_SPIN_CAP (1u << 22)
#define LAS __attribute__((address_space(3)))
DI unsigned xb_ld(unsigned* p)              { return __hip_atomic_load(p, __ATOMIC_RELAXED, __HIP_MEMORY_SCOPE_AGENT); }
DI unsigned xb_add(unsigned* p, unsigned v) { return __hip_atomic_fetch_add(p, v, __ATOMIC_RELAXED, __HIP_MEMORY_SCOPE_AGENT); }
DI unsigned xb_xcc_id() { return (unsigned)__builtin_amdgcn_s_getreg((3 << 11) | 20) & 0xFu; }
#define XB_SPIN(cond, bar) do { unsigned _sp = 0; while (cond) { __builtin_amdgcn_s_sleep(1); \
    if ((++_sp & 255u) == 0u) { if (xb_ld(&(bar)[XB_TMO])) break; if (_sp > XB_SPIN_CAP) { atomicAdd(&(bar)[XB_TMO], 1u); break; } } } } while (0)
struct XcdBarrier { unsigned* bar; unsigned x; volatile LAS unsigned* st; };
DI XcdBarrier xcd_barrier_post(unsigned* bar, volatile LAS unsigned* st) {
  XcdBarrier b; b.bar = bar; b.x = xb_xcc_id(); b.st = st;
  if (threadIdx.x == 0) (void)xb_add(&bar[XB_XCNT(b.x)], 1u);
  return b;
}
DI void xcd_barrier_complete(unsigned* bar, unsigned x, unsigned& nloc, unsigned& nx) {
  const unsigned G = gridDim.x * gridDim.y * gridDim.z;
  unsigned sum, cnt, mine, sp = 0u;
  for (;;) {
    sum = 0u; cnt = 0u; mine = 0u;
#pragma unroll
    for (unsigned j = 0; j < 16; ++j) { const unsigned c = xb_ld(&bar[XB_XCNT(j)]); sum += c; cnt += (c > 0u) ? 1u : 0u; mine = (j == x) ? c : mine; }
    if (sum == G) break;
    __builtin_amdgcn_s_sleep(1);
    if ((++sp & 255u) == 0u) { if (xb_ld(&bar[XB_TMO])) break; if (sp > XB_SPIN_CAP) { atomicAdd(&bar[XB_TMO], 1u); break; } }
  }
  nloc = mine > 0u ? mine : 1u; nx = cnt > 0u ? cnt : 1u;
}
DI void xcd_barrier(const XcdBarrier& b) {
  asm volatile("s_waitcnt vmcnt(0)" ::: "memory");
  __syncthreads();
  if (threadIdx.x == 0) {
    unsigned* bar = b.bar;
    __builtin_amdgcn_s_waitcnt(0);
    unsigned nloc = b.st[0], nx = b.st[1];
    if (nloc == 0u) { xcd_barrier_complete(bar, b.x, nloc, nx); b.st[0] = nloc; b.st[1] = nx; }
    const unsigned old = xb_add(&bar[XB_XSUB(b.x)], 1u);
    const unsigned gen = old / nloc;
    if (old + 1u == (gen + 1u) * nloc) {
      __builtin_amdgcn_fence(__ATOMIC_RELEASE, "agent");
      asm volatile("s_waitcnt vmcnt(0)" ::: "memory");
      const unsigned og = xb_add(&bar[XB_TOP], 1u);
      const unsigned tg = og / nx;
      if (og + 1u == (tg + 1u) * nx) xb_add(&bar[XB_TOPGEN], 1u);
      else XB_SPIN(xb_ld(&bar[XB_TOPGEN]) == tg, bar);
      __builtin_amdgcn_fence(__ATOMIC_ACQUIRE, "agent");
      xb_add(&bar[XB_XGEN(b.x)], 1u);
      asm volatile("s_waitcnt vmcnt(0)" ::: "memory");
    } else {
      XB_SPIN(xb_ld(&bar[XB_XGEN(b.x)]) == gen, bar);
      __builtin_amdgcn_fence(__ATOMIC_ACQUIRE, "agent");
      asm volatile("s_waitcnt vmcnt(0)" ::: "memory");
    }
  }
  __syncthreads();
}
__global__ void __launch_bounds__(NTHREADS, 2) fwd_megakernel(Params P) {
  extern __shared__ __attribute__((aligned(16))) char smem[];
  cg::grid_group grid = cg::this_grid();
  volatile LAS unsigned* st = (volatile LAS unsigned*)(smem + SMEM_BYTES - 16);
  if (threadIdx.x == 0) { st[0] = 0u; st[1] = 0u; st[2] = 0u; st[3] = 0u; }
  __syncthreads();
  const XcdBarrier xb = xcd_barrier_post(reinterpret_cast<unsigned*>(P.ws + OFF_BAR), st);
  run_phase_t<0>(P, smem); grid.sync();
#define RP(i) run_phase_t<i>(P, smem); xcd_barrier(xb); if constexpr ((PROBE_REPEAT >> i) & 1) { run_phase_t<i>(P, smem); xcd_barrier(xb); }
  RP(1) RP(2) RP(3) RP(4) RP(5) RP(6) RP(7) RP(8) RP(9) RP(10) RP(11) RP(12) RP(13) RP(14) RP(15) RP(16) RP(17) RP(18) RP(19) RP(20)
#undef RP
#ifdef PROBE_SYNC
  for (int i = 0; i < PROBE_SYNC; ++i) xcd_barrier(xb);
#endif
  run_phase_t<21>(P, smem);
}
#if MULTI_LAUNCH
__global__ void __launch_bounds__(NTHREADS, 2) fwd_phase_kernel(Params P, int ph) {
  extern __shared__ __attribute__((aligned(16))) char smem[];
  run_phase(P, ph, smem);
}
#endif

extern "C" void kernel_launch(void* const* d_in, const int* in_sizes, int n_in, void* d_out, int out_size, void* d_ws, size_t ws_size,
                              hipStream_t stream) {
  static int grid_blocks = 0;
  if (!grid_blocks) {
    int dev = 0, cus = 0, per_cu = 0;
    (void)hipGetDevice(&dev);
    (void)hipDeviceGetAttribute(&cus, hipDeviceAttributeMultiprocessorCount, dev);
    (void)hipFuncSetAttribute((const void*)fwd_megakernel, hipFuncAttributeMaxDynamicSharedMemorySize, SMEM_BYTES);
#if MULTI_LAUNCH
    (void)hipFuncSetAttribute((const void*)fwd_phase_kernel, hipFuncAttributeMaxDynamicSharedMemorySize, SMEM_BYTES);
#endif
    (void)hipOccupancyMaxActiveBlocksPerMultiprocessor(&per_cu, fwd_megakernel, NTHREADS, SMEM_BYTES);
    if (per_cu > 2) per_cu = 2;
    if (per_cu < 1) per_cu = 1;
#ifdef PROBE_FORCE2
    per_cu = 2;
#endif
    grid_blocks = cus * per_cu;
    if (ws_size < OFF_END) fprintf(stderr, "workspace too small: %zu < %zu\n", ws_size, (size_t)OFF_END);
  }
  Params p{};
  for (int i = 0; i < 41; ++i) p.in[i] = (const float*)d_in[i];
  p.out = (float*)d_out; p.ws = (char*)d_ws; p.pad_ = 0;
#if MULTI_LAUNCH
  for (int ph = 0; ph < N_PHASES; ++ph) hipLaunchKernelGGL(fwd_phase_kernel, dim3(grid_blocks), dim3(NTHREADS), SMEM_BYTES, stream, p, ph);
#else
  (void)hipMemsetAsync((char*)d_ws + OFF_BAR, 0, XCD_BAR_WORDS * 4, stream);
  void* args[] = {&p};
  hipError_t e = hipLaunchCooperativeKernel((void*)fwd_megakernel, dim3(grid_blocks), dim3(NTHREADS), args, SMEM_BYTES, stream);
  if (e != hipSuccess) fprintf(stderr, "cooperative launch failed: %s (grid %d)\n", hipGetErrorString(e), grid_blocks);
#endif
}
```

```cpp
#include <hip/hip_runtime.h>
#include <hip/hip_cooperative_groups.h>
#include <cstdio>
namespace cg = cooperative_groups;

typedef _Float16 h16;
typedef _Float16 h16x8 __attribute__((ext_vector_type(8)));
typedef _Float16 h16x4 __attribute__((ext_vector_type(4)));
typedef float f32x4 __attribute__((ext_vector_type(4)));
typedef float f32x16 __attribute__((ext_vector_type(16)));
#define DI __device__ __forceinline__

constexpr int DM = 1024, NBATCH = 8, SEQ = 8192, CTXL = 256, TLAT = 65536, TCTX = 2048, TT = 67584;
constexpr int KEYS = SEQ + CTXL;
constexpr int NTHREADS = 256;
constexpr float EPS = 1e-6f;
constexpr float QSCALE = 0.10206207261596575f * 1.4426950408889634f;

constexpr int LD1 = 1088, LD2 = 2880;
constexpr long WT_WIN = 0, WT_WGATE = WT_WIN + 2432L * LD1, WT_UKV = WT_WGATE + 3072L * LD1, WT_UQ = WT_UKV + 1024L * 256,
               WT_GLU = WT_UQ + 1024L * 512, WT_BRHY = WT_GLU + 768L * 384, WT_BRS5 = WT_BRHY + 1024L * 384,
               WT_BRMLA = WT_BRS5 + 1024L * 384, WT_WO = WT_BRMLA + 1024L * 512, WT_UP = WT_WO + 1024L * LD1,
               WT_DOWN = WT_UP + 5632L * LD1, WT_LAYER = WT_DOWN + 1024L * LD2;
constexpr size_t al256(size_t x) { return (x + 255) / 256 * 256; }
constexpr size_t OFF_WT = 0;
constexpr size_t OFF_H1 = al256(OFF_WT + 2 * WT_LAYER * 2);
constexpr size_t OFF_U = al256(OFF_H1 + (size_t)TT * LD1 * 2);
constexpr size_t OFF_KVLAT = al256(OFF_U + (size_t)TT * 384 * 2);
constexpr size_t OFF_QLAT = al256(OFF_KVLAT + (size_t)TT * 256 * 2);
constexpr size_t OFF_PHY = al256(OFF_QLAT + (size_t)TT * 512 * 2);
constexpr size_t OFF_PHYC = al256(OFF_PHY + (size_t)NBATCH * 1152 * SEQ * 2);
constexpr size_t OFF_Q = al256(OFF_PHYC + (size_t)NBATCH * 1152 * CTXL * 2);
constexpr size_t OFF_K = al256(OFF_Q + (size_t)64 * KEYS * 96 * 2);
constexpr size_t OFF_VT = al256(OFF_K + (size_t)64 * KEYS * 96 * 2);
constexpr size_t OFF_YS5PRE = al256(OFF_VT + (size_t)64 * 64 * KEYS * 2);
constexpr size_t OFF_YHY = al256(OFF_YS5PRE + (size_t)TT * 384 * 2);
constexpr size_t OFF_FILT = al256(OFF_YHY + (size_t)TT * 384 * 2);
constexpr size_t OFF_TAPSC = al256(OFF_FILT + (size_t)768 * 2 * SEQ * 8);
constexpr size_t OFF_E = al256(OFF_TAPSC + (size_t)768 * 2 * CTXL * 4);
constexpr size_t OFF_XC = al256(OFF_E + (size_t)NBATCH * 2 * 24 * 132 * 64 * 8);
constexpr size_t OFF_MOD = al256(OFF_XC + (size_t)TCTX * 1024 * 4);
constexpr size_t OFF_Z2 = al256(OFF_MOD + (size_t)2 * 9 * 6144 * 4);
constexpr size_t OFF_Z2C = al256(OFF_Z2 + (size_t)2 * SEQ * 64 * 4);
constexpr size_t OFF_S5A = al256(OFF_Z2C + (size_t)2 * CTXL * 64 * 4);
constexpr size_t OFF_S5A64 = al256(OFF_S5A + (size_t)2 * 2 * 24 * 64 * 8);
constexpr size_t OFF_S5B = al256(OFF_S5A64 + (size_t)2 * 2 * 24 * 64 * 8);
constexpr size_t OFF_S5C = al256(OFF_S5B + (size_t)2 * 2 * 24 * 64 * 16 * 8);
constexpr size_t OFF_ROPE = al256(OFF_S5C + (size_t)2 * 2 * 24 * 16 * 128 * 2);
constexpr size_t OFF_BAR = al256(OFF_ROPE + (size_t)SEQ * 16 * 8);
constexpr size_t OFF_END = al256(OFF_BAR + (size_t)3456 * 4);
constexpr size_t OFF_YS5 = OFF_U, OFF_YMLA = OFF_QLAT, OFF_MERGED = OFF_Q, OFF_F = OFF_U, OFF_H2 = OFF_H1;
static_assert(OFF_END <= (size_t)1024 * 1024 * 1024, "workspace over 1 GiB");
static_assert(OFF_F + (size_t)TT * LD2 * 2 <= OFF_FILT, "f alias overruns");
static_assert(OFF_MERGED + (size_t)TT * LD1 * 2 <= OFF_VT, "merged alias overruns");

constexpr int SMEM_BYTES = 73728 + 2048;

struct Params {
  const float* in[41];
  float* out;
  char* ws;
  unsigned long long pad_;
};
enum { I_X = 0, I_C, I_CTX, I_CCTX, I_WMOD, I_BMOD, I_N1G, I_N2G, I_WIN, I_HCW, I_HCB, I_FW1, I_FB1, I_FW2, I_FB2, I_FW3, I_FFREQ,
       I_FDECAY, I_HBIAS, I_LAMRE, I_LAMIM, I_LOGSTEP, I_BRE, I_BIM, I_CRE, I_CIM, I_S5D, I_WGLU, I_GQ, I_WUQ, I_GKV, I_WUKV,
       I_WBRHY, I_WBRS5, I_WBRMLA, I_WO, I_WUP, I_FCW, I_FCB, I_WDOWN, I_FINALG };

DI int tidx() { int t = threadIdx.x; asm volatile("" : "+v"(t)); return t; }
DI int opaque_tid() { return tidx(); }
DI float sigmoidf_(float x) { return 1.f / (1.f + __expf(-x)); }
DI float siluf_(float x) { return x / (1.f + __expf(-x)); }
DI float geluf_(float x) { float z = 0.7978845608028654f * (x + 0.044715f * x * x * x); float t = 1.f - 2.f / (1.f + __expf(2.f * z)); return 0.5f * x * (1.f + t); }
DI float wave_sum(float v) { for (int o = 32; o > 0; o >>= 1) v += __shfl_xor(v, o); return v; }
DI float wave_max(float v) { for (int o = 32; o > 0; o >>= 1) v = fmaxf(v, __shfl_xor(v, o)); return v; }
DI void dsincos(double x, double& s, double& c) {
  const double TWO_PI = 6.283185307179586476925287;
  double r = x - TWO_PI * rint(x / TWO_PI);
  double r2 = r * r, ts = r, tc = 1.0; s = r; c = 1.0;
  for (int k = 1; k <= 15; ++k) { tc = -tc * r2 / (double)((2 * k - 1) * (2 * k)); c += tc; ts = -ts * r2 / (double)((2 * k) * (2 * k + 1)); s += ts; }
}
DI float2 twid(float f) { return make_float2(__builtin_amdgcn_cosf(f), __builtin_amdgcn_sinf(f)); }
DI float2 cmul(float2 a, float2 b) { return make_float2(a.x * b.x - a.y * b.y, a.x * b.y + a.y * b.x); }

struct Tok { int b, pos, ctx, mrow; };
DI Tok tokinfo(int t) { Tok k; if (t < TLAT) { k.b = t >> 13; k.pos = t & 8191; k.ctx = 0; k.mrow = k.b; } else { int u = t - TLAT; k.b = u >> 8; k.pos = u & 255; k.ctx = 1; k.mrow = 8; } return k; }

struct Stg { uint4 a0, a1, a2, a3, b0, b1, b2, b3; };
DI void g_load(Stg& s, const h16* __restrict__ A0, const h16* __restrict__ A1, const h16* __restrict__ A2, const h16* __restrict__ A3,
               const h16* __restrict__ Bp, long b32, int k0) {
  s.a0 = *reinterpret_cast<const uint4*>(A0 + k0); s.a1 = *reinterpret_cast<const uint4*>(A1 + k0);
  s.a2 = *reinterpret_cast<const uint4*>(A2 + k0); s.a3 = *reinterpret_cast<const uint4*>(A3 + k0);
  s.b0 = *reinterpret_cast<const uint4*>(Bp + k0); s.b1 = *reinterpret_cast<const uint4*>(Bp + b32 + k0);
  s.b2 = *reinterpret_cast<const uint4*>(Bp + 2 * b32 + k0); s.b3 = *reinterpret_cast<const uint4*>(Bp + 3 * b32 + k0);
}
DI uint4 zsel(uint4 v, bool ok) { return ok ? v : make_uint4(0, 0, 0, 0); }
DI void s_write(char* sw, const Stg& s, int okm) {
  *reinterpret_cast<uint4*>(sw) = zsel(s.a0, okm & 1); *reinterpret_cast<uint4*>(sw + 32 * 128) = zsel(s.a1, okm & 2);
  *reinterpret_cast<uint4*>(sw + 64 * 128) = zsel(s.a2, okm & 4); *reinterpret_cast<uint4*>(sw + 96 * 128) = zsel(s.a3, okm & 8);
  *reinterpret_cast<uint4*>(sw + 16384) = s.b0; *reinterpret_cast<uint4*>(sw + 16384 + 32 * 128) = s.b1; *reinterpret_cast<uint4*>(sw + 16384 + 64 * 128) = s.b2; *reinterpret_cast<uint4*>(sw + 16384 + 96 * 128) = s.b3;
}
#ifndef PROBE_MFMA
#define PROBE_MFMA 0
#endif
#if PROBE_MFMA
DI void mma_step(f32x4 (&acc)[4][4], const char* sa, const char* sb, int o0, int o1, f32x4 (&dmy)[2][4]) {
#else
DI void mma_step(f32x4 (&acc)[4][4], const char* sa, const char* sb, int o0, int o1) {
#endif
#pragma unroll
  for (int ks = 0; ks < 2; ++ks) {
    h16x8 af[4], bf[4];
    const int o = ks ? o1 : o0;
#pragma unroll
    for (int m = 0; m < 4; ++m) af[m] = *reinterpret_cast<const h16x8*>(sa + m * 16 * 128 + o);
#pragma unroll
    for (int n = 0; n < 4; ++n) bf[n] = *reinterpret_cast<const h16x8*>(sb + n * 16 * 128 + o);
#pragma unroll
    for (int m = 0; m < 4; ++m)
#pragma unroll
      for (int n = 0; n < 4; ++n) acc[m][n] = __builtin_amdgcn_mfma_f32_16x16x32_f16(af[m], bf[n], acc[m][n], 0, 0, 0);
#if PROBE_MFMA
#pragma unroll
    for (int m = 0; m < 2; ++m)
#pragma unroll
      for (int n = 0; n < 4; ++n) dmy[m][n] = __builtin_amdgcn_mfma_f32_16x16x32_f16(af[m + 2], bf[n], dmy[m][n], 0, 0, 0);
#endif
  }
}
DI void gemm_kloop_body(f32x4 (&acc)[4][4], const h16* __restrict__ A, long lda, int a_lo, int a_hi,
                   const h16* __restrict__ Bt, long ldb, int K, char* smem, int tid) {
  const int lane = tid & 63, wid = tid >> 6, wr = wid >> 1, wc = wid & 1, fr = lane & 15, fq = lane >> 4;
#if PROBE_MFMA
  f32x4 dmy[2][4];
  for (int m = 0; m < 2; ++m) for (int n = 0; n < 4; ++n) dmy[m][n] = f32x4{0.f, 0.f, 0.f, 0.f};
#define MMA(a, b, c, d, e) mma_step(a, b, c, d, e, dmy)
#else
#define MMA(a, b, c, d, e) mma_step(a, b, c, d, e)
#endif
  Stg s0, s1;
  const int srow = tid >> 3, skc = tid & 7;
  int okm = 0;
  const h16* Ar[4];
#pragma unroll
  for (int i = 0; i < 4; ++i) { const int row = srow + 32 * i; const bool ok = row >= a_lo && row < a_hi; okm |= ok ? (1 << i) : 0;
    const int rc = min(max(row, a_lo), a_hi - 1); Ar[i] = A + (long)rc * lda + skc * 8; }
  const h16* Bp = Bt + (long)srow * ldb + skc * 8;
  const long b32 = 32 * ldb;
  char* sw = smem + srow * 128 + ((skc ^ ((srow >> 1) & 7)) << 4);
  const char* sra = smem + (wr * 64 + fr) * 128; const char* srb = smem + 16384 + (wc * 64 + fr) * 128;
  const int o0 = (fq ^ ((fr >> 1) & 7)) << 4, o1 = ((4 + fq) ^ ((fr >> 1) & 7)) << 4;
  const int nk = K >> 6;
  g_load(s0, Ar[0], Ar[1], Ar[2], Ar[3], Bp, b32, 0); g_load(s1, Ar[0], Ar[1], Ar[2], Ar[3], Bp, b32, 64);
  s_write(sw, s0, okm); __syncthreads();
  for (int kt = 0; kt + 2 < nk; kt += 2) {
    g_load(s0, Ar[0], Ar[1], Ar[2], Ar[3], Bp, b32, (kt + 2) << 6);
    __builtin_amdgcn_sched_barrier(0);
    MMA(acc, sra, srb, o0, o1);
    __builtin_amdgcn_sched_barrier(0);
    s_write(sw + 32768, s1, okm);
    __syncthreads();
    g_load(s1, Ar[0], Ar[1], Ar[2], Ar[3], Bp, b32, (kt + 3) << 6);
    __builtin_amdgcn_sched_barrier(0);
    MMA(acc, sra + 32768, srb + 32768, o0, o1);
    __builtin_amdgcn_sched_barrier(0);
    s_write(sw, s0, okm);
    __syncthreads();
  }
  MMA(acc, sra, srb, o0, o1);
  s_write(sw + 32768, s1, okm);
  __syncthreads();
  MMA(acc, sra + 32768, srb + 32768, o0, o1);
  __syncthreads();
#if PROBE_MFMA
  { float z = 0.f; asm volatile("" : "+v"(z)); for (int m = 0; m < 2; ++m) for (int n = 0; n < 4; ++n) acc[m][n] += dmy[m][n] * z; }
#endif
#undef MMA
}
#ifndef PROBE_KLOOP
#define PROBE_KLOOP 0
#endif
DI void gemm_kloop(f32x4 (&acc)[4][4], const h16* __restrict__ A, long lda, int a_lo, int a_hi,
                   const h16* __restrict__ Bt, long ldb, int K, char* smem, int tid) {
  gemm_kloop_body(acc, A, lda, a_lo, a_hi, Bt, ldb, K, smem, tid);
}
struct TileWalk { int lb, nlb, m0, Mx, NT, nfull; };
DI TileWalk tw_init(int MT, int NT) { TileWalk w; w.lb = blockIdx.x >> 3; w.nlb = gridDim.x >> 3; w.Mx = MT >> 3; w.m0 = (blockIdx.x & 7) * w.Mx; w.NT = NT; w.nfull = (w.Mx >> 3) * 8 * NT; return w; }
DI int tw_count(const TileWalk& w) { return w.Mx * w.NT; }
DI void tw_decode(const TileWalk& w, int idx, int& mt, int& nt) {
  if (idx < w.nfull) { const int mg = idx / (8 * w.NT), r = idx % (8 * w.NT); nt = r >> 3; mt = w.m0 + mg * 8 + (r & 7); }
  else { const int rem = w.Mx & 7, r = idx - w.nfull; nt = r / rem; mt = w.m0 + (w.Mx & ~7) + r % rem; }
}
DI void stage_acc(const f32x4 (&acc)[4][4], float* Zs, int tid) {
  const int lane = tid & 63, wid = tid >> 6, wr = wid >> 1, wc = wid & 1, fr = lane & 15, fq = lane >> 4;
#pragma unroll
  for (int m = 0; m < 4; ++m)
#pragma unroll
    for (int n = 0; n < 4; ++n)
#pragma unroll
      for (int j = 0; j < 4; ++j) Zs[(wr * 64 + m * 16 + fq * 4 + j) * 132 + wc * 64 + n * 16 + fr] = acc[m][n][j];
  __syncthreads();
}
DI void stage_acc_t(const f32x4 (&acc)[4][4], float* Zs, int tid) {
  const int lane = tid & 63, wid = tid >> 6, wr = wid >> 1, wc = wid & 1, fr = lane & 15, fq = lane >> 4;
#pragma unroll
  for (int m = 0; m < 4; ++m)
#pragma unroll
    for (int n = 0; n < 4; ++n)
      *reinterpret_cast<float4*>(Zs + (wc * 64 + n * 16 + fr) * 132 + wr * 64 + m * 16 + fq * 4) = make_float4(acc[m][n][0], acc[m][n][1], acc[m][n][2], acc[m][n][3]);
  __syncthreads();
}
DI void copy_out_f16(const float* Zs, h16* __restrict__ dst, long row0, long ld, int cb, int tid) {
#pragma unroll
  for (int it = 0; it < 8; ++it) {
    const int chunk = it * 256 + tid, row = chunk >> 4, c8 = (chunk & 15) * 8;
    const float4 x0 = *reinterpret_cast<const float4*>(Zs + row * 132 + c8), x1 = *reinterpret_cast<const float4*>(Zs + row * 132 + c8 + 4);
    h16x8 o; o[0] = (h16)x0.x; o[1] = (h16)x0.y; o[2] = (h16)x0.z; o[3] = (h16)x0.w; o[4] = (h16)x1.x; o[5] = (h16)x1.y; o[6] = (h16)x1.z; o[7] = (h16)x1.w;
    *reinterpret_cast<h16x8*>(dst + (row0 + row) * ld + cb + c8) = o;
  }
}
DI void acc_zero(f32x4 (&acc)[4][4]) {
#pragma unroll
  for (int m = 0; m < 4; ++m)
#pragma unroll
    for (int n = 0; n < 4; ++n) acc[m][n] = f32x4{0.f, 0.f, 0.f, 0.f};
}
DI void row_rms(const h16* __restrict__ A, long lda, int K, float* rs) {
  const int tid = tidx(), row = tid >> 1, half = tid & 1;
  const h16* p = A + (long)row * lda + half * (K >> 1);
  float ss = 0.f;
  for (int k = 0; k < (K >> 1); k += 8) {
    h16x8 v = *reinterpret_cast<const h16x8*>(p + k);
#pragma unroll
    for (int j = 0; j < 8; ++j) { float f = (float)v[j]; ss += f * f; }
  }
  ss += __shfl_xor(ss, 1);
  if (half == 0) rs[row] = rsqrtf(ss / (float)K + EPS);
}
DI int map_interleave(int n, int half) { int tile = n >> 7, r = n & 127, sub = r >> 4, fr = r & 15; int j = tile * 64 + (sub >> 1) * 16 + fr; return (sub & 1) ? half + j : j; }
DI int map_col(int mat, int n) {
  switch (mat) {
    case 0: if (n < 640) return n; if (n < 2304) return n + 32; if (n < 2336) return n - 2304 + 640; return -1;
    case 1: return 2336 + n;
    case 3: { int h = n >> 7, j = n & 127; return j < 96 ? h * 96 + j : -1; }
    case 4: return map_interleave(n, 384);
    case 9: return map_interleave(n, 2816);
    default: return n;
  }
}
struct MatDesc { const float* src; const float* scale; long dst; int K, Nmy, Nsrc, ld; };
DI MatDesc get_mat(const Params& P, int layer, int mat) {
  MatDesc d; d.scale = nullptr;
  d.ld = (mat == 0 || mat == 1 || mat == 8 || mat == 9) ? LD1 : 0;
  switch (mat) {
    case 0: d.src = P.in[I_WIN] + (long)layer * 1024 * 5408; d.dst = WT_WIN; d.K = 1024; d.Nmy = 2432; d.Nsrc = 5408; break;
    case 1: d.src = P.in[I_WIN] + (long)layer * 1024 * 5408; d.dst = WT_WGATE; d.K = 1024; d.Nmy = 3072; d.Nsrc = 5408; break;
    case 2: d.src = P.in[I_WUKV] + (long)layer * 256 * 1024; d.dst = WT_UKV; d.K = 256; d.Nmy = 1024; d.Nsrc = 1024; d.scale = P.in[I_GKV] + layer * 256; break;
    case 3: d.src = P.in[I_WUQ] + (long)layer * 512 * 768; d.dst = WT_UQ; d.K = 512; d.Nmy = 1024; d.Nsrc = 768; d.scale = P.in[I_GQ] + layer * 512; break;
    case 4: d.src = P.in[I_WGLU] + (long)layer * 384 * 768; d.dst = WT_GLU; d.K = 384; d.Nmy = 768; d.Nsrc = 768; break;
    case 5: d.src = P.in[I_WBRHY] + (long)layer * 384 * 1024; d.dst = WT_BRHY; d.K = 384; d.Nmy = 1024; d.Nsrc = 1024; break;
    case 6: d.src = P.in[I_WBRS5] + (long)layer * 384 * 1024; d.dst = WT_BRS5; d.K = 384; d.Nmy = 1024; d.Nsrc = 1024; break;
    case 7: d.src = P.in[I_WBRMLA] + (long)layer * 512 * 1024; d.dst = WT_BRMLA; d.K = 512; d.Nmy = 1024; d.Nsrc = 1024; break;
    case 8: d.src = P.in[I_WO] + (long)layer * 1024 * 1024; d.dst = WT_WO; d.K = 1024; d.Nmy = 1024; d.Nsrc = 1024; break;
    case 9: d.src = P.in[I_WUP] + (long)layer * 1024 * 5632; d.dst = WT_UP; d.K = 1024; d.Nmy = 5632; d.Nsrc = 5632; break;
    default: d.src = P.in[I_WDOWN] + (long)layer * 2816 * 1024; d.dst = WT_DOWN; d.K = 2816; d.Nmy = 1024; d.Nsrc = 1024; d.ld = LD2; break;
  }
  if (d.ld == 0) d.ld = d.K;
  return d;
}
constexpr int WT_TILES_PER_LAYER = 608 + 768 + 64 + 128 + 72 + 96 + 96 + 128 + 256 + 1408 + 704;
DI void item_wt(const Params& P, int item, char* smem) {
  const int layer = item / WT_TILES_PER_LAYER; int r = item % WT_TILES_PER_LAYER;
  const int cnt[11] = {608, 768, 64, 128, 72, 96, 96, 128, 256, 1408, 704};
  int mat = 0;
#pragma unroll
  for (int i = 0; i < 10; ++i) { if (mat == i && r >= cnt[i]) { r -= cnt[i]; mat = i + 1; } }
  MatDesc d = get_mat(P, layer, mat);
  const int kt = d.K >> 6, n0 = (r / kt) * 64, k0 = (r % kt) * 64;
  float* tile = reinterpret_cast<float*>(smem);
  h16* dst = reinterpret_cast<h16*>(P.ws + OFF_WT) + (long)layer * WT_LAYER + d.dst;
  const int tid = tidx(), lx = tid & 63, ly = tid >> 6;
  const int sc = map_col(mat, n0 + lx);
#pragma unroll 4
  for (int i = 0; i < 16; ++i) { int kk = i * 4 + ly; tile[kk * 65 + lx] = sc >= 0 ? d.src[(long)(k0 + kk) * d.Nsrc + sc] : 0.f; }
  __syncthreads();
  const float s = d.scale ? d.scale[k0 + lx] : 1.f;
#pragma unroll 4
  for (int i = 0; i < 16; ++i) { int nn = i * 4 + ly; dst[(long)(n0 + nn) * d.ld + k0 + lx] = (h16)(tile[lx * 65 + nn] * s); }
  __syncthreads();
}
DI void item_mod(const Params& P, int item, char* smem) {
  const int layer = item / 96, n0 = (item % 96) * 64;
  float* s = reinterpret_cast<float*>(smem);
  float* part = s + 9 * 1024;
  const int tid = tidx(), lane = tid & 63, wid = tid >> 6;
  for (int i = tid; i < 9 * 1024; i += NTHREADS) { float v = i < 8192 ? P.in[I_C][i] : P.in[I_CCTX][i - 8192]; s[i] = siluf_(v); }
  __syncthreads();
  const float* w = P.in[I_WMOD] + (long)layer * 1024 * 6144 + n0 + lane;
  float acc[9];
#pragma unroll
  for (int r = 0; r < 9; ++r) acc[r] = 0.f;
#pragma unroll 32
  for (int k = wid * 256; k < wid * 256 + 256; ++k) {
    const float wv = w[(long)k * 6144];
#pragma unroll
    for (int r = 0; r < 9; ++r) acc[r] += s[r * 1024 + k] * wv;
  }
#pragma unroll
  for (int r = 0; r < 9; ++r) part[(wid * 9 + r) * 64 + lane] = acc[r];
  __syncthreads();
  float* mod = reinterpret_cast<float*>(P.ws + OFF_MOD) + (long)layer * 9 * 6144;
  for (int i = tid; i < 9 * 64; i += NTHREADS) {
    const int r = i >> 6, c = i & 63;
    mod[r * 6144 + n0 + c] = part[(0 * 9 + r) * 64 + c] + part[(1 * 9 + r) * 64 + c] + part[(2 * 9 + r) * 64 + c] + part[(3 * 9 + r) * 64 + c] + P.in[I_BMOD][layer * 6144 + n0 + c];
  }
  __syncthreads();
}
DI void item_hymlp(const Params& P, int item, char* smem) {
  const int layer = item / 132; int r = item % 132;
  const int isc = r >= 128; const int Lf = isc ? CTXL : SEQ; const int t0 = (isc ? r - 128 : r) * 64;
  float* z1 = reinterpret_cast<float*>(smem);
  const int tid = tidx(), tl = tid >> 2, h0 = (tid & 3) * 16; const int t = t0 + tl;
  const float* w1 = P.in[I_FW1] + layer * 17 * 64; const float* b1 = P.in[I_FB1] + layer * 64;
  const float* w2 = P.in[I_FW2] + layer * 64 * 64; const float* b2 = P.in[I_FB2] + layer * 64; const float* fq = P.in[I_FFREQ] + layer * 64;
  float feat[17]; feat[0] = (float)t / (float)Lf;
#pragma unroll
  for (int k = 1; k <= 8; ++k) { float rev = (float)((t * k) % Lf) / (float)Lf; feat[k] = __builtin_amdgcn_cosf(rev); feat[8 + k] = __builtin_amdgcn_sinf(rev); }
#pragma unroll 4
  for (int j = 0; j < 16; ++j) {
    const int h = h0 + j; float a = b1[h];
#pragma unroll
    for (int f = 0; f < 17; ++f) a += feat[f] * w1[f * 64 + h];
    z1[tl * 65 + h] = __sinf(fq[h] * a);
  }
  __syncthreads();
  float* z2 = isc ? reinterpret_cast<float*>(P.ws + OFF_Z2C) + (long)layer * CTXL * 64 : reinterpret_cast<float*>(P.ws + OFF_Z2) + (long)layer * SEQ * 64;
  float a2[16];
#pragma unroll
  for (int j = 0; j < 16; ++j) a2[j] = b2[h0 + j];
  for (int k = 0; k < 64; ++k) {
    const float zv = z1[tl * 65 + k];
#pragma unroll
    for (int j = 0; j < 16; ++j) a2[j] += zv * w2[k * 64 + h0 + j];
  }
#pragma unroll
  for (int j = 0; j < 16; ++j) z2[(long)t * 64 + h0 + j] = __sinf(fq[h0 + j] * a2[j]);
  __syncthreads();
}
DI void item_s5disc(const Params& P, int item) {
  const int layer = item / 12, dir = (item % 12) / 6, gb = item % 6;
  const int tid = tidx(), g = gb * 4 + (tid >> 6), n = tid & 63;
  const int ld = layer * 2 + dir; const long gi = (long)ld * 24 + g;
  const double lre = P.in[I_LAMRE][gi * 64 + n], lim = P.in[I_LAMIM][gi * 64 + n];
  const double step = exp((double)P.in[I_LOGSTEP][gi]);
  double sn, cs; dsincos(lim * step, sn, cs);
  const double mag = exp(lre * step);
  const double are = mag * cs, aim = mag * sn;
  const double nr = are - 1.0, ni = aim, den = lre * lre + lim * lim;
  const double fre = (nr * lre + ni * lim) / den, fim = (ni * lre - nr * lim) / den;
  float2* A = reinterpret_cast<float2*>(P.ws + OFF_S5A); float2* A64 = reinterpret_cast<float2*>(P.ws + OFF_S5A64);
  A[gi * 64 + n] = make_float2((float)are, (float)aim);
  double pr = are, pi = aim;
  for (int i = 0; i < 6; ++i) { double t = pr * pr - pi * pi; pi = 2.0 * pr * pi; pr = t; }
  A64[gi * 64 + n] = make_float2((float)pr, (float)pi);
  float2* Bb = reinterpret_cast<float2*>(P.ws + OFF_S5B) + (gi * 64 + n) * 16;
  const float* bre = P.in[I_BRE] + (gi * 64 + n) * 16; const float* bim = P.in[I_BIM] + (gi * 64 + n) * 16;
  for (int c = 0; c < 16; ++c) { double br = bre[c], bi = bim[c]; Bb[c] = make_float2((float)(fre * br - fim * bi), (float)(fre * bi + fim * br)); }
  h16* Ct = reinterpret_cast<h16*>(P.ws + OFF_S5C) + gi * 16 * 128;
  const float* cre = P.in[I_CRE] + gi * 16 * 64; const float* cim = P.in[I_CIM] + gi * 16 * 64;
  for (int c = 0; c < 16; ++c) { Ct[c * 128 + n] = (h16)cre[c * 64 + n]; Ct[c * 128 + 64 + n] = (h16)(-cim[c * 64 + n]); }
}
DI void item_rope(const Params& P, int item) {
  const int idx = item * NTHREADS + tidx(); const int pos = idx >> 4, i = idx & 15;
  const double inv[8] = {1.0, 0.31622776601683794, 0.1, 0.031622776601683794, 0.01, 0.0031622776601683794, 0.001, 0.00031622776601683794};
  double iv = 1.0;
#pragma unroll
  for (int k = 0; k < 8; ++k) if ((i & 7) == k) iv = inv[k];
  const double ang = (double)(i < 8 ? (pos >> 6) : (pos & 63)) * iv;
  double s, c; dsincos(ang, s, c);
  reinterpret_cast<float2*>(P.ws + OFF_ROPE)[idx] = make_float2((float)c, (float)s);
}
constexpr int PRO_N_WT = 2 * WT_TILES_PER_LAYER, PRO_N_MOD = 192, PRO_N_HY = 264, PRO_N_S5 = 24, PRO_N_ROPE = 512;
DI void phase_prologue(const Params& P, char* smem) {
  const int total = PRO_N_MOD + PRO_N_HY + PRO_N_S5 + PRO_N_ROPE + PRO_N_WT;
  for (int it = blockIdx.x; it < total; it += gridDim.x) {
    int i = it;
    if (i < PRO_N_MOD) { item_mod(P, i, smem); continue; } i -= PRO_N_MOD;
    if (i < PRO_N_HY) { item_hymlp(P, i, smem); continue; } i -= PRO_N_HY;
    if (i < PRO_N_S5) { item_s5disc(P, i); continue; } i -= PRO_N_S5;
    if (i < PRO_N_ROPE) { item_rope(P, i); continue; } i -= PRO_N_ROPE;
    item_wt(P, i, smem);
  }
}

DI const float* xrow_src(const Params& P, int layer_stage, int t) {
  if (t < TLAT) return (layer_stage == 0 ? P.in[I_X] : P.out) + (long)t * 1024;
  return (layer_stage == 0 ? P.in[I_CTX] : reinterpret_cast<const float*>(P.ws + OFF_XC)) + (long)(t - TLAT) * 1024;
}
DI float* xrow_dst(const Params& P, int t) {
  if (t < TLAT) return P.out + (long)t * 1024;
  return reinterpret_cast<float*>(P.ws + OFF_XC) + (long)(t - TLAT) * 1024;
}
DI void normmod_rows(const Params& P, int layer, int which, int stage, int ntok, int item, int nitems_stride) {
  const int tid = tidx(), lane = tid & 63, wid = tid >> 6;
  const float* g = P.in[which ? I_N2G : I_N1G] + layer * 1024;
  const float* mod = reinterpret_cast<const float*>(P.ws + OFF_MOD) + (long)layer * 9 * 6144;
  h16* H = reinterpret_cast<h16*>(P.ws + OFF_H1);
  for (int rg = item; rg * 4 < ntok; rg += nitems_stride) {
    const int t = rg * 4 + wid;
    const Tok k = tokinfo(t);
    const float* xr = xrow_src(P, stage, t);
    const float* sh = mod + k.mrow * 6144 + (which ? 3 : 0) * 1024; const float* sc = sh + 1024;
    float4 v[4]; float ss = 0.f;
#pragma unroll
    for (int i = 0; i < 4; ++i) { v[i] = *reinterpret_cast<const float4*>(xr + i * 256 + lane * 4); ss += v[i].x * v[i].x + v[i].y * v[i].y + v[i].z * v[i].z + v[i].w * v[i].w; }
    ss = wave_sum(ss);
    const float r = rsqrtf(ss * (1.f / 1024.f) + EPS);
#pragma unroll
    for (int i = 0; i < 4; ++i) {
      const int c = i * 256 + lane * 4;
      const float4 gg = *reinterpret_cast<const float4*>(g + c), s1 = *reinterpret_cast<const float4*>(sc + c), s0 = *reinterpret_cast<const float4*>(sh + c);
      h16x4 o;
      o[0] = (h16)(v[i].x * r * gg.x * (1.f + s1.x) + s0.x); o[1] = (h16)(v[i].y * r * gg.y * (1.f + s1.y) + s0.y);
      o[2] = (h16)(v[i].z * r * gg.z * (1.f + s1.z) + s0.z); o[3] = (h16)(v[i].w * r * gg.w * (1.f + s1.w) + s0.w);
      *reinterpret_cast<h16x4*>(H + (long)t * LD1 + c) = o;
    }
  }
}
DI void phase_final(const Params& P) {
  const int lane = tidx() & 63, wid = tidx() >> 6;
  const float* g = P.in[I_FINALG];
  for (int rg = blockIdx.x; rg * 4 < TLAT; rg += gridDim.x) {
    float* xr = P.out + (long)(rg * 4 + wid) * 1024;
    float4 v[4]; float ss = 0.f;
#pragma unroll
    for (int i = 0; i < 4; ++i) { v[i] = *reinterpret_cast<const float4*>(xr + i * 256 + lane * 4); ss += v[i].x * v[i].x + v[i].y * v[i].y + v[i].z * v[i].z + v[i].w * v[i].w; }
    ss = wave_sum(ss);
    const float r = rsqrtf(ss * (1.f / 1024.f) + EPS);
#pragma unroll
    for (int i = 0; i < 4; ++i) {
      const int c = i * 256 + lane * 4; const float4 gg = *reinterpret_cast<const float4*>(g + c);
      *reinterpret_cast<float4*>(xr + c) = make_float4(v[i].x * r * gg.x, v[i].y * r * gg.y, v[i].z * r * gg.z, v[i].w * r * gg.w);
    }
  }
}
DI float2 r8(int idx) { const float c = 0.70710678118654752f; return idx == 0 ? make_float2(1.f, 0.f) : idx == 1 ? make_float2(c, -c) : idx == 2 ? make_float2(0.f, -1.f) : make_float2(-c, -c); }
DI float2 cmul_r8(float2 w, int idx, bool cj) {
  if (idx == 0) return w;
  float2 r = r8(idx); if (cj) r.y = -r.y;
  return cmul(w, r);
}
template <int S> DI void fft_dif_pass(float2* X, int h) {
  const int hs = h >> (S - 1);
#pragma unroll 1
  for (int item = tidx(); item < (8192 >> S); item += NTHREADS) {
    const int j = item % hs, blk = item / hs, i0 = blk * 2 * h + j;
    float2 v[1 << S];
#pragma unroll
    for (int k = 0; k < (1 << S); ++k) v[k] = X[i0 + k * hs];
    float2 wp[S];
    wp[0] = twid(-(float)j / (float)(2 * h));
#pragma unroll
    for (int q = 1; q < S; ++q) wp[q] = cmul(wp[q - 1], wp[q - 1]);
#pragma unroll
    for (int q = 0; q < S; ++q) {
      const int dist = 1 << (S - 1 - q);
#pragma unroll
      for (int k = 0; k < (1 << S); ++k) {
        if (k & dist) continue;
        const float2 a = v[k], b = v[k + dist];
        const int m = k & (dist - 1);
        const float2 tw = cmul_r8(wp[q], m << (3 - (S - q)), false);
        v[k] = make_float2(a.x + b.x, a.y + b.y);
        v[k + dist] = cmul(make_float2(a.x - b.x, a.y - b.y), tw);
      }
    }
#pragma unroll
    for (int k = 0; k < (1 << S); ++k) X[i0 + k * hs] = v[k];
  }
  __syncthreads();
}
template <int S> DI void fft_dit_pass(float2* X, int hs) {
  const int hmax = hs << (S - 1);
#pragma unroll 1
  for (int item = tidx(); item < (8192 >> S); item += NTHREADS) {
    const int j = item % hs, blk = item / hs, i0 = blk * 2 * hmax + j;
    float2 v[1 << S];
#pragma unroll
    for (int k = 0; k < (1 << S); ++k) v[k] = X[i0 + k * hs];
    float2 bp[S];
    bp[S - 1] = twid((float)j / (float)(2 * hmax));
#pragma unroll
    for (int q = S - 2; q >= 0; --q) bp[q] = cmul(bp[q + 1], bp[q + 1]);
#pragma unroll
    for (int q = 0; q < S; ++q) {
      const int dist = 1 << q;
#pragma unroll
      for (int k = 0; k < (1 << S); ++k) {
        if (k & dist) continue;
        const int m = k & (dist - 1);
        const float2 tw = cmul_r8(bp[q], m << (3 - (q + 1)), true);
        const float2 a = v[k], b = cmul(v[k + dist], tw);
        v[k] = make_float2(a.x + b.x, a.y + b.y);
        v[k + dist] = make_float2(a.x - b.x, a.y - b.y);
      }
    }
#pragma unroll
    for (int k = 0; k < (1 << S); ++k) X[i0 + k * hs] = v[k];
  }
  __syncthreads();
}
DI void fft_fwd1(float2* X) { fft_dif_pass<3>(X, 4096); fft_dif_pass<3>(X, 512); fft_dif_pass<3>(X, 64); fft_dif_pass<2>(X, 8); fft_dif_pass<2>(X, 2); }
DI void fft_inv(float2* X) { fft_dit_pass<2>(X, 1); fft_dit_pass<2>(X, 4); fft_dit_pass<3>(X, 16); fft_dit_pass<3>(X, 128); fft_dit_pass<3>(X, 1024); }
#ifndef PROBE_FFT
#define PROBE_FFT 0
#endif
DI void fft_fwd(float2* X) {
#if PROBE_FFT
  fft_fwd1(X); fft_inv(X);
  for (int i = tidx(); i < 8192; i += NTHREADS) { float2 v = X[i]; X[i] = make_float2(v.x * (1.f / 8192.f), v.y * (1.f / 8192.f)); }
  __syncthreads();
#endif
  fft_fwd1(X);
}

DI float block_sum(float v, float* red) {
  v = wave_sum(v);
  __syncthreads();
  if ((tidx() & 63) == 0) red[tidx() >> 6] = v;
  __syncthreads();
  const float r = red[0] + red[1] + red[2] + red[3];
  __syncthreads();
  return r;
}
DI void item_filter(const Params& P, int layer, int oc, char* smem) {
  float2* X = reinterpret_cast<float2*>(smem); float* red = reinterpret_cast<float*>(smem + 65536);
  const int tid = tidx();
  const float* z2 = reinterpret_cast<const float*>(P.ws + OFF_Z2) + (long)layer * SEQ * 64;
  const float* w3 = P.in[I_FW3] + (long)layer * 64 * 1536; const float* dec = P.in[I_FDECAY] + layer * 1536;
  const int colf = oc, colb = 768 + oc;
  const float df = fabsf(dec[colf]), db = fabsf(dec[colb]);
  float lsum = 0.f;
#pragma unroll 2
  for (int i = 0; i < 32; ++i) {
    const int t = tid + 256 * i; const float* zr = z2 + (long)t * 64;
    float af = 0.f, ab = 0.f;
#pragma unroll 8
    for (int k = 0; k < 64; ++k) { const float z = zr[k]; af += z * w3[k * 1536 + colf]; ab += z * w3[k * 1536 + colb]; }
    const float tn = (float)t * (1.f / 8192.f);
    af *= __expf(-tn * df); ab *= __expf(-tn * db);
    lsum += fabsf(af) + fabsf(ab);
    X[t] = make_float2(af, ab);
  }
  const float nrm = block_sum(lsum, red);
  const float sc = 0.5f / 8192.f / nrm;
  float ev[32];
  float2* F = reinterpret_cast<float2*>(P.ws + OFF_FILT) + (long)oc * 2 * 8192;
#pragma unroll
  for (int i = 0; i < 32; ++i) {
    const int n = tid + 256 * i; const float lo = X[n].x; const float hi = n > 0 ? X[8192 - n].y : 0.f;
    ev[i] = (lo + hi) * sc; F[8192 + n] = make_float2((lo - hi) * sc, 0.f);
  }
  __syncthreads();
#pragma unroll
  for (int i = 0; i < 32; ++i) X[tid + 256 * i] = make_float2(ev[i], 0.f);
  __syncthreads();
  fft_fwd(X);
#pragma unroll 4
  for (int i = 0; i < 32; ++i) F[tid + 256 * i] = X[tid + 256 * i];
  __syncthreads();
#pragma unroll 4
  for (int i = 0; i < 32; ++i) { const int n = tid + 256 * i; const float d = F[8192 + n].x; const float2 w = twid(-(float)n * (1.f / 16384.f)); X[n] = make_float2(d * w.x, d * w.y); }
  __syncthreads();
  fft_fwd(X);
#pragma unroll 4
  for (int i = 0; i < 32; ++i) F[8192 + tid + 256 * i] = X[tid + 256 * i];
  __syncthreads();
}
DI void item_filter_ctx(const Params& P, int layer, int oc, char* smem) {
  float* red = reinterpret_cast<float*>(smem);
  const int t = tidx();
  const float* zr = reinterpret_cast<const float*>(P.ws + OFF_Z2C) + (long)layer * CTXL * 64 + t * 64;
  const float* w3 = P.in[I_FW3] + (long)layer * 64 * 1536; const float* dec = P.in[I_FDECAY] + layer * 1536;
  float af = 0.f, ab = 0.f;
  for (int k = 0; k < 64; ++k) { const float z = zr[k]; af += z * w3[k * 1536 + oc]; ab += z * w3[k * 1536 + 768 + oc]; }
  const float tn = (float)t * (1.f / 256.f);
  af *= __expf(-tn * fabsf(dec[oc])); ab *= __expf(-tn * fabsf(dec[768 + oc]));
  const float nrm = block_sum(fabsf(af) + fabsf(ab), red);
  float* T = reinterpret_cast<float*>(P.ws + OFF_TAPSC) + (long)oc * 512;
  T[t] = af / nrm; T[256 + t] = ab / nrm;
}

DI void phase_norm1(const Params& P, int layer, char* smem) {
  const int nfilt = 768 + (layer == 0 ? 768 : 0);
  for (int it = blockIdx.x; it < nfilt; it += gridDim.x) {
    if (it < 768) item_filter(P, layer, it, smem); else item_filter_ctx(P, layer, it - 768, smem);
  }
  normmod_rows(P, layer, 0, layer, TT, blockIdx.x, gridDim.x);
}

DI void phase_gemm_in(const Params& P, int layer, char* smem) {
  const int tid = tidx(), lane = tid & 63, wid = tid >> 6, wr = wid >> 1, wc = wid & 1, fr = lane & 15, fq = lane >> 4;
  const h16* H = reinterpret_cast<const h16*>(P.ws + OFF_H1);
  const h16* W = reinterpret_cast<const h16*>(P.ws + OFF_WT) + (long)layer * WT_LAYER + WT_WIN;
  h16* U = reinterpret_cast<h16*>(P.ws + OFF_U); h16* KV = reinterpret_cast<h16*>(P.ws + OFF_KVLAT); h16* QL = reinterpret_cast<h16*>(P.ws + OFF_QLAT);
  h16* PHY = reinterpret_cast<h16*>(P.ws + OFF_PHY); h16* PHYC = reinterpret_cast<h16*>(P.ws + OFF_PHYC); h16* Kb = reinterpret_cast<h16*>(P.ws + OFF_K);
  const float2* rope = reinterpret_cast<const float2*>(P.ws + OFF_ROPE);
  constexpr int NT = 19, MT = TT / 128;
  const TileWalk tw = tw_init(MT, NT);
  for (int tile = tw.lb; tile < tw_count(tw); tile += tw.nlb) {
    int mt, nt; tw_decode(tw, tile, mt, nt);
    f32x4 acc[4][4]; acc_zero(acc);
    gemm_kloop(acc, H + (long)mt * 128 * LD1, LD1, 0, 128, W + (long)nt * 128 * LD1, LD1, 1024, smem, opaque_tid());
    const int t0 = mt * 128; const Tok tk = tokinfo(t0);
    if (nt < 18) {
      float* Zs = reinterpret_cast<float*>(smem);
      const int t2 = tidx();
      if (nt < 9) {
        stage_acc(acc, Zs, t2);
        h16* dst; int ld, cb;
        if (nt < 3) { dst = U; ld = 384; cb = nt * 128; } else if (nt < 5) { dst = KV; ld = 256; cb = (nt - 3) * 128; } else { dst = QL; ld = 512; cb = (nt - 5) * 128; }
        copy_out_f16(Zs, dst, t0, ld, cb, t2);
      } else {
        stage_acc_t(acc, Zs, t2);
        h16* base = tk.ctx ? PHYC + (long)tk.b * 1152 * CTXL : PHY + (long)tk.b * 1152 * SEQ; const int lp = tk.ctx ? CTXL : SEQ;
        copy_out_f16(Zs, base, (nt - 9) * 128, lp, tk.pos, t2);
      }
      __syncthreads();
    } else {
      h16* R = reinterpret_cast<h16*>(smem);
      if (wc == 0) {
#pragma unroll
        for (int m = 0; m < 4; ++m)
#pragma unroll
          for (int j = 0; j < 4; ++j) {
            const int row = wr * 64 + m * 16 + fq * 4 + j; const int pos = tk.pos + row;
            float x1 = acc[m][0][j], x2 = acc[m][1][j];
            if (!tk.ctx) { const float2 cs = rope[pos * 16 + fr]; const float y1 = x1 * cs.x - x2 * cs.y, y2 = x1 * cs.y + x2 * cs.x; x1 = y1; x2 = y2; }
            R[row * 32 + fr] = (h16)x1; R[row * 32 + 16 + fr] = (h16)x2;
          }
      }
      __syncthreads();
      {
        const int t2 = tidx(); const int key0 = (tk.ctx ? SEQ : 0) + tk.pos;
#pragma unroll
        for (int it = 0; it < 2; ++it) {
          const int chunk = it * 256 + t2, row = chunk >> 2, part = chunk & 3;
          const uint4 v = *reinterpret_cast<const uint4*>(R + row * 32 + part * 8);
#pragma unroll
          for (int h = 0; h < 8; ++h) *reinterpret_cast<uint4*>(Kb + ((long)(tk.b * 8 + h) * KEYS + key0 + row) * 96 + 64 + part * 8) = v;
        }
      }
      __syncthreads();
    }
  }
}
DI void item_kv(const Params& P, int layer, int tile, char* smem) {
  const int tid = tidx(), lane = tid & 63, wid = tid >> 6, wr = wid >> 1, wc = wid & 1, fr = lane & 15, fq = lane >> 4;
  const int mt = tile >> 3, hd = tile & 7; const int t0 = mt * 128; const Tok tk = tokinfo(t0);
  const h16* A = reinterpret_cast<const h16*>(P.ws + OFF_KVLAT) + (long)t0 * 256;
  const h16* W = reinterpret_cast<const h16*>(P.ws + OFF_WT) + (long)layer * WT_LAYER + WT_UKV + (long)hd * 128 * 256;
  float* rs = reinterpret_cast<float*>(smem + 73728);
  row_rms(A, 256, 256, rs);
  f32x4 acc[4][4]; acc_zero(acc);
  gemm_kloop(acc, A, 256, 0, 128, W, 256, 256, smem, opaque_tid());
  h16* Kb = reinterpret_cast<h16*>(P.ws + OFF_K) + (long)(tk.b * 8 + hd) * KEYS * 96;
  h16* Vt = reinterpret_cast<h16*>(P.ws + OFF_VT) + (long)(tk.b * 8 + hd) * 64 * KEYS;
  const int key0 = (tk.ctx ? SEQ : 0) + tk.pos;
#pragma unroll
  for (int m = 0; m < 4; ++m) {
    const int r0 = wr * 64 + m * 16 + fq * 4;
    const float s0 = rs[r0], s1 = rs[r0 + 1], s2 = rs[r0 + 2], s3 = rs[r0 + 3];
#pragma unroll
    for (int n = 0; n < 4; ++n) {
      acc[m][n][0] *= s0; acc[m][n][1] *= s1; acc[m][n][2] *= s2; acc[m][n][3] *= s3;
      if (wc == 1) {
        h16x4 o; o[0] = (h16)acc[m][n][0]; o[1] = (h16)acc[m][n][1]; o[2] = (h16)acc[m][n][2]; o[3] = (h16)acc[m][n][3];
        *reinterpret_cast<h16x4*>(Vt + (long)(n * 16 + fr) * KEYS + key0 + r0) = o;
      }
    }
  }
  {
    float* Zs = reinterpret_cast<float*>(smem);
    const int t2 = tidx();
    stage_acc(acc, Zs, t2);
#pragma unroll
    for (int it = 0; it < 4; ++it) {
      const int chunk = it * 256 + t2, row = chunk >> 3, c8 = (chunk & 7) * 8;
      const float4 x0 = *reinterpret_cast<const float4*>(Zs + row * 132 + c8), x1 = *reinterpret_cast<const float4*>(Zs + row * 132 + c8 + 4);
      h16x8 o; o[0] = (h16)x0.x; o[1] = (h16)x0.y; o[2] = (h16)x0.z; o[3] = (h16)x0.w; o[4] = (h16)x1.x; o[5] = (h16)x1.y; o[6] = (h16)x1.z; o[7] = (h16)x1.w;
      *reinterpret_cast<h16x8*>(Kb + (long)(key0 + row) * 96 + c8) = o;
    }
  }
  __syncthreads();
}
DI void item_q(const Params& P, int layer, int tile, char* smem) {
  const int tid = tidx(), lane = tid & 63, wid = tid >> 6, wr = wid >> 1, wc = wid & 1, fr = lane & 15, fq = lane >> 4;
  const int mt = tile >> 3, hd = tile & 7; const int t0 = mt * 128; const Tok tk = tokinfo(t0);
  const h16* A = reinterpret_cast<const h16*>(P.ws + OFF_QLAT) + (long)t0 * 512;
  const h16* W = reinterpret_cast<const h16*>(P.ws + OFF_WT) + (long)layer * WT_LAYER + WT_UQ + (long)hd * 128 * 512;
  float* rs = reinterpret_cast<float*>(smem + 73728);
  row_rms(A, 512, 512, rs);
  f32x4 acc[4][4]; acc_zero(acc);
  gemm_kloop(acc, A, 512, 0, 128, W, 512, 512, smem, opaque_tid());
  h16* Qb = reinterpret_cast<h16*>(P.ws + OFF_Q) + (long)(tk.b * 8 + hd) * KEYS * 96;
  const float2* rope = reinterpret_cast<const float2*>(P.ws + OFF_ROPE);
  const int q0 = (tk.ctx ? SEQ : 0) + tk.pos;
#pragma unroll
  for (int m = 0; m < 4; ++m)
#pragma unroll
    for (int j = 0; j < 4; ++j) {
      const int r = wr * 64 + m * 16 + fq * 4 + j; const float s = rs[r] * QSCALE;
      if (wc == 0) {
#pragma unroll
        for (int n = 0; n < 4; ++n) acc[m][n][j] *= s;
      } else {
        float x1 = acc[m][0][j], x2 = acc[m][1][j];
        if (!tk.ctx) { const float2 cs = rope[(tk.pos + r) * 16 + fr]; const float y1 = x1 * cs.x - x2 * cs.y, y2 = x1 * cs.y + x2 * cs.x; x1 = y1; x2 = y2; }
        acc[m][0][j] = x1 * s; acc[m][1][j] = x2 * s;
      }
    }
  {
    float* Zs = reinterpret_cast<float*>(smem);
    const int t2 = tidx();
    stage_acc(acc, Zs, t2);
#pragma unroll
    for (int it = 0; it < 6; ++it) {
      const int chunk = it * 256 + t2, row = chunk / 12, c8 = (chunk % 12) * 8;
      const float4 x0 = *reinterpret_cast<const float4*>(Zs + row * 132 + c8), x1 = *reinterpret_cast<const float4*>(Zs + row * 132 + c8 + 4);
      h16x8 o; o[0] = (h16)x0.x; o[1] = (h16)x0.y; o[2] = (h16)x0.z; o[3] = (h16)x0.w; o[4] = (h16)x1.x; o[5] = (h16)x1.y; o[6] = (h16)x1.z; o[7] = (h16)x1.w;
      *reinterpret_cast<h16x8*>(Qb + (long)(q0 + row) * 96 + c8) = o;
    }
  }
  __syncthreads();
}
DI int s5_chunk_base(int b, int dir, int si) {
  if (si < 4) { const int cc = dir ? 3 - si : si; return TLAT + b * CTXL + cc * 64; }
  const int lc = dir ? 127 - (si - 4) : si - 4; return b * SEQ + lc * 64;
}
DI void s5_stage_u(const h16* __restrict__ U, int tokbase, int g, float* us) {
  const int lane = tidx() & 63;
  const h16* p = U + (long)(tokbase + lane) * 384 + g * 16;
  const h16x8 v0 = *reinterpret_cast<const h16x8*>(p), v1 = *reinterpret_cast<const h16x8*>(p + 8);
#pragma unroll
  for (int j = 0; j < 8; ++j) { us[lane * 16 + j] = (float)v0[j]; us[lane * 16 + 8 + j] = (float)v1[j]; }
}
DI void item_s5_pass1(const Params& P, int layer, int wtask, char* smem) {
  const int lane = tidx() & 63, wid = tidx() >> 6;
  float* us = reinterpret_cast<float*>(smem + wid * 12800);
  const int si = wtask % 132; int r = wtask / 132; const int g = r % 24; r /= 24; const int dir = r & 1, b = r >> 1;
  const long gi = (long)(layer * 2 + dir) * 24 + g;
  const float2 a = reinterpret_cast<const float2*>(P.ws + OFF_S5A)[gi * 64 + lane];
  const float2* Bb = reinterpret_cast<const float2*>(P.ws + OFF_S5B) + (gi * 64 + lane) * 16;
  float bre[16], bim[16];
#pragma unroll
  for (int c = 0; c < 16; ++c) { const float2 v = Bb[c]; bre[c] = v.x; bim[c] = v.y; }
  s5_stage_u(reinterpret_cast<const h16*>(P.ws + OFF_U), s5_chunk_base(b, dir, si), g, us);
  float hr = 0.f, hi = 0.f;
#pragma unroll 4
  for (int s = 0; s < 64; ++s) {
    const int tau = dir ? 63 - s : s;
    const float4* up = reinterpret_cast<const float4*>(us + tau * 16);
    float br = 0.f, bi = 0.f;
#pragma unroll
    for (int q = 0; q < 4; ++q) { const float4 u = up[q];
      br += bre[q * 4] * u.x + bre[q * 4 + 1] * u.y + bre[q * 4 + 2] * u.z + bre[q * 4 + 3] * u.w;
      bi += bim[q * 4] * u.x + bim[q * 4 + 1] * u.y + bim[q * 4 + 2] * u.z + bim[q * 4 + 3] * u.w; }
    const float nr = a.x * hr - a.y * hi + br, ni = a.x * hi + a.y * hr + bi; hr = nr; hi = ni;
  }
  reinterpret_cast<float2*>(P.ws + OFF_E)[((long)((b * 2 + dir) * 24 + g) * 132 + si) * 64 + lane] = make_float2(hr, hi);
}

DI float hy_dw(const h16* __restrict__ p, int t, int Ls, float w0, float w1, float w2, float bias) {
  const float xm_ = (float)p[max(t - 1, 0)], x0 = (float)p[t], xp_ = (float)p[min(t + 1, Ls - 1)];
  const float xm = t > 0 ? xm_ : 0.f, xp = t + 1 < Ls ? xp_ : 0.f;
  return xm * w0 + x0 * w1 + xp * w2 + bias;
}
DI void item_hyena(const Params& P, int layer, int task, char* smem) {
  float2* X = reinterpret_cast<float2*>(smem);
  const int tid = tidx(); const int pair = task / 384, c = task % 384;
  const h16* PH0 = reinterpret_cast<const h16*>(P.ws + OFF_PHY) + (long)(2 * pair) * 1152 * SEQ;
  const h16* PH1 = PH0 + (long)1152 * SEQ;
  const float* cw = P.in[I_HCW] + layer * 3 * 1152; const float* cb = P.in[I_HCB] + layer * 1152;
  const float2* F = reinterpret_cast<const float2*>(P.ws + OFF_FILT);
  float2* SCR = reinterpret_cast<float2*>(P.ws + OFF_YS5PRE) + (long)blockIdx.x * 12288;
  float2* SCR2 = SCR + 8192;
  const float vw0 = cw[c], vw1 = cw[1152 + c], vw2 = cw[2304 + c], vbb = cb[c];
  const h16* pv0 = PH0 + (long)c * SEQ; const h16* pv1 = PH1 + (long)c * SEQ;
  float2 ye[16]; int tq;
#pragma unroll 1
  for (int o = 0; o < 2; ++o) {
    const float2* Te = F + (long)(o * 384 + c) * 2 * 8192; const float2* To = Te + 8192;
    float ts = 1.f / 16384.f; asm volatile("" : "+v"(ts));
{ tq = tid; asm volatile("" : "+v"(tq)); }
    if (o == 0) {
#pragma unroll 8
      for (int i = 0; i < 32; ++i) { const int t = tq + 256 * i; const float2 v = make_float2(hy_dw(pv0, t, SEQ, vw0, vw1, vw2, vbb), hy_dw(pv1, t, SEQ, vw0, vw1, vw2, vbb)); X[t] = v; SCR[t] = v; }
    } else {
#pragma unroll 16
      for (int i = 0; i < 32; ++i) { const int t = tq + 256 * i; X[t] = SCR[t]; }
    }
    __syncthreads();
    fft_fwd(X);
{ tq = tid; asm volatile("" : "+v"(tq)); }
#pragma unroll 8
    for (int i = 0; i < 32; ++i) { const int n = tq + 256 * i; X[n] = cmul(X[n], Te[n]); }
    __syncthreads();
    fft_inv(X);
{ tq = tid; asm volatile("" : "+v"(tq)); }
#pragma unroll
    for (int i = 0; i < 16; ++i) { ye[i] = X[tq + 256 * i]; SCR2[tq + 256 * i] = X[tq + 4096 + 256 * i]; }
    __syncthreads();
{ tq = tid; asm volatile("" : "+v"(tq)); }
#pragma unroll 16
    for (int i = 0; i < 32; ++i) { const int t = tq + 256 * i; X[t] = cmul(SCR[t], twid(-(float)t * ts)); }
    __syncthreads();
    fft_fwd(X);
{ tq = tid; asm volatile("" : "+v"(tq)); }
#pragma unroll 8
    for (int i = 0; i < 32; ++i) { const int n = tq + 256 * i; X[n] = cmul(X[n], To[n]); }
    __syncthreads();
    fft_inv(X);
    asm volatile("" : "+v"(ts));
{ tq = tid; asm volatile("" : "+v"(tq)); }
#pragma unroll
    for (int i = 0; i < 16; ++i) { const int t = tq + 256 * i; const float2 yo = cmul(X[t], twid((float)t * ts)); X[t] = make_float2(ye[i].x + yo.x, ye[i].y + yo.y); }
{ tq = tid; asm volatile("" : "+v"(tq)); }
#pragma unroll 2
    for (int i = 0; i < 16; ++i) { const int t = tq + 4096 + 256 * i; const float2 yo = cmul(X[t], twid((float)t * ts)); const float2 y2 = SCR2[tq + 256 * i]; X[t] = make_float2(y2.x + yo.x, y2.y + yo.y); }
    const int gc = (o + 1) * 384 + c;
    const float w0 = cw[gc], w1 = cw[1152 + gc], w2 = cw[2304 + gc], bb = cb[gc];
    const float bias = P.in[I_HBIAS][(layer * 2 + o) * 384 + c];
    const h16* pg0 = PH0 + (long)gc * SEQ; const h16* pg1 = PH1 + (long)gc * SEQ;
{ tq = tid; asm volatile("" : "+v"(tq)); }
    if (o == 0) {
#pragma unroll 8
      for (int i = 0; i < 32; ++i) {
        const int t = tq + 256 * i;
        const float2 lc = X[t];
        const float2 zz = SCR[t];
        const float gx = hy_dw(pg0, t, SEQ, w0, w1, w2, bb), gy = hy_dw(pg1, t, SEQ, w0, w1, w2, bb);
        SCR[t] = make_float2(gx * (lc.x + bias * zz.x), gy * (lc.y + bias * zz.y));
      }
    } else {
#pragma unroll 8
      for (int i = 0; i < 32; ++i) {
        const int t = tq + 256 * i;
        const float2 lc = X[t];
        const float2 zz = SCR[t];
        const float gx = hy_dw(pg0, t, SEQ, w0, w1, w2, bb), gy = hy_dw(pg1, t, SEQ, w0, w1, w2, bb);
        const_cast<h16*>(pv0)[t] = (h16)(gx * (lc.x + bias * zz.x)); const_cast<h16*>(pv1)[t] = (h16)(gy * (lc.y + bias * zz.y));
      }
    }
    __syncthreads();
  }
}
DI void item_hyena_ctx(const Params& P, int layer, int task, char* smem) {
  float* su = reinterpret_cast<float*>(smem); float* sf = su + 256; float* sb = sf + 256;
  const int t = tidx(); const int b = task / 384, c = task % 384;
  const h16* PH = reinterpret_cast<const h16*>(P.ws + OFF_PHYC) + (long)b * 1152 * CTXL;
  const float* cw = P.in[I_HCW] + layer * 3 * 1152; const float* cb = P.in[I_HCB] + layer * 1152;
  float u = hy_dw(PH + (long)c * CTXL, t, CTXL, cw[c], cw[1152 + c], cw[2304 + c], cb[c]);
  for (int o = 0; o < 2; ++o) {
    const float* T = reinterpret_cast<const float*>(P.ws + OFF_TAPSC) + (long)(o * 384 + c) * 512;
    __syncthreads();
    su[t] = u; sf[t] = T[t]; sb[t] = T[256 + t];
    __syncthreads();
    float y = 0.f;
    for (int s = 0; s <= t; ++s) y += sf[t - s] * su[s];
    for (int s = t + 1; s < 256; ++s) y += sb[s - t] * su[s];
    const int gc = (o + 1) * 384 + c;
    const float gx = hy_dw(PH + (long)gc * CTXL, t, CTXL, cw[gc], cw[1152 + gc], cw[2304 + gc], cb[gc]);
    u = gx * (y + P.in[I_HBIAS][(layer * 2 + o) * 384 + c] * u);
  }
  reinterpret_cast<h16*>(P.ws + OFF_YHY)[((long)TLAT + b * CTXL + t) * 384 + c] = (h16)u;
  __syncthreads();
}

#ifndef PROBE_HY
#define PROBE_HY 0
#endif
#ifndef PROBE_S5
#define PROBE_S5 0
#endif
DI int first_item(int base) { const int g = (int)gridDim.x; return (((int)blockIdx.x - base) % g + g) % g; }
DI void phase_mix1(const Params& P, int layer, char* smem) {
  const int n_hy = 4 * 384, n_hyc = layer == 0 ? 8 * 384 : 0;
  const int n_kv = (TT / 128) * 8, n_q = (layer == 0 ? TT / 128 : TLAT / 128) * 8;
  const int n_s5 = (NBATCH * 2 * 24 * 132) / 4;
  const int g = gridDim.x;
#pragma unroll 1
  for (int rep = 0; rep < 1 + PROBE_HY; ++rep)
#pragma unroll 1
  for (int i = first_item(0); i < n_hy; i += g) item_hyena(P, layer, i, smem);
  asm volatile("" ::: "memory");
#pragma unroll 1
  for (int i = first_item(n_hy); i < n_kv; i += g) item_kv(P, layer, i, smem);
  asm volatile("" ::: "memory");
#pragma unroll 1
  for (int i = first_item(n_hy + n_kv); i < n_q; i += g) item_q(P, layer, i, smem);
  asm volatile("" ::: "memory");
#pragma unroll 1
  for (int rep = 0; rep < 1 + PROBE_S5; ++rep)
#pragma unroll 1
  for (int i = first_item(n_hy + n_kv + n_q); i < n_s5; i += g) { item_s5_pass1(P, layer, i * 4 + (tidx() >> 6), smem); __syncthreads(); }
  asm volatile("" ::: "memory");
#pragma unroll 1
  for (int i = first_item(n_hy + n_kv + n_q + n_s5); i < n_hyc; i += g) item_hyena_ctx(P, layer, i, smem);
}
DI int crow32(int r, int hi) { return (r & 3) + 8 * (r >> 2) + 4 * hi; }
DI void item_attn(const Params& P, int bh, int q0, int key_lo, int ntiles, char* smem) {
  const int tid = tidx(), lane = tid & 63, wid = tid >> 6, r32 = lane & 31, hi = lane >> 5;
  const h16* Qb = reinterpret_cast<const h16*>(P.ws + OFF_Q) + (long)bh * KEYS * 96;
  const h16* Kb = reinterpret_cast<const h16*>(P.ws + OFF_K) + (long)bh * KEYS * 96;
  const h16* Vt = reinterpret_cast<const h16*>(P.ws + OFF_VT) + (long)bh * 64 * KEYS;
  h16x8 qf[6];
  { const h16* qrow = Qb + (long)(q0 + wid * 32 + r32) * 96 + hi * 8;
#pragma unroll
    for (int ds = 0; ds < 6; ++ds) qf[ds] = *reinterpret_cast<const h16x8*>(qrow + ds * 16); }
  constexpr int KT_BYTES = 64 * 208, VT_BYTES = 64 * 136, BUF = KT_BYTES + VT_BYTES;
  uint4 kr[3]; uint4 vr[2];
  const int vdv0 = tid >> 3, vpart = tid & 7;
  auto gload = [&](int j) {
    const long key0 = key_lo + j * 64;
#pragma unroll
    for (int i = 0; i < 3; ++i) kr[i] = *reinterpret_cast<const uint4*>(Kb + key0 * 96 + (long)(tid + 256 * i) * 8);
#pragma unroll
    for (int i = 0; i < 2; ++i) vr[i] = *reinterpret_cast<const uint4*>(Vt + (long)(vdv0 + 32 * i) * KEYS + key0 + vpart * 8);
  };
  auto swrite = [&](int buf) {
    char* ks = smem + buf * BUF; char* vs = ks + KT_BYTES;
#pragma unroll
    for (int i = 0; i < 3; ++i) { const int c = tid + 256 * i; *reinterpret_cast<uint4*>(ks + (c / 12) * 208 + (c % 12) * 16) = kr[i]; }
#pragma unroll
    for (int i = 0; i < 2; ++i) { char* d = vs + (vdv0 + 32 * i) * 136 + vpart * 16;
      *reinterpret_cast<uint2*>(d) = make_uint2(vr[i].x, vr[i].y); *reinterpret_cast<uint2*>(d + 8) = make_uint2(vr[i].z, vr[i].w); }
  };
  f32x16 o0, o1;
#pragma unroll
  for (int r = 0; r < 16; ++r) { o0[r] = 0.f; o1[r] = 0.f; }
  float m_run = -1e30f, l_run = 0.f;
  gload(0); swrite(0); __syncthreads();
  for (int j = 0; j < ntiles; ++j) {
    if (j + 1 < ntiles) gload(j + 1);
    const char* ks = smem + (j & 1) * BUF; const char* vs = ks + KT_BYTES;
    f32x16 p0, p1;
#pragma unroll
    for (int r = 0; r < 16; ++r) { p0[r] = 0.f; p1[r] = 0.f; }
#pragma unroll
    for (int ds = 0; ds < 6; ++ds) {
      const h16x8 a0 = *reinterpret_cast<const h16x8*>(ks + r32 * 208 + (ds * 16 + hi * 8) * 2);
      const h16x8 a1 = *reinterpret_cast<const h16x8*>(ks + (32 + r32) * 208 + (ds * 16 + hi * 8) * 2);
      p0 = __builtin_amdgcn_mfma_f32_32x32x16_f16(a0, qf[ds], p0, 0, 0, 0);
      p1 = __builtin_amdgcn_mfma_f32_32x32x16_f16(a1, qf[ds], p1, 0, 0, 0);
    }
    float mx = p0[0];
#pragma unroll
    for (int r = 1; r < 16; ++r) mx = fmaxf(mx, p0[r]);
#pragma unroll
    for (int r = 0; r < 16; ++r) mx = fmaxf(mx, p1[r]);
    mx = fmaxf(mx, __shfl_xor(mx, 32));
    const float mnew = fmaxf(m_run, mx);
    const float alpha = __builtin_amdgcn_exp2f(m_run - mnew);
    m_run = mnew;
    float rsum = 0.f;
#pragma unroll
    for (int r = 0; r < 16; ++r) { p0[r] = __builtin_amdgcn_exp2f(p0[r] - mnew); rsum += p0[r]; }
#pragma unroll
    for (int r = 0; r < 16; ++r) { p1[r] = __builtin_amdgcn_exp2f(p1[r] - mnew); rsum += p1[r]; }
    l_run = l_run * alpha + rsum;
    if (__any(alpha != 1.f)) {
#pragma unroll
      for (int r = 0; r < 16; ++r) { o0[r] *= alpha; o1[r] *= alpha; }
    }
#pragma unroll
    for (int kb = 0; kb < 2; ++kb)
#pragma unroll
      for (int s = 0; s < 2; ++s) {
        h16x8 pf;
#pragma unroll
        for (int e = 0; e < 8; ++e) pf[e] = (h16)(kb ? p1[8 * s + e] : p0[8 * s + e]);
        const int koff = (32 * kb + 16 * s + 4 * hi) * 2;
        {
          const h16x4 lo = *reinterpret_cast<const h16x4*>(vs + r32 * 136 + koff), hh = *reinterpret_cast<const h16x4*>(vs + r32 * 136 + koff + 16);
          const h16x8 af = __builtin_shufflevector(lo, hh, 0, 1, 2, 3, 4, 5, 6, 7);
          o0 = __builtin_amdgcn_mfma_f32_32x32x16_f16(af, pf, o0, 0, 0, 0);
        }
        {
          const h16x4 lo = *reinterpret_cast<const h16x4*>(vs + (32 + r32) * 136 + koff), hh = *reinterpret_cast<const h16x4*>(vs + (32 + r32) * 136 + koff + 16);
          const h16x8 af = __builtin_shufflevector(lo, hh, 0, 1, 2, 3, 4, 5, 6, 7);
          o1 = __builtin_amdgcn_mfma_f32_32x32x16_f16(af, pf, o1, 0, 0, 0);
        }
      }
    if (j + 1 < ntiles) swrite((j + 1) & 1);
    __syncthreads();
  }
  const float lt = l_run + __shfl_xor(l_run, 32);
  const float inv = 1.f / lt;
  {
    h16* Os = reinterpret_cast<h16*>(smem);
    h16* orow = Os + (wid * 32 + r32) * 72;
#pragma unroll
    for (int g = 0; g < 4; ++g) {
      h16x4 a, c;
#pragma unroll
      for (int e = 0; e < 4; ++e) { a[e] = (h16)(o0[4 * g + e] * inv); c[e] = (h16)(o1[4 * g + e] * inv); }
      *reinterpret_cast<h16x4*>(orow + 8 * g + 4 * hi) = a;
      *reinterpret_cast<h16x4*>(orow + 32 + 8 * g + 4 * hi) = c;
    }
    __syncthreads();
    const int b = bh >> 3, hd = bh & 7;
    const long tok0 = q0 < SEQ ? (long)b * SEQ + q0 : (long)TLAT + b * CTXL + (q0 - SEQ);
    h16* yb = reinterpret_cast<h16*>(P.ws + OFF_YMLA) + tok0 * 512 + hd * 64;
#pragma unroll
    for (int it = 0; it < 4; ++it) {
      const int chunk = it * 256 + tid, row = chunk >> 3, c8 = (chunk & 7) * 8;
      *reinterpret_cast<uint4*>(yb + (long)row * 512 + c8) = *reinterpret_cast<const uint4*>(Os + row * 72 + c8);
    }
    __syncthreads();
  }
}
DI void item_s5_pass3(const Params& P, int layer, int b, int g, int ck, char* smem) {
  const int lane = tidx() & 63, wid = tidx() >> 6, fr = lane & 15, fq = lane >> 4;
  float* us = reinterpret_cast<float*>(smem + wid * 12800); char* Hs = smem + wid * 12800 + 4096;
  const int tokbase = ck < 4 ? TLAT + b * CTXL + ck * 64 : b * SEQ + (ck - 4) * 64;
  s5_stage_u(reinterpret_cast<const h16*>(P.ws + OFF_U), tokbase, g, us);
  __syncthreads();
  f32x4 yacc[4];
#pragma unroll
  for (int i = 0; i < 4; ++i) yacc[i] = f32x4{0.f, 0.f, 0.f, 0.f};
#pragma unroll
  for (int dir = 0; dir < 2; ++dir) {
    const long gi = (long)(layer * 2 + dir) * 24 + g;
    const float2 a = reinterpret_cast<const float2*>(P.ws + OFF_S5A)[gi * 64 + lane];
    const float2 a64 = reinterpret_cast<const float2*>(P.ws + OFF_S5A64)[gi * 64 + lane];
    const float2* Bb = reinterpret_cast<const float2*>(P.ws + OFF_S5B) + (gi * 64 + lane) * 16;
    float bre[16], bim[16];
#pragma unroll
    for (int c = 0; c < 16; ++c) { const float2 v = Bb[c]; bre[c] = v.x; bim[c] = v.y; }
    const int si = ck < 4 ? (dir ? 3 - ck : ck) : 4 + (dir ? 127 - (ck - 4) : ck - 4);
    const float2* Ep = reinterpret_cast<const float2*>(P.ws + OFF_E) + ((long)((b * 2 + dir) * 24 + g) * 132) * 64 + lane;
    float hr = 0.f, hi = 0.f;
#pragma unroll 16
    for (int i = 0; i < si; ++i) { const float2 e = Ep[(long)i * 64]; const float nr = a64.x * hr - a64.y * hi + e.x, ni = a64.x * hi + a64.y * hr + e.y; hr = nr; hi = ni; }
    const h16* Ct = reinterpret_cast<const h16*>(P.ws + OFF_S5C) + gi * 16 * 128 + fr * 128 + fq * 8;
    h16x8 cf[4];
#pragma unroll
    for (int ks = 0; ks < 4; ++ks) cf[ks] = *reinterpret_cast<const h16x8*>(Ct + ks * 32);
#pragma unroll
    for (int half = 0; half < 2; ++half) {
#pragma unroll 4
      for (int s = 0; s < 32; ++s) {
        const int step = half * 32 + s; const int tau = dir ? 63 - step : step;
        const float4* up = reinterpret_cast<const float4*>(us + tau * 16);
        float br = 0.f, bi = 0.f;
#pragma unroll
        for (int q = 0; q < 4; ++q) { const float4 u = up[q];
          br += bre[q * 4] * u.x + bre[q * 4 + 1] * u.y + bre[q * 4 + 2] * u.z + bre[q * 4 + 3] * u.w;
          bi += bim[q * 4] * u.x + bim[q * 4 + 1] * u.y + bim[q * 4 + 2] * u.z + bim[q * 4 + 3] * u.w; }
        const float nr = a.x * hr - a.y * hi + br, ni = a.x * hi + a.y * hr + bi; hr = nr; hi = ni;
        h16* hrow = reinterpret_cast<h16*>(Hs + (tau & 31) * 272);
        hrow[lane] = (h16)hr; hrow[64 + lane] = (h16)hi;
      }
      __syncthreads();
      const int tb = dir ? 1 - half : half;
#pragma unroll
      for (int sb2 = 0; sb2 < 2; ++sb2)
#pragma unroll
        for (int ks = 0; ks < 4; ++ks) {
          const h16x8 bf = *reinterpret_cast<const h16x8*>(Hs + (sb2 * 16 + fr) * 272 + (ks * 32 + fq * 8) * 2);
          yacc[tb * 2 + sb2] = __builtin_amdgcn_mfma_f32_16x16x32_f16(cf[ks], bf, yacc[tb * 2 + sb2], 0, 0, 0);
        }
      __syncthreads();
    }
  }
  const float* dsk = P.in[I_S5D] + layer * 384 + g * 16 + fq * 4;
  h16* Y = reinterpret_cast<h16*>(P.ws + OFF_YS5PRE);
#pragma unroll
  for (int sbi = 0; sbi < 4; ++sbi) {
    const int tl = sbi * 16 + fr; h16x4 o;
#pragma unroll
    for (int j = 0; j < 4; ++j) o[j] = (h16)geluf_(yacc[sbi][j] + dsk[j] * us[tl * 16 + fq * 4 + j]);
    *reinterpret_cast<h16x4*>(Y + (long)(tokbase + tl) * 384 + g * 16 + fq * 4) = o;
  }
  __syncthreads();
}
DI void phase_mix2(const Params& P, int layer, char* smem) {
  if ((gridDim.x & 7) == 0) {
    const int xcd = blockIdx.x & 7, li = blockIdx.x >> 3, nloc = gridDim.x >> 3;
    for (int k = li; k < 512; k += nloc) item_attn(P, xcd + 8 * (k >> 6), (k & 63) * 128, 0, KEYS / 64, smem);
  } else {
    for (int k = blockIdx.x; k < 4096; k += gridDim.x) item_attn(P, k >> 6, (k & 63) * 128, 0, KEYS / 64, smem);
  }
  const int n_actx = layer == 0 ? 128 : 0;
  const int nck = layer == 0 ? 132 : 128;
  const int n_s5 = NBATCH * 24 * nck / 4;
  for (int it = blockIdx.x; it < n_actx + n_s5; it += gridDim.x) {
    if (it < n_actx) { item_attn(P, it >> 1, SEQ + (it & 1) * 128, SEQ, CTXL / 64, smem); continue; }
    const int w = (it - n_actx) * 4 + (tidx() >> 6);
    const int ck = w % nck + (layer == 0 ? 0 : 4); const int r = w / nck;
    item_s5_pass3(P, layer, r / 24, r % 24, ck, smem);
  }
}
DI void item_yhy_transpose(const Params& P, int item, char* smem) {
  h16* T = reinterpret_cast<h16*>(smem);
  const int tid = tidx();
  const int tt = item & 127, ct = (item >> 7) % 6, b = item / (128 * 6);
  const h16* src = reinterpret_cast<const h16*>(P.ws + OFF_PHY) + ((long)b * 1152 + ct * 64) * SEQ + tt * 64;
  h16* dst = reinterpret_cast<h16*>(P.ws + OFF_YHY) + ((long)b * SEQ + tt * 64) * 384 + ct * 64;
#pragma unroll
  for (int i = 0; i < 2; ++i) {
    const int chunk = tid + 256 * i, cr = chunk >> 3, tp = (chunk & 7) * 8;
    const h16x8 v = *reinterpret_cast<const h16x8*>(src + (long)cr * SEQ + tp);
#pragma unroll
    for (int e = 0; e < 8; ++e) T[cr * 66 + tp + e] = v[e];
  }
  __syncthreads();
#pragma unroll
  for (int i = 0; i < 2; ++i) {
    const int chunk = tid + 256 * i, tr = chunk >> 3, cp = (chunk & 7) * 8;
    h16x8 o;
#pragma unroll
    for (int e = 0; e < 8; ++e) o[e] = T[(cp + e) * 66 + tr];
    *reinterpret_cast<h16x8*>(dst + (long)tr * 384 + cp) = o;
  }
  __syncthreads();
}
DI void phase_glu(const Params& P, int layer, char* smem) {
  const int tid = tidx(), lane = tid & 63, wid = tid >> 6, wr = wid >> 1, wc = wid & 1, fr = lane & 15, fq = lane >> 4;
  const h16* A = reinterpret_cast<const h16*>(P.ws + OFF_YS5PRE);
  const h16* W = reinterpret_cast<const h16*>(P.ws + OFF_WT) + (long)layer * WT_LAYER + WT_GLU;
  h16* Y = reinterpret_cast<h16*>(P.ws + OFF_YS5);
#pragma unroll 1
  for (int it = blockIdx.x; it < NBATCH * 6 * 128; it += gridDim.x) item_yhy_transpose(P, it, smem);
  asm volatile("" ::: "memory");
  const int MT = (layer == 0 ? TT : TLAT) / 128;
  const TileWalk tw = tw_init(MT, 6);
  for (int tile = tw.lb; tile < tw_count(tw); tile += tw.nlb) {
    int mt, nt; tw_decode(tw, tile, mt, nt);
    f32x4 acc[4][4]; acc_zero(acc);
    gemm_kloop(acc, A + (long)mt * 128 * 384, 384, 0, 128, W + (long)nt * 128 * 384, 384, 384, smem, opaque_tid());
    {
      float* Zs = reinterpret_cast<float*>(smem);
#pragma unroll
      for (int m = 0; m < 4; ++m)
#pragma unroll
        for (int np = 0; np < 2; ++np)
#pragma unroll
          for (int j = 0; j < 4; ++j)
            Zs[(wr * 64 + m * 16 + fq * 4 + j) * 132 + wc * 32 + np * 16 + fr] = acc[m][2 * np][j] * sigmoidf_(acc[m][2 * np + 1][j]);
      __syncthreads();
      const int t2 = tidx();
#pragma unroll
      for (int it = 0; it < 4; ++it) {
        const int chunk = it * 256 + t2, row = chunk >> 3, c8 = (chunk & 7) * 8;
        const float4 x0 = *reinterpret_cast<const float4*>(Zs + row * 132 + c8), x1 = *reinterpret_cast<const float4*>(Zs + row * 132 + c8 + 4);
        h16x8 o; o[0] = (h16)x0.x; o[1] = (h16)x0.y; o[2] = (h16)x0.z; o[3] = (h16)x0.w; o[4] = (h16)x1.x; o[5] = (h16)x1.y; o[6] = (h16)x1.z; o[7] = (h16)x1.w;
        *reinterpret_cast<h16x8*>(Y + (long)(mt * 128 + row) * 384 + nt * 64 + c8) = o;
      }
      __syncthreads();
    }
  }
}
DI void phase_merge(const Params& P, int layer, char* smem) {
  const h16* H = reinterpret_cast<const h16*>(P.ws + OFF_H1);
  const h16* WL = reinterpret_cast<const h16*>(P.ws + OFF_WT) + (long)layer * WT_LAYER;
  h16* Mg = reinterpret_cast<h16*>(P.ws + OFF_MERGED);
  const int MT = (layer == 0 ? TT : TLAT) / 128;
  const TileWalk tw = tw_init(MT, 8);
  for (int tile = tw.lb; tile < tw_count(tw); tile += tw.nlb) {
    int mt, nt; tw_decode(tw, tile, mt, nt);
    h16* Tmp = reinterpret_cast<h16*>(P.ws + OFF_YS5PRE) + (long)blockIdx.x * 32768;
    h16* Run = Tmp + 16384;
#pragma unroll 1
    for (int br = 0; br < 3; ++br) {
      const h16* Ab; const h16* Wb; int Kb;
      if (br == 0) { Ab = reinterpret_cast<const h16*>(P.ws + OFF_YHY) + (long)mt * 128 * 384; Wb = WL + WT_BRHY + (long)nt * 128 * 384; Kb = 384; }
      else if (br == 1) { Ab = reinterpret_cast<const h16*>(P.ws + OFF_YS5) + (long)mt * 128 * 384; Wb = WL + WT_BRS5 + (long)nt * 128 * 384; Kb = 384; }
      else { Ab = reinterpret_cast<const h16*>(P.ws + OFF_YMLA) + (long)mt * 128 * 512; Wb = WL + WT_BRMLA + (long)nt * 128 * 512; Kb = 512; }
      {
        f32x4 acc[4][4]; acc_zero(acc);
        gemm_kloop(acc, Ab, Kb, 0, 128, Wb, Kb, Kb, smem, opaque_tid());
        const int tid = tidx();
#pragma unroll
        for (int m = 0; m < 4; ++m)
#pragma unroll
          for (int n = 0; n < 4; ++n) {
            h16x4 o; o[0] = (h16)acc[m][n][0]; o[1] = (h16)acc[m][n][1]; o[2] = (h16)acc[m][n][2]; o[3] = (h16)acc[m][n][3];
            *reinterpret_cast<h16x4*>(Tmp + ((m * 4 + n) * 256 + tid) * 4) = o;
          }
      }
      f32x4 acc[4][4]; acc_zero(acc);
      gemm_kloop(acc, H + (long)mt * 128 * LD1, LD1, 0, 128, WL + WT_WGATE + (long)(br * 1024 + nt * 128) * LD1, LD1, 1024, smem, opaque_tid());
      const int tid = tidx();
      h16x4 bv[16], rv[16];
#pragma unroll
      for (int q = 0; q < 16; ++q) bv[q] = *reinterpret_cast<const h16x4*>(Tmp + (q * 256 + tid) * 4);
      if (br > 0) {
#pragma unroll
        for (int q = 0; q < 16; ++q) rv[q] = *reinterpret_cast<const h16x4*>(Run + (q * 256 + tid) * 4);
      } else {
#pragma unroll
        for (int q = 0; q < 16; ++q) rv[q] = h16x4{(h16)0.f, (h16)0.f, (h16)0.f, (h16)0.f};
      }
#pragma unroll
      for (int m = 0; m < 4; ++m)
#pragma unroll
        for (int n = 0; n < 4; ++n)
#pragma unroll
          for (int j = 0; j < 4; ++j) acc[m][n][j] = (float)rv[m * 4 + n][j] + sigmoidf_(acc[m][n][j]) * (float)bv[m * 4 + n][j];
      if (br < 2) {
#pragma unroll
        for (int m = 0; m < 4; ++m)
#pragma unroll
          for (int n = 0; n < 4; ++n) {
            h16x4 o; o[0] = (h16)acc[m][n][0]; o[1] = (h16)acc[m][n][1]; o[2] = (h16)acc[m][n][2]; o[3] = (h16)acc[m][n][3];
            *reinterpret_cast<h16x4*>(Run + ((m * 4 + n) * 256 + tid) * 4) = o;
          }
      } else {
        float* Zs = reinterpret_cast<float*>(smem);
        stage_acc(acc, Zs, tid);
        copy_out_f16(Zs, Mg, (long)mt * 128, LD1, nt * 128, tid);
        __syncthreads();
      }
    }
  }
}
DI void phase_resid(const Params& P, int layer, int stage_src, size_t a_off, int K, long w_off, int gate_idx, char* smem) {
  const int tid = tidx(), lane = tid & 63, wid = tid >> 6, wr = wid >> 1, wc = wid & 1, fr = lane & 15, fq = lane >> 4;
  const h16* A = reinterpret_cast<const h16*>(P.ws + a_off);
  const h16* W = reinterpret_cast<const h16*>(P.ws + OFF_WT) + (long)layer * WT_LAYER + w_off;
  const float* mod = reinterpret_cast<const float*>(P.ws + OFF_MOD) + (long)layer * 9 * 6144 + gate_idx * 1024;
  const int MT = (layer == 0 ? TT : TLAT) / 128;
  const TileWalk tw = tw_init(MT, 8);
  for (int tile = tw.lb; tile < tw_count(tw); tile += tw.nlb) {
    int mt, nt; tw_decode(tw, tile, mt, nt);
    f32x4 acc[4][4]; acc_zero(acc);
    const int ld = K == 1024 ? LD1 : LD2;
    gemm_kloop(acc, A + (long)mt * 128 * ld, ld, 0, 128, W + (long)nt * 128 * ld, ld, K, smem, opaque_tid());
    const Tok tk = tokinfo(mt * 128);
    float* Zs = reinterpret_cast<float*>(smem);
    const int t2 = tidx();
    stage_acc(acc, Zs, t2);
    const int c4 = (t2 & 31) * 4;
    const float4 g4 = *reinterpret_cast<const float4*>(mod + tk.mrow * 6144 + nt * 128 + c4);
#pragma unroll 4
    for (int it = 0; it < 16; ++it) {
      const int row = it * 8 + (t2 >> 5); const int t = mt * 128 + row;
      const float4 a4 = *reinterpret_cast<const float4*>(Zs + row * 132 + c4);
      const float4 x4 = *reinterpret_cast<const float4*>(xrow_src(P, stage_src, t) + nt * 128 + c4);
      *reinterpret_cast<float4*>(xrow_dst(P, t) + nt * 128 + c4) = make_float4(x4.x + g4.x * a4.x, x4.y + g4.y * a4.y, x4.z + g4.z * a4.z, x4.w + g4.w * a4.w);
    }
    __syncthreads();
  }
}
DI void phase_ffn_up(const Params& P, int layer, char* smem) {
  const int tid = tidx(), lane = tid & 63, wid = tid >> 6, wr = wid >> 1, wc = wid & 1, fr = lane & 15, fq = lane >> 4;
  const h16* H = reinterpret_cast<const h16*>(P.ws + OFF_H2);
  const h16* W = reinterpret_cast<const h16*>(P.ws + OFF_WT) + (long)layer * WT_LAYER + WT_UP;
  h16* F = reinterpret_cast<h16*>(P.ws + OFF_F);
  const float* cw = P.in[I_FCW] + (long)layer * 3 * 5632; const float* cb = P.in[I_FCB] + (long)layer * 5632;
  float* Zs = reinterpret_cast<float*>(smem);
  const int n_mt = 8 * 66 + (layer == 0 ? 8 * 3 : 0);
  const TileWalk tw = tw_init(n_mt, 44);
  for (int tile = tw.lb; tile < tw_count(tw); tile += tw.nlb) {
    int mi, nt; tw_decode(tw, tile, mi, nt);
    int seq0, Ls, ti;
    if (mi < 528) { seq0 = (mi / 66) * SEQ; Ls = SEQ; ti = mi % 66; } else { const int u = mi - 528; seq0 = TLAT + (u / 3) * CTXL; Ls = CTXL; ti = u % 3; }
    const int p0 = ti * 126 - 1;
    const int a_lo = ti == 0 ? 1 : 0, a_hi = min(128, Ls - p0);
    const int nout = min(126, Ls - ti * 126);
    f32x4 acc[4][4]; acc_zero(acc);
    gemm_kloop(acc, H + ((long)seq0 + p0) * LD1, LD1, a_lo, a_hi, W + (long)nt * 128 * LD1, LD1, 1024, smem, opaque_tid());
#pragma unroll
    for (int m = 0; m < 4; ++m)
#pragma unroll
      for (int n = 0; n < 4; ++n)
#pragma unroll
        for (int j = 0; j < 4; ++j)
          Zs[(wr * 64 + m * 16 + fq * 4 + j) * 132 + 2 * (wc * 32 + (n >> 1) * 16 + fr) + (n & 1)] = acc[m][n][j];
    __syncthreads();
    {
      const int jc = tid & 63, rg = tid >> 6;
      const float2* Z2 = reinterpret_cast<const float2*>(Zs);
      const int cu = nt * 64 + jc, cg = 2816 + cu;
      const float wu0 = cw[cu], wu1 = cw[5632 + cu], wu2 = cw[2 * 5632 + cu], bu = cb[cu];
      const float wg0 = cw[cg], wg1 = cw[5632 + cg], wg2 = cw[2 * 5632 + cg], bg = cb[cg];
      const int r0 = rg * 32 + 1, r1 = min(r0 + 31, nout);
      float2 zm = Z2[(r0 - 1) * 66 + jc], z0 = Z2[r0 * 66 + jc];
      h16* fp = F + ((long)seq0 + p0 + r0) * LD2 + cu;
#pragma unroll 4
      for (int r = r0; r <= r1; ++r) {
        const float2 zp = Z2[(r + 1) * 66 + jc];
        const float au = wu0 * zm.x + wu1 * z0.x + wu2 * zp.x + bu;
        const float ag = wg0 * zm.y + wg1 * z0.y + wg2 * zp.y + bg;
        *fp = (h16)(siluf_(au) * ag); fp += LD2;
        zm = z0; z0 = zp;
      }
    }
    __syncthreads();
  }
}
DI void phase_norm2(const Params& P, int layer) { normmod_rows(P, layer, 1, 1, layer == 0 ? TT : TLAT, blockIdx.x, gridDim.x); }

constexpr int N_PHASES = 22;
#ifndef PROBE_REPEAT
#define PROBE_REPEAT 0u
#endif
template <int PH> DI void run_phase_t(const Params& P, char* smem) {
  asm volatile("" ::: "memory");
  if constexpr (PH == 0) phase_prologue(P, smem);
  else if constexpr (PH == 21) phase_final(P);
  else {
    constexpr int layer = (PH - 1) / 10, s = (PH - 1) % 10;
    if constexpr (s == 0) phase_norm1(P, layer, smem);
    else if constexpr (s == 1) phase_gemm_in(P, layer, smem);
    else if constexpr (s == 2) phase_mix1(P, layer, smem);
    else if constexpr (s == 3) phase_mix2(P, layer, smem);
    else if constexpr (s == 4) phase_glu(P, layer, smem);
    else if constexpr (s == 5) phase_merge(P, layer, smem);
    else if constexpr (s == 6) phase_resid(P, layer, layer, OFF_MERGED, 1024, WT_WO, 2, smem);
    else if constexpr (s == 7) phase_norm2(P, layer);
    else if constexpr (s == 8) phase_ffn_up(P, layer, smem);
    else phase_resid(P, layer, 1, OFF_F, 2816, WT_DOWN, 5, smem);
  }
}
DI void run_phase(const Params& P, int ph, char* smem) {
  switch (ph) {
#define RP(i) case i: run_phase_t<i>(P, smem); break;
    RP(0) RP(1) RP(2) RP(3) RP(4) RP(5) RP(6) RP(7) RP(8) RP(9) RP(10) RP(11) RP(12) RP(13) RP(14) RP(15) RP(16) RP(17) RP(18) RP(19) RP(20) RP(21)
#undef RP
    default: break;
  }
}
#ifndef MULTI_LAUNCH
#define MULTI_LAUNCH 0
#endif
#define XB_TMO      128
#define XB_XCNT(j)  (256  + 64 * (j))
#define XB_XSUB(j)  (1280 + 64 * (j))
#define XB_XGEN(j)  (2304 + 64 * (j))
#define XB_TOP      3328
#define XB_TOPGEN   3392
#define XCD_BAR_WORDS 3456
#define XB_SPIN_CAP (1u << 22)
#define LAS __attribute__((address_space(3)))
DI unsigned xb_ld(unsigned* p)              { return __hip_atomic_load(p, __ATOMIC_RELAXED, __HIP_MEMORY_SCOPE_AGENT); }
DI unsigned xb_add(unsigned* p, unsigned v) { return __hip_atomic_fetch_add(p, v, __ATOMIC_RELAXED, __HIP_MEMORY_SCOPE_AGENT); }
DI unsigned xb_xcc_id() { return (unsigned)__builtin_amdgcn_s_getreg((3 << 11) | 20) & 0xFu; }
#define XB_SPIN(cond, bar) do { unsigned _sp = 0; while (cond) { __builtin_amdgcn_s_sleep(1); \
    if ((++_sp & 255u) == 0u) { if (xb_ld(&(bar)[XB_TMO])) break; if (_sp > XB_SPIN_CAP) { atomicAdd(&(bar)[XB_TMO], 1u); break; } } } } while (0)
struct XcdBarrier { unsigned* bar; unsigned x; volatile LAS unsigned* st; };
DI XcdBarrier xcd_barrier_post(unsigned* bar, volatile LAS unsigned* st) {
  XcdBarrier b; b.bar = bar; b.x = xb_xcc_id(); b.st = st;
  if (threadIdx.x == 0) (void)xb_add(&bar[XB_XCNT(b.x)], 1u);
  return b;
}
DI void xcd_barrier_complete(unsigned* bar, unsigned x, unsigned& nloc, unsigned& nx) {
  const unsigned G = gridDim.x * gridDim.y * gridDim.z;
  unsigned sum, cnt, mine, sp = 0u;
  for (;;) {
    sum = 0u; cnt = 0u; mine = 0u;
#pragma unroll
    for (unsigned j = 0; j < 16; ++j) { const unsigned c = xb_ld(&bar[XB_XCNT(j)]); sum += c; cnt += (c > 0u) ? 1u : 0u; mine = (j == x) ? c : mine; }
    if (sum == G) break;
    __builtin_amdgcn_s_sleep(1);
    if ((++sp & 255u) == 0u) { if (xb_ld(&bar[XB_TMO])) break; if (sp > XB_SPIN_CAP) { atomicAdd(&bar[XB_TMO], 1u); break; } }
  }
  nloc = mine > 0u ? mine : 1u; nx = cnt > 0u ? cnt : 1u;
}
DI void xcd_barrier(const XcdBarrier& b) {
  asm volatile("s_waitcnt vmcnt(0)" ::: "memory");
  __syncthreads();
  if (threadIdx.x == 0) {
    unsigned* bar = b.bar;
    __builtin_amdgcn_s_waitcnt(0);
    unsigned nloc = b.st[0], nx = b.st[1];
    if (nloc == 0u) { xcd_barrier_complete(bar, b.x, nloc, nx); b.st[0] = nloc; b.st[1] = nx; }
    const unsigned old = xb_add(&bar[XB_XSUB(b.x)], 1u);
    const unsigned gen = old / nloc;
    if (old + 1u == (gen + 1u) * nloc) {
      __builtin_amdgcn_fence(__ATOMIC_RELEASE, "agent");
      asm volatile("s_waitcnt vmcnt(0)" ::: "memory");
      const unsigned og = xb_add(&bar[XB_TOP], 1u);
      const unsigned tg = og / nx;
      if (og + 1u == (tg + 1u) * nx) xb_add(&bar[XB_TOPGEN], 1u);
      else XB_SPIN(xb_ld(&bar[XB_TOPGEN]) == tg, bar);
      __builtin_amdgcn_fence(__ATOMIC_ACQUIRE, "agent");
      xb_add(&bar[XB_XGEN(b.x)], 1u);
      asm volatile("s_waitcnt vmcnt(0)" ::: "memory");
    } else {
      XB_SPIN(xb_ld(&bar[XB_XGEN(b.x)]) == gen, bar);
      __builtin_amdgcn_fence(__ATOMIC_ACQUIRE, "agent");
      asm volatile("s_waitcnt vmcnt(0)" ::: "memory");
    }
  }
  __syncthreads();
}
__global__ void __launch_bounds__(NTHREADS, 2) fwd_megakernel(Params P) {
  extern __shared__ __attribute__((aligned(16))) char smem[];
  cg::grid_group grid = cg::this_grid();
  volatile LAS unsigned* st = (volatile LAS unsigned*)(smem + SMEM_BYTES - 16);
  if (threadIdx.x == 0) { st[0] = 0u; st[1] = 0u; st[2] = 0u; st[3] = 0u; }
  __syncthreads();
  const XcdBarrier xb = xcd_barrier_post(reinterpret_cast<unsigned*>(P.ws + OFF_BAR), st);
  run_phase_t<0>(P, smem); grid.sync();
#define RP(i) run_phase_t<i>(P, smem); xcd_barrier(xb); if constexpr ((PROBE_REPEAT >> i) & 1) { run_phase_t<i>(P, smem); xcd_barrier(xb); }
  RP(1) RP(2) RP(3) RP(4) RP(5) RP(6) RP(7) RP(8) RP(9) RP(10) RP(11) RP(12) RP(13) RP(14) RP(15) RP(16) RP(17) RP(18) RP(19) RP(20)
#undef RP
#ifdef PROBE_SYNC
  for (int i = 0; i < PROBE_SYNC; ++i) xcd_barrier(xb);
#endif
  run_phase_t<21>(P, smem);
}
#if MULTI_LAUNCH
__global__ void __launch_bounds__(NTHREADS, 2) fwd_phase_kernel(Params P, int ph) {
  extern __shared__ __attribute__((aligned(16))) char smem[];
  run_phase(P, ph, smem);
}
#endif

extern "C" void kernel_launch(void* const* d_in, const int* in_sizes, int n_in, void* d_out, int out_size, void* d_ws, size_t ws_size,
                              hipStream_t stream) {
  static int grid_blocks = 0;
  if (!grid_blocks) {
    int dev = 0, cus = 0, per_cu = 0;
    (void)hipGetDevice(&dev);
    (void)hipDeviceGetAttribute(&cus, hipDeviceAttributeMultiprocessorCount, dev);
    (void)hipFuncSetAttribute((const void*)fwd_megakernel, hipFuncAttributeMaxDynamicSharedMemorySize, SMEM_BYTES);
#if MULTI_LAUNCH
    (void)hipFuncSetAttribute((const void*)fwd_phase_kernel, hipFuncAttributeMaxDynamicSharedMemorySize, SMEM_BYTES);
#endif
    (void)hipOccupancyMaxActiveBlocksPerMultiprocessor(&per_cu, fwd_megakernel, NTHREADS, SMEM_BYTES);
    if (per_cu > 2) per_cu = 2;
    if (per_cu < 1) per_cu = 1;
#ifdef PROBE_FORCE2
    per_cu = 2;
#endif
    grid_blocks = cus * per_cu;
    if (ws_size < OFF_END) fprintf(stderr, "workspace too small: %zu < %zu\n", ws_size, (size_t)OFF_END);
  }
  Params p{};
  for (int i = 0; i < 41; ++i) p.in[i] = (const float*)d_in[i];
  p.out = (float*)d_out; p.ws = (char*)d_ws; p.pad_ = 0;
#if MULTI_LAUNCH
  for (int ph = 0; ph < N_PHASES; ++ph) hipLaunchKernelGGL(fwd_phase_kernel, dim3(grid_blocks), dim3(NTHREADS), SMEM_BYTES, stream, p, ph);
#else
  (void)hipMemsetAsync((char*)d_ws + OFF_BAR, 0, XCD_BAR_WORDS * 4, stream);
  void* args[] = {&p};
  hipError_t e = hipLaunchCooperativeKernel((void*)fwd_megakernel, dim3(grid_blocks), dim3(NTHREADS), args, SMEM_BYTES, stream);
  if (e != hipSuccess) fprintf(stderr, "cooperative launch failed: %s (grid %d)\n", hipGetErrorString(e), grid_blocks);
#endif
}
```

```cpp
#include <hip/hip_runtime.h>
#include <hip/hip_cooperative_groups.h>
#include <cstdio>
namespace cg = cooperative_groups;

typedef _Float16 h16;
typedef _Float16 h16x8 __attribute__((ext_vector_type(8)));
typedef _Float16 h16x4 __attribute__((ext_vector_type(4)));
typedef float f32x4 __attribute__((ext_vector_type(4)));
typedef float f32x16 __attribute__((ext_vector_type(16)));
#define DI __device__ __forceinline__

constexpr int DM = 1024, NBATCH = 8, SEQ = 8192, CTXL = 256, TLAT = 65536, TCTX = 2048, TT = 67584;
constexpr int KEYS = SEQ + CTXL;
constexpr int NTHREADS = 256;
constexpr float EPS = 1e-6f;
constexpr float QSCALE = 0.10206207261596575f * 1.4426950408889634f;

constexpr int LD1 = 1088, LD2 = 2880;
constexpr long WT_WIN = 0, WT_WGATE = WT_WIN + 2432L * LD1, WT_UKV = WT_WGATE + 3072L * LD1, WT_UQ = WT_UKV + 1024L * 256,
               WT_GLU = WT_UQ + 1024L * 512, WT_BRHY = WT_GLU + 768L * 384, WT_BRS5 = WT_BRHY + 1024L * 384,
               WT_BRMLA = WT_BRS5 + 1024L * 384, WT_WO = WT_BRMLA + 1024L * 512, WT_UP = WT_WO + 1024L * LD1,
               WT_DOWN = WT_UP + 5632L * LD1, WT_LAYER = WT_DOWN + 1024L * LD2;
constexpr size_t al256(size_t x) { return (x + 255) / 256 * 256; }
constexpr size_t OFF_WT = 0;
constexpr size_t OFF_H1 = al256(OFF_WT + 2 * WT_LAYER * 2);
constexpr size_t OFF_U = al256(OFF_H1 + (size_t)TT * LD1 * 2);
constexpr size_t OFF_KVLAT = al256(OFF_U + (size_t)TT * 384 * 2);
constexpr size_t OFF_QLAT = al256(OFF_KVLAT + (size_t)TT * 256 * 2);
constexpr size_t OFF_PHY = al256(OFF_QLAT + (size_t)TT * 512 * 2);
constexpr size_t OFF_PHYC = al256(OFF_PHY + (size_t)NBATCH * 1152 * SEQ * 2);
constexpr size_t OFF_Q = al256(OFF_PHYC + (size_t)NBATCH * 1152 * CTXL * 2);
constexpr size_t OFF_K = al256(OFF_Q + (size_t)64 * KEYS * 96 * 2);
constexpr size_t OFF_VT = al256(OFF_K + (size_t)64 * KEYS * 96 * 2);
constexpr size_t OFF_YS5PRE = al256(OFF_VT + (size_t)64 * 64 * KEYS * 2);
constexpr size_t OFF_YHY = al256(OFF_YS5PRE + (size_t)TT * 384 * 2);
constexpr size_t OFF_FILT = al256(OFF_YHY + (size_t)TT * 384 * 2);
constexpr size_t OFF_TAPSC = al256(OFF_FILT + (size_t)768 * 2 * SEQ * 8);
constexpr size_t OFF_E = al256(OFF_TAPSC + (size_t)768 * 2 * CTXL * 4);
constexpr size_t OFF_XC = al256(OFF_E + (size_t)NBATCH * 2 * 24 * 132 * 64 * 8);
constexpr size_t OFF_MOD = al256(OFF_XC + (size_t)TCTX * 1024 * 4);
constexpr size_t OFF_Z2 = al256(OFF_MOD + (size_t)2 * 9 * 6144 * 4);
constexpr size_t OFF_Z2C = al256(OFF_Z2 + (size_t)2 * SEQ * 64 * 4);
constexpr size_t OFF_S5A = al256(OFF_Z2C + (size_t)2 * CTXL * 64 * 4);
constexpr size_t OFF_S5A64 = al256(OFF_S5A + (size_t)2 * 2 * 24 * 64 * 8);
constexpr size_t OFF_S5B = al256(OFF_S5A64 + (size_t)2 * 2 * 24 * 64 * 8);
constexpr size_t OFF_S5C = al256(OFF_S5B + (size_t)2 * 2 * 24 * 64 * 16 * 8);
constexpr size_t OFF_ROPE = al256(OFF_S5C + (size_t)2 * 2 * 24 * 16 * 128 * 2);
constexpr size_t OFF_BAR = al256(OFF_ROPE + (size_t)SEQ * 16 * 8);
constexpr size_t OFF_END = al256(OFF_BAR + (size_t)3456 * 4);
constexpr size_t OFF_YS5 = OFF_U, OFF_YMLA = OFF_QLAT, OFF_MERGED = OFF_Q, OFF_F = OFF_U, OFF_H2 = OFF_H1;
static_assert(OFF_END <= (size_t)1024 * 1024 * 1024, "workspace over 1 GiB");
static_assert(OFF_F + (size_t)TT * LD2 * 2 <= OFF_FILT, "f alias overruns");
static_assert(OFF_MERGED + (size_t)TT * LD1 * 2 <= OFF_VT, "merged alias overruns");

constexpr int SMEM_BYTES = 73728 + 2048;

struct Params {
  const float* in[41];
  float* out;
  char* ws;
  unsigned long long pad_;
};
enum { I_X = 0, I_C, I_CTX, I_CCTX, I_WMOD, I_BMOD, I_N1G, I_N2G, I_WIN, I_HCW, I_HCB, I_FW1, I_FB1, I_FW2, I_FB2, I_FW3, I_FFREQ,
       I_FDECAY, I_HBIAS, I_LAMRE, I_LAMIM, I_LOGSTEP, I_BRE, I_BIM, I_CRE, I_CIM, I_S5D, I_WGLU, I_GQ, I_WUQ, I_GKV, I_WUKV,
       I_WBRHY, I_WBRS5, I_WBRMLA, I_WO, I_WUP, I_FCW, I_FCB, I_WDOWN, I_FINALG };

DI int tidx() { int t = threadIdx.x; asm volatile("" : "+v"(t)); return t; }
DI int opaque_tid() { return tidx(); }
DI float sigmoidf_(float x) { return 1.f / (1.f + __expf(-x)); }
DI float siluf_(float x) { return x / (1.f + __expf(-x)); }
DI float geluf_(float x) { float z = 0.7978845608028654f * (x + 0.044715f * x * x * x); float t = 1.f - 2.f / (1.f + __expf(2.f * z)); return 0.5f * x * (1.f + t); }
DI float wave_sum(float v) { for (int o = 32; o > 0; o >>= 1) v += __shfl_xor(v, o); return v; }
DI float wave_max(float v) { for (int o = 32; o > 0; o >>= 1) v = fmaxf(v, __shfl_xor(v, o)); return v; }
DI void dsincos(double x, double& s, double& c) {
  const double TWO_PI = 6.283185307179586476925287;
  double r = x - TWO_PI * rint(x / TWO_PI);
  double r2 = r * r, ts = r, tc = 1.0; s = r; c = 1.0;
  for (int k = 1; k <= 15; ++k) { tc = -tc * r2 / (double)((2 * k - 1) * (2 * k)); c += tc; ts = -ts * r2 / (double)((2 * k) * (2 * k + 1)); s += ts; }
}
DI float2 twid(float f) { return make_float2(__builtin_amdgcn_cosf(f), __builtin_amdgcn_sinf(f)); }
DI float2 cmul(float2 a, float2 b) { return make_float2(a.x * b.x - a.y * b.y, a.x * b.y + a.y * b.x); }

struct Tok { int b, pos, ctx, mrow; };
DI Tok tokinfo(int t) { Tok k; if (t < TLAT) { k.b = t >> 13; k.pos = t & 8191; k.ctx = 0; k.mrow = k.b; } else { int u = t - TLAT; k.b = u >> 8; k.pos = u & 255; k.ctx = 1; k.mrow = 8; } return k; }

struct Stg { uint4 a0, a1, a2, a3, b0, b1, b2, b3; };
DI void g_load(Stg& s, const h16* __restrict__ A0, const h16* __restrict__ A1, const h16* __restrict__ A2, const h16* __restrict__ A3,
               const h16* __restrict__ Bp, long b32, int k0) {
  s.a0 = *reinterpret_cast<const uint4*>(A0 + k0); s.a1 = *reinterpret_cast<const uint4*>(A1 + k0);
  s.a2 = *reinterpret_cast<const uint4*>(A2 + k0); s.a3 = *reinterpret_cast<const uint4*>(A3 + k0);
  s.b0 = *reinterpret_cast<const uint4*>(Bp + k0); s.b1 = *reinterpret_cast<const uint4*>(Bp + b32 + k0);
  s.b2 = *reinterpret_cast<const uint4*>(Bp + 2 * b32 + k0); s.b3 = *reinterpret_cast<const uint4*>(Bp + 3 * b32 + k0);
}
DI uint4 zsel(uint4 v, bool ok) { return ok ? v : make_uint4(0, 0, 0, 0); }
DI void s_write(char* sw, const Stg& s, int okm) {
  *reinterpret_cast<uint4*>(sw) = zsel(s.a0, okm & 1); *reinterpret_cast<uint4*>(sw + 32 * 128) = zsel(s.a1, okm & 2);
  *reinterpret_cast<uint4*>(sw + 64 * 128) = zsel(s.a2, okm & 4); *reinterpret_cast<uint4*>(sw + 96 * 128) = zsel(s.a3, okm & 8);
  *reinterpret_cast<uint4*>(sw + 16384) = s.b0; *reinterpret_cast<uint4*>(sw + 16384 + 32 * 128) = s.b1; *reinterpret_cast<uint4*>(sw + 16384 + 64 * 128) = s.b2; *reinterpret_cast<uint4*>(sw + 16384 + 96 * 128) = s.b3;
}
#ifndef PROBE_MFMA
#define PROBE_MFMA 0
#endif
#if PROBE_MFMA
DI void mma_step(f32x4 (&acc)[4][4], const char* sa, const char* sb, int o0, int o1, f32x4 (&dmy)[2][4]) {
#else
DI void mma_step(f32x4 (&acc)[4][4], const char* sa, const char* sb, int o0, int o1) {
#endif
#pragma unroll
  for (int ks = 0; ks < 2; ++ks) {
    h16x8 af[4], bf[4];
    const int o = ks ? o1 : o0;
#pragma unroll
    for (int m = 0; m < 4; ++m) af[m] = *reinterpret_cast<const h16x8*>(sa + m * 16 * 128 + o);
#pragma unroll
    for (int n = 0; n < 4; ++n) bf[n] = *reinterpret_cast<const h16x8*>(sb + n * 16 * 128 + o);
#pragma unroll
    for (int m = 0; m < 4; ++m)
#pragma unroll
      for (int n = 0; n < 4; ++n) acc[m][n] = __builtin_amdgcn_mfma_f32_16x16x32_f16(af[m], bf[n], acc[m][n], 0, 0, 0);
#if PROBE_MFMA
#pragma unroll
    for (int m = 0; m < 2; ++m)
#pragma unroll
      for (int n = 0; n < 4; ++n) dmy[m][n] = __builtin_amdgcn_mfma_f32_16x16x32_f16(af[m + 2], bf[n], dmy[m][n], 0, 0, 0);
#endif
  }
}
DI void gemm_kloop_body(f32x4 (&acc)[4][4], const h16* __restrict__ A, long lda, int a_lo, int a_hi,
                   const h16* __restrict__ Bt, long ldb, int K, char* smem, int tid) {
  const int lane = tid & 63, wid = tid >> 6, wr = wid >> 1, wc = wid & 1, fr = lane & 15, fq = lane >> 4;
#if PROBE_MFMA
  f32x4 dmy[2][4];
  for (int m = 0; m < 2; ++m) for (int n = 0; n < 4; ++n) dmy[m][n] = f32x4{0.f, 0.f, 0.f, 0.f};
#define MMA(a, b, c, d, e) mma_step(a, b, c, d, e, dmy)
#else
#define MMA(a, b, c, d, e) mma_step(a, b, c, d, e)
#endif
  Stg s0, s1;
  const int srow = tid >> 3, skc = tid & 7;
  int okm = 0;
  const h16* Ar[4];
#pragma unroll
  for (int i = 0; i < 4; ++i) { const int row = srow + 32 * i; const bool ok = row >= a_lo && row < a_hi; okm |= ok ? (1 << i) : 0;
    const int rc = min(max(row, a_lo), a_hi - 1); Ar[i] = A + (long)rc * lda + skc * 8; }
  const h16* Bp = Bt + (long)srow * ldb + skc * 8;
  const long b32 = 32 * ldb;
  char* sw = smem + srow * 128 + ((skc ^ ((srow >> 1) & 7)) << 4);
  const char* sra = smem + (wr * 64 + fr) * 128; const char* srb = smem + 16384 + (wc * 64 + fr) * 128;
  const int o0 = (fq ^ ((fr >> 1) & 7)) << 4, o1 = ((4 + fq) ^ ((fr >> 1) & 7)) << 4;
  const int nk = K >> 6;
  g_load(s0, Ar[0], Ar[1], Ar[2], Ar[3], Bp, b32, 0); g_load(s1, Ar[0], Ar[1], Ar[2], Ar[3], Bp, b32, 64);
  s_write(sw, s0, okm); __syncthreads();
  for (int kt = 0; kt + 2 < nk; kt += 2) {
    g_load(s0, Ar[0], Ar[1], Ar[2], Ar[3], Bp, b32, (kt + 2) << 6);
    __builtin_amdgcn_sched_barrier(0);
    MMA(acc, sra, srb, o0, o1);
    __builtin_amdgcn_sched_barrier(0);
    s_write(sw + 32768, s1, okm);
    __syncthreads();
    g_load(s1, Ar[0], Ar[1], Ar[2], Ar[3], Bp, b32, (kt + 3) << 6);
    __builtin_amdgcn_sched_barrier(0);
    MMA(acc, sra + 32768, srb + 32768, o0, o1);
    __builtin_amdgcn_sched_barrier(0);
    s_write(sw, s0, okm);
    __syncthreads();
  }
  MMA(acc, sra, srb, o0, o1);
  s_write(sw + 32768, s1, okm);
  __syncthreads();
  MMA(acc, sra + 32768, srb + 32768, o0, o1);
  __syncthreads();
#if PROBE_MFMA
  { float z = 0.f; asm volatile("" : "+v"(z)); for (int m = 0; m < 2; ++m) for (int n = 0; n < 4; ++n) acc[m][n] += dmy[m][n] * z; }
#endif
#undef MMA
}
#ifndef PROBE_KLOOP
#define PROBE_KLOOP 0
#endif
DI void gemm_kloop(f32x4 (&acc)[4][4], const h16* __restrict__ A, long lda, int a_lo, int a_hi,
                   const h16* __restrict__ Bt, long ldb, int K, char* smem, int tid) {
  gemm_kloop_body(acc, A, lda, a_lo, a_hi, Bt, ldb, K, smem, tid);
}
struct TileWalk { int lb, nlb, m0, Mx, NT, nfull; };
DI TileWalk tw_init(int MT, int NT) { TileWalk w; w.lb = blockIdx.x >> 3; w.nlb = gridDim.x >> 3; w.Mx = MT >> 3; w.m0 = (blockIdx.x & 7) * w.Mx; w.NT = NT; w.nfull = (w.Mx >> 3) * 8 * NT; return w; }
DI int tw_count(const TileWalk& w) { return w.Mx * w.NT; }
DI void tw_decode(const TileWalk& w, int idx, int& mt, int& nt) {
  if (idx < w.nfull) { const int mg = idx / (8 * w.NT), r = idx % (8 * w.NT); nt = r >> 3; mt = w.m0 + mg * 8 + (r & 7); }
  else { const int rem = w.Mx & 7, r = idx - w.nfull; nt = r / rem; mt = w.m0 + (w.Mx & ~7) + r % rem; }
}
DI void stage_acc(const f32x4 (&acc)[4][4], float* Zs, int tid) {
  const int lane = tid & 63, wid = tid >> 6, wr = wid >> 1, wc = wid & 1, fr = lane & 15, fq = lane >> 4;
#pragma unroll
  for (int m = 0; m < 4; ++m)
#pragma unroll
    for (int n = 0; n < 4; ++n)
#pragma unroll
      for (int j = 0; j < 4; ++j) Zs[(wr * 64 + m * 16 + fq * 4 + j) * 132 + wc * 64 + n * 16 + fr] = acc[m][n][j];
  __syncthreads();
}
DI void stage_acc_t(const f32x4 (&acc)[4][4], float* Zs, int tid) {
  const int lane = tid & 63, wid = tid >> 6, wr = wid >> 1, wc = wid & 1, fr = lane & 15, fq = lane >> 4;
#pragma unroll
  for (int m = 0; m < 4; ++m)
#pragma unroll
    for (int n = 0; n < 4; ++n)
      *reinterpret_cast<float4*>(Zs + (wc * 64 + n * 16 + fr) * 132 + wr * 64 + m * 16 + fq * 4) = make_float4(acc[m][n][0], acc[m][n][1], acc[m][n][2], acc[m][n][3]);
  __syncthreads();
}
DI void copy_out_f16(const float* Zs, h16* __restrict__ dst, long row0, long ld, int cb, int tid) {
#pragma unroll
  for (int it = 0; it < 8; ++it) {
    const int chunk = it * 256 + tid, row = chunk >> 4, c8 = (chunk & 15) * 8;
    const float4 x0 = *reinterpret_cast<const float4*>(Zs + row * 132 + c8), x1 = *reinterpret_cast<const float4*>(Zs + row * 132 + c8 + 4);
    h16x8 o; o[0] = (h16)x0.x; o[1] = (h16)x0.y; o[2] = (h16)x0.z; o[3] = (h16)x0.w; o[4] = (h16)x1.x; o[5] = (h16)x1.y; o[6] = (h16)x1.z; o[7] = (h16)x1.w;
    *reinterpret_cast<h16x8*>(dst + (row0 + row) * ld + cb + c8) = o;
  }
}
DI void acc_zero(f32x4 (&acc)[4][4]) {
#pragma unroll
  for (int m = 0; m < 4; ++m)
#pragma unroll
    for (int n = 0; n < 4; ++n) acc[m][n] = f32x4{0.f, 0.f, 0.f, 0.f};
}
DI void row_rms(const h16* __restrict__ A, long lda, int K, float* rs) {
  const int tid = tidx(), row = tid >> 1, half = tid & 1;
  const h16* p = A + (long)row * lda + half * (K >> 1);
  float ss = 0.f;
  for (int k = 0; k < (K >> 1); k += 8) {
    h16x8 v = *reinterpret_cast<const h16x8*>(p + k);
#pragma unroll
    for (int j = 0; j < 8; ++j) { float f = (float)v[j]; ss += f * f; }
  }
  ss += __shfl_xor(ss, 1);
  if (half == 0) rs[row] = rsqrtf(ss / (float)K + EPS);
}
DI int map_interleave(int n, int half) { int tile = n >> 7, r = n & 127, sub = r >> 4, fr = r & 15; int j = tile * 64 + (sub >> 1) * 16 + fr; return (sub & 1) ? half + j : j; }
DI int map_col(int mat, int n) {
  switch (mat) {
    case 0: if (n < 640) return n; if (n < 2304) return n + 32; if (n < 2336) return n - 2304 + 640; return -1;
    case 1: return 2336 + n;
    case 3: { int h = n >> 7, j = n & 127; return j < 96 ? h * 96 + j : -1; }
    case 4: return map_interleave(n, 384);
    case 9: return map_interleave(n, 2816);
    default: return n;
  }
}
struct MatDesc { const float* src; const float* scale; long dst; int K, Nmy, Nsrc, ld; };
DI MatDesc get_mat(const Params& P, int layer, int mat) {
  MatDesc d; d.scale = nullptr;
  d.ld = (mat == 0 || mat == 1 || mat == 8 || mat == 9) ? LD1 : 0;
  switch (mat) {
    case 0: d.src = P.in[I_WIN] + (long)layer * 1024 * 5408; d.dst = WT_WIN; d.K = 1024; d.Nmy = 2432; d.Nsrc = 5408; break;
    case 1: d.src = P.in[I_WIN] + (long)layer * 1024 * 5408; d.dst = WT_WGATE; d.K = 1024; d.Nmy = 3072; d.Nsrc = 5408; break;
    case 2: d.src = P.in[I_WUKV] + (long)layer * 256 * 1024; d.dst = WT_UKV; d.K = 256; d.Nmy = 1024; d.Nsrc = 1024; d.scale = P.in[I_GKV] + layer * 256; break;
    case 3: d.src = P.in[I_WUQ] + (long)layer * 512 * 768; d.dst = WT_UQ; d.K = 512; d.Nmy = 1024; d.Nsrc = 768; d.scale = P.in[I_GQ] + layer * 512; break;
    case 4: d.src = P.in[I_WGLU] + (long)layer * 384 * 768; d.dst = WT_GLU; d.K = 384; d.Nmy = 768; d.Nsrc = 768; break;
    case 5: d.src = P.in[I_WBRHY] + (long)layer * 384 * 1024; d.dst = WT_BRHY; d.K = 384; d.Nmy = 1024; d.Nsrc = 1024; break;
    case 6: d.src = P.in[I_WBRS5] + (long)layer * 384 * 1024; d.dst = WT_BRS5; d.K = 384; d.Nmy = 1024; d.Nsrc = 1024; break;
    case 7: d.src = P.in[I_WBRMLA] + (long)layer * 512 * 1024; d.dst = WT_BRMLA; d.K = 512; d.Nmy = 1024; d.Nsrc = 1024; break;
    case 8: d.src = P.in[I_WO] + (long)layer * 1024 * 1024; d.dst = WT_WO; d.K = 1024; d.Nmy = 1024; d.Nsrc = 1024; break;
    case 9: d.src = P.in[I_WUP] + (long)layer * 1024 * 5632; d.dst = WT_UP; d.K = 1024; d.Nmy = 5632; d.Nsrc = 5632; break;
    default: d.src = P.in[I_WDOWN] + (long)layer * 2816 * 1024; d.dst = WT_DOWN; d.K = 2816; d.Nmy = 1024; d.Nsrc = 1024; d.ld = LD2; break;
  }
  if (d.ld == 0) d.ld = d.K;
  return d;
}
constexpr int WT_TILES_PER_LAYER = 608 + 768 + 64 + 128 + 72 + 96 + 96 + 128 + 256 + 1408 + 704;
DI void item_wt(const Params& P, int item, char* smem) {
  const int layer = item / WT_TILES_PER_LAYER; int r = item % WT_TILES_PER_LAYER;
  const int cnt[11] = {608, 768, 64, 128, 72, 96, 96, 128, 256, 1408, 704};
  int mat = 0;
#pragma unroll
  for (int i = 0; i < 10; ++i) { if (mat == i && r >= cnt[i]) { r -= cnt[i]; mat = i + 1; } }
  MatDesc d = get_mat(P, layer, mat);
  const int kt = d.K >> 6, n0 = (r / kt) * 64, k0 = (r % kt) * 64;
  float* tile = reinterpret_cast<float*>(smem);
  h16* dst = reinterpret_cast<h16*>(P.ws + OFF_WT) + (long)layer * WT_LAYER + d.dst;
  const int tid = tidx(), lx = tid & 63, ly = tid >> 6;
  const int sc = map_col(mat, n0 + lx);
#pragma unroll 4
  for (int i = 0; i < 16; ++i) { int kk = i * 4 + ly; tile[kk * 65 + lx] = sc >= 0 ? d.src[(long)(k0 + kk) * d.Nsrc + sc] : 0.f; }
  __syncthreads();
  const float s = d.scale ? d.scale[k0 + lx] : 1.f;
#pragma unroll 4
  for (int i = 0; i < 16; ++i) { int nn = i * 4 + ly; dst[(long)(n0 + nn) * d.ld + k0 + lx] = (h16)(tile[lx * 65 + nn] * s); }
  __syncthreads();
}
DI void item_mod(const Params& P, int item, char* smem) {
  const int layer = item / 96, n0 = (item % 96) * 64;
  float* s = reinterpret_cast<float*>(smem);
  float* part = s + 9 * 1024;
  const int tid = tidx(), lane = tid & 63, wid = tid >> 6;
  for (int i = tid; i < 9 * 1024; i += NTHREADS) { float v = i < 8192 ? P.in[I_C][i] : P.in[I_CCTX][i - 8192]; s[i] = siluf_(v); }
  __syncthreads();
  const float* w = P.in[I_WMOD] + (long)layer * 1024 * 6144 + n0 + lane;
  float acc[9];
#pragma unroll
  for (int r = 0; r < 9; ++r) acc[r] = 0.f;
#pragma unroll 32
  for (int k = wid * 256; k < wid * 256 + 256; ++k) {
    const float wv = w[(long)k * 6144];
#pragma unroll
    for (int r = 0; r < 9; ++r) acc[r] += s[r * 1024 + k] * wv;
  }
#pragma unroll
  for (int r = 0; r < 9; ++r) part[(wid * 9 + r) * 64 + lane] = acc[r];
  __syncthreads();
  float* mod = reinterpret_cast<float*>(P.ws + OFF_MOD) + (long)layer * 9 * 6144;
  for (int i = tid; i < 9 * 64; i += NTHREADS) {
    const int r = i >> 6, c = i & 63;
    mod[r * 6144 + n0 + c] = part[(0 * 9 + r) * 64 + c] + part[(1 * 9 + r) * 64 + c] + part[(2 * 9 + r) * 64 + c] + part[(3 * 9 + r) * 64 + c] + P.in[I_BMOD][layer * 6144 + n0 + c];
  }
  __syncthreads();
}
DI void item_hymlp(const Params& P, int item, char* smem) {
  const int layer = item / 132; int r = item % 132;
  const int isc = r >= 128; const int Lf = isc ? CTXL : SEQ; const int t0 = (isc ? r - 128 : r) * 64;
  float* z1 = reinterpret_cast<float*>(smem);
  const int tid = tidx(), tl = tid >> 2, h0 = (tid & 3) * 16; const int t = t0 + tl;
  const float* w1 = P.in[I_FW1] + layer * 17 * 64; const float* b1 = P.in[I_FB1] + layer * 64;
  const float* w2 = P.in[I_FW2] + layer * 64 * 64; const float* b2 = P.in[I_FB2] + layer * 64; const float* fq = P.in[I_FFREQ] + layer * 64;
  float feat[17]; feat[0] = (float)t / (float)Lf;
#pragma unroll
  for (int k = 1; k <= 8; ++k) { float rev = (float)((t * k) % Lf) / (float)Lf; feat[k] = __builtin_amdgcn_cosf(rev); feat[8 + k] = __builtin_amdgcn_sinf(rev); }
#pragma unroll 4
  for (int j = 0; j < 16; ++j) {
    const int h = h0 + j; float a = b1[h];
#pragma unroll
    for (int f = 0; f < 17; ++f) a += feat[f] * w1[f * 64 + h];
    z1[tl * 65 + h] = __sinf(fq[h] * a);
  }
  __syncthreads();
  float* z2 = isc ? reinterpret_cast<float*>(P.ws + OFF_Z2C) + (long)layer * CTXL * 64 : reinterpret_cast<float*>(P.ws + OFF_Z2) + (long)layer * SEQ * 64;
  float a2[16];
#pragma unroll
  for (int j = 0; j < 16; ++j) a2[j] = b2[h0 + j];
  for (int k = 0; k < 64; ++k) {
    const float zv = z1[tl * 65 + k];
#pragma unroll
    for (int j = 0; j < 16; ++j) a2[j] += zv * w2[k * 64 + h0 + j];
  }
#pragma unroll
  for (int j = 0; j < 16; ++j) z2[(long)t * 64 + h0 + j] = __sinf(fq[h0 + j] * a2[j]);
  __syncthreads();
}
DI void item_s5disc(const Params& P, int item) {
  const int layer = item / 12, dir = (item % 12) / 6, gb = item % 6;
  const int tid = tidx(), g = gb * 4 + (tid >> 6), n = tid & 63;
  const int ld = layer * 2 + dir; const long gi = (long)ld * 24 + g;
  const double lre = P.in[I_LAMRE][gi * 64 + n], lim = P.in[I_LAMIM][gi * 64 + n];
  const double step = exp((double)P.in[I_LOGSTEP][gi]);
  double sn, cs; dsincos(lim * step, sn, cs);
  const double mag = exp(lre * step);
  const double are = mag * cs, aim = mag * sn;
  const double nr = are - 1.0, ni = aim, den = lre * lre + lim * lim;
  const double fre = (nr * lre + ni * lim) / den, fim = (ni * lre - nr * lim) / den;
  float2* A = reinterpret_cast<float2*>(P.ws + OFF_S5A); float2* A64 = reinterpret_cast<float2*>(P.ws + OFF_S5A64);
  A[gi * 64 + n] = make_float2((float)are, (float)aim);
  double pr = are, pi = aim;
  for (int i = 0; i < 6; ++i) { double t = pr * pr - pi * pi; pi = 2.0 * pr * pi; pr = t; }
  A64[gi * 64 + n] = make_float2((float)pr, (float)pi);
  float2* Bb = reinterpret_cast<float2*>(P.ws + OFF_S5B) + (gi * 64 + n) * 16;
  const float* bre = P.in[I_BRE] + (gi * 64 + n) * 16; const float* bim = P.in[I_BIM] + (gi * 64 + n) * 16;
  for (int c = 0; c < 16; ++c) { double br = bre[c], bi = bim[c]; Bb[c] = make_float2((float)(fre * br - fim * bi), (float)(fre * bi + fim * br)); }
  h16* Ct = reinterpret_cast<h16*>(P.ws + OFF_S5C) + gi * 16 * 128;
  const float* cre = P.in[I_CRE] + gi * 16 * 64; const float* cim = P.in[I_CIM] + gi * 16 * 64;
  for (int c = 0; c < 16; ++c) { Ct[c * 128 + n] = (h16)cre[c * 64 + n]; Ct[c * 128 + 64 + n] = (h16)(-cim[c * 64 + n]); }
}
DI void item_rope(const Params& P, int item) {
  const int idx = item * NTHREADS + tidx(); const int pos = idx >> 4, i = idx & 15;
  const double inv[8] = {1.0, 0.31622776601683794, 0.1, 0.031622776601683794, 0.01, 0.0031622776601683794, 0.001, 0.00031622776601683794};
  double iv = 1.0;
#pragma unroll
  for (int k = 0; k < 8; ++k) if ((i & 7) == k) iv = inv[k];
  const double ang = (double)(i < 8 ? (pos >> 6) : (pos & 63)) * iv;
  double s, c; dsincos(ang, s, c);
  reinterpret_cast<float2*>(P.ws + OFF_ROPE)[idx] = make_float2((float)c, (float)s);
}
constexpr int PRO_N_WT = 2 * WT_TILES_PER_LAYER, PRO_N_MOD = 192, PRO_N_HY = 264, PRO_N_S5 = 24, PRO_N_ROPE = 512;
DI void phase_prologue(const Params& P, char* smem) {
  const int total = PRO_N_MOD + PRO_N_HY + PRO_N_S5 + PRO_N_ROPE + PRO_N_WT;
  for (int it = blockIdx.x; it < total; it += gridDim.x) {
    int i = it;
    if (i < PRO_N_MOD) { item_mod(P, i, smem); continue; } i -= PRO_N_MOD;
    if (i < PRO_N_HY) { item_hymlp(P, i, smem); continue; } i -= PRO_N_HY;
    if (i < PRO_N_S5) { item_s5disc(P, i); continue; } i -= PRO_N_S5;
    if (i < PRO_N_ROPE) { item_rope(P, i); continue; } i -= PRO_N_ROPE;
    item_wt(P, i, smem);
  }
}

DI const float* xrow_src(const Params& P, int layer_stage, int t) {
  if (t < TLAT) return (layer_stage == 0 ? P.in[I_X] : P.out) + (long)t * 1024;
  return (layer_stage == 0 ? P.in[I_CTX] : reinterpret_cast<const float*>(P.ws + OFF_XC)) + (long)(t - TLAT) * 1024;
}
DI float* xrow_dst(const Params& P, int t) {
  if (t < TLAT) return P.out + (long)t * 1024;
  return reinterpret_cast<float*>(P.ws + OFF_XC) + (long)(t - TLAT) * 1024;
}
DI void normmod_rows(const Params& P, int layer, int which, int stage, int ntok, int item, int nitems_stride) {
  const int tid = tidx(), lane = tid & 63, wid = tid >> 6;
  const float* g = P.in[which ? I_N2G : I_N1G] + layer * 1024;
  const float* mod = reinterpret_cast<const float*>(P.ws + OFF_MOD) + (long)layer * 9 * 6144;
  h16* H = reinterpret_cast<h16*>(P.ws + OFF_H1);
#pragma unroll 2
  for (int rg = item; rg * 4 < ntok; rg += nitems_stride) {
    const int t = rg * 4 + wid;
    const Tok k = tokinfo(t);
    const float* xr = xrow_src(P, stage, t);
    const float* sh = mod + k.mrow * 6144 + (which ? 3 : 0) * 1024; const float* sc = sh + 1024;
    float4 v[4]; float ss = 0.f;
#pragma unroll
    for (int i = 0; i < 4; ++i) { v[i] = *reinterpret_cast<const float4*>(xr + i * 256 + lane * 4); ss += v[i].x * v[i].x + v[i].y * v[i].y + v[i].z * v[i].z + v[i].w * v[i].w; }
    ss = wave_sum(ss);
    const float r = rsqrtf(ss * (1.f / 1024.f) + EPS);
#pragma unroll
    for (int i = 0; i < 4; ++i) {
      const int c = i * 256 + lane * 4;
      const float4 gg = *reinterpret_cast<const float4*>(g + c), s1 = *reinterpret_cast<const float4*>(sc + c), s0 = *reinterpret_cast<const float4*>(sh + c);
      h16x4 o;
      o[0] = (h16)(v[i].x * r * gg.x * (1.f + s1.x) + s0.x); o[1] = (h16)(v[i].y * r * gg.y * (1.f + s1.y) + s0.y);
      o[2] = (h16)(v[i].z * r * gg.z * (1.f + s1.z) + s0.z); o[3] = (h16)(v[i].w * r * gg.w * (1.f + s1.w) + s0.w);
      *reinterpret_cast<h16x4*>(H + (long)t * LD1 + c) = o;
    }
  }
}
DI void phase_final(const Params& P) {
  const int lane = tidx() & 63, wid = tidx() >> 6;
  const float* g = P.in[I_FINALG];
  for (int rg = blockIdx.x; rg * 4 < TLAT; rg += gridDim.x) {
    float* xr = P.out + (long)(rg * 4 + wid) * 1024;
    float4 v[4]; float ss = 0.f;
#pragma unroll
    for (int i = 0; i < 4; ++i) { v[i] = *reinterpret_cast<const float4*>(xr + i * 256 + lane * 4); ss += v[i].x * v[i].x + v[i].y * v[i].y + v[i].z * v[i].z + v[i].w * v[i].w; }
    ss = wave_sum(ss);
    const float r = rsqrtf(ss * (1.f / 1024.f) + EPS);
#pragma unroll
    for (int i = 0; i < 4; ++i) {
      const int c = i * 256 + lane * 4; const float4 gg = *reinterpret_cast<const float4*>(g + c);
      *reinterpret_cast<float4*>(xr + c) = make_float4(v[i].x * r * gg.x, v[i].y * r * gg.y, v[i].z * r * gg.z, v[i].w * r * gg.w);
    }
  }
}
DI float2 r8(int idx) { const float c = 0.70710678118654752f; return idx == 0 ? make_float2(1.f, 0.f) : idx == 1 ? make_float2(c, -c) : idx == 2 ? make_float2(0.f, -1.f) : make_float2(-c, -c); }
DI float2 cmul_r8(float2 w, int idx, bool cj) {
  if (idx == 0) return w;
  float2 r = r8(idx); if (cj) r.y = -r.y;
  return cmul(w, r);
}
template <int S> DI void fft_dif_pass(float2* X, int h) {
  const int hs = h >> (S - 1);
#pragma unroll 1
  for (int item = tidx(); item < (8192 >> S); item += NTHREADS) {
    const int j = item % hs, blk = item / hs, i0 = blk * 2 * h + j;
    float2 v[1 << S];
#pragma unroll
    for (int k = 0; k < (1 << S); ++k) v[k] = X[i0 + k * hs];
    float2 wp[S];
    wp[0] = twid(-(float)j / (float)(2 * h));
#pragma unroll
    for (int q = 1; q < S; ++q) wp[q] = cmul(wp[q - 1], wp[q - 1]);
#pragma unroll
    for (int q = 0; q < S; ++q) {
      const int dist = 1 << (S - 1 - q);
#pragma unroll
      for (int k = 0; k < (1 << S); ++k) {
        if (k & dist) continue;
        const float2 a = v[k], b = v[k + dist];
        const int m = k & (dist - 1);
        const float2 tw = cmul_r8(wp[q], m << (3 - (S - q)), false);
        v[k] = make_float2(a.x + b.x, a.y + b.y);
        v[k + dist] = cmul(make_float2(a.x - b.x, a.y - b.y), tw);
      }
    }
#pragma unroll
    for (int k = 0; k < (1 << S); ++k) X[i0 + k * hs] = v[k];
  }
  __syncthreads();
}
template <int S> DI void fft_dit_pass(float2* X, int hs) {
  const int hmax = hs << (S - 1);
#pragma unroll 1
  for (int item = tidx(); item < (8192 >> S); item += NTHREADS) {
    const int j = item % hs, blk = item / hs, i0 = blk * 2 * hmax + j;
    float2 v[1 << S];
#pragma unroll
    for (int k = 0; k < (1 << S); ++k) v[k] = X[i0 + k * hs];
    float2 bp[S];
    bp[S - 1] = twid((float)j / (float)(2 * hmax));
#pragma unroll
    for (int q = S - 2; q >= 0; --q) bp[q] = cmul(bp[q + 1], bp[q + 1]);
#pragma unroll
    for (int q = 0; q < S; ++q) {
      const int dist = 1 << q;
#pragma unroll
      for (int k = 0; k < (1 << S); ++k) {
        if (k & dist) continue;
        const int m = k & (dist - 1);
        const float2 tw = cmul_r8(bp[q], m << (3 - (q + 1)), true);
        const float2 a = v[k], b = cmul(v[k + dist], tw);
        v[k] = make_float2(a.x + b.x, a.y + b.y);
        v[k + dist] = make_float2(a.x - b.x, a.y - b.y);
      }
    }
#pragma unroll
    for (int k = 0; k < (1 << S); ++k) X[i0 + k * hs] = v[k];
  }
  __syncthreads();
}
DI void fft_fwd1(float2* X) { fft_dif_pass<3>(X, 4096); fft_dif_pass<3>(X, 512); fft_dif_pass<3>(X, 64); fft_dif_pass<2>(X, 8); fft_dif_pass<2>(X, 2); }
DI void fft_inv(float2* X) { fft_dit_pass<2>(X, 1); fft_dit_pass<2>(X, 4); fft_dit_pass<3>(X, 16); fft_dit_pass<3>(X, 128); fft_dit_pass<3>(X, 1024); }
#ifndef PROBE_FFT
#define PROBE_FFT 0
#endif
DI void fft_fwd(float2* X) {
#if PROBE_FFT
  fft_fwd1(X); fft_inv(X);
  for (int i = tidx(); i < 8192; i += NTHREADS) { float2 v = X[i]; X[i] = make_float2(v.x * (1.f / 8192.f), v.y * (1.f / 8192.f)); }
  __syncthreads();
#endif
  fft_fwd1(X);
}

DI float block_sum(float v, float* red) {
  v = wave_sum(v);
  __syncthreads();
  if ((tidx() & 63) == 0) red[tidx() >> 6] = v;
  __syncthreads();
  const float r = red[0] + red[1] + red[2] + red[3];
  __syncthreads();
  return r;
}
DI void item_filter(const Params& P, int layer, int oc, char* smem) {
  float2* X = reinterpret_cast<float2*>(smem); float* red = reinterpret_cast<float*>(smem + 65536);
  const int tid = tidx();
  const float* z2 = reinterpret_cast<const float*>(P.ws + OFF_Z2) + (long)layer * SEQ * 64;
  const float* w3 = P.in[I_FW3] + (long)layer * 64 * 1536; const float* dec = P.in[I_FDECAY] + layer * 1536;
  const int colf = oc, colb = 768 + oc;
  const float df = fabsf(dec[colf]), db = fabsf(dec[colb]);
  float lsum = 0.f;
#pragma unroll 2
  for (int i = 0; i < 32; ++i) {
    const int t = tid + 256 * i; const float* zr = z2 + (long)t * 64;
    float af = 0.f, ab = 0.f;
#pragma unroll 8
    for (int k = 0; k < 64; ++k) { const float z = zr[k]; af += z * w3[k * 1536 + colf]; ab += z * w3[k * 1536 + colb]; }
    const float tn = (float)t * (1.f / 8192.f);
    af *= __expf(-tn * df); ab *= __expf(-tn * db);
    lsum += fabsf(af) + fabsf(ab);
    X[t] = make_float2(af, ab);
  }
  const float nrm = block_sum(lsum, red);
  const float sc = 0.5f / 8192.f / nrm;
  float ev[32];
  float2* F = reinterpret_cast<float2*>(P.ws + OFF_FILT) + (long)oc * 2 * 8192;
#pragma unroll
  for (int i = 0; i < 32; ++i) {
    const int n = tid + 256 * i; const float lo = X[n].x; const float hi = n > 0 ? X[8192 - n].y : 0.f;
    ev[i] = (lo + hi) * sc; F[8192 + n] = make_float2((lo - hi) * sc, 0.f);
  }
  __syncthreads();
#pragma unroll
  for (int i = 0; i < 32; ++i) X[tid + 256 * i] = make_float2(ev[i], 0.f);
  __syncthreads();
  fft_fwd(X);
#pragma unroll 4
  for (int i = 0; i < 32; ++i) F[tid + 256 * i] = X[tid + 256 * i];
  __syncthreads();
#pragma unroll 4
  for (int i = 0; i < 32; ++i) { const int n = tid + 256 * i; const float d = F[8192 + n].x; const float2 w = twid(-(float)n * (1.f / 16384.f)); X[n] = make_float2(d * w.x, d * w.y); }
  __syncthreads();
  fft_fwd(X);
#pragma unroll 4
  for (int i = 0; i < 32; ++i) F[8192 + tid + 256 * i] = X[tid + 256 * i];
  __syncthreads();
}
DI void item_filter_ctx(const Params& P, int layer, int oc, char* smem) {
  float* red = reinterpret_cast<float*>(smem);
  const int t = tidx();
  const float* zr = reinterpret_cast<const float*>(P.ws + OFF_Z2C) + (long)layer * CTXL * 64 + t * 64;
  const float* w3 = P.in[I_FW3] + (long)layer * 64 * 1536; const float* dec = P.in[I_FDECAY] + layer * 1536;
  float af = 0.f, ab = 0.f;
  for (int k = 0; k < 64; ++k) { const float z = zr[k]; af += z * w3[k * 1536 + oc]; ab += z * w3[k * 1536 + 768 + oc]; }
  const float tn = (float)t * (1.f / 256.f);
  af *= __expf(-tn * fabsf(dec[oc])); ab *= __expf(-tn * fabsf(dec[768 + oc]));
  const float nrm = block_sum(fabsf(af) + fabsf(ab), red);
  float* T = reinterpret_cast<float*>(P.ws + OFF_TAPSC) + (long)oc * 512;
  T[t] = af / nrm; T[256 + t] = ab / nrm;
}

DI void phase_norm1(const Params& P, int layer, char* smem) {
  const int nfilt = 768 + (layer == 0 ? 768 : 0);
  for (int it = blockIdx.x; it < nfilt; it += gridDim.x) {
    if (it < 768) item_filter(P, layer, it, smem); else item_filter_ctx(P, layer, it - 768, smem);
  }
  normmod_rows(P, layer, 0, layer, TT, blockIdx.x, gridDim.x);
}

DI void phase_gemm_in(const Params& P, int layer, char* smem) {
  const int tid = tidx(), lane = tid & 63, wid = tid >> 6, wr = wid >> 1, wc = wid & 1, fr = lane & 15, fq = lane >> 4;
  const h16* H = reinterpret_cast<const h16*>(P.ws + OFF_H1);
  const h16* W = reinterpret_cast<const h16*>(P.ws + OFF_WT) + (long)layer * WT_LAYER + WT_WIN;
  h16* U = reinterpret_cast<h16*>(P.ws + OFF_U); h16* KV = reinterpret_cast<h16*>(P.ws + OFF_KVLAT); h16* QL = reinterpret_cast<h16*>(P.ws + OFF_QLAT);
  h16* PHY = reinterpret_cast<h16*>(P.ws + OFF_PHY); h16* PHYC = reinterpret_cast<h16*>(P.ws + OFF_PHYC); h16* Kb = reinterpret_cast<h16*>(P.ws + OFF_K);
  const float2* rope = reinterpret_cast<const float2*>(P.ws + OFF_ROPE);
  constexpr int NT = 19, MT = TT / 128;
  const TileWalk tw = tw_init(MT, NT);
  for (int tile = tw.lb; tile < tw_count(tw); tile += tw.nlb) {
    int mt, nt; tw_decode(tw, tile, mt, nt);
    f32x4 acc[4][4]; acc_zero(acc);
    gemm_kloop(acc, H + (long)mt * 128 * LD1, LD1, 0, 128, W + (long)nt * 128 * LD1, LD1, 1024, smem, opaque_tid());
    const int t0 = mt * 128; const Tok tk = tokinfo(t0);
    if (nt < 18) {
      float* Zs = reinterpret_cast<float*>(smem);
      const int t2 = tidx();
      if (nt < 9) {
        stage_acc(acc, Zs, t2);
        h16* dst; int ld, cb;
        if (nt < 3) { dst = U; ld = 384; cb = nt * 128; } else if (nt < 5) { dst = KV; ld = 256; cb = (nt - 3) * 128; } else { dst = QL; ld = 512; cb = (nt - 5) * 128; }
        copy_out_f16(Zs, dst, t0, ld, cb, t2);
      } else {
        stage_acc_t(acc, Zs, t2);
        h16* base = tk.ctx ? PHYC + (long)tk.b * 1152 * CTXL : PHY + (long)tk.b * 1152 * SEQ; const int lp = tk.ctx ? CTXL : SEQ;
        copy_out_f16(Zs, base, (nt - 9) * 128, lp, tk.pos, t2);
      }
      __syncthreads();
    } else {
      h16* R = reinterpret_cast<h16*>(smem);
      if (wc == 0) {
#pragma unroll
        for (int m = 0; m < 4; ++m)
#pragma unroll
          for (int j = 0; j < 4; ++j) {
            const int row = wr * 64 + m * 16 + fq * 4 + j; const int pos = tk.pos + row;
            float x1 = acc[m][0][j], x2 = acc[m][1][j];
            if (!tk.ctx) { const float2 cs = rope[pos * 16 + fr]; const float y1 = x1 * cs.x - x2 * cs.y, y2 = x1 * cs.y + x2 * cs.x; x1 = y1; x2 = y2; }
            R[row * 32 + fr] = (h16)x1; R[row * 32 + 16 + fr] = (h16)x2;
          }
      }
      __syncthreads();
      {
        const int t2 = tidx(); const int key0 = (tk.ctx ? SEQ : 0) + tk.pos;
#pragma unroll
        for (int it = 0; it < 2; ++it) {
          const int chunk = it * 256 + t2, row = chunk >> 2, part = chunk & 3;
          const uint4 v = *reinterpret_cast<const uint4*>(R + row * 32 + part * 8);
#pragma unroll
          for (int h = 0; h < 8; ++h) *reinterpret_cast<uint4*>(Kb + ((long)(tk.b * 8 + h) * KEYS + key0 + row) * 96 + 64 + part * 8) = v;
        }
      }
      __syncthreads();
    }
  }
}
DI void item_kv(const Params& P, int layer, int tile, char* smem) {
  const int tid = tidx(), lane = tid & 63, wid = tid >> 6, wr = wid >> 1, wc = wid & 1, fr = lane & 15, fq = lane >> 4;
  const int mt = tile >> 3, hd = tile & 7; const int t0 = mt * 128; const Tok tk = tokinfo(t0);
  const h16* A = reinterpret_cast<const h16*>(P.ws + OFF_KVLAT) + (long)t0 * 256;
  const h16* W = reinterpret_cast<const h16*>(P.ws + OFF_WT) + (long)layer * WT_LAYER + WT_UKV + (long)hd * 128 * 256;
  float* rs = reinterpret_cast<float*>(smem + 73728);
  row_rms(A, 256, 256, rs);
  f32x4 acc[4][4]; acc_zero(acc);
  gemm_kloop(acc, A, 256, 0, 128, W, 256, 256, smem, opaque_tid());
  h16* Kb = reinterpret_cast<h16*>(P.ws + OFF_K) + (long)(tk.b * 8 + hd) * KEYS * 96;
  h16* Vt = reinterpret_cast<h16*>(P.ws + OFF_VT) + (long)(tk.b * 8 + hd) * 64 * KEYS;
  const int key0 = (tk.ctx ? SEQ : 0) + tk.pos;
#pragma unroll
  for (int m = 0; m < 4; ++m) {
    const int r0 = wr * 64 + m * 16 + fq * 4;
    const float s0 = rs[r0], s1 = rs[r0 + 1], s2 = rs[r0 + 2], s3 = rs[r0 + 3];
#pragma unroll
    for (int n = 0; n < 4; ++n) {
      acc[m][n][0] *= s0; acc[m][n][1] *= s1; acc[m][n][2] *= s2; acc[m][n][3] *= s3;
      if (wc == 1) {
        h16x4 o; o[0] = (h16)acc[m][n][0]; o[1] = (h16)acc[m][n][1]; o[2] = (h16)acc[m][n][2]; o[3] = (h16)acc[m][n][3];
        *reinterpret_cast<h16x4*>(Vt + (long)(n * 16 + fr) * KEYS + key0 + r0) = o;
      }
    }
  }
  {
    float* Zs = reinterpret_cast<float*>(smem);
    const int t2 = tidx();
    stage_acc(acc, Zs, t2);
#pragma unroll
    for (int it = 0; it < 4; ++it) {
      const int chunk = it * 256 + t2, row = chunk >> 3, c8 = (chunk & 7) * 8;
      const float4 x0 = *reinterpret_cast<const float4*>(Zs + row * 132 + c8), x1 = *reinterpret_cast<const float4*>(Zs + row * 132 + c8 + 4);
      h16x8 o; o[0] = (h16)x0.x; o[1] = (h16)x0.y; o[2] = (h16)x0.z; o[3] = (h16)x0.w; o[4] = (h16)x1.x; o[5] = (h16)x1.y; o[6] = (h16)x1.z; o[7] = (h16)x1.w;
      *reinterpret_cast<h16x8*>(Kb + (long)(key0 + row) * 96 + c8) = o;
    }
  }
  __syncthreads();
}
DI void item_q(const Params& P, int layer, int tile, char* smem) {
  const int tid = tidx(), lane = tid & 63, wid = tid >> 6, wr = wid >> 1, wc = wid & 1, fr = lane & 15, fq = lane >> 4;
  const int mt = tile >> 3, hd = tile & 7; const int t0 = mt * 128; const Tok tk = tokinfo(t0);
  const h16* A = reinterpret_cast<const h16*>(P.ws + OFF_QLAT) + (long)t0 * 512;
  const h16* W = reinterpret_cast<const h16*>(P.ws + OFF_WT) + (long)layer * WT_LAYER + WT_UQ + (long)hd * 128 * 512;
  float* rs = reinterpret_cast<float*>(smem + 73728);
  row_rms(A, 512, 512, rs);
  f32x4 acc[4][4]; acc_zero(acc);
  gemm_kloop(acc, A, 512, 0, 128, W, 512, 512, smem, opaque_tid());
  h16* Qb = reinterpret_cast<h16*>(P.ws + OFF_Q) + (long)(tk.b * 8 + hd) * KEYS * 96;
  const float2* rope = reinterpret_cast<const float2*>(P.ws + OFF_ROPE);
  const int q0 = (tk.ctx ? SEQ : 0) + tk.pos;
#pragma unroll
  for (int m = 0; m < 4; ++m)
#pragma unroll
    for (int j = 0; j < 4; ++j) {
      const int r = wr * 64 + m * 16 + fq * 4 + j; const float s = rs[r] * QSCALE;
      if (wc == 0) {
#pragma unroll
        for (int n = 0; n < 4; ++n) acc[m][n][j] *= s;
      } else {
        float x1 = acc[m][0][j], x2 = acc[m][1][j];
        if (!tk.ctx) { const float2 cs = rope[(tk.pos + r) * 16 + fr]; const float y1 = x1 * cs.x - x2 * cs.y, y2 = x1 * cs.y + x2 * cs.x; x1 = y1; x2 = y2; }
        acc[m][0][j] = x1 * s; acc[m][1][j] = x2 * s;
      }
    }
  {
    float* Zs = reinterpret_cast<float*>(smem);
    const int t2 = tidx();
    stage_acc(acc, Zs, t2);
#pragma unroll
    for (int it = 0; it < 6; ++it) {
      const int chunk = it * 256 + t2, row = chunk / 12, c8 = (chunk % 12) * 8;
      const float4 x0 = *reinterpret_cast<const float4*>(Zs + row * 132 + c8), x1 = *reinterpret_cast<const float4*>(Zs + row * 132 + c8 + 4);
      h16x8 o; o[0] = (h16)x0.x; o[1] = (h16)x0.y; o[2] = (h16)x0.z; o[3] = (h16)x0.w; o[4] = (h16)x1.x; o[5] = (h16)x1.y; o[6] = (h16)x1.z; o[7] = (h16)x1.w;
      *reinterpret_cast<h16x8*>(Qb + (long)(q0 + row) * 96 + c8) = o;
    }
  }
  __syncthreads();
}
DI int s5_chunk_base(int b, int dir, int si) {
  if (si < 4) { const int cc = dir ? 3 - si : si; return TLAT + b * CTXL + cc * 64; }
  const int lc = dir ? 127 - (si - 4) : si - 4; return b * SEQ + lc * 64;
}
DI void s5_stage_u(const h16* __restrict__ U, int tokbase, int g, float* us) {
  const int lane = tidx() & 63;
  const h16* p = U + (long)(tokbase + lane) * 384 + g * 16;
  const h16x8 v0 = *reinterpret_cast<const h16x8*>(p), v1 = *reinterpret_cast<const h16x8*>(p + 8);
#pragma unroll
  for (int j = 0; j < 8; ++j) { us[lane * 16 + j] = (float)v0[j]; us[lane * 16 + 8 + j] = (float)v1[j]; }
}
DI void item_s5_pass1(const Params& P, int layer, int wtask, char* smem) {
  const int lane = tidx() & 63, wid = tidx() >> 6;
  float* us = reinterpret_cast<float*>(smem + wid * 12800);
  const int si = wtask % 132; int r = wtask / 132; const int g = r % 24; r /= 24; const int dir = r & 1, b = r >> 1;
  const long gi = (long)(layer * 2 + dir) * 24 + g;
  const float2 a = reinterpret_cast<const float2*>(P.ws + OFF_S5A)[gi * 64 + lane];
  const float2* Bb = reinterpret_cast<const float2*>(P.ws + OFF_S5B) + (gi * 64 + lane) * 16;
  float bre[16], bim[16];
#pragma unroll
  for (int c = 0; c < 16; ++c) { const float2 v = Bb[c]; bre[c] = v.x; bim[c] = v.y; }
  s5_stage_u(reinterpret_cast<const h16*>(P.ws + OFF_U), s5_chunk_base(b, dir, si), g, us);
  float hr = 0.f, hi = 0.f;
#pragma unroll 4
  for (int s = 0; s < 64; ++s) {
    const int tau = dir ? 63 - s : s;
    const float4* up = reinterpret_cast<const float4*>(us + tau * 16);
    float br = 0.f, bi = 0.f;
#pragma unroll
    for (int q = 0; q < 4; ++q) { const float4 u = up[q];
      br += bre[q * 4] * u.x + bre[q * 4 + 1] * u.y + bre[q * 4 + 2] * u.z + bre[q * 4 + 3] * u.w;
      bi += bim[q * 4] * u.x + bim[q * 4 + 1] * u.y + bim[q * 4 + 2] * u.z + bim[q * 4 + 3] * u.w; }
    const float nr = a.x * hr - a.y * hi + br, ni = a.x * hi + a.y * hr + bi; hr = nr; hi = ni;
  }
  reinterpret_cast<float2*>(P.ws + OFF_E)[((long)((b * 2 + dir) * 24 + g) * 132 + si) * 64 + lane] = make_float2(hr, hi);
}

DI float hy_dw(const h16* __restrict__ p, int t, int Ls, float w0, float w1, float w2, float bias) {
  const float xm_ = (float)p[max(t - 1, 0)], x0 = (float)p[t], xp_ = (float)p[min(t + 1, Ls - 1)];
  const float xm = t > 0 ? xm_ : 0.f, xp = t + 1 < Ls ? xp_ : 0.f;
  return xm * w0 + x0 * w1 + xp * w2 + bias;
}
DI void item_hyena(const Params& P, int layer, int task, char* smem) {
  float2* X = reinterpret_cast<float2*>(smem);
  const int tid = tidx(); const int pair = task / 384, c = task % 384;
  const h16* PH0 = reinterpret_cast<const h16*>(P.ws + OFF_PHY) + (long)(2 * pair) * 1152 * SEQ;
  const h16* PH1 = PH0 + (long)1152 * SEQ;
  const float* cw = P.in[I_HCW] + layer * 3 * 1152; const float* cb = P.in[I_HCB] + layer * 1152;
  const float2* F = reinterpret_cast<const float2*>(P.ws + OFF_FILT);
  float2* SCR = reinterpret_cast<float2*>(P.ws + OFF_YS5PRE) + (long)blockIdx.x * 12288;
  float2* SCR2 = SCR + 8192;
  const float vw0 = cw[c], vw1 = cw[1152 + c], vw2 = cw[2304 + c], vbb = cb[c];
  const h16* pv0 = PH0 + (long)c * SEQ; const h16* pv1 = PH1 + (long)c * SEQ;
  float2 ye[16]; int tq;
#pragma unroll 1
  for (int o = 0; o < 2; ++o) {
    const float2* Te = F + (long)(o * 384 + c) * 2 * 8192; const float2* To = Te + 8192;
    float ts = 1.f / 16384.f; asm volatile("" : "+v"(ts));
{ tq = tid; asm volatile("" : "+v"(tq)); }
    if (o == 0) {
#pragma unroll 8
      for (int i = 0; i < 32; ++i) { const int t = tq + 256 * i; const float2 v = make_float2(hy_dw(pv0, t, SEQ, vw0, vw1, vw2, vbb), hy_dw(pv1, t, SEQ, vw0, vw1, vw2, vbb)); X[t] = v; SCR[t] = v; }
    } else {
#pragma unroll 16
      for (int i = 0; i < 32; ++i) { const int t = tq + 256 * i; X[t] = SCR[t]; }
    }
    __syncthreads();
    fft_fwd(X);
{ tq = tid; asm volatile("" : "+v"(tq)); }
#pragma unroll 8
    for (int i = 0; i < 32; ++i) { const int n = tq + 256 * i; X[n] = cmul(X[n], Te[n]); }
    __syncthreads();
    fft_inv(X);
{ tq = tid; asm volatile("" : "+v"(tq)); }
#pragma unroll
    for (int i = 0; i < 16; ++i) { ye[i] = X[tq + 256 * i]; SCR2[tq + 256 * i] = X[tq + 4096 + 256 * i]; }
    __syncthreads();
{ tq = tid; asm volatile("" : "+v"(tq)); }
#pragma unroll 16
    for (int i = 0; i < 32; ++i) { const int t = tq + 256 * i; X[t] = cmul(SCR[t], twid(-(float)t * ts)); }
    __syncthreads();
    fft_fwd(X);
{ tq = tid; asm volatile("" : "+v"(tq)); }
#pragma unroll 8
    for (int i = 0; i < 32; ++i) { const int n = tq + 256 * i; X[n] = cmul(X[n], To[n]); }
    __syncthreads();
    fft_inv(X);
    asm volatile("" : "+v"(ts));
{ tq = tid; asm volatile("" : "+v"(tq)); }
#pragma unroll
    for (int i = 0; i < 16; ++i) { const int t = tq + 256 * i; const float2 yo = cmul(X[t], twid((float)t * ts)); X[t] = make_float2(ye[i].x + yo.x, ye[i].y + yo.y); }
{ tq = tid; asm volatile("" : "+v"(tq)); }
#pragma unroll 2
    for (int i = 0; i < 16; ++i) { const int t = tq + 4096 + 256 * i; const float2 yo = cmul(X[t], twid((float)t * ts)); const float2 y2 = SCR2[tq + 256 * i]; X[t] = make_float2(y2.x + yo.x, y2.y + yo.y); }
    const int gc = (o + 1) * 384 + c;
    const float w0 = cw[gc], w1 = cw[1152 + gc], w2 = cw[2304 + gc], bb = cb[gc];
    const float bias = P.in[I_HBIAS][(layer * 2 + o) * 384 + c];
    const h16* pg0 = PH0 + (long)gc * SEQ; const h16* pg1 = PH1 + (long)gc * SEQ;
{ tq = tid; asm volatile("" : "+v"(tq)); }
    if (o == 0) {
#pragma unroll 8
      for (int i = 0; i < 32; ++i) {
        const int t = tq + 256 * i;
        const float2 lc = X[t];
        const float2 zz = SCR[t];
        const float gx = hy_dw(pg0, t, SEQ, w0, w1, w2, bb), gy = hy_dw(pg1, t, SEQ, w0, w1, w2, bb);
        SCR[t] = make_float2(gx * (lc.x + bias * zz.x), gy * (lc.y + bias * zz.y));
      }
    } else {
#pragma unroll 8
      for (int i = 0; i < 32; ++i) {
        const int t = tq + 256 * i;
        const float2 lc = X[t];
        const float2 zz = SCR[t];
        const float gx = hy_dw(pg0, t, SEQ, w0, w1, w2, bb), gy = hy_dw(pg1, t, SEQ, w0, w1, w2, bb);
        const_cast<h16*>(pv0)[t] = (h16)(gx * (lc.x + bias * zz.x)); const_cast<h16*>(pv1)[t] = (h16)(gy * (lc.y + bias * zz.y));
      }
    }
    __syncthreads();
  }
}
DI void item_hyena_ctx(const Params& P, int layer, int task, char* smem) {
  float* su = reinterpret_cast<float*>(smem); float* sf = su + 256; float* sb = sf + 256;
  const int t = tidx(); const int b = task / 384, c = task % 384;
  const h16* PH = reinterpret_cast<const h16*>(P.ws + OFF_PHYC) + (long)b * 1152 * CTXL;
  const float* cw = P.in[I_HCW] + layer * 3 * 1152; const float* cb = P.in[I_HCB] + layer * 1152;
  float u = hy_dw(PH + (long)c * CTXL, t, CTXL, cw[c], cw[1152 + c], cw[2304 + c], cb[c]);
  for (int o = 0; o < 2; ++o) {
    const float* T = reinterpret_cast<const float*>(P.ws + OFF_TAPSC) + (long)(o * 384 + c) * 512;
    __syncthreads();
    su[t] = u; sf[t] = T[t]; sb[t] = T[256 + t];
    __syncthreads();
    float y = 0.f;
    for (int s = 0; s <= t; ++s) y += sf[t - s] * su[s];
    for (int s = t + 1; s < 256; ++s) y += sb[s - t] * su[s];
    const int gc = (o + 1) * 384 + c;
    const float gx = hy_dw(PH + (long)gc * CTXL, t, CTXL, cw[gc], cw[1152 + gc], cw[2304 + gc], cb[gc]);
    u = gx * (y + P.in[I_HBIAS][(layer * 2 + o) * 384 + c] * u);
  }
  reinterpret_cast<h16*>(P.ws + OFF_YHY)[((long)TLAT + b * CTXL + t) * 384 + c] = (h16)u;
  __syncthreads();
}

#ifndef PROBE_HY
#define PROBE_HY 0
#endif
#ifndef PROBE_S5
#define PROBE_S5 0
#endif
DI int first_item(int base) { const int g = (int)gridDim.x; return (((int)blockIdx.x - base) % g + g) % g; }
DI void phase_mix1(const Params& P, int layer, char* smem) {
  const int n_hy = 4 * 384, n_hyc = layer == 0 ? 8 * 384 : 0;
  const int n_kv = (TT / 128) * 8, n_q = (layer == 0 ? TT / 128 : TLAT / 128) * 8;
  const int n_s5 = (NBATCH * 2 * 24 * 132) / 4;
  const int g = gridDim.x;
#pragma unroll 1
  for (int rep = 0; rep < 1 + PROBE_HY; ++rep)
#pragma unroll 1
  for (int i = first_item(0); i < n_hy; i += g) item_hyena(P, layer, i, smem);
  asm volatile("" ::: "memory");
#pragma unroll 1
  for (int i = first_item(n_hy); i < n_kv; i += g) item_kv(P, layer, i, smem);
  asm volatile("" ::: "memory");
#pragma unroll 1
  for (int i = first_item(n_hy + n_kv); i < n_q; i += g) item_q(P, layer, i, smem);
  asm volatile("" ::: "memory");
#pragma unroll 1
  for (int rep = 0; rep < 1 + PROBE_S5; ++rep)
#pragma unroll 1
  for (int i = first_item(n_hy + n_kv + n_q); i < n_s5; i += g) { item_s5_pass1(P, layer, i * 4 + (tidx() >> 6), smem); __syncthreads(); }
  asm volatile("" ::: "memory");
#pragma unroll 1
  for (int i = first_item(n_hy + n_kv + n_q + n_s5); i < n_hyc; i += g) item_hyena_ctx(P, layer, i, smem);
}
DI int crow32(int r, int hi) { return (r & 3) + 8 * (r >> 2) + 4 * hi; }
DI void item_attn(const Params& P, int bh, int q0, int key_lo, int ntiles, char* smem) {
  const int tid = tidx(), lane = tid & 63, wid = tid >> 6, r32 = lane & 31, hi = lane >> 5;
  const h16* Qb = reinterpret_cast<const h16*>(P.ws + OFF_Q) + (long)bh * KEYS * 96;
  const h16* Kb = reinterpret_cast<const h16*>(P.ws + OFF_K) + (long)bh * KEYS * 96;
  const h16* Vt = reinterpret_cast<const h16*>(P.ws + OFF_VT) + (long)bh * 64 * KEYS;
  h16x8 qf[6];
  { const h16* qrow = Qb + (long)(q0 + wid * 32 + r32) * 96 + hi * 8;
#pragma unroll
    for (int ds = 0; ds < 6; ++ds) qf[ds] = *reinterpret_cast<const h16x8*>(qrow + ds * 16); }
  constexpr int KT_BYTES = 64 * 208, VT_BYTES = 64 * 136, BUF = KT_BYTES + VT_BYTES;
  uint4 kr[3]; uint4 vr[2];
  const int vdv0 = tid >> 3, vpart = tid & 7;
  auto gload = [&](int j) {
    const long key0 = key_lo + j * 64;
#pragma unroll
    for (int i = 0; i < 3; ++i) kr[i] = *reinterpret_cast<const uint4*>(Kb + key0 * 96 + (long)(tid + 256 * i) * 8);
#pragma unroll
    for (int i = 0; i < 2; ++i) vr[i] = *reinterpret_cast<const uint4*>(Vt + (long)(vdv0 + 32 * i) * KEYS + key0 + vpart * 8);
  };
  auto swrite = [&](int buf) {
    char* ks = smem + buf * BUF; char* vs = ks + KT_BYTES;
#pragma unroll
    for (int i = 0; i < 3; ++i) { const int c = tid + 256 * i; *reinterpret_cast<uint4*>(ks + (c / 12) * 208 + (c % 12) * 16) = kr[i]; }
#pragma unroll
    for (int i = 0; i < 2; ++i) { char* d = vs + (vdv0 + 32 * i) * 136 + vpart * 16;
      *reinterpret_cast<uint2*>(d) = make_uint2(vr[i].x, vr[i].y); *reinterpret_cast<uint2*>(d + 8) = make_uint2(vr[i].z, vr[i].w); }
  };
  f32x16 o0, o1;
#pragma unroll
  for (int r = 0; r < 16; ++r) { o0[r] = 0.f; o1[r] = 0.f; }
  float m_run = -1e30f, l_run = 0.f;
  gload(0); swrite(0); __syncthreads();
  for (int j = 0; j < ntiles; ++j) {
    if (j + 1 < ntiles) gload(j + 1);
    const char* ks = smem + (j & 1) * BUF; const char* vs = ks + KT_BYTES;
    f32x16 p0, p1;
#pragma unroll
    for (int r = 0; r < 16; ++r) { p0[r] = 0.f; p1[r] = 0.f; }
#pragma unroll
    for (int ds = 0; ds < 6; ++ds) {
      const h16x8 a0 = *reinterpret_cast<const h16x8*>(ks + r32 * 208 + (ds * 16 + hi * 8) * 2);
      const h16x8 a1 = *reinterpret_cast<const h16x8*>(ks + (32 + r32) * 208 + (ds * 16 + hi * 8) * 2);
      p0 = __builtin_amdgcn_mfma_f32_32x32x16_f16(a0, qf[ds], p0, 0, 0, 0);
      p1 = __builtin_amdgcn_mfma_f32_32x32x16_f16(a1, qf[ds], p1, 0, 0, 0);
    }
    float mx = p0[0];
#pragma unroll
    for (int r = 1; r < 16; ++r) mx = fmaxf(mx, p0[r]);
#pragma unroll
    for (int r = 0; r < 16; ++r) mx = fmaxf(mx, p1[r]);
    { const auto rr = __builtin_amdgcn_permlane32_swap(__float_as_uint(mx), __float_as_uint(mx), false, false);
      mx = fmaxf(__uint_as_float(rr[0]), __uint_as_float(rr[1])); }
    const float mnew = fmaxf(m_run, mx);
    const float alpha = __builtin_amdgcn_exp2f(m_run - mnew);
    m_run = mnew;
    float rsum = 0.f;
#pragma unroll
    for (int r = 0; r < 16; ++r) { p0[r] = __builtin_amdgcn_exp2f(p0[r] - mnew); rsum += p0[r]; }
#pragma unroll
    for (int r = 0; r < 16; ++r) { p1[r] = __builtin_amdgcn_exp2f(p1[r] - mnew); rsum += p1[r]; }
    l_run = l_run * alpha + rsum;
    if (__any(alpha != 1.f)) {
#pragma unroll
      for (int r = 0; r < 16; ++r) { o0[r] *= alpha; o1[r] *= alpha; }
    }
#pragma unroll
    for (int kb = 0; kb < 2; ++kb)
#pragma unroll
      for (int s = 0; s < 2; ++s) {
        h16x8 pf;
#pragma unroll
        for (int e = 0; e < 8; ++e) pf[e] = (h16)(kb ? p1[8 * s + e] : p0[8 * s + e]);
        const int koff = (32 * kb + 16 * s + 4 * hi) * 2;
        {
          const h16x4 lo = *reinterpret_cast<const h16x4*>(vs + r32 * 136 + koff), hh = *reinterpret_cast<const h16x4*>(vs + r32 * 136 + koff + 16);
          const h16x8 af = __builtin_shufflevector(lo, hh, 0, 1, 2, 3, 4, 5, 6, 7);
          o0 = __builtin_amdgcn_mfma_f32_32x32x16_f16(af, pf, o0, 0, 0, 0);
        }
        {
          const h16x4 lo = *reinterpret_cast<const h16x4*>(vs + (32 + r32) * 136 + koff), hh = *reinterpret_cast<const h16x4*>(vs + (32 + r32) * 136 + koff + 16);
          const h16x8 af = __builtin_shufflevector(lo, hh, 0, 1, 2, 3, 4, 5, 6, 7);
          o1 = __builtin_amdgcn_mfma_f32_32x32x16_f16(af, pf, o1, 0, 0, 0);
        }
      }
    if (j + 1 < ntiles) swrite((j + 1) & 1);
    __syncthreads();
  }
  const float lt = l_run + __shfl_xor(l_run, 32);
  const float inv = 1.f / lt;
  {
    h16* Os = reinterpret_cast<h16*>(smem);
    h16* orow = Os + (wid * 32 + r32) * 72;
#pragma unroll
    for (int g = 0; g < 4; ++g) {
      h16x4 a, c;
#pragma unroll
      for (int e = 0; e < 4; ++e) { a[e] = (h16)(o0[4 * g + e] * inv); c[e] = (h16)(o1[4 * g + e] * inv); }
      *reinterpret_cast<h16x4*>(orow + 8 * g + 4 * hi) = a;
      *reinterpret_cast<h16x4*>(orow + 32 + 8 * g + 4 * hi) = c;
    }
    __syncthreads();
    const int b = bh >> 3, hd = bh & 7;
    const long tok0 = q0 < SEQ ? (long)b * SEQ + q0 : (long)TLAT + b * CTXL + (q0 - SEQ);
    h16* yb = reinterpret_cast<h16*>(P.ws + OFF_YMLA) + tok0 * 512 + hd * 64;
#pragma unroll
    for (int it = 0; it < 4; ++it) {
      const int chunk = it * 256 + tid, row = chunk >> 3, c8 = (chunk & 7) * 8;
      *reinterpret_cast<uint4*>(yb + (long)row * 512 + c8) = *reinterpret_cast<const uint4*>(Os + row * 72 + c8);
    }
    __syncthreads();
  }
}
DI void item_s5_pass3(const Params& P, int layer, int b, int g, int ck, char* smem) {
  const int lane = tidx() & 63, wid = tidx() >> 6, fr = lane & 15, fq = lane >> 4;
  float* us = reinterpret_cast<float*>(smem + wid * 12800); char* Hs = smem + wid * 12800 + 4096;
  const int tokbase = ck < 4 ? TLAT + b * CTXL + ck * 64 : b * SEQ + (ck - 4) * 64;
  s5_stage_u(reinterpret_cast<const h16*>(P.ws + OFF_U), tokbase, g, us);
  __syncthreads();
  f32x4 yacc[4];
#pragma unroll
  for (int i = 0; i < 4; ++i) yacc[i] = f32x4{0.f, 0.f, 0.f, 0.f};
#pragma unroll
  for (int dir = 0; dir < 2; ++dir) {
    const long gi = (long)(layer * 2 + dir) * 24 + g;
    const float2 a = reinterpret_cast<const float2*>(P.ws + OFF_S5A)[gi * 64 + lane];
    const float2 a64 = reinterpret_cast<const float2*>(P.ws + OFF_S5A64)[gi * 64 + lane];
    const float2* Bb = reinterpret_cast<const float2*>(P.ws + OFF_S5B) + (gi * 64 + lane) * 16;
    float bre[16], bim[16];
#pragma unroll
    for (int c = 0; c < 16; ++c) { const float2 v = Bb[c]; bre[c] = v.x; bim[c] = v.y; }
    const int si = ck < 4 ? (dir ? 3 - ck : ck) : 4 + (dir ? 127 - (ck - 4) : ck - 4);
    const float2* Ep = reinterpret_cast<const float2*>(P.ws + OFF_E) + ((long)((b * 2 + dir) * 24 + g) * 132) * 64 + lane;
    float hr = 0.f, hi = 0.f;
#pragma unroll 16
    for (int i = 0; i < si; ++i) { const float2 e = Ep[(long)i * 64]; const float nr = a64.x * hr - a64.y * hi + e.x, ni = a64.x * hi + a64.y * hr + e.y; hr = nr; hi = ni; }
    const h16* Ct = reinterpret_cast<const h16*>(P.ws + OFF_S5C) + gi * 16 * 128 + fr * 128 + fq * 8;
    h16x8 cf[4];
#pragma unroll
    for (int ks = 0; ks < 4; ++ks) cf[ks] = *reinterpret_cast<const h16x8*>(Ct + ks * 32);
#pragma unroll
    for (int half = 0; half < 2; ++half) {
#pragma unroll 4
      for (int s = 0; s < 32; ++s) {
        const int step = half * 32 + s; const int tau = dir ? 63 - step : step;
        const float4* up = reinterpret_cast<const float4*>(us + tau * 16);
        float br = 0.f, bi = 0.f;
#pragma unroll
        for (int q = 0; q < 4; ++q) { const float4 u = up[q];
          br += bre[q * 4] * u.x + bre[q * 4 + 1] * u.y + bre[q * 4 + 2] * u.z + bre[q * 4 + 3] * u.w;
          bi += bim[q * 4] * u.x + bim[q * 4 + 1] * u.y + bim[q * 4 + 2] * u.z + bim[q * 4 + 3] * u.w; }
        const float nr = a.x * hr - a.y * hi + br, ni = a.x * hi + a.y * hr + bi; hr = nr; hi = ni;
        h16* hrow = reinterpret_cast<h16*>(Hs + (tau & 31) * 272);
        hrow[lane] = (h16)hr; hrow[64 + lane] = (h16)hi;
      }
      __syncthreads();
      const int tb = dir ? 1 - half : half;
#pragma unroll
      for (int sb2 = 0; sb2 < 2; ++sb2)
#pragma unroll
        for (int ks = 0; ks < 4; ++ks) {
          const h16x8 bf = *reinterpret_cast<const h16x8*>(Hs + (sb2 * 16 + fr) * 272 + (ks * 32 + fq * 8) * 2);
          yacc[tb * 2 + sb2] = __builtin_amdgcn_mfma_f32_16x16x32_f16(cf[ks], bf, yacc[tb * 2 + sb2], 0, 0, 0);
        }
      __syncthreads();
    }
  }
  const float* dsk = P.in[I_S5D] + layer * 384 + g * 16 + fq * 4;
  h16* Y = reinterpret_cast<h16*>(P.ws + OFF_YS5PRE);
#pragma unroll
  for (int sbi = 0; sbi < 4; ++sbi) {
    const int tl = sbi * 16 + fr; h16x4 o;
#pragma unroll
    for (int j = 0; j < 4; ++j) o[j] = (h16)geluf_(yacc[sbi][j] + dsk[j] * us[tl * 16 + fq * 4 + j]);
    *reinterpret_cast<h16x4*>(Y + (long)(tokbase + tl) * 384 + g * 16 + fq * 4) = o;
  }
  __syncthreads();
}
DI void phase_mix2(const Params& P, int layer, char* smem) {
  if ((gridDim.x & 7) == 0) {
    const int xcd = blockIdx.x & 7, li = blockIdx.x >> 3, nloc = gridDim.x >> 3;
    for (int k = li; k < 512; k += nloc) item_attn(P, xcd + 8 * (k >> 6), (k & 63) * 128, 0, KEYS / 64, smem);
  } else {
    for (int k = blockIdx.x; k < 4096; k += gridDim.x) item_attn(P, k >> 6, (k & 63) * 128, 0, KEYS / 64, smem);
  }
  const int n_actx = layer == 0 ? 128 : 0;
  const int nck = layer == 0 ? 132 : 128;
  const int n_s5 = NBATCH * 24 * nck / 4;
  for (int it = blockIdx.x; it < n_actx + n_s5; it += gridDim.x) {
    if (it < n_actx) { item_attn(P, it >> 1, SEQ + (it & 1) * 128, SEQ, CTXL / 64, smem); continue; }
    const int w = (it - n_actx) * 4 + (tidx() >> 6);
    const int ck = w % nck + (layer == 0 ? 0 : 4); const int r = w / nck;
    item_s5_pass3(P, layer, r / 24, r % 24, ck, smem);
  }
}
DI void item_yhy_transpose(const Params& P, int item, char* smem) {
  h16* T = reinterpret_cast<h16*>(smem);
  const int tid = tidx();
  const int tt = item & 127, ct = (item >> 7) % 6, b = item / (128 * 6);
  const h16* src = reinterpret_cast<const h16*>(P.ws + OFF_PHY) + ((long)b * 1152 + ct * 64) * SEQ + tt * 64;
  h16* dst = reinterpret_cast<h16*>(P.ws + OFF_YHY) + ((long)b * SEQ + tt * 64) * 384 + ct * 64;
#pragma unroll
  for (int i = 0; i < 2; ++i) {
    const int chunk = tid + 256 * i, cr = chunk >> 3, tp = (chunk & 7) * 8;
    const h16x8 v = *reinterpret_cast<const h16x8*>(src + (long)cr * SEQ + tp);
#pragma unroll
    for (int e = 0; e < 8; ++e) T[cr * 66 + tp + e] = v[e];
  }
  __syncthreads();
#pragma unroll
  for (int i = 0; i < 2; ++i) {
    const int chunk = tid + 256 * i, tr = chunk >> 3, cp = (chunk & 7) * 8;
    h16x8 o;
#pragma unroll
    for (int e = 0; e < 8; ++e) o[e] = T[(cp + e) * 66 + tr];
    *reinterpret_cast<h16x8*>(dst + (long)tr * 384 + cp) = o;
  }
  __syncthreads();
}
DI void phase_glu(const Params& P, int layer, char* smem) {
  const int tid = tidx(), lane = tid & 63, wid = tid >> 6, wr = wid >> 1, wc = wid & 1, fr = lane & 15, fq = lane >> 4;
  const h16* A = reinterpret_cast<const h16*>(P.ws + OFF_YS5PRE);
  const h16* W = reinterpret_cast<const h16*>(P.ws + OFF_WT) + (long)layer * WT_LAYER + WT_GLU;
  h16* Y = reinterpret_cast<h16*>(P.ws + OFF_YS5);
#pragma unroll 1
  for (int it = blockIdx.x; it < NBATCH * 6 * 128; it += gridDim.x) item_yhy_transpose(P, it, smem);
  asm volatile("" ::: "memory");
  const int MT = (layer == 0 ? TT : TLAT) / 128;
  const TileWalk tw = tw_init(MT, 6);
  for (int tile = tw.lb; tile < tw_count(tw); tile += tw.nlb) {
    int mt, nt; tw_decode(tw, tile, mt, nt);
    f32x4 acc[4][4]; acc_zero(acc);
    gemm_kloop(acc, A + (long)mt * 128 * 384, 384, 0, 128, W + (long)nt * 128 * 384, 384, 384, smem, opaque_tid());
    {
      float* Zs = reinterpret_cast<float*>(smem);
#pragma unroll
      for (int m = 0; m < 4; ++m)
#pragma unroll
        for (int np = 0; np < 2; ++np)
#pragma unroll
          for (int j = 0; j < 4; ++j)
            Zs[(wr * 64 + m * 16 + fq * 4 + j) * 132 + wc * 32 + np * 16 + fr] = acc[m][2 * np][j] * sigmoidf_(acc[m][2 * np + 1][j]);
      __syncthreads();
      const int t2 = tidx();
#pragma unroll
      for (int it = 0; it < 4; ++it) {
        const int chunk = it * 256 + t2, row = chunk >> 3, c8 = (chunk & 7) * 8;
        const float4 x0 = *reinterpret_cast<const float4*>(Zs + row * 132 + c8), x1 = *reinterpret_cast<const float4*>(Zs + row * 132 + c8 + 4);
        h16x8 o; o[0] = (h16)x0.x; o[1] = (h16)x0.y; o[2] = (h16)x0.z; o[3] = (h16)x0.w; o[4] = (h16)x1.x; o[5] = (h16)x1.y; o[6] = (h16)x1.z; o[7] = (h16)x1.w;
        *reinterpret_cast<h16x8*>(Y + (long)(mt * 128 + row) * 384 + nt * 64 + c8) = o;
      }
      __syncthreads();
    }
  }
}
DI void phase_merge(const Params& P, int layer, char* smem) {
  const h16* H = reinterpret_cast<const h16*>(P.ws + OFF_H1);
  const h16* WL = reinterpret_cast<const h16*>(P.ws + OFF_WT) + (long)layer * WT_LAYER;
  h16* Mg = reinterpret_cast<h16*>(P.ws + OFF_MERGED);
  const int MT = (layer == 0 ? TT : TLAT) / 128;
  const TileWalk tw = tw_init(MT, 8);
  for (int tile = tw.lb; tile < tw_count(tw); tile += tw.nlb) {
    int mt, nt; tw_decode(tw, tile, mt, nt);
    h16* Tmp = reinterpret_cast<h16*>(P.ws + OFF_YS5PRE) + (long)blockIdx.x * 32768;
    h16* Run = Tmp + 16384;
#pragma unroll 1
    for (int br = 0; br < 3; ++br) {
      const h16* Ab; const h16* Wb; int Kb;
      if (br == 0) { Ab = reinterpret_cast<const h16*>(P.ws + OFF_YHY) + (long)mt * 128 * 384; Wb = WL + WT_BRHY + (long)nt * 128 * 384; Kb = 384; }
      else if (br == 1) { Ab = reinterpret_cast<const h16*>(P.ws + OFF_YS5) + (long)mt * 128 * 384; Wb = WL + WT_BRS5 + (long)nt * 128 * 384; Kb = 384; }
      else { Ab = reinterpret_cast<const h16*>(P.ws + OFF_YMLA) + (long)mt * 128 * 512; Wb = WL + WT_BRMLA + (long)nt * 128 * 512; Kb = 512; }
      {
        f32x4 acc[4][4]; acc_zero(acc);
        gemm_kloop(acc, Ab, Kb, 0, 128, Wb, Kb, Kb, smem, opaque_tid());
        const int tid = tidx();
#pragma unroll
        for (int m = 0; m < 4; ++m)
#pragma unroll
          for (int n = 0; n < 4; ++n) {
            h16x4 o; o[0] = (h16)acc[m][n][0]; o[1] = (h16)acc[m][n][1]; o[2] = (h16)acc[m][n][2]; o[3] = (h16)acc[m][n][3];
            *reinterpret_cast<h16x4*>(Tmp + ((m * 4 + n) * 256 + tid) * 4) = o;
          }
      }
      f32x4 acc[4][4]; acc_zero(acc);
      gemm_kloop(acc, H + (long)mt * 128 * LD1, LD1, 0, 128, WL + WT_WGATE + (long)(br * 1024 + nt * 128) * LD1, LD1, 1024, smem, opaque_tid());
      const int tid = tidx();
      h16x4 bv[16], rv[16];
#pragma unroll
      for (int q = 0; q < 16; ++q) bv[q] = *reinterpret_cast<const h16x4*>(Tmp + (q * 256 + tid) * 4);
      if (br > 0) {
#pragma unroll
        for (int q = 0; q < 16; ++q) rv[q] = *reinterpret_cast<const h16x4*>(Run + (q * 256 + tid) * 4);
      } else {
#pragma unroll
        for (int q = 0; q < 16; ++q) rv[q] = h16x4{(h16)0.f, (h16)0.f, (h16)0.f, (h16)0.f};
      }
#pragma unroll
      for (int m = 0; m < 4; ++m)
#pragma unroll
        for (int n = 0; n < 4; ++n)
#pragma unroll
          for (int j = 0; j < 4; ++j) acc[m][n][j] = (float)rv[m * 4 + n][j] + sigmoidf_(acc[m][n][j]) * (float)bv[m * 4 + n][j];
      if (br < 2) {
#pragma unroll
        for (int m = 0; m < 4; ++m)
#pragma unroll
          for (int n = 0; n < 4; ++n) {
            h16x4 o; o[0] = (h16)acc[m][n][0]; o[1] = (h16)acc[m][n][1]; o[2] = (h16)acc[m][n][2]; o[3] = (h16)acc[m][n][3];
            *reinterpret_cast<h16x4*>(Run + ((m * 4 + n) * 256 + tid) * 4) = o;
          }
      } else {
        float* Zs = reinterpret_cast<float*>(smem);
        stage_acc(acc, Zs, tid);
        copy_out_f16(Zs, Mg, (long)mt * 128, LD1, nt * 128, tid);
        __syncthreads();
      }
    }
  }
}
DI void phase_resid(const Params& P, int layer, int stage_src, size_t a_off, int K, long w_off, int gate_idx, char* smem) {
  const int tid = tidx(), lane = tid & 63, wid = tid >> 6, wr = wid >> 1, wc = wid & 1, fr = lane & 15, fq = lane >> 4;
  const h16* A = reinterpret_cast<const h16*>(P.ws + a_off);
  const h16* W = reinterpret_cast<const h16*>(P.ws + OFF_WT) + (long)layer * WT_LAYER + w_off;
  const float* mod = reinterpret_cast<const float*>(P.ws + OFF_MOD) + (long)layer * 9 * 6144 + gate_idx * 1024;
  const int MT = (layer == 0 ? TT : TLAT) / 128;
  const TileWalk tw = tw_init(MT, 8);
  for (int tile = tw.lb; tile < tw_count(tw); tile += tw.nlb) {
    int mt, nt; tw_decode(tw, tile, mt, nt);
    f32x4 acc[4][4]; acc_zero(acc);
    const int ld = K == 1024 ? LD1 : LD2;
    gemm_kloop(acc, A + (long)mt * 128 * ld, ld, 0, 128, W + (long)nt * 128 * ld, ld, K, smem, opaque_tid());
    const Tok tk = tokinfo(mt * 128);
    float* Zs = reinterpret_cast<float*>(smem);
    const int t2 = tidx();
    stage_acc(acc, Zs, t2);
    const int c4 = (t2 & 31) * 4;
    const float4 g4 = *reinterpret_cast<const float4*>(mod + tk.mrow * 6144 + nt * 128 + c4);
#pragma unroll
    for (int it = 0; it < 16; ++it) {
      const int row = it * 8 + (t2 >> 5); const int t = mt * 128 + row;
      const float4 a4 = *reinterpret_cast<const float4*>(Zs + row * 132 + c4);
      const float4 x4 = *reinterpret_cast<const float4*>(xrow_src(P, stage_src, t) + nt * 128 + c4);
      *reinterpret_cast<float4*>(xrow_dst(P, t) + nt * 128 + c4) = make_float4(x4.x + g4.x * a4.x, x4.y + g4.y * a4.y, x4.z + g4.z * a4.z, x4.w + g4.w * a4.w);
    }
    __syncthreads();
  }
}
DI void phase_ffn_up(const Params& P, int layer, char* smem) {
  const int tid = tidx(), lane = tid & 63, wid = tid >> 6, wr = wid >> 1, wc = wid & 1, fr = lane & 15, fq = lane >> 4;
  const h16* H = reinterpret_cast<const h16*>(P.ws + OFF_H2);
  const h16* W = reinterpret_cast<const h16*>(P.ws + OFF_WT) + (long)layer * WT_LAYER + WT_UP;
  h16* F = reinterpret_cast<h16*>(P.ws + OFF_F);
  const float* cw = P.in[I_FCW] + (long)layer * 3 * 5632; const float* cb = P.in[I_FCB] + (long)layer * 5632;
  float* Zs = reinterpret_cast<float*>(smem);
  const int n_mt = 8 * 66 + (layer == 0 ? 8 * 3 : 0);
  const TileWalk tw = tw_init(n_mt, 44);
  for (int tile = tw.lb; tile < tw_count(tw); tile += tw.nlb) {
    int mi, nt; tw_decode(tw, tile, mi, nt);
    int seq0, Ls, ti;
    if (mi < 528) { seq0 = (mi / 66) * SEQ; Ls = SEQ; ti = mi % 66; } else { const int u = mi - 528; seq0 = TLAT + (u / 3) * CTXL; Ls = CTXL; ti = u % 3; }
    const int p0 = ti * 126 - 1;
    const int a_lo = ti == 0 ? 1 : 0, a_hi = min(128, Ls - p0);
    const int nout = min(126, Ls - ti * 126);
    f32x4 acc[4][4]; acc_zero(acc);
    gemm_kloop(acc, H + ((long)seq0 + p0) * LD1, LD1, a_lo, a_hi, W + (long)nt * 128 * LD1, LD1, 1024, smem, opaque_tid());
#pragma unroll
    for (int m = 0; m < 4; ++m)
#pragma unroll
      for (int n = 0; n < 4; ++n)
#pragma unroll
        for (int j = 0; j < 4; ++j)
          Zs[(wr * 64 + m * 16 + fq * 4 + j) * 132 + 2 * (wc * 32 + (n >> 1) * 16 + fr) + (n & 1)] = acc[m][n][j];
    __syncthreads();
    {
      const int jc = tid & 63, rg = tid >> 6;
      const float2* Z2 = reinterpret_cast<const float2*>(Zs);
      const int cu = nt * 64 + jc, cg = 2816 + cu;
      const float wu0 = cw[cu], wu1 = cw[5632 + cu], wu2 = cw[2 * 5632 + cu], bu = cb[cu];
      const float wg0 = cw[cg], wg1 = cw[5632 + cg], wg2 = cw[2 * 5632 + cg], bg = cb[cg];
      const int r0 = rg * 32 + 1, r1 = min(r0 + 31, nout);
      float2 zm = Z2[(r0 - 1) * 66 + jc], z0 = Z2[r0 * 66 + jc];
      h16* fp = F + ((long)seq0 + p0 + r0) * LD2 + cu;
#pragma unroll 4
      for (int r = r0; r <= r1; ++r) {
        const float2 zp = Z2[(r + 1) * 66 + jc];
        const float au = wu0 * zm.x + wu1 * z0.x + wu2 * zp.x + bu;
        const float ag = wg0 * zm.y + wg1 * z0.y + wg2 * zp.y + bg;
        *fp = (h16)(siluf_(au) * ag); fp += LD2;
        zm = z0; z0 = zp;
      }
    }
    __syncthreads();
  }
}
DI void phase_norm2(const Params& P, int layer) { normmod_rows(P, layer, 1, 1, layer == 0 ? TT : TLAT, blockIdx.x, gridDim.x); }

constexpr int N_PHASES = 22;
#ifndef PROBE_REPEAT
#define PROBE_REPEAT 0u
#endif
template <int PH> DI void run_phase_t(const Params& P, char* smem) {
  asm volatile("" ::: "memory");
  if constexpr (PH == 0) phase_prologue(P, smem);
  else if constexpr (PH == 21) phase_final(P);
  else {
    constexpr int layer = (PH - 1) / 10, s = (PH - 1) % 10;
    if constexpr (s == 0) phase_norm1(P, layer, smem);
    else if constexpr (s == 1) phase_gemm_in(P, layer, smem);
    else if constexpr (s == 2) phase_mix1(P, layer, smem);
    else if constexpr (s == 3) phase_mix2(P, layer, smem);
    else if constexpr (s == 4) phase_glu(P, layer, smem);
    else if constexpr (s == 5) phase_merge(P, layer, smem);
    else if constexpr (s == 6) phase_resid(P, layer, layer, OFF_MERGED, 1024, WT_WO, 2, smem);
    else if constexpr (s == 7) phase_norm2(P, layer);
    else if constexpr (s == 8) phase_ffn_up(P, layer, smem);
    else phase_resid(P, layer, 1, OFF_F, 2816, WT_DOWN, 5, smem);
  }
}
DI void run_phase(const Params& P, int ph, char* smem) {
  switch (ph) {
#define RP(i) case i: run_phase_t<i>(P, smem); break;
    RP(0) RP(1) RP(2) RP(3) RP(4) RP(5) RP(6) RP(7) RP(8) RP(9) RP(10) RP(11) RP(12) RP(13) RP(14) RP(15) RP(16) RP(17) RP(18) RP(19) RP(20) RP(21)
#undef RP
    default: break;
  }
}
#ifndef MULTI_LAUNCH
#define MULTI_LAUNCH 0
#endif
#define XB_TMO      128
#define XB_XCNT(j)  (256  + 64 * (j))
#define XB_XSUB(j)  (1280 + 64 * (j))
#define XB_XGEN(j)  (2304 + 64 * (j))
#define XB_TOP      3328
#define XB_TOPGEN   3392
#define XCD_BAR_WORDS 3456
#define XB_SPIN_CAP (1u << 22)
#define LAS __attribute__((address_space(3)))
DI unsigned xb_ld(unsigned* p)              { return __hip_atomic_load(p, __ATOMIC_RELAXED, __HIP_MEMORY_SCOPE_AGENT); }
DI unsigned xb_add(unsigned* p, unsigned v) { return __hip_atomic_fetch_add(p, v, __ATOMIC_RELAXED, __HIP_MEMORY_SCOPE_AGENT); }
DI unsigned xb_xcc_id() { return (unsigned)__builtin_amdgcn_s_getreg((3 << 11) | 20) & 0xFu; }
#define XB_SPIN(cond, bar) do { unsigned _sp = 0; while (cond) { __builtin_amdgcn_s_sleep(1); \
    if ((++_sp & 255u) == 0u) { if (xb_ld(&(bar)[XB_TMO])) break; if (_sp > XB_SPIN_CAP) { atomicAdd(&(bar)[XB_TMO], 1u); break; } } } } while (0)
struct XcdBarrier { unsigned* bar; unsigned x; volatile LAS unsigned* st; };
DI XcdBarrier xcd_barrier_post(unsigned* bar, volatile LAS unsigned* st) {
  XcdBarrier b; b.bar = bar; b.x = xb_xcc_id(); b.st = st;
  if (threadIdx.x == 0) (void)xb_add(&bar[XB_XCNT(b.x)], 1u);
  return b;
}
DI void xcd_barrier_complete(unsigned* bar, unsigned x, unsigned& nloc, unsigned& nx) {
  const unsigned G = gridDim.x * gridDim.y * gridDim.z;
  unsigned sum, cnt, mine, sp = 0u;
  for (;;) {
    sum = 0u; cnt = 0u; mine = 0u;
#pragma unroll
    for (unsigned j = 0; j < 16; ++j) { const unsigned c = xb_ld(&bar[XB_XCNT(j)]); sum += c; cnt += (c > 0u) ? 1u : 0u; mine = (j == x) ? c : mine; }
    if (sum == G) break;
    __builtin_amdgcn_s_sleep(1);
    if ((++sp & 255u) == 0u) { if (xb_ld(&bar[XB_TMO])) break; if (sp > XB_SPIN_CAP) { atomicAdd(&bar[XB_TMO], 1u); break; } }
  }
  nloc = mine > 0u ? mine : 1u; nx = cnt > 0u ? cnt : 1u;
}
DI void xcd_barrier(const XcdBarrier& b) {
  asm volatile("s_waitcnt vmcnt(0)" ::: "memory");
  __syncthreads();
  if (threadIdx.x == 0) {
    unsigned* bar = b.bar;
    __builtin_amdgcn_s_waitcnt(0);
    unsigned nloc = b.st[0], nx = b.st[1];
    if (nloc == 0u) { xcd_barrier_complete(bar, b.x, nloc, nx); b.st[0] = nloc; b.st[1] = nx; }
    const unsigned old = xb_add(&bar[XB_XSUB(b.x)], 1u);
    const unsigned gen = old / nloc;
    if (old + 1u == (gen + 1u) * nloc) {
      __builtin_amdgcn_fence(__ATOMIC_RELEASE, "agent");
      asm volatile("s_waitcnt vmcnt(0)" ::: "memory");
      const unsigned og = xb_add(&bar[XB_TOP], 1u);
      const unsigned tg = og / nx;
      if (og + 1u == (tg + 1u) * nx) xb_add(&bar[XB_TOPGEN], 1u);
      else XB_SPIN(xb_ld(&bar[XB_TOPGEN]) == tg, bar);
      __builtin_amdgcn_fence(__ATOMIC_ACQUIRE, "agent");
      xb_add(&bar[XB_XGEN(b.x)], 1u);
      asm volatile("s_waitcnt vmcnt(0)" ::: "memory");
    } else {
      XB_SPIN(xb_ld(&bar[XB_XGEN(b.x)]) == gen, bar);
      __builtin_amdgcn_fence(__ATOMIC_ACQUIRE, "agent");
      asm volatile("s_waitcnt vmcnt(0)" ::: "memory");
    }
  }
  __syncthreads();
}
__global__ void __launch_bounds__(NTHREADS, 2) fwd_megakernel(Params P) {
  extern __shared__ __attribute__((aligned(16))) char smem[];
  cg::grid_group grid = cg::this_grid();
  volatile LAS unsigned* st = (volatile LAS unsigned*)(smem + SMEM_BYTES - 16);
  if (threadIdx.x == 0) { st[0] = 0u; st[1] = 0u; st[2] = 0u; st[3] = 0u; }
  __syncthreads();
  const XcdBarrier xb = xcd_barrier_post(reinterpret_cast<unsigned*>(P.ws + OFF_BAR), st);
  run_phase_t<0>(P, smem); grid.sync();
#define RP(i) run_phase_t<i>(P, smem); xcd_barrier(xb); if constexpr ((PROBE_REPEAT >> i) & 1) { run_phase_t<i>(P, smem); xcd_barrier(xb); }
  RP(1) RP(2) RP(3) RP(4) RP(5) RP(6) RP(7) RP(8) RP(9) RP(10) RP(11) RP(12) RP(13) RP(14) RP(15) RP(16) RP(17) RP(18) RP(19) RP(20)
#undef RP
#ifdef PROBE_SYNC
  for (int i = 0; i < PROBE_SYNC; ++i) xcd_barrier(xb);
#endif
  run_phase_t<21>(P, smem);
}
#if MULTI_LAUNCH
__global__ void __launch_bounds__(NTHREADS, 2) fwd_phase_kernel(Params P, int ph) {
  extern __shared__ __attribute__((aligned(16))) char smem[];
  run_phase(P, ph, smem);
}
#endif

extern "C" void kernel_launch(void* const* d_in, const int* in_sizes, int n_in, void* d_out, int out_size, void* d_ws, size_t ws_size,
                              hipStream_t stream) {
  static int grid_blocks = 0;
  if (!grid_blocks) {
    int dev = 0, cus = 0, per_cu = 0;
    (void)hipGetDevice(&dev);
    (void)hipDeviceGetAttribute(&cus, hipDeviceAttributeMultiprocessorCount, dev);
    (void)hipFuncSetAttribute((const void*)fwd_megakernel, hipFuncAttributeMaxDynamicSharedMemorySize, SMEM_BYTES);
#if MULTI_LAUNCH
    (void)hipFuncSetAttribute((const void*)fwd_phase_kernel, hipFuncAttributeMaxDynamicSharedMemorySize, SMEM_BYTES);
#endif
    (void)hipOccupancyMaxActiveBlocksPerMultiprocessor(&per_cu, fwd_megakernel, NTHREADS, SMEM_BYTES);
    if (per_cu > 2) per_cu = 2;
    if (per_cu < 1) per_cu = 1;
#ifdef PROBE_FORCE2
    per_cu = 2;
#endif
    grid_blocks = cus * per_cu;
    if (ws_size < OFF_END) fprintf(stderr, "workspace too small: %zu < %zu\n", ws_size, (size_t)OFF_END);
  }
  Params p{};
  for (int i = 0; i < 41; ++i) p.in[i] = (const float*)d_in[i];
  p.out = (float*)d_out; p.ws = (char*)d_ws; p.pad_ = 0;
#if MULTI_LAUNCH
  for (int ph = 0; ph < N_PHASES; ++ph) hipLaunchKernelGGL(fwd_phase_kernel, dim3(grid_blocks), dim3(NTHREADS), SMEM_BYTES, stream, p, ph);
#else
  (void)hipMemsetAsync((char*)d_ws + OFF_BAR, 0, XCD_BAR_WORDS * 4, stream);
  void* args[] = {&p};
  hipError_t e = hipLaunchCooperativeKernel((void*)fwd_megakernel, dim3(grid_blocks), dim3(NTHREADS), args, SMEM_BYTES, stream);
  if (e != hipSuccess) fprintf(stderr, "cooperative launch failed: %s (grid %d)\n", hipGetErrorString(e), grid_blocks);
#endif
}
```

```cpp
#include <hip/hip_runtime.h>
#include <hip/hip_cooperative_groups.h>
#include <cstdio>
namespace cg = cooperative_groups;

typedef _Float16 h16;
typedef _Float16 h16x8 __attribute__((ext_vector_type(8)));
typedef _Float16 h16x4 __attribute__((ext_vector_type(4)));
typedef float f32x4 __attribute__((ext_vector_type(4)));
typedef float f32x16 __attribute__((ext_vector_type(16)));
#define DI __device__ __forceinline__

constexpr int DM = 1024, NBATCH = 8, SEQ = 8192, CTXL = 256, TLAT = 65536, TCTX = 2048, TT = 67584;
constexpr int KEYS = SEQ + CTXL;
constexpr int NTHREADS = 256;
constexpr float EPS = 1e-6f;
constexpr float QSCALE = 0.10206207261596575f * 1.4426950408889634f;

constexpr int LD1 = 1088, LD2 = 2880;
constexpr long WT_WIN = 0, WT_WGATE = WT_WIN + 2432L * LD1, WT_UKV = WT_WGATE + 3072L * LD1, WT_UQ = WT_UKV + 1024L * 256,
               WT_GLU = WT_UQ + 1024L * 512, WT_BRHY = WT_GLU + 768L * 384, WT_BRS5 = WT_BRHY + 1024L * 384,
               WT_BRMLA = WT_BRS5 + 1024L * 384, WT_WO = WT_BRMLA + 1024L * 512, WT_UP = WT_WO + 1024L * LD1,
               WT_DOWN = WT_UP + 5632L * LD1, WT_LAYER = WT_DOWN + 1024L * LD2;
constexpr size_t al256(size_t x) { return (x + 255) / 256 * 256; }
constexpr size_t OFF_WT = 0;
constexpr size_t OFF_H1 = al256(OFF_WT + 2 * WT_LAYER * 2);
constexpr size_t OFF_U = al256(OFF_H1 + (size_t)TT * LD1 * 2);
constexpr size_t OFF_KVLAT = al256(OFF_U + (size_t)TT * 384 * 2);
constexpr size_t OFF_QLAT = al256(OFF_KVLAT + (size_t)TT * 256 * 2);
constexpr size_t OFF_PHY = al256(OFF_QLAT + (size_t)TT * 512 * 2);
constexpr size_t OFF_PHYC = al256(OFF_PHY + (size_t)NBATCH * 1152 * SEQ * 2);
constexpr size_t OFF_Q = al256(OFF_PHYC + (size_t)NBATCH * 1152 * CTXL * 2);
constexpr size_t OFF_K = al256(OFF_Q + (size_t)64 * KEYS * 96 * 2);
constexpr size_t OFF_VT = al256(OFF_K + (size_t)64 * KEYS * 96 * 2);
constexpr size_t OFF_YS5PRE = al256(OFF_VT + (size_t)64 * 64 * KEYS * 2);
constexpr size_t OFF_YHY = al256(OFF_YS5PRE + (size_t)TT * 384 * 2);
constexpr size_t OFF_FILT = al256(OFF_YHY + (size_t)TT * 384 * 2);
constexpr size_t OFF_TAPSC = al256(OFF_FILT + (size_t)768 * 2 * SEQ * 8);
constexpr size_t OFF_E = al256(OFF_TAPSC + (size_t)768 * 2 * CTXL * 4);
constexpr size_t OFF_XC = al256(OFF_E + (size_t)NBATCH * 2 * 24 * 132 * 64 * 8);
constexpr size_t OFF_MOD = al256(OFF_XC + (size_t)TCTX * 1024 * 4);
constexpr size_t OFF_Z2 = al256(OFF_MOD + (size_t)2 * 9 * 6144 * 4);
constexpr size_t OFF_Z2C = al256(OFF_Z2 + (size_t)2 * SEQ * 64 * 4);
constexpr size_t OFF_S5A = al256(OFF_Z2C + (size_t)2 * CTXL * 64 * 4);
constexpr size_t OFF_S5A64 = al256(OFF_S5A + (size_t)2 * 2 * 24 * 64 * 8);
constexpr size_t OFF_S5B = al256(OFF_S5A64 + (size_t)2 * 2 * 24 * 64 * 8);
constexpr size_t OFF_S5C = al256(OFF_S5B + (size_t)2 * 2 * 24 * 64 * 16 * 8);
constexpr size_t OFF_ROPE = al256(OFF_S5C + (size_t)2 * 2 * 24 * 16 * 128 * 2);
constexpr size_t OFF_BAR = al256(OFF_ROPE + (size_t)SEQ * 16 * 8);
constexpr size_t OFF_END = al256(OFF_BAR + (size_t)3456 * 4);
constexpr size_t OFF_YS5 = OFF_U, OFF_YMLA = OFF_QLAT, OFF_MERGED = OFF_Q, OFF_F = OFF_U, OFF_H2 = OFF_H1;
static_assert(OFF_END <= (size_t)1024 * 1024 * 1024, "workspace over 1 GiB");
static_assert(OFF_F + (size_t)TT * LD2 * 2 <= OFF_FILT, "f alias overruns");
static_assert(OFF_MERGED + (size_t)TT * LD1 * 2 <= OFF_VT, "merged alias overruns");

constexpr int SMEM_BYTES = 73728 + 2048;

struct Params {
  const float* in[41];
  float* out;
  char* ws;
  unsigned long long pad_;
};
enum { I_X = 0, I_C, I_CTX, I_CCTX, I_WMOD, I_BMOD, I_N1G, I_N2G, I_WIN, I_HCW, I_HCB, I_FW1, I_FB1, I_FW2, I_FB2, I_FW3, I_FFREQ,
       I_FDECAY, I_HBIAS, I_LAMRE, I_LAMIM, I_LOGSTEP, I_BRE, I_BIM, I_CRE, I_CIM, I_S5D, I_WGLU, I_GQ, I_WUQ, I_GKV, I_WUKV,
       I_WBRHY, I_WBRS5, I_WBRMLA, I_WO, I_WUP, I_FCW, I_FCB, I_WDOWN, I_FINALG };

DI int tidx() { int t = threadIdx.x; asm volatile("" : "+v"(t)); return t; }
DI int opaque_tid() { return tidx(); }
DI float sigmoidf_(float x) { return 1.f / (1.f + __expf(-x)); }
DI float siluf_(float x) { return x / (1.f + __expf(-x)); }
DI float geluf_(float x) { float z = 0.7978845608028654f * (x + 0.044715f * x * x * x); float t = 1.f - 2.f / (1.f + __expf(2.f * z)); return 0.5f * x * (1.f + t); }
DI float wave_sum(float v) { for (int o = 32; o > 0; o >>= 1) v += __shfl_xor(v, o); return v; }
DI float wave_max(float v) { for (int o = 32; o > 0; o >>= 1) v = fmaxf(v, __shfl_xor(v, o)); return v; }
DI void dsincos(double x, double& s, double& c) {
  const double TWO_PI = 6.283185307179586476925287;
  double r = x - TWO_PI * rint(x / TWO_PI);
  double r2 = r * r, ts = r, tc = 1.0; s = r; c = 1.0;
  for (int k = 1; k <= 15; ++k) { tc = -tc * r2 / (double)((2 * k - 1) * (2 * k)); c += tc; ts = -ts * r2 / (double)((2 * k) * (2 * k + 1)); s += ts; }
}
DI float2 twid(float f) { return make_float2(__builtin_amdgcn_cosf(f), __builtin_amdgcn_sinf(f)); }
DI float2 cmul(float2 a, float2 b) { return make_float2(a.x * b.x - a.y * b.y, a.x * b.y + a.y * b.x); }

struct Tok { int b, pos, ctx, mrow; };
DI Tok tokinfo(int t) { Tok k; if (t < TLAT) { k.b = t >> 13; k.pos = t & 8191; k.ctx = 0; k.mrow = k.b; } else { int u = t - TLAT; k.b = u >> 8; k.pos = u & 255; k.ctx = 1; k.mrow = 8; } return k; }

struct Stg { uint4 a0, a1, a2, a3, b0, b1, b2, b3; };
DI void g_load(Stg& s, const h16* __restrict__ A0, const h16* __restrict__ A1, const h16* __restrict__ A2, const h16* __restrict__ A3,
               const h16* __restrict__ Bp, long b32, int k0) {
  s.a0 = *reinterpret_cast<const uint4*>(A0 + k0); s.a1 = *reinterpret_cast<const uint4*>(A1 + k0);
  s.a2 = *reinterpret_cast<const uint4*>(A2 + k0); s.a3 = *reinterpret_cast<const uint4*>(A3 + k0);
  s.b0 = *reinterpret_cast<const uint4*>(Bp + k0); s.b1 = *reinterpret_cast<const uint4*>(Bp + b32 + k0);
  s.b2 = *reinterpret_cast<const uint4*>(Bp + 2 * b32 + k0); s.b3 = *reinterpret_cast<const uint4*>(Bp + 3 * b32 + k0);
}
DI uint4 zsel(uint4 v, bool ok) { return ok ? v : make_uint4(0, 0, 0, 0); }
DI void s_write(char* sw, const Stg& s, int okm) {
  *reinterpret_cast<uint4*>(sw) = zsel(s.a0, okm & 1); *reinterpret_cast<uint4*>(sw + 32 * 128) = zsel(s.a1, okm & 2);
  *reinterpret_cast<uint4*>(sw + 64 * 128) = zsel(s.a2, okm & 4); *reinterpret_cast<uint4*>(sw + 96 * 128) = zsel(s.a3, okm & 8);
  *reinterpret_cast<uint4*>(sw + 16384) = s.b0; *reinterpret_cast<uint4*>(sw + 16384 + 32 * 128) = s.b1; *reinterpret_cast<uint4*>(sw + 16384 + 64 * 128) = s.b2; *reinterpret_cast<uint4*>(sw + 16384 + 96 * 128) = s.b3;
}
#ifndef PROBE_MFMA
#define PROBE_MFMA 0
#endif
#if PROBE_MFMA
DI void mma_step(f32x4 (&acc)[4][4], const char* sa, const char* sb, int o0, int o1, f32x4 (&dmy)[2][4]) {
#else
DI void mma_step(f32x4 (&acc)[4][4], const char* sa, const char* sb, int o0, int o1) {
#endif
#pragma unroll
  for (int ks = 0; ks < 2; ++ks) {
    h16x8 af[4], bf[4];
    const int o = ks ? o1 : o0;
#pragma unroll
    for (int m = 0; m < 4; ++m) af[m] = *reinterpret_cast<const h16x8*>(sa + m * 16 * 128 + o);
#pragma unroll
    for (int n = 0; n < 4; ++n) bf[n] = *reinterpret_cast<const h16x8*>(sb + n * 16 * 128 + o);
    __builtin_amdgcn_s_setprio(1);
#pragma unroll
    for (int m = 0; m < 4; ++m)
#pragma unroll
      for (int n = 0; n < 4; ++n) acc[m][n] = __builtin_amdgcn_mfma_f32_16x16x32_f16(af[m], bf[n], acc[m][n], 0, 0, 0);
    __builtin_amdgcn_s_setprio(0);
#if PROBE_MFMA
#pragma unroll
    for (int m = 0; m < 2; ++m)
#pragma unroll
      for (int n = 0; n < 4; ++n) dmy[m][n] = __builtin_amdgcn_mfma_f32_16x16x32_f16(af[m + 2], bf[n], dmy[m][n], 0, 0, 0);
#endif
  }
}
DI void gemm_kloop_body(f32x4 (&acc)[4][4], const h16* __restrict__ A, long lda, int a_lo, int a_hi,
                   const h16* __restrict__ Bt, long ldb, int K, char* smem, int tid) {
  const int lane = tid & 63, wid = tid >> 6, wr = wid >> 1, wc = wid & 1, fr = lane & 15, fq = lane >> 4;
#if PROBE_MFMA
  f32x4 dmy[2][4];
  for (int m = 0; m < 2; ++m) for (int n = 0; n < 4; ++n) dmy[m][n] = f32x4{0.f, 0.f, 0.f, 0.f};
#define MMA(a, b, c, d, e) mma_step(a, b, c, d, e, dmy)
#else
#define MMA(a, b, c, d, e) mma_step(a, b, c, d, e)
#endif
  Stg s0, s1;
  const int srow = tid >> 3, skc = tid & 7;
  int okm = 0;
  const h16* Ar[4];
#pragma unroll
  for (int i = 0; i < 4; ++i) { const int row = srow + 32 * i; const bool ok = row >= a_lo && row < a_hi; okm |= ok ? (1 << i) : 0;
    const int rc = min(max(row, a_lo), a_hi - 1); Ar[i] = A + (long)rc * lda + skc * 8; }
  const h16* Bp = Bt + (long)srow * ldb + skc * 8;
  const long b32 = 32 * ldb;
  char* sw = smem + srow * 128 + ((skc ^ ((srow >> 1) & 7)) << 4);
  const char* sra = smem + (wr * 64 + fr) * 128; const char* srb = smem + 16384 + (wc * 64 + fr) * 128;
  const int o0 = (fq ^ ((fr >> 1) & 7)) << 4, o1 = ((4 + fq) ^ ((fr >> 1) & 7)) << 4;
  const int nk = K >> 6;
  g_load(s0, Ar[0], Ar[1], Ar[2], Ar[3], Bp, b32, 0); g_load(s1, Ar[0], Ar[1], Ar[2], Ar[3], Bp, b32, 64);
  s_write(sw, s0, okm); __syncthreads();
  for (int kt = 0; kt + 2 < nk; kt += 2) {
    g_load(s0, Ar[0], Ar[1], Ar[2], Ar[3], Bp, b32, (kt + 2) << 6);
    __builtin_amdgcn_sched_barrier(0);
    MMA(acc, sra, srb, o0, o1);
    __builtin_amdgcn_sched_barrier(0);
    s_write(sw + 32768, s1, okm);
    __syncthreads();
    g_load(s1, Ar[0], Ar[1], Ar[2], Ar[3], Bp, b32, (kt + 3) << 6);
    __builtin_amdgcn_sched_barrier(0);
    MMA(acc, sra + 32768, srb + 32768, o0, o1);
    __builtin_amdgcn_sched_barrier(0);
    s_write(sw, s0, okm);
    __syncthreads();
  }
  MMA(acc, sra, srb, o0, o1);
  s_write(sw + 32768, s1, okm);
  __syncthreads();
  MMA(acc, sra + 32768, srb + 32768, o0, o1);
  __syncthreads();
#if PROBE_MFMA
  { float z = 0.f; asm volatile("" : "+v"(z)); for (int m = 0; m < 2; ++m) for (int n = 0; n < 4; ++n) acc[m][n] += dmy[m][n] * z; }
#endif
#undef MMA
}
#ifndef PROBE_KLOOP
#define PROBE_KLOOP 0
#endif
DI void gemm_kloop(f32x4 (&acc)[4][4], const h16* __restrict__ A, long lda, int a_lo, int a_hi,
                   const h16* __restrict__ Bt, long ldb, int K, char* smem, int tid) {
  gemm_kloop_body(acc, A, lda, a_lo, a_hi, Bt, ldb, K, smem, tid);
}
struct TileWalk { int lb, nlb, m0, Mx, NT, nfull; };
DI TileWalk tw_init(int MT, int NT) { TileWalk w; w.lb = blockIdx.x >> 3; w.nlb = gridDim.x >> 3; w.Mx = MT >> 3; w.m0 = (blockIdx.x & 7) * w.Mx; w.NT = NT; w.nfull = (w.Mx >> 3) * 8 * NT; return w; }
DI int tw_count(const TileWalk& w) { return w.Mx * w.NT; }
DI void tw_decode(const TileWalk& w, int idx, int& mt, int& nt) {
  if (idx < w.nfull) { const int mg = idx / (8 * w.NT), r = idx % (8 * w.NT); nt = r >> 3; mt = w.m0 + mg * 8 + (r & 7); }
  else { const int rem = w.Mx & 7, r = idx - w.nfull; nt = r / rem; mt = w.m0 + (w.Mx & ~7) + r % rem; }
}
DI void stage_acc(const f32x4 (&acc)[4][4], float* Zs, int tid) {
  const int lane = tid & 63, wid = tid >> 6, wr = wid >> 1, wc = wid & 1, fr = lane & 15, fq = lane >> 4;
#pragma unroll
  for (int m = 0; m < 4; ++m)
#pragma unroll
    for (int n = 0; n < 4; ++n)
#pragma unroll
      for (int j = 0; j < 4; ++j) Zs[(wr * 64 + m * 16 + fq * 4 + j) * 132 + wc * 64 + n * 16 + fr] = acc[m][n][j];
  __syncthreads();
}
DI void stage_acc_t(const f32x4 (&acc)[4][4], float* Zs, int tid) {
  const int lane = tid & 63, wid = tid >> 6, wr = wid >> 1, wc = wid & 1, fr = lane & 15, fq = lane >> 4;
#pragma unroll
  for (int m = 0; m < 4; ++m)
#pragma unroll
    for (int n = 0; n < 4; ++n)
      *reinterpret_cast<float4*>(Zs + (wc * 64 + n * 16 + fr) * 132 + wr * 64 + m * 16 + fq * 4) = make_float4(acc[m][n][0], acc[m][n][1], acc[m][n][2], acc[m][n][3]);
  __syncthreads();
}
DI void copy_out_f16(const float* Zs, h16* __restrict__ dst, long row0, long ld, int cb, int tid) {
#pragma unroll
  for (int it = 0; it < 8; ++it) {
    const int chunk = it * 256 + tid, row = chunk >> 4, c8 = (chunk & 15) * 8;
    const float4 x0 = *reinterpret_cast<const float4*>(Zs + row * 132 + c8), x1 = *reinterpret_cast<const float4*>(Zs + row * 132 + c8 + 4);
    h16x8 o; o[0] = (h16)x0.x; o[1] = (h16)x0.y; o[2] = (h16)x0.z; o[3] = (h16)x0.w; o[4] = (h16)x1.x; o[5] = (h16)x1.y; o[6] = (h16)x1.z; o[7] = (h16)x1.w;
    *reinterpret_cast<h16x8*>(dst + (row0 + row) * ld + cb + c8) = o;
  }
}
DI void acc_zero(f32x4 (&acc)[4][4]) {
#pragma unroll
  for (int m = 0; m < 4; ++m)
#pragma unroll
    for (int n = 0; n < 4; ++n) acc[m][n] = f32x4{0.f, 0.f, 0.f, 0.f};
}
DI void row_rms(const h16* __restrict__ A, long lda, int K, float* rs) {
  const int tid = tidx(), row = tid >> 1, half = tid & 1;
  const h16* p = A + (long)row * lda + half * (K >> 1);
  float ss = 0.f;
  for (int k = 0; k < (K >> 1); k += 8) {
    h16x8 v = *reinterpret_cast<const h16x8*>(p + k);
#pragma unroll
    for (int j = 0; j < 8; ++j) { float f = (float)v[j]; ss += f * f; }
  }
  ss += __shfl_xor(ss, 1);
  if (half == 0) rs[row] = rsqrtf(ss / (float)K + EPS);
}
DI int map_interleave(int n, int half) { int tile = n >> 7, r = n & 127, sub = r >> 4, fr = r & 15; int j = tile * 64 + (sub >> 1) * 16 + fr; return (sub & 1) ? half + j : j; }
DI int map_col(int mat, int n) {
  switch (mat) {
    case 0: if (n < 640) return n; if (n < 2304) return n + 32; if (n < 2336) return n - 2304 + 640; return -1;
    case 1: return 2336 + n;
    case 3: { int h = n >> 7, j = n & 127; return j < 96 ? h * 96 + j : -1; }
    case 4: return map_interleave(n, 384);
    case 9: return map_interleave(n, 2816);
    default: return n;
  }
}
struct MatDesc { const float* src; const float* scale; long dst; int K, Nmy, Nsrc, ld; };
DI MatDesc get_mat(const Params& P, int layer, int mat) {
  MatDesc d; d.scale = nullptr;
  d.ld = (mat == 0 || mat == 1 || mat == 8 || mat == 9) ? LD1 : 0;
  switch (mat) {
    case 0: d.src = P.in[I_WIN] + (long)layer * 1024 * 5408; d.dst = WT_WIN; d.K = 1024; d.Nmy = 2432; d.Nsrc = 5408; break;
    case 1: d.src = P.in[I_WIN] + (long)layer * 1024 * 5408; d.dst = WT_WGATE; d.K = 1024; d.Nmy = 3072; d.Nsrc = 5408; break;
    case 2: d.src = P.in[I_WUKV] + (long)layer * 256 * 1024; d.dst = WT_UKV; d.K = 256; d.Nmy = 1024; d.Nsrc = 1024; d.scale = P.in[I_GKV] + layer * 256; break;
    case 3: d.src = P.in[I_WUQ] + (long)layer * 512 * 768; d.dst = WT_UQ; d.K = 512; d.Nmy = 1024; d.Nsrc = 768; d.scale = P.in[I_GQ] + layer * 512; break;
    case 4: d.src = P.in[I_WGLU] + (long)layer * 384 * 768; d.dst = WT_GLU; d.K = 384; d.Nmy = 768; d.Nsrc = 768; break;
    case 5: d.src = P.in[I_WBRHY] + (long)layer * 384 * 1024; d.dst = WT_BRHY; d.K = 384; d.Nmy = 1024; d.Nsrc = 1024; break;
    case 6: d.src = P.in[I_WBRS5] + (long)layer * 384 * 1024; d.dst = WT_BRS5; d.K = 384; d.Nmy = 1024; d.Nsrc = 1024; break;
    case 7: d.src = P.in[I_WBRMLA] + (long)layer * 512 * 1024; d.dst = WT_BRMLA; d.K = 512; d.Nmy = 1024; d.Nsrc = 1024; break;
    case 8: d.src = P.in[I_WO] + (long)layer * 1024 * 1024; d.dst = WT_WO; d.K = 1024; d.Nmy = 1024; d.Nsrc = 1024; break;
    case 9: d.src = P.in[I_WUP] + (long)layer * 1024 * 5632; d.dst = WT_UP; d.K = 1024; d.Nmy = 5632; d.Nsrc = 5632; break;
    default: d.src = P.in[I_WDOWN] + (long)layer * 2816 * 1024; d.dst = WT_DOWN; d.K = 2816; d.Nmy = 1024; d.Nsrc = 1024; d.ld = LD2; break;
  }
  if (d.ld == 0) d.ld = d.K;
  return d;
}
constexpr int WT_TILES_PER_LAYER = 608 + 768 + 64 + 128 + 72 + 96 + 96 + 128 + 256 + 1408 + 704;
DI void item_wt(const Params& P, int item, char* smem) {
  const int layer = item / WT_TILES_PER_LAYER; int r = item % WT_TILES_PER_LAYER;
  const int cnt[11] = {608, 768, 64, 128, 72, 96, 96, 128, 256, 1408, 704};
  int mat = 0;
#pragma unroll
  for (int i = 0; i < 10; ++i) { if (mat == i && r >= cnt[i]) { r -= cnt[i]; mat = i + 1; } }
  MatDesc d = get_mat(P, layer, mat);
  const int kt = d.K >> 6, n0 = (r / kt) * 64, k0 = (r % kt) * 64;
  float* tile = reinterpret_cast<float*>(smem);
  h16* dst = reinterpret_cast<h16*>(P.ws + OFF_WT) + (long)layer * WT_LAYER + d.dst;
  const int tid = tidx(), lx = tid & 63, ly = tid >> 6;
  const int sc = map_col(mat, n0 + lx);
#pragma unroll 4
  for (int i = 0; i < 16; ++i) { int kk = i * 4 + ly; tile[kk * 65 + lx] = sc >= 0 ? d.src[(long)(k0 + kk) * d.Nsrc + sc] : 0.f; }
  __syncthreads();
  const float s = d.scale ? d.scale[k0 + lx] : 1.f;
#pragma unroll 4
  for (int i = 0; i < 16; ++i) { int nn = i * 4 + ly; dst[(long)(n0 + nn) * d.ld + k0 + lx] = (h16)(tile[lx * 65 + nn] * s); }
  __syncthreads();
}
DI void item_mod(const Params& P, int item, char* smem) {
  const int layer = item / 96, n0 = (item % 96) * 64;
  float* s = reinterpret_cast<float*>(smem);
  float* part = s + 9 * 1024;
  const int tid = tidx(), lane = tid & 63, wid = tid >> 6;
  for (int i = tid; i < 9 * 1024; i += NTHREADS) { float v = i < 8192 ? P.in[I_C][i] : P.in[I_CCTX][i - 8192]; s[i] = siluf_(v); }
  __syncthreads();
  const float* w = P.in[I_WMOD] + (long)layer * 1024 * 6144 + n0 + lane;
  float acc[9];
#pragma unroll
  for (int r = 0; r < 9; ++r) acc[r] = 0.f;
#pragma unroll 32
  for (int k = wid * 256; k < wid * 256 + 256; ++k) {
    const float wv = w[(long)k * 6144];
#pragma unroll
    for (int r = 0; r < 9; ++r) acc[r] += s[r * 1024 + k] * wv;
  }
#pragma unroll
  for (int r = 0; r < 9; ++r) part[(wid * 9 + r) * 64 + lane] = acc[r];
  __syncthreads();
  float* mod = reinterpret_cast<float*>(P.ws + OFF_MOD) + (long)layer * 9 * 6144;
  for (int i = tid; i < 9 * 64; i += NTHREADS) {
    const int r = i >> 6, c = i & 63;
    mod[r * 6144 + n0 + c] = part[(0 * 9 + r) * 64 + c] + part[(1 * 9 + r) * 64 + c] + part[(2 * 9 + r) * 64 + c] + part[(3 * 9 + r) * 64 + c] + P.in[I_BMOD][layer * 6144 + n0 + c];
  }
  __syncthreads();
}
DI void item_hymlp(const Params& P, int item, char* smem) {
  const int layer = item / 132; int r = item % 132;
  const int isc = r >= 128; const int Lf = isc ? CTXL : SEQ; const int t0 = (isc ? r - 128 : r) * 64;
  float* z1 = reinterpret_cast<float*>(smem);
  const int tid = tidx(), tl = tid >> 2, h0 = (tid & 3) * 16; const int t = t0 + tl;
  const float* w1 = P.in[I_FW1] + layer * 17 * 64; const float* b1 = P.in[I_FB1] + layer * 64;
  const float* w2 = P.in[I_FW2] + layer * 64 * 64; const float* b2 = P.in[I_FB2] + layer * 64; const float* fq = P.in[I_FFREQ] + layer * 64;
  float feat[17]; feat[0] = (float)t / (float)Lf;
#pragma unroll
  for (int k = 1; k <= 8; ++k) { float rev = (float)((t * k) % Lf) / (float)Lf; feat[k] = __builtin_amdgcn_cosf(rev); feat[8 + k] = __builtin_amdgcn_sinf(rev); }
#pragma unroll 4
  for (int j = 0; j < 16; ++j) {
    const int h = h0 + j; float a = b1[h];
#pragma unroll
    for (int f = 0; f < 17; ++f) a += feat[f] * w1[f * 64 + h];
    z1[tl * 65 + h] = __sinf(fq[h] * a);
  }
  __syncthreads();
  float* z2 = isc ? reinterpret_cast<float*>(P.ws + OFF_Z2C) + (long)layer * CTXL * 64 : reinterpret_cast<float*>(P.ws + OFF_Z2) + (long)layer * SEQ * 64;
  float a2[16];
#pragma unroll
  for (int j = 0; j < 16; ++j) a2[j] = b2[h0 + j];
  for (int k = 0; k < 64; ++k) {
    const float zv = z1[tl * 65 + k];
#pragma unroll
    for (int j = 0; j < 16; ++j) a2[j] += zv * w2[k * 64 + h0 + j];
  }
#pragma unroll
  for (int j = 0; j < 16; ++j) z2[(long)t * 64 + h0 + j] = __sinf(fq[h0 + j] * a2[j]);
  __syncthreads();
}
DI void item_s5disc(const Params& P, int item) {
  const int layer = item / 12, dir = (item % 12) / 6, gb = item % 6;
  const int tid = tidx(), g = gb * 4 + (tid >> 6), n = tid & 63;
  const int ld = layer * 2 + dir; const long gi = (long)ld * 24 + g;
  const double lre = P.in[I_LAMRE][gi * 64 + n], lim = P.in[I_LAMIM][gi * 64 + n];
  const double step = exp((double)P.in[I_LOGSTEP][gi]);
  double sn, cs; dsincos(lim * step, sn, cs);
  const double mag = exp(lre * step);
  const double are = mag * cs, aim = mag * sn;
  const double nr = are - 1.0, ni = aim, den = lre * lre + lim * lim;
  const double fre = (nr * lre + ni * lim) / den, fim = (ni * lre - nr * lim) / den;
  float2* A = reinterpret_cast<float2*>(P.ws + OFF_S5A); float2* A64 = reinterpret_cast<float2*>(P.ws + OFF_S5A64);
  A[gi * 64 + n] = make_float2((float)are, (float)aim);
  double pr = are, pi = aim;
  for (int i = 0; i < 6; ++i) { double t = pr * pr - pi * pi; pi = 2.0 * pr * pi; pr = t; }
  A64[gi * 64 + n] = make_float2((float)pr, (float)pi);
  float2* Bb = reinterpret_cast<float2*>(P.ws + OFF_S5B) + (gi * 64 + n) * 16;
  const float* bre = P.in[I_BRE] + (gi * 64 + n) * 16; const float* bim = P.in[I_BIM] + (gi * 64 + n) * 16;
  for (int c = 0; c < 16; ++c) { double br = bre[c], bi = bim[c]; Bb[c] = make_float2((float)(fre * br - fim * bi), (float)(fre * bi + fim * br)); }
  h16* Ct = reinterpret_cast<h16*>(P.ws + OFF_S5C) + gi * 16 * 128;
  const float* cre = P.in[I_CRE] + gi * 16 * 64; const float* cim = P.in[I_CIM] + gi * 16 * 64;
  for (int c = 0; c < 16; ++c) { Ct[c * 128 + n] = (h16)cre[c * 64 + n]; Ct[c * 128 + 64 + n] = (h16)(-cim[c * 64 + n]); }
}
DI void item_rope(const Params& P, int item) {
  const int idx = item * NTHREADS + tidx(); const int pos = idx >> 4, i = idx & 15;
  const double inv[8] = {1.0, 0.31622776601683794, 0.1, 0.031622776601683794, 0.01, 0.0031622776601683794, 0.001, 0.00031622776601683794};
  double iv = 1.0;
#pragma unroll
  for (int k = 0; k < 8; ++k) if ((i & 7) == k) iv = inv[k];
  const double ang = (double)(i < 8 ? (pos >> 6) : (pos & 63)) * iv;
  double s, c; dsincos(ang, s, c);
  reinterpret_cast<float2*>(P.ws + OFF_ROPE)[idx] = make_float2((float)c, (float)s);
}
constexpr int PRO_N_WT = 2 * WT_TILES_PER_LAYER, PRO_N_MOD = 192, PRO_N_HY = 264, PRO_N_S5 = 24, PRO_N_ROPE = 512;
DI void phase_prologue(const Params& P, char* smem) {
  const int total = PRO_N_MOD + PRO_N_HY + PRO_N_S5 + PRO_N_ROPE + PRO_N_WT;
  for (int it = blockIdx.x; it < total; it += gridDim.x) {
    int i = it;
    if (i < PRO_N_MOD) { item_mod(P, i, smem); continue; } i -= PRO_N_MOD;
    if (i < PRO_N_HY) { item_hymlp(P, i, smem); continue; } i -= PRO_N_HY;
    if (i < PRO_N_S5) { item_s5disc(P, i); continue; } i -= PRO_N_S5;
    if (i < PRO_N_ROPE) { item_rope(P, i); continue; } i -= PRO_N_ROPE;
    item_wt(P, i, smem);
  }
}

DI const float* xrow_src(const Params& P, int layer_stage, int t) {
  if (t < TLAT) return (layer_stage == 0 ? P.in[I_X] : P.out) + (long)t * 1024;
  return (layer_stage == 0 ? P.in[I_CTX] : reinterpret_cast<const float*>(P.ws + OFF_XC)) + (long)(t - TLAT) * 1024;
}
DI float* xrow_dst(const Params& P, int t) {
  if (t < TLAT) return P.out + (long)t * 1024;
  return reinterpret_cast<float*>(P.ws + OFF_XC) + (long)(t - TLAT) * 1024;
}
DI void normmod_rows(const Params& P, int layer, int which, int stage, int ntok, int item, int nitems_stride) {
  const int tid = tidx(), lane = tid & 63, wid = tid >> 6;
  const float* g = P.in[which ? I_N2G : I_N1G] + layer * 1024;
  const float* mod = reinterpret_cast<const float*>(P.ws + OFF_MOD) + (long)layer * 9 * 6144;
  h16* H = reinterpret_cast<h16*>(P.ws + OFF_H1);
#pragma unroll 2
  for (int rg = item; rg * 4 < ntok; rg += nitems_stride) {
    const int t = rg * 4 + wid;
    const Tok k = tokinfo(t);
    const float* xr = xrow_src(P, stage, t);
    const float* sh = mod + k.mrow * 6144 + (which ? 3 : 0) * 1024; const float* sc = sh + 1024;
    float4 v[4]; float ss = 0.f;
#pragma unroll
    for (int i = 0; i < 4; ++i) { v[i] = *reinterpret_cast<const float4*>(xr + i * 256 + lane * 4); ss += v[i].x * v[i].x + v[i].y * v[i].y + v[i].z * v[i].z + v[i].w * v[i].w; }
    ss = wave_sum(ss);
    const float r = rsqrtf(ss * (1.f / 1024.f) + EPS);
#pragma unroll
    for (int i = 0; i < 4; ++i) {
      const int c = i * 256 + lane * 4;
      const float4 gg = *reinterpret_cast<const float4*>(g + c), s1 = *reinterpret_cast<const float4*>(sc + c), s0 = *reinterpret_cast<const float4*>(sh + c);
      h16x4 o;
      o[0] = (h16)(v[i].x * r * gg.x * (1.f + s1.x) + s0.x); o[1] = (h16)(v[i].y * r * gg.y * (1.f + s1.y) + s0.y);
      o[2] = (h16)(v[i].z * r * gg.z * (1.f + s1.z) + s0.z); o[3] = (h16)(v[i].w * r * gg.w * (1.f + s1.w) + s0.w);
      *reinterpret_cast<h16x4*>(H + (long)t * LD1 + c) = o;
    }
  }
}
DI void phase_final(const Params& P) {
  const int lane = tidx() & 63, wid = tidx() >> 6;
  const float* g = P.in[I_FINALG];
  for (int rg = blockIdx.x; rg * 4 < TLAT; rg += gridDim.x) {
    float* xr = P.out + (long)(rg * 4 + wid) * 1024;
    float4 v[4]; float ss = 0.f;
#pragma unroll
    for (int i = 0; i < 4; ++i) { v[i] = *reinterpret_cast<const float4*>(xr + i * 256 + lane * 4); ss += v[i].x * v[i].x + v[i].y * v[i].y + v[i].z * v[i].z + v[i].w * v[i].w; }
    ss = wave_sum(ss);
    const float r = rsqrtf(ss * (1.f / 1024.f) + EPS);
#pragma unroll
    for (int i = 0; i < 4; ++i) {
      const int c = i * 256 + lane * 4; const float4 gg = *reinterpret_cast<const float4*>(g + c);
      *reinterpret_cast<float4*>(xr + c) = make_float4(v[i].x * r * gg.x, v[i].y * r * gg.y, v[i].z * r * gg.z, v[i].w * r * gg.w);
    }
  }
}
DI float2 r8(int idx) { const float c = 0.70710678118654752f; return idx == 0 ? make_float2(1.f, 0.f) : idx == 1 ? make_float2(c, -c) : idx == 2 ? make_float2(0.f, -1.f) : make_float2(-c, -c); }
DI float2 cmul_r8(float2 w, int idx, bool cj) {
  if (idx == 0) return w;
  float2 r = r8(idx); if (cj) r.y = -r.y;
  return cmul(w, r);
}
template <int S> DI void fft_dif_pass(float2* X, int h) {
  const int hs = h >> (S - 1);
#pragma unroll 1
  for (int item = tidx(); item < (8192 >> S); item += NTHREADS) {
    const int j = item % hs, blk = item / hs, i0 = blk * 2 * h + j;
    float2 v[1 << S];
#pragma unroll
    for (int k = 0; k < (1 << S); ++k) v[k] = X[i0 + k * hs];
    float2 wp[S];
    wp[0] = twid(-(float)j / (float)(2 * h));
#pragma unroll
    for (int q = 1; q < S; ++q) wp[q] = cmul(wp[q - 1], wp[q - 1]);
#pragma unroll
    for (int q = 0; q < S; ++q) {
      const int dist = 1 << (S - 1 - q);
#pragma unroll
      for (int k = 0; k < (1 << S); ++k) {
        if (k & dist) continue;
        const float2 a = v[k], b = v[k + dist];
        const int m = k & (dist - 1);
        const float2 tw = cmul_r8(wp[q], m << (3 - (S - q)), false);
        v[k] = make_float2(a.x + b.x, a.y + b.y);
        v[k + dist] = cmul(make_float2(a.x - b.x, a.y - b.y), tw);
      }
    }
#pragma unroll
    for (int k = 0; k < (1 << S); ++k) X[i0 + k * hs] = v[k];
  }
  __syncthreads();
}
template <int S> DI void fft_dit_pass(float2* X, int hs) {
  const int hmax = hs << (S - 1);
#pragma unroll 1
  for (int item = tidx(); item < (8192 >> S); item += NTHREADS) {
    const int j = item % hs, blk = item / hs, i0 = blk * 2 * hmax + j;
    float2 v[1 << S];
#pragma unroll
    for (int k = 0; k < (1 << S); ++k) v[k] = X[i0 + k * hs];
    float2 bp[S];
    bp[S - 1] = twid((float)j / (float)(2 * hmax));
#pragma unroll
    for (int q = S - 2; q >= 0; --q) bp[q] = cmul(bp[q + 1], bp[q + 1]);
#pragma unroll
    for (int q = 0; q < S; ++q) {
      const int dist = 1 << q;
#pragma unroll
      for (int k = 0; k < (1 << S); ++k) {
        if (k & dist) continue;
        const int m = k & (dist - 1);
        const float2 tw = cmul_r8(bp[q], m << (3 - (q + 1)), true);
        const float2 a = v[k], b = cmul(v[k + dist], tw);
        v[k] = make_float2(a.x + b.x, a.y + b.y);
        v[k + dist] = make_float2(a.x - b.x, a.y - b.y);
      }
    }
#pragma unroll
    for (int k = 0; k < (1 << S); ++k) X[i0 + k * hs] = v[k];
  }
  __syncthreads();
}
DI void fft_fwd1(float2* X) { fft_dif_pass<3>(X, 4096); fft_dif_pass<3>(X, 512); fft_dif_pass<3>(X, 64); fft_dif_pass<2>(X, 8); fft_dif_pass<2>(X, 2); }
DI void fft_inv(float2* X) { fft_dit_pass<2>(X, 1); fft_dit_pass<2>(X, 4); fft_dit_pass<3>(X, 16); fft_dit_pass<3>(X, 128); fft_dit_pass<3>(X, 1024); }
#ifndef PROBE_FFT
#define PROBE_FFT 0
#endif
DI void fft_fwd(float2* X) {
#if PROBE_FFT
  fft_fwd1(X); fft_inv(X);
  for (int i = tidx(); i < 8192; i += NTHREADS) { float2 v = X[i]; X[i] = make_float2(v.x * (1.f / 8192.f), v.y * (1.f / 8192.f)); }
  __syncthreads();
#endif
  fft_fwd1(X);
}

DI float block_sum(float v, float* red) {
  v = wave_sum(v);
  __syncthreads();
  if ((tidx() & 63) == 0) red[tidx() >> 6] = v;
  __syncthreads();
  const float r = red[0] + red[1] + red[2] + red[3];
  __syncthreads();
  return r;
}
DI void item_filter(const Params& P, int layer, int oc, char* smem) {
  float2* X = reinterpret_cast<float2*>(smem); float* red = reinterpret_cast<float*>(smem + 65536);
  const int tid = tidx();
  const float* z2 = reinterpret_cast<const float*>(P.ws + OFF_Z2) + (long)layer * SEQ * 64;
  const float* w3 = P.in[I_FW3] + (long)layer * 64 * 1536; const float* dec = P.in[I_FDECAY] + layer * 1536;
  const int colf = oc, colb = 768 + oc;
  const float df = fabsf(dec[colf]), db = fabsf(dec[colb]);
  float lsum = 0.f;
#pragma unroll 2
  for (int i = 0; i < 32; ++i) {
    const int t = tid + 256 * i; const float* zr = z2 + (long)t * 64;
    float af = 0.f, ab = 0.f;
#pragma unroll 8
    for (int k = 0; k < 64; ++k) { const float z = zr[k]; af += z * w3[k * 1536 + colf]; ab += z * w3[k * 1536 + colb]; }
    const float tn = (float)t * (1.f / 8192.f);
    af *= __expf(-tn * df); ab *= __expf(-tn * db);
    lsum += fabsf(af) + fabsf(ab);
    X[t] = make_float2(af, ab);
  }
  const float nrm = block_sum(lsum, red);
  const float sc = 0.5f / 8192.f / nrm;
  float ev[32];
  float2* F = reinterpret_cast<float2*>(P.ws + OFF_FILT) + (long)oc * 2 * 8192;
#pragma unroll
  for (int i = 0; i < 32; ++i) {
    const int n = tid + 256 * i; const float lo = X[n].x; const float hi = n > 0 ? X[8192 - n].y : 0.f;
    ev[i] = (lo + hi) * sc; F[8192 + n] = make_float2((lo - hi) * sc, 0.f);
  }
  __syncthreads();
#pragma unroll
  for (int i = 0; i < 32; ++i) X[tid + 256 * i] = make_float2(ev[i], 0.f);
  __syncthreads();
  fft_fwd(X);
#pragma unroll 4
  for (int i = 0; i < 32; ++i) F[tid + 256 * i] = X[tid + 256 * i];
  __syncthreads();
#pragma unroll 4
  for (int i = 0; i < 32; ++i) { const int n = tid + 256 * i; const float d = F[8192 + n].x; const float2 w = twid(-(float)n * (1.f / 16384.f)); X[n] = make_float2(d * w.x, d * w.y); }
  __syncthreads();
  fft_fwd(X);
#pragma unroll 4
  for (int i = 0; i < 32; ++i) F[8192 + tid + 256 * i] = X[tid + 256 * i];
  __syncthreads();
}
DI void item_filter_ctx(const Params& P, int layer, int oc, char* smem) {
  float* red = reinterpret_cast<float*>(smem);
  const int t = tidx();
  const float* zr = reinterpret_cast<const float*>(P.ws + OFF_Z2C) + (long)layer * CTXL * 64 + t * 64;
  const float* w3 = P.in[I_FW3] + (long)layer * 64 * 1536; const float* dec = P.in[I_FDECAY] + layer * 1536;
  float af = 0.f, ab = 0.f;
  for (int k = 0; k < 64; ++k) { const float z = zr[k]; af += z * w3[k * 1536 + oc]; ab += z * w3[k * 1536 + 768 + oc]; }
  const float tn = (float)t * (1.f / 256.f);
  af *= __expf(-tn * fabsf(dec[oc])); ab *= __expf(-tn * fabsf(dec[768 + oc]));
  const float nrm = block_sum(fabsf(af) + fabsf(ab), red);
  float* T = reinterpret_cast<float*>(P.ws + OFF_TAPSC) + (long)oc * 512;
  T[t] = af / nrm; T[256 + t] = ab / nrm;
}

DI void phase_norm1(const Params& P, int layer, char* smem) {
  const int nfilt = 768 + (layer == 0 ? 768 : 0);
  for (int it = blockIdx.x; it < nfilt; it += gridDim.x) {
    if (it < 768) item_filter(P, layer, it, smem); else item_filter_ctx(P, layer, it - 768, smem);
  }
  normmod_rows(P, layer, 0, layer, TT, blockIdx.x, gridDim.x);
}

DI void phase_gemm_in(const Params& P, int layer, char* smem) {
  const int tid = tidx(), lane = tid & 63, wid = tid >> 6, wr = wid >> 1, wc = wid & 1, fr = lane & 15, fq = lane >> 4;
  const h16* H = reinterpret_cast<const h16*>(P.ws + OFF_H1);
  const h16* W = reinterpret_cast<const h16*>(P.ws + OFF_WT) + (long)layer * WT_LAYER + WT_WIN;
  h16* U = reinterpret_cast<h16*>(P.ws + OFF_U); h16* KV = reinterpret_cast<h16*>(P.ws + OFF_KVLAT); h16* QL = reinterpret_cast<h16*>(P.ws + OFF_QLAT);
  h16* PHY = reinterpret_cast<h16*>(P.ws + OFF_PHY); h16* PHYC = reinterpret_cast<h16*>(P.ws + OFF_PHYC); h16* Kb = reinterpret_cast<h16*>(P.ws + OFF_K);
  const float2* rope = reinterpret_cast<const float2*>(P.ws + OFF_ROPE);
  constexpr int NT = 19, MT = TT / 128;
  const TileWalk tw = tw_init(MT, NT);
  for (int tile = tw.lb; tile < tw_count(tw); tile += tw.nlb) {
    int mt, nt; tw_decode(tw, tile, mt, nt);
    f32x4 acc[4][4]; acc_zero(acc);
    gemm_kloop(acc, H + (long)mt * 128 * LD1, LD1, 0, 128, W + (long)nt * 128 * LD1, LD1, 1024, smem, opaque_tid());
    const int t0 = mt * 128; const Tok tk = tokinfo(t0);
    if (nt < 18) {
      float* Zs = reinterpret_cast<float*>(smem);
      const int t2 = tidx();
      if (nt < 9) {
        stage_acc(acc, Zs, t2);
        h16* dst; int ld, cb;
        if (nt < 3) { dst = U; ld = 384; cb = nt * 128; } else if (nt < 5) { dst = KV; ld = 256; cb = (nt - 3) * 128; } else { dst = QL; ld = 512; cb = (nt - 5) * 128; }
        copy_out_f16(Zs, dst, t0, ld, cb, t2);
      } else {
        stage_acc_t(acc, Zs, t2);
        h16* base = tk.ctx ? PHYC + (long)tk.b * 1152 * CTXL : PHY + (long)tk.b * 1152 * SEQ; const int lp = tk.ctx ? CTXL : SEQ;
        copy_out_f16(Zs, base, (nt - 9) * 128, lp, tk.pos, t2);
      }
      __syncthreads();
    } else {
      h16* R = reinterpret_cast<h16*>(smem);
      if (wc == 0) {
#pragma unroll
        for (int m = 0; m < 4; ++m)
#pragma unroll
          for (int j = 0; j < 4; ++j) {
            const int row = wr * 64 + m * 16 + fq * 4 + j; const int pos = tk.pos + row;
            float x1 = acc[m][0][j], x2 = acc[m][1][j];
            if (!tk.ctx) { const float2 cs = rope[pos * 16 + fr]; const float y1 = x1 * cs.x - x2 * cs.y, y2 = x1 * cs.y + x2 * cs.x; x1 = y1; x2 = y2; }
            R[row * 32 + fr] = (h16)x1; R[row * 32 + 16 + fr] = (h16)x2;
          }
      }
      __syncthreads();
      {
        const int t2 = tidx(); const int key0 = (tk.ctx ? SEQ : 0) + tk.pos;
#pragma unroll
        for (int it = 0; it < 2; ++it) {
          const int chunk = it * 256 + t2, row = chunk >> 2, part = chunk & 3;
          const uint4 v = *reinterpret_cast<const uint4*>(R + row * 32 + part * 8);
#pragma unroll
          for (int h = 0; h < 8; ++h) *reinterpret_cast<uint4*>(Kb + ((long)(tk.b * 8 + h) * KEYS + key0 + row) * 96 + 64 + part * 8) = v;
        }
      }
      __syncthreads();
    }
  }
}
DI void item_kv(const Params& P, int layer, int tile, char* smem) {
  const int tid = tidx(), lane = tid & 63, wid = tid >> 6, wr = wid >> 1, wc = wid & 1, fr = lane & 15, fq = lane >> 4;
  const int mt = tile >> 3, hd = tile & 7; const int t0 = mt * 128; const Tok tk = tokinfo(t0);
  const h16* A = reinterpret_cast<const h16*>(P.ws + OFF_KVLAT) + (long)t0 * 256;
  const h16* W = reinterpret_cast<const h16*>(P.ws + OFF_WT) + (long)layer * WT_LAYER + WT_UKV + (long)hd * 128 * 256;
  float* rs = reinterpret_cast<float*>(smem + 73728);
  row_rms(A, 256, 256, rs);
  f32x4 acc[4][4]; acc_zero(acc);
  gemm_kloop(acc, A, 256, 0, 128, W, 256, 256, smem, opaque_tid());
  h16* Kb = reinterpret_cast<h16*>(P.ws + OFF_K) + (long)(tk.b * 8 + hd) * KEYS * 96;
  h16* Vt = reinterpret_cast<h16*>(P.ws + OFF_VT) + (long)(tk.b * 8 + hd) * 64 * KEYS;
  const int key0 = (tk.ctx ? SEQ : 0) + tk.pos;
#pragma unroll
  for (int m = 0; m < 4; ++m) {
    const int r0 = wr * 64 + m * 16 + fq * 4;
    const float s0 = rs[r0], s1 = rs[r0 + 1], s2 = rs[r0 + 2], s3 = rs[r0 + 3];
#pragma unroll
    for (int n = 0; n < 4; ++n) {
      acc[m][n][0] *= s0; acc[m][n][1] *= s1; acc[m][n][2] *= s2; acc[m][n][3] *= s3;
      if (wc == 1) {
        h16x4 o; o[0] = (h16)acc[m][n][0]; o[1] = (h16)acc[m][n][1]; o[2] = (h16)acc[m][n][2]; o[3] = (h16)acc[m][n][3];
        *reinterpret_cast<h16x4*>(Vt + (long)(n * 16 + fr) * KEYS + key0 + r0) = o;
      }
    }
  }
  {
    float* Zs = reinterpret_cast<float*>(smem);
    const int t2 = tidx();
    stage_acc(acc, Zs, t2);
#pragma unroll
    for (int it = 0; it < 4; ++it) {
      const int chunk = it * 256 + t2, row = chunk >> 3, c8 = (chunk & 7) * 8;
      const float4 x0 = *reinterpret_cast<const float4*>(Zs + row * 132 + c8), x1 = *reinterpret_cast<const float4*>(Zs + row * 132 + c8 + 4);
      h16x8 o; o[0] = (h16)x0.x; o[1] = (h16)x0.y; o[2] = (h16)x0.z; o[3] = (h16)x0.w; o[4] = (h16)x1.x; o[5] = (h16)x1.y; o[6] = (h16)x1.z; o[7] = (h16)x1.w;
      *reinterpret_cast<h16x8*>(Kb + (long)(key0 + row) * 96 + c8) = o;
    }
  }
  __syncthreads();
}
DI void item_q(const Params& P, int layer, int tile, char* smem) {
  const int tid = tidx(), lane = tid & 63, wid = tid >> 6, wr = wid >> 1, wc = wid & 1, fr = lane & 15, fq = lane >> 4;
  const int mt = tile >> 3, hd = tile & 7; const int t0 = mt * 128; const Tok tk = tokinfo(t0);
  const h16* A = reinterpret_cast<const h16*>(P.ws + OFF_QLAT) + (long)t0 * 512;
  const h16* W = reinterpret_cast<const h16*>(P.ws + OFF_WT) + (long)layer * WT_LAYER + WT_UQ + (long)hd * 128 * 512;
  float* rs = reinterpret_cast<float*>(smem + 73728);
  row_rms(A, 512, 512, rs);
  f32x4 acc[4][4]; acc_zero(acc);
  gemm_kloop(acc, A, 512, 0, 128, W, 512, 512, smem, opaque_tid());
  h16* Qb = reinterpret_cast<h16*>(P.ws + OFF_Q) + (long)(tk.b * 8 + hd) * KEYS * 96;
  const float2* rope = reinterpret_cast<const float2*>(P.ws + OFF_ROPE);
  const int q0 = (tk.ctx ? SEQ : 0) + tk.pos;
#pragma unroll
  for (int m = 0; m < 4; ++m)
#pragma unroll
    for (int j = 0; j < 4; ++j) {
      const int r = wr * 64 + m * 16 + fq * 4 + j; const float s = rs[r] * QSCALE;
      if (wc == 0) {
#pragma unroll
        for (int n = 0; n < 4; ++n) acc[m][n][j] *= s;
      } else {
        float x1 = acc[m][0][j], x2 = acc[m][1][j];
        if (!tk.ctx) { const float2 cs = rope[(tk.pos + r) * 16 + fr]; const float y1 = x1 * cs.x - x2 * cs.y, y2 = x1 * cs.y + x2 * cs.x; x1 = y1; x2 = y2; }
        acc[m][0][j] = x1 * s; acc[m][1][j] = x2 * s;
      }
    }
  {
    float* Zs = reinterpret_cast<float*>(smem);
    const int t2 = tidx();
    stage_acc(acc, Zs, t2);
#pragma unroll
    for (int it = 0; it < 6; ++it) {
      const int chunk = it * 256 + t2, row = chunk / 12, c8 = (chunk % 12) * 8;
      const float4 x0 = *reinterpret_cast<const float4*>(Zs + row * 132 + c8), x1 = *reinterpret_cast<const float4*>(Zs + row * 132 + c8 + 4);
      h16x8 o; o[0] = (h16)x0.x; o[1] = (h16)x0.y; o[2] = (h16)x0.z; o[3] = (h16)x0.w; o[4] = (h16)x1.x; o[5] = (h16)x1.y; o[6] = (h16)x1.z; o[7] = (h16)x1.w;
      *reinterpret_cast<h16x8*>(Qb + (long)(q0 + row) * 96 + c8) = o;
    }
  }
  __syncthreads();
}
DI int s5_chunk_base(int b, int dir, int si) {
  if (si < 4) { const int cc = dir ? 3 - si : si; return TLAT + b * CTXL + cc * 64; }
  const int lc = dir ? 127 - (si - 4) : si - 4; return b * SEQ + lc * 64;
}
DI void s5_stage_u(const h16* __restrict__ U, int tokbase, int g, float* us) {
  const int lane = tidx() & 63;
  const h16* p = U + (long)(tokbase + lane) * 384 + g * 16;
  const h16x8 v0 = *reinterpret_cast<const h16x8*>(p), v1 = *reinterpret_cast<const h16x8*>(p + 8);
#pragma unroll
  for (int j = 0; j < 8; ++j) { us[lane * 16 + j] = (float)v0[j]; us[lane * 16 + 8 + j] = (float)v1[j]; }
}
DI void item_s5_pass1(const Params& P, int layer, int wtask, char* smem) {
  const int lane = tidx() & 63, wid = tidx() >> 6;
  float* us = reinterpret_cast<float*>(smem + wid * 12800);
  const int si = wtask % 132; int r = wtask / 132; const int g = r % 24; r /= 24; const int dir = r & 1, b = r >> 1;
  const long gi = (long)(layer * 2 + dir) * 24 + g;
  const float2 a = reinterpret_cast<const float2*>(P.ws + OFF_S5A)[gi * 64 + lane];
  const float2* Bb = reinterpret_cast<const float2*>(P.ws + OFF_S5B) + (gi * 64 + lane) * 16;
  float bre[16], bim[16];
#pragma unroll
  for (int c = 0; c < 16; ++c) { const float2 v = Bb[c]; bre[c] = v.x; bim[c] = v.y; }
  s5_stage_u(reinterpret_cast<const h16*>(P.ws + OFF_U), s5_chunk_base(b, dir, si), g, us);
  float hr = 0.f, hi = 0.f;
#pragma unroll 4
  for (int s = 0; s < 64; ++s) {
    const int tau = dir ? 63 - s : s;
    const float4* up = reinterpret_cast<const float4*>(us + tau * 16);
    float br = 0.f, bi = 0.f;
#pragma unroll
    for (int q = 0; q < 4; ++q) { const float4 u = up[q];
      br += bre[q * 4] * u.x + bre[q * 4 + 1] * u.y + bre[q * 4 + 2] * u.z + bre[q * 4 + 3] * u.w;
      bi += bim[q * 4] * u.x + bim[q * 4 + 1] * u.y + bim[q * 4 + 2] * u.z + bim[q * 4 + 3] * u.w; }
    const float nr = a.x * hr - a.y * hi + br, ni = a.x * hi + a.y * hr + bi; hr = nr; hi = ni;
  }
  reinterpret_cast<float2*>(P.ws + OFF_E)[((long)((b * 2 + dir) * 24 + g) * 132 + si) * 64 + lane] = make_float2(hr, hi);
}

DI float hy_dw(const h16* __restrict__ p, int t, int Ls, float w0, float w1, float w2, float bias) {
  const float xm_ = (float)p[max(t - 1, 0)], x0 = (float)p[t], xp_ = (float)p[min(t + 1, Ls - 1)];
  const float xm = t > 0 ? xm_ : 0.f, xp = t + 1 < Ls ? xp_ : 0.f;
  return xm * w0 + x0 * w1 + xp * w2 + bias;
}
DI void item_hyena(const Params& P, int layer, int task, char* smem) {
  float2* X = reinterpret_cast<float2*>(smem);
  const int tid = tidx(); const int pair = task / 384, c = task % 384;
  const h16* PH0 = reinterpret_cast<const h16*>(P.ws + OFF_PHY) + (long)(2 * pair) * 1152 * SEQ;
  const h16* PH1 = PH0 + (long)1152 * SEQ;
  const float* cw = P.in[I_HCW] + layer * 3 * 1152; const float* cb = P.in[I_HCB] + layer * 1152;
  const float2* F = reinterpret_cast<const float2*>(P.ws + OFF_FILT);
  float2* SCR = reinterpret_cast<float2*>(P.ws + OFF_YS5PRE) + (long)blockIdx.x * 12288;
  float2* SCR2 = SCR + 8192;
  const float vw0 = cw[c], vw1 = cw[1152 + c], vw2 = cw[2304 + c], vbb = cb[c];
  const h16* pv0 = PH0 + (long)c * SEQ; const h16* pv1 = PH1 + (long)c * SEQ;
  float2 ye[16]; int tq;
#pragma unroll 1
  for (int o = 0; o < 2; ++o) {
    const float2* Te = F + (long)(o * 384 + c) * 2 * 8192; const float2* To = Te + 8192;
    float ts = 1.f / 16384.f; asm volatile("" : "+v"(ts));
{ tq = tid; asm volatile("" : "+v"(tq)); }
    if (o == 0) {
#pragma unroll 8
      for (int i = 0; i < 32; ++i) { const int t = tq + 256 * i; const float2 v = make_float2(hy_dw(pv0, t, SEQ, vw0, vw1, vw2, vbb), hy_dw(pv1, t, SEQ, vw0, vw1, vw2, vbb)); X[t] = v; SCR[t] = v; }
    } else {
#pragma unroll 16
      for (int i = 0; i < 32; ++i) { const int t = tq + 256 * i; X[t] = SCR[t]; }
    }
    __syncthreads();
    fft_fwd(X);
{ tq = tid; asm volatile("" : "+v"(tq)); }
#pragma unroll 8
    for (int i = 0; i < 32; ++i) { const int n = tq + 256 * i; X[n] = cmul(X[n], Te[n]); }
    __syncthreads();
    fft_inv(X);
{ tq = tid; asm volatile("" : "+v"(tq)); }
#pragma unroll
    for (int i = 0; i < 16; ++i) { ye[i] = X[tq + 256 * i]; SCR2[tq + 256 * i] = X[tq + 4096 + 256 * i]; }
    __syncthreads();
{ tq = tid; asm volatile("" : "+v"(tq)); }
#pragma unroll 16
    for (int i = 0; i < 32; ++i) { const int t = tq + 256 * i; X[t] = cmul(SCR[t], twid(-(float)t * ts)); }
    __syncthreads();
    fft_fwd(X);
{ tq = tid; asm volatile("" : "+v"(tq)); }
#pragma unroll 8
    for (int i = 0; i < 32; ++i) { const int n = tq + 256 * i; X[n] = cmul(X[n], To[n]); }
    __syncthreads();
    fft_inv(X);
    asm volatile("" : "+v"(ts));
{ tq = tid; asm volatile("" : "+v"(tq)); }
#pragma unroll
    for (int i = 0; i < 16; ++i) { const int t = tq + 256 * i; const float2 yo = cmul(X[t], twid((float)t * ts)); X[t] = make_float2(ye[i].x + yo.x, ye[i].y + yo.y); }
{ tq = tid; asm volatile("" : "+v"(tq)); }
#pragma unroll 2
    for (int i = 0; i < 16; ++i) { const int t = tq + 4096 + 256 * i; const float2 yo = cmul(X[t], twid((float)t * ts)); const float2 y2 = SCR2[tq + 256 * i]; X[t] = make_float2(y2.x + yo.x, y2.y + yo.y); }
    const int gc = (o + 1) * 384 + c;
    const float w0 = cw[gc], w1 = cw[1152 + gc], w2 = cw[2304 + gc], bb = cb[gc];
    const float bias = P.in[I_HBIAS][(layer * 2 + o) * 384 + c];
    const h16* pg0 = PH0 + (long)gc * SEQ; const h16* pg1 = PH1 + (long)gc * SEQ;
{ tq = tid; asm volatile("" : "+v"(tq)); }
    if (o == 0) {
#pragma unroll 8
      for (int i = 0; i < 32; ++i) {
        const int t = tq + 256 * i;
        const float2 lc = X[t];
        const float2 zz = SCR[t];
        const float gx = hy_dw(pg0, t, SEQ, w0, w1, w2, bb), gy = hy_dw(pg1, t, SEQ, w0, w1, w2, bb);
        SCR[t] = make_float2(gx * (lc.x + bias * zz.x), gy * (lc.y + bias * zz.y));
      }
    } else {
#pragma unroll 8
      for (int i = 0; i < 32; ++i) {
        const int t = tq + 256 * i;
        const float2 lc = X[t];
        const float2 zz = SCR[t];
        const float gx = hy_dw(pg0, t, SEQ, w0, w1, w2, bb), gy = hy_dw(pg1, t, SEQ, w0, w1, w2, bb);
        const_cast<h16*>(pv0)[t] = (h16)(gx * (lc.x + bias * zz.x)); const_cast<h16*>(pv1)[t] = (h16)(gy * (lc.y + bias * zz.y));
      }
    }
    __syncthreads();
  }
}
DI void item_hyena_ctx(const Params& P, int layer, int task, char* smem) {
  float* su = reinterpret_cast<float*>(smem); float* sf = su + 256; float* sb = sf + 256;
  const int t = tidx(); const int b = task / 384, c = task % 384;
  const h16* PH = reinterpret_cast<const h16*>(P.ws + OFF_PHYC) + (long)b * 1152 * CTXL;
  const float* cw = P.in[I_HCW] + layer * 3 * 1152; const float* cb = P.in[I_HCB] + layer * 1152;
  float u = hy_dw(PH + (long)c * CTXL, t, CTXL, cw[c], cw[1152 + c], cw[2304 + c], cb[c]);
  for (int o = 0; o < 2; ++o) {
    const float* T = reinterpret_cast<const float*>(P.ws + OFF_TAPSC) + (long)(o * 384 + c) * 512;
    __syncthreads();
    su[t] = u; sf[t] = T[t]; sb[t] = T[256 + t];
    __syncthreads();
    float y = 0.f;
    for (int s = 0; s <= t; ++s) y += sf[t - s] * su[s];
    for (int s = t + 1; s < 256; ++s) y += sb[s - t] * su[s];
    const int gc = (o + 1) * 384 + c;
    const float gx = hy_dw(PH + (long)gc * CTXL, t, CTXL, cw[gc], cw[1152 + gc], cw[2304 + gc], cb[gc]);
    u = gx * (y + P.in[I_HBIAS][(layer * 2 + o) * 384 + c] * u);
  }
  reinterpret_cast<h16*>(P.ws + OFF_YHY)[((long)TLAT + b * CTXL + t) * 384 + c] = (h16)u;
  __syncthreads();
}

#ifndef PROBE_HY
#define PROBE_HY 0
#endif
#ifndef PROBE_S5
#define PROBE_S5 0
#endif
DI int first_item(int base) { const int g = (int)gridDim.x; return (((int)blockIdx.x - base) % g + g) % g; }
DI void phase_mix1(const Params& P, int layer, char* smem) {
  const int n_hy = 4 * 384, n_hyc = layer == 0 ? 8 * 384 : 0;
  const int n_kv = (TT / 128) * 8, n_q = (layer == 0 ? TT / 128 : TLAT / 128) * 8;
  const int n_s5 = (NBATCH * 2 * 24 * 132) / 4;
  const int g = gridDim.x;
#pragma unroll 1
  for (int rep = 0; rep < 1 + PROBE_HY; ++rep)
#pragma unroll 1
  for (int i = first_item(0); i < n_hy; i += g) item_hyena(P, layer, i, smem);
  asm volatile("" ::: "memory");
#pragma unroll 1
  for (int i = first_item(n_hy); i < n_kv; i += g) item_kv(P, layer, i, smem);
  asm volatile("" ::: "memory");
#pragma unroll 1
  for (int i = first_item(n_hy + n_kv); i < n_q; i += g) item_q(P, layer, i, smem);
  asm volatile("" ::: "memory");
#pragma unroll 1
  for (int rep = 0; rep < 1 + PROBE_S5; ++rep)
#pragma unroll 1
  for (int i = first_item(n_hy + n_kv + n_q); i < n_s5; i += g) { item_s5_pass1(P, layer, i * 4 + (tidx() >> 6), smem); __syncthreads(); }
  asm volatile("" ::: "memory");
#pragma unroll 1
  for (int i = first_item(n_hy + n_kv + n_q + n_s5); i < n_hyc; i += g) item_hyena_ctx(P, layer, i, smem);
}
DI int crow32(int r, int hi) { return (r & 3) + 8 * (r >> 2) + 4 * hi; }
DI void item_attn(const Params& P, int bh, int q0, int key_lo, int ntiles, char* smem) {
  const int tid = tidx(), lane = tid & 63, wid = tid >> 6, r32 = lane & 31, hi = lane >> 5;
  const h16* Qb = reinterpret_cast<const h16*>(P.ws + OFF_Q) + (long)bh * KEYS * 96;
  const h16* Kb = reinterpret_cast<const h16*>(P.ws + OFF_K) + (long)bh * KEYS * 96;
  const h16* Vt = reinterpret_cast<const h16*>(P.ws + OFF_VT) + (long)bh * 64 * KEYS;
  h16x8 qf[6];
  { const h16* qrow = Qb + (long)(q0 + wid * 32 + r32) * 96 + hi * 8;
#pragma unroll
    for (int ds = 0; ds < 6; ++ds) qf[ds] = *reinterpret_cast<const h16x8*>(qrow + ds * 16); }
  constexpr int KT_BYTES = 64 * 208, VT_BYTES = 64 * 136, BUF = KT_BYTES + VT_BYTES;
  uint4 kr[3]; uint4 vr[2];
  const int vdv0 = tid >> 3, vpart = tid & 7;
  auto gload = [&](int j) {
    const long key0 = key_lo + j * 64;
#pragma unroll
    for (int i = 0; i < 3; ++i) kr[i] = *reinterpret_cast<const uint4*>(Kb + key0 * 96 + (long)(tid + 256 * i) * 8);
#pragma unroll
    for (int i = 0; i < 2; ++i) vr[i] = *reinterpret_cast<const uint4*>(Vt + (long)(vdv0 + 32 * i) * KEYS + key0 + vpart * 8);
  };
  auto swrite = [&](int buf) {
    char* ks = smem + buf * BUF; char* vs = ks + KT_BYTES;
#pragma unroll
    for (int i = 0; i < 3; ++i) { const int c = tid + 256 * i; *reinterpret_cast<uint4*>(ks + (c / 12) * 208 + (c % 12) * 16) = kr[i]; }
#pragma unroll
    for (int i = 0; i < 2; ++i) { char* d = vs + (vdv0 + 32 * i) * 136 + vpart * 16;
      *reinterpret_cast<uint2*>(d) = make_uint2(vr[i].x, vr[i].y); *reinterpret_cast<uint2*>(d + 8) = make_uint2(vr[i].z, vr[i].w); }
  };
  f32x16 o0, o1;
#pragma unroll
  for (int r = 0; r < 16; ++r) { o0[r] = 0.f; o1[r] = 0.f; }
  float m_run = -1e30f, l_run = 0.f;
  gload(0); swrite(0); __syncthreads();
  for (int j = 0; j < ntiles; ++j) {
    if (j + 1 < ntiles) gload(j + 1);
    const char* ks = smem + (j & 1) * BUF; const char* vs = ks + KT_BYTES;
    f32x16 p0, p1;
#pragma unroll
    for (int r = 0; r < 16; ++r) { p0[r] = 0.f; p1[r] = 0.f; }
#pragma unroll
    for (int ds = 0; ds < 6; ++ds) {
      const h16x8 a0 = *reinterpret_cast<const h16x8*>(ks + r32 * 208 + (ds * 16 + hi * 8) * 2);
      const h16x8 a1 = *reinterpret_cast<const h16x8*>(ks + (32 + r32) * 208 + (ds * 16 + hi * 8) * 2);
      p0 = __builtin_amdgcn_mfma_f32_32x32x16_f16(a0, qf[ds], p0, 0, 0, 0);
      p1 = __builtin_amdgcn_mfma_f32_32x32x16_f16(a1, qf[ds], p1, 0, 0, 0);
    }
    float mx = p0[0];
#pragma unroll
    for (int r = 1; r < 16; ++r) mx = fmaxf(mx, p0[r]);
#pragma unroll
    for (int r = 0; r < 16; ++r) mx = fmaxf(mx, p1[r]);
    { const auto rr = __builtin_amdgcn_permlane32_swap(__float_as_uint(mx), __float_as_uint(mx), false, false);
      mx = fmaxf(__uint_as_float(rr[0]), __uint_as_float(rr[1])); }
    const float mnew = fmaxf(m_run, mx);
    const float alpha = __builtin_amdgcn_exp2f(m_run - mnew);
    m_run = mnew;
    float rsum = 0.f;
#pragma unroll
    for (int r = 0; r < 16; ++r) { p0[r] = __builtin_amdgcn_exp2f(p0[r] - mnew); rsum += p0[r]; }
#pragma unroll
    for (int r = 0; r < 16; ++r) { p1[r] = __builtin_amdgcn_exp2f(p1[r] - mnew); rsum += p1[r]; }
    l_run = l_run * alpha + rsum;
    if (__any(alpha != 1.f)) {
#pragma unroll
      for (int r = 0; r < 16; ++r) { o0[r] *= alpha; o1[r] *= alpha; }
    }
#pragma unroll
    for (int kb = 0; kb < 2; ++kb)
#pragma unroll
      for (int s = 0; s < 2; ++s) {
        h16x8 pf;
#pragma unroll
        for (int e = 0; e < 8; ++e) pf[e] = (h16)(kb ? p1[8 * s + e] : p0[8 * s + e]);
        const int koff = (32 * kb + 16 * s + 4 * hi) * 2;
        {
          const h16x4 lo = *reinterpret_cast<const h16x4*>(vs + r32 * 136 + koff), hh = *reinterpret_cast<const h16x4*>(vs + r32 * 136 + koff + 16);
          const h16x8 af = __builtin_shufflevector(lo, hh, 0, 1, 2, 3, 4, 5, 6, 7);
          o0 = __builtin_amdgcn_mfma_f32_32x32x16_f16(af, pf, o0, 0, 0, 0);
        }
        {
          const h16x4 lo = *reinterpret_cast<const h16x4*>(vs + (32 + r32) * 136 + koff), hh = *reinterpret_cast<const h16x4*>(vs + (32 + r32) * 136 + koff + 16);
          const h16x8 af = __builtin_shufflevector(lo, hh, 0, 1, 2, 3, 4, 5, 6, 7);
          o1 = __builtin_amdgcn_mfma_f32_32x32x16_f16(af, pf, o1, 0, 0, 0);
        }
      }
    if (j + 1 < ntiles) swrite((j + 1) & 1);
    __syncthreads();
  }
  const float lt = l_run + __shfl_xor(l_run, 32);
  const float inv = 1.f / lt;
  {
    h16* Os = reinterpret_cast<h16*>(smem);
    h16* orow = Os + (wid * 32 + r32) * 72;
#pragma unroll
    for (int g = 0; g < 4; ++g) {
      h16x4 a, c;
#pragma unroll
      for (int e = 0; e < 4; ++e) { a[e] = (h16)(o0[4 * g + e] * inv); c[e] = (h16)(o1[4 * g + e] * inv); }
      *reinterpret_cast<h16x4*>(orow + 8 * g + 4 * hi) = a;
      *reinterpret_cast<h16x4*>(orow + 32 + 8 * g + 4 * hi) = c;
    }
    __syncthreads();
    const int b = bh >> 3, hd = bh & 7;
    const long tok0 = q0 < SEQ ? (long)b * SEQ + q0 : (long)TLAT + b * CTXL + (q0 - SEQ);
    h16* yb = reinterpret_cast<h16*>(P.ws + OFF_YMLA) + tok0 * 512 + hd * 64;
#pragma unroll
    for (int it = 0; it < 4; ++it) {
      const int chunk = it * 256 + tid, row = chunk >> 3, c8 = (chunk & 7) * 8;
      *reinterpret_cast<uint4*>(yb + (long)row * 512 + c8) = *reinterpret_cast<const uint4*>(Os + row * 72 + c8);
    }
    __syncthreads();
  }
}
DI void item_s5_pass3(const Params& P, int layer, int b, int g, int ck, char* smem) {
  const int lane = tidx() & 63, wid = tidx() >> 6, fr = lane & 15, fq = lane >> 4;
  float* us = reinterpret_cast<float*>(smem + wid * 12800); char* Hs = smem + wid * 12800 + 4096;
  const int tokbase = ck < 4 ? TLAT + b * CTXL + ck * 64 : b * SEQ + (ck - 4) * 64;
  s5_stage_u(reinterpret_cast<const h16*>(P.ws + OFF_U), tokbase, g, us);
  __syncthreads();
  f32x4 yacc[4];
#pragma unroll
  for (int i = 0; i < 4; ++i) yacc[i] = f32x4{0.f, 0.f, 0.f, 0.f};
#pragma unroll
  for (int dir = 0; dir < 2; ++dir) {
    const long gi = (long)(layer * 2 + dir) * 24 + g;
    const float2 a = reinterpret_cast<const float2*>(P.ws + OFF_S5A)[gi * 64 + lane];
    const float2 a64 = reinterpret_cast<const float2*>(P.ws + OFF_S5A64)[gi * 64 + lane];
    const float2* Bb = reinterpret_cast<const float2*>(P.ws + OFF_S5B) + (gi * 64 + lane) * 16;
    float bre[16], bim[16];
#pragma unroll
    for (int c = 0; c < 16; ++c) { const float2 v = Bb[c]; bre[c] = v.x; bim[c] = v.y; }
    const int si = ck < 4 ? (dir ? 3 - ck : ck) : 4 + (dir ? 127 - (ck - 4) : ck - 4);
    const float2* Ep = reinterpret_cast<const float2*>(P.ws + OFF_E) + ((long)((b * 2 + dir) * 24 + g) * 132) * 64 + lane;
    float hr = 0.f, hi = 0.f;
#pragma unroll 16
    for (int i = 0; i < si; ++i) { const float2 e = Ep[(long)i * 64]; const float nr = a64.x * hr - a64.y * hi + e.x, ni = a64.x * hi + a64.y * hr + e.y; hr = nr; hi = ni; }
    const h16* Ct = reinterpret_cast<const h16*>(P.ws + OFF_S5C) + gi * 16 * 128 + fr * 128 + fq * 8;
    h16x8 cf[4];
#pragma unroll
    for (int ks = 0; ks < 4; ++ks) cf[ks] = *reinterpret_cast<const h16x8*>(Ct + ks * 32);
#pragma unroll
    for (int half = 0; half < 2; ++half) {
#pragma unroll 4
      for (int s = 0; s < 32; ++s) {
        const int step = half * 32 + s; const int tau = dir ? 63 - step : step;
        const float4* up = reinterpret_cast<const float4*>(us + tau * 16);
        float br = 0.f, bi = 0.f;
#pragma unroll
        for (int q = 0; q < 4; ++q) { const float4 u = up[q];
          br += bre[q * 4] * u.x + bre[q * 4 + 1] * u.y + bre[q * 4 + 2] * u.z + bre[q * 4 + 3] * u.w;
          bi += bim[q * 4] * u.x + bim[q * 4 + 1] * u.y + bim[q * 4 + 2] * u.z + bim[q * 4 + 3] * u.w; }
        const float nr = a.x * hr - a.y * hi + br, ni = a.x * hi + a.y * hr + bi; hr = nr; hi = ni;
        h16* hrow = reinterpret_cast<h16*>(Hs + (tau & 31) * 272);
        hrow[lane] = (h16)hr; hrow[64 + lane] = (h16)hi;
      }
      __syncthreads();
      const int tb = dir ? 1 - half : half;
#pragma unroll
      for (int sb2 = 0; sb2 < 2; ++sb2)
#pragma unroll
        for (int ks = 0; ks < 4; ++ks) {
          const h16x8 bf = *reinterpret_cast<const h16x8*>(Hs + (sb2 * 16 + fr) * 272 + (ks * 32 + fq * 8) * 2);
          yacc[tb * 2 + sb2] = __builtin_amdgcn_mfma_f32_16x16x32_f16(cf[ks], bf, yacc[tb * 2 + sb2], 0, 0, 0);
        }
      __syncthreads();
    }
  }
  const float* dsk = P.in[I_S5D] + layer * 384 + g * 16 + fq * 4;
  h16* Y = reinterpret_cast<h16*>(P.ws + OFF_YS5PRE);
#pragma unroll
  for (int sbi = 0; sbi < 4; ++sbi) {
    const int tl = sbi * 16 + fr; h16x4 o;
#pragma unroll
    for (int j = 0; j < 4; ++j) o[j] = (h16)geluf_(yacc[sbi][j] + dsk[j] * us[tl * 16 + fq * 4 + j]);
    *reinterpret_cast<h16x4*>(Y + (long)(tokbase + tl) * 384 + g * 16 + fq * 4) = o;
  }
  __syncthreads();
}
DI void phase_mix2(const Params& P, int layer, char* smem) {
  if ((gridDim.x & 7) == 0) {
    const int xcd = blockIdx.x & 7, li = blockIdx.x >> 3, nloc = gridDim.x >> 3;
    for (int k = li; k < 512; k += nloc) item_attn(P, xcd + 8 * (k >> 6), (k & 63) * 128, 0, KEYS / 64, smem);
  } else {
    for (int k = blockIdx.x; k < 4096; k += gridDim.x) item_attn(P, k >> 6, (k & 63) * 128, 0, KEYS / 64, smem);
  }
  const int n_actx = layer == 0 ? 128 : 0;
  const int nck = layer == 0 ? 132 : 128;
  const int n_s5 = NBATCH * 24 * nck / 4;
  for (int it = blockIdx.x; it < n_actx + n_s5; it += gridDim.x) {
    if (it < n_actx) { item_attn(P, it >> 1, SEQ + (it & 1) * 128, SEQ, CTXL / 64, smem); continue; }
    const int w = (it - n_actx) * 4 + (tidx() >> 6);
    const int ck = w % nck + (layer == 0 ? 0 : 4); const int r = w / nck;
    item_s5_pass3(P, layer, r / 24, r % 24, ck, smem);
  }
}
DI void item_yhy_transpose(const Params& P, int item, char* smem) {
  h16* T = reinterpret_cast<h16*>(smem);
  const int tid = tidx();
  const int tt = item & 127, ct = (item >> 7) % 6, b = item / (128 * 6);
  const h16* src = reinterpret_cast<const h16*>(P.ws + OFF_PHY) + ((long)b * 1152 + ct * 64) * SEQ + tt * 64;
  h16* dst = reinterpret_cast<h16*>(P.ws + OFF_YHY) + ((long)b * SEQ + tt * 64) * 384 + ct * 64;
#pragma unroll
  for (int i = 0; i < 2; ++i) {
    const int chunk = tid + 256 * i, cr = chunk >> 3, tp = (chunk & 7) * 8;
    const h16x8 v = *reinterpret_cast<const h16x8*>(src + (long)cr * SEQ + tp);
#pragma unroll
    for (int e = 0; e < 8; ++e) T[cr * 66 + tp + e] = v[e];
  }
  __syncthreads();
#pragma unroll
  for (int i = 0; i < 2; ++i) {
    const int chunk = tid + 256 * i, tr = chunk >> 3, cp = (chunk & 7) * 8;
    h16x8 o;
#pragma unroll
    for (int e = 0; e < 8; ++e) o[e] = T[(cp + e) * 66 + tr];
    *reinterpret_cast<h16x8*>(dst + (long)tr * 384 + cp) = o;
  }
  __syncthreads();
}
DI void phase_glu(const Params& P, int layer, char* smem) {
  const int tid = tidx(), lane = tid & 63, wid = tid >> 6, wr = wid >> 1, wc = wid & 1, fr = lane & 15, fq = lane >> 4;
  const h16* A = reinterpret_cast<const h16*>(P.ws + OFF_YS5PRE);
  const h16* W = reinterpret_cast<const h16*>(P.ws + OFF_WT) + (long)layer * WT_LAYER + WT_GLU;
  h16* Y = reinterpret_cast<h16*>(P.ws + OFF_YS5);
#pragma unroll 1
  for (int it = blockIdx.x; it < NBATCH * 6 * 128; it += gridDim.x) item_yhy_transpose(P, it, smem);
  asm volatile("" ::: "memory");
  const int MT = (layer == 0 ? TT : TLAT) / 128;
  const TileWalk tw = tw_init(MT, 6);
  for (int tile = tw.lb; tile < tw_count(tw); tile += tw.nlb) {
    int mt, nt; tw_decode(tw, tile, mt, nt);
    f32x4 acc[4][4]; acc_zero(acc);
    gemm_kloop(acc, A + (long)mt * 128 * 384, 384, 0, 128, W + (long)nt * 128 * 384, 384, 384, smem, opaque_tid());
    {
      float* Zs = reinterpret_cast<float*>(smem);
#pragma unroll
      for (int m = 0; m < 4; ++m)
#pragma unroll
        for (int np = 0; np < 2; ++np)
#pragma unroll
          for (int j = 0; j < 4; ++j)
            Zs[(wr * 64 + m * 16 + fq * 4 + j) * 132 + wc * 32 + np * 16 + fr] = acc[m][2 * np][j] * sigmoidf_(acc[m][2 * np + 1][j]);
      __syncthreads();
      const int t2 = tidx();
#pragma unroll
      for (int it = 0; it < 4; ++it) {
        const int chunk = it * 256 + t2, row = chunk >> 3, c8 = (chunk & 7) * 8;
        const float4 x0 = *reinterpret_cast<const float4*>(Zs + row * 132 + c8), x1 = *reinterpret_cast<const float4*>(Zs + row * 132 + c8 + 4);
        h16x8 o; o[0] = (h16)x0.x; o[1] = (h16)x0.y; o[2] = (h16)x0.z; o[3] = (h16)x0.w; o[4] = (h16)x1.x; o[5] = (h16)x1.y; o[6] = (h16)x1.z; o[7] = (h16)x1.w;
        *reinterpret_cast<h16x8*>(Y + (long)(mt * 128 + row) * 384 + nt * 64 + c8) = o;
      }
      __syncthreads();
    }
  }
}
DI void phase_merge(const Params& P, int layer, char* smem) {
  const h16* H = reinterpret_cast<const h16*>(P.ws + OFF_H1);
  const h16* WL = reinterpret_cast<const h16*>(P.ws + OFF_WT) + (long)layer * WT_LAYER;
  h16* Mg = reinterpret_cast<h16*>(P.ws + OFF_MERGED);
  const int MT = (layer == 0 ? TT : TLAT) / 128;
  const TileWalk tw = tw_init(MT, 8);
  for (int tile = tw.lb; tile < tw_count(tw); tile += tw.nlb) {
    int mt, nt; tw_decode(tw, tile, mt, nt);
    h16* Tmp = reinterpret_cast<h16*>(P.ws + OFF_YS5PRE) + (long)blockIdx.x * 32768;
    h16* Run = Tmp + 16384;
#pragma unroll 1
    for (int br = 0; br < 3; ++br) {
      const h16* Ab; const h16* Wb; int Kb;
      if (br == 0) { Ab = reinterpret_cast<const h16*>(P.ws + OFF_YHY) + (long)mt * 128 * 384; Wb = WL + WT_BRHY + (long)nt * 128 * 384; Kb = 384; }
      else if (br == 1) { Ab = reinterpret_cast<const h16*>(P.ws + OFF_YS5) + (long)mt * 128 * 384; Wb = WL + WT_BRS5 + (long)nt * 128 * 384; Kb = 384; }
      else { Ab = reinterpret_cast<const h16*>(P.ws + OFF_YMLA) + (long)mt * 128 * 512; Wb = WL + WT_BRMLA + (long)nt * 128 * 512; Kb = 512; }
      {
        f32x4 acc[4][4]; acc_zero(acc);
        gemm_kloop(acc, Ab, Kb, 0, 128, Wb, Kb, Kb, smem, opaque_tid());
        const int tid = tidx();
#pragma unroll
        for (int m = 0; m < 4; ++m)
#pragma unroll
          for (int n = 0; n < 4; ++n) {
            h16x4 o; o[0] = (h16)acc[m][n][0]; o[1] = (h16)acc[m][n][1]; o[2] = (h16)acc[m][n][2]; o[3] = (h16)acc[m][n][3];
            *reinterpret_cast<h16x4*>(Tmp + ((m * 4 + n) * 256 + tid) * 4) = o;
          }
      }
      f32x4 acc[4][4]; acc_zero(acc);
      gemm_kloop(acc, H + (long)mt * 128 * LD1, LD1, 0, 128, WL + WT_WGATE + (long)(br * 1024 + nt * 128) * LD1, LD1, 1024, smem, opaque_tid());
      const int tid = tidx();
      h16x4 bv[16], rv[16];
#pragma unroll
      for (int q = 0; q < 16; ++q) bv[q] = *reinterpret_cast<const h16x4*>(Tmp + (q * 256 + tid) * 4);
      if (br > 0) {
#pragma unroll
        for (int q = 0; q < 16; ++q) rv[q] = *reinterpret_cast<const h16x4*>(Run + (q * 256 + tid) * 4);
      } else {
#pragma unroll
        for (int q = 0; q < 16; ++q) rv[q] = h16x4{(h16)0.f, (h16)0.f, (h16)0.f, (h16)0.f};
      }
#pragma unroll
      for (int m = 0; m < 4; ++m)
#pragma unroll
        for (int n = 0; n < 4; ++n)
#pragma unroll
          for (int j = 0; j < 4; ++j) acc[m][n][j] = (float)rv[m * 4 + n][j] + sigmoidf_(acc[m][n][j]) * (float)bv[m * 4 + n][j];
      if (br < 2) {
#pragma unroll
        for (int m = 0; m < 4; ++m)
#pragma unroll
          for (int n = 0; n < 4; ++n) {
            h16x4 o; o[0] = (h16)acc[m][n][0]; o[1] = (h16)acc[m][n][1]; o[2] = (h16)acc[m][n][2]; o[3] = (h16)acc[m][n][3];
            *reinterpret_cast<h16x4*>(Run + ((m * 4 + n) * 256 + tid) * 4) = o;
          }
      } else {
        float* Zs = reinterpret_cast<float*>(smem);
        stage_acc(acc, Zs, tid);
        copy_out_f16(Zs, Mg, (long)mt * 128, LD1, nt * 128, tid);
        __syncthreads();
      }
    }
  }
}
DI void phase_resid(const Params& P, int layer, int stage_src, size_t a_off, int K, long w_off, int gate_idx, char* smem) {
  const int tid = tidx(), lane = tid & 63, wid = tid >> 6, wr = wid >> 1, wc = wid & 1, fr = lane & 15, fq = lane >> 4;
  const h16* A = reinterpret_cast<const h16*>(P.ws + a_off);
  const h16* W = reinterpret_cast<const h16*>(P.ws + OFF_WT) + (long)layer * WT_LAYER + w_off;
  const float* mod = reinterpret_cast<const float*>(P.ws + OFF_MOD) + (long)layer * 9 * 6144 + gate_idx * 1024;
  const int MT = (layer == 0 ? TT : TLAT) / 128;
  const TileWalk tw = tw_init(MT, 8);
  for (int tile = tw.lb; tile < tw_count(tw); tile += tw.nlb) {
    int mt, nt; tw_decode(tw, tile, mt, nt);
    f32x4 acc[4][4]; acc_zero(acc);
    const int ld = K == 1024 ? LD1 : LD2;
    gemm_kloop(acc, A + (long)mt * 128 * ld, ld, 0, 128, W + (long)nt * 128 * ld, ld, K, smem, opaque_tid());
    const Tok tk = tokinfo(mt * 128);
    float* Zs = reinterpret_cast<float*>(smem);
    const int t2 = tidx();
    stage_acc(acc, Zs, t2);
    const int c4 = (t2 & 31) * 4;
    const float4 g4 = *reinterpret_cast<const float4*>(mod + tk.mrow * 6144 + nt * 128 + c4);
#pragma unroll
    for (int it = 0; it < 16; ++it) {
      const int row = it * 8 + (t2 >> 5); const int t = mt * 128 + row;
      const float4 a4 = *reinterpret_cast<const float4*>(Zs + row * 132 + c4);
      const float4 x4 = *reinterpret_cast<const float4*>(xrow_src(P, stage_src, t) + nt * 128 + c4);
      *reinterpret_cast<float4*>(xrow_dst(P, t) + nt * 128 + c4) = make_float4(x4.x + g4.x * a4.x, x4.y + g4.y * a4.y, x4.z + g4.z * a4.z, x4.w + g4.w * a4.w);
    }
    __syncthreads();
  }
}
DI void phase_ffn_up(const Params& P, int layer, char* smem) {
  const int tid = tidx(), lane = tid & 63, wid = tid >> 6, wr = wid >> 1, wc = wid & 1, fr = lane & 15, fq = lane >> 4;
  const h16* H = reinterpret_cast<const h16*>(P.ws + OFF_H2);
  const h16* W = reinterpret_cast<const h16*>(P.ws + OFF_WT) + (long)layer * WT_LAYER + WT_UP;
  h16* F = reinterpret_cast<h16*>(P.ws + OFF_F);
  const float* cw = P.in[I_FCW] + (long)layer * 3 * 5632; const float* cb = P.in[I_FCB] + (long)layer * 5632;
  float* Zs = reinterpret_cast<float*>(smem);
  const int n_mt = 8 * 66 + (layer == 0 ? 8 * 3 : 0);
  const TileWalk tw = tw_init(n_mt, 44);
  for (int tile = tw.lb; tile < tw_count(tw); tile += tw.nlb) {
    int mi, nt; tw_decode(tw, tile, mi, nt);
    int seq0, Ls, ti;
    if (mi < 528) { seq0 = (mi / 66) * SEQ; Ls = SEQ; ti = mi % 66; } else { const int u = mi - 528; seq0 = TLAT + (u / 3) * CTXL; Ls = CTXL; ti = u % 3; }
    const int p0 = ti * 126 - 1;
    const int a_lo = ti == 0 ? 1 : 0, a_hi = min(128, Ls - p0);
    const int nout = min(126, Ls - ti * 126);
    f32x4 acc[4][4]; acc_zero(acc);
    gemm_kloop(acc, H + ((long)seq0 + p0) * LD1, LD1, a_lo, a_hi, W + (long)nt * 128 * LD1, LD1, 1024, smem, opaque_tid());
#pragma unroll
    for (int m = 0; m < 4; ++m)
#pragma unroll
      for (int n = 0; n < 4; ++n)
#pragma unroll
        for (int j = 0; j < 4; ++j)
          Zs[(wr * 64 + m * 16 + fq * 4 + j) * 132 + 2 * (wc * 32 + (n >> 1) * 16 + fr) + (n & 1)] = acc[m][n][j];
    __syncthreads();
    {
      const int jc = tid & 63, rg = tid >> 6;
      const float2* Z2 = reinterpret_cast<const float2*>(Zs);
      const int cu = nt * 64 + jc, cg = 2816 + cu;
      const float wu0 = cw[cu], wu1 = cw[5632 + cu], wu2 = cw[2 * 5632 + cu], bu = cb[cu];
      const float wg0 = cw[cg], wg1 = cw[5632 + cg], wg2 = cw[2 * 5632 + cg], bg = cb[cg];
      const int r0 = rg * 32 + 1, r1 = min(r0 + 31, nout);
      float2 zm = Z2[(r0 - 1) * 66 + jc], z0 = Z2[r0 * 66 + jc];
      h16* fp = F + ((long)seq0 + p0 + r0) * LD2 + cu;
#pragma unroll 4
      for (int r = r0; r <= r1; ++r) {
        const float2 zp = Z2[(r + 1) * 66 + jc];
        const float au = wu0 * zm.x + wu1 * z0.x + wu2 * zp.x + bu;
        const float ag = wg0 * zm.y + wg1 * z0.y + wg2 * zp.y + bg;
        *fp = (h16)(siluf_(au) * ag); fp += LD2;
        zm = z0; z0 = zp;
      }
    }
    __syncthreads();
  }
}
DI void phase_norm2(const Params& P, int layer) { normmod_rows(P, layer, 1, 1, layer == 0 ? TT : TLAT, blockIdx.x, gridDim.x); }

constexpr int N_PHASES = 22;
#ifndef PROBE_REPEAT
#define PROBE_REPEAT 0u
#endif
template <int PH> DI void run_phase_t(const Params& P, char* smem) {
  asm volatile("" ::: "memory");
  if constexpr (PH == 0) phase_prologue(P, smem);
  else if constexpr (PH == 21) phase_final(P);
  else {
    constexpr int layer = (PH - 1) / 10, s = (PH - 1) % 10;
    if constexpr (s == 0) phase_norm1(P, layer, smem);
    else if constexpr (s == 1) phase_gemm_in(P, layer, smem);
    else if constexpr (s == 2) phase_mix1(P, layer, smem);
    else if constexpr (s == 3) phase_mix2(P, layer, smem);
    else if constexpr (s == 4) phase_glu(P, layer, smem);
    else if constexpr (s == 5) phase_merge(P, layer, smem);
    else if constexpr (s == 6) phase_resid(P, layer, layer, OFF_MERGED, 1024, WT_WO, 2, smem);
    else if constexpr (s == 7) phase_norm2(P, layer);
    else if constexpr (s == 8) phase_ffn_up(P, layer, smem);
    else phase_resid(P, layer, 1, OFF_F, 2816, WT_DOWN, 5, smem);
  }
}
DI void run_phase(const Params& P, int ph, char* smem) {
  switch (ph) {
#define RP(i) case i: run_phase_t<i>(P, smem); break;
    RP(0) RP(1) RP(2) RP(3) RP(4) RP(5) RP(6) RP(7) RP(8) RP(9) RP(10) RP(11) RP(12) RP(13) RP(14) RP(15) RP(16) RP(17) RP(18) RP(19) RP(20) RP(21)
#undef RP
    default: break;
  }
}
#ifndef MULTI_LAUNCH
#define MULTI_LAUNCH 0
#endif
#define XB_TMO      128
#define XB_XCNT(j)  (256  + 64 * (j))
#define XB_XSUB(j)  (1280 + 64 * (j))
#define XB_XGEN(j)  (2304 + 64 * (j))
#define XB_TOP      3328
#define XB_TOPGEN   3392
#define XCD_BAR_WORDS 3456
#define XB_SPIN_CAP (1u << 22)
#define LAS __attribute__((address_space(3)))
DI unsigned xb_ld(unsigned* p)              { return __hip_atomic_load(p, __ATOMIC_RELAXED, __HIP_MEMORY_SCOPE_AGENT); }
DI unsigned xb_add(unsigned* p, unsigned v) { return __hip_atomic_fetch_add(p, v, __ATOMIC_RELAXED, __HIP_MEMORY_SCOPE_AGENT); }
DI unsigned xb_xcc_id() { return (unsigned)__builtin_amdgcn_s_getreg((3 << 11) | 20) & 0xFu; }
#define XB_SPIN(cond, bar) do { unsigned _sp = 0; while (cond) { __builtin_amdgcn_s_sleep(1); \
    if ((++_sp & 255u) == 0u) { if (xb_ld(&(bar)[XB_TMO])) break; if (_sp > XB_SPIN_CAP) { atomicAdd(&(bar)[XB_TMO], 1u); break; } } } } while (0)
struct XcdBarrier { unsigned* bar; unsigned x; volatile LAS unsigned* st; };
DI XcdBarrier xcd_barrier_post(unsigned* bar, volatile LAS unsigned* st) {
  XcdBarrier b; b.bar = bar; b.x = xb_xcc_id(); b.st = st;
  if (threadIdx.x == 0) (void)xb_add(&bar[XB_XCNT(b.x)], 1u);
  return b;
}
DI void xcd_barrier_complete(unsigned* bar, unsigned x, unsigned& nloc, unsigned& nx) {
  const unsigned G = gridDim.x * gridDim.y * gridDim.z;
  unsigned sum, cnt, mine, sp = 0u;
  for (;;) {
    sum = 0u; cnt = 0u; mine = 0u;
#pragma unroll
    for (unsigned j = 0; j < 16; ++j) { const unsigned c = xb_ld(&bar[XB_XCNT(j)]); sum += c; cnt += (c > 0u) ? 1u : 0u; mine = (j == x) ? c : mine; }
    if (sum == G) break;
    __builtin_amdgcn_s_sleep(1);
    if ((++sp & 255u) == 0u) { if (xb_ld(&bar[XB_TMO])) break; if (sp > XB_SPIN_CAP) { atomicAdd(&bar[XB_TMO], 1u); break; } }
  }
  nloc = mine > 0u ? mine : 1u; nx = cnt > 0u ? cnt : 1u;
}
DI void xcd_barrier(const XcdBarrier& b) {
  asm volatile("s_waitcnt vmcnt(0)" ::: "memory");
  __syncthreads();
  if (threadIdx.x == 0) {
    unsigned* bar = b.bar;
    __builtin_amdgcn_s_waitcnt(0);
    unsigned nloc = b.st[0], nx = b.st[1];
    if (nloc == 0u) { xcd_barrier_complete(bar, b.x, nloc, nx); b.st[0] = nloc; b.st[1] = nx; }
    const unsigned old = xb_add(&bar[XB_XSUB(b.x)], 1u);
    const unsigned gen = old / nloc;
    if (old + 1u == (gen + 1u) * nloc) {
      __builtin_amdgcn_fence(__ATOMIC_RELEASE, "agent");
      asm volatile("s_waitcnt vmcnt(0)" ::: "memory");
      const unsigned og = xb_add(&bar[XB_TOP], 1u);
      const unsigned tg = og / nx;
      if (og + 1u == (tg + 1u) * nx) xb_add(&bar[XB_TOPGEN], 1u);
      else XB_SPIN(xb_ld(&bar[XB_TOPGEN]) == tg, bar);
      __builtin_amdgcn_fence(__ATOMIC_ACQUIRE, "agent");
      xb_add(&bar[XB_XGEN(b.x)], 1u);
      asm volatile("s_waitcnt vmcnt(0)" ::: "memory");
    } else {
      XB_SPIN(xb_ld(&bar[XB_XGEN(b.x)]) == gen, bar);
      __builtin_amdgcn_fence(__ATOMIC_ACQUIRE, "agent");
      asm volatile("s_waitcnt vmcnt(0)" ::: "memory");
    }
  }
  __syncthreads();
}
__global__ void __launch_bounds__(NTHREADS, 2) fwd_megakernel(Params P) {
  extern __shared__ __attribute__((aligned(16))) char smem[];
  cg::grid_group grid = cg::this_grid();
  volatile LAS unsigned* st = (volatile LAS unsigned*)(smem + SMEM_BYTES - 16);
  if (threadIdx.x == 0) { st[0] = 0u; st[1] = 0u; st[2] = 0u; st[3] = 0u; }
  __syncthreads();
  const XcdBarrier xb = xcd_barrier_post(reinterpret_cast<unsigned*>(P.ws + OFF_BAR), st);
  run_phase_t<0>(P, smem); grid.sync();
#define RP(i) run_phase_t<i>(P, smem); xcd_barrier(xb); if constexpr ((PROBE_REPEAT >> i) & 1) { run_phase_t<i>(P, smem); xcd_barrier(xb); }
  RP(1) RP(2) RP(3) RP(4) RP(5) RP(6) RP(7) RP(8) RP(9) RP(10) RP(11) RP(12) RP(13) RP(14) RP(15) RP(16) RP(17) RP(18) RP(19) RP(20)
#undef RP
#ifdef PROBE_SYNC
  for (int i = 0; i < PROBE_SYNC; ++i) xcd_barrier(xb);
#endif
  run_phase_t<21>(P, smem);
}
#if MULTI_LAUNCH
__global__ void __launch_bounds__(NTHREADS, 2) fwd_phase_kernel(Params P, int ph) {
  extern __shared__ __attribute__((aligned(16))) char smem[];
  run_phase(P, ph, smem);
}
#endif

extern "C" void kernel_launch(void* const* d_in, const int* in_sizes, int n_in, void* d_out, int out_size, void* d_ws, size_t ws_size,
                              hipStream_t stream) {
  static int grid_blocks = 0;
  if (!grid_blocks) {
    int dev = 0, cus = 0, per_cu = 0;
    (void)hipGetDevice(&dev);
    (void)hipDeviceGetAttribute(&cus, hipDeviceAttributeMultiprocessorCount, dev);
    (void)hipFuncSetAttribute((const void*)fwd_megakernel, hipFuncAttributeMaxDynamicSharedMemorySize, SMEM_BYTES);
#if MULTI_LAUNCH
    (void)hipFuncSetAttribute((const void*)fwd_phase_kernel, hipFuncAttributeMaxDynamicSharedMemorySize, SMEM_BYTES);
#endif
    (void)hipOccupancyMaxActiveBlocksPerMultiprocessor(&per_cu, fwd_megakernel, NTHREADS, SMEM_BYTES);
    if (per_cu > 2) per_cu = 2;
    if (per_cu < 1) per_cu = 1;
#ifdef PROBE_FORCE2
    per_cu = 2;
#endif
    grid_blocks = cus * per_cu;
    if (ws_size < OFF_END) fprintf(stderr, "workspace too small: %zu < %zu\n", ws_size, (size_t)OFF_END);
  }
  Params p{};
  for (int i = 0; i < 41; ++i) p.in[i] = (const float*)d_in[i];
  p.out = (float*)d_out; p.ws = (char*)d_ws; p.pad_ = 0;
#if MULTI_LAUNCH
  for (int ph = 0; ph < N_PHASES; ++ph) hipLaunchKernelGGL(fwd_phase_kernel, dim3(grid_blocks), dim3(NTHREADS), SMEM_BYTES, stream, p, ph);
#else
  (void)hipMemsetAsync((char*)d_ws + OFF_BAR, 0, XCD_BAR_WORDS * 4, stream);
  void* args[] = {&p};
  hipError_t e = hipLaunchCooperativeKernel((void*)fwd_megakernel, dim3(grid_blocks), dim3(NTHREADS), args, SMEM_BYTES, stream);
  if (e != hipSuccess) fprintf(stderr, "cooperative launch failed: %s (grid %d)\n", hipGetErrorString(e), grid_blocks);
#endif
}
```

```cpp
#include <hip/hip_runtime.h>
#include <hip/hip_cooperative_groups.h>
#include <cstdio>
namespace cg = cooperative_groups;

typedef _Float16 h16;
typedef _Float16 h16x8 __attribute__((ext_vector_type(8)));
typedef _Float16 h16x4 __attribute__((ext_vector_type(4)));
typedef float f32x4 __attribute__((ext_vector_type(4)));
typedef float f32x16 __attribute__((ext_vector_type(16)));
#define DI __device__ __forceinline__

constexpr int DM = 1024, NBATCH = 8, SEQ = 8192, CTXL = 256, TLAT = 65536, TCTX = 2048, TT = 67584;
constexpr int KEYS = SEQ + CTXL;
constexpr int NTHREADS = 256;
constexpr float EPS = 1e-6f;
constexpr float QSCALE = 0.10206207261596575f * 1.4426950408889634f;

constexpr int LD1 = 1088, LD2 = 2880;
constexpr long WT_WIN = 0, WT_WGATE = WT_WIN + 2432L * LD1, WT_UKV = WT_WGATE + 3072L * LD1, WT_UQ = WT_UKV + 1024L * 256,
               WT_GLU = WT_UQ + 1024L * 512, WT_BRHY = WT_GLU + 768L * 384, WT_BRS5 = WT_BRHY + 1024L * 384,
               WT_BRMLA = WT_BRS5 + 1024L * 384, WT_WO = WT_BRMLA + 1024L * 512, WT_UP = WT_WO + 1024L * LD1,
               WT_DOWN = WT_UP + 5632L * LD1, WT_LAYER = WT_DOWN + 1024L * LD2;
constexpr size_t al256(size_t x) { return (x + 255) / 256 * 256; }
constexpr size_t OFF_WT = 0;
constexpr size_t OFF_H1 = al256(OFF_WT + 2 * WT_LAYER * 2);
constexpr size_t OFF_U = al256(OFF_H1 + (size_t)TT * LD1 * 2);
constexpr size_t OFF_KVLAT = al256(OFF_U + (size_t)TT * 384 * 2);
constexpr size_t OFF_QLAT = al256(OFF_KVLAT + (size_t)TT * 256 * 2);
constexpr size_t OFF_PHY = al256(OFF_QLAT + (size_t)TT * 512 * 2);
constexpr size_t OFF_PHYC = al256(OFF_PHY + (size_t)NBATCH * 1152 * SEQ * 2);
constexpr size_t OFF_Q = al256(OFF_PHYC + (size_t)NBATCH * 1152 * CTXL * 2);
constexpr size_t OFF_K = al256(OFF_Q + (size_t)64 * KEYS * 96 * 2);
constexpr size_t OFF_VT = al256(OFF_K + (size_t)64 * KEYS * 96 * 2);
constexpr size_t OFF_YS5PRE = al256(OFF_VT + (size_t)64 * 64 * KEYS * 2);
constexpr size_t OFF_YHY = al256(OFF_YS5PRE + (size_t)TT * 384 * 2);
constexpr size_t OFF_FILT = al256(OFF_YHY + (size_t)TT * 384 * 2);
constexpr size_t OFF_TAPSC = al256(OFF_FILT + (size_t)768 * 2 * SEQ * 8);
constexpr size_t OFF_E = al256(OFF_TAPSC + (size_t)768 * 2 * CTXL * 4);
constexpr size_t OFF_XC = al256(OFF_E + (size_t)NBATCH * 2 * 24 * 132 * 64 * 8);
constexpr size_t OFF_MOD = al256(OFF_XC + (size_t)TCTX * 1024 * 4);
constexpr size_t OFF_Z2 = al256(OFF_MOD + (size_t)2 * 9 * 6144 * 4);
constexpr size_t OFF_Z2C = al256(OFF_Z2 + (size_t)2 * SEQ * 64 * 4);
constexpr size_t OFF_S5A = al256(OFF_Z2C + (size_t)2 * CTXL * 64 * 4);
constexpr size_t OFF_S5A64 = al256(OFF_S5A + (size_t)2 * 2 * 24 * 64 * 8);
constexpr size_t OFF_S5B = al256(OFF_S5A64 + (size_t)2 * 2 * 24 * 64 * 8);
constexpr size_t OFF_S5C = al256(OFF_S5B + (size_t)2 * 2 * 24 * 64 * 16 * 8);
constexpr size_t OFF_ROPE = al256(OFF_S5C + (size_t)2 * 2 * 24 * 16 * 128 * 2);
constexpr size_t OFF_BAR = al256(OFF_ROPE + (size_t)SEQ * 16 * 8);
constexpr size_t OFF_END = al256(OFF_BAR + (size_t)3456 * 4);
constexpr size_t OFF_YS5 = OFF_U, OFF_YMLA = OFF_QLAT, OFF_MERGED = OFF_Q, OFF_F = OFF_U, OFF_H2 = OFF_H1;
static_assert(OFF_END <= (size_t)1024 * 1024 * 1024, "workspace over 1 GiB");
static_assert(OFF_F + (size_t)TT * LD2 * 2 <= OFF_FILT, "f alias overruns");
static_assert(OFF_MERGED + (size_t)TT * LD1 * 2 <= OFF_VT, "merged alias overruns");

constexpr int SMEM_BYTES = 73728 + 2048;

struct Params {
  const float* in[41];
  float* out;
  char* ws;
  unsigned long long pad_;
};
enum { I_X = 0, I_C, I_CTX, I_CCTX, I_WMOD, I_BMOD, I_N1G, I_N2G, I_WIN, I_HCW, I_HCB, I_FW1, I_FB1, I_FW2, I_FB2, I_FW3, I_FFREQ,
       I_FDECAY, I_HBIAS, I_LAMRE, I_LAMIM, I_LOGSTEP, I_BRE, I_BIM, I_CRE, I_CIM, I_S5D, I_WGLU, I_GQ, I_WUQ, I_GKV, I_WUKV,
       I_WBRHY, I_WBRS5, I_WBRMLA, I_WO, I_WUP, I_FCW, I_FCB, I_WDOWN, I_FINALG };

DI int tidx() { int t = threadIdx.x; asm volatile("" : "+v"(t)); return t; }
DI int opaque_tid() { return tidx(); }
DI float sigmoidf_(float x) { return 1.f / (1.f + __expf(-x)); }
DI float siluf_(float x) { return x / (1.f + __expf(-x)); }
DI float geluf_(float x) { float z = 0.7978845608028654f * (x + 0.044715f * x * x * x); float t = 1.f - 2.f / (1.f + __expf(2.f * z)); return 0.5f * x * (1.f + t); }
DI float wave_sum(float v) { for (int o = 32; o > 0; o >>= 1) v += __shfl_xor(v, o); return v; }
DI float wave_max(float v) { for (int o = 32; o > 0; o >>= 1) v = fmaxf(v, __shfl_xor(v, o)); return v; }
DI void dsincos(double x, double& s, double& c) {
  const double TWO_PI = 6.283185307179586476925287;
  double r = x - TWO_PI * rint(x / TWO_PI);
  double r2 = r * r, ts = r, tc = 1.0; s = r; c = 1.0;
  for (int k = 1; k <= 15; ++k) { tc = -tc * r2 / (double)((2 * k - 1) * (2 * k)); c += tc; ts = -ts * r2 / (double)((2 * k) * (2 * k + 1)); s += ts; }
}
DI float2 twid(float f) { return make_float2(__builtin_amdgcn_cosf(f), __builtin_amdgcn_sinf(f)); }
DI float2 cmul(float2 a, float2 b) { return make_float2(a.x * b.x - a.y * b.y, a.x * b.y + a.y * b.x); }

struct Tok { int b, pos, ctx, mrow; };
DI Tok tokinfo(int t) { Tok k; if (t < TLAT) { k.b = t >> 13; k.pos = t & 8191; k.ctx = 0; k.mrow = k.b; } else { int u = t - TLAT; k.b = u >> 8; k.pos = u & 255; k.ctx = 1; k.mrow = 8; } return k; }

struct Stg { uint4 a0, a1, a2, a3, b0, b1, b2, b3; };
DI void g_load(Stg& s, const h16* __restrict__ A0, const h16* __restrict__ A1, const h16* __restrict__ A2, const h16* __restrict__ A3,
               const h16* __restrict__ Bp, long b32, int k0) {
  s.a0 = *reinterpret_cast<const uint4*>(A0 + k0); s.a1 = *reinterpret_cast<const uint4*>(A1 + k0);
  s.a2 = *reinterpret_cast<const uint4*>(A2 + k0); s.a3 = *reinterpret_cast<const uint4*>(A3 + k0);
  s.b0 = *reinterpret_cast<const uint4*>(Bp + k0); s.b1 = *reinterpret_cast<const uint4*>(Bp + b32 + k0);
  s.b2 = *reinterpret_cast<const uint4*>(Bp + 2 * b32 + k0); s.b3 = *reinterpret_cast<const uint4*>(Bp + 3 * b32 + k0);
}
DI uint4 zsel(uint4 v, bool ok) { return ok ? v : make_uint4(0, 0, 0, 0); }
DI void s_write(char* sw, const Stg& s, int okm) {
  *reinterpret_cast<uint4*>(sw) = zsel(s.a0, okm & 1); *reinterpret_cast<uint4*>(sw + 32 * 128) = zsel(s.a1, okm & 2);
  *reinterpret_cast<uint4*>(sw + 64 * 128) = zsel(s.a2, okm & 4); *reinterpret_cast<uint4*>(sw + 96 * 128) = zsel(s.a3, okm & 8);
  *reinterpret_cast<uint4*>(sw + 16384) = s.b0; *reinterpret_cast<uint4*>(sw + 16384 + 32 * 128) = s.b1; *reinterpret_cast<uint4*>(sw + 16384 + 64 * 128) = s.b2; *reinterpret_cast<uint4*>(sw + 16384 + 96 * 128) = s.b3;
}
#ifndef PROBE_MFMA
#define PROBE_MFMA 0
#endif
#if PROBE_MFMA
DI void mma_step(f32x4 (&acc)[4][4], const char* sa, const char* sb, int o0, int o1, f32x4 (&dmy)[2][4]) {
#else
DI void mma_step(f32x4 (&acc)[4][4], const char* sa, const char* sb, int o0, int o1) {
#endif
  __builtin_amdgcn_s_setprio(1);
#pragma unroll
  for (int ks = 0; ks < 2; ++ks) {
    h16x8 af[4], bf[4];
    const int o = ks ? o1 : o0;
#pragma unroll
    for (int m = 0; m < 4; ++m) af[m] = *reinterpret_cast<const h16x8*>(sa + m * 16 * 128 + o);
#pragma unroll
    for (int n = 0; n < 4; ++n) bf[n] = *reinterpret_cast<const h16x8*>(sb + n * 16 * 128 + o);
#pragma unroll
    for (int m = 0; m < 4; ++m)
#pragma unroll
      for (int n = 0; n < 4; ++n) acc[m][n] = __builtin_amdgcn_mfma_f32_16x16x32_f16(af[m], bf[n], acc[m][n], 0, 0, 0);
#if PROBE_MFMA
#pragma unroll
    for (int m = 0; m < 2; ++m)
#pragma unroll
      for (int n = 0; n < 4; ++n) dmy[m][n] = __builtin_amdgcn_mfma_f32_16x16x32_f16(af[m + 2], bf[n], dmy[m][n], 0, 0, 0);
#endif
  }
  __builtin_amdgcn_s_setprio(0);
}
DI void gemm_kloop_body(f32x4 (&acc)[4][4], const h16* __restrict__ A, long lda, int a_lo, int a_hi,
                   const h16* __restrict__ Bt, long ldb, int K, char* smem, int tid) {
  const int lane = tid & 63, wid = tid >> 6, wr = wid >> 1, wc = wid & 1, fr = lane & 15, fq = lane >> 4;
#if PROBE_MFMA
  f32x4 dmy[2][4];
  for (int m = 0; m < 2; ++m) for (int n = 0; n < 4; ++n) dmy[m][n] = f32x4{0.f, 0.f, 0.f, 0.f};
#define MMA(a, b, c, d, e) mma_step(a, b, c, d, e, dmy)
#else
#define MMA(a, b, c, d, e) mma_step(a, b, c, d, e)
#endif
  Stg s0, s1;
  const int srow = tid >> 3, skc = tid & 7;
  int okm = 0;
  const h16* Ar[4];
#pragma unroll
  for (int i = 0; i < 4; ++i) { const int row = srow + 32 * i; const bool ok = row >= a_lo && row < a_hi; okm |= ok ? (1 << i) : 0;
    const int rc = min(max(row, a_lo), a_hi - 1); Ar[i] = A + (long)rc * lda + skc * 8; }
  const h16* Bp = Bt + (long)srow * ldb + skc * 8;
  const long b32 = 32 * ldb;
  char* sw = smem + srow * 128 + ((skc ^ ((srow >> 1) & 7)) << 4);
  const char* sra = smem + (wr * 64 + fr) * 128; const char* srb = smem + 16384 + (wc * 64 + fr) * 128;
  const int o0 = (fq ^ ((fr >> 1) & 7)) << 4, o1 = ((4 + fq) ^ ((fr >> 1) & 7)) << 4;
  const int nk = K >> 6;
  g_load(s0, Ar[0], Ar[1], Ar[2], Ar[3], Bp, b32, 0); g_load(s1, Ar[0], Ar[1], Ar[2], Ar[3], Bp, b32, 64);
  s_write(sw, s0, okm); __syncthreads();
  for (int kt = 0; kt + 2 < nk; kt += 2) {
    g_load(s0, Ar[0], Ar[1], Ar[2], Ar[3], Bp, b32, (kt + 2) << 6);
    __builtin_amdgcn_sched_barrier(0);
    MMA(acc, sra, srb, o0, o1);
    __builtin_amdgcn_sched_barrier(0);
    s_write(sw + 32768, s1, okm);
    __syncthreads();
    g_load(s1, Ar[0], Ar[1], Ar[2], Ar[3], Bp, b32, (kt + 3) << 6);
    __builtin_amdgcn_sched_barrier(0);
    MMA(acc, sra + 32768, srb + 32768, o0, o1);
    __builtin_amdgcn_sched_barrier(0);
    s_write(sw, s0, okm);
    __syncthreads();
  }
  MMA(acc, sra, srb, o0, o1);
  s_write(sw + 32768, s1, okm);
  __syncthreads();
  MMA(acc, sra + 32768, srb + 32768, o0, o1);
  __syncthreads();
#if PROBE_MFMA
  { float z = 0.f; asm volatile("" : "+v"(z)); for (int m = 0; m < 2; ++m) for (int n = 0; n < 4; ++n) acc[m][n] += dmy[m][n] * z; }
#endif
#undef MMA
}
#ifndef PROBE_KLOOP
#define PROBE_KLOOP 0
#endif
DI void gemm_kloop(f32x4 (&acc)[4][4], const h16* __restrict__ A, long lda, int a_lo, int a_hi,
                   const h16* __restrict__ Bt, long ldb, int K, char* smem, int tid) {
  gemm_kloop_body(acc, A, lda, a_lo, a_hi, Bt, ldb, K, smem, tid);
}
struct TileWalk { int lb, nlb, m0, Mx, NT, nfull; };
DI TileWalk tw_init(int MT, int NT) { TileWalk w; w.lb = blockIdx.x >> 3; w.nlb = gridDim.x >> 3; w.Mx = MT >> 3; w.m0 = (blockIdx.x & 7) * w.Mx; w.NT = NT; w.nfull = (w.Mx >> 3) * 8 * NT; return w; }
DI int tw_count(const TileWalk& w) { return w.Mx * w.NT; }
DI void tw_decode(const TileWalk& w, int idx, int& mt, int& nt) {
  if (idx < w.nfull) { const int mg = idx / (8 * w.NT), r = idx % (8 * w.NT); nt = r >> 3; mt = w.m0 + mg * 8 + (r & 7); }
  else { const int rem = w.Mx & 7, r = idx - w.nfull; nt = r / rem; mt = w.m0 + (w.Mx & ~7) + r % rem; }
}
DI void stage_acc(const f32x4 (&acc)[4][4], float* Zs, int tid) {
  const int lane = tid & 63, wid = tid >> 6, wr = wid >> 1, wc = wid & 1, fr = lane & 15, fq = lane >> 4;
#pragma unroll
  for (int m = 0; m < 4; ++m)
#pragma unroll
    for (int n = 0; n < 4; ++n)
#pragma unroll
      for (int j = 0; j < 4; ++j) Zs[(wr * 64 + m * 16 + fq * 4 + j) * 132 + wc * 64 + n * 16 + fr] = acc[m][n][j];
  __syncthreads();
}
DI void stage_acc_t(const f32x4 (&acc)[4][4], float* Zs, int tid) {
  const int lane = tid & 63, wid = tid >> 6, wr = wid >> 1, wc = wid & 1, fr = lane & 15, fq = lane >> 4;
#pragma unroll
  for (int m = 0; m < 4; ++m)
#pragma unroll
    for (int n = 0; n < 4; ++n)
      *reinterpret_cast<float4*>(Zs + (wc * 64 + n * 16 + fr) * 132 + wr * 64 + m * 16 + fq * 4) = make_float4(acc[m][n][0], acc[m][n][1], acc[m][n][2], acc[m][n][3]);
  __syncthreads();
}
DI void copy_out_f16(const float* Zs, h16* __restrict__ dst, long row0, long ld, int cb, int tid) {
#pragma unroll
  for (int it = 0; it < 8; ++it) {
    const int chunk = it * 256 + tid, row = chunk >> 4, c8 = (chunk & 15) * 8;
    const float4 x0 = *reinterpret_cast<const float4*>(Zs + row * 132 + c8), x1 = *reinterpret_cast<const float4*>(Zs + row * 132 + c8 + 4);
    h16x8 o; o[0] = (h16)x0.x; o[1] = (h16)x0.y; o[2] = (h16)x0.z; o[3] = (h16)x0.w; o[4] = (h16)x1.x; o[5] = (h16)x1.y; o[6] = (h16)x1.z; o[7] = (h16)x1.w;
    *reinterpret_cast<h16x8*>(dst + (row0 + row) * ld + cb + c8) = o;
  }
}
DI void acc_zero(f32x4 (&acc)[4][4]) {
#pragma unroll
  for (int m = 0; m < 4; ++m)
#pragma unroll
    for (int n = 0; n < 4; ++n) acc[m][n] = f32x4{0.f, 0.f, 0.f, 0.f};
}
DI void row_rms(const h16* __restrict__ A, long lda, int K, float* rs) {
  const int tid = tidx(), row = tid >> 1, half = tid & 1;
  const h16* p = A + (long)row * lda + half * (K >> 1);
  float ss = 0.f;
  for (int k = 0; k < (K >> 1); k += 8) {
    h16x8 v = *reinterpret_cast<const h16x8*>(p + k);
#pragma unroll
    for (int j = 0; j < 8; ++j) { float f = (float)v[j]; ss += f * f; }
  }
  ss += __shfl_xor(ss, 1);
  if (half == 0) rs[row] = rsqrtf(ss / (float)K + EPS);
}
DI int map_interleave(int n, int half) { int tile = n >> 7, r = n & 127, sub = r >> 4, fr = r & 15; int j = tile * 64 + (sub >> 1) * 16 + fr; return (sub & 1) ? half + j : j; }
DI int map_col(int mat, int n) {
  switch (mat) {
    case 0: if (n < 640) return n; if (n < 2304) return n + 32; if (n < 2336) return n - 2304 + 640; return -1;
    case 1: return 2336 + n;
    case 3: { int h = n >> 7, j = n & 127; return j < 96 ? h * 96 + j : -1; }
    case 4: return map_interleave(n, 384);
    case 9: return map_interleave(n, 2816);
    default: return n;
  }
}
struct MatDesc { const float* src; const float* scale; long dst; int K, Nmy, Nsrc, ld; };
DI MatDesc get_mat(const Params& P, int layer, int mat) {
  MatDesc d; d.scale = nullptr;
  d.ld = (mat == 0 || mat == 1 || mat == 8 || mat == 9) ? LD1 : 0;
  switch (mat) {
    case 0: d.src = P.in[I_WIN] + (long)layer * 1024 * 5408; d.dst = WT_WIN; d.K = 1024; d.Nmy = 2432; d.Nsrc = 5408; break;
    case 1: d.src = P.in[I_WIN] + (long)layer * 1024 * 5408; d.dst = WT_WGATE; d.K = 1024; d.Nmy = 3072; d.Nsrc = 5408; break;
    case 2: d.src = P.in[I_WUKV] + (long)layer * 256 * 1024; d.dst = WT_UKV; d.K = 256; d.Nmy = 1024; d.Nsrc = 1024; d.scale = P.in[I_GKV] + layer * 256; break;
    case 3: d.src = P.in[I_WUQ] + (long)layer * 512 * 768; d.dst = WT_UQ; d.K = 512; d.Nmy = 1024; d.Nsrc = 768; d.scale = P.in[I_GQ] + layer * 512; break;
    case 4: d.src = P.in[I_WGLU] + (long)layer * 384 * 768; d.dst = WT_GLU; d.K = 384; d.Nmy = 768; d.Nsrc = 768; break;
    case 5: d.src = P.in[I_WBRHY] + (long)layer * 384 * 1024; d.dst = WT_BRHY; d.K = 384; d.Nmy = 1024; d.Nsrc = 1024; break;
    case 6: d.src = P.in[I_WBRS5] + (long)layer * 384 * 1024; d.dst = WT_BRS5; d.K = 384; d.Nmy = 1024; d.Nsrc = 1024; break;
    case 7: d.src = P.in[I_WBRMLA] + (long)layer * 512 * 1024; d.dst = WT_BRMLA; d.K = 512; d.Nmy = 1024; d.Nsrc = 1024; break;
    case 8: d.src = P.in[I_WO] + (long)layer * 1024 * 1024; d.dst = WT_WO; d.K = 1024; d.Nmy = 1024; d.Nsrc = 1024; break;
    case 9: d.src = P.in[I_WUP] + (long)layer * 1024 * 5632; d.dst = WT_UP; d.K = 1024; d.Nmy = 5632; d.Nsrc = 5632; break;
    default: d.src = P.in[I_WDOWN] + (long)layer * 2816 * 1024; d.dst = WT_DOWN; d.K = 2816; d.Nmy = 1024; d.Nsrc = 1024; d.ld = LD2; break;
  }
  if (d.ld == 0) d.ld = d.K;
  return d;
}
constexpr int WT_TILES_PER_LAYER = 608 + 768 + 64 + 128 + 72 + 96 + 96 + 128 + 256 + 1408 + 704;
DI void item_wt(const Params& P, int item, char* smem) {
  const int layer = item / WT_TILES_PER_LAYER; int r = item % WT_TILES_PER_LAYER;
  const int cnt[11] = {608, 768, 64, 128, 72, 96, 96, 128, 256, 1408, 704};
  int mat = 0;
#pragma unroll
  for (int i = 0; i < 10; ++i) { if (mat == i && r >= cnt[i]) { r -= cnt[i]; mat = i + 1; } }
  MatDesc d = get_mat(P, layer, mat);
  const int kt = d.K >> 6, n0 = (r / kt) * 64, k0 = (r % kt) * 64;
  float* tile = reinterpret_cast<float*>(smem);
  h16* dst = reinterpret_cast<h16*>(P.ws + OFF_WT) + (long)layer * WT_LAYER + d.dst;
  const int tid = tidx(), lx = tid & 63, ly = tid >> 6;
  const int sc = map_col(mat, n0 + lx);
#pragma unroll 4
  for (int i = 0; i < 16; ++i) { int kk = i * 4 + ly; tile[kk * 65 + lx] = sc >= 0 ? d.src[(long)(k0 + kk) * d.Nsrc + sc] : 0.f; }
  __syncthreads();
  const float s = d.scale ? d.scale[k0 + lx] : 1.f;
#pragma unroll 4
  for (int i = 0; i < 16; ++i) { int nn = i * 4 + ly; dst[(long)(n0 + nn) * d.ld + k0 + lx] = (h16)(tile[lx * 65 + nn] * s); }
  __syncthreads();
}
DI void item_mod(const Params& P, int item, char* smem) {
  const int layer = item / 96, n0 = (item % 96) * 64;
  float* s = reinterpret_cast<float*>(smem);
  float* part = s + 9 * 1024;
  const int tid = tidx(), lane = tid & 63, wid = tid >> 6;
  for (int i = tid; i < 9 * 1024; i += NTHREADS) { float v = i < 8192 ? P.in[I_C][i] : P.in[I_CCTX][i - 8192]; s[i] = siluf_(v); }
  __syncthreads();
  const float* w = P.in[I_WMOD] + (long)layer * 1024 * 6144 + n0 + lane;
  float acc[9];
#pragma unroll
  for (int r = 0; r < 9; ++r) acc[r] = 0.f;
#pragma unroll 32
  for (int k = wid * 256; k < wid * 256 + 256; ++k) {
    const float wv = w[(long)k * 6144];
#pragma unroll
    for (int r = 0; r < 9; ++r) acc[r] += s[r * 1024 + k] * wv;
  }
#pragma unroll
  for (int r = 0; r < 9; ++r) part[(wid * 9 + r) * 64 + lane] = acc[r];
  __syncthreads();
  float* mod = reinterpret_cast<float*>(P.ws + OFF_MOD) + (long)layer * 9 * 6144;
  for (int i = tid; i < 9 * 64; i += NTHREADS) {
    const int r = i >> 6, c = i & 63;
    mod[r * 6144 + n0 + c] = part[(0 * 9 + r) * 64 + c] + part[(1 * 9 + r) * 64 + c] + part[(2 * 9 + r) * 64 + c] + part[(3 * 9 + r) * 64 + c] + P.in[I_BMOD][layer * 6144 + n0 + c];
  }
  __syncthreads();
}
DI void item_hymlp(const Params& P, int item, char* smem) {
  const int layer = item / 132; int r = item % 132;
  const int isc = r >= 128; const int Lf = isc ? CTXL : SEQ; const int t0 = (isc ? r - 128 : r) * 64;
  float* z1 = reinterpret_cast<float*>(smem);
  const int tid = tidx(), tl = tid >> 2, h0 = (tid & 3) * 16; const int t = t0 + tl;
  const float* w1 = P.in[I_FW1] + layer * 17 * 64; const float* b1 = P.in[I_FB1] + layer * 64;
  const float* w2 = P.in[I_FW2] + layer * 64 * 64; const float* b2 = P.in[I_FB2] + layer * 64; const float* fq = P.in[I_FFREQ] + layer * 64;
  float feat[17]; feat[0] = (float)t / (float)Lf;
#pragma unroll
  for (int k = 1; k <= 8; ++k) { float rev = (float)((t * k) % Lf) / (float)Lf; feat[k] = __builtin_amdgcn_cosf(rev); feat[8 + k] = __builtin_amdgcn_sinf(rev); }
#pragma unroll 4
  for (int j = 0; j < 16; ++j) {
    const int h = h0 + j; float a = b1[h];
#pragma unroll
    for (int f = 0; f < 17; ++f) a += feat[f] * w1[f * 64 + h];
    z1[tl * 65 + h] = __sinf(fq[h] * a);
  }
  __syncthreads();
  float* z2 = isc ? reinterpret_cast<float*>(P.ws + OFF_Z2C) + (long)layer * CTXL * 64 : reinterpret_cast<float*>(P.ws + OFF_Z2) + (long)layer * SEQ * 64;
  float a2[16];
#pragma unroll
  for (int j = 0; j < 16; ++j) a2[j] = b2[h0 + j];
  for (int k = 0; k < 64; ++k) {
    const float zv = z1[tl * 65 + k];
#pragma unroll
    for (int j = 0; j < 16; ++j) a2[j] += zv * w2[k * 64 + h0 + j];
  }
#pragma unroll
  for (int j = 0; j < 16; ++j) z2[(long)t * 64 + h0 + j] = __sinf(fq[h0 + j] * a2[j]);
  __syncthreads();
}
DI void item_s5disc(const Params& P, int item) {
  const int layer = item / 12, dir = (item % 12) / 6, gb = item % 6;
  const int tid = tidx(), g = gb * 4 + (tid >> 6), n = tid & 63;
  const int ld = layer * 2 + dir; const long gi = (long)ld * 24 + g;
  const double lre = P.in[I_LAMRE][gi * 64 + n], lim = P.in[I_LAMIM][gi * 64 + n];
  const double step = exp((double)P.in[I_LOGSTEP][gi]);
  double sn, cs; dsincos(lim * step, sn, cs);
  const double mag = exp(lre * step);
  const double are = mag * cs, aim = mag * sn;
  const double nr = are - 1.0, ni = aim, den = lre * lre + lim * lim;
  const double fre = (nr * lre + ni * lim) / den, fim = (ni * lre - nr * lim) / den;
  float2* A = reinterpret_cast<float2*>(P.ws + OFF_S5A); float2* A64 = reinterpret_cast<float2*>(P.ws + OFF_S5A64);
  A[gi * 64 + n] = make_float2((float)are, (float)aim);
  double pr = are, pi = aim;
  for (int i = 0; i < 6; ++i) { double t = pr * pr - pi * pi; pi = 2.0 * pr * pi; pr = t; }
  A64[gi * 64 + n] = make_float2((float)pr, (float)pi);
  float2* Bb = reinterpret_cast<float2*>(P.ws + OFF_S5B) + (gi * 64 + n) * 16;
  const float* bre = P.in[I_BRE] + (gi * 64 + n) * 16; const float* bim = P.in[I_BIM] + (gi * 64 + n) * 16;
  for (int c = 0; c < 16; ++c) { double br = bre[c], bi = bim[c]; Bb[c] = make_float2((float)(fre * br - fim * bi), (float)(fre * bi + fim * br)); }
  h16* Ct = reinterpret_cast<h16*>(P.ws + OFF_S5C) + gi * 16 * 128;
  const float* cre = P.in[I_CRE] + gi * 16 * 64; const float* cim = P.in[I_CIM] + gi * 16 * 64;
  for (int c = 0; c < 16; ++c) { Ct[c * 128 + n] = (h16)cre[c * 64 + n]; Ct[c * 128 + 64 + n] = (h16)(-cim[c * 64 + n]); }
}
DI void item_rope(const Params& P, int item) {
  const int idx = item * NTHREADS + tidx(); const int pos = idx >> 4, i = idx & 15;
  const double inv[8] = {1.0, 0.31622776601683794, 0.1, 0.031622776601683794, 0.01, 0.0031622776601683794, 0.001, 0.00031622776601683794};
  double iv = 1.0;
#pragma unroll
  for (int k = 0; k < 8; ++k) if ((i & 7) == k) iv = inv[k];
  const double ang = (double)(i < 8 ? (pos >> 6) : (pos & 63)) * iv;
  double s, c; dsincos(ang, s, c);
  reinterpret_cast<float2*>(P.ws + OFF_ROPE)[idx] = make_float2((float)c, (float)s);
}
constexpr int PRO_N_WT = 2 * WT_TILES_PER_LAYER, PRO_N_MOD = 192, PRO_N_HY = 264, PRO_N_S5 = 24, PRO_N_ROPE = 512;
DI void phase_prologue(const Params& P, char* smem) {
  const int total = PRO_N_MOD + PRO_N_HY + PRO_N_S5 + PRO_N_ROPE + PRO_N_WT;
  for (int it = blockIdx.x; it < total; it += gridDim.x) {
    int i = it;
    if (i < PRO_N_MOD) { item_mod(P, i, smem); continue; } i -= PRO_N_MOD;
    if (i < PRO_N_HY) { item_hymlp(P, i, smem); continue; } i -= PRO_N_HY;
    if (i < PRO_N_S5) { item_s5disc(P, i); continue; } i -= PRO_N_S5;
    if (i < PRO_N_ROPE) { item_rope(P, i); continue; } i -= PRO_N_ROPE;
    item_wt(P, i, smem);
  }
}

DI const float* xrow_src(const Params& P, int layer_stage, int t) {
  if (t < TLAT) return (layer_stage == 0 ? P.in[I_X] : P.out) + (long)t * 1024;
  return (layer_stage == 0 ? P.in[I_CTX] : reinterpret_cast<const float*>(P.ws + OFF_XC)) + (long)(t - TLAT) * 1024;
}
DI float* xrow_dst(const Params& P, int t) {
  if (t < TLAT) return P.out + (long)t * 1024;
  return reinterpret_cast<float*>(P.ws + OFF_XC) + (long)(t - TLAT) * 1024;
}
DI void normmod_rows(const Params& P, int layer, int which, int stage, int ntok, int item, int nitems_stride) {
  const int tid = tidx(), lane = tid & 63, wid = tid >> 6;
  const float* g = P.in[which ? I_N2G : I_N1G] + layer * 1024;
  const float* mod = reinterpret_cast<const float*>(P.ws + OFF_MOD) + (long)layer * 9 * 6144;
  h16* H = reinterpret_cast<h16*>(P.ws + OFF_H1);
#pragma unroll 2
  for (int rg = item; rg * 4 < ntok; rg += nitems_stride) {
    const int t = rg * 4 + wid;
    const Tok k = tokinfo(t);
    const float* xr = xrow_src(P, stage, t);
    const float* sh = mod + k.mrow * 6144 + (which ? 3 : 0) * 1024; const float* sc = sh + 1024;
    float4 v[4]; float ss = 0.f;
#pragma unroll
    for (int i = 0; i < 4; ++i) { v[i] = *reinterpret_cast<const float4*>(xr + i * 256 + lane * 4); ss += v[i].x * v[i].x + v[i].y * v[i].y + v[i].z * v[i].z + v[i].w * v[i].w; }
    ss = wave_sum(ss);
    const float r = rsqrtf(ss * (1.f / 1024.f) + EPS);
#pragma unroll
    for (int i = 0; i < 4; ++i) {
      const int c = i * 256 + lane * 4;
      const float4 gg = *reinterpret_cast<const float4*>(g + c), s1 = *reinterpret_cast<const float4*>(sc + c), s0 = *reinterpret_cast<const float4*>(sh + c);
      h16x4 o;
      o[0] = (h16)(v[i].x * r * gg.x * (1.f + s1.x) + s0.x); o[1] = (h16)(v[i].y * r * gg.y * (1.f + s1.y) + s0.y);
      o[2] = (h16)(v[i].z * r * gg.z * (1.f + s1.z) + s0.z); o[3] = (h16)(v[i].w * r * gg.w * (1.f + s1.w) + s0.w);
      *reinterpret_cast<h16x4*>(H + (long)t * LD1 + c) = o;
    }
  }
}
DI void phase_final(const Params& P) {
  const int lane = tidx() & 63, wid = tidx() >> 6;
  const float* g = P.in[I_FINALG];
  for (int rg = blockIdx.x; rg * 4 < TLAT; rg += gridDim.x) {
    float* xr = P.out + (long)(rg * 4 + wid) * 1024;
    float4 v[4]; float ss = 0.f;
#pragma unroll
    for (int i = 0; i < 4; ++i) { v[i] = *reinterpret_cast<const float4*>(xr + i * 256 + lane * 4); ss += v[i].x * v[i].x + v[i].y * v[i].y + v[i].z * v[i].z + v[i].w * v[i].w; }
    ss = wave_sum(ss);
    const float r = rsqrtf(ss * (1.f / 1024.f) + EPS);
#pragma unroll
    for (int i = 0; i < 4; ++i) {
      const int c = i * 256 + lane * 4; const float4 gg = *reinterpret_cast<const float4*>(g + c);
      *reinterpret_cast<float4*>(xr + c) = make_float4(v[i].x * r * gg.x, v[i].y * r * gg.y, v[i].z * r * gg.z, v[i].w * r * gg.w);
    }
  }
}
DI float2 r8(int idx) { const float c = 0.70710678118654752f; return idx == 0 ? make_float2(1.f, 0.f) : idx == 1 ? make_float2(c, -c) : idx == 2 ? make_float2(0.f, -1.f) : make_float2(-c, -c); }
DI float2 cmul_r8(float2 w, int idx, bool cj) {
  if (idx == 0) return w;
  float2 r = r8(idx); if (cj) r.y = -r.y;
  return cmul(w, r);
}
template <int S> DI void fft_dif_pass(float2* X, int h) {
  const int hs = h >> (S - 1);
#pragma unroll 1
  for (int item = tidx(); item < (8192 >> S); item += NTHREADS) {
    const int j = item % hs, blk = item / hs, i0 = blk * 2 * h + j;
    float2 v[1 << S];
#pragma unroll
    for (int k = 0; k < (1 << S); ++k) v[k] = X[i0 + k * hs];
    float2 wp[S];
    wp[0] = twid(-(float)j / (float)(2 * h));
#pragma unroll
    for (int q = 1; q < S; ++q) wp[q] = cmul(wp[q - 1], wp[q - 1]);
#pragma unroll
    for (int q = 0; q < S; ++q) {
      const int dist = 1 << (S - 1 - q);
#pragma unroll
      for (int k = 0; k < (1 << S); ++k) {
        if (k & dist) continue;
        const float2 a = v[k], b = v[k + dist];
        const int m = k & (dist - 1);
        const float2 tw = cmul_r8(wp[q], m << (3 - (S - q)), false);
        v[k] = make_float2(a.x + b.x, a.y + b.y);
        v[k + dist] = cmul(make_float2(a.x - b.x, a.y - b.y), tw);
      }
    }
#pragma unroll
    for (int k = 0; k < (1 << S); ++k) X[i0 + k * hs] = v[k];
  }
  __syncthreads();
}
template <int S> DI void fft_dit_pass(float2* X, int hs) {
  const int hmax = hs << (S - 1);
#pragma unroll 1
  for (int item = tidx(); item < (8192 >> S); item += NTHREADS) {
    const int j = item % hs, blk = item / hs, i0 = blk * 2 * hmax + j;
    float2 v[1 << S];
#pragma unroll
    for (int k = 0; k < (1 << S); ++k) v[k] = X[i0 + k * hs];
    float2 bp[S];
    bp[S - 1] = twid((float)j / (float)(2 * hmax));
#pragma unroll
    for (int q = S - 2; q >= 0; --q) bp[q] = cmul(bp[q + 1], bp[q + 1]);
#pragma unroll
    for (int q = 0; q < S; ++q) {
      const int dist = 1 << q;
#pragma unroll
      for (int k = 0; k < (1 << S); ++k) {
        if (k & dist) continue;
        const int m = k & (dist - 1);
        const float2 tw = cmul_r8(bp[q], m << (3 - (q + 1)), true);
        const float2 a = v[k], b = cmul(v[k + dist], tw);
        v[k] = make_float2(a.x + b.x, a.y + b.y);
        v[k + dist] = make_float2(a.x - b.x, a.y - b.y);
      }
    }
#pragma unroll
    for (int k = 0; k < (1 << S); ++k) X[i0 + k * hs] = v[k];
  }
  __syncthreads();
}
DI void fft_fwd1(float2* X) { fft_dif_pass<3>(X, 4096); fft_dif_pass<3>(X, 512); fft_dif_pass<3>(X, 64); fft_dif_pass<2>(X, 8); fft_dif_pass<2>(X, 2); }
DI void fft_inv(float2* X) { fft_dit_pass<2>(X, 1); fft_dit_pass<2>(X, 4); fft_dit_pass<3>(X, 16); fft_dit_pass<3>(X, 128); fft_dit_pass<3>(X, 1024); }
#ifndef PROBE_FFT
#define PROBE_FFT 0
#endif
DI void fft_fwd(float2* X) {
#if PROBE_FFT
  fft_fwd1(X); fft_inv(X);
  for (int i = tidx(); i < 8192; i += NTHREADS) { float2 v = X[i]; X[i] = make_float2(v.x * (1.f / 8192.f), v.y * (1.f / 8192.f)); }
  __syncthreads();
#endif
  fft_fwd1(X);
}

DI float block_sum(float v, float* red) {
  v = wave_sum(v);
  __syncthreads();
  if ((tidx() & 63) == 0) red[tidx() >> 6] = v;
  __syncthreads();
  const float r = red[0] + red[1] + red[2] + red[3];
  __syncthreads();
  return r;
}
DI void item_filter(const Params& P, int layer, int oc, char* smem) {
  float2* X = reinterpret_cast<float2*>(smem); float* red = reinterpret_cast<float*>(smem + 65536);
  const int tid = tidx();
  const float* z2 = reinterpret_cast<const float*>(P.ws + OFF_Z2) + (long)layer * SEQ * 64;
  const float* w3 = P.in[I_FW3] + (long)layer * 64 * 1536; const float* dec = P.in[I_FDECAY] + layer * 1536;
  const int colf = oc, colb = 768 + oc;
  const float df = fabsf(dec[colf]), db = fabsf(dec[colb]);
  float lsum = 0.f;
#pragma unroll 2
  for (int i = 0; i < 32; ++i) {
    const int t = tid + 256 * i; const float* zr = z2 + (long)t * 64;
    float af = 0.f, ab = 0.f;
#pragma unroll 8
    for (int k = 0; k < 64; ++k) { const float z = zr[k]; af += z * w3[k * 1536 + colf]; ab += z * w3[k * 1536 + colb]; }
    const float tn = (float)t * (1.f / 8192.f);
    af *= __expf(-tn * df); ab *= __expf(-tn * db);
    lsum += fabsf(af) + fabsf(ab);
    X[t] = make_float2(af, ab);
  }
  const float nrm = block_sum(lsum, red);
  const float sc = 0.5f / 8192.f / nrm;
  float ev[32];
  float2* F = reinterpret_cast<float2*>(P.ws + OFF_FILT) + (long)oc * 2 * 8192;
#pragma unroll
  for (int i = 0; i < 32; ++i) {
    const int n = tid + 256 * i; const float lo = X[n].x; const float hi = n > 0 ? X[8192 - n].y : 0.f;
    ev[i] = (lo + hi) * sc; F[8192 + n] = make_float2((lo - hi) * sc, 0.f);
  }
  __syncthreads();
#pragma unroll
  for (int i = 0; i < 32; ++i) X[tid + 256 * i] = make_float2(ev[i], 0.f);
  __syncthreads();
  fft_fwd(X);
#pragma unroll 4
  for (int i = 0; i < 32; ++i) F[tid + 256 * i] = X[tid + 256 * i];
  __syncthreads();
#pragma unroll 4
  for (int i = 0; i < 32; ++i) { const int n = tid + 256 * i; const float d = F[8192 + n].x; const float2 w = twid(-(float)n * (1.f / 16384.f)); X[n] = make_float2(d * w.x, d * w.y); }
  __syncthreads();
  fft_fwd(X);
#pragma unroll 4
  for (int i = 0; i < 32; ++i) F[8192 + tid + 256 * i] = X[tid + 256 * i];
  __syncthreads();
}
DI void item_filter_ctx(const Params& P, int layer, int oc, char* smem) {
  float* red = reinterpret_cast<float*>(smem);
  const int t = tidx();
  const float* zr = reinterpret_cast<const float*>(P.ws + OFF_Z2C) + (long)layer * CTXL * 64 + t * 64;
  const float* w3 = P.in[I_FW3] + (long)layer * 64 * 1536; const float* dec = P.in[I_FDECAY] + layer * 1536;
  float af = 0.f, ab = 0.f;
  for (int k = 0; k < 64; ++k) { const float z = zr[k]; af += z * w3[k * 1536 + oc]; ab += z * w3[k * 1536 + 768 + oc]; }
  const float tn = (float)t * (1.f / 256.f);
  af *= __expf(-tn * fabsf(dec[oc])); ab *= __expf(-tn * fabsf(dec[768 + oc]));
  const float nrm = block_sum(fabsf(af) + fabsf(ab), red);
  float* T = reinterpret_cast<float*>(P.ws + OFF_TAPSC) + (long)oc * 512;
  T[t] = af / nrm; T[256 + t] = ab / nrm;
}

DI void phase_norm1(const Params& P, int layer, char* smem) {
  const int nfilt = 768 + (layer == 0 ? 768 : 0);
  for (int it = blockIdx.x; it < nfilt; it += gridDim.x) {
    if (it < 768) item_filter(P, layer, it, smem); else item_filter_ctx(P, layer, it - 768, smem);
  }
  normmod_rows(P, layer, 0, layer, TT, blockIdx.x, gridDim.x);
}

DI void phase_gemm_in(const Params& P, int layer, char* smem) {
  const int tid = tidx(), lane = tid & 63, wid = tid >> 6, wr = wid >> 1, wc = wid & 1, fr = lane & 15, fq = lane >> 4;
  const h16* H = reinterpret_cast<const h16*>(P.ws + OFF_H1);
  const h16* W = reinterpret_cast<const h16*>(P.ws + OFF_WT) + (long)layer * WT_LAYER + WT_WIN;
  h16* U = reinterpret_cast<h16*>(P.ws + OFF_U); h16* KV = reinterpret_cast<h16*>(P.ws + OFF_KVLAT); h16* QL = reinterpret_cast<h16*>(P.ws + OFF_QLAT);
  h16* PHY = reinterpret_cast<h16*>(P.ws + OFF_PHY); h16* PHYC = reinterpret_cast<h16*>(P.ws + OFF_PHYC); h16* Kb = reinterpret_cast<h16*>(P.ws + OFF_K);
  const float2* rope = reinterpret_cast<const float2*>(P.ws + OFF_ROPE);
  constexpr int NT = 19, MT = TT / 128;
  const TileWalk tw = tw_init(MT, NT);
  for (int tile = tw.lb; tile < tw_count(tw); tile += tw.nlb) {
    int mt, nt; tw_decode(tw, tile, mt, nt);
    f32x4 acc[4][4]; acc_zero(acc);
    gemm_kloop(acc, H + (long)mt * 128 * LD1, LD1, 0, 128, W + (long)nt * 128 * LD1, LD1, 1024, smem, opaque_tid());
    const int t0 = mt * 128; const Tok tk = tokinfo(t0);
    if (nt < 18) {
      float* Zs = reinterpret_cast<float*>(smem);
      const int t2 = tidx();
      if (nt < 9) {
        stage_acc(acc, Zs, t2);
        h16* dst; int ld, cb;
        if (nt < 3) { dst = U; ld = 384; cb = nt * 128; } else if (nt < 5) { dst = KV; ld = 256; cb = (nt - 3) * 128; } else { dst = QL; ld = 512; cb = (nt - 5) * 128; }
        copy_out_f16(Zs, dst, t0, ld, cb, t2);
      } else {
        stage_acc_t(acc, Zs, t2);
        h16* base = tk.ctx ? PHYC + (long)tk.b * 1152 * CTXL : PHY + (long)tk.b * 1152 * SEQ; const int lp = tk.ctx ? CTXL : SEQ;
        copy_out_f16(Zs, base, (nt - 9) * 128, lp, tk.pos, t2);
      }
      __syncthreads();
    } else {
      h16* R = reinterpret_cast<h16*>(smem);
      if (wc == 0) {
#pragma unroll
        for (int m = 0; m < 4; ++m)
#pragma unroll
          for (int j = 0; j < 4; ++j) {
            const int row = wr * 64 + m * 16 + fq * 4 + j; const int pos = tk.pos + row;
            float x1 = acc[m][0][j], x2 = acc[m][1][j];
            if (!tk.ctx) { const float2 cs = rope[pos * 16 + fr]; const float y1 = x1 * cs.x - x2 * cs.y, y2 = x1 * cs.y + x2 * cs.x; x1 = y1; x2 = y2; }
            R[row * 32 + fr] = (h16)x1; R[row * 32 + 16 + fr] = (h16)x2;
          }
      }
      __syncthreads();
      {
        const int t2 = tidx(); const int key0 = (tk.ctx ? SEQ : 0) + tk.pos;
#pragma unroll
        for (int it = 0; it < 2; ++it) {
          const int chunk = it * 256 + t2, row = chunk >> 2, part = chunk & 3;
          const uint4 v = *reinterpret_cast<const uint4*>(R + row * 32 + part * 8);
#pragma unroll
          for (int h = 0; h < 8; ++h) *reinterpret_cast<uint4*>(Kb + ((long)(tk.b * 8 + h) * KEYS + key0 + row) * 96 + 64 + part * 8) = v;
        }
      }
      __syncthreads();
    }
  }
}
DI void item_kv(const Params& P, int layer, int tile, char* smem) {
  const int tid = tidx(), lane = tid & 63, wid = tid >> 6, wr = wid >> 1, wc = wid & 1, fr = lane & 15, fq = lane >> 4;
  const int mt = tile >> 3, hd = tile & 7; const int t0 = mt * 128; const Tok tk = tokinfo(t0);
  const h16* A = reinterpret_cast<const h16*>(P.ws + OFF_KVLAT) + (long)t0 * 256;
  const h16* W = reinterpret_cast<const h16*>(P.ws + OFF_WT) + (long)layer * WT_LAYER + WT_UKV + (long)hd * 128 * 256;
  float* rs = reinterpret_cast<float*>(smem + 73728);
  row_rms(A, 256, 256, rs);
  f32x4 acc[4][4]; acc_zero(acc);
  gemm_kloop(acc, A, 256, 0, 128, W, 256, 256, smem, opaque_tid());
  h16* Kb = reinterpret_cast<h16*>(P.ws + OFF_K) + (long)(tk.b * 8 + hd) * KEYS * 96;
  h16* Vt = reinterpret_cast<h16*>(P.ws + OFF_VT) + (long)(tk.b * 8 + hd) * 64 * KEYS;
  const int key0 = (tk.ctx ? SEQ : 0) + tk.pos;
#pragma unroll
  for (int m = 0; m < 4; ++m) {
    const int r0 = wr * 64 + m * 16 + fq * 4;
    const float s0 = rs[r0], s1 = rs[r0 + 1], s2 = rs[r0 + 2], s3 = rs[r0 + 3];
#pragma unroll
    for (int n = 0; n < 4; ++n) {
      acc[m][n][0] *= s0; acc[m][n][1] *= s1; acc[m][n][2] *= s2; acc[m][n][3] *= s3;
      if (wc == 1) {
        h16x4 o; o[0] = (h16)acc[m][n][0]; o[1] = (h16)acc[m][n][1]; o[2] = (h16)acc[m][n][2]; o[3] = (h16)acc[m][n][3];
        *reinterpret_cast<h16x4*>(Vt + (long)(n * 16 + fr) * KEYS + key0 + r0) = o;
      }
    }
  }
  {
    float* Zs = reinterpret_cast<float*>(smem);
    const int t2 = tidx();
    stage_acc(acc, Zs, t2);
#pragma unroll
    for (int it = 0; it < 4; ++it) {
      const int chunk = it * 256 + t2, row = chunk >> 3, c8 = (chunk & 7) * 8;
      const float4 x0 = *reinterpret_cast<const float4*>(Zs + row * 132 + c8), x1 = *reinterpret_cast<const float4*>(Zs + row * 132 + c8 + 4);
      h16x8 o; o[0] = (h16)x0.x; o[1] = (h16)x0.y; o[2] = (h16)x0.z; o[3] = (h16)x0.w; o[4] = (h16)x1.x; o[5] = (h16)x1.y; o[6] = (h16)x1.z; o[7] = (h16)x1.w;
      *reinterpret_cast<h16x8*>(Kb + (long)(key0 + row) * 96 + c8) = o;
    }
  }
  __syncthreads();
}
DI void item_q(const Params& P, int layer, int tile, char* smem) {
  const int tid = tidx(), lane = tid & 63, wid = tid >> 6, wr = wid >> 1, wc = wid & 1, fr = lane & 15, fq = lane >> 4;
  const int mt = tile >> 3, hd = tile & 7; const int t0 = mt * 128; const Tok tk = tokinfo(t0);
  const h16* A = reinterpret_cast<const h16*>(P.ws + OFF_QLAT) + (long)t0 * 512;
  const h16* W = reinterpret_cast<const h16*>(P.ws + OFF_WT) + (long)layer * WT_LAYER + WT_UQ + (long)hd * 128 * 512;
  float* rs = reinterpret_cast<float*>(smem + 73728);
  row_rms(A, 512, 512, rs);
  f32x4 acc[4][4]; acc_zero(acc);
  gemm_kloop(acc, A, 512, 0, 128, W, 512, 512, smem, opaque_tid());
  h16* Qb = reinterpret_cast<h16*>(P.ws + OFF_Q) + (long)(tk.b * 8 + hd) * KEYS * 96;
  const float2* rope = reinterpret_cast<const float2*>(P.ws + OFF_ROPE);
  const int q0 = (tk.ctx ? SEQ : 0) + tk.pos;
#pragma unroll
  for (int m = 0; m < 4; ++m)
#pragma unroll
    for (int j = 0; j < 4; ++j) {
      const int r = wr * 64 + m * 16 + fq * 4 + j; const float s = rs[r] * QSCALE;
      if (wc == 0) {
#pragma unroll
        for (int n = 0; n < 4; ++n) acc[m][n][j] *= s;
      } else {
        float x1 = acc[m][0][j], x2 = acc[m][1][j];
        if (!tk.ctx) { const float2 cs = rope[(tk.pos + r) * 16 + fr]; const float y1 = x1 * cs.x - x2 * cs.y, y2 = x1 * cs.y + x2 * cs.x; x1 = y1; x2 = y2; }
        acc[m][0][j] = x1 * s; acc[m][1][j] = x2 * s;
      }
    }
  {
    float* Zs = reinterpret_cast<float*>(smem);
    const int t2 = tidx();
    stage_acc(acc, Zs, t2);
#pragma unroll
    for (int it = 0; it < 6; ++it) {
      const int chunk = it * 256 + t2, row = chunk / 12, c8 = (chunk % 12) * 8;
      const float4 x0 = *reinterpret_cast<const float4*>(Zs + row * 132 + c8), x1 = *reinterpret_cast<const float4*>(Zs + row * 132 + c8 + 4);
      h16x8 o; o[0] = (h16)x0.x; o[1] = (h16)x0.y; o[2] = (h16)x0.z; o[3] = (h16)x0.w; o[4] = (h16)x1.x; o[5] = (h16)x1.y; o[6] = (h16)x1.z; o[7] = (h16)x1.w;
      *reinterpret_cast<h16x8*>(Qb + (long)(q0 + row) * 96 + c8) = o;
    }
  }
  __syncthreads();
}
DI int s5_chunk_base(int b, int dir, int si) {
  if (si < 4) { const int cc = dir ? 3 - si : si; return TLAT + b * CTXL + cc * 64; }
  const int lc = dir ? 127 - (si - 4) : si - 4; return b * SEQ + lc * 64;
}
DI void s5_stage_u(const h16* __restrict__ U, int tokbase, int g, float* us) {
  const int lane = tidx() & 63;
  const h16* p = U + (long)(tokbase + lane) * 384 + g * 16;
  const h16x8 v0 = *reinterpret_cast<const h16x8*>(p), v1 = *reinterpret_cast<const h16x8*>(p + 8);
#pragma unroll
  for (int j = 0; j < 8; ++j) { us[lane * 16 + j] = (float)v0[j]; us[lane * 16 + 8 + j] = (float)v1[j]; }
}
DI void item_s5_pass1(const Params& P, int layer, int wtask, char* smem) {
  const int lane = tidx() & 63, wid = tidx() >> 6;
  float* us = reinterpret_cast<float*>(smem + wid * 12800);
  const int si = wtask % 132; int r = wtask / 132; const int g = r % 24; r /= 24; const int dir = r & 1, b = r >> 1;
  const long gi = (long)(layer * 2 + dir) * 24 + g;
  const float2 a = reinterpret_cast<const float2*>(P.ws + OFF_S5A)[gi * 64 + lane];
  const float2* Bb = reinterpret_cast<const float2*>(P.ws + OFF_S5B) + (gi * 64 + lane) * 16;
  float bre[16], bim[16];
#pragma unroll
  for (int c = 0; c < 16; ++c) { const float2 v = Bb[c]; bre[c] = v.x; bim[c] = v.y; }
  s5_stage_u(reinterpret_cast<const h16*>(P.ws + OFF_U), s5_chunk_base(b, dir, si), g, us);
  float hr = 0.f, hi = 0.f;
#pragma unroll 4
  for (int s = 0; s < 64; ++s) {
    const int tau = dir ? 63 - s : s;
    const float4* up = reinterpret_cast<const float4*>(us + tau * 16);
    float br = 0.f, bi = 0.f;
#pragma unroll
    for (int q = 0; q < 4; ++q) { const float4 u = up[q];
      br += bre[q * 4] * u.x + bre[q * 4 + 1] * u.y + bre[q * 4 + 2] * u.z + bre[q * 4 + 3] * u.w;
      bi += bim[q * 4] * u.x + bim[q * 4 + 1] * u.y + bim[q * 4 + 2] * u.z + bim[q * 4 + 3] * u.w; }
    const float nr = a.x * hr - a.y * hi + br, ni = a.x * hi + a.y * hr + bi; hr = nr; hi = ni;
  }
  reinterpret_cast<float2*>(P.ws + OFF_E)[((long)((b * 2 + dir) * 24 + g) * 132 + si) * 64 + lane] = make_float2(hr, hi);
}

DI float hy_dw(const h16* __restrict__ p, int t, int Ls, float w0, float w1, float w2, float bias) {
  const float xm_ = (float)p[max(t - 1, 0)], x0 = (float)p[t], xp_ = (float)p[min(t + 1, Ls - 1)];
  const float xm = t > 0 ? xm_ : 0.f, xp = t + 1 < Ls ? xp_ : 0.f;
  return xm * w0 + x0 * w1 + xp * w2 + bias;
}
DI void item_hyena(const Params& P, int layer, int task, char* smem) {
  float2* X = reinterpret_cast<float2*>(smem);
  const int tid = tidx(); const int pair = task / 384, c = task % 384;
  const h16* PH0 = reinterpret_cast<const h16*>(P.ws + OFF_PHY) + (long)(2 * pair) * 1152 * SEQ;
  const h16* PH1 = PH0 + (long)1152 * SEQ;
  const float* cw = P.in[I_HCW] + layer * 3 * 1152; const float* cb = P.in[I_HCB] + layer * 1152;
  const float2* F = reinterpret_cast<const float2*>(P.ws + OFF_FILT);
  float2* SCR = reinterpret_cast<float2*>(P.ws + OFF_YS5PRE) + (long)blockIdx.x * 12288;
  float2* SCR2 = SCR + 8192;
  const float vw0 = cw[c], vw1 = cw[1152 + c], vw2 = cw[2304 + c], vbb = cb[c];
  const h16* pv0 = PH0 + (long)c * SEQ; const h16* pv1 = PH1 + (long)c * SEQ;
  float2 ye[16]; int tq;
#pragma unroll 1
  for (int o = 0; o < 2; ++o) {
    const float2* Te = F + (long)(o * 384 + c) * 2 * 8192; const float2* To = Te + 8192;
    float ts = 1.f / 16384.f; asm volatile("" : "+v"(ts));
{ tq = tid; asm volatile("" : "+v"(tq)); }
    if (o == 0) {
#pragma unroll 8
      for (int i = 0; i < 32; ++i) { const int t = tq + 256 * i; const float2 v = make_float2(hy_dw(pv0, t, SEQ, vw0, vw1, vw2, vbb), hy_dw(pv1, t, SEQ, vw0, vw1, vw2, vbb)); X[t] = v; SCR[t] = v; }
    } else {
#pragma unroll 16
      for (int i = 0; i < 32; ++i) { const int t = tq + 256 * i; X[t] = SCR[t]; }
    }
    __syncthreads();
    fft_fwd(X);
{ tq = tid; asm volatile("" : "+v"(tq)); }
#pragma unroll 8
    for (int i = 0; i < 32; ++i) { const int n = tq + 256 * i; X[n] = cmul(X[n], Te[n]); }
    __syncthreads();
    fft_inv(X);
{ tq = tid; asm volatile("" : "+v"(tq)); }
#pragma unroll
    for (int i = 0; i < 16; ++i) { ye[i] = X[tq + 256 * i]; SCR2[tq + 256 * i] = X[tq + 4096 + 256 * i]; }
    __syncthreads();
{ tq = tid; asm volatile("" : "+v"(tq)); }
#pragma unroll 16
    for (int i = 0; i < 32; ++i) { const int t = tq + 256 * i; X[t] = cmul(SCR[t], twid(-(float)t * ts)); }
    __syncthreads();
    fft_fwd(X);
{ tq = tid; asm volatile("" : "+v"(tq)); }
#pragma unroll 8
    for (int i = 0; i < 32; ++i) { const int n = tq + 256 * i; X[n] = cmul(X[n], To[n]); }
    __syncthreads();
    fft_inv(X);
    asm volatile("" : "+v"(ts));
{ tq = tid; asm volatile("" : "+v"(tq)); }
#pragma unroll
    for (int i = 0; i < 16; ++i) { const int t = tq + 256 * i; const float2 yo = cmul(X[t], twid((float)t * ts)); X[t] = make_float2(ye[i].x + yo.x, ye[i].y + yo.y); }
{ tq = tid; asm volatile("" : "+v"(tq)); }
#pragma unroll 2
    for (int i = 0; i < 16; ++i) { const int t = tq + 4096 + 256 * i; const float2 yo = cmul(X[t], twid((float)t * ts)); const float2 y2 = SCR2[tq + 256 * i]; X[t] = make_float2(y2.x + yo.x, y2.y + yo.y); }
    const int gc = (o + 1) * 384 + c;
    const float w0 = cw[gc], w1 = cw[1152 + gc], w2 = cw[2304 + gc], bb = cb[gc];
    const float bias = P.in[I_HBIAS][(layer * 2 + o) * 384 + c];
    const h16* pg0 = PH0 + (long)gc * SEQ; const h16* pg1 = PH1 + (long)gc * SEQ;
{ tq = tid; asm volatile("" : "+v"(tq)); }
    if (o == 0) {
#pragma unroll 8
      for (int i = 0; i < 32; ++i) {
        const int t = tq + 256 * i;
        const float2 lc = X[t];
        const float2 zz = SCR[t];
        const float gx = hy_dw(pg0, t, SEQ, w0, w1, w2, bb), gy = hy_dw(pg1, t, SEQ, w0, w1, w2, bb);
        SCR[t] = make_float2(gx * (lc.x + bias * zz.x), gy * (lc.y + bias * zz.y));
      }
    } else {
#pragma unroll 8
      for (int i = 0; i < 32; ++i) {
        const int t = tq + 256 * i;
        const float2 lc = X[t];
        const float2 zz = SCR[t];
        const float gx = hy_dw(pg0, t, SEQ, w0, w1, w2, bb), gy = hy_dw(pg1, t, SEQ, w0, w1, w2, bb);
        const_cast<h16*>(pv0)[t] = (h16)(gx * (lc.x + bias * zz.x)); const_cast<h16*>(pv1)[t] = (h16)(gy * (lc.y + bias * zz.y));
      }
    }
    __syncthreads();
  }
}
DI void item_hyena_ctx(const Params& P, int layer, int task, char* smem) {
  float* su = reinterpret_cast<float*>(smem); float* sf = su + 256; float* sb = sf + 256;
  const int t = tidx(); const int b = task / 384, c = task % 384;
  const h16* PH = reinterpret_cast<const h16*>(P.ws + OFF_PHYC) + (long)b * 1152 * CTXL;
  const float* cw = P.in[I_HCW] + layer * 3 * 1152; const float* cb = P.in[I_HCB] + layer * 1152;
  float u = hy_dw(PH + (long)c * CTXL, t, CTXL, cw[c], cw[1152 + c], cw[2304 + c], cb[c]);
  for (int o = 0; o < 2; ++o) {
    const float* T = reinterpret_cast<const float*>(P.ws + OFF_TAPSC) + (long)(o * 384 + c) * 512;
    __syncthreads();
    su[t] = u; sf[t] = T[t]; sb[t] = T[256 + t];
    __syncthreads();
    float y = 0.f;
    for (int s = 0; s <= t; ++s) y += sf[t - s] * su[s];
    for (int s = t + 1; s < 256; ++s) y += sb[s - t] * su[s];
    const int gc = (o + 1) * 384 + c;
    const float gx = hy_dw(PH + (long)gc * CTXL, t, CTXL, cw[gc], cw[1152 + gc], cw[2304 + gc], cb[gc]);
    u = gx * (y + P.in[I_HBIAS][(layer * 2 + o) * 384 + c] * u);
  }
  reinterpret_cast<h16*>(P.ws + OFF_YHY)[((long)TLAT + b * CTXL + t) * 384 + c] = (h16)u;
  __syncthreads();
}

#ifndef PROBE_HY
#define PROBE_HY 0
#endif
#ifndef PROBE_S5
#define PROBE_S5 0
#endif
DI int first_item(int base) { const int g = (int)gridDim.x; return (((int)blockIdx.x - base) % g + g) % g; }
DI void phase_mix1(const Params& P, int layer, char* smem) {
  const int n_hy = 4 * 384, n_hyc = layer == 0 ? 8 * 384 : 0;
  const int n_kv = (TT / 128) * 8, n_q = (layer == 0 ? TT / 128 : TLAT / 128) * 8;
  const int n_s5 = (NBATCH * 2 * 24 * 132) / 4;
  const int g = gridDim.x;
#pragma unroll 1
  for (int rep = 0; rep < 1 + PROBE_HY; ++rep)
#pragma unroll 1
  for (int i = first_item(0); i < n_hy; i += g) item_hyena(P, layer, i, smem);
  asm volatile("" ::: "memory");
#pragma unroll 1
  for (int i = first_item(n_hy); i < n_kv; i += g) item_kv(P, layer, i, smem);
  asm volatile("" ::: "memory");
#pragma unroll 1
  for (int i = first_item(n_hy + n_kv); i < n_q; i += g) item_q(P, layer, i, smem);
  asm volatile("" ::: "memory");
#pragma unroll 1
  for (int rep = 0; rep < 1 + PROBE_S5; ++rep)
#pragma unroll 1
  for (int i = first_item(n_hy + n_kv + n_q); i < n_s5; i += g) { item_s5_pass1(P, layer, i * 4 + (tidx() >> 6), smem); __syncthreads(); }
  asm volatile("" ::: "memory");
#pragma unroll 1
  for (int i = first_item(n_hy + n_kv + n_q + n_s5); i < n_hyc; i += g) item_hyena_ctx(P, layer, i, smem);
}
DI int crow32(int r, int hi) { return (r & 3) + 8 * (r >> 2) + 4 * hi; }
DI void item_attn(const Params& P, int bh, int q0, int key_lo, int ntiles, char* smem) {
  const int tid = tidx(), lane = tid & 63, wid = tid >> 6, r32 = lane & 31, hi = lane >> 5;
  const h16* Qb = reinterpret_cast<const h16*>(P.ws + OFF_Q) + (long)bh * KEYS * 96;
  const h16* Kb = reinterpret_cast<const h16*>(P.ws + OFF_K) + (long)bh * KEYS * 96;
  const h16* Vt = reinterpret_cast<const h16*>(P.ws + OFF_VT) + (long)bh * 64 * KEYS;
  h16x8 qf[6];
  { const h16* qrow = Qb + (long)(q0 + wid * 32 + r32) * 96 + hi * 8;
#pragma unroll
    for (int ds = 0; ds < 6; ++ds) qf[ds] = *reinterpret_cast<const h16x8*>(qrow + ds * 16); }
  constexpr int KT_BYTES = 64 * 208, VT_BYTES = 64 * 136, BUF = KT_BYTES + VT_BYTES;
  uint4 kr[3]; uint4 vr[2];
  const int vdv0 = tid >> 3, vpart = tid & 7;
  auto gload = [&](int j) {
    const long key0 = key_lo + j * 64;
#pragma unroll
    for (int i = 0; i < 3; ++i) kr[i] = *reinterpret_cast<const uint4*>(Kb + key0 * 96 + (long)(tid + 256 * i) * 8);
#pragma unroll
    for (int i = 0; i < 2; ++i) vr[i] = *reinterpret_cast<const uint4*>(Vt + (long)(vdv0 + 32 * i) * KEYS + key0 + vpart * 8);
  };
  auto swrite = [&](int buf) {
    char* ks = smem + buf * BUF; char* vs = ks + KT_BYTES;
#pragma unroll
    for (int i = 0; i < 3; ++i) { const int c = tid + 256 * i; *reinterpret_cast<uint4*>(ks + (c / 12) * 208 + (c % 12) * 16) = kr[i]; }
#pragma unroll
    for (int i = 0; i < 2; ++i) { char* d = vs + (vdv0 + 32 * i) * 136 + vpart * 16;
      *reinterpret_cast<uint2*>(d) = make_uint2(vr[i].x, vr[i].y); *reinterpret_cast<uint2*>(d + 8) = make_uint2(vr[i].z, vr[i].w); }
  };
  f32x16 o0, o1;
#pragma unroll
  for (int r = 0; r < 16; ++r) { o0[r] = 0.f; o1[r] = 0.f; }
  float m_run = -1e30f, l_run = 0.f;
  gload(0); swrite(0); __syncthreads();
  for (int j = 0; j < ntiles; ++j) {
    if (j + 1 < ntiles) gload(j + 1);
    const char* ks = smem + (j & 1) * BUF; const char* vs = ks + KT_BYTES;
    f32x16 p0, p1;
#pragma unroll
    for (int r = 0; r < 16; ++r) { p0[r] = 0.f; p1[r] = 0.f; }
#pragma unroll
    for (int ds = 0; ds < 6; ++ds) {
      const h16x8 a0 = *reinterpret_cast<const h16x8*>(ks + r32 * 208 + (ds * 16 + hi * 8) * 2);
      const h16x8 a1 = *reinterpret_cast<const h16x8*>(ks + (32 + r32) * 208 + (ds * 16 + hi * 8) * 2);
      p0 = __builtin_amdgcn_mfma_f32_32x32x16_f16(a0, qf[ds], p0, 0, 0, 0);
      p1 = __builtin_amdgcn_mfma_f32_32x32x16_f16(a1, qf[ds], p1, 0, 0, 0);
    }
    float mx = p0[0];
#pragma unroll
    for (int r = 1; r < 16; ++r) mx = fmaxf(mx, p0[r]);
#pragma unroll
    for (int r = 0; r < 16; ++r) mx = fmaxf(mx, p1[r]);
    { const auto rr = __builtin_amdgcn_permlane32_swap(__float_as_uint(mx), __float_as_uint(mx), false, false);
      mx = fmaxf(__uint_as_float(rr[0]), __uint_as_float(rr[1])); }
    const float mnew = fmaxf(m_run, mx);
    const float alpha = __builtin_amdgcn_exp2f(m_run - mnew);
    m_run = mnew;
    float rsum = 0.f;
#pragma unroll
    for (int r = 0; r < 16; ++r) { p0[r] = __builtin_amdgcn_exp2f(p0[r] - mnew); rsum += p0[r]; }
#pragma unroll
    for (int r = 0; r < 16; ++r) { p1[r] = __builtin_amdgcn_exp2f(p1[r] - mnew); rsum += p1[r]; }
    l_run = l_run * alpha + rsum;
    if (__any(alpha != 1.f)) {
#pragma unroll
      for (int r = 0; r < 16; ++r) { o0[r] *= alpha; o1[r] *= alpha; }
    }
#pragma unroll
    for (int kb = 0; kb < 2; ++kb)
#pragma unroll
      for (int s = 0; s < 2; ++s) {
        h16x8 pf;
#pragma unroll
        for (int e = 0; e < 8; ++e) pf[e] = (h16)(kb ? p1[8 * s + e] : p0[8 * s + e]);
        const int koff = (32 * kb + 16 * s + 4 * hi) * 2;
        {
          const h16x4 lo = *reinterpret_cast<const h16x4*>(vs + r32 * 136 + koff), hh = *reinterpret_cast<const h16x4*>(vs + r32 * 136 + koff + 16);
          const h16x8 af = __builtin_shufflevector(lo, hh, 0, 1, 2, 3, 4, 5, 6, 7);
          o0 = __builtin_amdgcn_mfma_f32_32x32x16_f16(af, pf, o0, 0, 0, 0);
        }
        {
          const h16x4 lo = *reinterpret_cast<const h16x4*>(vs + (32 + r32) * 136 + koff), hh = *reinterpret_cast<const h16x4*>(vs + (32 + r32) * 136 + koff + 16);
          const h16x8 af = __builtin_shufflevector(lo, hh, 0, 1, 2, 3, 4, 5, 6, 7);
          o1 = __builtin_amdgcn_mfma_f32_32x32x16_f16(af, pf, o1, 0, 0, 0);
        }
      }
    if (j + 1 < ntiles) swrite((j + 1) & 1);
    __syncthreads();
  }
  const float lt = l_run + __shfl_xor(l_run, 32);
  const float inv = 1.f / lt;
  {
    h16* Os = reinterpret_cast<h16*>(smem);
    h16* orow = Os + (wid * 32 + r32) * 72;
#pragma unroll
    for (int g = 0; g < 4; ++g) {
      h16x4 a, c;
#pragma unroll
      for (int e = 0; e < 4; ++e) { a[e] = (h16)(o0[4 * g + e] * inv); c[e] = (h16)(o1[4 * g + e] * inv); }
      *reinterpret_cast<h16x4*>(orow + 8 * g + 4 * hi) = a;
      *reinterpret_cast<h16x4*>(orow + 32 + 8 * g + 4 * hi) = c;
    }
    __syncthreads();
    const int b = bh >> 3, hd = bh & 7;
    const long tok0 = q0 < SEQ ? (long)b * SEQ + q0 : (long)TLAT + b * CTXL + (q0 - SEQ);
    h16* yb = reinterpret_cast<h16*>(P.ws + OFF_YMLA) + tok0 * 512 + hd * 64;
#pragma unroll
    for (int it = 0; it < 4; ++it) {
      const int chunk = it * 256 + tid, row = chunk >> 3, c8 = (chunk & 7) * 8;
      *reinterpret_cast<uint4*>(yb + (long)row * 512 + c8) = *reinterpret_cast<const uint4*>(Os + row * 72 + c8);
    }
    __syncthreads();
  }
}
DI void item_s5_pass3(const Params& P, int layer, int b, int g, int ck, char* smem) {
  const int lane = tidx() & 63, wid = tidx() >> 6, fr = lane & 15, fq = lane >> 4;
  float* us = reinterpret_cast<float*>(smem + wid * 12800); char* Hs = smem + wid * 12800 + 4096;
  const int tokbase = ck < 4 ? TLAT + b * CTXL + ck * 64 : b * SEQ + (ck - 4) * 64;
  s5_stage_u(reinterpret_cast<const h16*>(P.ws + OFF_U), tokbase, g, us);
  __syncthreads();
  f32x4 yacc[4];
#pragma unroll
  for (int i = 0; i < 4; ++i) yacc[i] = f32x4{0.f, 0.f, 0.f, 0.f};
#pragma unroll
  for (int dir = 0; dir < 2; ++dir) {
    const long gi = (long)(layer * 2 + dir) * 24 + g;
    const float2 a = reinterpret_cast<const float2*>(P.ws + OFF_S5A)[gi * 64 + lane];
    const float2 a64 = reinterpret_cast<const float2*>(P.ws + OFF_S5A64)[gi * 64 + lane];
    const float2* Bb = reinterpret_cast<const float2*>(P.ws + OFF_S5B) + (gi * 64 + lane) * 16;
    float bre[16], bim[16];
#pragma unroll
    for (int c = 0; c < 16; ++c) { const float2 v = Bb[c]; bre[c] = v.x; bim[c] = v.y; }
    const int si = ck < 4 ? (dir ? 3 - ck : ck) : 4 + (dir ? 127 - (ck - 4) : ck - 4);
    const float2* Ep = reinterpret_cast<const float2*>(P.ws + OFF_E) + ((long)((b * 2 + dir) * 24 + g) * 132) * 64 + lane;
    float hr = 0.f, hi = 0.f;
#pragma unroll 16
    for (int i = 0; i < si; ++i) { const float2 e = Ep[(long)i * 64]; const float nr = a64.x * hr - a64.y * hi + e.x, ni = a64.x * hi + a64.y * hr + e.y; hr = nr; hi = ni; }
    const h16* Ct = reinterpret_cast<const h16*>(P.ws + OFF_S5C) + gi * 16 * 128 + fr * 128 + fq * 8;
    h16x8 cf[4];
#pragma unroll
    for (int ks = 0; ks < 4; ++ks) cf[ks] = *reinterpret_cast<const h16x8*>(Ct + ks * 32);
#pragma unroll
    for (int half = 0; half < 2; ++half) {
#pragma unroll 4
      for (int s = 0; s < 32; ++s) {
        const int step = half * 32 + s; const int tau = dir ? 63 - step : step;
        const float4* up = reinterpret_cast<const float4*>(us + tau * 16);
        float br = 0.f, bi = 0.f;
#pragma unroll
        for (int q = 0; q < 4; ++q) { const float4 u = up[q];
          br += bre[q * 4] * u.x + bre[q * 4 + 1] * u.y + bre[q * 4 + 2] * u.z + bre[q * 4 + 3] * u.w;
          bi += bim[q * 4] * u.x + bim[q * 4 + 1] * u.y + bim[q * 4 + 2] * u.z + bim[q * 4 + 3] * u.w; }
        const float nr = a.x * hr - a.y * hi + br, ni = a.x * hi + a.y * hr + bi; hr = nr; hi = ni;
        h16* hrow = reinterpret_cast<h16*>(Hs + (tau & 31) * 272);
        hrow[lane] = (h16)hr; hrow[64 + lane] = (h16)hi;
      }
      __syncthreads();
      const int tb = dir ? 1 - half : half;
#pragma unroll
      for (int sb2 = 0; sb2 < 2; ++sb2)
#pragma unroll
        for (int ks = 0; ks < 4; ++ks) {
          const h16x8 bf = *reinterpret_cast<const h16x8*>(Hs + (sb2 * 16 + fr) * 272 + (ks * 32 + fq * 8) * 2);
          yacc[tb * 2 + sb2] = __builtin_amdgcn_mfma_f32_16x16x32_f16(cf[ks], bf, yacc[tb * 2 + sb2], 0, 0, 0);
        }
      __syncthreads();
    }
  }
  const float* dsk = P.in[I_S5D] + layer * 384 + g * 16 + fq * 4;
  h16* Y = reinterpret_cast<h16*>(P.ws + OFF_YS5PRE);
#pragma unroll
  for (int sbi = 0; sbi < 4; ++sbi) {
    const int tl = sbi * 16 + fr; h16x4 o;
#pragma unroll
    for (int j = 0; j < 4; ++j) o[j] = (h16)geluf_(yacc[sbi][j] + dsk[j] * us[tl * 16 + fq * 4 + j]);
    *reinterpret_cast<h16x4*>(Y + (long)(tokbase + tl) * 384 + g * 16 + fq * 4) = o;
  }
  __syncthreads();
}
DI void phase_mix2(const Params& P, int layer, char* smem) {
  if ((gridDim.x & 7) == 0) {
    const int xcd = blockIdx.x & 7, li = blockIdx.x >> 3, nloc = gridDim.x >> 3;
    for (int k = li; k < 512; k += nloc) item_attn(P, xcd + 8 * (k >> 6), (k & 63) * 128, 0, KEYS / 64, smem);
  } else {
    for (int k = blockIdx.x; k < 4096; k += gridDim.x) item_attn(P, k >> 6, (k & 63) * 128, 0, KEYS / 64, smem);
  }
  const int n_actx = layer == 0 ? 128 : 0;
  const int nck = layer == 0 ? 132 : 128;
  const int n_s5 = NBATCH * 24 * nck / 4;
  for (int it = blockIdx.x; it < n_actx + n_s5; it += gridDim.x) {
    if (it < n_actx) { item_attn(P, it >> 1, SEQ + (it & 1) * 128, SEQ, CTXL / 64, smem); continue; }
    const int w = (it - n_actx) * 4 + (tidx() >> 6);
    const int ck = w % nck + (layer == 0 ? 0 : 4); const int r = w / nck;
    item_s5_pass3(P, layer, r / 24, r % 24, ck, smem);
  }
}
DI void item_yhy_transpose(const Params& P, int item, char* smem) {
  h16* T = reinterpret_cast<h16*>(smem);
  const int tid = tidx();
  const int tt = item & 127, ct = (item >> 7) % 6, b = item / (128 * 6);
  const h16* src = reinterpret_cast<const h16*>(P.ws + OFF_PHY) + ((long)b * 1152 + ct * 64) * SEQ + tt * 64;
  h16* dst = reinterpret_cast<h16*>(P.ws + OFF_YHY) + ((long)b * SEQ + tt * 64) * 384 + ct * 64;
#pragma unroll
  for (int i = 0; i < 2; ++i) {
    const int chunk = tid + 256 * i, cr = chunk >> 3, tp = (chunk & 7) * 8;
    const h16x8 v = *reinterpret_cast<const h16x8*>(src + (long)cr * SEQ + tp);
#pragma unroll
    for (int e = 0; e < 8; ++e) T[cr * 66 + tp + e] = v[e];
  }
  __syncthreads();
#pragma unroll
  for (int i = 0; i < 2; ++i) {
    const int chunk = tid + 256 * i, tr = chunk >> 3, cp = (chunk & 7) * 8;
    h16x8 o;
#pragma unroll
    for (int e = 0; e < 8; ++e) o[e] = T[(cp + e) * 66 + tr];
    *reinterpret_cast<h16x8*>(dst + (long)tr * 384 + cp) = o;
  }
  __syncthreads();
}
DI void phase_glu(const Params& P, int layer, char* smem) {
  const int tid = tidx(), lane = tid & 63, wid = tid >> 6, wr = wid >> 1, wc = wid & 1, fr = lane & 15, fq = lane >> 4;
  const h16* A = reinterpret_cast<const h16*>(P.ws + OFF_YS5PRE);
  const h16* W = reinterpret_cast<const h16*>(P.ws + OFF_WT) + (long)layer * WT_LAYER + WT_GLU;
  h16* Y = reinterpret_cast<h16*>(P.ws + OFF_YS5);
#pragma unroll 1
  for (int it = blockIdx.x; it < NBATCH * 6 * 128; it += gridDim.x) item_yhy_transpose(P, it, smem);
  asm volatile("" ::: "memory");
  const int MT = (layer == 0 ? TT : TLAT) / 128;
  const TileWalk tw = tw_init(MT, 6);
  for (int tile = tw.lb; tile < tw_count(tw); tile += tw.nlb) {
    int mt, nt; tw_decode(tw, tile, mt, nt);
    f32x4 acc[4][4]; acc_zero(acc);
    gemm_kloop(acc, A + (long)mt * 128 * 384, 384, 0, 128, W + (long)nt * 128 * 384, 384, 384, smem, opaque_tid());
    {
      float* Zs = reinterpret_cast<float*>(smem);
#pragma unroll
      for (int m = 0; m < 4; ++m)
#pragma unroll
        for (int np = 0; np < 2; ++np)
#pragma unroll
          for (int j = 0; j < 4; ++j)
            Zs[(wr * 64 + m * 16 + fq * 4 + j) * 132 + wc * 32 + np * 16 + fr] = acc[m][2 * np][j] * sigmoidf_(acc[m][2 * np + 1][j]);
      __syncthreads();
      const int t2 = tidx();
#pragma unroll
      for (int it = 0; it < 4; ++it) {
        const int chunk = it * 256 + t2, row = chunk >> 3, c8 = (chunk & 7) * 8;
        const float4 x0 = *reinterpret_cast<const float4*>(Zs + row * 132 + c8), x1 = *reinterpret_cast<const float4*>(Zs + row * 132 + c8 + 4);
        h16x8 o; o[0] = (h16)x0.x; o[1] = (h16)x0.y; o[2] = (h16)x0.z; o[3] = (h16)x0.w; o[4] = (h16)x1.x; o[5] = (h16)x1.y; o[6] = (h16)x1.z; o[7] = (h16)x1.w;
        *reinterpret_cast<h16x8*>(Y + (long)(mt * 128 + row) * 384 + nt * 64 + c8) = o;
      }
      __syncthreads();
    }
  }
}
DI void phase_merge(const Params& P, int layer, char* smem) {
  const h16* H = reinterpret_cast<const h16*>(P.ws + OFF_H1);
  const h16* WL = reinterpret_cast<const h16*>(P.ws + OFF_WT) + (long)layer * WT_LAYER;
  h16* Mg = reinterpret_cast<h16*>(P.ws + OFF_MERGED);
  const int MT = (layer == 0 ? TT : TLAT) / 128;
  const TileWalk tw = tw_init(MT, 8);
  for (int tile = tw.lb; tile < tw_count(tw); tile += tw.nlb) {
    int mt, nt; tw_decode(tw, tile, mt, nt);
    h16* Tmp = reinterpret_cast<h16*>(P.ws + OFF_YS5PRE) + (long)blockIdx.x * 32768;
    h16* Run = Tmp + 16384;
#pragma unroll 1
    for (int br = 0; br < 3; ++br) {
      const h16* Ab; const h16* Wb; int Kb;
      if (br == 0) { Ab = reinterpret_cast<const h16*>(P.ws + OFF_YHY) + (long)mt * 128 * 384; Wb = WL + WT_BRHY + (long)nt * 128 * 384; Kb = 384; }
      else if (br == 1) { Ab = reinterpret_cast<const h16*>(P.ws + OFF_YS5) + (long)mt * 128 * 384; Wb = WL + WT_BRS5 + (long)nt * 128 * 384; Kb = 384; }
      else { Ab = reinterpret_cast<const h16*>(P.ws + OFF_YMLA) + (long)mt * 128 * 512; Wb = WL + WT_BRMLA + (long)nt * 128 * 512; Kb = 512; }
      {
        f32x4 acc[4][4]; acc_zero(acc);
        gemm_kloop(acc, Ab, Kb, 0, 128, Wb, Kb, Kb, smem, opaque_tid());
        const int tid = tidx();
#pragma unroll
        for (int m = 0; m < 4; ++m)
#pragma unroll
          for (int n = 0; n < 4; ++n) {
            h16x4 o; o[0] = (h16)acc[m][n][0]; o[1] = (h16)acc[m][n][1]; o[2] = (h16)acc[m][n][2]; o[3] = (h16)acc[m][n][3];
            *reinterpret_cast<h16x4*>(Tmp + ((m * 4 + n) * 256 + tid) * 4) = o;
          }
      }
      f32x4 acc[4][4]; acc_zero(acc);
      gemm_kloop(acc, H + (long)mt * 128 * LD1, LD1, 0, 128, WL + WT_WGATE + (long)(br * 1024 + nt * 128) * LD1, LD1, 1024, smem, opaque_tid());
      const int tid = tidx();
      h16x4 bv[16], rv[16];
#pragma unroll
      for (int q = 0; q < 16; ++q) bv[q] = *reinterpret_cast<const h16x4*>(Tmp + (q * 256 + tid) * 4);
      if (br > 0) {
#pragma unroll
        for (int q = 0; q < 16; ++q) rv[q] = *reinterpret_cast<const h16x4*>(Run + (q * 256 + tid) * 4);
      } else {
#pragma unroll
        for (int q = 0; q < 16; ++q) rv[q] = h16x4{(h16)0.f, (h16)0.f, (h16)0.f, (h16)0.f};
      }
#pragma unroll
      for (int m = 0; m < 4; ++m)
#pragma unroll
        for (int n = 0; n < 4; ++n)
#pragma unroll
          for (int j = 0; j < 4; ++j) acc[m][n][j] = (float)rv[m * 4 + n][j] + sigmoidf_(acc[m][n][j]) * (float)bv[m * 4 + n][j];
      if (br < 2) {
#pragma unroll
        for (int m = 0; m < 4; ++m)
#pragma unroll
          for (int n = 0; n < 4; ++n) {
            h16x4 o; o[0] = (h16)acc[m][n][0]; o[1] = (h16)acc[m][n][1]; o[2] = (h16)acc[m][n][2]; o[3] = (h16)acc[m][n][3];
            *reinterpret_cast<h16x4*>(Run + ((m * 4 + n) * 256 + tid) * 4) = o;
          }
      } else {
        float* Zs = reinterpret_cast<float*>(smem);
        stage_acc(acc, Zs, tid);
        copy_out_f16(Zs, Mg, (long)mt * 128, LD1, nt * 128, tid);
        __syncthreads();
      }
    }
  }
}
DI void phase_resid(const Params& P, int layer, int stage_src, size_t a_off, int K, long w_off, int gate_idx, char* smem) {
  const int tid = tidx(), lane = tid & 63, wid = tid >> 6, wr = wid >> 1, wc = wid & 1, fr = lane & 15, fq = lane >> 4;
  const h16* A = reinterpret_cast<const h16*>(P.ws + a_off);
  const h16* W = reinterpret_cast<const h16*>(P.ws + OFF_WT) + (long)layer * WT_LAYER + w_off;
  const float* mod = reinterpret_cast<const float*>(P.ws + OFF_MOD) + (long)layer * 9 * 6144 + gate_idx * 1024;
  const int MT = (layer == 0 ? TT : TLAT) / 128;
  const TileWalk tw = tw_init(MT, 8);
  for (int tile = tw.lb; tile < tw_count(tw); tile += tw.nlb) {
    int mt, nt; tw_decode(tw, tile, mt, nt);
    f32x4 acc[4][4]; acc_zero(acc);
    const int ld = K == 1024 ? LD1 : LD2;
    gemm_kloop(acc, A + (long)mt * 128 * ld, ld, 0, 128, W + (long)nt * 128 * ld, ld, K, smem, opaque_tid());
    const Tok tk = tokinfo(mt * 128);
    float* Zs = reinterpret_cast<float*>(smem);
    const int t2 = tidx();
    stage_acc(acc, Zs, t2);
    const int c4 = (t2 & 31) * 4;
    const float4 g4 = *reinterpret_cast<const float4*>(mod + tk.mrow * 6144 + nt * 128 + c4);
#pragma unroll
    for (int it = 0; it < 16; ++it) {
      const int row = it * 8 + (t2 >> 5); const int t = mt * 128 + row;
      const float4 a4 = *reinterpret_cast<const float4*>(Zs + row * 132 + c4);
      const float4 x4 = *reinterpret_cast<const float4*>(xrow_src(P, stage_src, t) + nt * 128 + c4);
      *reinterpret_cast<float4*>(xrow_dst(P, t) + nt * 128 + c4) = make_float4(x4.x + g4.x * a4.x, x4.y + g4.y * a4.y, x4.z + g4.z * a4.z, x4.w + g4.w * a4.w);
    }
    __syncthreads();
  }
}
DI void phase_ffn_up(const Params& P, int layer, char* smem) {
  const int tid = tidx(), lane = tid & 63, wid = tid >> 6, wr = wid >> 1, wc = wid & 1, fr = lane & 15, fq = lane >> 4;
  const h16* H = reinterpret_cast<const h16*>(P.ws + OFF_H2);
  const h16* W = reinterpret_cast<const h16*>(P.ws + OFF_WT) + (long)layer * WT_LAYER + WT_UP;
  h16* F = reinterpret_cast<h16*>(P.ws + OFF_F);
  const float* cw = P.in[I_FCW] + (long)layer * 3 * 5632; const float* cb = P.in[I_FCB] + (long)layer * 5632;
  float* Zs = reinterpret_cast<float*>(smem);
  const int n_mt = 8 * 66 + (layer == 0 ? 8 * 3 : 0);
  const TileWalk tw = tw_init(n_mt, 44);
  for (int tile = tw.lb; tile < tw_count(tw); tile += tw.nlb) {
    int mi, nt; tw_decode(tw, tile, mi, nt);
    int seq0, Ls, ti;
    if (mi < 528) { seq0 = (mi / 66) * SEQ; Ls = SEQ; ti = mi % 66; } else { const int u = mi - 528; seq0 = TLAT + (u / 3) * CTXL; Ls = CTXL; ti = u % 3; }
    const int p0 = ti * 126 - 1;
    const int a_lo = ti == 0 ? 1 : 0, a_hi = min(128, Ls - p0);
    const int nout = min(126, Ls - ti * 126);
    f32x4 acc[4][4]; acc_zero(acc);
    gemm_kloop(acc, H + ((long)seq0 + p0) * LD1, LD1, a_lo, a_hi, W + (long)nt * 128 * LD1, LD1, 1024, smem, opaque_tid());
#pragma unroll
    for (int m = 0; m < 4; ++m)
#pragma unroll
      for (int n = 0; n < 4; ++n)
#pragma unroll
        for (int j = 0; j < 4; ++j)
          Zs[(wr * 64 + m * 16 + fq * 4 + j) * 132 + 2 * (wc * 32 + (n >> 1) * 16 + fr) + (n & 1)] = acc[m][n][j];
    __syncthreads();
    {
      const int jc = tid & 63, rg = tid >> 6;
      const float2* Z2 = reinterpret_cast<const float2*>(Zs);
      const int cu = nt * 64 + jc, cg = 2816 + cu;
      const float wu0 = cw[cu], wu1 = cw[5632 + cu], wu2 = cw[2 * 5632 + cu], bu = cb[cu];
      const float wg0 = cw[cg], wg1 = cw[5632 + cg], wg2 = cw[2 * 5632 + cg], bg = cb[cg];
      const int r0 = rg * 32 + 1, r1 = min(r0 + 31, nout);
      float2 zm = Z2[(r0 - 1) * 66 + jc], z0 = Z2[r0 * 66 + jc];
      h16* fp = F + ((long)seq0 + p0 + r0) * LD2 + cu;
#pragma unroll 4
      for (int r = r0; r <= r1; ++r) {
        const float2 zp = Z2[(r + 1) * 66 + jc];
        const float au = wu0 * zm.x + wu1 * z0.x + wu2 * zp.x + bu;
        const float ag = wg0 * zm.y + wg1 * z0.y + wg2 * zp.y + bg;
        *fp = (h16)(siluf_(au) * ag); fp += LD2;
        zm = z0; z0 = zp;
      }
    }
    __syncthreads();
  }
}
DI void phase_norm2(const Params& P, int layer) { normmod_rows(P, layer, 1, 1, layer == 0 ? TT : TLAT, blockIdx.x, gridDim.x); }

constexpr int N_PHASES = 22;
#ifndef PROBE_REPEAT
#define PROBE_REPEAT 0u
#endif
template <int PH> DI void run_phase_t(const Params& P, char* smem) {
  asm volatile("" ::: "memory");
  if constexpr (PH == 0) phase_prologue(P, smem);
  else if constexpr (PH == 21) phase_final(P);
  else {
    constexpr int layer = (PH - 1) / 10, s = (PH - 1) % 10;
    if constexpr (s == 0) phase_norm1(P, layer, smem);
    else if constexpr (s == 1) phase_gemm_in(P, layer, smem);
    else if constexpr (s == 2) phase_mix1(P, layer, smem);
    else if constexpr (s == 3) phase_mix2(P, layer, smem);
    else if constexpr (s == 4) phase_glu(P, layer, smem);
    else if constexpr (s == 5) phase_merge(P, layer, smem);
    else if constexpr (s == 6) phase_resid(P, layer, layer, OFF_MERGED, 1024, WT_WO, 2, smem);
    else if constexpr (s == 7) phase_norm2(P, layer);
    else if constexpr (s == 8) phase_ffn_up(P, layer, smem);
    else phase_resid(P, layer, 1, OFF_F, 2816, WT_DOWN, 5, smem);
  }
}
DI void run_phase(const Params& P, int ph, char* smem) {
  switch (ph) {
#define RP(i) case i: run_phase_t<i>(P, smem); break;
    RP(0) RP(1) RP(2) RP(3) RP(4) RP(5) RP(6) RP(7) RP(8) RP(9) RP(10) RP(11) RP(12) RP(13) RP(14) RP(15) RP(16) RP(17) RP(18) RP(19) RP(20) RP(21)
#undef RP
    default: break;
  }
}
#ifndef MULTI_LAUNCH
#define MULTI_LAUNCH 0
#endif
#define XB_TMO      128
#define XB_XCNT(j)  (256  + 64 * (j))
#define XB_XSUB(j)  (1280 + 64 * (j))
#define XB_XGEN(j)  (2304 + 64 * (j))
#define XB_TOP      3328
#define XB_TOPGEN   3392
#define XCD_BAR_WORDS 3456
#define XB_SPIN_CAP (1u << 22)
#define LAS __attribute__((address_space(3)))
DI unsigned xb_ld(unsigned* p)              { return __hip_atomic_load(p, __ATOMIC_RELAXED, __HIP_MEMORY_SCOPE_AGENT); }
DI unsigned xb_add(unsigned* p, unsigned v) { return __hip_atomic_fetch_add(p, v, __ATOMIC_RELAXED, __HIP_MEMORY_SCOPE_AGENT); }
DI unsigned xb_xcc_id() { return (unsigned)__builtin_amdgcn_s_getreg((3 << 11) | 20) & 0xFu; }
#define XB_SPIN(cond, bar) do { unsigned _sp = 0; while (cond) { __builtin_amdgcn_s_sleep(1); \
    if ((++_sp & 255u) == 0u) { if (xb_ld(&(bar)[XB_TMO])) break; if (_sp > XB_SPIN_CAP) { atomicAdd(&(bar)[XB_TMO], 1u); break; } } } } while (0)
struct XcdBarrier { unsigned* bar; unsigned x; volatile LAS unsigned* st; };
DI XcdBarrier xcd_barrier_post(unsigned* bar, volatile LAS unsigned* st) {
  XcdBarrier b; b.bar = bar; b.x = xb_xcc_id(); b.st = st;
  if (threadIdx.x == 0) (void)xb_add(&bar[XB_XCNT(b.x)], 1u);
  return b;
}
DI void xcd_barrier_complete(unsigned* bar, unsigned x, unsigned& nloc, unsigned& nx) {
  const unsigned G = gridDim.x * gridDim.y * gridDim.z;
  unsigned sum, cnt, mine, sp = 0u;
  for (;;) {
    sum = 0u; cnt = 0u; mine = 0u;
#pragma unroll
    for (unsigned j = 0; j < 16; ++j) { const unsigned c = xb_ld(&bar[XB_XCNT(j)]); sum += c; cnt += (c > 0u) ? 1u : 0u; mine = (j == x) ? c : mine; }
    if (sum == G) break;
    __builtin_amdgcn_s_sleep(1);
    if ((++sp & 255u) == 0u) { if (xb_ld(&bar[XB_TMO])) break; if (sp > XB_SPIN_CAP) { atomicAdd(&bar[XB_TMO], 1u); break; } }
  }
  nloc = mine > 0u ? mine : 1u; nx = cnt > 0u ? cnt : 1u;
}
DI void xcd_barrier(const XcdBarrier& b) {
  asm volatile("s_waitcnt vmcnt(0)" ::: "memory");
  __syncthreads();
  if (threadIdx.x == 0) {
    unsigned* bar = b.bar;
    __builtin_amdgcn_s_waitcnt(0);
    unsigned nloc = b.st[0], nx = b.st[1];
    if (nloc == 0u) { xcd_barrier_complete(bar, b.x, nloc, nx); b.st[0] = nloc; b.st[1] = nx; }
    const unsigned old = xb_add(&bar[XB_XSUB(b.x)], 1u);
    const unsigned gen = old / nloc;
    if (old + 1u == (gen + 1u) * nloc) {
      __builtin_amdgcn_fence(__ATOMIC_RELEASE, "agent");
      asm volatile("s_waitcnt vmcnt(0)" ::: "memory");
      const unsigned og = xb_add(&bar[XB_TOP], 1u);
      const unsigned tg = og / nx;
      if (og + 1u == (tg + 1u) * nx) xb_add(&bar[XB_TOPGEN], 1u);
      else XB_SPIN(xb_ld(&bar[XB_TOPGEN]) == tg, bar);
      __builtin_amdgcn_fence(__ATOMIC_ACQUIRE, "agent");
      xb_add(&bar[XB_XGEN(b.x)], 1u);
      asm volatile("s_waitcnt vmcnt(0)" ::: "memory");
    } else {
      XB_SPIN(xb_ld(&bar[XB_XGEN(b.x)]) == gen, bar);
      __builtin_amdgcn_fence(__ATOMIC_ACQUIRE, "agent");
      asm volatile("s_waitcnt vmcnt(0)" ::: "memory");
    }
  }
  __syncthreads();
}
__global__ void __launch_bounds__(NTHREADS, 2) fwd_megakernel(Params P) {
  extern __shared__ __attribute__((aligned(16))) char smem[];
  cg::grid_group grid = cg::this_grid();
  volatile LAS unsigned* st = (volatile LAS unsigned*)(smem + SMEM_BYTES - 16);
  if (threadIdx.x == 0) { st[0] = 0u; st[1] = 0u; st[2] = 0u; st[3] = 0u; }
  __syncthreads();
  const XcdBarrier xb = xcd_barrier_post(reinterpret_cast<unsigned*>(P.ws + OFF_BAR), st);
  run_phase_t<0>(P, smem); grid.sync();
#define RP(i) run_phase_t<i>(P, smem); xcd_barrier(xb); if constexpr ((PROBE_REPEAT >> i) & 1) { run_phase_t<i>(P, smem); xcd_barrier(xb); }
  RP(1) RP(2) RP(3) RP(4) RP(5) RP(6) RP(7) RP(8) RP(9) RP(10) RP(11) RP(12) RP(13) RP(14) RP(15) RP(16) RP(17) RP(18) RP(19) RP(20)
#undef RP
#ifdef PROBE_SYNC
  for (int i = 0; i < PROBE_SYNC; ++i) xcd_barrier(xb);
#endif
  run_phase_t<21>(P, smem);
}
#if MULTI_LAUNCH
__global__ void __launch_bounds__(NTHREADS, 2) fwd_phase_kernel(Params P, int ph) {
  extern __shared__ __attribute__((aligned(16))) char smem[];
  run_phase(P, ph, smem);
}
#endif

extern "C" void kernel_launch(void* const* d_in, const int* in_sizes, int n_in, void* d_out, int out_size, void* d_ws, size_t ws_size,
                              hipStream_t stream) {
  static int grid_blocks = 0;
  if (!grid_blocks) {
    int dev = 0, cus = 0, per_cu = 0;
    (void)hipGetDevice(&dev);
    (void)hipDeviceGetAttribute(&cus, hipDeviceAttributeMultiprocessorCount, dev);
    (void)hipFuncSetAttribute((const void*)fwd_megakernel, hipFuncAttributeMaxDynamicSharedMemorySize, SMEM_BYTES);
#if MULTI_LAUNCH
    (void)hipFuncSetAttribute((const void*)fwd_phase_kernel, hipFuncAttributeMaxDynamicSharedMemorySize, SMEM_BYTES);
#endif
    (void)hipOccupancyMaxActiveBlocksPerMultiprocessor(&per_cu, fwd_megakernel, NTHREADS, SMEM_BYTES);
    if (per_cu > 2) per_cu = 2;
    if (per_cu < 1) per_cu = 1;
#ifdef PROBE_FORCE2
    per_cu = 2;
#endif
    grid_blocks = cus * per_cu;
    if (ws_size < OFF_END) fprintf(stderr, "workspace too small: %zu < %zu\n", ws_size, (size_t)OFF_END);
  }
  Params p{};
  for (int i = 0; i < 41; ++i) p.in[i] = (const float*)d_in[i];
  p.out = (float*)d_out; p.ws = (char*)d_ws; p.pad_ = 0;
#if MULTI_LAUNCH
  for (int ph = 0; ph < N_PHASES; ++ph) hipLaunchKernelGGL(fwd_phase_kernel, dim3(grid_blocks), dim3(NTHREADS), SMEM_BYTES, stream, p, ph);
#else
  (void)hipMemsetAsync((char*)d_ws + OFF_BAR, 0, XCD_BAR_WORDS * 4, stream);
  void* args[] = {&p};
  hipError_t e = hipLaunchCooperativeKernel((void*)fwd_megakernel, dim3(grid_blocks), dim3(NTHREADS), args, SMEM_BYTES, stream);
  if (e != hipSuccess) fprintf(stderr, "cooperative launch failed: %s (grid %d)\n", hipGetErrorString(e), grid_blocks);
#endif
}
```

```cpp
#include <hip/hip_runtime.h>
#include <hip/hip_cooperative_groups.h>
#include <cstdio>
namespace cg = cooperative_groups;

typedef _Float16 h16;
typedef _Float16 h16x8 __attribute__((ext_vector_type(8)));
typedef _Float16 h16x4 __attribute__((ext_vector_type(4)));
typedef float f32x4 __attribute__((ext_vector_type(4)));
typedef float f32x16 __attribute__((ext_vector_type(16)));
#define DI __device__ __forceinline__

constexpr int DM = 1024, NBATCH = 8, SEQ = 8192, CTXL = 256, TLAT = 65536, TCTX = 2048, TT = 67584;
constexpr int KEYS = SEQ + CTXL;
constexpr int NTHREADS = 256;
constexpr float EPS = 1e-6f;
constexpr float QSCALE = 0.10206207261596575f * 1.4426950408889634f;

constexpr int LD1 = 1088, LD2 = 2880;
constexpr long WT_WIN = 0, WT_WGATE = WT_WIN + 2432L * LD1, WT_UKV = WT_WGATE + 3072L * LD1, WT_UQ = WT_UKV + 1024L * 256,
               WT_GLU = WT_UQ + 1024L * 512, WT_BRHY = WT_GLU + 768L * 384, WT_BRS5 = WT_BRHY + 1024L * 384,
               WT_BRMLA = WT_BRS5 + 1024L * 384, WT_WO = WT_BRMLA + 1024L * 512, WT_UP = WT_WO + 1024L * LD1,
               WT_DOWN = WT_UP + 5632L * LD1, WT_LAYER = WT_DOWN + 1024L * LD2;
constexpr size_t al256(size_t x) { return (x + 255) / 256 * 256; }
constexpr size_t OFF_WT = 0;
constexpr size_t OFF_H1 = al256(OFF_WT + 2 * WT_LAYER * 2);
constexpr size_t OFF_U = al256(OFF_H1 + (size_t)TT * LD1 * 2);
constexpr size_t OFF_KVLAT = al256(OFF_U + (size_t)TT * 384 * 2);
constexpr size_t OFF_QLAT = al256(OFF_KVLAT + (size_t)TT * 256 * 2);
constexpr size_t OFF_PHY = al256(OFF_QLAT + (size_t)TT * 512 * 2);
constexpr size_t OFF_PHYC = al256(OFF_PHY + (size_t)NBATCH * 1152 * SEQ * 2);
constexpr size_t OFF_Q = al256(OFF_PHYC + (size_t)NBATCH * 1152 * CTXL * 2);
constexpr size_t OFF_K = al256(OFF_Q + (size_t)64 * KEYS * 96 * 2);
constexpr size_t OFF_VT = al256(OFF_K + (size_t)64 * KEYS * 96 * 2);
constexpr size_t OFF_YS5PRE = al256(OFF_VT + (size_t)64 * 64 * KEYS * 2);
constexpr size_t OFF_YHY = al256(OFF_YS5PRE + (size_t)TT * 384 * 2);
constexpr size_t OFF_FILT = al256(OFF_YHY + (size_t)TT * 384 * 2);
constexpr size_t OFF_TAPSC = al256(OFF_FILT + (size_t)768 * 2 * SEQ * 8);
constexpr size_t OFF_E = al256(OFF_TAPSC + (size_t)768 * 2 * CTXL * 4);
constexpr size_t OFF_XC = al256(OFF_E + (size_t)NBATCH * 2 * 24 * 132 * 64 * 8);
constexpr size_t OFF_MOD = al256(OFF_XC + (size_t)TCTX * 1024 * 4);
constexpr size_t OFF_Z2 = al256(OFF_MOD + (size_t)2 * 9 * 6144 * 4);
constexpr size_t OFF_Z2C = al256(OFF_Z2 + (size_t)2 * SEQ * 64 * 4);
constexpr size_t OFF_S5A = al256(OFF_Z2C + (size_t)2 * CTXL * 64 * 4);
constexpr size_t OFF_S5A64 = al256(OFF_S5A + (size_t)2 * 2 * 24 * 64 * 8);
constexpr size_t OFF_S5B = al256(OFF_S5A64 + (size_t)2 * 2 * 24 * 64 * 8);
constexpr size_t OFF_S5C = al256(OFF_S5B + (size_t)2 * 2 * 24 * 64 * 16 * 8);
constexpr size_t OFF_ROPE = al256(OFF_S5C + (size_t)2 * 2 * 24 * 16 * 128 * 2);
constexpr size_t OFF_BAR = al256(OFF_ROPE + (size_t)SEQ * 16 * 8);
constexpr size_t OFF_END = al256(OFF_BAR + (size_t)3456 * 4);
constexpr size_t OFF_YS5 = OFF_U, OFF_YMLA = OFF_QLAT, OFF_MERGED = OFF_Q, OFF_F = OFF_U, OFF_H2 = OFF_H1;
static_assert(OFF_END <= (size_t)1024 * 1024 * 1024, "workspace over 1 GiB");
static_assert(OFF_F + (size_t)TT * LD2 * 2 <= OFF_FILT, "f alias overruns");
static_assert(OFF_MERGED + (size_t)TT * LD1 * 2 <= OFF_VT, "merged alias overruns");

constexpr int SMEM_BYTES = 73728 + 2048;

struct Params {
  const float* in[41];
  float* out;
  char* ws;
  unsigned long long pad_;
};
enum { I_X = 0, I_C, I_CTX, I_CCTX, I_WMOD, I_BMOD, I_N1G, I_N2G, I_WIN, I_HCW, I_HCB, I_FW1, I_FB1, I_FW2, I_FB2, I_FW3, I_FFREQ,
       I_FDECAY, I_HBIAS, I_LAMRE, I_LAMIM, I_LOGSTEP, I_BRE, I_BIM, I_CRE, I_CIM, I_S5D, I_WGLU, I_GQ, I_WUQ, I_GKV, I_WUKV,
       I_WBRHY, I_WBRS5, I_WBRMLA, I_WO, I_WUP, I_FCW, I_FCB, I_WDOWN, I_FINALG };

DI int tidx() { int t = threadIdx.x; asm volatile("" : "+v"(t)); return t; }
DI int opaque_tid() { return tidx(); }
DI float sigmoidf_(float x) { return 1.f / (1.f + __expf(-x)); }
DI float siluf_(float x) { return x / (1.f + __expf(-x)); }
DI float geluf_(float x) { float z = 0.7978845608028654f * (x + 0.044715f * x * x * x); float t = 1.f - 2.f / (1.f + __expf(2.f * z)); return 0.5f * x * (1.f + t); }
DI float wave_sum(float v) { for (int o = 32; o > 0; o >>= 1) v += __shfl_xor(v, o); return v; }
DI float wave_max(float v) { for (int o = 32; o > 0; o >>= 1) v = fmaxf(v, __shfl_xor(v, o)); return v; }
DI void dsincos(double x, double& s, double& c) {
  const double TWO_PI = 6.283185307179586476925287;
  double r = x - TWO_PI * rint(x / TWO_PI);
  double r2 = r * r, ts = r, tc = 1.0; s = r; c = 1.0;
  for (int k = 1; k <= 15; ++k) { tc = -tc * r2 / (double)((2 * k - 1) * (2 * k)); c += tc; ts = -ts * r2 / (double)((2 * k) * (2 * k + 1)); s += ts; }
}
DI float2 twid(float f) { return make_float2(__builtin_amdgcn_cosf(f), __builtin_amdgcn_sinf(f)); }
DI float2 cmul(float2 a, float2 b) { return make_float2(a.x * b.x - a.y * b.y, a.x * b.y + a.y * b.x); }

struct Tok { int b, pos, ctx, mrow; };
DI Tok tokinfo(int t) { Tok k; if (t < TLAT) { k.b = t >> 13; k.pos = t & 8191; k.ctx = 0; k.mrow = k.b; } else { int u = t - TLAT; k.b = u >> 8; k.pos = u & 255; k.ctx = 1; k.mrow = 8; } return k; }

struct Stg { uint4 a0, a1, a2, a3, b0, b1, b2, b3; };
DI void g_load(Stg& s, const h16* __restrict__ A0, const h16* __restrict__ A1, const h16* __restrict__ A2, const h16* __restrict__ A3,
               const h16* __restrict__ Bp, long b32, int k0) {
  s.a0 = *reinterpret_cast<const uint4*>(A0 + k0); s.a1 = *reinterpret_cast<const uint4*>(A1 + k0);
  s.a2 = *reinterpret_cast<const uint4*>(A2 + k0); s.a3 = *reinterpret_cast<const uint4*>(A3 + k0);
  s.b0 = *reinterpret_cast<const uint4*>(Bp + k0); s.b1 = *reinterpret_cast<const uint4*>(Bp + b32 + k0);
  s.b2 = *reinterpret_cast<const uint4*>(Bp + 2 * b32 + k0); s.b3 = *reinterpret_cast<const uint4*>(Bp + 3 * b32 + k0);
}
DI uint4 zsel(uint4 v, bool ok) { return ok ? v : make_uint4(0, 0, 0, 0); }
DI void s_write(char* sw, const Stg& s, int okm) {
  *reinterpret_cast<uint4*>(sw) = zsel(s.a0, okm & 1); *reinterpret_cast<uint4*>(sw + 32 * 128) = zsel(s.a1, okm & 2);
  *reinterpret_cast<uint4*>(sw + 64 * 128) = zsel(s.a2, okm & 4); *reinterpret_cast<uint4*>(sw + 96 * 128) = zsel(s.a3, okm & 8);
  *reinterpret_cast<uint4*>(sw + 16384) = s.b0; *reinterpret_cast<uint4*>(sw + 16384 + 32 * 128) = s.b1; *reinterpret_cast<uint4*>(sw + 16384 + 64 * 128) = s.b2; *reinterpret_cast<uint4*>(sw + 16384 + 96 * 128) = s.b3;
}
#ifndef PROBE_MFMA
#define PROBE_MFMA 0
#endif
#if PROBE_MFMA
DI void mma_step(f32x4 (&acc)[4][4], const char* sa, const char* sb, int o0, int o1, f32x4 (&dmy)[2][4]) {
#else
DI void mma_step(f32x4 (&acc)[4][4], const char* sa, const char* sb, int o0, int o1) {
#endif
  __builtin_amdgcn_s_setprio(1);
#pragma unroll
  for (int ks = 0; ks < 2; ++ks) {
    h16x8 af[4], bf[4];
    const int o = ks ? o1 : o0;
#pragma unroll
    for (int m = 0; m < 4; ++m) af[m] = *reinterpret_cast<const h16x8*>(sa + m * 16 * 128 + o);
#pragma unroll
    for (int n = 0; n < 4; ++n) bf[n] = *reinterpret_cast<const h16x8*>(sb + n * 16 * 128 + o);
#pragma unroll
    for (int m = 0; m < 4; ++m)
#pragma unroll
      for (int n = 0; n < 4; ++n) acc[m][n] = __builtin_amdgcn_mfma_f32_16x16x32_f16(af[m], bf[n], acc[m][n], 0, 0, 0);
#if PROBE_MFMA
#pragma unroll
    for (int m = 0; m < 2; ++m)
#pragma unroll
      for (int n = 0; n < 4; ++n) dmy[m][n] = __builtin_amdgcn_mfma_f32_16x16x32_f16(af[m + 2], bf[n], dmy[m][n], 0, 0, 0);
#endif
  }
  __builtin_amdgcn_s_setprio(0);
}
DI void gemm_kloop_body(f32x4 (&acc)[4][4], const h16* __restrict__ A, long lda, int a_lo, int a_hi,
                   const h16* __restrict__ Bt, long ldb, int K, char* smem, int tid) {
  const int lane = tid & 63, wid = tid >> 6, wr = wid >> 1, wc = wid & 1, fr = lane & 15, fq = lane >> 4;
#if PROBE_MFMA
  f32x4 dmy[2][4];
  for (int m = 0; m < 2; ++m) for (int n = 0; n < 4; ++n) dmy[m][n] = f32x4{0.f, 0.f, 0.f, 0.f};
#define MMA(a, b, c, d, e) mma_step(a, b, c, d, e, dmy)
#else
#define MMA(a, b, c, d, e) mma_step(a, b, c, d, e)
#endif
  Stg s0, s1;
  const int srow = tid >> 3, skc = tid & 7;
  int okm = 0;
  const h16* Ar[4];
#pragma unroll
  for (int i = 0; i < 4; ++i) { const int row = srow + 32 * i; const bool ok = row >= a_lo && row < a_hi; okm |= ok ? (1 << i) : 0;
    const int rc = min(max(row, a_lo), a_hi - 1); Ar[i] = A + (long)rc * lda + skc * 8; }
  const h16* Bp = Bt + (long)srow * ldb + skc * 8;
  const long b32 = 32 * ldb;
  char* sw = smem + srow * 128 + ((skc ^ ((srow >> 1) & 7)) << 4);
  const char* sra = smem + (wr * 64 + fr) * 128; const char* srb = smem + 16384 + (wc * 64 + fr) * 128;
  const int o0 = (fq ^ ((fr >> 1) & 7)) << 4, o1 = ((4 + fq) ^ ((fr >> 1) & 7)) << 4;
  const int nk = K >> 6;
  g_load(s0, Ar[0], Ar[1], Ar[2], Ar[3], Bp, b32, 0); g_load(s1, Ar[0], Ar[1], Ar[2], Ar[3], Bp, b32, 64);
  s_write(sw, s0, okm); __syncthreads();
  for (int kt = 0; kt + 2 < nk; kt += 2) {
    __builtin_amdgcn_s_setprio(1);
    g_load(s0, Ar[0], Ar[1], Ar[2], Ar[3], Bp, b32, (kt + 2) << 6);
    __builtin_amdgcn_sched_barrier(0);
    MMA(acc, sra, srb, o0, o1);
    __builtin_amdgcn_sched_barrier(0);
    s_write(sw + 32768, s1, okm);
    __syncthreads();
    __builtin_amdgcn_s_setprio(1);
    g_load(s1, Ar[0], Ar[1], Ar[2], Ar[3], Bp, b32, (kt + 3) << 6);
    __builtin_amdgcn_sched_barrier(0);
    MMA(acc, sra + 32768, srb + 32768, o0, o1);
    __builtin_amdgcn_sched_barrier(0);
    s_write(sw, s0, okm);
    __syncthreads();
  }
  MMA(acc, sra, srb, o0, o1);
  s_write(sw + 32768, s1, okm);
  __syncthreads();
  MMA(acc, sra + 32768, srb + 32768, o0, o1);
  __syncthreads();
#if PROBE_MFMA
  { float z = 0.f; asm volatile("" : "+v"(z)); for (int m = 0; m < 2; ++m) for (int n = 0; n < 4; ++n) acc[m][n] += dmy[m][n] * z; }
#endif
#undef MMA
}
#ifndef PROBE_KLOOP
#define PROBE_KLOOP 0
#endif
DI void gemm_kloop(f32x4 (&acc)[4][4], const h16* __restrict__ A, long lda, int a_lo, int a_hi,
                   const h16* __restrict__ Bt, long ldb, int K, char* smem, int tid) {
  gemm_kloop_body(acc, A, lda, a_lo, a_hi, Bt, ldb, K, smem, tid);
}
struct TileWalk { int lb, nlb, m0, Mx, NT, nfull; };
DI TileWalk tw_init(int MT, int NT) { TileWalk w; w.lb = blockIdx.x >> 3; w.nlb = gridDim.x >> 3; w.Mx = MT >> 3; w.m0 = (blockIdx.x & 7) * w.Mx; w.NT = NT; w.nfull = (w.Mx >> 3) * 8 * NT; return w; }
DI int tw_count(const TileWalk& w) { return w.Mx * w.NT; }
DI void tw_decode(const TileWalk& w, int idx, int& mt, int& nt) {
  if (idx < w.nfull) { const int mg = idx / (8 * w.NT), r = idx % (8 * w.NT); nt = r >> 3; mt = w.m0 + mg * 8 + (r & 7); }
  else { const int rem = w.Mx & 7, r = idx - w.nfull; nt = r / rem; mt = w.m0 + (w.Mx & ~7) + r % rem; }
}
DI void stage_acc(const f32x4 (&acc)[4][4], float* Zs, int tid) {
  const int lane = tid & 63, wid = tid >> 6, wr = wid >> 1, wc = wid & 1, fr = lane & 15, fq = lane >> 4;
#pragma unroll
  for (int m = 0; m < 4; ++m)
#pragma unroll
    for (int n = 0; n < 4; ++n)
#pragma unroll
      for (int j = 0; j < 4; ++j) Zs[(wr * 64 + m * 16 + fq * 4 + j) * 132 + wc * 64 + n * 16 + fr] = acc[m][n][j];
  __syncthreads();
}
DI void stage_acc_t(const f32x4 (&acc)[4][4], float* Zs, int tid) {
  const int lane = tid & 63, wid = tid >> 6, wr = wid >> 1, wc = wid & 1, fr = lane & 15, fq = lane >> 4;
#pragma unroll
  for (int m = 0; m < 4; ++m)
#pragma unroll
    for (int n = 0; n < 4; ++n)
      *reinterpret_cast<float4*>(Zs + (wc * 64 + n * 16 + fr) * 132 + wr * 64 + m * 16 + fq * 4) = make_float4(acc[m][n][0], acc[m][n][1], acc[m][n][2], acc[m][n][3]);
  __syncthreads();
}
DI void copy_out_f16(const float* Zs, h16* __restrict__ dst, long row0, long ld, int cb, int tid) {
#pragma unroll
  for (int it = 0; it < 8; ++it) {
    const int chunk = it * 256 + tid, row = chunk >> 4, c8 = (chunk & 15) * 8;
    const float4 x0 = *reinterpret_cast<const float4*>(Zs + row * 132 + c8), x1 = *reinterpret_cast<const float4*>(Zs + row * 132 + c8 + 4);
    h16x8 o; o[0] = (h16)x0.x; o[1] = (h16)x0.y; o[2] = (h16)x0.z; o[3] = (h16)x0.w; o[4] = (h16)x1.x; o[5] = (h16)x1.y; o[6] = (h16)x1.z; o[7] = (h16)x1.w;
    *reinterpret_cast<h16x8*>(dst + (row0 + row) * ld + cb + c8) = o;
  }
}
DI void acc_zero(f32x4 (&acc)[4][4]) {
#pragma unroll
  for (int m = 0; m < 4; ++m)
#pragma unroll
    for (int n = 0; n < 4; ++n) acc[m][n] = f32x4{0.f, 0.f, 0.f, 0.f};
}
DI void row_rms(const h16* __restrict__ A, long lda, int K, float* rs) {
  const int tid = tidx(), row = tid >> 1, half = tid & 1;
  const h16* p = A + (long)row * lda + half * (K >> 1);
  float ss = 0.f;
  for (int k = 0; k < (K >> 1); k += 8) {
    h16x8 v = *reinterpret_cast<const h16x8*>(p + k);
#pragma unroll
    for (int j = 0; j < 8; ++j) { float f = (float)v[j]; ss += f * f; }
  }
  ss += __shfl_xor(ss, 1);
  if (half == 0) rs[row] = rsqrtf(ss / (float)K + EPS);
}
DI int map_interleave(int n, int half) { int tile = n >> 7, r = n & 127, sub = r >> 4, fr = r & 15; int j = tile * 64 + (sub >> 1) * 16 + fr; return (sub & 1) ? half + j : j; }
DI int map_col(int mat, int n) {
  switch (mat) {
    case 0: if (n < 640) return n; if (n < 2304) return n + 32; if (n < 2336) return n - 2304 + 640; return -1;
    case 1: return 2336 + n;
    case 3: { int h = n >> 7, j = n & 127; return j < 96 ? h * 96 + j : -1; }
    case 4: return map_interleave(n, 384);
    case 9: return map_interleave(n, 2816);
    default: return n;
  }
}
struct MatDesc { const float* src; const float* scale; long dst; int K, Nmy, Nsrc, ld; };
DI MatDesc get_mat(const Params& P, int layer, int mat) {
  MatDesc d; d.scale = nullptr;
  d.ld = (mat == 0 || mat == 1 || mat == 8 || mat == 9) ? LD1 : 0;
  switch (mat) {
    case 0: d.src = P.in[I_WIN] + (long)layer * 1024 * 5408; d.dst = WT_WIN; d.K = 1024; d.Nmy = 2432; d.Nsrc = 5408; break;
    case 1: d.src = P.in[I_WIN] + (long)layer * 1024 * 5408; d.dst = WT_WGATE; d.K = 1024; d.Nmy = 3072; d.Nsrc = 5408; break;
    case 2: d.src = P.in[I_WUKV] + (long)layer * 256 * 1024; d.dst = WT_UKV; d.K = 256; d.Nmy = 1024; d.Nsrc = 1024; d.scale = P.in[I_GKV] + layer * 256; break;
    case 3: d.src = P.in[I_WUQ] + (long)layer * 512 * 768; d.dst = WT_UQ; d.K = 512; d.Nmy = 1024; d.Nsrc = 768; d.scale = P.in[I_GQ] + layer * 512; break;
    case 4: d.src = P.in[I_WGLU] + (long)layer * 384 * 768; d.dst = WT_GLU; d.K = 384; d.Nmy = 768; d.Nsrc = 768; break;
    case 5: d.src = P.in[I_WBRHY] + (long)layer * 384 * 1024; d.dst = WT_BRHY; d.K = 384; d.Nmy = 1024; d.Nsrc = 1024; break;
    case 6: d.src = P.in[I_WBRS5] + (long)layer * 384 * 1024; d.dst = WT_BRS5; d.K = 384; d.Nmy = 1024; d.Nsrc = 1024; break;
    case 7: d.src = P.in[I_WBRMLA] + (long)layer * 512 * 1024; d.dst = WT_BRMLA; d.K = 512; d.Nmy = 1024; d.Nsrc = 1024; break;
    case 8: d.src = P.in[I_WO] + (long)layer * 1024 * 1024; d.dst = WT_WO; d.K = 1024; d.Nmy = 1024; d.Nsrc = 1024; break;
    case 9: d.src = P.in[I_WUP] + (long)layer * 1024 * 5632; d.dst = WT_UP; d.K = 1024; d.Nmy = 5632; d.Nsrc = 5632; break;
    default: d.src = P.in[I_WDOWN] + (long)layer * 2816 * 1024; d.dst = WT_DOWN; d.K = 2816; d.Nmy = 1024; d.Nsrc = 1024; d.ld = LD2; break;
  }
  if (d.ld == 0) d.ld = d.K;
  return d;
}
constexpr int WT_TILES_PER_LAYER = 608 + 768 + 64 + 128 + 72 + 96 + 96 + 128 + 256 + 1408 + 704;
DI void item_wt(const Params& P, int item, char* smem) {
  const int layer = item / WT_TILES_PER_LAYER; int r = item % WT_TILES_PER_LAYER;
  const int cnt[11] = {608, 768, 64, 128, 72, 96, 96, 128, 256, 1408, 704};
  int mat = 0;
#pragma unroll
  for (int i = 0; i < 10; ++i) { if (mat == i && r >= cnt[i]) { r -= cnt[i]; mat = i + 1; } }
  MatDesc d = get_mat(P, layer, mat);
  const int kt = d.K >> 6, n0 = (r / kt) * 64, k0 = (r % kt) * 64;
  float* tile = reinterpret_cast<float*>(smem);
  h16* dst = reinterpret_cast<h16*>(P.ws + OFF_WT) + (long)layer * WT_LAYER + d.dst;
  const int tid = tidx(), lx = tid & 63, ly = tid >> 6;
  const int sc = map_col(mat, n0 + lx);
#pragma unroll 4
  for (int i = 0; i < 16; ++i) { int kk = i * 4 + ly; tile[kk * 65 + lx] = sc >= 0 ? d.src[(long)(k0 + kk) * d.Nsrc + sc] : 0.f; }
  __syncthreads();
  const float s = d.scale ? d.scale[k0 + lx] : 1.f;
#pragma unroll 4
  for (int i = 0; i < 16; ++i) { int nn = i * 4 + ly; dst[(long)(n0 + nn) * d.ld + k0 + lx] = (h16)(tile[lx * 65 + nn] * s); }
  __syncthreads();
}
DI void item_mod(const Params& P, int item, char* smem) {
  const int layer = item / 96, n0 = (item % 96) * 64;
  float* s = reinterpret_cast<float*>(smem);
  float* part = s + 9 * 1024;
  const int tid = tidx(), lane = tid & 63, wid = tid >> 6;
  for (int i = tid; i < 9 * 1024; i += NTHREADS) { float v = i < 8192 ? P.in[I_C][i] : P.in[I_CCTX][i - 8192]; s[i] = siluf_(v); }
  __syncthreads();
  const float* w = P.in[I_WMOD] + (long)layer * 1024 * 6144 + n0 + lane;
  float acc[9];
#pragma unroll
  for (int r = 0; r < 9; ++r) acc[r] = 0.f;
#pragma unroll 32
  for (int k = wid * 256; k < wid * 256 + 256; ++k) {
    const float wv = w[(long)k * 6144];
#pragma unroll
    for (int r = 0; r < 9; ++r) acc[r] += s[r * 1024 + k] * wv;
  }
#pragma unroll
  for (int r = 0; r < 9; ++r) part[(wid * 9 + r) * 64 + lane] = acc[r];
  __syncthreads();
  float* mod = reinterpret_cast<float*>(P.ws + OFF_MOD) + (long)layer * 9 * 6144;
  for (int i = tid; i < 9 * 64; i += NTHREADS) {
    const int r = i >> 6, c = i & 63;
    mod[r * 6144 + n0 + c] = part[(0 * 9 + r) * 64 + c] + part[(1 * 9 + r) * 64 + c] + part[(2 * 9 + r) * 64 + c] + part[(3 * 9 + r) * 64 + c] + P.in[I_BMOD][layer * 6144 + n0 + c];
  }
  __syncthreads();
}
DI void item_hymlp(const Params& P, int item, char* smem) {
  const int layer = item / 132; int r = item % 132;
  const int isc = r >= 128; const int Lf = isc ? CTXL : SEQ; const int t0 = (isc ? r - 128 : r) * 64;
  float* z1 = reinterpret_cast<float*>(smem);
  const int tid = tidx(), tl = tid >> 2, h0 = (tid & 3) * 16; const int t = t0 + tl;
  const float* w1 = P.in[I_FW1] + layer * 17 * 64; const float* b1 = P.in[I_FB1] + layer * 64;
  const float* w2 = P.in[I_FW2] + layer * 64 * 64; const float* b2 = P.in[I_FB2] + layer * 64; const float* fq = P.in[I_FFREQ] + layer * 64;
  float feat[17]; feat[0] = (float)t / (float)Lf;
#pragma unroll
  for (int k = 1; k <= 8; ++k) { float rev = (float)((t * k) % Lf) / (float)Lf; feat[k] = __builtin_amdgcn_cosf(rev); feat[8 + k] = __builtin_amdgcn_sinf(rev); }
#pragma unroll 4
  for (int j = 0; j < 16; ++j) {
    const int h = h0 + j; float a = b1[h];
#pragma unroll
    for (int f = 0; f < 17; ++f) a += feat[f] * w1[f * 64 + h];
    z1[tl * 65 + h] = __sinf(fq[h] * a);
  }
  __syncthreads();
  float* z2 = isc ? reinterpret_cast<float*>(P.ws + OFF_Z2C) + (long)layer * CTXL * 64 : reinterpret_cast<float*>(P.ws + OFF_Z2) + (long)layer * SEQ * 64;
  float a2[16];
#pragma unroll
  for (int j = 0; j < 16; ++j) a2[j] = b2[h0 + j];
  for (int k = 0; k < 64; ++k) {
    const float zv = z1[tl * 65 + k];
#pragma unroll
    for (int j = 0; j < 16; ++j) a2[j] += zv * w2[k * 64 + h0 + j];
  }
#pragma unroll
  for (int j = 0; j < 16; ++j) z2[(long)t * 64 + h0 + j] = __sinf(fq[h0 + j] * a2[j]);
  __syncthreads();
}
DI void item_s5disc(const Params& P, int item) {
  const int layer = item / 12, dir = (item % 12) / 6, gb = item % 6;
  const int tid = tidx(), g = gb * 4 + (tid >> 6), n = tid & 63;
  const int ld = layer * 2 + dir; const long gi = (long)ld * 24 + g;
  const double lre = P.in[I_LAMRE][gi * 64 + n], lim = P.in[I_LAMIM][gi * 64 + n];
  const double step = exp((double)P.in[I_LOGSTEP][gi]);
  double sn, cs; dsincos(lim * step, sn, cs);
  const double mag = exp(lre * step);
  const double are = mag * cs, aim = mag * sn;
  const double nr = are - 1.0, ni = aim, den = lre * lre + lim * lim;
  const double fre = (nr * lre + ni * lim) / den, fim = (ni * lre - nr * lim) / den;
  float2* A = reinterpret_cast<float2*>(P.ws + OFF_S5A); float2* A64 = reinterpret_cast<float2*>(P.ws + OFF_S5A64);
  A[gi * 64 + n] = make_float2((float)are, (float)aim);
  double pr = are, pi = aim;
  for (int i = 0; i < 6; ++i) { double t = pr * pr - pi * pi; pi = 2.0 * pr * pi; pr = t; }
  A64[gi * 64 + n] = make_float2((float)pr, (float)pi);
  float2* Bb = reinterpret_cast<float2*>(P.ws + OFF_S5B) + (gi * 64 + n) * 16;
  const float* bre = P.in[I_BRE] + (gi * 64 + n) * 16; const float* bim = P.in[I_BIM] + (gi * 64 + n) * 16;
  for (int c = 0; c < 16; ++c) { double br = bre[c], bi = bim[c]; Bb[c] = make_float2((float)(fre * br - fim * bi), (float)(fre * bi + fim * br)); }
  h16* Ct = reinterpret_cast<h16*>(P.ws + OFF_S5C) + gi * 16 * 128;
  const float* cre = P.in[I_CRE] + gi * 16 * 64; const float* cim = P.in[I_CIM] + gi * 16 * 64;
  for (int c = 0; c < 16; ++c) { Ct[c * 128 + n] = (h16)cre[c * 64 + n]; Ct[c * 128 + 64 + n] = (h16)(-cim[c * 64 + n]); }
}
DI void item_rope(const Params& P, int item) {
  const int idx = item * NTHREADS + tidx(); const int pos = idx >> 4, i = idx & 15;
  const double inv[8] = {1.0, 0.31622776601683794, 0.1, 0.031622776601683794, 0.01, 0.0031622776601683794, 0.001, 0.00031622776601683794};
  double iv = 1.0;
#pragma unroll
  for (int k = 0; k < 8; ++k) if ((i & 7) == k) iv = inv[k];
  const double ang = (double)(i < 8 ? (pos >> 6) : (pos & 63)) * iv;
  double s, c; dsincos(ang, s, c);
  reinterpret_cast<float2*>(P.ws + OFF_ROPE)[idx] = make_float2((float)c, (float)s);
}
constexpr int PRO_N_WT = 2 * WT_TILES_PER_LAYER, PRO_N_MOD = 192, PRO_N_HY = 264, PRO_N_S5 = 24, PRO_N_ROPE = 512;
DI void phase_prologue(const Params& P, char* smem) {
  const int total = PRO_N_MOD + PRO_N_HY + PRO_N_S5 + PRO_N_ROPE + PRO_N_WT;
  for (int it = blockIdx.x; it < total; it += gridDim.x) {
    int i = it;
    if (i < PRO_N_MOD) { item_mod(P, i, smem); continue; } i -= PRO_N_MOD;
    if (i < PRO_N_HY) { item_hymlp(P, i, smem); continue; } i -= PRO_N_HY;
    if (i < PRO_N_S5) { item_s5disc(P, i); continue; } i -= PRO_N_S5;
    if (i < PRO_N_ROPE) { item_rope(P, i); continue; } i -= PRO_N_ROPE;
    item_wt(P, i, smem);
  }
}

DI const float* xrow_src(const Params& P, int layer_stage, int t) {
  if (t < TLAT) return (layer_stage == 0 ? P.in[I_X] : P.out) + (long)t * 1024;
  return (layer_stage == 0 ? P.in[I_CTX] : reinterpret_cast<const float*>(P.ws + OFF_XC)) + (long)(t - TLAT) * 1024;
}
DI float* xrow_dst(const Params& P, int t) {
  if (t < TLAT) return P.out + (long)t * 1024;
  return reinterpret_cast<float*>(P.ws + OFF_XC) + (long)(t - TLAT) * 1024;
}
DI void normmod_rows(const Params& P, int layer, int which, int stage, int ntok, int item, int nitems_stride) {
  const int tid = tidx(), lane = tid & 63, wid = tid >> 6;
  const float* g = P.in[which ? I_N2G : I_N1G] + layer * 1024;
  const float* mod = reinterpret_cast<const float*>(P.ws + OFF_MOD) + (long)layer * 9 * 6144;
  h16* H = reinterpret_cast<h16*>(P.ws + OFF_H1);
#pragma unroll 2
  for (int rg = item; rg * 4 < ntok; rg += nitems_stride) {
    const int t = rg * 4 + wid;
    const Tok k = tokinfo(t);
    const float* xr = xrow_src(P, stage, t);
    const float* sh = mod + k.mrow * 6144 + (which ? 3 : 0) * 1024; const float* sc = sh + 1024;
    float4 v[4]; float ss = 0.f;
#pragma unroll
    for (int i = 0; i < 4; ++i) { v[i] = *reinterpret_cast<const float4*>(xr + i * 256 + lane * 4); ss += v[i].x * v[i].x + v[i].y * v[i].y + v[i].z * v[i].z + v[i].w * v[i].w; }
    ss = wave_sum(ss);
    const float r = rsqrtf(ss * (1.f / 1024.f) + EPS);
#pragma unroll
    for (int i = 0; i < 4; ++i) {
      const int c = i * 256 + lane * 4;
      const float4 gg = *reinterpret_cast<const float4*>(g + c), s1 = *reinterpret_cast<const float4*>(sc + c), s0 = *reinterpret_cast<const float4*>(sh + c);
      h16x4 o;
      o[0] = (h16)(v[i].x * r * gg.x * (1.f + s1.x) + s0.x); o[1] = (h16)(v[i].y * r * gg.y * (1.f + s1.y) + s0.y);
      o[2] = (h16)(v[i].z * r * gg.z * (1.f + s1.z) + s0.z); o[3] = (h16)(v[i].w * r * gg.w * (1.f + s1.w) + s0.w);
      *reinterpret_cast<h16x4*>(H + (long)t * LD1 + c) = o;
    }
  }
}
DI void phase_final(const Params& P) {
  const int lane = tidx() & 63, wid = tidx() >> 6;
  const float* g = P.in[I_FINALG];
  for (int rg = blockIdx.x; rg * 4 < TLAT; rg += gridDim.x) {
    float* xr = P.out + (long)(rg * 4 + wid) * 1024;
    float4 v[4]; float ss = 0.f;
#pragma unroll
    for (int i = 0; i < 4; ++i) { v[i] = *reinterpret_cast<const float4*>(xr + i * 256 + lane * 4); ss += v[i].x * v[i].x + v[i].y * v[i].y + v[i].z * v[i].z + v[i].w * v[i].w; }
    ss = wave_sum(ss);
    const float r = rsqrtf(ss * (1.f / 1024.f) + EPS);
#pragma unroll
    for (int i = 0; i < 4; ++i) {
      const int c = i * 256 + lane * 4; const float4 gg = *reinterpret_cast<const float4*>(g + c);
      *reinterpret_cast<float4*>(xr + c) = make_float4(v[i].x * r * gg.x, v[i].y * r * gg.y, v[i].z * r * gg.z, v[i].w * r * gg.w);
    }
  }
}
DI float2 r8(int idx) { const float c = 0.70710678118654752f; return idx == 0 ? make_float2(1.f, 0.f) : idx == 1 ? make_float2(c, -c) : idx == 2 ? make_float2(0.f, -1.f) : make_float2(-c, -c); }
DI float2 cmul_r8(float2 w, int idx, bool cj) {
  if (idx == 0) return w;
  float2 r = r8(idx); if (cj) r.y = -r.y;
  return cmul(w, r);
}
template <int S> DI void fft_dif_pass(float2* X, int h) {
  const int hs = h >> (S - 1);
#pragma unroll 1
  for (int item = tidx(); item < (8192 >> S); item += NTHREADS) {
    const int j = item % hs, blk = item / hs, i0 = blk * 2 * h + j;
    float2 v[1 << S];
#pragma unroll
    for (int k = 0; k < (1 << S); ++k) v[k] = X[i0 + k * hs];
    float2 wp[S];
    wp[0] = twid(-(float)j / (float)(2 * h));
#pragma unroll
    for (int q = 1; q < S; ++q) wp[q] = cmul(wp[q - 1], wp[q - 1]);
#pragma unroll
    for (int q = 0; q < S; ++q) {
      const int dist = 1 << (S - 1 - q);
#pragma unroll
      for (int k = 0; k < (1 << S); ++k) {
        if (k & dist) continue;
        const float2 a = v[k], b = v[k + dist];
        const int m = k & (dist - 1);
        const float2 tw = cmul_r8(wp[q], m << (3 - (S - q)), false);
        v[k] = make_float2(a.x + b.x, a.y + b.y);
        v[k + dist] = cmul(make_float2(a.x - b.x, a.y - b.y), tw);
      }
    }
#pragma unroll
    for (int k = 0; k < (1 << S); ++k) X[i0 + k * hs] = v[k];
  }
  __syncthreads();
}
template <int S> DI void fft_dit_pass(float2* X, int hs) {
  const int hmax = hs << (S - 1);
#pragma unroll 1
  for (int item = tidx(); item < (8192 >> S); item += NTHREADS) {
    const int j = item % hs, blk = item / hs, i0 = blk * 2 * hmax + j;
    float2 v[1 << S];
#pragma unroll
    for (int k = 0; k < (1 << S); ++k) v[k] = X[i0 + k * hs];
    float2 bp[S];
    bp[S - 1] = twid((float)j / (float)(2 * hmax));
#pragma unroll
    for (int q = S - 2; q >= 0; --q) bp[q] = cmul(bp[q + 1], bp[q + 1]);
#pragma unroll
    for (int q = 0; q < S; ++q) {
      const int dist = 1 << q;
#pragma unroll
      for (int k = 0; k < (1 << S); ++k) {
        if (k & dist) continue;
        const int m = k & (dist - 1);
        const float2 tw = cmul_r8(bp[q], m << (3 - (q + 1)), true);
        const float2 a = v[k], b = cmul(v[k + dist], tw);
        v[k] = make_float2(a.x + b.x, a.y + b.y);
        v[k + dist] = make_float2(a.x - b.x, a.y - b.y);
      }
    }
#pragma unroll
    for (int k = 0; k < (1 << S); ++k) X[i0 + k * hs] = v[k];
  }
  __syncthreads();
}
DI void fft_fwd1(float2* X) { fft_dif_pass<3>(X, 4096); fft_dif_pass<3>(X, 512); fft_dif_pass<3>(X, 64); fft_dif_pass<2>(X, 8); fft_dif_pass<2>(X, 2); }
DI void fft_inv(float2* X) { fft_dit_pass<2>(X, 1); fft_dit_pass<2>(X, 4); fft_dit_pass<3>(X, 16); fft_dit_pass<3>(X, 128); fft_dit_pass<3>(X, 1024); }
#ifndef PROBE_FFT
#define PROBE_FFT 0
#endif
DI void fft_fwd(float2* X) {
#if PROBE_FFT
  fft_fwd1(X); fft_inv(X);
  for (int i = tidx(); i < 8192; i += NTHREADS) { float2 v = X[i]; X[i] = make_float2(v.x * (1.f / 8192.f), v.y * (1.f / 8192.f)); }
  __syncthreads();
#endif
  fft_fwd1(X);
}

DI float block_sum(float v, float* red) {
  v = wave_sum(v);
  __syncthreads();
  if ((tidx() & 63) == 0) red[tidx() >> 6] = v;
  __syncthreads();
  const float r = red[0] + red[1] + red[2] + red[3];
  __syncthreads();
  return r;
}
DI void item_filter(const Params& P, int layer, int oc, char* smem) {
  float2* X = reinterpret_cast<float2*>(smem); float* red = reinterpret_cast<float*>(smem + 65536);
  const int tid = tidx();
  const float* z2 = reinterpret_cast<const float*>(P.ws + OFF_Z2) + (long)layer * SEQ * 64;
  const float* w3 = P.in[I_FW3] + (long)layer * 64 * 1536; const float* dec = P.in[I_FDECAY] + layer * 1536;
  const int colf = oc, colb = 768 + oc;
  const float df = fabsf(dec[colf]), db = fabsf(dec[colb]);
  float lsum = 0.f;
#pragma unroll 2
  for (int i = 0; i < 32; ++i) {
    const int t = tid + 256 * i; const float* zr = z2 + (long)t * 64;
    float af = 0.f, ab = 0.f;
#pragma unroll 8
    for (int k = 0; k < 64; ++k) { const float z = zr[k]; af += z * w3[k * 1536 + colf]; ab += z * w3[k * 1536 + colb]; }
    const float tn = (float)t * (1.f / 8192.f);
    af *= __expf(-tn * df); ab *= __expf(-tn * db);
    lsum += fabsf(af) + fabsf(ab);
    X[t] = make_float2(af, ab);
  }
  const float nrm = block_sum(lsum, red);
  const float sc = 0.5f / 8192.f / nrm;
  float ev[32];
  float2* F = reinterpret_cast<float2*>(P.ws + OFF_FILT) + (long)oc * 2 * 8192;
#pragma unroll
  for (int i = 0; i < 32; ++i) {
    const int n = tid + 256 * i; const float lo = X[n].x; const float hi = n > 0 ? X[8192 - n].y : 0.f;
    ev[i] = (lo + hi) * sc; F[8192 + n] = make_float2((lo - hi) * sc, 0.f);
  }
  __syncthreads();
#pragma unroll
  for (int i = 0; i < 32; ++i) X[tid + 256 * i] = make_float2(ev[i], 0.f);
  __syncthreads();
  fft_fwd(X);
#pragma unroll 4
  for (int i = 0; i < 32; ++i) F[tid + 256 * i] = X[tid + 256 * i];
  __syncthreads();
#pragma unroll 4
  for (int i = 0; i < 32; ++i) { const int n = tid + 256 * i; const float d = F[8192 + n].x; const float2 w = twid(-(float)n * (1.f / 16384.f)); X[n] = make_float2(d * w.x, d * w.y); }
  __syncthreads();
  fft_fwd(X);
#pragma unroll 4
  for (int i = 0; i < 32; ++i) F[8192 + tid + 256 * i] = X[tid + 256 * i];
  __syncthreads();
}
DI void item_filter_ctx(const Params& P, int layer, int oc, char* smem) {
  float* red = reinterpret_cast<float*>(smem);
  const int t = tidx();
  const float* zr = reinterpret_cast<const float*>(P.ws + OFF_Z2C) + (long)layer * CTXL * 64 + t * 64;
  const float* w3 = P.in[I_FW3] + (long)layer * 64 * 1536; const float* dec = P.in[I_FDECAY] + layer * 1536;
  float af = 0.f, ab = 0.f;
  for (int k = 0; k < 64; ++k) { const float z = zr[k]; af += z * w3[k * 1536 + oc]; ab += z * w3[k * 1536 + 768 + oc]; }
  const float tn = (float)t * (1.f / 256.f);
  af *= __expf(-tn * fabsf(dec[oc])); ab *= __expf(-tn * fabsf(dec[768 + oc]));
  const float nrm = block_sum(fabsf(af) + fabsf(ab), red);
  float* T = reinterpret_cast<float*>(P.ws + OFF_TAPSC) + (long)oc * 512;
  T[t] = af / nrm; T[256 + t] = ab / nrm;
}

DI void phase_norm1(const Params& P, int layer, char* smem) {
  const int nfilt = 768 + (layer == 0 ? 768 : 0);
  for (int it = blockIdx.x; it < nfilt; it += gridDim.x) {
    if (it < 768) item_filter(P, layer, it, smem); else item_filter_ctx(P, layer, it - 768, smem);
  }
  normmod_rows(P, layer, 0, layer, TT, blockIdx.x, gridDim.x);
}

DI void phase_gemm_in(const Params& P, int layer, char* smem) {
  const int tid = tidx(), lane = tid & 63, wid = tid >> 6, wr = wid >> 1, wc = wid & 1, fr = lane & 15, fq = lane >> 4;
  const h16* H = reinterpret_cast<const h16*>(P.ws + OFF_H1);
  const h16* W = reinterpret_cast<const h16*>(P.ws + OFF_WT) + (long)layer * WT_LAYER + WT_WIN;
  h16* U = reinterpret_cast<h16*>(P.ws + OFF_U); h16* KV = reinterpret_cast<h16*>(P.ws + OFF_KVLAT); h16* QL = reinterpret_cast<h16*>(P.ws + OFF_QLAT);
  h16* PHY = reinterpret_cast<h16*>(P.ws + OFF_PHY); h16* PHYC = reinterpret_cast<h16*>(P.ws + OFF_PHYC); h16* Kb = reinterpret_cast<h16*>(P.ws + OFF_K);
  const float2* rope = reinterpret_cast<const float2*>(P.ws + OFF_ROPE);
  constexpr int NT = 19, MT = TT / 128;
  const TileWalk tw = tw_init(MT, NT);
  for (int tile = tw.lb; tile < tw_count(tw); tile += tw.nlb) {
    int mt, nt; tw_decode(tw, tile, mt, nt);
    f32x4 acc[4][4]; acc_zero(acc);
    gemm_kloop(acc, H + (long)mt * 128 * LD1, LD1, 0, 128, W + (long)nt * 128 * LD1, LD1, 1024, smem, opaque_tid());
    const int t0 = mt * 128; const Tok tk = tokinfo(t0);
    if (nt < 18) {
      float* Zs = reinterpret_cast<float*>(smem);
      const int t2 = tidx();
      if (nt < 9) {
        stage_acc(acc, Zs, t2);
        h16* dst; int ld, cb;
        if (nt < 3) { dst = U; ld = 384; cb = nt * 128; } else if (nt < 5) { dst = KV; ld = 256; cb = (nt - 3) * 128; } else { dst = QL; ld = 512; cb = (nt - 5) * 128; }
        copy_out_f16(Zs, dst, t0, ld, cb, t2);
      } else {
        stage_acc_t(acc, Zs, t2);
        h16* base = tk.ctx ? PHYC + (long)tk.b * 1152 * CTXL : PHY + (long)tk.b * 1152 * SEQ; const int lp = tk.ctx ? CTXL : SEQ;
        copy_out_f16(Zs, base, (nt - 9) * 128, lp, tk.pos, t2);
      }
      __syncthreads();
    } else {
      h16* R = reinterpret_cast<h16*>(smem);
      if (wc == 0) {
#pragma unroll
        for (int m = 0; m < 4; ++m)
#pragma unroll
          for (int j = 0; j < 4; ++j) {
            const int row = wr * 64 + m * 16 + fq * 4 + j; const int pos = tk.pos + row;
            float x1 = acc[m][0][j], x2 = acc[m][1][j];
            if (!tk.ctx) { const float2 cs = rope[pos * 16 + fr]; const float y1 = x1 * cs.x - x2 * cs.y, y2 = x1 * cs.y + x2 * cs.x; x1 = y1; x2 = y2; }
            R[row * 32 + fr] = (h16)x1; R[row * 32 + 16 + fr] = (h16)x2;
          }
      }
      __syncthreads();
      {
        const int t2 = tidx(); const int key0 = (tk.ctx ? SEQ : 0) + tk.pos;
#pragma unroll
        for (int it = 0; it < 2; ++it) {
          const int chunk = it * 256 + t2, row = chunk >> 2, part = chunk & 3;
          const uint4 v = *reinterpret_cast<const uint4*>(R + row * 32 + part * 8);
#pragma unroll
          for (int h = 0; h < 8; ++h) *reinterpret_cast<uint4*>(Kb + ((long)(tk.b * 8 + h) * KEYS + key0 + row) * 96 + 64 + part * 8) = v;
        }
      }
      __syncthreads();
    }
  }
}
DI void item_kv(const Params& P, int layer, int tile, char* smem) {
  const int tid = tidx(), lane = tid & 63, wid = tid >> 6, wr = wid >> 1, wc = wid & 1, fr = lane & 15, fq = lane >> 4;
  const int mt = tile >> 3, hd = tile & 7; const int t0 = mt * 128; const Tok tk = tokinfo(t0);
  const h16* A = reinterpret_cast<const h16*>(P.ws + OFF_KVLAT) + (long)t0 * 256;
  const h16* W = reinterpret_cast<const h16*>(P.ws + OFF_WT) + (long)layer * WT_LAYER + WT_UKV + (long)hd * 128 * 256;
  float* rs = reinterpret_cast<float*>(smem + 73728);
  row_rms(A, 256, 256, rs);
  f32x4 acc[4][4]; acc_zero(acc);
  gemm_kloop(acc, A, 256, 0, 128, W, 256, 256, smem, opaque_tid());
  h16* Kb = reinterpret_cast<h16*>(P.ws + OFF_K) + (long)(tk.b * 8 + hd) * KEYS * 96;
  h16* Vt = reinterpret_cast<h16*>(P.ws + OFF_VT) + (long)(tk.b * 8 + hd) * 64 * KEYS;
  const int key0 = (tk.ctx ? SEQ : 0) + tk.pos;
#pragma unroll
  for (int m = 0; m < 4; ++m) {
    const int r0 = wr * 64 + m * 16 + fq * 4;
    const float s0 = rs[r0], s1 = rs[r0 + 1], s2 = rs[r0 + 2], s3 = rs[r0 + 3];
#pragma unroll
    for (int n = 0; n < 4; ++n) {
      acc[m][n][0] *= s0; acc[m][n][1] *= s1; acc[m][n][2] *= s2; acc[m][n][3] *= s3;
      if (wc == 1) {
        h16x4 o; o[0] = (h16)acc[m][n][0]; o[1] = (h16)acc[m][n][1]; o[2] = (h16)acc[m][n][2]; o[3] = (h16)acc[m][n][3];
        *reinterpret_cast<h16x4*>(Vt + (long)(n * 16 + fr) * KEYS + key0 + r0) = o;
      }
    }
  }
  {
    float* Zs = reinterpret_cast<float*>(smem);
    const int t2 = tidx();
    stage_acc(acc, Zs, t2);
#pragma unroll
    for (int it = 0; it < 4; ++it) {
      const int chunk = it * 256 + t2, row = chunk >> 3, c8 = (chunk & 7) * 8;
      const float4 x0 = *reinterpret_cast<const float4*>(Zs + row * 132 + c8), x1 = *reinterpret_cast<const float4*>(Zs + row * 132 + c8 + 4);
      h16x8 o; o[0] = (h16)x0.x; o[1] = (h16)x0.y; o[2] = (h16)x0.z; o[3] = (h16)x0.w; o[4] = (h16)x1.x; o[5] = (h16)x1.y; o[6] = (h16)x1.z; o[7] = (h16)x1.w;
      *reinterpret_cast<h16x8*>(Kb + (long)(key0 + row) * 96 + c8) = o;
    }
  }
  __syncthreads();
}
DI void item_q(const Params& P, int layer, int tile, char* smem) {
  const int tid = tidx(), lane = tid & 63, wid = tid >> 6, wr = wid >> 1, wc = wid & 1, fr = lane & 15, fq = lane >> 4;
  const int mt = tile >> 3, hd = tile & 7; const int t0 = mt * 128; const Tok tk = tokinfo(t0);
  const h16* A = reinterpret_cast<const h16*>(P.ws + OFF_QLAT) + (long)t0 * 512;
  const h16* W = reinterpret_cast<const h16*>(P.ws + OFF_WT) + (long)layer * WT_LAYER + WT_UQ + (long)hd * 128 * 512;
  float* rs = reinterpret_cast<float*>(smem + 73728);
  row_rms(A, 512, 512, rs);
  f32x4 acc[4][4]; acc_zero(acc);
  gemm_kloop(acc, A, 512, 0, 128, W, 512, 512, smem, opaque_tid());
  h16* Qb = reinterpret_cast<h16*>(P.ws + OFF_Q) + (long)(tk.b * 8 + hd) * KEYS * 96;
  const float2* rope = reinterpret_cast<const float2*>(P.ws + OFF_ROPE);
  const int q0 = (tk.ctx ? SEQ : 0) + tk.pos;
#pragma unroll
  for (int m = 0; m < 4; ++m)
#pragma unroll
    for (int j = 0; j < 4; ++j) {
      const int r = wr * 64 + m * 16 + fq * 4 + j; const float s = rs[r] * QSCALE;
      if (wc == 0) {
#pragma unroll
        for (int n = 0; n < 4; ++n) acc[m][n][j] *= s;
      } else {
        float x1 = acc[m][0][j], x2 = acc[m][1][j];
        if (!tk.ctx) { const float2 cs = rope[(tk.pos + r) * 16 + fr]; const float y1 = x1 * cs.x - x2 * cs.y, y2 = x1 * cs.y + x2 * cs.x; x1 = y1; x2 = y2; }
        acc[m][0][j] = x1 * s; acc[m][1][j] = x2 * s;
      }
    }
  {
    float* Zs = reinterpret_cast<float*>(smem);
    const int t2 = tidx();
    stage_acc(acc, Zs, t2);
#pragma unroll
    for (int it = 0; it < 6; ++it) {
      const int chunk = it * 256 + t2, row = chunk / 12, c8 = (chunk % 12) * 8;
      const float4 x0 = *reinterpret_cast<const float4*>(Zs + row * 132 + c8), x1 = *reinterpret_cast<const float4*>(Zs + row * 132 + c8 + 4);
      h16x8 o; o[0] = (h16)x0.x; o[1] = (h16)x0.y; o[2] = (h16)x0.z; o[3] = (h16)x0.w; o[4] = (h16)x1.x; o[5] = (h16)x1.y; o[6] = (h16)x1.z; o[7] = (h16)x1.w;
      *reinterpret_cast<h16x8*>(Qb + (long)(q0 + row) * 96 + c8) = o;
    }
  }
  __syncthreads();
}
DI int s5_chunk_base(int b, int dir, int si) {
  if (si < 4) { const int cc = dir ? 3 - si : si; return TLAT + b * CTXL + cc * 64; }
  const int lc = dir ? 127 - (si - 4) : si - 4; return b * SEQ + lc * 64;
}
DI void s5_stage_u(const h16* __restrict__ U, int tokbase, int g, float* us) {
  const int lane = tidx() & 63;
  const h16* p = U + (long)(tokbase + lane) * 384 + g * 16;
  const h16x8 v0 = *reinterpret_cast<const h16x8*>(p), v1 = *reinterpret_cast<const h16x8*>(p + 8);
#pragma unroll
  for (int j = 0; j < 8; ++j) { us[lane * 16 + j] = (float)v0[j]; us[lane * 16 + 8 + j] = (float)v1[j]; }
}
DI void item_s5_pass1(const Params& P, int layer, int wtask, char* smem) {
  const int lane = tidx() & 63, wid = tidx() >> 6;
  float* us = reinterpret_cast<float*>(smem + wid * 12800);
  const int si = wtask % 132; int r = wtask / 132; const int g = r % 24; r /= 24; const int dir = r & 1, b = r >> 1;
  const long gi = (long)(layer * 2 + dir) * 24 + g;
  const float2 a = reinterpret_cast<const float2*>(P.ws + OFF_S5A)[gi * 64 + lane];
  const float2* Bb = reinterpret_cast<const float2*>(P.ws + OFF_S5B) + (gi * 64 + lane) * 16;
  float bre[16], bim[16];
#pragma unroll
  for (int c = 0; c < 16; ++c) { const float2 v = Bb[c]; bre[c] = v.x; bim[c] = v.y; }
  s5_stage_u(reinterpret_cast<const h16*>(P.ws + OFF_U), s5_chunk_base(b, dir, si), g, us);
  float hr = 0.f, hi = 0.f;
#pragma unroll 4
  for (int s = 0; s < 64; ++s) {
    const int tau = dir ? 63 - s : s;
    const float4* up = reinterpret_cast<const float4*>(us + tau * 16);
    float br = 0.f, bi = 0.f;
#pragma unroll
    for (int q = 0; q < 4; ++q) { const float4 u = up[q];
      br += bre[q * 4] * u.x + bre[q * 4 + 1] * u.y + bre[q * 4 + 2] * u.z + bre[q * 4 + 3] * u.w;
      bi += bim[q * 4] * u.x + bim[q * 4 + 1] * u.y + bim[q * 4 + 2] * u.z + bim[q * 4 + 3] * u.w; }
    const float nr = a.x * hr - a.y * hi + br, ni = a.x * hi + a.y * hr + bi; hr = nr; hi = ni;
  }
  reinterpret_cast<float2*>(P.ws + OFF_E)[((long)((b * 2 + dir) * 24 + g) * 132 + si) * 64 + lane] = make_float2(hr, hi);
}

DI float hy_dw(const h16* __restrict__ p, int t, int Ls, float w0, float w1, float w2, float bias) {
  const float xm_ = (float)p[max(t - 1, 0)], x0 = (float)p[t], xp_ = (float)p[min(t + 1, Ls - 1)];
  const float xm = t > 0 ? xm_ : 0.f, xp = t + 1 < Ls ? xp_ : 0.f;
  return xm * w0 + x0 * w1 + xp * w2 + bias;
}
DI void item_hyena(const Params& P, int layer, int task, char* smem) {
  float2* X = reinterpret_cast<float2*>(smem);
  const int tid = tidx(); const int pair = task / 384, c = task % 384;
  const h16* PH0 = reinterpret_cast<const h16*>(P.ws + OFF_PHY) + (long)(2 * pair) * 1152 * SEQ;
  const h16* PH1 = PH0 + (long)1152 * SEQ;
  const float* cw = P.in[I_HCW] + layer * 3 * 1152; const float* cb = P.in[I_HCB] + layer * 1152;
  const float2* F = reinterpret_cast<const float2*>(P.ws + OFF_FILT);
  float2* SCR = reinterpret_cast<float2*>(P.ws + OFF_YS5PRE) + (long)blockIdx.x * 12288;
  float2* SCR2 = SCR + 8192;
  const float vw0 = cw[c], vw1 = cw[1152 + c], vw2 = cw[2304 + c], vbb = cb[c];
  const h16* pv0 = PH0 + (long)c * SEQ; const h16* pv1 = PH1 + (long)c * SEQ;
  float2 ye[16]; int tq;
#pragma unroll 1
  for (int o = 0; o < 2; ++o) {
    const float2* Te = F + (long)(o * 384 + c) * 2 * 8192; const float2* To = Te + 8192;
    float ts = 1.f / 16384.f; asm volatile("" : "+v"(ts));
{ tq = tid; asm volatile("" : "+v"(tq)); }
    if (o == 0) {
#pragma unroll 8
      for (int i = 0; i < 32; ++i) { const int t = tq + 256 * i; const float2 v = make_float2(hy_dw(pv0, t, SEQ, vw0, vw1, vw2, vbb), hy_dw(pv1, t, SEQ, vw0, vw1, vw2, vbb)); X[t] = v; SCR[t] = v; }
    } else {
#pragma unroll 16
      for (int i = 0; i < 32; ++i) { const int t = tq + 256 * i; X[t] = SCR[t]; }
    }
    __syncthreads();
    fft_fwd(X);
{ tq = tid; asm volatile("" : "+v"(tq)); }
#pragma unroll 8
    for (int i = 0; i < 32; ++i) { const int n = tq + 256 * i; X[n] = cmul(X[n], Te[n]); }
    __syncthreads();
    fft_inv(X);
{ tq = tid; asm volatile("" : "+v"(tq)); }
#pragma unroll
    for (int i = 0; i < 16; ++i) { ye[i] = X[tq + 256 * i]; SCR2[tq + 256 * i] = X[tq + 4096 + 256 * i]; }
    __syncthreads();
{ tq = tid; asm volatile("" : "+v"(tq)); }
#pragma unroll 16
    for (int i = 0; i < 32; ++i) { const int t = tq + 256 * i; X[t] = cmul(SCR[t], twid(-(float)t * ts)); }
    __syncthreads();
    fft_fwd(X);
{ tq = tid; asm volatile("" : "+v"(tq)); }
#pragma unroll 8
    for (int i = 0; i < 32; ++i) { const int n = tq + 256 * i; X[n] = cmul(X[n], To[n]); }
    __syncthreads();
    fft_inv(X);
    asm volatile("" : "+v"(ts));
{ tq = tid; asm volatile("" : "+v"(tq)); }
#pragma unroll
    for (int i = 0; i < 16; ++i) { const int t = tq + 256 * i; const float2 yo = cmul(X[t], twid((float)t * ts)); X[t] = make_float2(ye[i].x + yo.x, ye[i].y + yo.y); }
{ tq = tid; asm volatile("" : "+v"(tq)); }
#pragma unroll 2
    for (int i = 0; i < 16; ++i) { const int t = tq + 4096 + 256 * i; const float2 yo = cmul(X[t], twid((float)t * ts)); const float2 y2 = SCR2[tq + 256 * i]; X[t] = make_float2(y2.x + yo.x, y2.y + yo.y); }
    const int gc = (o + 1) * 384 + c;
    const float w0 = cw[gc], w1 = cw[1152 + gc], w2 = cw[2304 + gc], bb = cb[gc];
    const float bias = P.in[I_HBIAS][(layer * 2 + o) * 384 + c];
    const h16* pg0 = PH0 + (long)gc * SEQ; const h16* pg1 = PH1 + (long)gc * SEQ;
{ tq = tid; asm volatile("" : "+v"(tq)); }
    if (o == 0) {
#pragma unroll 8
      for (int i = 0; i < 32; ++i) {
        const int t = tq + 256 * i;
        const float2 lc = X[t];
        const float2 zz = SCR[t];
        const float gx = hy_dw(pg0, t, SEQ, w0, w1, w2, bb), gy = hy_dw(pg1, t, SEQ, w0, w1, w2, bb);
        SCR[t] = make_float2(gx * (lc.x + bias * zz.x), gy * (lc.y + bias * zz.y));
      }
    } else {
#pragma unroll 8
      for (int i = 0; i < 32; ++i) {
        const int t = tq + 256 * i;
        const float2 lc = X[t];
        const float2 zz = SCR[t];
        const float gx = hy_dw(pg0, t, SEQ, w0, w1, w2, bb), gy = hy_dw(pg1, t, SEQ, w0, w1, w2, bb);
        const_cast<h16*>(pv0)[t] = (h16)(gx * (lc.x + bias * zz.x)); const_cast<h16*>(pv1)[t] = (h16)(gy * (lc.y + bias * zz.y));
      }
    }
    __syncthreads();
  }
}
DI void item_hyena_ctx(const Params& P, int layer, int task, char* smem) {
  float* su = reinterpret_cast<float*>(smem); float* sf = su + 256; float* sb = sf + 256;
  const int t = tidx(); const int b = task / 384, c = task % 384;
  const h16* PH = reinterpret_cast<const h16*>(P.ws + OFF_PHYC) + (long)b * 1152 * CTXL;
  const float* cw = P.in[I_HCW] + layer * 3 * 1152; const float* cb = P.in[I_HCB] + layer * 1152;
  float u = hy_dw(PH + (long)c * CTXL, t, CTXL, cw[c], cw[1152 + c], cw[2304 + c], cb[c]);
  for (int o = 0; o < 2; ++o) {
    const float* T = reinterpret_cast<const float*>(P.ws + OFF_TAPSC) + (long)(o * 384 + c) * 512;
    __syncthreads();
    su[t] = u; sf[t] = T[t]; sb[t] = T[256 + t];
    __syncthreads();
    float y = 0.f;
    for (int s = 0; s <= t; ++s) y += sf[t - s] * su[s];
    for (int s = t + 1; s < 256; ++s) y += sb[s - t] * su[s];
    const int gc = (o + 1) * 384 + c;
    const float gx = hy_dw(PH + (long)gc * CTXL, t, CTXL, cw[gc], cw[1152 + gc], cw[2304 + gc], cb[gc]);
    u = gx * (y + P.in[I_HBIAS][(layer * 2 + o) * 384 + c] * u);
  }
  reinterpret_cast<h16*>(P.ws + OFF_YHY)[((long)TLAT + b * CTXL + t) * 384 + c] = (h16)u;
  __syncthreads();
}

#ifndef PROBE_HY
#define PROBE_HY 0
#endif
#ifndef PROBE_S5
#define PROBE_S5 0
#endif
DI int first_item(int base) { const int g = (int)gridDim.x; return (((int)blockIdx.x - base) % g + g) % g; }
DI void phase_mix1(const Params& P, int layer, char* smem) {
  const int n_hy = 4 * 384, n_hyc = layer == 0 ? 8 * 384 : 0;
  const int n_kv = (TT / 128) * 8, n_q = (layer == 0 ? TT / 128 : TLAT / 128) * 8;
  const int n_s5 = (NBATCH * 2 * 24 * 132) / 4;
  const int g = gridDim.x;
#pragma unroll 1
  for (int rep = 0; rep < 1 + PROBE_HY; ++rep)
#pragma unroll 1
  for (int i = first_item(0); i < n_hy; i += g) item_hyena(P, layer, i, smem);
  asm volatile("" ::: "memory");
#pragma unroll 1
  for (int i = first_item(n_hy); i < n_kv; i += g) item_kv(P, layer, i, smem);
  asm volatile("" ::: "memory");
#pragma unroll 1
  for (int i = first_item(n_hy + n_kv); i < n_q; i += g) item_q(P, layer, i, smem);
  asm volatile("" ::: "memory");
#pragma unroll 1
  for (int rep = 0; rep < 1 + PROBE_S5; ++rep)
#pragma unroll 1
  for (int i = first_item(n_hy + n_kv + n_q); i < n_s5; i += g) { item_s5_pass1(P, layer, i * 4 + (tidx() >> 6), smem); __syncthreads(); }
  asm volatile("" ::: "memory");
#pragma unroll 1
  for (int i = first_item(n_hy + n_kv + n_q + n_s5); i < n_hyc; i += g) item_hyena_ctx(P, layer, i, smem);
}
DI int crow32(int r, int hi) { return (r & 3) + 8 * (r >> 2) + 4 * hi; }
DI void item_attn(const Params& P, int bh, int q0, int key_lo, int ntiles, char* smem) {
  const int tid = tidx(), lane = tid & 63, wid = tid >> 6, r32 = lane & 31, hi = lane >> 5;
  const h16* Qb = reinterpret_cast<const h16*>(P.ws + OFF_Q) + (long)bh * KEYS * 96;
  const h16* Kb = reinterpret_cast<const h16*>(P.ws + OFF_K) + (long)bh * KEYS * 96;
  const h16* Vt = reinterpret_cast<const h16*>(P.ws + OFF_VT) + (long)bh * 64 * KEYS;
  h16x8 qf[6];
  { const h16* qrow = Qb + (long)(q0 + wid * 32 + r32) * 96 + hi * 8;
#pragma unroll
    for (int ds = 0; ds < 6; ++ds) qf[ds] = *reinterpret_cast<const h16x8*>(qrow + ds * 16); }
  constexpr int KT_BYTES = 64 * 208, VT_BYTES = 64 * 136, BUF = KT_BYTES + VT_BYTES;
  uint4 kr[3]; uint4 vr[2];
  const int vdv0 = tid >> 3, vpart = tid & 7;
  auto gload = [&](int j) {
    const long key0 = key_lo + j * 64;
#pragma unroll
    for (int i = 0; i < 3; ++i) kr[i] = *reinterpret_cast<const uint4*>(Kb + key0 * 96 + (long)(tid + 256 * i) * 8);
#pragma unroll
    for (int i = 0; i < 2; ++i) vr[i] = *reinterpret_cast<const uint4*>(Vt + (long)(vdv0 + 32 * i) * KEYS + key0 + vpart * 8);
  };
  auto swrite = [&](int buf) {
    char* ks = smem + buf * BUF; char* vs = ks + KT_BYTES;
#pragma unroll
    for (int i = 0; i < 3; ++i) { const int c = tid + 256 * i; *reinterpret_cast<uint4*>(ks + (c / 12) * 208 + (c % 12) * 16) = kr[i]; }
#pragma unroll
    for (int i = 0; i < 2; ++i) { char* d = vs + (vdv0 + 32 * i) * 136 + vpart * 16;
      *reinterpret_cast<uint2*>(d) = make_uint2(vr[i].x, vr[i].y); *reinterpret_cast<uint2*>(d + 8) = make_uint2(vr[i].z, vr[i].w); }
  };
  f32x16 o0, o1;
#pragma unroll
  for (int r = 0; r < 16; ++r) { o0[r] = 0.f; o1[r] = 0.f; }
  float m_run = -1e30f, l_run = 0.f;
  gload(0); swrite(0); __syncthreads();
  for (int j = 0; j < ntiles; ++j) {
    if (j + 1 < ntiles) gload(j + 1);
    const char* ks = smem + (j & 1) * BUF; const char* vs = ks + KT_BYTES;
    f32x16 p0, p1;
#pragma unroll
    for (int r = 0; r < 16; ++r) { p0[r] = 0.f; p1[r] = 0.f; }
#pragma unroll
    for (int ds = 0; ds < 6; ++ds) {
      const h16x8 a0 = *reinterpret_cast<const h16x8*>(ks + r32 * 208 + (ds * 16 + hi * 8) * 2);
      const h16x8 a1 = *reinterpret_cast<const h16x8*>(ks + (32 + r32) * 208 + (ds * 16 + hi * 8) * 2);
      p0 = __builtin_amdgcn_mfma_f32_32x32x16_f16(a0, qf[ds], p0, 0, 0, 0);
      p1 = __builtin_amdgcn_mfma_f32_32x32x16_f16(a1, qf[ds], p1, 0, 0, 0);
    }
    float mx = p0[0];
#pragma unroll
    for (int r = 1; r < 16; ++r) mx = fmaxf(mx, p0[r]);
#pragma unroll
    for (int r = 0; r < 16; ++r) mx = fmaxf(mx, p1[r]);
    { const auto rr = __builtin_amdgcn_permlane32_swap(__float_as_uint(mx), __float_as_uint(mx), false, false);
      mx = fmaxf(__uint_as_float(rr[0]), __uint_as_float(rr[1])); }
    const float mnew = fmaxf(m_run, mx);
    const float alpha = __builtin_amdgcn_exp2f(m_run - mnew);
    m_run = mnew;
    float rsum = 0.f;
#pragma unroll
    for (int r = 0; r < 16; ++r) { p0[r] = __builtin_amdgcn_exp2f(p0[r] - mnew); rsum += p0[r]; }
#pragma unroll
    for (int r = 0; r < 16; ++r) { p1[r] = __builtin_amdgcn_exp2f(p1[r] - mnew); rsum += p1[r]; }
    l_run = l_run * alpha + rsum;
    if (__any(alpha != 1.f)) {
#pragma unroll
      for (int r = 0; r < 16; ++r) { o0[r] *= alpha; o1[r] *= alpha; }
    }
#pragma unroll
    for (int kb = 0; kb < 2; ++kb)
#pragma unroll
      for (int s = 0; s < 2; ++s) {
        h16x8 pf;
#pragma unroll
        for (int e = 0; e < 8; ++e) pf[e] = (h16)(kb ? p1[8 * s + e] : p0[8 * s + e]);
        const int koff = (32 * kb + 16 * s + 4 * hi) * 2;
        {
          const h16x4 lo = *reinterpret_cast<const h16x4*>(vs + r32 * 136 + koff), hh = *reinterpret_cast<const h16x4*>(vs + r32 * 136 + koff + 16);
          const h16x8 af = __builtin_shufflevector(lo, hh, 0, 1, 2, 3, 4, 5, 6, 7);
          o0 = __builtin_amdgcn_mfma_f32_32x32x16_f16(af, pf, o0, 0, 0, 0);
        }
        {
          const h16x4 lo = *reinterpret_cast<const h16x4*>(vs + (32 + r32) * 136 + koff), hh = *reinterpret_cast<const h16x4*>(vs + (32 + r32) * 136 + koff + 16);
          const h16x8 af = __builtin_shufflevector(lo, hh, 0, 1, 2, 3, 4, 5, 6, 7);
          o1 = __builtin_amdgcn_mfma_f32_32x32x16_f16(af, pf, o1, 0, 0, 0);
        }
      }
    if (j + 1 < ntiles) swrite((j + 1) & 1);
    __syncthreads();
  }
  const float lt = l_run + __shfl_xor(l_run, 32);
  const float inv = 1.f / lt;
  {
    h16* Os = reinterpret_cast<h16*>(smem);
    h16* orow = Os + (wid * 32 + r32) * 72;
#pragma unroll
    for (int g = 0; g < 4; ++g) {
      h16x4 a, c;
#pragma unroll
      for (int e = 0; e < 4; ++e) { a[e] = (h16)(o0[4 * g + e] * inv); c[e] = (h16)(o1[4 * g + e] * inv); }
      *reinterpret_cast<h16x4*>(orow + 8 * g + 4 * hi) = a;
      *reinterpret_cast<h16x4*>(orow + 32 + 8 * g + 4 * hi) = c;
    }
    __syncthreads();
    const int b = bh >> 3, hd = bh & 7;
    const long tok0 = q0 < SEQ ? (long)b * SEQ + q0 : (long)TLAT + b * CTXL + (q0 - SEQ);
    h16* yb = reinterpret_cast<h16*>(P.ws + OFF_YMLA) + tok0 * 512 + hd * 64;
#pragma unroll
    for (int it = 0; it < 4; ++it) {
      const int chunk = it * 256 + tid, row = chunk >> 3, c8 = (chunk & 7) * 8;
      *reinterpret_cast<uint4*>(yb + (long)row * 512 + c8) = *reinterpret_cast<const uint4*>(Os + row * 72 + c8);
    }
    __syncthreads();
  }
}
DI void item_s5_pass3(const Params& P, int layer, int b, int g, int ck, char* smem) {
  const int lane = tidx() & 63, wid = tidx() >> 6, fr = lane & 15, fq = lane >> 4;
  float* us = reinterpret_cast<float*>(smem + wid * 12800); char* Hs = smem + wid * 12800 + 4096;
  const int tokbase = ck < 4 ? TLAT + b * CTXL + ck * 64 : b * SEQ + (ck - 4) * 64;
  s5_stage_u(reinterpret_cast<const h16*>(P.ws + OFF_U), tokbase, g, us);
  __syncthreads();
  f32x4 yacc[4];
#pragma unroll
  for (int i = 0; i < 4; ++i) yacc[i] = f32x4{0.f, 0.f, 0.f, 0.f};
#pragma unroll
  for (int dir = 0; dir < 2; ++dir) {
    const long gi = (long)(layer * 2 + dir) * 24 + g;
    const float2 a = reinterpret_cast<const float2*>(P.ws + OFF_S5A)[gi * 64 + lane];
    const float2 a64 = reinterpret_cast<const float2*>(P.ws + OFF_S5A64)[gi * 64 + lane];
    const float2* Bb = reinterpret_cast<const float2*>(P.ws + OFF_S5B) + (gi * 64 + lane) * 16;
    float bre[16], bim[16];
#pragma unroll
    for (int c = 0; c < 16; ++c) { const float2 v = Bb[c]; bre[c] = v.x; bim[c] = v.y; }
    const int si = ck < 4 ? (dir ? 3 - ck : ck) : 4 + (dir ? 127 - (ck - 4) : ck - 4);
    const float2* Ep = reinterpret_cast<const float2*>(P.ws + OFF_E) + ((long)((b * 2 + dir) * 24 + g) * 132) * 64 + lane;
    float hr = 0.f, hi = 0.f;
#pragma unroll 16
    for (int i = 0; i < si; ++i) { const float2 e = Ep[(long)i * 64]; const float nr = a64.x * hr - a64.y * hi + e.x, ni = a64.x * hi + a64.y * hr + e.y; hr = nr; hi = ni; }
    const h16* Ct = reinterpret_cast<const h16*>(P.ws + OFF_S5C) + gi * 16 * 128 + fr * 128 + fq * 8;
    h16x8 cf[4];
#pragma unroll
    for (int ks = 0; ks < 4; ++ks) cf[ks] = *reinterpret_cast<const h16x8*>(Ct + ks * 32);
#pragma unroll
    for (int half = 0; half < 2; ++half) {
#pragma unroll 4
      for (int s = 0; s < 32; ++s) {
        const int step = half * 32 + s; const int tau = dir ? 63 - step : step;
        const float4* up = reinterpret_cast<const float4*>(us + tau * 16);
        float br = 0.f, bi = 0.f;
#pragma unroll
        for (int q = 0; q < 4; ++q) { const float4 u = up[q];
          br += bre[q * 4] * u.x + bre[q * 4 + 1] * u.y + bre[q * 4 + 2] * u.z + bre[q * 4 + 3] * u.w;
          bi += bim[q * 4] * u.x + bim[q * 4 + 1] * u.y + bim[q * 4 + 2] * u.z + bim[q * 4 + 3] * u.w; }
        const float nr = a.x * hr - a.y * hi + br, ni = a.x * hi + a.y * hr + bi; hr = nr; hi = ni;
        h16* hrow = reinterpret_cast<h16*>(Hs + (tau & 31) * 272);
        hrow[lane] = (h16)hr; hrow[64 + lane] = (h16)hi;
      }
      __syncthreads();
      const int tb = dir ? 1 - half : half;
#pragma unroll
      for (int sb2 = 0; sb2 < 2; ++sb2)
#pragma unroll
        for (int ks = 0; ks < 4; ++ks) {
          const h16x8 bf = *reinterpret_cast<const h16x8*>(Hs + (sb2 * 16 + fr) * 272 + (ks * 32 + fq * 8) * 2);
          yacc[tb * 2 + sb2] = __builtin_amdgcn_mfma_f32_16x16x32_f16(cf[ks], bf, yacc[tb * 2 + sb2], 0, 0, 0);
        }
      __syncthreads();
    }
  }
  const float* dsk = P.in[I_S5D] + layer * 384 + g * 16 + fq * 4;
  h16* Y = reinterpret_cast<h16*>(P.ws + OFF_YS5PRE);
#pragma unroll
  for (int sbi = 0; sbi < 4; ++sbi) {
    const int tl = sbi * 16 + fr; h16x4 o;
#pragma unroll
    for (int j = 0; j < 4; ++j) o[j] = (h16)geluf_(yacc[sbi][j] + dsk[j] * us[tl * 16 + fq * 4 + j]);
    *reinterpret_cast<h16x4*>(Y + (long)(tokbase + tl) * 384 + g * 16 + fq * 4) = o;
  }
  __syncthreads();
}
DI void phase_mix2(const Params& P, int layer, char* smem) {
  if ((gridDim.x & 7) == 0) {
    const int xcd = blockIdx.x & 7, li = blockIdx.x >> 3, nloc = gridDim.x >> 3;
    for (int k = li; k < 512; k += nloc) item_attn(P, xcd + 8 * (k >> 6), (k & 63) * 128, 0, KEYS / 64, smem);
  } else {
    for (int k = blockIdx.x; k < 4096; k += gridDim.x) item_attn(P, k >> 6, (k & 63) * 128, 0, KEYS / 64, smem);
  }
  const int n_actx = layer == 0 ? 128 : 0;
  const int nck = layer == 0 ? 132 : 128;
  const int n_s5 = NBATCH * 24 * nck / 4;
  for (int it = blockIdx.x; it < n_actx + n_s5; it += gridDim.x) {
    if (it < n_actx) { item_attn(P, it >> 1, SEQ + (it & 1) * 128, SEQ, CTXL / 64, smem); continue; }
    const int w = (it - n_actx) * 4 + (tidx() >> 6);
    const int ck = w % nck + (layer == 0 ? 0 : 4); const int r = w / nck;
    item_s5_pass3(P, layer, r / 24, r % 24, ck, smem);
  }
}
DI void item_yhy_transpose(const Params& P, int item, char* smem) {
  h16* T = reinterpret_cast<h16*>(smem);
  const int tid = tidx();
  const int tt = item & 127, ct = (item >> 7) % 6, b = item / (128 * 6);
  const h16* src = reinterpret_cast<const h16*>(P.ws + OFF_PHY) + ((long)b * 1152 + ct * 64) * SEQ + tt * 64;
  h16* dst = reinterpret_cast<h16*>(P.ws + OFF_YHY) + ((long)b * SEQ + tt * 64) * 384 + ct * 64;
#pragma unroll
  for (int i = 0; i < 2; ++i) {
    const int chunk = tid + 256 * i, cr = chunk >> 3, tp = (chunk & 7) * 8;
    const h16x8 v = *reinterpret_cast<const h16x8*>(src + (long)cr * SEQ + tp);
#pragma unroll
    for (int e = 0; e < 8; ++e) T[cr * 66 + tp + e] = v[e];
  }
  __syncthreads();
#pragma unroll
  for (int i = 0; i < 2; ++i) {
    const int chunk = tid + 256 * i, tr = chunk >> 3, cp = (chunk & 7) * 8;
    h16x8 o;
#pragma unroll
    for (int e = 0; e < 8; ++e) o[e] = T[(cp + e) * 66 + tr];
    *reinterpret_cast<h16x8*>(dst + (long)tr * 384 + cp) = o;
  }
  __syncthreads();
}
DI void phase_glu(const Params& P, int layer, char* smem) {
  const int tid = tidx(), lane = tid & 63, wid = tid >> 6, wr = wid >> 1, wc = wid & 1, fr = lane & 15, fq = lane >> 4;
  const h16* A = reinterpret_cast<const h16*>(P.ws + OFF_YS5PRE);
  const h16* W = reinterpret_cast<const h16*>(P.ws + OFF_WT) + (long)layer * WT_LAYER + WT_GLU;
  h16* Y = reinterpret_cast<h16*>(P.ws + OFF_YS5);
#pragma unroll 1
  for (int it = blockIdx.x; it < NBATCH * 6 * 128; it += gridDim.x) item_yhy_transpose(P, it, smem);
  asm volatile("" ::: "memory");
  const int MT = (layer == 0 ? TT : TLAT) / 128;
  const TileWalk tw = tw_init(MT, 6);
  for (int tile = tw.lb; tile < tw_count(tw); tile += tw.nlb) {
    int mt, nt; tw_decode(tw, tile, mt, nt);
    f32x4 acc[4][4]; acc_zero(acc);
    gemm_kloop(acc, A + (long)mt * 128 * 384, 384, 0, 128, W + (long)nt * 128 * 384, 384, 384, smem, opaque_tid());
    {
      float* Zs = reinterpret_cast<float*>(smem);
#pragma unroll
      for (int m = 0; m < 4; ++m)
#pragma unroll
        for (int np = 0; np < 2; ++np)
#pragma unroll
          for (int j = 0; j < 4; ++j)
            Zs[(wr * 64 + m * 16 + fq * 4 + j) * 132 + wc * 32 + np * 16 + fr] = acc[m][2 * np][j] * sigmoidf_(acc[m][2 * np + 1][j]);
      __syncthreads();
      const int t2 = tidx();
#pragma unroll
      for (int it = 0; it < 4; ++it) {
        const int chunk = it * 256 + t2, row = chunk >> 3, c8 = (chunk & 7) * 8;
        const float4 x0 = *reinterpret_cast<const float4*>(Zs + row * 132 + c8), x1 = *reinterpret_cast<const float4*>(Zs + row * 132 + c8 + 4);
        h16x8 o; o[0] = (h16)x0.x; o[1] = (h16)x0.y; o[2] = (h16)x0.z; o[3] = (h16)x0.w; o[4] = (h16)x1.x; o[5] = (h16)x1.y; o[6] = (h16)x1.z; o[7] = (h16)x1.w;
        *reinterpret_cast<h16x8*>(Y + (long)(mt * 128 + row) * 384 + nt * 64 + c8) = o;
      }
      __syncthreads();
    }
  }
}
DI void phase_merge(const Params& P, int layer, char* smem) {
  const h16* H = reinterpret_cast<const h16*>(P.ws + OFF_H1);
  const h16* WL = reinterpret_cast<const h16*>(P.ws + OFF_WT) + (long)layer * WT_LAYER;
  h16* Mg = reinterpret_cast<h16*>(P.ws + OFF_MERGED);
  const int MT = (layer == 0 ? TT : TLAT) / 128;
  const TileWalk tw = tw_init(MT, 8);
  for (int tile = tw.lb; tile < tw_count(tw); tile += tw.nlb) {
    int mt, nt; tw_decode(tw, tile, mt, nt);
    h16* Tmp = reinterpret_cast<h16*>(P.ws + OFF_YS5PRE) + (long)blockIdx.x * 32768;
    h16* Run = Tmp + 16384;
#pragma unroll 1
    for (int br = 0; br < 3; ++br) {
      const h16* Ab; const h16* Wb; int Kb;
      if (br == 0) { Ab = reinterpret_cast<const h16*>(P.ws + OFF_YHY) + (long)mt * 128 * 384; Wb = WL + WT_BRHY + (long)nt * 128 * 384; Kb = 384; }
      else if (br == 1) { Ab = reinterpret_cast<const h16*>(P.ws + OFF_YS5) + (long)mt * 128 * 384; Wb = WL + WT_BRS5 + (long)nt * 128 * 384; Kb = 384; }
      else { Ab = reinterpret_cast<const h16*>(P.ws + OFF_YMLA) + (long)mt * 128 * 512; Wb = WL + WT_BRMLA + (long)nt * 128 * 512; Kb = 512; }
      {
        f32x4 acc[4][4]; acc_zero(acc);
        gemm_kloop(acc, Ab, Kb, 0, 128, Wb, Kb, Kb, smem, opaque_tid());
        const int tid = tidx();
#pragma unroll
        for (int m = 0; m < 4; ++m)
#pragma unroll
          for (int n = 0; n < 4; ++n) {
            h16x4 o; o[0] = (h16)acc[m][n][0]; o[1] = (h16)acc[m][n][1]; o[2] = (h16)acc[m][n][2]; o[3] = (h16)acc[m][n][3];
            *reinterpret_cast<h16x4*>(Tmp + ((m * 4 + n) * 256 + tid) * 4) = o;
          }
      }
      f32x4 acc[4][4]; acc_zero(acc);
      gemm_kloop(acc, H + (long)mt * 128 * LD1, LD1, 0, 128, WL + WT_WGATE + (long)(br * 1024 + nt * 128) * LD1, LD1, 1024, smem, opaque_tid());
      const int tid = tidx();
      h16x4 bv[16], rv[16];
#pragma unroll
      for (int q = 0; q < 16; ++q) bv[q] = *reinterpret_cast<const h16x4*>(Tmp + (q * 256 + tid) * 4);
      if (br > 0) {
#pragma unroll
        for (int q = 0; q < 16; ++q) rv[q] = *reinterpret_cast<const h16x4*>(Run + (q * 256 + tid) * 4);
      } else {
#pragma unroll
        for (int q = 0; q < 16; ++q) rv[q] = h16x4{(h16)0.f, (h16)0.f, (h16)0.f, (h16)0.f};
      }
#pragma unroll
      for (int m = 0; m < 4; ++m)
#pragma unroll
        for (int n = 0; n < 4; ++n)
#pragma unroll
          for (int j = 0; j < 4; ++j) acc[m][n][j] = (float)rv[m * 4 + n][j] + sigmoidf_(acc[m][n][j]) * (float)bv[m * 4 + n][j];
      if (br < 2) {
#pragma unroll
        for (int m = 0; m < 4; ++m)
#pragma unroll
          for (int n = 0; n < 4; ++n) {
            h16x4 o; o[0] = (h16)acc[m][n][0]; o[1] = (h16)acc[m][n][1]; o[2] = (h16)acc[m][n][2]; o[3] = (h16)acc[m][n][3];
            *reinterpret_cast<h16x4*>(Run + ((m * 4 + n) * 256 + tid) * 4) = o;
          }
      } else {
        float* Zs = reinterpret_cast<float*>(smem);
        stage_acc(acc, Zs, tid);
        copy_out_f16(Zs, Mg, (long)mt * 128, LD1, nt * 128, tid);
        __syncthreads();
      }
    }
  }
}
DI void phase_resid(const Params& P, int layer, int stage_src, size_t a_off, int K, long w_off, int gate_idx, char* smem) {
  const int tid = tidx(), lane = tid & 63, wid = tid >> 6, wr = wid >> 1, wc = wid & 1, fr = lane & 15, fq = lane >> 4;
  const h16* A = reinterpret_cast<const h16*>(P.ws + a_off);
  const h16* W = reinterpret_cast<const h16*>(P.ws + OFF_WT) + (long)layer * WT_LAYER + w_off;
  const float* mod = reinterpret_cast<const float*>(P.ws + OFF_MOD) + (long)layer * 9 * 6144 + gate_idx * 1024;
  const int MT = (layer == 0 ? TT : TLAT) / 128;
  const TileWalk tw = tw_init(MT, 8);
  for (int tile = tw.lb; tile < tw_count(tw); tile += tw.nlb) {
    int mt, nt; tw_decode(tw, tile, mt, nt);
    f32x4 acc[4][4]; acc_zero(acc);
    const int ld = K == 1024 ? LD1 : LD2;
    gemm_kloop(acc, A + (long)mt * 128 * ld, ld, 0, 128, W + (long)nt * 128 * ld, ld, K, smem, opaque_tid());
    const Tok tk = tokinfo(mt * 128);
    float* Zs = reinterpret_cast<float*>(smem);
    const int t2 = tidx();
    stage_acc(acc, Zs, t2);
    const int c4 = (t2 & 31) * 4;
    const float4 g4 = *reinterpret_cast<const float4*>(mod + tk.mrow * 6144 + nt * 128 + c4);
#pragma unroll
    for (int it = 0; it < 16; ++it) {
      const int row = it * 8 + (t2 >> 5); const int t = mt * 128 + row;
      const float4 a4 = *reinterpret_cast<const float4*>(Zs + row * 132 + c4);
      const float4 x4 = *reinterpret_cast<const float4*>(xrow_src(P, stage_src, t) + nt * 128 + c4);
      *reinterpret_cast<float4*>(xrow_dst(P, t) + nt * 128 + c4) = make_float4(x4.x + g4.x * a4.x, x4.y + g4.y * a4.y, x4.z + g4.z * a4.z, x4.w + g4.w * a4.w);
    }
    __syncthreads();
  }
}
DI void phase_ffn_up(const Params& P, int layer, char* smem) {
  const int tid = tidx(), lane = tid & 63, wid = tid >> 6, wr = wid >> 1, wc = wid & 1, fr = lane & 15, fq = lane >> 4;
  const h16* H = reinterpret_cast<const h16*>(P.ws + OFF_H2);
  const h16* W = reinterpret_cast<const h16*>(P.ws + OFF_WT) + (long)layer * WT_LAYER + WT_UP;
  h16* F = reinterpret_cast<h16*>(P.ws + OFF_F);
  const float* cw = P.in[I_FCW] + (long)layer * 3 * 5632; const float* cb = P.in[I_FCB] + (long)layer * 5632;
  float* Zs = reinterpret_cast<float*>(smem);
  const int n_mt = 8 * 66 + (layer == 0 ? 8 * 3 : 0);
  const TileWalk tw = tw_init(n_mt, 44);
  for (int tile = tw.lb; tile < tw_count(tw); tile += tw.nlb) {
    int mi, nt; tw_decode(tw, tile, mi, nt);
    int seq0, Ls, ti;
    if (mi < 528) { seq0 = (mi / 66) * SEQ; Ls = SEQ; ti = mi % 66; } else { const int u = mi - 528; seq0 = TLAT + (u / 3) * CTXL; Ls = CTXL; ti = u % 3; }
    const int p0 = ti * 126 - 1;
    const int a_lo = ti == 0 ? 1 : 0, a_hi = min(128, Ls - p0);
    const int nout = min(126, Ls - ti * 126);
    f32x4 acc[4][4]; acc_zero(acc);
    gemm_kloop(acc, H + ((long)seq0 + p0) * LD1, LD1, a_lo, a_hi, W + (long)nt * 128 * LD1, LD1, 1024, smem, opaque_tid());
#pragma unroll
    for (int m = 0; m < 4; ++m)
#pragma unroll
      for (int n = 0; n < 4; ++n)
#pragma unroll
        for (int j = 0; j < 4; ++j)
          Zs[(wr * 64 + m * 16 + fq * 4 + j) * 132 + 2 * (wc * 32 + (n >> 1) * 16 + fr) + (n & 1)] = acc[m][n][j];
    __syncthreads();
    {
      const int jc = tid & 63, rg = tid >> 6;
      const float2* Z2 = reinterpret_cast<const float2*>(Zs);
      const int cu = nt * 64 + jc, cg = 2816 + cu;
      const float wu0 = cw[cu], wu1 = cw[5632 + cu], wu2 = cw[2 * 5632 + cu], bu = cb[cu];
      const float wg0 = cw[cg], wg1 = cw[5632 + cg], wg2 = cw[2 * 5632 + cg], bg = cb[cg];
      const int r0 = rg * 32 + 1, r1 = min(r0 + 31, nout);
      float2 zm = Z2[(r0 - 1) * 66 + jc], z0 = Z2[r0 * 66 + jc];
      h16* fp = F + ((long)seq0 + p0 + r0) * LD2 + cu;
#pragma unroll 4
      for (int r = r0; r <= r1; ++r) {
        const float2 zp = Z2[(r + 1) * 66 + jc];
        const float au = wu0 * zm.x + wu1 * z0.x + wu2 * zp.x + bu;
        const float ag = wg0 * zm.y + wg1 * z0.y + wg2 * zp.y + bg;
        *fp = (h16)(siluf_(au) * ag); fp += LD2;
        zm = z0; z0 = zp;
      }
    }
    __syncthreads();
  }
}
DI void phase_norm2(const Params& P, int layer) { normmod_rows(P, layer, 1, 1, layer == 0 ? TT : TLAT, blockIdx.x, gridDim.x); }

constexpr int N_PHASES = 22;
#ifndef PROBE_REPEAT
#define PROBE_REPEAT 0u
#endif
template <int PH> DI void run_phase_t(const Params& P, char* smem) {
  asm volatile("" ::: "memory");
  if constexpr (PH == 0) phase_prologue(P, smem);
  else if constexpr (PH == 21) phase_final(P);
  else {
    constexpr int layer = (PH - 1) / 10, s = (PH - 1) % 10;
    if constexpr (s == 0) phase_norm1(P, layer, smem);
    else if constexpr (s == 1) phase_gemm_in(P, layer, smem);
    else if constexpr (s == 2) phase_mix1(P, layer, smem);
    else if constexpr (s == 3) phase_mix2(P, layer, smem);
    else if constexpr (s == 4) phase_glu(P, layer, smem);
    else if constexpr (s == 5) phase_merge(P, layer, smem);
    else if constexpr (s == 6) phase_resid(P, layer, layer, OFF_MERGED, 1024, WT_WO, 2, smem);
    else if constexpr (s == 7) phase_norm2(P, layer);
    else if constexpr (s == 8) phase_ffn_up(P, layer, smem);
    else phase_resid(P, layer, 1, OFF_F, 2816, WT_DOWN, 5, smem);
  }
}
DI void run_phase(const Params& P, int ph, char* smem) {
  switch (ph) {
#define RP(i) case i: run_phase_t<i>(P, smem); break;
    RP(0) RP(1) RP(2) RP(3) RP(4) RP(5) RP(6) RP(7) RP(8) RP(9) RP(10) RP(11) RP(12) RP(13) RP(14) RP(15) RP(16) RP(17) RP(18) RP(19) RP(20) RP(21)
#undef RP
    default: break;
  }
}
#ifndef MULTI_LAUNCH
#define MULTI_LAUNCH 0
#endif
#define XB_TMO      128
#define XB_XCNT(j)  (256  + 64 * (j))
#define XB_XSUB(j)  (1280 + 64 * (j))
#define XB_XGEN(j)  (2304 + 64 * (j))
#define XB_TOP      3328
#define XB_TOPGEN   3392
#define XCD_BAR_WORDS 3456
#define XB_SPIN_CAP (1u << 22)
#define LAS __attribute__((address_space(3)))
DI unsigned xb_ld(unsigned* p)              { return __hip_atomic_load(p, __ATOMIC_RELAXED, __HIP_MEMORY_SCOPE_AGENT); }
DI unsigned xb_add(unsigned* p, unsigned v) { return __hip_atomic_fetch_add(p, v, __ATOMIC_RELAXED, __HIP_MEMORY_SCOPE_AGENT); }
DI unsigned xb_xcc_id() { return (unsigned)__builtin_amdgcn_s_getreg((3 << 11) | 20) & 0xFu; }
#define XB_SPIN(cond, bar) do { unsigned _sp = 0; while (cond) { __builtin_amdgcn_s_sleep(1); \
    if ((++_sp & 255u) == 0u) { if (xb_ld(&(bar)[XB_TMO])) break; if (_sp > XB_SPIN_CAP) { atomicAdd(&(bar)[XB_TMO], 1u); break; } } } } while (0)
struct XcdBarrier { unsigned* bar; unsigned x; volatile LAS unsigned* st; };
DI XcdBarrier xcd_barrier_post(unsigned* bar, volatile LAS unsigned* st) {
  XcdBarrier b; b.bar = bar; b.x = xb_xcc_id(); b.st = st;
  if (threadIdx.x == 0) (void)xb_add(&bar[XB_XCNT(b.x)], 1u);
  return b;
}
DI void xcd_barrier_complete(unsigned* bar, unsigned x, unsigned& nloc, unsigned& nx) {
  const unsigned G = gridDim.x * gridDim.y * gridDim.z;
  unsigned sum, cnt, mine, sp = 0u;
  for (;;) {
    sum = 0u; cnt = 0u; mine = 0u;
#pragma unroll
    for (unsigned j = 0; j < 16; ++j) { const unsigned c = xb_ld(&bar[XB_XCNT(j)]); sum += c; cnt += (c > 0u) ? 1u : 0u; mine = (j == x) ? c : mine; }
    if (sum == G) break;
    __builtin_amdgcn_s_sleep(1);
    if ((++sp & 255u) == 0u) { if (xb_ld(&bar[XB_TMO])) break; if (sp > XB_SPIN_CAP) { atomicAdd(&bar[XB_TMO], 1u); break; } }
  }
  nloc = mine > 0u ? mine : 1u; nx = cnt > 0u ? cnt : 1u;
}
DI void xcd_barrier(const XcdBarrier& b) {
  asm volatile("s_waitcnt vmcnt(0)" ::: "memory");
  __syncthreads();
  if (threadIdx.x == 0) {
    unsigned* bar = b.bar;
    __builtin_amdgcn_s_waitcnt(0);
    unsigned nloc = b.st[0], nx = b.st[1];
    if (nloc == 0u) { xcd_barrier_complete(bar, b.x, nloc, nx); b.st[0] = nloc; b.st[1] = nx; }
    const unsigned old = xb_add(&bar[XB_XSUB(b.x)], 1u);
    const unsigned gen = old / nloc;
    if (old + 1u == (gen + 1u) * nloc) {
      __builtin_amdgcn_fence(__ATOMIC_RELEASE, "agent");
      asm volatile("s_waitcnt vmcnt(0)" ::: "memory");
      const unsigned og = xb_add(&bar[XB_TOP], 1u);
      const unsigned tg = og / nx;
      if (og + 1u == (tg + 1u) * nx) xb_add(&bar[XB_TOPGEN], 1u);
      else XB_SPIN(xb_ld(&bar[XB_TOPGEN]) == tg, bar);
      __builtin_amdgcn_fence(__ATOMIC_ACQUIRE, "agent");
      xb_add(&bar[XB_XGEN(b.x)], 1u);
      asm volatile("s_waitcnt vmcnt(0)" ::: "memory");
    } else {
      XB_SPIN(xb_ld(&bar[XB_XGEN(b.x)]) == gen, bar);
      __builtin_amdgcn_fence(__ATOMIC_ACQUIRE, "agent");
      asm volatile("s_waitcnt vmcnt(0)" ::: "memory");
    }
  }
  __syncthreads();
}
__global__ void __launch_bounds__(NTHREADS, 2) fwd_megakernel(Params P) {
  extern __shared__ __attribute__((aligned(16))) char smem[];
  cg::grid_group grid = cg::this_grid();
  volatile LAS unsigned* st = (volatile LAS unsigned*)(smem + SMEM_BYTES - 16);
  if (threadIdx.x == 0) { st[0] = 0u; st[1] = 0u; st[2] = 0u; st[3] = 0u; }
  __syncthreads();
  const XcdBarrier xb = xcd_barrier_post(reinterpret_cast<unsigned*>(P.ws + OFF_BAR), st);
  run_phase_t<0>(P, smem); grid.sync();
#define RP(i) run_phase_t<i>(P, smem); xcd_barrier(xb); if constexpr ((PROBE_REPEAT >> i) & 1) { run_phase_t<i>(P, smem); xcd_barrier(xb); }
  RP(1) RP(2) RP(3) RP(4) RP(5) RP(6) RP(7) RP(8) RP(9) RP(10) RP(11) RP(12) RP(13) RP(14) RP(15) RP(16) RP(17) RP(18) RP(19) RP(20)
#undef RP
#ifdef PROBE_SYNC
  for (int i = 0; i < PROBE_SYNC; ++i) xcd_barrier(xb);
#endif
  run_phase_t<21>(P, smem);
}
#if MULTI_LAUNCH
__global__ void __launch_bounds__(NTHREADS, 2) fwd_phase_kernel(Params P, int ph) {
  extern __shared__ __attribute__((aligned(16))) char smem[];
  run_phase(P, ph, smem);
}
#endif

extern "C" void kernel_launch(void* const* d_in, const int* in_sizes, int n_in, void* d_out, int out_size, void* d_ws, size_t ws_size,
                              hipStream_t stream) {
  static int grid_blocks = 0;
  if (!grid_blocks) {
    int dev = 0, cus = 0, per_cu = 0;
    (void)hipGetDevice(&dev);
    (void)hipDeviceGetAttribute(&cus, hipDeviceAttributeMultiprocessorCount, dev);
    (void)hipFuncSetAttribute((const void*)fwd_megakernel, hipFuncAttributeMaxDynamicSharedMemorySize, SMEM_BYTES);
#if MULTI_LAUNCH
    (void)hipFuncSetAttribute((const void*)fwd_phase_kernel, hipFuncAttributeMaxDynamicSharedMemorySize, SMEM_BYTES);
#endif
    (void)hipOccupancyMaxActiveBlocksPerMultiprocessor(&per_cu, fwd_megakernel, NTHREADS, SMEM_BYTES);
    if (per_cu > 2) per_cu = 2;
    if (per_cu < 1) per_cu = 1;
#ifdef PROBE_FORCE2
    per_cu = 2;
#endif
    grid_blocks = cus * per_cu;
    if (ws_size < OFF_END) fprintf(stderr, "workspace too small: %zu < %zu\n", ws_size, (size_t)OFF_END);
  }
  Params p{};
  for (int i = 0; i < 41; ++i) p.in[i] = (const float*)d_in[i];
  p.out = (float*)d_out; p.ws = (char*)d_ws; p.pad_ = 0;
#if MULTI_LAUNCH
  for (int ph = 0; ph < N_PHASES; ++ph) hipLaunchKernelGGL(fwd_phase_kernel, dim3(grid_blocks), dim3(NTHREADS), SMEM_BYTES, stream, p, ph);
#else
  (void)hipMemsetAsync((char*)d_ws + OFF_BAR, 0, XCD_BAR_WORDS * 4, stream);
  void* args[] = {&p};
  hipError_t e = hipLaunchCooperativeKernel((void*)fwd_megakernel, dim3(grid_blocks), dim3(NTHREADS), args, SMEM_BYTES, stream);
  if (e != hipSuccess) fprintf(stderr, "cooperative launch failed: %s (grid %d)\n", hipGetErrorString(e), grid_blocks);
#endif
}
```
